# Optimizing an MI355X kernel written in HIP

```python
import jax
import jax.numpy as jnp
from jax import lax
import numpy as np

D_MODEL = 2048
BATCH = 32
SEQ = 256
DEPTH = 4
DEC_BATCH = 8
DEC_SEQ = 2048
PAST_LEN = 256

GRID_W = 64
HEAD_DIM = 128
N_HEADS = D_MODEL // HEAD_DIM
N_KV_HEADS = N_HEADS // 4
Q_GROUP = N_HEADS // N_KV_HEADS
Q_BLOCK = 128
ROPE_BASE = 10000.0
ROPE_FREQS = HEAD_DIM // 4
LRU_WIDTH = D_MODEL
LRU_BLOCKS = 16
LRU_BW = LRU_WIDTH // LRU_BLOCKS
CONV_W = 4
CONV_PAD_L = 2
LRU_C = 8.0
CHUNK = 128
CMLP_WIDTH = D_MODEL
CMLP_GROUPS = 16
CMLP_GW = CMLP_WIDTH // CMLP_GROUPS
D_FF = 4 * D_MODEL
N_BRANCH = 3
N_MOD = 6
EPS = 1e-6
Q_W = N_HEADS * HEAD_DIM
KV_W = N_KV_HEADS * HEAD_DIM
IN_SPLITS = (Q_W, KV_W, KV_W, LRU_WIDTH, LRU_WIDTH, CMLP_WIDTH, CMLP_WIDTH, N_BRANCH * D_MODEL)
IN_W = Q_W + 2 * KV_W + 2 * LRU_WIDTH + 2 * CMLP_WIDTH + N_BRANCH * D_MODEL

kernel_name = 'hybrid_gated_rglru_gqa_chunkmlp_step'


def _rmsnorm(x, g):
    xf = x.astype(jnp.float32)
    y = xf * lax.rsqrt(jnp.mean(xf * xf, axis=-1, keepdims=True) + EPS)
    return (y * g.astype(jnp.float32)).astype(x.dtype)


def _split_in(z):
    idx = []
    off = 0
    for s in IN_SPLITS[:-1]:
        off += s
        idx.append(off)
    return jnp.split(z, idx, axis=-1)


def _modulation(cond, w_mod, b_mod):
    m = jax.nn.silu(cond) @ w_mod + b_mod
    return [t[:, None, :] for t in jnp.split(m, N_MOD, axis=-1)]


def _axial_rope(n_tokens):
    rows = n_tokens // GRID_W
    pos_row = jnp.repeat(jnp.arange(rows), GRID_W).astype(jnp.float32)
    pos_col = (jnp.arange(n_tokens) % GRID_W).astype(jnp.float32)
    inv = ROPE_BASE ** (-jnp.arange(ROPE_FREQS, dtype=jnp.float32) / ROPE_FREQS)
    ang = jnp.stack([pos_row[:, None] * inv, pos_col[:, None] * inv], axis=1)
    return jnp.cos(ang), jnp.sin(ang)


def _apply_rope(x, cos, sin):
    xs = x.astype(jnp.float32).reshape(*x.shape[:-1], 2, 2, ROPE_FREQS)
    xa = xs[..., 0, :]
    xb = xs[..., 1, :]
    c = cos[None, :, None]
    s = sin[None, :, None]
    out = jnp.stack([xa * c - xb * s, xa * s + xb * c], axis=-2)
    return out.reshape(x.shape).astype(x.dtype)


def _attend(q, k, v):
    b, tq = q.shape[0], q.shape[1]
    nb = tq // Q_BLOCK
    qb = q.reshape(b, nb, Q_BLOCK, N_KV_HEADS, Q_GROUP, HEAD_DIM).transpose(1, 0, 2, 3, 4, 5)
    scale = HEAD_DIM ** -0.5

    def one_block(qblk):
        s = jnp.einsum('bqhgd,bkhd->bhgqk', qblk, k, preferred_element_type=jnp.float32) * scale
        p = jax.nn.softmax(s, axis=-1)
        return jnp.einsum('bhgqk,bkhd->bqhgd', p.astype(v.dtype), v)

    o = lax.map(one_block, qb)
    return o.transpose(1, 0, 2, 3, 4, 5).reshape(b, tq, Q_W)


def _dwconv(x, w, b):
    t = x.shape[1]
    xp = jnp.pad(x, ((0, 0), (CONV_PAD_L, CONV_W - 1 - CONV_PAD_L), (0, 0)))
    y = b
    for j in range(CONV_W):
        y = y + xp[:, j:j + t] * w[j]
    return y


def _blockdiag(x, w, b):
    xb = x.reshape(*x.shape[:-1], LRU_BLOCKS, LRU_BW)
    return jnp.einsum('btnc,ncd->btnd', xb, w).reshape(x.shape) + b


def _lin_combine(e1, e2):
    a1, b1 = e1
    a2, b2 = e2
    return (a1 * a2, a2 * b1 + b2)


def _rglru_dir(x, w_a, b_a, w_x, b_x, lam, h0, reverse):
    xf = x.astype(jnp.float32)
    r = jax.nn.sigmoid(_blockdiag(x, w_a, b_a).astype(jnp.float32))
    i = jax.nn.sigmoid(_blockdiag(x, w_x, b_x).astype(jnp.float32))
    log_a = -LRU_C * r * jax.nn.softplus(-lam.astype(jnp.float32))
    a = jnp.exp(log_a)
    bterm = jnp.sqrt(jnp.maximum(-jnp.expm1(2.0 * log_a), 0.0)) * (i * xf)
    edge = -1 if reverse else 0
    bterm = bterm.at[:, edge].add(a[:, edge] * h0.astype(jnp.float32))
    _, h = lax.associative_scan(_lin_combine, (a, bterm), axis=1, reverse=reverse)
    return h


def _chunk_mix(zu, zv, g_norm, w_s, b_s):
    b, t, _ = zu.shape
    u = jax.nn.gelu(zu)
    v = _rmsnorm(jax.nn.gelu(zv), g_norm)
    vb = v.reshape(b, t // CHUNK, CHUNK, CMLP_GROUPS, CMLP_GW)
    mixed = jnp.einsum('gqp,bnpgc->bnqgc', w_s, vb) + b_s.T[None, None, :, :, None]
    return u * mixed.reshape(b, t, CMLP_WIDTH)


def _layer(x, cond, p, rope, ctx_k, ctx_v, h0):
    b, t, _ = x.shape
    sh1, sc1, g1, sh2, sc2, g2 = _modulation(cond, p['w_mod'], p['b_mod'])
    h = _rmsnorm(x, p['g_pre_mix']) * (1 + sc1) + sh1
    zq, zk, zv, zlx, zlg, zcu, zcv, zg = _split_in(h @ p['w_in'])
    q = _rmsnorm(zq.reshape(b, t, N_HEADS, HEAD_DIM), p['g_q'])
    k = _rmsnorm(zk.reshape(b, t, N_KV_HEADS, HEAD_DIM), p['g_k'])
    v = zv.reshape(b, t, N_KV_HEADS, HEAD_DIM)
    if rope is None:
        k_all, v_all = k, v
    else:
        cos, sin = rope
        q = _apply_rope(q, cos, sin)
        k = _apply_rope(k, cos, sin)
        k_all = jnp.concatenate([k, ctx_k.astype(k.dtype)], axis=1)
        v_all = jnp.concatenate([v, ctx_v.astype(v.dtype)], axis=1)
    y_attn = _attend(q, k_all, v_all) @ p['w_attn_out']
    xc = _dwconv(zlx, p['conv_w'], p['conv_b'])
    if h0 is None:
        h0 = jnp.zeros((b, 2, LRU_WIDTH), jnp.float32)
    hf = _rglru_dir(xc, p['lru_wa'][0], p['lru_ba'][0], p['lru_wx'][0], p['lru_bx'][0], p['lru_lam'][0], h0[:, 0], False)
    hb = _rglru_dir(xc, p['lru_wa'][1], p['lru_ba'][1], p['lru_wx'][1], p['lru_bx'][1], p['lru_lam'][1], h0[:, 1], True)
    y_lru = ((hf + hb).astype(x.dtype) * jax.nn.gelu(zlg)) @ p['w_lru_out']
    lru_final = jnp.stack([hf[:, -1], hb[:, 0]], axis=1).astype(x.dtype)
    y_cm = _chunk_mix(zcu, zcv, p['cm_g'], p['cm_ws'], p['cm_bs']) @ p['w_cm_out']
    gates = jax.nn.sigmoid(zg.reshape(b, t, N_BRANCH, D_MODEL))
    merged = gates[:, :, 0] * y_attn + gates[:, :, 1] * y_lru + gates[:, :, 2] * y_cm
    x = x + g1 * _rmsnorm(merged @ p['w_out'], p['g_post_mix'])
    h2 = _rmsnorm(x, p['g_pre_ff']) * (1 + sc2) + sh2
    f = jnp.square(jax.nn.relu(h2 @ p['w_ff1'])) @ p['w_ff2']
    x = x + g2 * _rmsnorm(f, p['g_post_ff'])
    return x, k, v, lru_final


def setup_inputs(seed: int = 0) -> dict:
    key = jax.random.key(seed)
    ks = jax.random.split(key, 32)
    f32 = jnp.float32

    def nrm(k, shape, scale):
        return jax.random.normal(k, shape, f32) * scale

    def gain(k, shape):
        return 1.0 + 0.02 * jax.random.normal(k, shape, f32)

    u = jax.random.uniform(ks[23], (DEPTH, 2, LRU_WIDTH), f32, minval=0.9, maxval=0.999)
    sig = u ** (1.0 / LRU_C)
    lru_lam = jnp.log(sig) - jnp.log1p(-sig)
    return {
        'x_prompt': nrm(ks[0], (BATCH, SEQ, D_MODEL), 1.0),
        'x_sample': nrm(ks[1], (DEC_BATCH, DEC_SEQ, D_MODEL), 1.0),
        'cache_k': nrm(ks[2], (DEC_BATCH, DEPTH, PAST_LEN, N_KV_HEADS, HEAD_DIM), 1.0),
        'cache_v': nrm(ks[3], (DEC_BATCH, DEPTH, PAST_LEN, N_KV_HEADS, HEAD_DIM), 1.0),
        'state_lru': nrm(ks[4], (DEC_BATCH, DEPTH, 2, LRU_WIDTH), 0.5),
        'c': nrm(ks[5], (DEC_BATCH, D_MODEL), 1.0),
        'c_ctx': nrm(ks[6], (D_MODEL,), 1.0),
        'w_mod': nrm(ks[7], (DEPTH, D_MODEL, N_MOD * D_MODEL), 0.5 * D_MODEL ** -0.5),
        'b_mod': nrm(ks[8], (DEPTH, N_MOD * D_MODEL), 0.02),
        'g_pre_mix': gain(ks[9], (DEPTH, D_MODEL)),
        'g_post_mix': gain(ks[10], (DEPTH, D_MODEL)),
        'g_pre_ff': gain(ks[11], (DEPTH, D_MODEL)),
        'g_post_ff': gain(ks[12], (DEPTH, D_MODEL)),
        'w_in': nrm(ks[13], (DEPTH, D_MODEL, IN_W), D_MODEL ** -0.5),
        'g_q': gain(ks[14], (DEPTH, HEAD_DIM)),
        'g_k': gain(ks[15], (DEPTH, HEAD_DIM)),
        'w_attn_out': nrm(ks[16], (DEPTH, Q_W, D_MODEL), Q_W ** -0.5),
        'conv_w': nrm(ks[17], (DEPTH, CONV_W, LRU_WIDTH), CONV_W ** -0.5),
        'conv_b': nrm(ks[18], (DEPTH, LRU_WIDTH), 0.02),
        'lru_wa': nrm(ks[19], (DEPTH, 2, LRU_BLOCKS, LRU_BW, LRU_BW), LRU_BW ** -0.5),
        'lru_ba': nrm(ks[20], (DEPTH, 2, LRU_WIDTH), 0.1),
        'lru_wx': nrm(ks[21], (DEPTH, 2, LRU_BLOCKS, LRU_BW, LRU_BW), LRU_BW ** -0.5),
        'lru_bx': nrm(ks[22], (DEPTH, 2, LRU_WIDTH), 0.1),
        'lru_lam': lru_lam,
        'w_lru_out': nrm(ks[24], (DEPTH, LRU_WIDTH, D_MODEL), LRU_WIDTH ** -0.5),
        'cm_g': gain(ks[25], (DEPTH, CMLP_WIDTH)),
        'cm_ws': nrm(ks[26], (DEPTH, CMLP_GROUPS, CHUNK, CHUNK), CHUNK ** -0.5),
        'cm_bs': nrm(ks[27], (DEPTH, CMLP_GROUPS, CHUNK), 0.1),
        'w_cm_out': nrm(ks[28], (DEPTH, CMLP_WIDTH, D_MODEL), CMLP_WIDTH ** -0.5),
        'w_out': nrm(ks[29], (DEPTH, D_MODEL, D_MODEL), D_MODEL ** -0.5),
        'w_ff1': nrm(ks[30], (DEPTH, D_MODEL, D_FF), D_MODEL ** -0.5),
        'w_ff2': nrm(ks[31], (DEPTH, D_FF, D_MODEL), D_FF ** -0.5),
    }


def reference(x_prompt, x_sample, cache_k, cache_v, state_lru, c, c_ctx,
              w_mod, b_mod, g_pre_mix, g_post_mix, g_pre_ff, g_post_ff,
              w_in, g_q, g_k, w_attn_out, conv_w, conv_b,
              lru_wa, lru_ba, lru_wx, lru_bx, lru_lam, w_lru_out,
              cm_g, cm_ws, cm_bs, w_cm_out, w_out, w_ff1, w_ff2):
    rope = _axial_rope(x_sample.shape[1])
    cond_ctx = c_ctx[None, :]
    y_p = x_prompt
    y_s = x_sample
    new_k, new_v, new_s = [], [], []
    for l in range(DEPTH):
        p = {
            'w_mod': w_mod[l], 'b_mod': b_mod[l],
            'g_pre_mix': g_pre_mix[l], 'g_post_mix': g_post_mix[l],
            'g_pre_ff': g_pre_ff[l], 'g_post_ff': g_post_ff[l],
            'w_in': w_in[l], 'g_q': g_q[l], 'g_k': g_k[l], 'w_attn_out': w_attn_out[l],
            'conv_w': conv_w[l], 'conv_b': conv_b[l],
            'lru_wa': lru_wa[l], 'lru_ba': lru_ba[l], 'lru_wx': lru_wx[l], 'lru_bx': lru_bx[l],
            'lru_lam': lru_lam[l], 'w_lru_out': w_lru_out[l],
            'cm_g': cm_g[l], 'cm_ws': cm_ws[l], 'cm_bs': cm_bs[l], 'w_cm_out': w_cm_out[l],
            'w_out': w_out[l], 'w_ff1': w_ff1[l], 'w_ff2': w_ff2[l],
        }
        y_p, k_l, v_l, s_l = _layer(y_p, cond_ctx, p, None, None, None, None)
        new_k.append(k_l)
        new_v.append(v_l)
        new_s.append(s_l)
        y_s, _, _, _ = _layer(y_s, c, p, rope, cache_k[:, l], cache_v[:, l], state_lru[:, l])
    new_cache_k = jnp.stack(new_k, axis=1)
    new_cache_v = jnp.stack(new_v, axis=1)
    new_state_lru = jnp.stack(new_s, axis=1)
    return (y_prompt_out := y_p, y_s, new_cache_k, new_cache_v, new_state_lru)
```

```cpp
#include <hip/hip_runtime.h>
#include <cstdio>
namespace nv {
constexpr int D = 2048, NH = 16, NKV = 4, HD = 128, INW = 17408, DFF = 8192, DEPTH = 4, NCOND = 9;
constexpr int OFF_Q = 0, OFF_K = 2048, OFF_V = 2560, OFF_LX = 3072, OFF_LG = 5120, OFF_CU = 7168, OFF_CV = 9216, OFF_G = 11264;
constexpr int NPROMPT_ROWS = 8192;
constexpr float EPS = 1e-6f;

__device__ __forceinline__ float gelu_t(float x) { const float u = 0.7978845608028654f * (x + 0.044715f * x * x * x); return 0.5f * x * (1.f + tanhf(u)); }
__device__ __forceinline__ float sigm(float x) { return 1.f / (1.f + expf(-x)); }
__device__ __forceinline__ float block_sum256(float v, float* red) {
    for (int o = 32; o > 0; o >>= 1) v += __shfl_xor(v, o);
    __syncthreads();
    if ((threadIdx.x & 63) == 0) red[threadIdx.x >> 6] = v;
    __syncthreads();
    return red[0] + red[1] + red[2] + red[3];
}

template <bool TB>
__global__ __launch_bounds__(256) void gemm_f32(const float* __restrict__ A, long lda, const float* __restrict__ B, long ldb, float* __restrict__ C, long ldc, int K,
                                                int nb2, long sA1, long sA2, long sB1, long sB2, long sC1, long sC2) {
    __shared__ float As[16][132];
    __shared__ float Bs[16][132];
    const int z = blockIdx.z, z1 = z / nb2, z2 = z % nb2;
    A += z1 * sA1 + z2 * sA2; B += z1 * sB1 + z2 * sB2; C += z1 * sC1 + z2 * sC2;
    const int m0 = blockIdx.y * 128, n0 = blockIdx.x * 128, tid = threadIdx.x, ty = tid >> 4, tx = tid & 15;
    float acc[8][8];
#pragma unroll
    for (int i = 0; i < 8; ++i)
#pragma unroll
        for (int j = 0; j < 8; ++j) acc[i][j] = 0.f;
    for (int k0 = 0; k0 < K; k0 += 16) {
#pragma unroll
        for (int i = 0; i < 2; ++i) {
            const int idx = tid + i * 256, row = idx >> 2, k4 = (idx & 3) * 4;
            const float4 v = *(const float4*)&A[(long)(m0 + row) * lda + k0 + k4];
            As[k4 + 0][row] = v.x; As[k4 + 1][row] = v.y; As[k4 + 2][row] = v.z; As[k4 + 3][row] = v.w;
        }
        if (TB) {
#pragma unroll
            for (int i = 0; i < 2; ++i) {
                const int idx = tid + i * 256, row = idx >> 2, k4 = (idx & 3) * 4;
                const float4 v = *(const float4*)&B[(long)(n0 + row) * ldb + k0 + k4];
                Bs[k4 + 0][row] = v.x; Bs[k4 + 1][row] = v.y; Bs[k4 + 2][row] = v.z; Bs[k4 + 3][row] = v.w;
            }
        } else {
#pragma unroll
            for (int i = 0; i < 2; ++i) {
                const int idx = tid + i * 256, kr = idx >> 5, n4 = (idx & 31) * 4;
                *(float4*)&Bs[kr][n4] = *(const float4*)&B[(long)(k0 + kr) * ldb + n0 + n4];
            }
        }
        __syncthreads();
#pragma unroll
        for (int k = 0; k < 16; ++k) {
            const float4 a0 = *(const float4*)&As[k][ty * 4], a1 = *(const float4*)&As[k][64 + ty * 4];
            const float4 b0 = *(const float4*)&Bs[k][tx * 4], b1 = *(const float4*)&Bs[k][64 + tx * 4];
            const float a[8] = {a0.x, a0.y, a0.z, a0.w, a1.x, a1.y, a1.z, a1.w};
            const float b[8] = {b0.x, b0.y, b0.z, b0.w, b1.x, b1.y, b1.z, b1.w};
#pragma unroll
            for (int i = 0; i < 8; ++i)
#pragma unroll
                for (int j = 0; j < 8; ++j) acc[i][j] = fmaf(a[i], b[j], acc[i][j]);
        }
        __syncthreads();
    }
#pragma unroll
    for (int i = 0; i < 8; ++i) {
        const int row = m0 + (i < 4 ? ty * 4 + i : 64 + ty * 4 + i - 4);
        float* cr = C + (long)row * ldc + n0;
        *(float4*)&cr[tx * 4] = make_float4(acc[i][0], acc[i][1], acc[i][2], acc[i][3]);
        *(float4*)&cr[64 + tx * 4] = make_float4(acc[i][4], acc[i][5], acc[i][6], acc[i][7]);
    }
}
inline void gemm(hipStream_t s, bool tb, const float* A, long lda, const float* B, long ldb, float* C, long ldc, int M, int N, int K,
                 int nb1 = 1, int nb2 = 1, long sA1 = 0, long sA2 = 0, long sB1 = 0, long sB2 = 0, long sC1 = 0, long sC2 = 0) {
    dim3 g(N / 128, M / 128, nb1 * nb2);
    if (tb) hipLaunchKernelGGL(gemm_f32<true>, g, dim3(256), 0, s, A, lda, B, ldb, C, ldc, K, nb2, sA1, sA2, sB1, sB2, sC1, sC2);
    else hipLaunchKernelGGL(gemm_f32<false>, g, dim3(256), 0, s, A, lda, B, ldb, C, ldc, K, nb2, sA1, sA2, sB1, sB2, sC1, sC2);
}

__global__ __launch_bounds__(256) void k_mod(const float* __restrict__ c, const float* __restrict__ c_ctx, const float* __restrict__ w_mod, const float* __restrict__ b_mod, float* __restrict__ mod) {
    __shared__ float sc[NCOND][256];
    const int l = blockIdx.y, j = blockIdx.x * 256 + threadIdx.x;
    float acc[NCOND];
#pragma unroll
    for (int ci = 0; ci < NCOND; ++ci) acc[ci] = b_mod[(long)l * 12288 + j];
    for (int k0 = 0; k0 < D; k0 += 256) {
        __syncthreads();
#pragma unroll
        for (int ci = 0; ci < NCOND; ++ci) { const float v = ci == 0 ? c_ctx[k0 + threadIdx.x] : c[(ci - 1) * D + k0 + threadIdx.x]; sc[ci][threadIdx.x] = v * sigm(v); }
        __syncthreads();
        for (int k = 0; k < 256; ++k) {
            const float w = w_mod[((long)l * D + k0 + k) * 12288 + j];
#pragma unroll
            for (int ci = 0; ci < NCOND; ++ci) acc[ci] = fmaf(sc[ci][k], w, acc[ci]);
        }
    }
#pragma unroll
    for (int ci = 0; ci < NCOND; ++ci) mod[((long)l * NCOND + ci) * 12288 + j] = acc[ci];
}
__device__ __forceinline__ int cond_of_row(int m) { return m < NPROMPT_ROWS ? 0 : 1 + (m - NPROMPT_ROWS) / 2048; }

__global__ __launch_bounds__(256) void k_norm_mod(const float* __restrict__ x, int m0, const float* __restrict__ g, const float* __restrict__ modl, int which_sh, int which_sc, float* __restrict__ h) {
    __shared__ float red[4];
    const int r = blockIdx.x, m = m0 + r, ci = cond_of_row(m);
    const float* xr = x + (long)m * D; float v[8]; float ss = 0.f;
#pragma unroll
    for (int i = 0; i < 8; ++i) { v[i] = xr[threadIdx.x + i * 256]; ss += v[i] * v[i]; }
    ss = block_sum256(ss, red);
    const float rs = rsqrtf(ss / D + EPS);
    const float* sh = modl + ((long)ci * 6 + which_sh) * D; const float* sc = modl + ((long)ci * 6 + which_sc) * D;
#pragma unroll
    for (int i = 0; i < 8; ++i) { const int cidx = threadIdx.x + i * 256; h[(long)r * D + cidx] = v[i] * rs * g[cidx] * (1.f + sc[cidx]) + sh[cidx]; }
}
__global__ __launch_bounds__(256) void k_resid(float* __restrict__ x, int m0, const float* __restrict__ f, const float* __restrict__ gpost, const float* __restrict__ modl, int which_g) {
    __shared__ float red[4];
    const int r = blockIdx.x, m = m0 + r, ci = cond_of_row(m);
    const float* fr = f + (long)r * D; float v[8]; float ss = 0.f;
#pragma unroll
    for (int i = 0; i < 8; ++i) { v[i] = fr[threadIdx.x + i * 256]; ss += v[i] * v[i]; }
    ss = block_sum256(ss, red);
    const float rs = rsqrtf(ss / D + EPS);
    const float* gt = modl + ((long)ci * 6 + which_g) * D;
#pragma unroll
    for (int i = 0; i < 8; ++i) { const int cidx = threadIdx.x + i * 256; x[(long)m * D + cidx] += gt[cidx] * (v[i] * rs * gpost[cidx]); }
}
__global__ __launch_bounds__(128) void k_qkv_prep(float* __restrict__ Z, int T, int sample, const float* __restrict__ gq, const float* __restrict__ gk,
                                                  float* __restrict__ kall, float* __restrict__ vall, float* __restrict__ new_k, float* __restrict__ new_v, int l, int seq0) {
    __shared__ float sh[128]; __shared__ float red[2];
    const int r = blockIdx.x, hs = blockIdx.y, d = threadIdx.x, sl = r / T, t = r % T, Tk = T + (sample ? 256 : 0);
    if (hs >= 20) {
        const int kvh = hs - 20; const float v = Z[(long)r * INW + OFF_V + kvh * HD + d];
        vall[((long)sl * Tk + t) * 512 + kvh * HD + d] = v;
        if (!sample) new_v[((((long)(seq0 + sl) * DEPTH + l) * 256 + t) * NKV + kvh) * HD + d] = v;
        return;
    }
    const bool isq = hs < 16; const int kvh = hs - 16;
    float* src = Z + (long)r * INW + (isq ? OFF_Q + hs * HD : OFF_K + kvh * HD);
    const float v = src[d];
    float ss = v * v;
    for (int o = 32; o > 0; o >>= 1) ss += __shfl_xor(ss, o);
    if ((d & 63) == 0) red[d >> 6] = ss;
    __syncthreads();
    ss = red[0] + red[1];
    float n = v * rsqrtf(ss / HD + EPS) * (isq ? gq[d] : gk[d]);
    if (!sample && !isq) new_k[((((long)(seq0 + sl) * DEPTH + l) * 256 + t) * NKV + kvh) * HD + d] = n;
    if (sample) {
        sh[d] = n; __syncthreads();
        const float p = sh[d ^ 32];
        const int axis = d >> 6, half = (d >> 5) & 1, f = d & 31;
        const double inv = pow(10000.0, -(double)f / 32.0);
        const double ang = (double)(axis == 0 ? t / 64 : t % 64) * inv;
        const float cs = (float)cos(ang), sn = (float)sin(ang);
        const float xa = half == 0 ? n : p, xb = half == 0 ? p : n;
        n = half == 0 ? xa * cs - xb * sn : xa * sn + xb * cs;
    }
    if (isq) src[d] = n; else kall[((long)sl * Tk + t) * 512 + kvh * HD + d] = n;
}
__global__ __launch_bounds__(512) void k_cache_copy(const float* __restrict__ ck, const float* __restrict__ cv, float* __restrict__ kall, float* __restrict__ vall, int l, int seq0) {
    const int sl = blockIdx.x / 256, p = blockIdx.x % 256, e = threadIdx.x; const int b = seq0 + sl;
    const long src = (((long)b * DEPTH + l) * 256 + p) * 512 + e, dst = ((long)sl * 2304 + 2048 + p) * 512 + e;
    kall[dst] = ck[src]; vall[dst] = cv[src];
}
__global__ __launch_bounds__(256) void k_softmax(float* __restrict__ S, int n, float scale) {
    __shared__ float red[4];
    float* s = S + (long)blockIdx.x * n;
    float mx = -3.0e38f;
    for (int i = threadIdx.x; i < n; i += 256) mx = fmaxf(mx, s[i] * scale);
    for (int o = 32; o > 0; o >>= 1) mx = fmaxf(mx, __shfl_xor(mx, o));
    if ((threadIdx.x & 63) == 0) red[threadIdx.x >> 6] = mx;
    __syncthreads();
    mx = fmaxf(fmaxf(red[0], red[1]), fmaxf(red[2], red[3]));
    float sum = 0.f;
    for (int i = threadIdx.x; i < n; i += 256) { const float e = expf(s[i] * scale - mx); s[i] = e; sum += e; }
    sum = block_sum256(sum, red);
    const float inv = 1.f / sum;
    for (int i = threadIdx.x; i < n; i += 256) s[i] *= inv;
}
__global__ __launch_bounds__(256) void k_conv(const float* __restrict__ Z, int T, const float* __restrict__ cw, const float* __restrict__ cb, float* __restrict__ xc) {
    const int r = blockIdx.x, t = r % T;
    for (int c = threadIdx.x; c < D; c += 256) {
        float y = cb[c];
#pragma unroll
        for (int j = 0; j < 4; ++j) { const int tt = t + j - 2; if (tt >= 0 && tt < T) y += Z[(long)(r + j - 2) * INW + OFF_LX + c] * cw[j * D + c]; }
        xc[(long)r * D + c] = y;
    }
}
__global__ __launch_bounds__(256) void k_scan(const float* __restrict__ xc, const float* __restrict__ pa0, const float* __restrict__ px0, const float* __restrict__ pa1, const float* __restrict__ px1,
                                              const float* __restrict__ ba, const float* __restrict__ bx, const float* __restrict__ lam, const float* __restrict__ h0  , long h0_stride,
                                              int T, float* __restrict__ hf, float* __restrict__ hb) {
    const int gid = blockIdx.x * 256 + threadIdx.x, c = gid % D, dir = (gid / D) & 1, sl = gid / (2 * D);
    const float* pa = dir ? pa1 : pa0; const float* px = dir ? px1 : px0; float* ho = dir ? hb : hf;
    const float bav = ba[dir * D + c], bxv = bx[dir * D + c], lm = lam[dir * D + c];
    const float sp = log1pf(expf(-lm));
    float h = h0 ? h0[(long)sl * h0_stride + (long)dir * D + c] : 0.f;
    for (int s = 0; s < T; ++s) {
        const int t = dir ? T - 1 - s : s; const long idx = ((long)sl * T + t) * D + c;
        const float r = sigm(pa[idx] + bav), i = sigm(px[idx] + bxv);
        const float la = -8.f * r * sp, a = expf(la);
        const float b = sqrtf(fmaxf(-expm1f(2.f * la), 0.f)) * (i * xc[idx]);
        h = a * h + b; ho[idx] = h;
    }
}
__global__ __launch_bounds__(256) void k_lru_out(const float* __restrict__ Z, const float* __restrict__ hf, const float* __restrict__ hb, float* __restrict__ y, int T, int sample, float* __restrict__ new_s, int l, int seq0) {
    const int r = blockIdx.x, sl = r / T, t = r % T;
    for (int c = threadIdx.x; c < D; c += 256) {
        const long idx = (long)r * D + c;
        y[idx] = (hf[idx] + hb[idx]) * gelu_t(Z[(long)r * INW + OFF_LG + c]);
        if (!sample) {
            if (t == T - 1) new_s[(((long)(seq0 + sl) * DEPTH + l) * 2 + 0) * D + c] = hf[idx];
            if (t == 0) new_s[(((long)(seq0 + sl) * DEPTH + l) * 2 + 1) * D + c] = hb[idx];
        }
    }
}
__global__ __launch_bounds__(256) void k_cm_vn(const float* __restrict__ Z, const float* __restrict__ cmg, float* __restrict__ vn) {
    __shared__ float red[4];
    const int r = blockIdx.x; float v[8]; float ss = 0.f;
#pragma unroll
    for (int i = 0; i < 8; ++i) { v[i] = gelu_t(Z[(long)r * INW + OFF_CV + threadIdx.x + i * 256]); ss += v[i] * v[i]; }
    ss = block_sum256(ss, red);
    const float rs = rsqrtf(ss / D + EPS);
#pragma unroll
    for (int i = 0; i < 8; ++i) { const int c = threadIdx.x + i * 256; vn[(long)r * D + c] = v[i] * rs * cmg[c]; }
}
__global__ __launch_bounds__(256) void k_cm_out(const float* __restrict__ Z, const float* __restrict__ mixed, const float* __restrict__ bs, float* __restrict__ o) {
    const int r = blockIdx.x, q = r % 128;
    for (int c = threadIdx.x; c < D; c += 256) o[(long)r * D + c] = gelu_t(Z[(long)r * INW + OFF_CU + c]) * (mixed[(long)r * D + c] + bs[(c / 128) * 128 + q]);
}
__global__ __launch_bounds__(256) void k_merge(const float* __restrict__ Z, const float* __restrict__ y0, const float* __restrict__ y1, const float* __restrict__ y2, float* __restrict__ mg) {
    const int r = blockIdx.x; const float* zg = Z + (long)r * INW + OFF_G;
    for (int c = threadIdx.x; c < D; c += 256) { const long idx = (long)r * D + c; mg[idx] = sigm(zg[c]) * y0[idx] + sigm(zg[D + c]) * y1[idx] + sigm(zg[2 * D + c]) * y2[idx]; }
}
__global__ __launch_bounds__(256) void k_relu2(float* __restrict__ a, long n) { for (long i = blockIdx.x * 256L + threadIdx.x; i < n; i += gridDim.x * 256L) { const float v = fmaxf(a[i], 0.f); a[i] = v * v; } }

struct In {
    const float *x_prompt, *x_sample, *cache_k, *cache_v, *state_lru, *c, *c_ctx, *w_mod, *b_mod, *g_pre_mix, *g_post_mix, *g_pre_ff, *g_post_ff, *w_in, *g_q, *g_k, *w_attn_out,
        *conv_w, *conv_b, *lru_wa, *lru_ba, *lru_wx, *lru_bx, *lru_lam, *w_lru_out, *cm_g, *cm_ws, *cm_bs, *w_cm_out, *w_out, *w_ff1, *w_ff2;
};
struct Ws {
    static constexpr long RMAX = 4096;
    float *MOD, *H, *Z, *KALL, *VALL, *S, *ATT, *XC, *PA0, *PX0, *PA1, *PX1, *HF, *HB, *LY, *VN, *MIX, *CMO, *Y0, *Y1, *Y2, *MG, *F, *FFH;
    long total;
    void carve(float* base) {
        long o = 0; auto take = [&](long n) { float* p = base ? base + o : nullptr; o += (n + 63) / 64 * 64; return p; };
        MOD = take((long)DEPTH * NCOND * 12288); H = take(RMAX * D); Z = take(RMAX * INW); KALL = take(4608L * 512); VALL = take(4608L * 512); S = take(16L * 2048 * 2304);
        ATT = take(RMAX * D); XC = take(RMAX * D); PA0 = take(RMAX * D); PX0 = take(RMAX * D); PA1 = take(RMAX * D); PX1 = take(RMAX * D); HF = take(RMAX * D); HB = take(RMAX * D);
        LY = take(RMAX * D); VN = take(RMAX * D); MIX = take(RMAX * D); CMO = take(RMAX * D); Y0 = take(RMAX * D); Y1 = take(RMAX * D); Y2 = take(RMAX * D); MG = take(RMAX * D); F = take(RMAX * D);
        FFH = take(RMAX * DFF); total = o;
    }
};
inline void layer_batch(hipStream_t s, const In& in, const Ws& w, float* x, float* new_k, float* new_v, float* new_s, int l, int sample, int seq0, int nseq) {
    const int T = sample ? 2048 : 256, R = nseq * T, Tk = T + (sample ? 256 : 0);
    const int m0 = sample ? NPROMPT_ROWS + seq0 * 2048 : seq0 * 256;
    const float* modl = w.MOD + (long)l * NCOND * 12288;
    hipLaunchKernelGGL(k_norm_mod, dim3(R), dim3(256), 0, s, (const float*)x, m0, in.g_pre_mix + l * D, modl, 0, 1, w.H);
    gemm(s, false, w.H, D, in.w_in + (long)l * D * INW, INW, w.Z, INW, R, INW, D);
    hipLaunchKernelGGL(k_qkv_prep, dim3(R, 24), dim3(128), 0, s, w.Z, T, sample, in.g_q + l * HD, in.g_k + l * HD, w.KALL, w.VALL, new_k, new_v, l, seq0);
    if (sample) hipLaunchKernelGGL(k_cache_copy, dim3(nseq * 256), dim3(512), 0, s, in.cache_k, in.cache_v, w.KALL, w.VALL, l, seq0);
    for (int sl = 0; sl < nseq; ++sl) {
        const float* q = w.Z + (long)sl * T * INW + OFF_Q; const float* kk = w.KALL + (long)sl * Tk * 512; const float* vv = w.VALL + (long)sl * Tk * 512;
        gemm(s, true, q, INW, kk, 512, w.S, Tk, T, Tk, HD, 4, 4, 512, 128, 128, 0, 4L * T * Tk, (long)T * Tk);
        hipLaunchKernelGGL(k_softmax, dim3(16 * T), dim3(256), 0, s, w.S, Tk, 0.08838834764831845f);
        gemm(s, false, w.S, Tk, vv, 512, w.ATT + (long)sl * T * D, D, T, HD, Tk, 4, 4, 4L * T * Tk, (long)T * Tk, 128, 0, 512, 128);
    }
    hipLaunchKernelGGL(k_conv, dim3(R), dim3(256), 0, s, (const float*)w.Z, T, in.conv_w + (long)l * 4 * D, in.conv_b + (long)l * D, w.XC);
    const float* wa = in.lru_wa + (long)l * 2 * 16 * 16384; const float* wx = in.lru_wx + (long)l * 2 * 16 * 16384;
    gemm(s, false, w.XC, D, wa, 128, w.PA0, D, R, 128, 128, 1, 16, 0, 128, 0, 16384, 0, 128);
    gemm(s, false, w.XC, D, wx, 128, w.PX0, D, R, 128, 128, 1, 16, 0, 128, 0, 16384, 0, 128);
    gemm(s, false, w.XC, D, wa + 16 * 16384, 128, w.PA1, D, R, 128, 128, 1, 16, 0, 128, 0, 16384, 0, 128);
    gemm(s, false, w.XC, D, wx + 16 * 16384, 128, w.PX1, D, R, 128, 128, 1, 16, 0, 128, 0, 16384, 0, 128);
    hipLaunchKernelGGL(k_scan, dim3(nseq * 2 * D / 256), dim3(256), 0, s, (const float*)w.XC, (const float*)w.PA0, (const float*)w.PX0, (const float*)w.PA1, (const float*)w.PX1,
                       in.lru_ba + (long)l * 2 * D, in.lru_bx + (long)l * 2 * D, in.lru_lam + (long)l * 2 * D,
                       sample ? in.state_lru + ((long)seq0 * DEPTH + l) * 2 * D : (const float*)nullptr, (long)DEPTH * 2 * D, T, w.HF, w.HB);
    hipLaunchKernelGGL(k_lru_out, dim3(R), dim3(256), 0, s, (const float*)w.Z, (const float*)w.HF, (const float*)w.HB, w.LY, T, sample, new_s, l, seq0);
    hipLaunchKernelGGL(k_cm_vn, dim3(R), dim3(256), 0, s, (const float*)w.Z, in.cm_g + (long)l * D, w.VN);
    gemm(s, false, in.cm_ws + (long)l * 16 * 16384, 128, w.VN, D, w.MIX, D, 128, 128, 128, R / 128, 16, 0, 16384, 128L * D, 128, 128L * D, 128);
    hipLaunchKernelGGL(k_cm_out, dim3(R), dim3(256), 0, s, (const float*)w.Z, (const float*)w.MIX, in.cm_bs + (long)l * 16 * 128, w.CMO);
    gemm(s, false, w.ATT, D, in.w_attn_out + (long)l * D * D, D, w.Y0, D, R, D, D);
    gemm(s, false, w.LY, D, in.w_lru_out + (long)l * D * D, D, w.Y1, D, R, D, D);
    gemm(s, false, w.CMO, D, in.w_cm_out + (long)l * D * D, D, w.Y2, D, R, D, D);
    hipLaunchKernelGGL(k_merge, dim3(R), dim3(256), 0, s, (const float*)w.Z, (const float*)w.Y0, (const float*)w.Y1, (const float*)w.Y2, w.MG);
    gemm(s, false, w.MG, D, in.w_out + (long)l * D * D, D, w.F, D, R, D, D);
    hipLaunchKernelGGL(k_resid, dim3(R), dim3(256), 0, s, x, m0, (const float*)w.F, in.g_post_mix + l * D, modl, 2);
    hipLaunchKernelGGL(k_norm_mod, dim3(R), dim3(256), 0, s, (const float*)x, m0, in.g_pre_ff + l * D, modl, 3, 4, w.H);
    gemm(s, false, w.H, D, in.w_ff1 + (long)l * D * DFF, DFF, w.FFH, DFF, R, DFF, D);
    hipLaunchKernelGGL(k_relu2, dim3(4096), dim3(256), 0, s, w.FFH, (long)R * DFF);
    gemm(s, false, w.FFH, DFF, in.w_ff2 + (long)l * DFF * D, D, w.F, D, R, D, DFF);
    hipLaunchKernelGGL(k_resid, dim3(R), dim3(256), 0, s, x, m0, (const float*)w.F, in.g_post_ff + l * D, modl, 5);
}
inline In make_in(void* const* d_in) {
    In in; const float** p = (const float**)&in; for (int i = 0; i < 32; ++i) p[i] = (const float*)d_in[i]; return in;
}
}

extern "C" void kernel_launch(void* const* d_in, const int* in_sizes, int n_in, void* d_out, int out_size, void* d_ws, size_t ws_size, hipStream_t stream) {
    nv::In in = nv::make_in(d_in);
    float* out = (float*)d_out;
    float* x = out; float* new_k = out + 50331648L; float* new_v = new_k + 16777216L; float* new_s = new_v + 16777216L;
    nv::Ws w; w.carve((float*)d_ws);
    if ((size_t)w.total * 4 > ws_size || n_in != 32 || out_size != 84410368) { fprintf(stderr, "kernel_launch: ws %zu need %ld, n_in %d out %d\n", ws_size, w.total * 4, n_in, out_size); return; }
    hipMemcpyAsync(x, in.x_prompt, 16777216L * 4, hipMemcpyDeviceToDevice, stream);
    hipMemcpyAsync(x + 16777216L, in.x_sample, 33554432L * 4, hipMemcpyDeviceToDevice, stream);
    hipLaunchKernelGGL(nv::k_mod, dim3(12288 / 256, nv::DEPTH), dim3(256), 0, stream, in.c, in.c_ctx, in.w_mod, in.b_mod, w.MOD);
    for (int l = 0; l < nv::DEPTH; ++l) {
        for (int s0 = 0; s0 < 32; s0 += 16) nv::layer_batch(stream, in, w, x, new_k, new_v, new_s, l, 0, s0, 16);
        for (int s0 = 0; s0 < 8; s0 += 2) nv::layer_batch(stream, in, w, x, new_k, new_v, new_s, l, 1, s0, 2);
    }
}
```

```cpp
#include <hip/hip_runtime.h>
#include <hip/hip_bf16.h>
#include <cstdio>
#include <cstdint>
namespace pg8 {
#define PG8_LAS __attribute__((address_space(3)))
typedef unsigned short bf16_t;
typedef short bf16x8 __attribute__((ext_vector_type(8)));
typedef float f32x4 __attribute__((ext_vector_type(4)));
typedef unsigned u32x4 __attribute__((ext_vector_type(4)));
constexpr int BM = 256, BK = 64, HALF = 128, HTB = HALF * BK * 2  , STAGE_BYTES = 8 * HTB, NXCD = 8, WGM = 8;

__host__ __device__ __forceinline__ int lds_byte(int r, int c) { const int st = (r >> 4) * 2 + (c >> 5), rr = r & 15, cc = c & 31, ob = rr * 64 + cc * 2; return st * 1024 + (ob ^ (((ob >> 9) & 1) << 5)); }
__host__ __device__ __forceinline__ void stage_rc(int b, int& R, int& C) { const int st = b / 1024, sb = b % 1024, swz = sb ^ (((sb >> 9) & 1) << 5); R = (st >> 1) * 16 + swz / 64; C = (st & 1) * 32 + (swz % 64) / 2; }
__host__ __device__ __forceinline__ int perm32(int rho) { const int n = rho >> 4, i = rho & 15; return 8 * (i >> 2) + 4 * n + (i & 3); }

struct Unit { int pm, pn; };
struct Gemm { const bf16_t* A; const bf16_t* Bt; int M, N, K; };

struct StaticOrder {
    int nM, nN, nwg, G, c;
    __host__ __device__ void init(int M, int N, int G_, int c_) { nM = M / BM; nN = N / BM; nwg = nM * nN; G = G_; c = c_; }
    __host__ __device__ bool next(int i, Unit& u) const {
        const long L = (long)i * G + c; if (L >= nwg) return false;
        int wgid = (int)L; { const int q = nwg / NXCD, r = nwg % NXCD, xcd = wgid % NXCD, off = wgid / NXCD; wgid = (xcd < r ? xcd * (q + 1) : r * (q + 1) + (xcd - r) * q) + off; }
        const int nig = WGM * nN, gid = wgid / nig, fm = gid * WGM, gsz = (nM - fm) < WGM ? (nM - fm) : WGM;
        u.pm = fm + ((wgid % nig) % gsz); u.pn = (wgid % nig) / gsz; return true;
    }
    __device__ __forceinline__ void a_ready(const Unit&) const {}
    __device__ __forceinline__ void done(const Unit&) const {}
};
__device__ __forceinline__ unsigned cvt_pk_bf16(float lo, float hi) { unsigned r; asm volatile("v_cvt_pk_bf16_f32 %0, %1, %2" : "=v"(r) : "v"(lo), "v"(hi)); return r; }
template <class Epi, class Sched, bool ALIGN_EPI = false, bool SP2 = false>
__device__ __forceinline__ void gemm_phase(PG8_LAS unsigned char* lds, const Gemm g, const Sched& S, const Epi& E) {
    int tid_ = threadIdx.x; asm volatile("" : "+v"(tid_));
    const int tid = tid_, wid = __builtin_amdgcn_readfirstlane(tid >> 6), lane = tid & 63, wr = wid >> 2, wc = wid & 3, fr = lane & 15, fq = lane >> 4;
    const int K = g.K, nt = K / BK;
    unsigned voffA[2], voffB[2];
#pragma unroll
    for (int i = 0; i < 2; ++i) { int R, C; stage_rc(tid * 16 + i * 8192, R, C); const int Rb = Epi::PERM ? ((R & ~31) + perm32(R & 31)) : R;
        voffA[i] = (unsigned)(R * K + C) * 2u; voffB[i] = (unsigned)(Rb * K + C) * 2u; }
    const size_t kstep = (size_t)(BK * 2);
    const size_t hstep = (size_t)HALF * K * 2;
    const size_t tstep = 2 * hstep;
    const unsigned ldsw = (unsigned)wid * 1024u;
    const int aoff = lds_byte(wr * 64 + fr, fq * 8), boff = lds_byte(wc * 32 + fr, fq * 8);
#define PG8_SA(b, h) (((b) * 2 + (h)) * HTB)
#define PG8_SB(b, h) ((4 + (b) * 2 + (h)) * HTB)
#define PG8_STAGE(bufoff, gbase, voff) do { _Pragma("unroll") for (int _i = 0; _i < 2; ++_i) \
        __builtin_amdgcn_global_load_lds((const unsigned*)((const char*)(gbase) + (voff)[_i]), (PG8_LAS unsigned*)(lds + (bufoff) + ldsw + _i * 8192), 16, 0, 0); } while (0)
#define PG8_LDA(dst, b, h) do { _Pragma("unroll") for (int m = 0; m < 4; ++m) _Pragma("unroll") for (int k = 0; k < 2; ++k) dst[m][k] = *(const PG8_LAS bf16x8*)(lds + PG8_SA(b, h) + aoff + m * 2048 + k * 1024); } while (0)
#define PG8_LDB(dst, b, h) do { _Pragma("unroll") for (int n = 0; n < 2; ++n) _Pragma("unroll") for (int k = 0; k < 2; ++k) dst[n][k] = *(const PG8_LAS bf16x8*)(lds + PG8_SB(b, h) + boff + n * 2048 + k * 1024); } while (0)
#define PG8_MMA(ai, bj, At, Bt) do { __builtin_amdgcn_s_setprio(1); _Pragma("unroll") for (int m = 0; m < 4; ++m) _Pragma("unroll") for (int n = 0; n < 2; ++n) _Pragma("unroll") for (int k = 0; k < 2; ++k) \
        acc[ai][bj][m][n] = __builtin_amdgcn_mfma_f32_16x16x32_bf16(Bt[n][k], At[m][k], acc[ai][bj][m][n], 0, 0, 0); __builtin_amdgcn_s_setprio(0); } while (0)
#define PG8_WAIT_V(n) asm volatile("s_waitcnt vmcnt(" #n ")" ::: "memory")
#define PG8_WAIT_L(n) asm volatile("s_waitcnt lgkmcnt(" #n ")" ::: "memory")
#define PG8_BAR __builtin_amdgcn_s_barrier()
#define PG8_SCHED __builtin_amdgcn_sched_barrier(0)
    Unit cur, nxt; int ui = 0;
    if (!S.next(0, cur)) return;
    f32x4 acc[2][2][4][2];
#pragma unroll
    for (int a = 0; a < 2; ++a)
#pragma unroll
        for (int b = 0; b < 2; ++b)
#pragma unroll
            for (int m = 0; m < 4; ++m)
#pragma unroll
                for (int n = 0; n < 2; ++n) acc[a][b][m][n] = (f32x4){0.f, 0.f, 0.f, 0.f};
    bf16x8 At[4][2], B0[2][2], B1[2][2];
    const char* cA = (const char*)g.A + (size_t)cur.pm * tstep; const char* cB = (const char*)g.Bt + (size_t)cur.pn * tstep;
    S.a_ready(cur);
    if constexpr (SP2) {
        PG8_STAGE(PG8_SB(0, 0), cB, voffB); PG8_STAGE(PG8_SB(0, 1), cB + hstep, voffB); PG8_STAGE(PG8_SA(0, 0), cA, voffA); PG8_STAGE(PG8_SA(0, 1), cA + hstep, voffA);
        if (wr == 1) PG8_BAR;
        PG8_WAIT_V(2); PG8_BAR;
        PG8_STAGE(PG8_SB(1, 0), cB + kstep, voffB); PG8_STAGE(PG8_SA(1, 0), cA + kstep, voffA); PG8_STAGE(PG8_SB(1, 1), cB + hstep + kstep, voffB);
        PG8_WAIT_V(6); PG8_BAR;
    } else {
        PG8_STAGE(PG8_SB(0, 0), cB, voffB); PG8_STAGE(PG8_SA(0, 0), cA, voffA); PG8_STAGE(PG8_SB(0, 1), cB + hstep, voffB); PG8_STAGE(PG8_SA(0, 1), cA + hstep, voffA);
        if (wr == 1) PG8_BAR;
        PG8_WAIT_V(4); PG8_BAR;
        PG8_STAGE(PG8_SB(1, 0), cB + kstep, voffB); PG8_STAGE(PG8_SA(1, 0), cA + kstep, voffA); PG8_STAGE(PG8_SB(1, 1), cB + hstep + kstep, voffB);
        PG8_WAIT_V(6); PG8_BAR;
    }
    for (;;) {
        const bool has_next = S.next(ui + 1, nxt);
        const char* nA = has_next ? (const char*)g.A + (size_t)nxt.pm * tstep : cA; const char* nB = has_next ? (const char*)g.Bt + (size_t)nxt.pn * tstep : cB;
        for (int t = 0; t < nt; t += 2) {
            const bool last = (t == nt - 2);
            const char* a1 = cA + (size_t)(t + 1) * kstep;
            const char* a2 = last ? nA : cA + (size_t)(t + 2) * kstep; const char* b2 = last ? nB : cB + (size_t)(t + 2) * kstep;
            const char* a3 = a2 + kstep; const char* b3 = b2 + kstep;
            if (last && has_next) S.a_ready(nxt);
            if constexpr (SP2) {
            PG8_LDB(B0, 0, 0); PG8_LDB(B1, 0, 1); PG8_SCHED; PG8_LDA(At, 0, 0); PG8_STAGE(PG8_SA(1, 1), a1 + hstep, voffA);
            PG8_WAIT_V(8); PG8_WAIT_L(0); PG8_BAR; PG8_MMA(0, 0, At, B0); PG8_MMA(0, 1, At, B1); PG8_BAR; PG8_SCHED;
            PG8_LDA(At, 0, 1); PG8_STAGE(PG8_SB(0, 0), b2, voffB); PG8_STAGE(PG8_SB(0, 1), b2 + hstep, voffB); PG8_STAGE(PG8_SA(0, 0), a2, voffA);
            PG8_WAIT_V(8); PG8_WAIT_L(0); PG8_BAR; PG8_MMA(1, 0, At, B0); PG8_MMA(1, 1, At, B1); PG8_BAR; PG8_SCHED;
            PG8_LDB(B0, 1, 0); PG8_LDB(B1, 1, 1); PG8_SCHED; PG8_LDA(At, 1, 0); PG8_STAGE(PG8_SA(0, 1), a2 + hstep, voffA);
            PG8_WAIT_V(8); PG8_WAIT_L(0); PG8_BAR; PG8_MMA(0, 0, At, B0); PG8_MMA(0, 1, At, B1); PG8_BAR; PG8_SCHED;
            PG8_LDA(At, 1, 1); PG8_STAGE(PG8_SB(1, 0), b3, voffB); PG8_STAGE(PG8_SB(1, 1), b3 + hstep, voffB); PG8_STAGE(PG8_SA(1, 0), a3, voffA);
            PG8_WAIT_V(8); PG8_WAIT_L(0); PG8_BAR; PG8_MMA(1, 0, At, B0); PG8_MMA(1, 1, At, B1); PG8_BAR; PG8_SCHED;
            } else {
            PG8_LDB(B0, 0, 0); PG8_SCHED; PG8_LDA(At, 0, 0); PG8_STAGE(PG8_SA(1, 1), a1 + hstep, voffA);
            PG8_WAIT_L(8); PG8_BAR; PG8_WAIT_L(0); PG8_MMA(0, 0, At, B0); PG8_BAR; PG8_SCHED;
            PG8_LDB(B1, 0, 1); PG8_STAGE(PG8_SB(0, 0), b2, voffB);
            PG8_BAR; PG8_WAIT_L(0); PG8_MMA(0, 1, At, B1); PG8_BAR;
            PG8_LDA(At, 0, 1); PG8_STAGE(PG8_SA(0, 0), a2, voffA);
            PG8_BAR; PG8_WAIT_L(0); PG8_MMA(1, 0, At, B0); PG8_BAR; PG8_SCHED;
            PG8_STAGE(PG8_SB(0, 1), b2 + hstep, voffB);
            PG8_WAIT_V(6); PG8_BAR; PG8_MMA(1, 1, At, B1); PG8_BAR;
            PG8_LDB(B0, 1, 0); PG8_SCHED; PG8_LDA(At, 1, 0); PG8_STAGE(PG8_SA(0, 1), a2 + hstep, voffA);
            PG8_WAIT_L(8); PG8_BAR; PG8_WAIT_L(0); PG8_MMA(0, 0, At, B0); PG8_BAR; PG8_SCHED;
            PG8_LDB(B1, 1, 1); PG8_STAGE(PG8_SB(1, 0), b3, voffB);
            PG8_BAR; PG8_WAIT_L(0); PG8_MMA(0, 1, At, B1); PG8_BAR;
            PG8_LDA(At, 1, 1); PG8_STAGE(PG8_SA(1, 0), a3, voffA);
            PG8_BAR; PG8_WAIT_L(0); PG8_MMA(1, 0, At, B0); PG8_BAR; PG8_SCHED;
            PG8_STAGE(PG8_SB(1, 1), b3 + hstep, voffB);
            PG8_WAIT_V(6); PG8_BAR; PG8_MMA(1, 1, At, B1); PG8_BAR;
            }
        }
        if constexpr (ALIGN_EPI) { if (wr == 0) PG8_BAR; }
        if constexpr (!Epi::AFTER_DRAIN) { E(acc, cur, wr, wc, fr, fq); S.done(cur); }
        if (!has_next) break;
#pragma unroll
        for (int a = 0; a < 2; ++a)
#pragma unroll
            for (int b = 0; b < 2; ++b)
#pragma unroll
                for (int m = 0; m < 4; ++m)
#pragma unroll
                    for (int n = 0; n < 2; ++n) acc[a][b][m][n] = (f32x4){0.f, 0.f, 0.f, 0.f};
        cur = nxt; cA = nA; cB = nB; ++ui;
        if constexpr (ALIGN_EPI) { if (wr == 1) PG8_BAR; }
    }
    PG8_WAIT_V(0);
    if constexpr (!ALIGN_EPI) { if (wr == 0) PG8_BAR; }
    PG8_BAR;
    if constexpr (Epi::AFTER_DRAIN) { E.fused(acc, cur, wr, wc, fr, fq, lds, wid, lane); S.done(cur); }
#undef PG8_SA
#undef PG8_SB
#undef PG8_STAGE
#undef PG8_LDA
#undef PG8_LDB
#undef PG8_MMA
#undef PG8_WAIT_V
#undef PG8_WAIT_L
#undef PG8_BAR
#undef PG8_SCHED
}
}
#define GAS __attribute__((address_space(1)))
#define LAS __attribute__((address_space(3)))
typedef unsigned short bf16;
typedef unsigned v4u __attribute__((ext_vector_type(4)));
typedef float f32x4 __attribute__((ext_vector_type(4)));
typedef short bf16x8 __attribute__((ext_vector_type(8)));
typedef GAS unsigned gu32;
typedef GAS unsigned long long gu64;
#define RLX_AGENT __ATOMIC_RELAXED, __HIP_MEMORY_SCOPE_AGENT
#define LDS_WAIT() asm volatile("s_waitcnt lgkmcnt(0)" ::: "memory")
#define VM_WAIT() asm volatile("s_waitcnt vmcnt(0)" ::: "memory")
__device__ __forceinline__ unsigned long long rt() { return __builtin_amdgcn_s_memrealtime(); }
__device__ __forceinline__ unsigned f2bf(float f) { unsigned u = __builtin_bit_cast(unsigned, f); return (u + 0x7fffu + ((u >> 16) & 1u)) >> 16; }
__device__ __forceinline__ unsigned pk2(float lo, float hi) { return f2bf(lo) | (f2bf(hi) << 16); }

#define XB_TMO      128
#define XB_XCNT(j)  (256  + 64 * (j))
#define XB_XSUB(j)  (1280 + 64 * (j))
#define XB_XGEN(j)  (2304 + 64 * (j))
#define XB_TOP      3328
#define XB_TOPGEN   3392
#define XCD_BAR_WORDS 3456
#define XB_SPIN_CAP (1u << 18)

__device__ __forceinline__ unsigned xb_ld(unsigned* p)              { return __hip_atomic_load(p, __ATOMIC_RELAXED, __HIP_MEMORY_SCOPE_AGENT); }
__device__ __forceinline__ unsigned xb_add(unsigned* p, unsigned v) { return __hip_atomic_fetch_add(p, v, __ATOMIC_RELAXED, __HIP_MEMORY_SCOPE_AGENT); }
__device__ __forceinline__ unsigned xb_xcc_id() { return (unsigned)__builtin_amdgcn_s_getreg((3 << 11) | 20) & 0xFu; }
#define XB_SPIN(cond, bar) do { unsigned _sp = 0; while (cond) { __builtin_amdgcn_s_sleep(1); \
    if ((++_sp & 255u) == 0u) { if (xb_ld(&(bar)[XB_TMO])) break; if (_sp > XB_SPIN_CAP) { atomicAdd(&(bar)[XB_TMO], 1u); break; } } } } while (0)

struct XcdBarrier {
    unsigned* bar; unsigned x;
    volatile LAS unsigned* st;
};

__device__ __forceinline__ XcdBarrier xcd_barrier_post(unsigned* bar, volatile LAS unsigned* st) {
    XcdBarrier b; b.bar = bar; b.x = xb_xcc_id(); b.st = st;
    if (threadIdx.x == 0) (void)xb_add(&bar[XB_XCNT(b.x)], 1u);
    return b;
}
__device__ __forceinline__ void xcd_barrier_complete(unsigned* bar, unsigned x, unsigned& nloc, unsigned& nx) {
    const unsigned G = gridDim.x * gridDim.y * gridDim.z;
    unsigned sum, cnt, mine, sp = 0u;
    for (;;) {
        sum = 0u; cnt = 0u; mine = 0u;
#pragma unroll
        for (unsigned j = 0; j < 16; ++j) { const unsigned c = xb_ld(&bar[XB_XCNT(j)]); sum += c; cnt += (c > 0u) ? 1u : 0u; mine = (j == x) ? c : mine; }
        if (sum == G) break;
        __builtin_amdgcn_s_sleep(1);
        if ((++sp & 255u) == 0u) { if (xb_ld(&bar[XB_TMO])) break; if (sp > XB_SPIN_CAP) { atomicAdd(&bar[XB_TMO], 1u); break; } }
    }
    nloc = mine > 0u ? mine : 1u; nx = cnt > 0u ? cnt : 1u;
}

__device__ __forceinline__ void xcd_barrier(const XcdBarrier& b) {
    asm volatile("s_waitcnt vmcnt(0)" ::: "memory");
    __syncthreads();
    if (threadIdx.x == 0) {
        unsigned* bar = b.bar;
        __builtin_amdgcn_s_waitcnt(0);
        unsigned nloc = b.st[0], nx = b.st[1];
        if (nloc == 0u) { xcd_barrier_complete(bar, b.x, nloc, nx); b.st[0] = nloc; b.st[1] = nx; }
        const unsigned old = xb_add(&bar[XB_XSUB(b.x)], 1u);
        const unsigned gen = old / nloc;
        if (old + 1u == (gen + 1u) * nloc) {
            __builtin_amdgcn_fence(__ATOMIC_RELEASE, "agent");
            asm volatile("s_waitcnt vmcnt(0)" ::: "memory");
            const unsigned og = xb_add(&bar[XB_TOP], 1u);
            const unsigned tg = og / nx;
            if (og + 1u == (tg + 1u) * nx) xb_add(&bar[XB_TOPGEN], 1u);
            else XB_SPIN(xb_ld(&bar[XB_TOPGEN]) == tg, bar);
            __builtin_amdgcn_fence(__ATOMIC_ACQUIRE, "agent");
            xb_add(&bar[XB_XGEN(b.x)], 1u);
            asm volatile("s_waitcnt vmcnt(0)" ::: "memory");
        } else {
            XB_SPIN(xb_ld(&bar[XB_XGEN(b.x)]) == gen, bar);
            __builtin_amdgcn_fence(__ATOMIC_ACQUIRE, "agent");
            asm volatile("s_waitcnt vmcnt(0)" ::: "memory");
        }
    }
    __syncthreads();
}
namespace att {
constexpr int   D = 128, NW = 8, QBLK = 32, KVBLK = 64;
constexpr float SCALE = 0.088388347648318440f;
constexpr float THR = 8.f;
constexpr int SDEPTH = 2;
constexpr int LDQ = 17408, LDK = 512, LDO = 2048;
constexpr size_t SHM_V = KVBLK * D * 2, SHM_K = KVBLK * D * 2, SHM_ATTN = 2 * SHM_V + 2 * SHM_K + NW * 64 * 4;
using bf16 = __hip_bfloat16;
using bf16x8 = __attribute__((ext_vector_type(8))) short;
using s16x4  = __attribute__((ext_vector_type(4))) short;
using f32x16 = __attribute__((ext_vector_type(16))) float;
using f32x8  = __attribute__((ext_vector_type(8))) float;
using u32x4  = __attribute__((ext_vector_type(4))) unsigned;
#define KSWZ(row, colB) ((row) * 256 + ((colB) ^ (((row) & 7) << 4)))
#define SBAR() __builtin_amdgcn_sched_barrier(0)
__device__ __forceinline__ int crow(int r, int hi) { return (r & 3) + 8 * (r >> 2) + 4 * hi; }
__device__ __forceinline__ unsigned cvtpk(float lo, float hi) {
  unsigned r; asm volatile("v_cvt_pk_bf16_f32 %0, %1, %2" : "=v"(r) : "v"(lo), "v"(hi)); return r;
}
template <typename TIn> struct Stage;
template <> struct Stage<bf16>  { using T = bf16x8;
  __device__ static __forceinline__ T ld8(const bf16* p) { return *reinterpret_cast<const bf16x8*>(p); }
  __device__ static __forceinline__ bf16x8 tobf(T x) { return x; } };
template <> struct Stage<float> { using T = f32x8;
  __device__ static __forceinline__ T ld8(const float* p) { return *reinterpret_cast<const f32x8*>(p); }
  __device__ static __forceinline__ bf16x8 tobf(T x) {
    u32x4 w = {cvtpk(x[0], x[1]), cvtpk(x[2], x[3]), cvtpk(x[4], x[5]), cvtpk(x[6], x[7])}; return *reinterpret_cast<bf16x8*>(&w); } };

__device__ __forceinline__ void partialSM(f32x16& p0, f32x16& p1, float& m_reg, float& mn, float& alpha) {
  constexpr float C = SCALE * 1.4426950408889634f;
  float pmax = p0[0]; for (int r = 1; r < 16; ++r) pmax = fmaxf(pmax, p0[r]); for (int r = 0; r < 16; ++r) pmax = fmaxf(pmax, p1[r]);
  { auto rr = __builtin_amdgcn_permlane32_swap(__float_as_uint(pmax), __float_as_uint(pmax), false, false);
    pmax = fmaxf(__uint_as_float(rr[0]), __uint_as_float(rr[1])); }
  if (__builtin_expect(__all(pmax - m_reg <= THR / SCALE), 1)) { mn = m_reg; alpha = 1.f; }
  else { mn = fmaxf(m_reg, pmax); alpha = __builtin_amdgcn_exp2f((m_reg - mn) * C); m_reg = mn; }
  float mnC = -mn * C;
  for (int r = 0; r < 16; ++r) p0[r] = fmaf(p0[r], C, mnC); for (int r = 0; r < 16; ++r) p1[r] = fmaf(p1[r], C, mnC);
  for (int r = 0; r < 16; ++r) p0[r] = __builtin_amdgcn_exp2f(p0[r]);
}
__device__ __forceinline__ void finishSM(f32x16& p0, f32x16& p1, float alpha, float& l_reg, bf16x8& pa0, bf16x8& pa1, bf16x8& pa2, bf16x8& pa3) {
  for (int r = 0; r < 16; ++r) p1[r] = __builtin_amdgcn_exp2f(p1[r]);
  float ps = 0; for (int r = 0; r < 16; ++r) ps += p0[r]; for (int r = 0; r < 16; ++r) ps += p1[r];
  { auto rr = __builtin_amdgcn_permlane32_swap(__float_as_uint(ps), __float_as_uint(ps), false, false);
    ps = __uint_as_float(rr[0]) + __uint_as_float(rr[1]); }
  l_reg = l_reg * alpha + ps;
#define PK4(P, BASE, OUT) do { unsigned a0 = cvtpk(P[BASE + 0], P[BASE + 1]), a1 = cvtpk(P[BASE + 2], P[BASE + 3]);   \
    unsigned b0 = cvtpk(P[BASE + 4], P[BASE + 5]), b1 = cvtpk(P[BASE + 6], P[BASE + 7]);                              \
    auto r0 = __builtin_amdgcn_permlane32_swap(a0, b0, false, false); auto r1 = __builtin_amdgcn_permlane32_swap(a1, b1, false, false); \
    u32x4 w = {r0[0], r1[0], r0[1], r1[1]}; OUT = *reinterpret_cast<bf16x8*>(&w); } while (0)
  PK4(p0, 0, pa0); PK4(p0, 8, pa1); PK4(p1, 0, pa2); PK4(p1, 8, pa3);
#undef PK4
}
__device__ __forceinline__ void qkt(f32x16& p0, f32x16& p1, const bf16* Ks, const bf16x8* qr, int r32, int hi) {
  p0 = f32x16{}; p1 = f32x16{};
  for (int d0 = 0; d0 < 8; ++d0) { int cb = (d0 * 16 + hi * 8) * 2;
    bf16x8 b0 = *reinterpret_cast<const bf16x8*>((const char*)Ks + KSWZ(r32, cb));
    bf16x8 b1 = *reinterpret_cast<const bf16x8*>((const char*)Ks + KSWZ(32 + r32, cb));
    p0 = __builtin_amdgcn_mfma_f32_32x32x16_bf16(b0, qr[d0], p0, 0, 0, 0);
    p1 = __builtin_amdgcn_mfma_f32_32x32x16_bf16(b1, qr[d0], p1, 0, 0, 0); }
}
__device__ __forceinline__ int v_st(int k, int c) { const int kk = (k & ~0xC) | ((k & 4) << 1) | ((k & 8) >> 1); return ((kk >> 3) * 4 + (c >> 5)) * 512 + ((kk & 7) * 32 + (c & 31)) * 2; }
__device__ __forceinline__ int v_rd_base(int lane) { return ((lane & 3) << 3) | (((lane >> 2) & 3) << 6) | (((lane >> 4) & 1) << 5) | (((lane >> 5) & 1) << 8); }
constexpr int v_rd_off(int d0, int ks, int half) { return d0 * 512 + ks * 4096 + half * 2048; }
template <int OFF> __device__ __forceinline__ s16x4 tr_read(int vb) {
  s16x4 r; asm volatile("ds_read_b64_tr_b16 %0, %1 offset:%2" : "=&v"(r) : "v"(vb), "i"(OFF) : "memory"); return r;
}
template <int D0> __device__ __forceinline__ void pv_one(f32x16& od, int vb, bf16x8 pa0, bf16x8 pa1, bf16x8 pa2, bf16x8 pa3) {
  const s16x4 l0 = tr_read<v_rd_off(D0, 0, 0)>(vb), h0 = tr_read<v_rd_off(D0, 0, 1)>(vb), l1 = tr_read<v_rd_off(D0, 1, 0)>(vb), h1 = tr_read<v_rd_off(D0, 1, 1)>(vb);
  const s16x4 l2 = tr_read<v_rd_off(D0, 2, 0)>(vb), h2 = tr_read<v_rd_off(D0, 2, 1)>(vb), l3 = tr_read<v_rd_off(D0, 3, 0)>(vb), h3 = tr_read<v_rd_off(D0, 3, 1)>(vb);
  asm volatile("s_waitcnt lgkmcnt(0)" ::: "memory"); SBAR();
#define PK(L, H) (bf16x8){L[0], L[1], L[2], L[3], H[0], H[1], H[2], H[3]}
  od = __builtin_amdgcn_mfma_f32_32x32x16_bf16(pa0, PK(l0, h0), od, 0, 0, 0);
  od = __builtin_amdgcn_mfma_f32_32x32x16_bf16(pa1, PK(l1, h1), od, 0, 0, 0);
  od = __builtin_amdgcn_mfma_f32_32x32x16_bf16(pa2, PK(l2, h2), od, 0, 0, 0);
  od = __builtin_amdgcn_mfma_f32_32x32x16_bf16(pa3, PK(l3, h3), od, 0, 0, 0);
#undef PK
}
__device__ __forceinline__ void pv_d0(f32x16* o, int vb, bf16x8 pa0, bf16x8 pa1, bf16x8 pa2, bf16x8 pa3) {
  pv_one<0>(o[0], vb, pa0, pa1, pa2, pa3); pv_one<1>(o[1], vb, pa0, pa1, pa2, pa3); pv_one<2>(o[2], vb, pa0, pa1, pa2, pa3); pv_one<3>(o[3], vb, pa0, pa1, pa2, pa3);
}

template <typename TQ>
__device__ __forceinline__ void attn_dense_body(const TQ* __restrict__ Qb, const bf16* __restrict__ Kh, const bf16* __restrict__ Vh,
                                                bf16* __restrict__ Ob, int seq, char* lds) {
  using St = Stage<bf16>; using SQ = Stage<TQ>;
  int tid_ = threadIdx.x; asm volatile("" : "+v"(tid_));
  const int tid = tid_, wid = tid >> 6, lane = tid & 63, r32 = lane & 31, hi = lane >> 5;
  bf16* V_lds = (bf16*)lds; bf16* K_lds = (bf16*)(lds + 2 * SHM_V);
  float* ws = (float*)(lds + 2 * SHM_V + 2 * SHM_K) + wid * 64; float* li_l = ws; float* al_l = ws + 32;
  float m_reg = -1e30f, l_reg = 0; f32x16 o[4] = {}; bf16x8 qr[8];
  const TQ* Qw = Qb + (long)(wid * QBLK + r32) * LDQ + hi * 8;
#pragma unroll
  for (int d0 = 0; d0 < 8; ++d0) qr[d0] = SQ::tobf(SQ::ld8(Qw + d0 * 16));
  const int sr = tid >> 4, sc = (tid & 15) * 8, vst0 = v_st(sr, sc), vst1 = v_st(32 + sr, sc);
  const int vb0 = (int)(uintptr_t)V_lds + v_rd_base(lane);
  struct { typename St::T vs0, vs1, ks0, ks1; } sr_[SDEPTH];
#define SLOAD(i, k0) do { sr_[i].vs0 = St::ld8(&Vh[(long)((k0) + sr) * LDK + sc]); sr_[i].vs1 = St::ld8(&Vh[(long)((k0) + 32 + sr) * LDK + sc]); \
    sr_[i].ks0 = St::ld8(&Kh[(long)((k0) + sr) * LDK + sc]); sr_[i].ks1 = St::ld8(&Kh[(long)((k0) + 32 + sr) * LDK + sc]); } while (0)
#define SWRITE(b, i) do { *(bf16x8*)((char*)V_lds + (b) * SHM_V + vst0) = St::tobf(sr_[i].vs0);          \
    *(bf16x8*)((char*)V_lds + (b) * SHM_V + vst1) = St::tobf(sr_[i].vs1); int kc = sc * 2;               \
    *(bf16x8*)((char*)K_lds + (b) * SHM_K + KSWZ(sr, kc)) = St::tobf(sr_[i].ks0);                       \
    *(bf16x8*)((char*)K_lds + (b) * SHM_K + KSWZ(32 + sr, kc)) = St::tobf(sr_[i].ks1); } while (0)
#define SWAIT() do { if constexpr (SDEPTH == 2) asm volatile("s_waitcnt vmcnt(4)" ::: "memory"); else asm volatile("s_waitcnt vmcnt(0)" ::: "memory"); } while (0)
#define RESC(a) do { if (__any((a) < 1.f)) { if (hi == 0) al_l[r32] = (a); asm volatile("s_waitcnt lgkmcnt(0)" ::: "memory"); \
    for (int d = 0; d < 4; ++d) for (int r = 0; r < 16; ++r) o[d][r] *= al_l[crow(r, hi)]; } } while (0)
  f32x16 pA0, pA1, pB0, pB1; float mnA, mnB, alA, alB; bf16x8 pa0, pa1, pa2, pa3; const int NT = seq / KVBLK;
  constexpr int SE = 0, SO = SDEPTH - 1;
  SLOAD(SE, 0); asm volatile("s_waitcnt vmcnt(0)" ::: "memory"); SWRITE(0, SE); __syncthreads();
  qkt(pA0, pA1, K_lds, qr, r32, hi); partialSM(pA0, pA1, m_reg, mnA, alA);
  SLOAD(SO, KVBLK); if constexpr (SDEPTH == 2) { if (2 < NT) SLOAD(SE, 2 * KVBLK); }
  SWAIT(); SWRITE(1, SO); __syncthreads();
  for (int j = 1; j + 1 < NT; j += 2) {
    SBAR(); qkt(pB0, pB1, (bf16*)((char*)K_lds + SHM_K), qr, r32, hi);
    finishSM(pA0, pA1, alA, l_reg, pa0, pa1, pa2, pa3); SBAR();
    SLOAD(SO, (j + SDEPTH) * KVBLK); SBAR();
    pv_d0(o, vb0, pa0, pa1, pa2, pa3); partialSM(pB0, pB1, m_reg, mnB, alB);
    __syncthreads(); SWAIT(); SWRITE(0, SE);
    RESC(alB); __syncthreads();
    SBAR(); qkt(pA0, pA1, K_lds, qr, r32, hi);
    finishSM(pB0, pB1, alB, l_reg, pa0, pa1, pa2, pa3); SBAR();
    if (SDEPTH == 1 || j + 3 < NT) SLOAD(SE, (j + 1 + SDEPTH) * KVBLK); SBAR();
    pv_d0(o, vb0 + (int)SHM_V, pa0, pa1, pa2, pa3); partialSM(pA0, pA1, m_reg, mnA, alA);
    __syncthreads(); SWAIT(); SWRITE(1, SO);
    RESC(alA); __syncthreads();
  }
  SBAR(); qkt(pB0, pB1, (bf16*)((char*)K_lds + SHM_K), qr, r32, hi);
  finishSM(pA0, pA1, alA, l_reg, pa0, pa1, pa2, pa3); SBAR();
  pv_d0(o, vb0, pa0, pa1, pa2, pa3); partialSM(pB0, pB1, m_reg, mnB, alB);
  __syncthreads(); RESC(alB);
  finishSM(pB0, pB1, alB, l_reg, pa0, pa1, pa2, pa3); SBAR();
  pv_d0(o, vb0 + (int)SHM_V, pa0, pa1, pa2, pa3);
  if (hi == 0) li_l[r32] = l_reg; asm volatile("s_waitcnt lgkmcnt(0)" ::: "memory");
  float rli[16];
#pragma unroll
  for (int r = 0; r < 16; ++r) rli[r] = __builtin_amdgcn_rcpf(li_l[crow(r, hi)]);
  bf16* Ow = Ob + (long)(wid * QBLK) * LDO;
#pragma unroll
  for (int r = 0; r < 16; ++r) { int orow = crow(r, hi);
    for (int d0 = 0; d0 < 4; ++d0) Ow[(long)orow * LDO + d0 * 32 + r32] = __float2bfloat16(o[d0][r] * rli[r]); }
#undef SLOAD
#undef SWRITE
#undef SWAIT
#undef RESC
}
#undef KSWZ
#undef SBAR
}
namespace fk {
using pg8::bf16_t; using pg8::f32x4; using pg8::u32x4; using pg8::Unit; using pg8::cvt_pk_bf16;
typedef unsigned u32x2 __attribute__((ext_vector_type(2)));
typedef float f32x16 __attribute__((ext_vector_type(16)));
constexpr int M = 24576, MP = 8192, D = 2048, INW = 17408, DFF = 8192, DEPTH = 4, NWAVES = 8, NCOND = 9;
constexpr int OFF_Q = 0, OFF_K = 2048, OFF_V = 2560, OFF_LX = 3072, OFF_LG = 5120, OFF_CU = 7168, OFF_CV = 9216, OFF_G = 11264;
constexpr int NKVROWS = 26624;
constexpr float EPS = 1e-6f;
constexpr int NPHASE = 3 + 9 * DEPTH;
constexpr size_t MiB = 1u << 20;
constexpr size_t WS_CTL = 0, CTL_ZERO_BYTES = 1 * MiB;
constexpr size_t WS_MODP = 1 * MiB, WS_MOD = 28 * MiB, WS_ROPE = 30 * MiB, WS_CVSTAT = 31 * MiB, WS_FSTAT = 34 * MiB, WS_AGG = 37 * MiB, WS_WLRU = 49 * MiB, WS_CMW = 51 * MiB;
constexpr size_t WS_WIN = 52 * MiB, WS_WBR = 120 * MiB, WS_WOUT = 144 * MiB, WS_WFF1 = 152 * MiB, WS_WFF2 = 184 * MiB;
constexpr size_t WS_H = 216 * MiB, WS_KALL = 312 * MiB, WS_VALL = 338 * MiB, WS_BR = 364 * MiB, WS_MSCR = 652 * MiB, WS_Z = 716 * MiB, WS_END = 1532 * MiB;
constexpr size_t WS_FFH = WS_Z, WS_F = WS_Z + 384 * MiB;
constexpr int CW_BAR = 4096;
constexpr int RING_BYTES = 131072;
constexpr int LRU_XC = 0, LRU_XC_PITCH = 272, LRU_A0 = 17408, LRU_B0 = LRU_A0 + 32768, LRU_A1 = LRU_B0 + 32768, LRU_B1 = LRU_A1 + 32768;
constexpr int CM_VT = 0, CM_VT_PITCH = 272, CM_RS = 128 * 272;
constexpr int MISC_OFF = 149504, LDS_BYTES = 150528;
static_assert(LRU_B1 + 32768 <= MISC_OFF, "lds map");

struct Params { const float* in[32]; float* out; unsigned char* ws; int ph_lo, ph_hi, li, pad; };

typedef const __attribute__((address_space(4))) void* kaptr_t;
struct Frame {
    LAS unsigned char* lds;
    int tid, lane, wave, vcu, G, gw, NGW, bx;
    float* out; unsigned char* ws; kaptr_t ka;
    __device__ __forceinline__ float* x() const { return out; }
    __device__ __forceinline__ float* new_k() const { return out + 50331648L; }
    __device__ __forceinline__ float* new_v() const { return out + 50331648L + 16777216L; }
    __device__ __forceinline__ float* new_s() const { return out + 50331648L + 2 * 16777216L; }
#define FK_WSP(name, type, off) __device__ __forceinline__ type* name() const { return (type*)(ws + (off)); }
    FK_WSP(MODP, float, WS_MODP) FK_WSP(MOD, float, WS_MOD) FK_WSP(ROPE, float, WS_ROPE) FK_WSP(CVSTAT, float, WS_CVSTAT) FK_WSP(FSTAT, float, WS_FSTAT) FK_WSP(AGG, float, WS_AGG) FK_WSP(MSCR, float, WS_MSCR)
    FK_WSP(WLRU, bf16_t, WS_WLRU) FK_WSP(CMW, bf16_t, WS_CMW) FK_WSP(WIN, bf16_t, WS_WIN) FK_WSP(WBR, bf16_t, WS_WBR) FK_WSP(WOUT, bf16_t, WS_WOUT) FK_WSP(WFF1, bf16_t, WS_WFF1) FK_WSP(WFF2, bf16_t, WS_WFF2)
    FK_WSP(H, bf16_t, WS_H) FK_WSP(KALL, bf16_t, WS_KALL) FK_WSP(VALL, bf16_t, WS_VALL) FK_WSP(BR, bf16_t, WS_BR) FK_WSP(Z, bf16_t, WS_Z) FK_WSP(FFH, bf16_t, WS_FFH) FK_WSP(Fb, bf16_t, WS_F)
#undef FK_WSP
};
enum { I_XP = 0, I_XS, I_CK, I_CV, I_SL, I_C, I_CCTX, I_WMOD, I_BMOD, I_GPM, I_GPOM, I_GPF, I_GPOF, I_WIN, I_GQ, I_GK, I_WAO, I_CW, I_CB, I_LWA, I_LBA, I_LWX, I_LBX, I_LAM, I_WLO, I_CMG, I_CMWS, I_CMBS, I_WCO, I_WOUT, I_WFF1, I_WFF2 };
template <int I> __device__ __forceinline__ const float* inp(const Frame& F) { const float* r; asm volatile("s_load_dwordx2 %0, %1, %2\n\ts_waitcnt lgkmcnt(0)" : "=s"(r) : "s"(F.ka), "i"(I * 8) : "memory"); return r; }


__device__ __forceinline__ Frame phase_frame(const Frame& F) {
    Frame P = F; int t = F.tid; int bx = blockIdx.x; unsigned char* w = F.ws; float* o = F.out;
    asm volatile("" : "+v"(t)); asm volatile("" : "+s"(bx), "+s"(w), "+s"(o));
    P.tid = t; P.lane = t & 63; P.wave = __builtin_amdgcn_readfirstlane(t >> 6); P.ws = w; P.out = o; P.bx = bx;
    P.vcu = (F.G % 8 == 0) ? (bx % 8) * (F.G / 8) + bx / 8 : bx; P.gw = P.vcu * NWAVES + P.wave;
    return P;
}
__device__ __forceinline__ float wave_sum(float v) {
#pragma unroll
    for (int o = 1; o < 64; o <<= 1) v += __shfl_xor(v, o);
    return v;
}
__device__ __forceinline__ float bf2f(unsigned short h) { return __uint_as_float((unsigned)h << 16); }
__device__ __forceinline__ float bflo(unsigned w) { return __uint_as_float(w << 16); }
__device__ __forceinline__ float bfhi(unsigned w) { return __uint_as_float(w & 0xffff0000u); }
__device__ __forceinline__ float fsigm(float x) { return __builtin_amdgcn_rcpf(1.f + __builtin_amdgcn_exp2f(-1.4426950408889634f * x)); }
__device__ __forceinline__ float fgelu(float x) { const float u = x * (1.5957691216057308f + 0.0713548162726009f * x * x); return x * fsigm(u); }

__device__ __forceinline__ void transpose_item(const float* W, int K, int N, bf16_t* WT, int row_off, LAS float* scr, int item, int lane) {
    const int nblk = N / 32, kb = item / nblk, nb = item % nblk, k0 = 64 * kb, n0 = 32 * nb;
#pragma unroll 8
    for (int i = 0; i < 32; ++i) { const int kk = 2 * i + (lane >> 5); scr[kk * 33 + (lane & 31)] = W[(size_t)(k0 + kk) * N + n0 + (lane & 31)]; }
    LDS_WAIT(); asm volatile("" ::: "memory");
    const int c = lane & 7;
#pragma unroll
    for (int j = 0; j < 4; ++j) { const int n = (lane >> 3) + 8 * j; const LAS float* s = scr + (8 * c) * 33 + n;
        v4u o; o.x = pk2(s[0 * 33], s[1 * 33]); o.y = pk2(s[2 * 33], s[3 * 33]); o.z = pk2(s[4 * 33], s[5 * 33]); o.w = pk2(s[6 * 33], s[7 * 33]);
        *(GAS v4u*)(WT + (size_t)(row_off + n0 + n) * K + k0 + 8 * c) = o; }
    LDS_WAIT(); asm volatile("" ::: "memory");
}
__device__ __forceinline__ void convert_layer(const Frame& F, int l) {
    LAS float* scr = (LAS float*)(F.lds + F.wave * 16384);
    constexpr int I_IN = 32 * 544, I_SQ = 32 * 64, I_F1 = 32 * 256, I_F2 = 128 * 64, I_LRU = 64 * 8;
    constexpr int NITEMS = I_IN + 4 * I_SQ + I_F1 + I_F2 + I_LRU;
    for (int it = F.gw; it < NITEMS; it += F.NGW) {
        int r = it;
        if (r < I_IN) { transpose_item(inp<I_WIN>(F) + (size_t)l * D * INW, D, INW, F.WIN(), 0, scr, r, F.lane); continue; } r -= I_IN;
        if (r < I_SQ) { transpose_item(inp<I_WAO>(F) + (size_t)l * D * D, D, D, F.WBR(), 0, scr, r, F.lane); continue; } r -= I_SQ;
        if (r < I_SQ) { transpose_item(inp<I_WLO>(F) + (size_t)l * D * D, D, D, F.WBR(), D, scr, r, F.lane); continue; } r -= I_SQ;
        if (r < I_SQ) { transpose_item(inp<I_WCO>(F) + (size_t)l * D * D, D, D, F.WBR(), 2 * D, scr, r, F.lane); continue; } r -= I_SQ;
        if (r < I_SQ) { transpose_item(inp<I_WOUT>(F) + (size_t)l * D * D, D, D, F.WOUT(), 0, scr, r, F.lane); continue; } r -= I_SQ;
        if (r < I_F1) { transpose_item(inp<I_WFF1>(F) + (size_t)l * D * DFF, D, DFF, F.WFF1(), 0, scr, r, F.lane); continue; } r -= I_F1;
        if (r < I_F2) { transpose_item(inp<I_WFF2>(F) + (size_t)l * DFF * D, DFF, D, F.WFF2(), 0, scr, r, F.lane); continue; } r -= I_F2;
        { const int bi = r >> 3, sub = r & 7, d = bi >> 5, mat = (bi >> 4) & 1, blk = bi & 15;
          const float* src = (mat ? inp<I_LWX>(F) : inp<I_LWA>(F)) + ((size_t)(l * 2 + d) * 16 + blk) * 16384;
          transpose_item(src, 128, 128, F.WLRU() + (size_t)bi * 16384, 0, scr, sub, F.lane); }
    }
    const float* cw = inp<I_CMWS>(F) + (size_t)l * 16 * 16384;
    for (int i = (F.gw * 64 + F.lane) * 8; i < 16 * 16384; i += F.NGW * 64 * 8) {
        const f32x4 a = *(const f32x4*)(cw + i), b = *(const f32x4*)(cw + i + 4);
        v4u o; o.x = pk2(a.x, a.y); o.y = pk2(a.z, a.w); o.z = pk2(b.x, b.y); o.w = pk2(b.z, b.w);
        *(v4u*)(F.CMW() + i) = o;
    }
}
__device__ __forceinline__ void mod_partials(const Frame& F) {
    LAS float* scr = (LAS float*)(F.lds + F.wave * 16384);
    for (int it = F.gw; it < DEPTH * 48 * 16; it += F.NGW) {
        const int kc = it & 15, jb = (it >> 4) % 48, l = it / (16 * 48), k0 = kc * 128;
        for (int e = F.lane; e < NCOND * 128; e += 64) { const int ci = e >> 7, kk = e & 127; const float v = ci == 0 ? inp<I_CCTX>(F)[k0 + kk] : inp<I_C>(F)[(ci - 1) * D + k0 + kk]; scr[e] = v * (1.f / (1.f + __expf(-v))); }
        LDS_WAIT(); asm volatile("" ::: "memory");
        f32x4 acc[NCOND];
#pragma unroll
        for (int ci = 0; ci < NCOND; ++ci) acc[ci] = (f32x4){0.f, 0.f, 0.f, 0.f};
        const float* wp = inp<I_WMOD>(F) + ((size_t)l * D + k0) * 12288 + jb * 256 + F.lane * 4;
#pragma unroll 4
        for (int kk = 0; kk < 128; ++kk) {
            const f32x4 w = *(const f32x4*)(wp + (size_t)kk * 12288);
#pragma unroll
            for (int ci = 0; ci < NCOND; ++ci) acc[ci] += w * scr[ci * 128 + kk];
        }
#pragma unroll
        for (int ci = 0; ci < NCOND; ++ci) *(f32x4*)(F.MODP() + (((size_t)kc * DEPTH + l) * NCOND + ci) * 12288 + jb * 256 + F.lane * 4) = acc[ci];
        LDS_WAIT(); asm volatile("" ::: "memory");
    }
}
__device__ __forceinline__ void mod_reduce(const Frame& F) {
    constexpr int NEL = DEPTH * NCOND * 12288;
    for (int i = (F.gw * 64 + F.lane) * 4; i < NEL; i += F.NGW * 64 * 4) {
        const int l = i / (NCOND * 12288), j = i % 12288;
        f32x4 s = *(const f32x4*)(inp<I_BMOD>(F) + (size_t)l * 12288 + j);
#pragma unroll
        for (int kc = 0; kc < 16; ++kc) s += *(const f32x4*)(F.MODP() + (size_t)kc * NEL + i);
        *(f32x4*)(F.MOD() + i) = s;
    }
}
__device__ __forceinline__ void rope_table(const Frame& F) {
    if (F.bx == 0) for (int e = F.tid; e < 2048; e += NWAVES * 64) {
        const int pos = e >> 5, f = e & 31; const float inv = exp2f(-(float)f * (13.287712379549449f / 32.f)); float s, c; sincosf((float)pos * inv, &s, &c);
        F.ROPE()[e] = c; F.ROPE()[2048 + e] = s; }
}
template <bool HAS_F, bool HAS_H>
__device__ __forceinline__ void rowlocal_row(const Frame& F, const float* xsrc, float* xdst, const bf16_t* frow, const float* fstat, const float* gate, const float* gpost,
                                             const float* gpre, const float* sc, const float* sh, bf16_t* hrow) {
    f32x4 xv[4][2];
#pragma unroll
    for (int j = 0; j < 4; ++j) { const int e = (j * 64 + F.lane) * 8; xv[j][0] = *(const f32x4*)(xsrc + e); xv[j][1] = *(const f32x4*)(xsrc + e + 4); }
    if (HAS_F) {
        const float st = F.lane < 32 ? fstat[F.lane] : 0.f;
        const float rs = rsqrtf(wave_sum(st) * (1.f / D) + EPS);
#pragma unroll
        for (int j = 0; j < 4; ++j) { const int e = (j * 64 + F.lane) * 8;
            const u32x4 fw = *(const u32x4*)(frow + e);
            const f32x4 g0 = *(const f32x4*)(gate + e), g1 = *(const f32x4*)(gate + e + 4), p0 = *(const f32x4*)(gpost + e), p1 = *(const f32x4*)(gpost + e + 4);
            const f32x4 f0 = {bflo(fw.x), bfhi(fw.x), bflo(fw.y), bfhi(fw.y)}, f1 = {bflo(fw.z), bfhi(fw.z), bflo(fw.w), bfhi(fw.w)};
            xv[j][0] += g0 * (f0 * rs * p0); xv[j][1] += g1 * (f1 * rs * p1); }
    }
#pragma unroll
    for (int j = 0; j < 4; ++j) { const int e = (j * 64 + F.lane) * 8; *(f32x4*)(xdst + e) = xv[j][0]; *(f32x4*)(xdst + e + 4) = xv[j][1]; }
    if (HAS_H) {
        float ss = 0.f;
#pragma unroll
        for (int j = 0; j < 4; ++j)
#pragma unroll
            for (int h = 0; h < 2; ++h) ss += (xv[j][h].x * xv[j][h].x + xv[j][h].y * xv[j][h].y) + (xv[j][h].z * xv[j][h].z + xv[j][h].w * xv[j][h].w);
        const float rs = rsqrtf(wave_sum(ss) * (1.f / D) + EPS);
#pragma unroll
        for (int j = 0; j < 4; ++j) { const int e = (j * 64 + F.lane) * 8;
            f32x4 o[2];
#pragma unroll
            for (int h = 0; h < 2; ++h) { const f32x4 g = *(const f32x4*)(gpre + e + 4 * h), s1 = *(const f32x4*)(sc + e + 4 * h), s0 = *(const f32x4*)(sh + e + 4 * h); o[h] = xv[j][h] * rs * g * (s1 + 1.f) + s0; }
            u32x4 w; w.x = cvt_pk_bf16(o[0].x, o[0].y); w.y = cvt_pk_bf16(o[0].z, o[0].w); w.z = cvt_pk_bf16(o[1].x, o[1].y); w.w = cvt_pk_bf16(o[1].z, o[1].w);
            *(u32x4*)(hrow + e) = w; }
    }
}
__device__ __forceinline__ int cond_of_row(int m) { return m < MP ? 0 : 1 + ((m - MP) >> 11); }
template <int MODE>
__device__ __forceinline__ void rowlocal_phase(const Frame& F, int l) {
    for (int m = F.gw; m < M; m += F.NGW) {
        const int ci = cond_of_row(m);
        float* xrow = F.x() + (size_t)m * D;
        const float* modl = F.MOD() + ((size_t)l * NCOND + ci) * 12288;
        if (MODE == 0) {
            const float* xs = m < MP ? inp<I_XP>(F) + (size_t)m * D : inp<I_XS>(F) + (size_t)(m - MP) * D;
            rowlocal_row<false, true>(F, xs, xrow, nullptr, nullptr, nullptr, nullptr, inp<I_GPM>(F), modl + 1 * D, modl + 0 * D, F.H() + (size_t)m * D);
        } else if (MODE == 1) {
            rowlocal_row<true, true>(F, xrow, xrow, F.Fb() + (size_t)m * D, F.FSTAT() + (size_t)m * 32, modl + 2 * D, inp<I_GPOM>(F) + (size_t)l * D,
                                     inp<I_GPF>(F) + (size_t)l * D, modl + 4 * D, modl + 3 * D, F.H() + (size_t)m * D);
        } else {
            if (l + 1 < DEPTH) { const float* modn = F.MOD() + ((size_t)(l + 1) * NCOND + ci) * 12288;
                rowlocal_row<true, true>(F, xrow, xrow, F.Fb() + (size_t)m * D, F.FSTAT() + (size_t)m * 32, modl + 5 * D, inp<I_GPOF>(F) + (size_t)l * D,
                                         inp<I_GPM>(F) + (size_t)(l + 1) * D, modn + 1 * D, modn + 0 * D, F.H() + (size_t)m * D); }
            else rowlocal_row<true, false>(F, xrow, xrow, F.Fb() + (size_t)m * D, F.FSTAT() + (size_t)m * 32, modl + 5 * D, inp<I_GPOF>(F) + (size_t)l * D, nullptr, nullptr, nullptr, nullptr);
        }
    }
}
__device__ __forceinline__ u32x4 pack8(const f32x4& a, const f32x4& b) { u32x4 w; w.x = cvt_pk_bf16(a[0], a[1]); w.y = cvt_pk_bf16(a[2], a[3]); w.z = cvt_pk_bf16(b[0], b[1]); w.w = cvt_pk_bf16(b[2], b[3]); return w; }
__device__ __forceinline__ f32x4 gelu4(const f32x4& v) { return (f32x4){fgelu(v[0]), fgelu(v[1]), fgelu(v[2]), fgelu(v[3])}; }
__device__ __forceinline__ f32x4 sigm4(const f32x4& v) { return (f32x4){fsigm(v[0]), fsigm(v[1]), fsigm(v[2]), fsigm(v[3])}; }
__device__ __forceinline__ int kv_row(int m) { return m < MP ? m : MP + ((m - MP) >> 11) * 2304 + ((m - MP) & 2047); }
struct EpiIn {
    static constexpr bool PERM = true, AFTER_DRAIN = false;
    bf16_t* Z; bf16_t* VALL; float* new_v; float* cvstat; int layer;
    __device__ __forceinline__ void operator()(const f32x4 (&acc)[2][2][4][2], const Unit& u, int wr, int wc, int fr, int fq) const {
        const int pn = u.pn, row0 = u.pm * 256 + wr * 64 + fr, cl = wc * 32 + 8 * fq;
        if (pn >= 10 && pn < 12) {
            const int colv = (pn - 10) * 256 + cl;
#pragma unroll
            for (int ai = 0; ai < 2; ++ai)
#pragma unroll
                for (int m = 0; m < 4; ++m) { const int row = row0 + ai * 128 + m * 16; bf16_t* dst = VALL + (size_t)kv_row(row) * 512 + colv;
#pragma unroll
                    for (int bj = 0; bj < 2; ++bj) { *(u32x4*)(dst + bj * 128) = pack8(acc[ai][bj][m][0], acc[ai][bj][m][1]);
                        if (row < MP) { float* nv = new_v + ((size_t)((row >> 8) * DEPTH + layer) * 256 + (row & 255)) * 512 + colv + bj * 128; *(f32x4*)nv = acc[ai][bj][m][0]; *(f32x4*)(nv + 4) = acc[ai][bj][m][1]; } } }
            return;
        }
        const int mode = (pn < 20) ? 0 : (pn < 36) ? 1 : (pn < 44) ? 2 : 3;
        const int col0 = pn * 256 + cl;
#pragma unroll
        for (int ai = 0; ai < 2; ++ai)
#pragma unroll
            for (int m = 0; m < 4; ++m) { const int row = row0 + ai * 128 + m * 16; bf16_t* dst = Z + (size_t)row * INW + col0; float ss = 0.f;
#pragma unroll
                for (int bj = 0; bj < 2; ++bj) { f32x4 v0 = acc[ai][bj][m][0], v1 = acc[ai][bj][m][1];
                    if (mode == 1 || mode == 2) { v0 = gelu4(v0); v1 = gelu4(v1); }
                    if (mode == 3) { v0 = sigm4(v0); v1 = sigm4(v1); }
                    if (mode == 2) ss += (v0[0] * v0[0] + v0[1] * v0[1]) + (v0[2] * v0[2] + v0[3] * v0[3]) + (v1[0] * v1[0] + v1[1] * v1[1]) + (v1[2] * v1[2] + v1[3] * v1[3]);
                    *(u32x4*)(dst + bj * 128) = pack8(v0, v1); }
                if (mode == 2) { ss += __shfl_xor(ss, 16); ss += __shfl_xor(ss, 32); if (fq == 0) cvstat[(size_t)row * 32 + (pn - 36) * 4 + wc] = ss; } }
    }
};
struct EpiRelu2 {
    static constexpr bool PERM = true, AFTER_DRAIN = false;
    bf16_t* O; int ldc;
    __device__ __forceinline__ void operator()(const f32x4 (&acc)[2][2][4][2], const Unit& u, int wr, int wc, int fr, int fq) const {
        const int row0 = u.pm * 256 + wr * 64 + fr, col0 = u.pn * 256 + wc * 32 + 8 * fq;
#pragma unroll
        for (int ai = 0; ai < 2; ++ai)
#pragma unroll
            for (int m = 0; m < 4; ++m) { bf16_t* dst = O + (size_t)(row0 + ai * 128 + m * 16) * ldc + col0;
#pragma unroll
                for (int bj = 0; bj < 2; ++bj) { f32x4 v0 = __builtin_elementwise_max(acc[ai][bj][m][0], (f32x4){0.f, 0.f, 0.f, 0.f}), v1 = __builtin_elementwise_max(acc[ai][bj][m][1], (f32x4){0.f, 0.f, 0.f, 0.f});
                    *(u32x4*)(dst + bj * 128) = pack8(v0 * v0, v1 * v1); } }
    }
};
struct EpiF {
    static constexpr bool PERM = true, AFTER_DRAIN = false;
    bf16_t* O; float* stat;
    __device__ __forceinline__ void operator()(const f32x4 (&acc)[2][2][4][2], const Unit& u, int wr, int wc, int fr, int fq) const {
        const int row0 = u.pm * 256 + wr * 64 + fr, col0 = u.pn * 256 + wc * 32 + 8 * fq;
#pragma unroll
        for (int ai = 0; ai < 2; ++ai)
#pragma unroll
            for (int m = 0; m < 4; ++m) { const int row = row0 + ai * 128 + m * 16; bf16_t* dst = O + (size_t)row * D + col0; float ss = 0.f;
#pragma unroll
                for (int bj = 0; bj < 2; ++bj) { const f32x4 v0 = acc[ai][bj][m][0], v1 = acc[ai][bj][m][1];
                    ss += (v0[0] * v0[0] + v0[1] * v0[1]) + (v0[2] * v0[2] + v0[3] * v0[3]) + (v1[0] * v1[0] + v1[1] * v1[1]) + (v1[2] * v1[2] + v1[3] * v1[3]);
                    *(u32x4*)(dst + bj * 128) = pack8(v0, v1); }
                ss += __shfl_xor(ss, 16); ss += __shfl_xor(ss, 32); if (fq == 0) stat[(size_t)row * 32 + u.pn * 4 + wc] = ss; }
    }
};
struct EpiMerge {
    static constexpr bool PERM = true, AFTER_DRAIN = false;
    const bf16_t* Z; float* scr  ; bf16_t* O;
    __device__ __forceinline__ void operator()(const f32x4 (&acc)[2][2][4][2], const Unit& u, int wr, int wc, int fr, int fq) const {
        const int br = u.pn >> 3, pn = u.pn & 7, pm = u.pm - 96 * br;
        const int rl0 = wr * 64 + fr, cl = wc * 32 + 8 * fq;
#pragma unroll
        for (int ai = 0; ai < 2; ++ai)
#pragma unroll
            for (int m = 0; m < 4; ++m) { const int rl = rl0 + ai * 128 + m * 16, row = pm * 256 + rl;
#pragma unroll
                for (int bj = 0; bj < 2; ++bj) { const int c = cl + bj * 128;
                    const u32x4 gw = *(const u32x4*)(Z + (size_t)row * INW + OFF_G + br * D + pn * 256 + c);
                    const f32x4 g0 = {bflo(gw.x), bfhi(gw.x), bflo(gw.y), bfhi(gw.y)}, g1 = {bflo(gw.z), bfhi(gw.z), bflo(gw.w), bfhi(gw.w)};
                    f32x4 v0 = g0 * acc[ai][bj][m][0], v1 = g1 * acc[ai][bj][m][1];
                    float* sp = scr + rl * 256 + c;
                    if (br > 0) { v0 += *(const f32x4*)sp; v1 += *(const f32x4*)(sp + 4); }
                    if (br < 2) { *(f32x4*)sp = v0; *(f32x4*)(sp + 4) = v1; }
                    else *(u32x4*)(O + (size_t)row * D + pn * 256 + c) = pack8(v0, v1); } }
    }
};
struct MergeOrder {
    pg8::StaticOrder so;
    __device__ void init(int G, int c) { so.init(M, D, G, c); }
    __device__ bool next(int i, Unit& u) const { const int br = i % 3; if (!so.next(i / 3, u)) return false; u.pm += 96 * br; u.pn += 8 * br; return true; }
    __device__ __forceinline__ void a_ready(const Unit&) const {}
    __device__ __forceinline__ void done(const Unit&) const {}
};
}
namespace fk {
typedef short bf16x8 __attribute__((ext_vector_type(8)));
__device__ __forceinline__ void prep_row(const Frame& F, int m, int l) {
    const bool sample = m >= MP; int b, t;
    if (!sample) { b = m >> 8; t = m & 255; } else { b = (m - MP) >> 11; t = (m - MP) & 2047; }
    const int kvrow = sample ? MP + b * 2304 + t : m;
    const int lane = F.lane, g8 = lane >> 3, j = lane & 7, axis = g8 & 1, hsel = lane >> 4;
    bf16_t* zrow = F.Z() + (size_t)m * INW;
    const int dA = axis * 64 + 4 * j, dB = dA + 32;
    const f32x4 gqa = *(const f32x4*)(inp<I_GQ>(F) + l * 128 + dA), gqb = *(const f32x4*)(inp<I_GQ>(F) + l * 128 + dB);
    const f32x4 gka = *(const f32x4*)(inp<I_GK>(F) + l * 128 + dA), gkb = *(const f32x4*)(inp<I_GK>(F) + l * 128 + dB);
    f32x4 cs = {1.f, 1.f, 1.f, 1.f}, sn = {0.f, 0.f, 0.f, 0.f};
    if (sample) { const int pos = axis == 0 ? (t >> 6) : (t & 63); cs = *(const f32x4*)(F.ROPE() + pos * 32 + 4 * j); sn = *(const f32x4*)(F.ROPE() + 2048 + pos * 32 + 4 * j); }
#pragma unroll
    for (int pass = 0; pass < 5; ++pass) {
        const bool isq = pass < 4;
        const int base = isq ? OFF_Q + (pass * 4 + hsel) * 128 + dA : OFF_K + hsel * 128 + dA;
        const u32x2 wa = *(const u32x2*)(zrow + base), wb = *(const u32x2*)(zrow + base + 32);
        const f32x4 xa = {bflo(wa.x), bfhi(wa.x), bflo(wa.y), bfhi(wa.y)}, xb = {bflo(wb.x), bfhi(wb.x), bflo(wb.y), bfhi(wb.y)};
        float ss = (xa.x * xa.x + xa.y * xa.y) + (xa.z * xa.z + xa.w * xa.w) + (xb.x * xb.x + xb.y * xb.y) + (xb.z * xb.z + xb.w * xb.w);
        ss += __shfl_xor(ss, 1); ss += __shfl_xor(ss, 2); ss += __shfl_xor(ss, 4); ss += __shfl_xor(ss, 8);
        const float rs = rsqrtf(ss * (1.f / 128.f) + EPS);
        const f32x4 na = xa * rs * (isq ? gqa : gka), nb = xb * rs * (isq ? gqb : gkb);
        const f32x4 ra = na * cs - nb * sn, rb = na * sn + nb * cs;
        u32x2 oa, ob; oa.x = cvt_pk_bf16(ra.x, ra.y); oa.y = cvt_pk_bf16(ra.z, ra.w); ob.x = cvt_pk_bf16(rb.x, rb.y); ob.y = cvt_pk_bf16(rb.z, rb.w);
        if (isq) { *(u32x2*)(zrow + base) = oa; *(u32x2*)(zrow + base + 32) = ob; }
        else {
            bf16_t* kd = F.KALL() + (size_t)kvrow * 512 + hsel * 128 + dA; *(u32x2*)kd = oa; *(u32x2*)(kd + 32) = ob;
            if (!sample) { float* nk = F.new_k() + ((size_t)(b * DEPTH + l) * 256 + t) * 512 + hsel * 128 + dA; *(f32x4*)nk = na; *(f32x4*)(nk + 32) = nb; }
        }
    }
}
__device__ __forceinline__ void prep_phase(const Frame& F, int l) {
    for (int m = F.gw; m < M; m += F.NGW) prep_row(F, m, l);
    for (int it = F.gw; it < 2 * 8 * 256; it += F.NGW) {
        const int which = it >> 11, b = (it >> 8) & 7, p = it & 255;
        const float* src = (which ? inp<I_CV>(F) : inp<I_CK>(F)) + ((size_t)(b * DEPTH + l) * 256 + p) * 512 + F.lane * 8;
        bf16_t* dst = (which ? F.VALL() : F.KALL()) + (size_t)(MP + b * 2304 + 2048 + p) * 512 + F.lane * 8;
        const f32x4 a = *(const f32x4*)src, c = *(const f32x4*)(src + 4);
        *(u32x4*)dst = pack8(a, c);
    }
}
__device__ __forceinline__ int crow(int r, int hi) { return (r & 3) + 8 * (r >> 2) + 4 * hi; }
template <int PASS>
__device__ __forceinline__ void lru_unit(const Frame& F, int l, int ck, int blk) {
    const int tid = F.tid, lane = F.lane, wave = F.wave;
    const int m0 = ck * 64; const bool sample = m0 >= MP;
    int b, t0, T; if (!sample) { b = m0 >> 8; t0 = m0 & 255; T = 256; } else { b = (m0 - MP) >> 11; t0 = (m0 - MP) & 2047; T = 2048; }
    const int C0 = blk * 128;
    LAS unsigned char* lds = F.lds;
    {
        const int row = tid >> 3, c16 = (tid & 7) * 16, t = t0 + row;
        float xc[16];
        const float* cb = inp<I_CB>(F) + (size_t)l * D + C0 + c16;
#pragma unroll
        for (int i = 0; i < 16; i += 4) { const f32x4 v = *(const f32x4*)(cb + i); xc[i] = v.x; xc[i + 1] = v.y; xc[i + 2] = v.z; xc[i + 3] = v.w; }
#pragma unroll
        for (int jj = 0; jj < 4; ++jj) {
            const int tt = t + jj - 2;
            if (tt >= 0 && tt < T) {
                const bf16_t* zp = F.Z() + (size_t)(m0 + row + jj - 2) * INW + OFF_LX + C0 + c16;
                const u32x4 z0 = *(const u32x4*)zp, z1 = *(const u32x4*)(zp + 8);
                const float* cw = inp<I_CW>(F) + ((size_t)l * 4 + jj) * D + C0 + c16;
                const f32x4 w0 = *(const f32x4*)cw, w1 = *(const f32x4*)(cw + 4), w2 = *(const f32x4*)(cw + 8), w3 = *(const f32x4*)(cw + 12);
                xc[0] += bflo(z0.x) * w0.x; xc[1] += bfhi(z0.x) * w0.y; xc[2] += bflo(z0.y) * w0.z; xc[3] += bfhi(z0.y) * w0.w;
                xc[4] += bflo(z0.z) * w1.x; xc[5] += bfhi(z0.z) * w1.y; xc[6] += bflo(z0.w) * w1.z; xc[7] += bfhi(z0.w) * w1.w;
                xc[8] += bflo(z1.x) * w2.x; xc[9] += bfhi(z1.x) * w2.y; xc[10] += bflo(z1.y) * w2.z; xc[11] += bfhi(z1.y) * w2.w;
                xc[12] += bflo(z1.z) * w3.x; xc[13] += bfhi(z1.z) * w3.y; xc[14] += bflo(z1.w) * w3.z; xc[15] += bfhi(z1.w) * w3.w;
            }
        }
        u32x4 o0, o1; o0.x = cvt_pk_bf16(xc[0], xc[1]); o0.y = cvt_pk_bf16(xc[2], xc[3]); o0.z = cvt_pk_bf16(xc[4], xc[5]); o0.w = cvt_pk_bf16(xc[6], xc[7]);
        o1.x = cvt_pk_bf16(xc[8], xc[9]); o1.y = cvt_pk_bf16(xc[10], xc[11]); o1.z = cvt_pk_bf16(xc[12], xc[13]); o1.w = cvt_pk_bf16(xc[14], xc[15]);
        LAS unsigned char* xp = lds + LRU_XC + row * LRU_XC_PITCH + c16 * 2;
        *(LAS u32x4*)xp = o0; *(LAS u32x4*)(xp + 16) = o1;
    }
    __syncthreads();
    {
        const int d = wave >> 2, n0 = (wave & 3) * 32, nl = lane & 31, hi = lane >> 5;
        f32x16 acc[2][2];
#pragma unroll
        for (int mat = 0; mat < 2; ++mat)
#pragma unroll
            for (int mt = 0; mt < 2; ++mt)
#pragma unroll
                for (int r = 0; r < 16; ++r) acc[mat][mt][r] = 0.f;
        const bf16_t* wb0 = F.WLRU() + ((size_t)((d * 2 + 0) * 16 + blk) * 128 + n0 + nl) * 128 + hi * 8;
        const bf16_t* wb1 = F.WLRU() + ((size_t)((d * 2 + 1) * 16 + blk) * 128 + n0 + nl) * 128 + hi * 8;
        const LAS unsigned char* ap = lds + LRU_XC + nl * LRU_XC_PITCH + hi * 16;
#pragma unroll
        for (int ks = 0; ks < 8; ++ks) {
            const bf16x8 bw0 = *(const bf16x8*)(wb0 + ks * 16), bw1 = *(const bf16x8*)(wb1 + ks * 16);
            const bf16x8 a0 = *(const LAS bf16x8*)(ap + ks * 32), a1 = *(const LAS bf16x8*)(ap + 32 * LRU_XC_PITCH + ks * 32);
            acc[0][0] = __builtin_amdgcn_mfma_f32_32x32x16_bf16(a0, bw0, acc[0][0], 0, 0, 0);
            acc[0][1] = __builtin_amdgcn_mfma_f32_32x32x16_bf16(a1, bw0, acc[0][1], 0, 0, 0);
            acc[1][0] = __builtin_amdgcn_mfma_f32_32x32x16_bf16(a0, bw1, acc[1][0], 0, 0, 0);
            acc[1][1] = __builtin_amdgcn_mfma_f32_32x32x16_bf16(a1, bw1, acc[1][1], 0, 0, 0);
        }
        const int c = n0 + nl, C = C0 + c;
        const float bav = inp<I_LBA>(F)[(size_t)(l * 2 + d) * D + C], bxv = inp<I_LBX>(F)[(size_t)(l * 2 + d) * D + C], lam = inp<I_LAM>(F)[(size_t)(l * 2 + d) * D + C];
        const float sp = log1pf(__expf(-lam));
        LAS float* Ad = (LAS float*)(lds + (d ? LRU_A1 : LRU_A0)); LAS float* Bd = (LAS float*)(lds + (d ? LRU_B1 : LRU_B0));
#pragma unroll
        for (int mt = 0; mt < 2; ++mt)
#pragma unroll
            for (int r = 0; r < 16; ++r) {
                const int tl = mt * 32 + crow(r, hi);
                const float rg = fsigm(acc[0][mt][r] + bav), ig = fsigm(acc[1][mt][r] + bxv);
                const float la = -8.f * rg * sp, a = __expf(la);
                const float mult = sqrtf(fmaxf(-expm1f(2.f * la), 0.f));
                const float xcv = bf2f(*(const LAS unsigned short*)(lds + LRU_XC + tl * LRU_XC_PITCH + c * 2));
                Ad[tl * 128 + c] = a; Bd[tl * 128 + c] = mult * ig * xcv;
            }
    }
    __syncthreads();
    if (tid < 256) {
        const int d = tid >> 7, c = tid & 127, C = C0 + c;
        const LAS float* Ad = (const LAS float*)(lds + (d ? LRU_A1 : LRU_A0)); LAS float* Bd = (LAS float*)(lds + (d ? LRU_B1 : LRU_B0));
        if (PASS == 1) {
            float h = 0.f, P = 1.f;
#pragma unroll 8
            for (int s = 0; s < 64; ++s) { const int t = d ? 63 - s : s; const float a = Ad[t * 128 + c]; h = a * h + Bd[t * 128 + c]; P *= a; }
            *(float2*)(F.AGG() + ((size_t)(ck * 2 + d) * D + C) * 2) = make_float2(P, h);
        } else {
            const int jc = t0 >> 6, nch = T >> 6;
            float carry = sample ? inp<I_SL>(F)[((size_t)(b * DEPTH + l) * 2 + d) * D + C] : 0.f;
            if (d == 0) { for (int jj = 0; jj < jc; ++jj) { const float2 pe = *(const float2*)(F.AGG() + ((size_t)((ck - jc + jj) * 2 + 0) * D + C) * 2); carry = pe.x * carry + pe.y; } }
            else { for (int jj = nch - 1; jj > jc; --jj) { const float2 pe = *(const float2*)(F.AGG() + ((size_t)((ck - jc + jj) * 2 + 1) * D + C) * 2); carry = pe.x * carry + pe.y; } }
            float h = carry;
#pragma unroll 8
            for (int s = 0; s < 64; ++s) { const int t = d ? 63 - s : s; h = Ad[t * 128 + c] * h + Bd[t * 128 + c]; Bd[t * 128 + c] = h; }
            if (!sample && ((d == 0 && jc == nch - 1) || (d == 1 && jc == 0))) F.new_s()[((size_t)(b * DEPTH + l) * 2 + d) * D + C] = h;
        }
    }
    if (PASS == 2) {
        __syncthreads();
        const int row = tid >> 3, c16 = (tid & 7) * 16;
        const LAS float* h0 = (const LAS float*)(lds + LRU_B0) + row * 128 + c16; const LAS float* h1 = (const LAS float*)(lds + LRU_B1) + row * 128 + c16;
        const bf16_t* gp = F.Z() + (size_t)(m0 + row) * INW + OFF_LG + C0 + c16;
        const u32x4 g0 = *(const u32x4*)gp, g1 = *(const u32x4*)(gp + 8);
        const unsigned gw[8] = {g0.x, g0.y, g0.z, g0.w, g1.x, g1.y, g1.z, g1.w};
        unsigned ow[8];
#pragma unroll
        for (int i = 0; i < 8; ++i) ow[i] = cvt_pk_bf16((h0[2 * i] + h1[2 * i]) * bflo(gw[i]), (h0[2 * i + 1] + h1[2 * i + 1]) * bfhi(gw[i]));
        bf16_t* yp = F.BR() + (size_t)1 * M * D + (size_t)(m0 + row) * D + C0 + c16;
        *(u32x4*)yp = (u32x4){ow[0], ow[1], ow[2], ow[3]}; *(u32x4*)(yp + 8) = (u32x4){ow[4], ow[5], ow[6], ow[7]};
    }
    __syncthreads();
}
__device__ __forceinline__ void cm_unit(const Frame& F, int l, int cn, int g) {
    const int tid = F.tid, lane = F.lane, wave = F.wave, m0 = cn * 128, C0 = g * 128;
    LAS unsigned char* lds = F.lds;
    LAS float* RS = (LAS float*)(lds + CM_RS);
    if (tid < 128) { const float* st = F.CVSTAT() + (size_t)(m0 + tid) * 32; float s = 0.f;
#pragma unroll
        for (int i = 0; i < 32; i += 4) { const f32x4 v = *(const f32x4*)(st + i); s += (v.x + v.y) + (v.z + v.w); }
        RS[tid] = rsqrtf(s * (1.f / D) + EPS); }
    __syncthreads();
    {
        const int p = tid >> 2, c32 = (tid & 3) * 32; const float rs = RS[p];
        const bf16_t* vp = F.Z() + (size_t)(m0 + p) * INW + OFF_CV + C0 + c32; const float* gp = inp<I_CMG>(F) + (size_t)l * D + C0 + c32;
#pragma unroll
        for (int q4 = 0; q4 < 4; ++q4) {
            const u32x4 w = *(const u32x4*)(vp + q4 * 8); const f32x4 ga = *(const f32x4*)(gp + q4 * 8), gb = *(const f32x4*)(gp + q4 * 8 + 4);
            const float v[8] = {bflo(w.x) * ga.x, bfhi(w.x) * ga.y, bflo(w.y) * ga.z, bfhi(w.y) * ga.w, bflo(w.z) * gb.x, bfhi(w.z) * gb.y, bflo(w.w) * gb.z, bfhi(w.w) * gb.w};
#pragma unroll
            for (int i = 0; i < 8; ++i) *(LAS unsigned short*)(lds + CM_VT + (c32 + q4 * 8 + i) * CM_VT_PITCH + p * 2) = (unsigned short)(cvt_pk_bf16(v[i] * rs, 0.f) & 0xffffu);
        }
    }
    __syncthreads();
    {
        const int mt = wave >> 1, nt0 = (wave & 1) * 2, xl = lane & 31, hi = lane >> 5;
        f32x16 acc[2];
#pragma unroll
        for (int r = 0; r < 16; ++r) { acc[0][r] = 0.f; acc[1][r] = 0.f; }
        const bf16_t* wp = F.CMW() + ((size_t)g * 128 + mt * 32 + xl) * 128 + hi * 8;
        const LAS unsigned char* bp = lds + CM_VT + (nt0 * 32 + xl) * CM_VT_PITCH + hi * 16;
#pragma unroll
        for (int ks = 0; ks < 8; ++ks) {
            const bf16x8 a = *(const bf16x8*)(wp + ks * 16);
            const bf16x8 b0 = *(const LAS bf16x8*)(bp + ks * 32), b1 = *(const LAS bf16x8*)(bp + 32 * CM_VT_PITCH + ks * 32);
            acc[0] = __builtin_amdgcn_mfma_f32_32x32x16_bf16(a, b0, acc[0], 0, 0, 0);
            acc[1] = __builtin_amdgcn_mfma_f32_32x32x16_bf16(a, b1, acc[1], 0, 0, 0);
        }
        const float* bs = inp<I_CMBS>(F) + ((size_t)l * 16 + g) * 128;
#pragma unroll
        for (int nt = 0; nt < 2; ++nt)
#pragma unroll
            for (int r = 0; r < 16; ++r) {
                const int q = mt * 32 + crow(r, hi), c = (nt0 + nt) * 32 + xl;
                const float u = bf2f(F.Z()[(size_t)(m0 + q) * INW + OFF_CU + C0 + c]);
                const float o = u * (acc[nt][r] + bs[q]);
                F.BR()[(size_t)2 * M * D + (size_t)(m0 + q) * D + C0 + c] = (bf16_t)(cvt_pk_bf16(o, 0.f) & 0xffffu);
            }
    }
    __syncthreads();
}
__device__ __forceinline__ void attn_phase(const Frame& F) {
    char* lds = (char*)F.lds;
    const att::bf16* Z = (const att::bf16*)F.Z(); const att::bf16* K = (const att::bf16*)F.KALL(); const att::bf16* V = (const att::bf16*)F.VALL(); att::bf16* O = (att::bf16*)F.BR();
    for (int id = F.bx; id < 1536; id += F.G) {
        size_t qrow, kvrow; int h, nkeys;
        if (id < 1024) { const int qb = id & 7, b = id >> 7; h = (id >> 3) & 15; qrow = (size_t)MP + (size_t)b * 2048 + qb * 256; kvrow = (size_t)MP + (size_t)b * 2304; nkeys = 2304; }
        else { const int id2 = id - 1024, b = id2 >> 4; h = id2 & 15; qrow = (size_t)b * 256; kvrow = qrow; nkeys = 256; }
        att::attn_dense_body<att::bf16>(Z + qrow * INW + OFF_Q + h * 128, K + kvrow * 512 + (h >> 2) * 128, V + kvrow * 512 + (h >> 2) * 128, O + qrow * D + h * 128, nkeys, lds);
    }
    __syncthreads();
}
}
namespace fk {
__global__ void __launch_bounds__(NWAVES * 64, 2) mega(Params p) {
    extern __shared__ __attribute__((aligned(16))) unsigned char lds_raw[];
    Frame F;
    F.lds = (LAS unsigned char*)lds_raw;
    F.tid = threadIdx.x; F.lane = F.tid & 63; F.wave = __builtin_amdgcn_readfirstlane(F.tid >> 6);
    F.G = gridDim.x; { const int bx = blockIdx.x; F.vcu = (F.G % 8 == 0) ? (bx % 8) * (F.G / 8) + bx / 8 : bx; }
    F.gw = F.vcu * NWAVES + F.wave; F.NGW = F.G * NWAVES; F.bx = blockIdx.x;
    F.out = p.out; F.ws = p.ws; F.ka = (kaptr_t)__builtin_amdgcn_kernarg_segment_ptr();
    unsigned char* ws = p.ws;
    volatile LAS unsigned* MISC = (volatile LAS unsigned*)(F.lds + MISC_OFF);
    for (int u = F.tid; u < (LDS_BYTES - MISC_OFF) / 4; u += NWAVES * 64) ((LAS unsigned*)(F.lds + MISC_OFF))[u] = 0u;
    __syncthreads();
    unsigned* barw = (unsigned*)(ws + WS_CTL) + CW_BAR + p.li * XCD_BAR_WORDS;
    XcdBarrier bar = xcd_barrier_post(barw, MISC + 8);
    const int lo = p.ph_lo, hi = p.ph_hi;
#define IN_PH(k) (lo <= (k) && (k) < hi)
#define SEAM(k) do { if ((k) + 1 < hi) xcd_barrier(bar); } while (0)

    if (IN_PH(0)) { const Frame P = phase_frame(F);
#ifndef OFF_P0
convert_layer(P, 0); mod_partials(P); rope_table(P);
#endif
 SEAM(0); }
    if (IN_PH(1)) { const Frame P = phase_frame(F); mod_reduce(P); SEAM(1); }
    if (IN_PH(2)) { const Frame P = phase_frame(F); rowlocal_phase<0>(P, 0); SEAM(2); }
    for (int l = 0; l < DEPTH; ++l) {
        const int pb = 3 + 9 * l;
        if (IN_PH(pb + 0)) { const Frame P = phase_frame(F);
            pg8::Gemm g{P.H(), P.WIN(), M, INW, D}; pg8::StaticOrder S; S.init(M, INW, P.G, P.bx);
            EpiIn E{P.Z(), P.VALL(), P.new_v(), P.CVSTAT(), l};

#ifndef OFF_GIN
pg8::gemm_phase<EpiIn, pg8::StaticOrder, true, true>(P.lds, g, S, E);
#endif

            SEAM(pb + 0);
        }
        if (IN_PH(pb + 1)) { const Frame P = phase_frame(F);

#ifndef OFF_PREP
prep_phase(P, l);
#endif

            __syncthreads();

#ifndef OFF_LRU1
for (int u = P.bx; u < 384 * 16; u += P.G) lru_unit<1>(P, l, u >> 4, u & 15);
#endif


#ifndef OFF_CM
for (int u = P.bx; u < 192 * 16; u += P.G) cm_unit(P, l, u >> 4, u & 15);
#endif

            SEAM(pb + 1);
        }
        if (IN_PH(pb + 2)) { const Frame P = phase_frame(F);

#ifndef OFF_ATT
attn_phase(P);
#endif


#ifndef OFF_LRU2
for (int u = P.bx; u < 384 * 16; u += P.G) lru_unit<2>(P, l, u >> 4, u & 15);
#endif

            SEAM(pb + 2);
        }
        if (IN_PH(pb + 3)) { const Frame P = phase_frame(F);
            pg8::Gemm g{P.BR(), P.WBR(), 3 * M, 3 * D, D}; MergeOrder S; S.init(P.G, P.bx);
            EpiMerge E{P.Z(), P.MSCR() + (size_t)P.bx * 65536, P.H()};

#ifndef OFF_GMERGE
pg8::gemm_phase<EpiMerge, MergeOrder, true, true>(P.lds, g, S, E);
#endif

            SEAM(pb + 3);
        }
        if (IN_PH(pb + 4)) { const Frame P = phase_frame(F);
            pg8::Gemm g{P.H(), P.WOUT(), M, D, D}; pg8::StaticOrder S; S.init(M, D, P.G, P.bx);
            EpiF E{P.Fb(), P.FSTAT()};

#ifndef OFF_GOUT
pg8::gemm_phase<EpiF, pg8::StaticOrder, true, true>(P.lds, g, S, E);
            SEAM(pb + 4);
#endif

        }
        if (IN_PH(pb + 5)) { const Frame P = phase_frame(F);
#ifndef OFF_ROW1
rowlocal_phase<1>(P, l);
#endif
 SEAM(pb + 5); }
        if (IN_PH(pb + 6)) { const Frame P = phase_frame(F);
            pg8::Gemm g{P.H(), P.WFF1(), M, DFF, D}; pg8::StaticOrder S; S.init(M, DFF, P.G, P.bx);
            EpiRelu2 E{P.FFH(), DFF};

#ifndef OFF_GFF1
pg8::gemm_phase<EpiRelu2, pg8::StaticOrder, true, true>(P.lds, g, S, E);
#endif

            SEAM(pb + 6);
        }
        if (IN_PH(pb + 7)) { const Frame P = phase_frame(F);
            pg8::Gemm g{P.FFH(), P.WFF2(), M, D, DFF}; pg8::StaticOrder S; S.init(M, D, P.G, P.bx);
            EpiF E{P.Fb(), P.FSTAT()};

#ifndef OFF_GFF2
pg8::gemm_phase<EpiF, pg8::StaticOrder, true, true>(P.lds, g, S, E);
            SEAM(pb + 7);
#endif

        }
        if (IN_PH(pb + 8)) { const Frame P = phase_frame(F);

#ifndef OFF_ROW2
rowlocal_phase<2>(P, l);
#endif


#ifndef OFF_CONVN
if (l + 1 < DEPTH) { __syncthreads(); convert_layer(P, l + 1); }
#endif

            SEAM(pb + 8);
        }
    }
#undef IN_PH
#undef SEAM
}
}
extern "C" void kernel_launch(void* const* d_in, const int* in_sizes, int n_in, void* d_out, int out_size, void* d_ws, size_t ws_size, hipStream_t stream) {
    static int grid = 0;
    if (grid == 0) {
        if (n_in != 32 || out_size != 84410368 || ws_size < fk::WS_END) { fprintf(stderr, "kernel_launch: unexpected shapes: n_in %d out %d ws %zu (need %zu)\n", n_in, out_size, ws_size, (size_t)fk::WS_END); grid = -1; return; }
        int dev = 0, cus = 0;
        if (hipGetDevice(&dev) != hipSuccess || hipDeviceGetAttribute(&cus, hipDeviceAttributeMultiprocessorCount, dev) != hipSuccess) { grid = -1; return; }
        if (hipFuncSetAttribute((const void*)fk::mega, hipFuncAttributeMaxDynamicSharedMemorySize, fk::LDS_BYTES) != hipSuccess) { fprintf(stderr, "kernel_launch: hipFuncSetAttribute failed\n"); grid = -1; return; }
        int per_cu = 0;
        if (hipOccupancyMaxActiveBlocksPerMultiprocessor(&per_cu, (const void*)fk::mega, fk::NWAVES * 64, fk::LDS_BYTES) != hipSuccess || per_cu < 1) fprintf(stderr, "kernel_launch: occupancy query says %d blocks per CU\n", per_cu);
        (void)hipGetLastError();
        grid = cus < 256 ? cus : 256;
    }
    if (grid < 0) return;
    (void)hipMemsetAsync((char*)d_ws + fk::WS_CTL, 0, fk::CTL_ZERO_BYTES, stream);
    fk::Params p{};
    for (int i = 0; i < 32; ++i) p.in[i] = (const float*)d_in[i];
    p.out = (float*)d_out; p.ws = (unsigned char*)d_ws; p.ph_lo = 0; p.ph_hi = fk::NPHASE; p.li = 0; p.pad = 0;
    hipLaunchKernelGGL(fk::mega, dim3(grid), dim3(fk::NWAVES * 64), fk::LDS_BYTES, stream, p);
}
```

```cpp
#include <hip/hip_runtime.h>
#include <hip/hip_bf16.h>
#include <cstdio>
#include <cstdint>
namespace pg8 {
#define PG8_LAS __attribute__((address_space(3)))
typedef unsigned short bf16_t;
typedef short bf16x8 __attribute__((ext_vector_type(8)));
typedef float f32x4 __attribute__((ext_vector_type(4)));
typedef unsigned u32x4 __attribute__((ext_vector_type(4)));
constexpr int BM = 256, BK = 64, HALF = 128, HTB = HALF * BK * 2  , STAGE_BYTES = 8 * HTB, NXCD = 8, WGM = 8;

__host__ __device__ __forceinline__ int lds_byte(int r, int c) { const int st = (r >> 4) * 2 + (c >> 5), rr = r & 15, cc = c & 31, ob = rr * 64 + cc * 2; return st * 1024 + (ob ^ (((ob >> 9) & 1) << 5)); }
__host__ __device__ __forceinline__ void stage_rc(int b, int& R, int& C) { const int st = b / 1024, sb = b % 1024, swz = sb ^ (((sb >> 9) & 1) << 5); R = (st >> 1) * 16 + swz / 64; C = (st & 1) * 32 + (swz % 64) / 2; }
__host__ __device__ __forceinline__ int perm32(int rho) { const int n = rho >> 4, i = rho & 15; return 8 * (i >> 2) + 4 * n + (i & 3); }

struct Unit { int pm, pn; };
struct Gemm { const bf16_t* A; const bf16_t* Bt; int M, N, K; };

struct StaticOrder {
    int nM, nN, nwg, G, c;
    __host__ __device__ void init(int M, int N, int G_, int c_) { nM = M / BM; nN = N / BM; nwg = nM * nN; G = G_; c = c_; }
    __host__ __device__ bool next(int i, Unit& u) const {
        const long L = (long)i * G + c; if (L >= nwg) return false;
        int wgid = (int)L; { const int q = nwg / NXCD, r = nwg % NXCD, xcd = wgid % NXCD, off = wgid / NXCD; wgid = (xcd < r ? xcd * (q + 1) : r * (q + 1) + (xcd - r) * q) + off; }
        const int nig = WGM * nN, gid = wgid / nig, fm = gid * WGM, gsz = (nM - fm) < WGM ? (nM - fm) : WGM;
        u.pm = fm + ((wgid % nig) % gsz); u.pn = (wgid % nig) / gsz; return true;
    }
    __device__ __forceinline__ void a_ready(const Unit&) const {}
    __device__ __forceinline__ void done(const Unit&) const {}
};
__device__ __forceinline__ unsigned cvt_pk_bf16(float lo, float hi) { unsigned r; asm volatile("v_cvt_pk_bf16_f32 %0, %1, %2" : "=v"(r) : "v"(lo), "v"(hi)); return r; }
template <class Epi, class Sched, bool ALIGN_EPI = false, bool SP2 = false>
__device__ __forceinline__ void gemm_phase(PG8_LAS unsigned char* lds, const Gemm g, const Sched& S, const Epi& E) {
    int tid_ = threadIdx.x; asm volatile("" : "+v"(tid_));
    const int tid = tid_, wid = __builtin_amdgcn_readfirstlane(tid >> 6), lane = tid & 63, wr = wid >> 2, wc = wid & 3, fr = lane & 15, fq = lane >> 4;
    const int K = g.K, nt = K / BK;
    unsigned voffA[2], voffB[2];
#pragma unroll
    for (int i = 0; i < 2; ++i) { int R, C; stage_rc(tid * 16 + i * 8192, R, C); const int Rb = Epi::PERM ? ((R & ~31) + perm32(R & 31)) : R;
        voffA[i] = (unsigned)(R * K + C) * 2u; voffB[i] = (unsigned)(Rb * K + C) * 2u; }
    const size_t kstep = (size_t)(BK * 2);
    const size_t hstep = (size_t)HALF * K * 2;
    const size_t tstep = 2 * hstep;
    const unsigned ldsw = (unsigned)wid * 1024u;
    const int aoff = lds_byte(wr * 64 + fr, fq * 8), boff = lds_byte(wc * 32 + fr, fq * 8);
#define PG8_SA(b, h) (((b) * 2 + (h)) * HTB)
#define PG8_SB(b, h) ((4 + (b) * 2 + (h)) * HTB)
#define PG8_STAGE(bufoff, gbase, voff) do { _Pragma("unroll") for (int _i = 0; _i < 2; ++_i) \
        __builtin_amdgcn_global_load_lds((const unsigned*)((const char*)(gbase) + (voff)[_i]), (PG8_LAS unsigned*)(lds + (bufoff) + ldsw + _i * 8192), 16, 0, 0); } while (0)
#define PG8_LDA(dst, b, h) do { _Pragma("unroll") for (int m = 0; m < 4; ++m) _Pragma("unroll") for (int k = 0; k < 2; ++k) dst[m][k] = *(const PG8_LAS bf16x8*)(lds + PG8_SA(b, h) + aoff + m * 2048 + k * 1024); } while (0)
#define PG8_LDB(dst, b, h) do { _Pragma("unroll") for (int n = 0; n < 2; ++n) _Pragma("unroll") for (int k = 0; k < 2; ++k) dst[n][k] = *(const PG8_LAS bf16x8*)(lds + PG8_SB(b, h) + boff + n * 2048 + k * 1024); } while (0)
#define PG8_MMA(ai, bj, At, Bt) do { __builtin_amdgcn_s_setprio(1); _Pragma("unroll") for (int m = 0; m < 4; ++m) _Pragma("unroll") for (int n = 0; n < 2; ++n) _Pragma("unroll") for (int k = 0; k < 2; ++k) \
        acc[ai][bj][m][n] = __builtin_amdgcn_mfma_f32_16x16x32_bf16(Bt[n][k], At[m][k], acc[ai][bj][m][n], 0, 0, 0); __builtin_amdgcn_s_setprio(0); } while (0)
#define PG8_WAIT_V(n) asm volatile("s_waitcnt vmcnt(" #n ")" ::: "memory")
#define PG8_WAIT_L(n) asm volatile("s_waitcnt lgkmcnt(" #n ")" ::: "memory")
#define PG8_BAR __builtin_amdgcn_s_barrier()
#define PG8_SCHED __builtin_amdgcn_sched_barrier(0)
    Unit cur, nxt; int ui = 0;
    if (!S.next(0, cur)) return;
    f32x4 acc[2][2][4][2];
#pragma unroll
    for (int a = 0; a < 2; ++a)
#pragma unroll
        for (int b = 0; b < 2; ++b)
#pragma unroll
            for (int m = 0; m < 4; ++m)
#pragma unroll
                for (int n = 0; n < 2; ++n) acc[a][b][m][n] = (f32x4){0.f, 0.f, 0.f, 0.f};
    bf16x8 At[4][2], B0[2][2], B1[2][2];
    const char* cA = (const char*)g.A + (size_t)cur.pm * tstep; const char* cB = (const char*)g.Bt + (size_t)cur.pn * tstep;
    S.a_ready(cur);
    if constexpr (SP2) {
        PG8_STAGE(PG8_SB(0, 0), cB, voffB); PG8_STAGE(PG8_SB(0, 1), cB + hstep, voffB); PG8_STAGE(PG8_SA(0, 0), cA, voffA); PG8_STAGE(PG8_SA(0, 1), cA + hstep, voffA);
        if (wr == 1) PG8_BAR;
        PG8_WAIT_V(2); PG8_BAR;
        PG8_STAGE(PG8_SB(1, 0), cB + kstep, voffB); PG8_STAGE(PG8_SA(1, 0), cA + kstep, voffA); PG8_STAGE(PG8_SB(1, 1), cB + hstep + kstep, voffB);
        PG8_WAIT_V(6); PG8_BAR;
    } else {
        PG8_STAGE(PG8_SB(0, 0), cB, voffB); PG8_STAGE(PG8_SA(0, 0), cA, voffA); PG8_STAGE(PG8_SB(0, 1), cB + hstep, voffB); PG8_STAGE(PG8_SA(0, 1), cA + hstep, voffA);
        if (wr == 1) PG8_BAR;
        PG8_WAIT_V(4); PG8_BAR;
        PG8_STAGE(PG8_SB(1, 0), cB + kstep, voffB); PG8_STAGE(PG8_SA(1, 0), cA + kstep, voffA); PG8_STAGE(PG8_SB(1, 1), cB + hstep + kstep, voffB);
        PG8_WAIT_V(6); PG8_BAR;
    }
    for (;;) {
        const bool has_next = S.next(ui + 1, nxt);
        const char* nA = has_next ? (const char*)g.A + (size_t)nxt.pm * tstep : cA; const char* nB = has_next ? (const char*)g.Bt + (size_t)nxt.pn * tstep : cB;
        for (int t = 0; t < nt; t += 2) {
            const bool last = (t == nt - 2);
            const char* a1 = cA + (size_t)(t + 1) * kstep;
            const char* a2 = last ? nA : cA + (size_t)(t + 2) * kstep; const char* b2 = last ? nB : cB + (size_t)(t + 2) * kstep;
            const char* a3 = a2 + kstep; const char* b3 = b2 + kstep;
            if (last && has_next) S.a_ready(nxt);
            if constexpr (SP2) {
            PG8_LDB(B0, 0, 0); PG8_LDB(B1, 0, 1); PG8_SCHED; PG8_LDA(At, 0, 0); PG8_STAGE(PG8_SA(1, 1), a1 + hstep, voffA);
            PG8_WAIT_V(8); PG8_WAIT_L(0); PG8_BAR; PG8_MMA(0, 0, At, B0); PG8_MMA(0, 1, At, B1); PG8_BAR; PG8_SCHED;
            PG8_LDA(At, 0, 1); PG8_STAGE(PG8_SB(0, 0), b2, voffB); PG8_STAGE(PG8_SB(0, 1), b2 + hstep, voffB); PG8_STAGE(PG8_SA(0, 0), a2, voffA);
            PG8_WAIT_V(8); PG8_WAIT_L(0); PG8_BAR; PG8_MMA(1, 0, At, B0); PG8_MMA(1, 1, At, B1); PG8_BAR; PG8_SCHED;
            PG8_LDB(B0, 1, 0); PG8_LDB(B1, 1, 1); PG8_SCHED; PG8_LDA(At, 1, 0); PG8_STAGE(PG8_SA(0, 1), a2 + hstep, voffA);
            PG8_WAIT_V(8); PG8_WAIT_L(0); PG8_BAR; PG8_MMA(0, 0, At, B0); PG8_MMA(0, 1, At, B1); PG8_BAR; PG8_SCHED;
            PG8_LDA(At, 1, 1); PG8_STAGE(PG8_SB(1, 0), b3, voffB); PG8_STAGE(PG8_SB(1, 1), b3 + hstep, voffB); PG8_STAGE(PG8_SA(1, 0), a3, voffA);
            PG8_WAIT_V(8); PG8_WAIT_L(0); PG8_BAR; PG8_MMA(1, 0, At, B0); PG8_MMA(1, 1, At, B1); PG8_BAR; PG8_SCHED;
            } else {
            PG8_LDB(B0, 0, 0); PG8_SCHED; PG8_LDA(At, 0, 0); PG8_STAGE(PG8_SA(1, 1), a1 + hstep, voffA);
            PG8_WAIT_L(8); PG8_BAR; PG8_WAIT_L(0); PG8_MMA(0, 0, At, B0); PG8_BAR; PG8_SCHED;
            PG8_LDB(B1, 0, 1); PG8_STAGE(PG8_SB(0, 0), b2, voffB);
            PG8_BAR; PG8_WAIT_L(0); PG8_MMA(0, 1, At, B1); PG8_BAR;
            PG8_LDA(At, 0, 1); PG8_STAGE(PG8_SA(0, 0), a2, voffA);
            PG8_BAR; PG8_WAIT_L(0); PG8_MMA(1, 0, At, B0); PG8_BAR; PG8_SCHED;
            PG8_STAGE(PG8_SB(0, 1), b2 + hstep, voffB);
            PG8_WAIT_V(6); PG8_BAR; PG8_MMA(1, 1, At, B1); PG8_BAR;
            PG8_LDB(B0, 1, 0); PG8_SCHED; PG8_LDA(At, 1, 0); PG8_STAGE(PG8_SA(0, 1), a2 + hstep, voffA);
            PG8_WAIT_L(8); PG8_BAR; PG8_WAIT_L(0); PG8_MMA(0, 0, At, B0); PG8_BAR; PG8_SCHED;
            PG8_LDB(B1, 1, 1); PG8_STAGE(PG8_SB(1, 0), b3, voffB);
            PG8_BAR; PG8_WAIT_L(0); PG8_MMA(0, 1, At, B1); PG8_BAR;
            PG8_LDA(At, 1, 1); PG8_STAGE(PG8_SA(1, 0), a3, voffA);
            PG8_BAR; PG8_WAIT_L(0); PG8_MMA(1, 0, At, B0); PG8_BAR; PG8_SCHED;
            PG8_STAGE(PG8_SB(1, 1), b3 + hstep, voffB);
            PG8_WAIT_V(6); PG8_BAR; PG8_MMA(1, 1, At, B1); PG8_BAR;
            }
        }
        if constexpr (ALIGN_EPI) { if (wr == 0) PG8_BAR; }
        if constexpr (!Epi::AFTER_DRAIN) { E(acc, cur, wr, wc, fr, fq); S.done(cur); }
        if (!has_next) break;
#pragma unroll
        for (int a = 0; a < 2; ++a)
#pragma unroll
            for (int b = 0; b < 2; ++b)
#pragma unroll
                for (int m = 0; m < 4; ++m)
#pragma unroll
                    for (int n = 0; n < 2; ++n) acc[a][b][m][n] = (f32x4){0.f, 0.f, 0.f, 0.f};
        cur = nxt; cA = nA; cB = nB; ++ui;
        if constexpr (ALIGN_EPI) { if (wr == 1) PG8_BAR; }
    }
    PG8_WAIT_V(0);
    if constexpr (!ALIGN_EPI) { if (wr == 0) PG8_BAR; }
    PG8_BAR;
    if constexpr (Epi::AFTER_DRAIN) { E.fused(acc, cur, wr, wc, fr, fq, lds, wid, lane); S.done(cur); }
#undef PG8_SA
#undef PG8_SB
#undef PG8_STAGE
#undef PG8_LDA
#undef PG8_LDB
#undef PG8_MMA
#undef PG8_WAIT_V
#undef PG8_WAIT_L
#undef PG8_BAR
#undef PG8_SCHED
}
}
#define GAS __attribute__((address_space(1)))
#define LAS __attribute__((address_space(3)))
typedef unsigned short bf16;
typedef unsigned v4u __attribute__((ext_vector_type(4)));
typedef float f32x4 __attribute__((ext_vector_type(4)));
typedef short bf16x8 __attribute__((ext_vector_type(8)));
typedef GAS unsigned gu32;
typedef GAS unsigned long long gu64;
#define RLX_AGENT __ATOMIC_RELAXED, __HIP_MEMORY_SCOPE_AGENT
#define LDS_WAIT() asm volatile("s_waitcnt lgkmcnt(0)" ::: "memory")
#define VM_WAIT() asm volatile("s_waitcnt vmcnt(0)" ::: "memory")
__device__ __forceinline__ unsigned long long rt() { return __builtin_amdgcn_s_memrealtime(); }
__device__ __forceinline__ unsigned f2bf(float f) { unsigned u = __builtin_bit_cast(unsigned, f); return (u + 0x7fffu + ((u >> 16) & 1u)) >> 16; }
__device__ __forceinline__ unsigned pk2(float lo, float hi) { return f2bf(lo) | (f2bf(hi) << 16); }

#define XB_TMO      128
#define XB_XCNT(j)  (256  + 64 * (j))
#define XB_XSUB(j)  (1280 + 64 * (j))
#define XB_XGEN(j)  (2304 + 64 * (j))
#define XB_TOP      3328
#define XB_TOPGEN   3392
#define XCD_BAR_WORDS 3456
#define XB_SPIN_CAP (1u << 18)

__device__ __forceinline__ unsigned xb_ld(unsigned* p)              { return __hip_atomic_load(p, __ATOMIC_RELAXED, __HIP_MEMORY_SCOPE_AGENT); }
__device__ __forceinline__ unsigned xb_add(unsigned* p, unsigned v) { return __hip_atomic_fetch_add(p, v, __ATOMIC_RELAXED, __HIP_MEMORY_SCOPE_AGENT); }
__device__ __forceinline__ unsigned xb_xcc_id() { return (unsigned)__builtin_amdgcn_s_getreg((3 << 11) | 20) & 0xFu; }
#define XB_SPIN(cond, bar) do { unsigned _sp = 0; while (cond) { __builtin_amdgcn_s_sleep(1); \
    if ((++_sp & 255u) == 0u) { if (xb_ld(&(bar)[XB_TMO])) break; if (_sp > XB_SPIN_CAP) { atomicAdd(&(bar)[XB_TMO], 1u); break; } } } } while (0)

struct XcdBarrier {
    unsigned* bar; unsigned x;
    volatile LAS unsigned* st;
};

__device__ __forceinline__ XcdBarrier xcd_barrier_post(unsigned* bar, volatile LAS unsigned* st) {
    XcdBarrier b; b.bar = bar; b.x = xb_xcc_id(); b.st = st;
    if (threadIdx.x == 0) (void)xb_add(&bar[XB_XCNT(b.x)], 1u);
    return b;
}
__device__ __forceinline__ void xcd_barrier_complete(unsigned* bar, unsigned x, unsigned& nloc, unsigned& nx) {
    const unsigned G = gridDim.x * gridDim.y * gridDim.z;
    unsigned sum, cnt, mine, sp = 0u;
    for (;;) {
        sum = 0u; cnt = 0u; mine = 0u;
#pragma unroll
        for (unsigned j = 0; j < 16; ++j) { const unsigned c = xb_ld(&bar[XB_XCNT(j)]); sum += c; cnt += (c > 0u) ? 1u : 0u; mine = (j == x) ? c : mine; }
        if (sum == G) break;
        __builtin_amdgcn_s_sleep(1);
        if ((++sp & 255u) == 0u) { if (xb_ld(&bar[XB_TMO])) break; if (sp > XB_SPIN_CAP) { atomicAdd(&bar[XB_TMO], 1u); break; } }
    }
    nloc = mine > 0u ? mine : 1u; nx = cnt > 0u ? cnt : 1u;
}

__device__ __forceinline__ void xcd_barrier(const XcdBarrier& b) {
    asm volatile("s_waitcnt vmcnt(0)" ::: "memory");
    __syncthreads();
    if (threadIdx.x == 0) {
        unsigned* bar = b.bar;
        __builtin_amdgcn_s_waitcnt(0);
        unsigned nloc = b.st[0], nx = b.st[1];
        if (nloc == 0u) { xcd_barrier_complete(bar, b.x, nloc, nx); b.st[0] = nloc; b.st[1] = nx; }
        const unsigned old = xb_add(&bar[XB_XSUB(b.x)], 1u);
        const unsigned gen = old / nloc;
        if (old + 1u == (gen + 1u) * nloc) {
            __builtin_amdgcn_fence(__ATOMIC_RELEASE, "agent");
            asm volatile("s_waitcnt vmcnt(0)" ::: "memory");
            const unsigned og = xb_add(&bar[XB_TOP], 1u);
            const unsigned tg = og / nx;
            if (og + 1u == (tg + 1u) * nx) xb_add(&bar[XB_TOPGEN], 1u);
            else XB_SPIN(xb_ld(&bar[XB_TOPGEN]) == tg, bar);
            __builtin_amdgcn_fence(__ATOMIC_ACQUIRE, "agent");
            xb_add(&bar[XB_XGEN(b.x)], 1u);
            asm volatile("s_waitcnt vmcnt(0)" ::: "memory");
        } else {
            XB_SPIN(xb_ld(&bar[XB_XGEN(b.x)]) == gen, bar);
            __builtin_amdgcn_fence(__ATOMIC_ACQUIRE, "agent");
            asm volatile("s_waitcnt vmcnt(0)" ::: "memory");
        }
    }
    __syncthreads();
}
namespace att {
constexpr int   D = 128, NW = 8, QBLK = 32, KVBLK = 64;
constexpr float SCALE = 0.088388347648318440f;
constexpr float THR = 8.f;
constexpr int SDEPTH = 2;
constexpr int LDQ = 17408, LDK = 512, LDO = 2048;
constexpr size_t SHM_V = KVBLK * D * 2, SHM_K = KVBLK * D * 2, SHM_ATTN = 2 * SHM_V + 2 * SHM_K + NW * 64 * 4;
using bf16 = __hip_bfloat16;
using bf16x8 = __attribute__((ext_vector_type(8))) short;
using s16x4  = __attribute__((ext_vector_type(4))) short;
using f32x16 = __attribute__((ext_vector_type(16))) float;
using f32x8  = __attribute__((ext_vector_type(8))) float;
using u32x4  = __attribute__((ext_vector_type(4))) unsigned;
#define KSWZ(row, colB) ((row) * 256 + ((colB) ^ (((row) & 7) << 4)))
#define SBAR() __builtin_amdgcn_sched_barrier(0)
__device__ __forceinline__ int crow(int r, int hi) { return (r & 3) + 8 * (r >> 2) + 4 * hi; }
__device__ __forceinline__ unsigned cvtpk(float lo, float hi) {
  unsigned r; asm volatile("v_cvt_pk_bf16_f32 %0, %1, %2" : "=v"(r) : "v"(lo), "v"(hi)); return r;
}
template <typename TIn> struct Stage;
template <> struct Stage<bf16>  { using T = bf16x8;
  __device__ static __forceinline__ T ld8(const bf16* p) { return *reinterpret_cast<const bf16x8*>(p); }
  __device__ static __forceinline__ bf16x8 tobf(T x) { return x; } };
template <> struct Stage<float> { using T = f32x8;
  __device__ static __forceinline__ T ld8(const float* p) { return *reinterpret_cast<const f32x8*>(p); }
  __device__ static __forceinline__ bf16x8 tobf(T x) {
    u32x4 w = {cvtpk(x[0], x[1]), cvtpk(x[2], x[3]), cvtpk(x[4], x[5]), cvtpk(x[6], x[7])}; return *reinterpret_cast<bf16x8*>(&w); } };

__device__ __forceinline__ void partialSM(f32x16& p0, f32x16& p1, float& m_reg, float& mn, float& alpha) {
  constexpr float C = SCALE * 1.4426950408889634f;
  float pmax = p0[0]; for (int r = 1; r < 16; ++r) pmax = fmaxf(pmax, p0[r]); for (int r = 0; r < 16; ++r) pmax = fmaxf(pmax, p1[r]);
  { auto rr = __builtin_amdgcn_permlane32_swap(__float_as_uint(pmax), __float_as_uint(pmax), false, false);
    pmax = fmaxf(__uint_as_float(rr[0]), __uint_as_float(rr[1])); }
  if (__builtin_expect(__all(pmax - m_reg <= THR / SCALE), 1)) { mn = m_reg; alpha = 1.f; }
  else { mn = fmaxf(m_reg, pmax); alpha = __builtin_amdgcn_exp2f((m_reg - mn) * C); m_reg = mn; }
  float mnC = -mn * C;
  for (int r = 0; r < 16; ++r) p0[r] = fmaf(p0[r], C, mnC); for (int r = 0; r < 16; ++r) p1[r] = fmaf(p1[r], C, mnC);
  for (int r = 0; r < 16; ++r) p0[r] = __builtin_amdgcn_exp2f(p0[r]);
}
__device__ __forceinline__ void finishSM(f32x16& p0, f32x16& p1, float alpha, float& l_reg, bf16x8& pa0, bf16x8& pa1, bf16x8& pa2, bf16x8& pa3) {
  for (int r = 0; r < 16; ++r) p1[r] = __builtin_amdgcn_exp2f(p1[r]);
  float ps = 0; for (int r = 0; r < 16; ++r) ps += p0[r]; for (int r = 0; r < 16; ++r) ps += p1[r];
  { auto rr = __builtin_amdgcn_permlane32_swap(__float_as_uint(ps), __float_as_uint(ps), false, false);
    ps = __uint_as_float(rr[0]) + __uint_as_float(rr[1]); }
  l_reg = l_reg * alpha + ps;
#define PK4(P, BASE, OUT) do { unsigned a0 = cvtpk(P[BASE + 0], P[BASE + 1]), a1 = cvtpk(P[BASE + 2], P[BASE + 3]);   \
    unsigned b0 = cvtpk(P[BASE + 4], P[BASE + 5]), b1 = cvtpk(P[BASE + 6], P[BASE + 7]);                              \
    auto r0 = __builtin_amdgcn_permlane32_swap(a0, b0, false, false); auto r1 = __builtin_amdgcn_permlane32_swap(a1, b1, false, false); \
    u32x4 w = {r0[0], r1[0], r0[1], r1[1]}; OUT = *reinterpret_cast<bf16x8*>(&w); } while (0)
  PK4(p0, 0, pa0); PK4(p0, 8, pa1); PK4(p1, 0, pa2); PK4(p1, 8, pa3);
#undef PK4
}
__device__ __forceinline__ void qkt(f32x16& p0, f32x16& p1, const bf16* Ks, const bf16x8* qr, int r32, int hi) {
  p0 = f32x16{}; p1 = f32x16{};
  for (int d0 = 0; d0 < 8; ++d0) { int cb = (d0 * 16 + hi * 8) * 2;
    bf16x8 b0 = *reinterpret_cast<const bf16x8*>((const char*)Ks + KSWZ(r32, cb));
    bf16x8 b1 = *reinterpret_cast<const bf16x8*>((const char*)Ks + KSWZ(32 + r32, cb));
    p0 = __builtin_amdgcn_mfma_f32_32x32x16_bf16(b0, qr[d0], p0, 0, 0, 0);
    p1 = __builtin_amdgcn_mfma_f32_32x32x16_bf16(b1, qr[d0], p1, 0, 0, 0); }
}
__device__ __forceinline__ int v_st(int k, int c) { const int kk = (k & ~0xC) | ((k & 4) << 1) | ((k & 8) >> 1); return ((kk >> 3) * 4 + (c >> 5)) * 512 + ((kk & 7) * 32 + (c & 31)) * 2; }
__device__ __forceinline__ int v_rd_base(int lane) { return ((lane & 3) << 3) | (((lane >> 2) & 3) << 6) | (((lane >> 4) & 1) << 5) | (((lane >> 5) & 1) << 8); }
constexpr int v_rd_off(int d0, int ks, int half) { return d0 * 512 + ks * 4096 + half * 2048; }
template <int OFF> __device__ __forceinline__ s16x4 tr_read(int vb) {
  s16x4 r; asm volatile("ds_read_b64_tr_b16 %0, %1 offset:%2" : "=&v"(r) : "v"(vb), "i"(OFF) : "memory"); return r;
}
template <int D0> __device__ __forceinline__ void pv_one(f32x16& od, int vb, bf16x8 pa0, bf16x8 pa1, bf16x8 pa2, bf16x8 pa3) {
  const s16x4 l0 = tr_read<v_rd_off(D0, 0, 0)>(vb), h0 = tr_read<v_rd_off(D0, 0, 1)>(vb), l1 = tr_read<v_rd_off(D0, 1, 0)>(vb), h1 = tr_read<v_rd_off(D0, 1, 1)>(vb);
  const s16x4 l2 = tr_read<v_rd_off(D0, 2, 0)>(vb), h2 = tr_read<v_rd_off(D0, 2, 1)>(vb), l3 = tr_read<v_rd_off(D0, 3, 0)>(vb), h3 = tr_read<v_rd_off(D0, 3, 1)>(vb);
  asm volatile("s_waitcnt lgkmcnt(0)" ::: "memory"); SBAR();
#define PK(L, H) (bf16x8){L[0], L[1], L[2], L[3], H[0], H[1], H[2], H[3]}
  od = __builtin_amdgcn_mfma_f32_32x32x16_bf16(pa0, PK(l0, h0), od, 0, 0, 0);
  od = __builtin_amdgcn_mfma_f32_32x32x16_bf16(pa1, PK(l1, h1), od, 0, 0, 0);
  od = __builtin_amdgcn_mfma_f32_32x32x16_bf16(pa2, PK(l2, h2), od, 0, 0, 0);
  od = __builtin_amdgcn_mfma_f32_32x32x16_bf16(pa3, PK(l3, h3), od, 0, 0, 0);
#undef PK
}
__device__ __forceinline__ void pv_d0(f32x16* o, int vb, bf16x8 pa0, bf16x8 pa1, bf16x8 pa2, bf16x8 pa3) {
  pv_one<0>(o[0], vb, pa0, pa1, pa2, pa3); pv_one<1>(o[1], vb, pa0, pa1, pa2, pa3); pv_one<2>(o[2], vb, pa0, pa1, pa2, pa3); pv_one<3>(o[3], vb, pa0, pa1, pa2, pa3);
}

template <typename TQ>
__device__ __forceinline__ void attn_dense_body(const TQ* __restrict__ Qb, const bf16* __restrict__ Kh, const bf16* __restrict__ Vh,
                                                bf16* __restrict__ Ob, int seq, char* lds) {
  using St = Stage<bf16>; using SQ = Stage<TQ>;
  int tid_ = threadIdx.x; asm volatile("" : "+v"(tid_));
  const int tid = tid_, wid = tid >> 6, lane = tid & 63, r32 = lane & 31, hi = lane >> 5;
  bf16* V_lds = (bf16*)lds; bf16* K_lds = (bf16*)(lds + 2 * SHM_V);
  float* ws = (float*)(lds + 2 * SHM_V + 2 * SHM_K) + wid * 64; float* li_l = ws; float* al_l = ws + 32;
  float m_reg = -1e30f, l_reg = 0; f32x16 o[4] = {}; bf16x8 qr[8];
  const TQ* Qw = Qb + (long)(wid * QBLK + r32) * LDQ + hi * 8;
#pragma unroll
  for (int d0 = 0; d0 < 8; ++d0) qr[d0] = SQ::tobf(SQ::ld8(Qw + d0 * 16));
  const int sr = tid >> 4, sc = (tid & 15) * 8, vst0 = v_st(sr, sc), vst1 = v_st(32 + sr, sc);
  const int vb0 = (int)(uintptr_t)V_lds + v_rd_base(lane);
  struct { typename St::T vs0, vs1, ks0, ks1; } sr_[SDEPTH];
#define SLOAD(i, k0) do { sr_[i].vs0 = St::ld8(&Vh[(long)((k0) + sr) * LDK + sc]); sr_[i].vs1 = St::ld8(&Vh[(long)((k0) + 32 + sr) * LDK + sc]); \
    sr_[i].ks0 = St::ld8(&Kh[(long)((k0) + sr) * LDK + sc]); sr_[i].ks1 = St::ld8(&Kh[(long)((k0) + 32 + sr) * LDK + sc]); } while (0)
#define SWRITE(b, i) do { *(bf16x8*)((char*)V_lds + (b) * SHM_V + vst0) = St::tobf(sr_[i].vs0);          \
    *(bf16x8*)((char*)V_lds + (b) * SHM_V + vst1) = St::tobf(sr_[i].vs1); int kc = sc * 2;               \
    *(bf16x8*)((char*)K_lds + (b) * SHM_K + KSWZ(sr, kc)) = St::tobf(sr_[i].ks0);                       \
    *(bf16x8*)((char*)K_lds + (b) * SHM_K + KSWZ(32 + sr, kc)) = St::tobf(sr_[i].ks1); } while (0)
#define SWAIT() do { if constexpr (SDEPTH == 2) asm volatile("s_waitcnt vmcnt(4)" ::: "memory"); else asm volatile("s_waitcnt vmcnt(0)" ::: "memory"); } while (0)
#define RESC(a) do { if (__any((a) < 1.f)) { if (hi == 0) al_l[r32] = (a); asm volatile("s_waitcnt lgkmcnt(0)" ::: "memory"); \
    for (int d = 0; d < 4; ++d) for (int r = 0; r < 16; ++r) o[d][r] *= al_l[crow(r, hi)]; } } while (0)
  f32x16 pA0, pA1, pB0, pB1; float mnA, mnB, alA, alB; bf16x8 pa0, pa1, pa2, pa3; const int NT = seq / KVBLK;
  constexpr int SE = 0, SO = SDEPTH - 1;
  SLOAD(SE, 0); asm volatile("s_waitcnt vmcnt(0)" ::: "memory"); SWRITE(0, SE); __syncthreads();
  qkt(pA0, pA1, K_lds, qr, r32, hi); partialSM(pA0, pA1, m_reg, mnA, alA);
  SLOAD(SO, KVBLK); if constexpr (SDEPTH == 2) { if (2 < NT) SLOAD(SE, 2 * KVBLK); }
  SWAIT(); SWRITE(1, SO); __syncthreads();
  for (int j = 1; j + 1 < NT; j += 2) {
    SBAR(); qkt(pB0, pB1, (bf16*)((char*)K_lds + SHM_K), qr, r32, hi);
    finishSM(pA0, pA1, alA, l_reg, pa0, pa1, pa2, pa3); SBAR();
    SLOAD(SO, (j + SDEPTH) * KVBLK); SBAR();
    pv_d0(o, vb0, pa0, pa1, pa2, pa3); partialSM(pB0, pB1, m_reg, mnB, alB);
    __syncthreads(); SWAIT(); SWRITE(0, SE);
    RESC(alB); __syncthreads();
    SBAR(); qkt(pA0, pA1, K_lds, qr, r32, hi);
    finishSM(pB0, pB1, alB, l_reg, pa0, pa1, pa2, pa3); SBAR();
    if (SDEPTH == 1 || j + 3 < NT) SLOAD(SE, (j + 1 + SDEPTH) * KVBLK); SBAR();
    pv_d0(o, vb0 + (int)SHM_V, pa0, pa1, pa2, pa3); partialSM(pA0, pA1, m_reg, mnA, alA);
    __syncthreads(); SWAIT(); SWRITE(1, SO);
    RESC(alA); __syncthreads();
  }
  SBAR(); qkt(pB0, pB1, (bf16*)((char*)K_lds + SHM_K), qr, r32, hi);
  finishSM(pA0, pA1, alA, l_reg, pa0, pa1, pa2, pa3); SBAR();
  pv_d0(o, vb0, pa0, pa1, pa2, pa3); partialSM(pB0, pB1, m_reg, mnB, alB);
  __syncthreads(); RESC(alB);
  finishSM(pB0, pB1, alB, l_reg, pa0, pa1, pa2, pa3); SBAR();
  pv_d0(o, vb0 + (int)SHM_V, pa0, pa1, pa2, pa3);
  if (hi == 0) li_l[r32] = l_reg; asm volatile("s_waitcnt lgkmcnt(0)" ::: "memory");
  float rli[16];
#pragma unroll
  for (int r = 0; r < 16; ++r) rli[r] = __builtin_amdgcn_rcpf(li_l[crow(r, hi)]);
  bf16* Ow = Ob + (long)(wid * QBLK) * LDO;
#pragma unroll
  for (int r = 0; r < 16; ++r) { int orow = crow(r, hi);
    for (int d0 = 0; d0 < 4; ++d0) Ow[(long)orow * LDO + d0 * 32 + r32] = __float2bfloat16(o[d0][r] * rli[r]); }
#undef SLOAD
#undef SWRITE
#undef SWAIT
#undef RESC
}
#undef KSWZ
#undef SBAR
}
namespace fk {
using pg8::bf16_t; using pg8::f32x4; using pg8::u32x4; using pg8::Unit; using pg8::cvt_pk_bf16;
typedef unsigned u32x2 __attribute__((ext_vector_type(2)));
typedef float f32x16 __attribute__((ext_vector_type(16)));
constexpr int M = 24576, MP = 8192, D = 2048, INW = 17408, DFF = 8192, DEPTH = 4, NWAVES = 8, NCOND = 9;
constexpr int OFF_Q = 0, OFF_K = 2048, OFF_V = 2560, OFF_LX = 3072, OFF_LG = 5120, OFF_CU = 7168, OFF_CV = 9216, OFF_G = 11264;
constexpr int NKVROWS = 26624;
constexpr float EPS = 1e-6f;
constexpr int NPHASE = 3 + 9 * DEPTH;
constexpr size_t MiB = 1u << 20;
constexpr size_t WS_CTL = 0, CTL_ZERO_BYTES = 1 * MiB;
constexpr size_t WS_MODP = 1 * MiB, WS_MOD = 28 * MiB, WS_ROPE = 30 * MiB, WS_CVSTAT = 31 * MiB, WS_FSTAT = 34 * MiB, WS_AGG = 37 * MiB, WS_WLRU = 49 * MiB, WS_CMW = 51 * MiB;
constexpr size_t WS_WIN = 52 * MiB, WS_WBR = 120 * MiB, WS_WOUT = 144 * MiB, WS_WFF1 = 152 * MiB, WS_WFF2 = 184 * MiB;
constexpr size_t WS_H = 216 * MiB, WS_KALL = 312 * MiB, WS_VALL = 338 * MiB, WS_BR = 364 * MiB, WS_MSCR = 652 * MiB, WS_Z = 716 * MiB, WS_END = 1532 * MiB;
constexpr size_t WS_FFH = WS_Z, WS_F = WS_Z + 384 * MiB;
constexpr int CW_BAR = 4096;
constexpr int RING_BYTES = 131072;
constexpr int LRU_XC = 0, LRU_XC_PITCH = 272, LRU_A0 = 17408, LRU_B0 = LRU_A0 + 32768, LRU_A1 = LRU_B0 + 32768, LRU_B1 = LRU_A1 + 32768;
constexpr int CM_VT = 0, CM_VT_PITCH = 272, CM_RS = 128 * 272;
constexpr int MISC_OFF = 149504, LDS_BYTES = 150528;
static_assert(LRU_B1 + 32768 <= MISC_OFF, "lds map");

struct Params { const float* in[32]; float* out; unsigned char* ws; int ph_lo, ph_hi, li, pad; };

typedef const __attribute__((address_space(4))) void* kaptr_t;
struct Frame {
    LAS unsigned char* lds;
    int tid, lane, wave, vcu, G, gw, NGW, bx;
    float* out; unsigned char* ws; kaptr_t ka;
    __device__ __forceinline__ float* x() const { return out; }
    __device__ __forceinline__ float* new_k() const { return out + 50331648L; }
    __device__ __forceinline__ float* new_v() const { return out + 50331648L + 16777216L; }
    __device__ __forceinline__ float* new_s() const { return out + 50331648L + 2 * 16777216L; }
#define FK_WSP(name, type, off) __device__ __forceinline__ type* name() const { return (type*)(ws + (off)); }
    FK_WSP(MODP, float, WS_MODP) FK_WSP(MOD, float, WS_MOD) FK_WSP(ROPE, float, WS_ROPE) FK_WSP(CVSTAT, float, WS_CVSTAT) FK_WSP(FSTAT, float, WS_FSTAT) FK_WSP(AGG, float, WS_AGG) FK_WSP(MSCR, float, WS_MSCR)
    FK_WSP(WLRU, bf16_t, WS_WLRU) FK_WSP(CMW, bf16_t, WS_CMW) FK_WSP(WIN, bf16_t, WS_WIN) FK_WSP(WBR, bf16_t, WS_WBR) FK_WSP(WOUT, bf16_t, WS_WOUT) FK_WSP(WFF1, bf16_t, WS_WFF1) FK_WSP(WFF2, bf16_t, WS_WFF2)
    FK_WSP(H, bf16_t, WS_H) FK_WSP(KALL, bf16_t, WS_KALL) FK_WSP(VALL, bf16_t, WS_VALL) FK_WSP(BR, bf16_t, WS_BR) FK_WSP(Z, bf16_t, WS_Z) FK_WSP(FFH, bf16_t, WS_FFH) FK_WSP(Fb, bf16_t, WS_F)
#undef FK_WSP
};
enum { I_XP = 0, I_XS, I_CK, I_CV, I_SL, I_C, I_CCTX, I_WMOD, I_BMOD, I_GPM, I_GPOM, I_GPF, I_GPOF, I_WIN, I_GQ, I_GK, I_WAO, I_CW, I_CB, I_LWA, I_LBA, I_LWX, I_LBX, I_LAM, I_WLO, I_CMG, I_CMWS, I_CMBS, I_WCO, I_WOUT, I_WFF1, I_WFF2 };
template <int I> __device__ __forceinline__ const float* inp(const Frame& F) { const float* r; asm volatile("s_load_dwordx2 %0, %1, %2\n\ts_waitcnt lgkmcnt(0)" : "=s"(r) : "s"(F.ka), "i"(I * 8) : "memory"); return r; }


__device__ __forceinline__ Frame phase_frame(const Frame& F) {
    Frame P = F; int t = F.tid; int bx = blockIdx.x; int g = F.G; unsigned char* w = F.ws; float* o = F.out;
    asm volatile("" : "+v"(t)); asm volatile("" : "+s"(bx), "+s"(g), "+s"(w), "+s"(o));
    P.tid = t; P.lane = t & 63; P.wave = __builtin_amdgcn_readfirstlane(t >> 6); P.ws = w; P.out = o; P.bx = bx; P.G = g; P.NGW = g * NWAVES;
    P.vcu = (g % 8 == 0) ? (bx % 8) * (g / 8) + bx / 8 : bx; P.gw = P.vcu * NWAVES + P.wave;
    return P;
}
__device__ __forceinline__ float wave_sum(float v) {
#pragma unroll
    for (int o = 1; o < 64; o <<= 1) v += __shfl_xor(v, o);
    return v;
}
__device__ __forceinline__ float bf2f(unsigned short h) { return __uint_as_float((unsigned)h << 16); }
__device__ __forceinline__ float bflo(unsigned w) { return __uint_as_float(w << 16); }
__device__ __forceinline__ float bfhi(unsigned w) { return __uint_as_float(w & 0xffff0000u); }
__device__ __forceinline__ float fsigm(float x) { return __builtin_amdgcn_rcpf(1.f + __builtin_amdgcn_exp2f(-1.4426950408889634f * x)); }
__device__ __forceinline__ float fgelu(float x) { const float u = x * (1.5957691216057308f + 0.0713548162726009f * x * x); return x * fsigm(u); }

__device__ __forceinline__ void transpose_item(const float* W, int K, int N, bf16_t* WT, int row_off, LAS float* scr, int item, int lane) {
    const int nblk = N / 32, kb = item / nblk, nb = item % nblk, k0 = 64 * kb, n0 = 32 * nb;
#pragma unroll 8
    for (int i = 0; i < 32; ++i) { const int kk = 2 * i + (lane >> 5); scr[kk * 33 + (lane & 31)] = W[(size_t)(k0 + kk) * N + n0 + (lane & 31)]; }
    LDS_WAIT(); asm volatile("" ::: "memory");
    const int c = lane & 7;
#pragma unroll
    for (int j = 0; j < 4; ++j) { const int n = (lane >> 3) + 8 * j; const LAS float* s = scr + (8 * c) * 33 + n;
        v4u o; o.x = pk2(s[0 * 33], s[1 * 33]); o.y = pk2(s[2 * 33], s[3 * 33]); o.z = pk2(s[4 * 33], s[5 * 33]); o.w = pk2(s[6 * 33], s[7 * 33]);
        *(GAS v4u*)(WT + (size_t)(row_off + n0 + n) * K + k0 + 8 * c) = o; }
    LDS_WAIT(); asm volatile("" ::: "memory");
}
__device__ __forceinline__ void convert_layer(const Frame& F, int l) {
    LAS float* scr = (LAS float*)(F.lds + F.wave * 16384);
    constexpr int I_IN = 32 * 544, I_SQ = 32 * 64, I_F1 = 32 * 256, I_F2 = 128 * 64, I_LRU = 64 * 8;
    constexpr int NITEMS = I_IN + 4 * I_SQ + I_F1 + I_F2 + I_LRU;
    for (int it = F.gw; it < NITEMS; it += F.NGW) {
        int r = it;
        if (r < I_IN) { transpose_item(inp<I_WIN>(F) + (size_t)l * D * INW, D, INW, F.WIN(), 0, scr, r, F.lane); continue; } r -= I_IN;
        if (r < I_SQ) { transpose_item(inp<I_WAO>(F) + (size_t)l * D * D, D, D, F.WBR(), 0, scr, r, F.lane); continue; } r -= I_SQ;
        if (r < I_SQ) { transpose_item(inp<I_WLO>(F) + (size_t)l * D * D, D, D, F.WBR(), D, scr, r, F.lane); continue; } r -= I_SQ;
        if (r < I_SQ) { transpose_item(inp<I_WCO>(F) + (size_t)l * D * D, D, D, F.WBR(), 2 * D, scr, r, F.lane); continue; } r -= I_SQ;
        if (r < I_SQ) { transpose_item(inp<I_WOUT>(F) + (size_t)l * D * D, D, D, F.WOUT(), 0, scr, r, F.lane); continue; } r -= I_SQ;
        if (r < I_F1) { transpose_item(inp<I_WFF1>(F) + (size_t)l * D * DFF, D, DFF, F.WFF1(), 0, scr, r, F.lane); continue; } r -= I_F1;
        if (r < I_F2) { transpose_item(inp<I_WFF2>(F) + (size_t)l * DFF * D, DFF, D, F.WFF2(), 0, scr, r, F.lane); continue; } r -= I_F2;
        { const int bi = r >> 3, sub = r & 7, d = bi >> 5, mat = (bi >> 4) & 1, blk = bi & 15;
          const float* src = (mat ? inp<I_LWX>(F) : inp<I_LWA>(F)) + ((size_t)(l * 2 + d) * 16 + blk) * 16384;
          transpose_item(src, 128, 128, F.WLRU() + (size_t)bi * 16384, 0, scr, sub, F.lane); }
    }
    const float* cw = inp<I_CMWS>(F) + (size_t)l * 16 * 16384;
    for (int i = (F.gw * 64 + F.lane) * 8; i < 16 * 16384; i += F.NGW * 64 * 8) {
        const f32x4 a = *(const f32x4*)(cw + i), b = *(const f32x4*)(cw + i + 4);
        v4u o; o.x = pk2(a.x, a.y); o.y = pk2(a.z, a.w); o.z = pk2(b.x, b.y); o.w = pk2(b.z, b.w);
        *(v4u*)(F.CMW() + i) = o;
    }
}
__device__ __forceinline__ void mod_partials(const Frame& F) {
    LAS float* scr = (LAS float*)(F.lds + F.wave * 16384);
    for (int it = F.gw; it < DEPTH * 48 * 16; it += F.NGW) {
        const int kc = it & 15, jb = (it >> 4) % 48, l = it / (16 * 48), k0 = kc * 128;
        for (int e = F.lane; e < NCOND * 128; e += 64) { const int ci = e >> 7, kk = e & 127; const float v = ci == 0 ? inp<I_CCTX>(F)[k0 + kk] : inp<I_C>(F)[(ci - 1) * D + k0 + kk]; scr[e] = v * (1.f / (1.f + __expf(-v))); }
        LDS_WAIT(); asm volatile("" ::: "memory");
        f32x4 acc[NCOND];
#pragma unroll
        for (int ci = 0; ci < NCOND; ++ci) acc[ci] = (f32x4){0.f, 0.f, 0.f, 0.f};
        const float* wp = inp<I_WMOD>(F) + ((size_t)l * D + k0) * 12288 + jb * 256 + F.lane * 4;
#pragma unroll 4
        for (int kk = 0; kk < 128; ++kk) {
            const f32x4 w = *(const f32x4*)(wp + (size_t)kk * 12288);
#pragma unroll
            for (int ci = 0; ci < NCOND; ++ci) acc[ci] += w * scr[ci * 128 + kk];
        }
#pragma unroll
        for (int ci = 0; ci < NCOND; ++ci) *(f32x4*)(F.MODP() + (((size_t)kc * DEPTH + l) * NCOND + ci) * 12288 + jb * 256 + F.lane * 4) = acc[ci];
        LDS_WAIT(); asm volatile("" ::: "memory");
    }
}
__device__ __forceinline__ void mod_reduce(const Frame& F) {
    constexpr int NEL = DEPTH * NCOND * 12288;
    for (int i = (F.gw * 64 + F.lane) * 4; i < NEL; i += F.NGW * 64 * 4) {
        const int l = i / (NCOND * 12288), j = i % 12288;
        f32x4 s = *(const f32x4*)(inp<I_BMOD>(F) + (size_t)l * 12288 + j);
#pragma unroll
        for (int kc = 0; kc < 16; ++kc) s += *(const f32x4*)(F.MODP() + (size_t)kc * NEL + i);
        *(f32x4*)(F.MOD() + i) = s;
    }
}
__device__ __forceinline__ void rope_table(const Frame& F) {
    if (F.bx == 0) for (int e = F.tid; e < 2048; e += NWAVES * 64) {
        const int pos = e >> 5, f = e & 31; const float inv = exp2f(-(float)f * (13.287712379549449f / 32.f)); float s, c; sincosf((float)pos * inv, &s, &c);
        F.ROPE()[e] = c; F.ROPE()[2048 + e] = s; }
}
template <bool HAS_F, bool HAS_H>
__device__ __forceinline__ void rowlocal_row(const Frame& F, const float* xsrc, float* xdst, const bf16_t* frow, const float* fstat, const float* gate, const float* gpost,
                                             const float* gpre, const float* sc, const float* sh, bf16_t* hrow) {
    f32x4 xv[4][2];
#pragma unroll
    for (int j = 0; j < 4; ++j) { const int e = (j * 64 + F.lane) * 8; xv[j][0] = *(const f32x4*)(xsrc + e); xv[j][1] = *(const f32x4*)(xsrc + e + 4); }
    if (HAS_F) {
        const float st = F.lane < 32 ? fstat[F.lane] : 0.f;
        const float rs = rsqrtf(wave_sum(st) * (1.f / D) + EPS);
#pragma unroll
        for (int j = 0; j < 4; ++j) { const int e = (j * 64 + F.lane) * 8;
            const u32x4 fw = *(const u32x4*)(frow + e);
            const f32x4 g0 = *(const f32x4*)(gate + e), g1 = *(const f32x4*)(gate + e + 4), p0 = *(const f32x4*)(gpost + e), p1 = *(const f32x4*)(gpost + e + 4);
            const f32x4 f0 = {bflo(fw.x), bfhi(fw.x), bflo(fw.y), bfhi(fw.y)}, f1 = {bflo(fw.z), bfhi(fw.z), bflo(fw.w), bfhi(fw.w)};
            xv[j][0] += g0 * (f0 * rs * p0); xv[j][1] += g1 * (f1 * rs * p1); }
    }
#pragma unroll
    for (int j = 0; j < 4; ++j) { const int e = (j * 64 + F.lane) * 8; *(f32x4*)(xdst + e) = xv[j][0]; *(f32x4*)(xdst + e + 4) = xv[j][1]; }
    if (HAS_H) {
        float ss = 0.f;
#pragma unroll
        for (int j = 0; j < 4; ++j)
#pragma unroll
            for (int h = 0; h < 2; ++h) ss += (xv[j][h].x * xv[j][h].x + xv[j][h].y * xv[j][h].y) + (xv[j][h].z * xv[j][h].z + xv[j][h].w * xv[j][h].w);
        const float rs = rsqrtf(wave_sum(ss) * (1.f / D) + EPS);
#pragma unroll
        for (int j = 0; j < 4; ++j) { const int e = (j * 64 + F.lane) * 8;
            f32x4 o[2];
#pragma unroll
            for (int h = 0; h < 2; ++h) { const f32x4 g = *(const f32x4*)(gpre + e + 4 * h), s1 = *(const f32x4*)(sc + e + 4 * h), s0 = *(const f32x4*)(sh + e + 4 * h); o[h] = xv[j][h] * rs * g * (s1 + 1.f) + s0; }
            u32x4 w; w.x = cvt_pk_bf16(o[0].x, o[0].y); w.y = cvt_pk_bf16(o[0].z, o[0].w); w.z = cvt_pk_bf16(o[1].x, o[1].y); w.w = cvt_pk_bf16(o[1].z, o[1].w);
            *(u32x4*)(hrow + e) = w; }
    }
}
__device__ __forceinline__ int cond_of_row(int m) { return m < MP ? 0 : 1 + ((m - MP) >> 11); }
template <int MODE>
__device__ __forceinline__ void rowlocal_phase(const Frame& F, int l) {
    for (int m = F.gw; m < M; m += F.NGW) {
        const int ci = cond_of_row(m);
        float* xrow = F.x() + (size_t)m * D;
        const float* modl = F.MOD() + ((size_t)l * NCOND + ci) * 12288;
        if (MODE == 0) {
            const float* xs = m < MP ? inp<I_XP>(F) + (size_t)m * D : inp<I_XS>(F) + (size_t)(m - MP) * D;
            rowlocal_row<false, true>(F, xs, xrow, nullptr, nullptr, nullptr, nullptr, inp<I_GPM>(F), modl + 1 * D, modl + 0 * D, F.H() + (size_t)m * D);
        } else if (MODE == 1) {
            rowlocal_row<true, true>(F, xrow, xrow, F.Fb() + (size_t)m * D, F.FSTAT() + (size_t)m * 32, modl + 2 * D, inp<I_GPOM>(F) + (size_t)l * D,
                                     inp<I_GPF>(F) + (size_t)l * D, modl + 4 * D, modl + 3 * D, F.H() + (size_t)m * D);
        } else {
            if (l + 1 < DEPTH) { const float* modn = F.MOD() + ((size_t)(l + 1) * NCOND + ci) * 12288;
                rowlocal_row<true, true>(F, xrow, xrow, F.Fb() + (size_t)m * D, F.FSTAT() + (size_t)m * 32, modl + 5 * D, inp<I_GPOF>(F) + (size_t)l * D,
                                         inp<I_GPM>(F) + (size_t)(l + 1) * D, modn + 1 * D, modn + 0 * D, F.H() + (size_t)m * D); }
            else rowlocal_row<true, false>(F, xrow, xrow, F.Fb() + (size_t)m * D, F.FSTAT() + (size_t)m * 32, modl + 5 * D, inp<I_GPOF>(F) + (size_t)l * D, nullptr, nullptr, nullptr, nullptr);
        }
    }
}
__device__ __forceinline__ u32x4 pack8(const f32x4& a, const f32x4& b) { u32x4 w; w.x = cvt_pk_bf16(a[0], a[1]); w.y = cvt_pk_bf16(a[2], a[3]); w.z = cvt_pk_bf16(b[0], b[1]); w.w = cvt_pk_bf16(b[2], b[3]); return w; }
__device__ __forceinline__ f32x4 gelu4(const f32x4& v) { return (f32x4){fgelu(v[0]), fgelu(v[1]), fgelu(v[2]), fgelu(v[3])}; }
__device__ __forceinline__ f32x4 sigm4(const f32x4& v) { return (f32x4){fsigm(v[0]), fsigm(v[1]), fsigm(v[2]), fsigm(v[3])}; }
__device__ __forceinline__ int kv_row(int m) { return m < MP ? m : MP + ((m - MP) >> 11) * 2304 + ((m - MP) & 2047); }
struct EpiIn {
    static constexpr bool PERM = true, AFTER_DRAIN = false;
    bf16_t* Z; bf16_t* VALL; float* new_v; float* cvstat; int layer;
    __device__ __forceinline__ void operator()(const f32x4 (&acc)[2][2][4][2], const Unit& u, int wr, int wc, int fr, int fq) const {
        const int pn = u.pn, row0 = u.pm * 256 + wr * 64 + fr, cl = wc * 32 + 8 * fq;
        if (pn >= 10 && pn < 12) {
            const int colv = (pn - 10) * 256 + cl;
#pragma unroll
            for (int ai = 0; ai < 2; ++ai)
#pragma unroll
                for (int m = 0; m < 4; ++m) { const int row = row0 + ai * 128 + m * 16; bf16_t* dst = VALL + (size_t)kv_row(row) * 512 + colv;
#pragma unroll
                    for (int bj = 0; bj < 2; ++bj) { *(u32x4*)(dst + bj * 128) = pack8(acc[ai][bj][m][0], acc[ai][bj][m][1]);
                        if (row < MP) { float* nv = new_v + ((size_t)((row >> 8) * DEPTH + layer) * 256 + (row & 255)) * 512 + colv + bj * 128; *(f32x4*)nv = acc[ai][bj][m][0]; *(f32x4*)(nv + 4) = acc[ai][bj][m][1]; } } }
            return;
        }
        const int mode = (pn < 20) ? 0 : (pn < 36) ? 1 : (pn < 44) ? 2 : 3;
        const int col0 = pn * 256 + cl;
#pragma unroll
        for (int ai = 0; ai < 2; ++ai)
#pragma unroll
            for (int m = 0; m < 4; ++m) { const int row = row0 + ai * 128 + m * 16; bf16_t* dst = Z + (size_t)row * INW + col0; float ss = 0.f;
#pragma unroll
                for (int bj = 0; bj < 2; ++bj) { f32x4 v0 = acc[ai][bj][m][0], v1 = acc[ai][bj][m][1];
                    if (mode == 1 || mode == 2) { v0 = gelu4(v0); v1 = gelu4(v1); }
                    if (mode == 3) { v0 = sigm4(v0); v1 = sigm4(v1); }
                    if (mode == 2) ss += (v0[0] * v0[0] + v0[1] * v0[1]) + (v0[2] * v0[2] + v0[3] * v0[3]) + (v1[0] * v1[0] + v1[1] * v1[1]) + (v1[2] * v1[2] + v1[3] * v1[3]);
                    *(u32x4*)(dst + bj * 128) = pack8(v0, v1); }
                if (mode == 2) { ss += __shfl_xor(ss, 16); ss += __shfl_xor(ss, 32); if (fq == 0) cvstat[(size_t)row * 32 + (pn - 36) * 4 + wc] = ss; } }
    }
};
struct EpiRelu2 {
    static constexpr bool PERM = true, AFTER_DRAIN = false;
    bf16_t* O; int ldc;
    __device__ __forceinline__ void operator()(const f32x4 (&acc)[2][2][4][2], const Unit& u, int wr, int wc, int fr, int fq) const {
        const int row0 = u.pm * 256 + wr * 64 + fr, col0 = u.pn * 256 + wc * 32 + 8 * fq;
#pragma unroll
        for (int ai = 0; ai < 2; ++ai)
#pragma unroll
            for (int m = 0; m < 4; ++m) { bf16_t* dst = O + (size_t)(row0 + ai * 128 + m * 16) * ldc + col0;
#pragma unroll
                for (int bj = 0; bj < 2; ++bj) { f32x4 v0 = __builtin_elementwise_max(acc[ai][bj][m][0], (f32x4){0.f, 0.f, 0.f, 0.f}), v1 = __builtin_elementwise_max(acc[ai][bj][m][1], (f32x4){0.f, 0.f, 0.f, 0.f});
                    *(u32x4*)(dst + bj * 128) = pack8(v0 * v0, v1 * v1); } }
    }
};
struct EpiF {
    static constexpr bool PERM = true, AFTER_DRAIN = false;
    bf16_t* O; float* stat;
    __device__ __forceinline__ void operator()(const f32x4 (&acc)[2][2][4][2], const Unit& u, int wr, int wc, int fr, int fq) const {
        const int row0 = u.pm * 256 + wr * 64 + fr, col0 = u.pn * 256 + wc * 32 + 8 * fq;
#pragma unroll
        for (int ai = 0; ai < 2; ++ai)
#pragma unroll
            for (int m = 0; m < 4; ++m) { const int row = row0 + ai * 128 + m * 16; bf16_t* dst = O + (size_t)row * D + col0; float ss = 0.f;
#pragma unroll
                for (int bj = 0; bj < 2; ++bj) { const f32x4 v0 = acc[ai][bj][m][0], v1 = acc[ai][bj][m][1];
                    ss += (v0[0] * v0[0] + v0[1] * v0[1]) + (v0[2] * v0[2] + v0[3] * v0[3]) + (v1[0] * v1[0] + v1[1] * v1[1]) + (v1[2] * v1[2] + v1[3] * v1[3]);
                    *(u32x4*)(dst + bj * 128) = pack8(v0, v1); }
                ss += __shfl_xor(ss, 16); ss += __shfl_xor(ss, 32); if (fq == 0) stat[(size_t)row * 32 + u.pn * 4 + wc] = ss; }
    }
};
struct EpiMerge {
    static constexpr bool PERM = true, AFTER_DRAIN = false;
    const bf16_t* Z; float* scr  ; bf16_t* O;
    __device__ __forceinline__ void operator()(const f32x4 (&acc)[2][2][4][2], const Unit& u, int wr, int wc, int fr, int fq) const {
        const int br = u.pn >> 3, pn = u.pn & 7, pm = u.pm - 96 * br;
        const int rl0 = wr * 64 + fr, cl = wc * 32 + 8 * fq;
#pragma unroll
        for (int ai = 0; ai < 2; ++ai)
#pragma unroll
            for (int m = 0; m < 4; ++m) { const int rl = rl0 + ai * 128 + m * 16, row = pm * 256 + rl;
#pragma unroll
                for (int bj = 0; bj < 2; ++bj) { const int c = cl + bj * 128;
                    const u32x4 gw = *(const u32x4*)(Z + (size_t)row * INW + OFF_G + br * D + pn * 256 + c);
                    const f32x4 g0 = {bflo(gw.x), bfhi(gw.x), bflo(gw.y), bfhi(gw.y)}, g1 = {bflo(gw.z), bfhi(gw.z), bflo(gw.w), bfhi(gw.w)};
                    f32x4 v0 = g0 * acc[ai][bj][m][0], v1 = g1 * acc[ai][bj][m][1];
                    float* sp = scr + rl * 256 + c;
                    if (br > 0) { v0 += *(const f32x4*)sp; v1 += *(const f32x4*)(sp + 4); }
                    if (br < 2) { *(f32x4*)sp = v0; *(f32x4*)(sp + 4) = v1; }
                    else *(u32x4*)(O + (size_t)row * D + pn * 256 + c) = pack8(v0, v1); } }
    }
};
struct MergeOrder {
    pg8::StaticOrder so;
    __device__ void init(int G, int c) { so.init(M, D, G, c); }
    __device__ bool next(int i, Unit& u) const { const int br = i % 3; if (!so.next(i / 3, u)) return false; u.pm += 96 * br; u.pn += 8 * br; return true; }
    __device__ __forceinline__ void a_ready(const Unit&) const {}
    __device__ __forceinline__ void done(const Unit&) const {}
};
}
namespace fk {
typedef short bf16x8 __attribute__((ext_vector_type(8)));
__device__ __forceinline__ void prep_row(const Frame& F, int m, int l) {
    const bool sample = m >= MP; int b, t;
    if (!sample) { b = m >> 8; t = m & 255; } else { b = (m - MP) >> 11; t = (m - MP) & 2047; }
    const int kvrow = sample ? MP + b * 2304 + t : m;
    const int lane = F.lane, g8 = lane >> 3, j = lane & 7, axis = g8 & 1, hsel = lane >> 4;
    bf16_t* zrow = F.Z() + (size_t)m * INW;
    const int dA = axis * 64 + 4 * j, dB = dA + 32;
    const f32x4 gqa = *(const f32x4*)(inp<I_GQ>(F) + l * 128 + dA), gqb = *(const f32x4*)(inp<I_GQ>(F) + l * 128 + dB);
    const f32x4 gka = *(const f32x4*)(inp<I_GK>(F) + l * 128 + dA), gkb = *(const f32x4*)(inp<I_GK>(F) + l * 128 + dB);
    f32x4 cs = {1.f, 1.f, 1.f, 1.f}, sn = {0.f, 0.f, 0.f, 0.f};
    if (sample) { const int pos = axis == 0 ? (t >> 6) : (t & 63); cs = *(const f32x4*)(F.ROPE() + pos * 32 + 4 * j); sn = *(const f32x4*)(F.ROPE() + 2048 + pos * 32 + 4 * j); }
#pragma unroll
    for (int pass = 0; pass < 5; ++pass) {
        const bool isq = pass < 4;
        const int base = isq ? OFF_Q + (pass * 4 + hsel) * 128 + dA : OFF_K + hsel * 128 + dA;
        const u32x2 wa = *(const u32x2*)(zrow + base), wb = *(const u32x2*)(zrow + base + 32);
        const f32x4 xa = {bflo(wa.x), bfhi(wa.x), bflo(wa.y), bfhi(wa.y)}, xb = {bflo(wb.x), bfhi(wb.x), bflo(wb.y), bfhi(wb.y)};
        float ss = (xa.x * xa.x + xa.y * xa.y) + (xa.z * xa.z + xa.w * xa.w) + (xb.x * xb.x + xb.y * xb.y) + (xb.z * xb.z + xb.w * xb.w);
        ss += __shfl_xor(ss, 1); ss += __shfl_xor(ss, 2); ss += __shfl_xor(ss, 4); ss += __shfl_xor(ss, 8);
        const float rs = rsqrtf(ss * (1.f / 128.f) + EPS);
        const f32x4 na = xa * rs * (isq ? gqa : gka), nb = xb * rs * (isq ? gqb : gkb);
        const f32x4 ra = na * cs - nb * sn, rb = na * sn + nb * cs;
        u32x2 oa, ob; oa.x = cvt_pk_bf16(ra.x, ra.y); oa.y = cvt_pk_bf16(ra.z, ra.w); ob.x = cvt_pk_bf16(rb.x, rb.y); ob.y = cvt_pk_bf16(rb.z, rb.w);
        if (isq) { *(u32x2*)(zrow + base) = oa; *(u32x2*)(zrow + base + 32) = ob; }
        else {
            bf16_t* kd = F.KALL() + (size_t)kvrow * 512 + hsel * 128 + dA; *(u32x2*)kd = oa; *(u32x2*)(kd + 32) = ob;
            if (!sample) { float* nk = F.new_k() + ((size_t)(b * DEPTH + l) * 256 + t) * 512 + hsel * 128 + dA; *(f32x4*)nk = na; *(f32x4*)(nk + 32) = nb; }
        }
    }
}
__device__ __forceinline__ void prep_phase(const Frame& F, int l) {
    for (int m = F.gw; m < M; m += F.NGW) prep_row(F, m, l);
    for (int it = F.gw; it < 2 * 8 * 256; it += F.NGW) {
        const int which = it >> 11, b = (it >> 8) & 7, p = it & 255;
        const float* src = (which ? inp<I_CV>(F) : inp<I_CK>(F)) + ((size_t)(b * DEPTH + l) * 256 + p) * 512 + F.lane * 8;
        bf16_t* dst = (which ? F.VALL() : F.KALL()) + (size_t)(MP + b * 2304 + 2048 + p) * 512 + F.lane * 8;
        const f32x4 a = *(const f32x4*)src, c = *(const f32x4*)(src + 4);
        *(u32x4*)dst = pack8(a, c);
    }
}
__device__ __forceinline__ int crow(int r, int hi) { return (r & 3) + 8 * (r >> 2) + 4 * hi; }
struct LruCtx {
    bf16x8 bw0[8], bw1[8];
    float bav, bxv, c8;
    bool small;
};
__device__ __forceinline__ void lru_ctx_load(const Frame& F, int l, int blk, LruCtx& X) {
    const int lane = F.lane, wave = F.wave, d = wave >> 2, n0 = (wave & 3) * 32, nl = lane & 31, hi = lane >> 5, C = blk * 128 + n0 + nl;
    const bf16_t* wb0 = F.WLRU() + ((size_t)((d * 2 + 0) * 16 + blk) * 128 + n0 + nl) * 128 + hi * 8;
    const bf16_t* wb1 = F.WLRU() + ((size_t)((d * 2 + 1) * 16 + blk) * 128 + n0 + nl) * 128 + hi * 8;
#pragma unroll
    for (int ks = 0; ks < 8; ++ks) { X.bw0[ks] = *(const bf16x8*)(wb0 + ks * 16); X.bw1[ks] = *(const bf16x8*)(wb1 + ks * 16); }
    X.bav = inp<I_LBA>(F)[(size_t)(l * 2 + d) * D + C]; X.bxv = inp<I_LBX>(F)[(size_t)(l * 2 + d) * D + C];
    const float lam = inp<I_LAM>(F)[(size_t)(l * 2 + d) * D + C];
    X.c8 = -8.f * log1pf(__expf(-lam));
    X.small = __all(X.c8 > -0.5f);
}
template <int PASS>
__device__ __forceinline__ void lru_unit(const Frame& F, int l, int ck, int blk, const LruCtx& X, const float* __restrict__ state_l, float* __restrict__ AGG, const float* __restrict__ cwl, const float* __restrict__ cbl) {
    int tid_ = F.tid; asm volatile("" : "+v"(tid_));
    const int tid = tid_, lane = tid & 63, wave = __builtin_amdgcn_readfirstlane(tid >> 6);
    const int m0 = ck * 64; const bool sample = m0 >= MP;
    int b, t0, T; if (!sample) { b = m0 >> 8; t0 = m0 & 255; T = 256; } else { b = (m0 - MP) >> 11; t0 = (m0 - MP) & 2047; T = 2048; }
    const int C0 = blk * 128;
    LAS unsigned char* lds = F.lds;
    const bf16_t* Zb = F.Z();
    {
        const int c4 = (tid & 31) * 4, r0 = (tid >> 5) * 4;
        f32x4 cw[4];
#pragma unroll
        for (int j = 0; j < 4; ++j) cw[j] = *(const f32x4*)(cwl + (size_t)j * D + C0 + c4);
        const f32x4 cb = *(const f32x4*)(cbl + C0 + c4);
        f32x4 zr[7];
#pragma unroll
        for (int i = 0; i < 7; ++i) {
            const int tt = t0 + r0 + i - 2;
            if (tt >= 0 && tt < T) { const u32x2 z = *(const u32x2*)(Zb + (size_t)(m0 + r0 + i - 2) * INW + OFF_LX + C0 + c4); zr[i] = (f32x4){bflo(z.x), bfhi(z.x), bflo(z.y), bfhi(z.y)}; }
            else zr[i] = (f32x4){0.f, 0.f, 0.f, 0.f};
        }
#pragma unroll
        for (int r = 0; r < 4; ++r) {
            const f32x4 y = cb + zr[r] * cw[0] + zr[r + 1] * cw[1] + zr[r + 2] * cw[2] + zr[r + 3] * cw[3];
            u32x2 o; o.x = cvt_pk_bf16(y.x, y.y); o.y = cvt_pk_bf16(y.z, y.w);
            *(LAS u32x2*)(lds + LRU_XC + (r0 + r) * LRU_XC_PITCH + c4 * 2) = o;
        }
    }
    __syncthreads();
    {
        const int d = wave >> 2, n0 = (wave & 3) * 32, nl = lane & 31, hi = lane >> 5;
        f32x16 acc[2][2];
#pragma unroll
        for (int mat = 0; mat < 2; ++mat)
#pragma unroll
            for (int mt = 0; mt < 2; ++mt)
#pragma unroll
                for (int r = 0; r < 16; ++r) acc[mat][mt][r] = 0.f;
        const LAS unsigned char* ap = lds + LRU_XC + nl * LRU_XC_PITCH + hi * 16;
#pragma unroll
        for (int ks = 0; ks < 8; ++ks) {
            const bf16x8 a0 = *(const LAS bf16x8*)(ap + ks * 32), a1 = *(const LAS bf16x8*)(ap + 32 * LRU_XC_PITCH + ks * 32);
            acc[0][0] = __builtin_amdgcn_mfma_f32_32x32x16_bf16(a0, X.bw0[ks], acc[0][0], 0, 0, 0);
            acc[0][1] = __builtin_amdgcn_mfma_f32_32x32x16_bf16(a1, X.bw0[ks], acc[0][1], 0, 0, 0);
            acc[1][0] = __builtin_amdgcn_mfma_f32_32x32x16_bf16(a0, X.bw1[ks], acc[1][0], 0, 0, 0);
            acc[1][1] = __builtin_amdgcn_mfma_f32_32x32x16_bf16(a1, X.bw1[ks], acc[1][1], 0, 0, 0);
        }
        const int c = n0 + nl;
        LAS float* Ad = (LAS float*)(lds + (d ? LRU_A1 : LRU_A0)); LAS float* Bd = (LAS float*)(lds + (d ? LRU_B1 : LRU_B0));
        const float bav = X.bav, bxv = X.bxv, c8 = X.c8;
        if (X.small) {
#pragma unroll
            for (int mt = 0; mt < 2; ++mt)
#pragma unroll
                for (int r = 0; r < 16; ++r) {
                    const int tl = mt * 32 + crow(r, hi);
                    const float rg = fsigm(acc[0][mt][r] + bav), ig = fsigm(acc[1][mt][r] + bxv);
                    const float la = c8 * rg;
                    float q = 1.f + la * (1.f / 7.f); q = 1.f + la * (1.f / 6.f) * q; q = 1.f + la * 0.2f * q; q = 1.f + la * 0.25f * q; q = 1.f + la * (1.f / 3.f) * q; q = 1.f + la * 0.5f * q;
                    const float e1 = la * q;
                    const float om = fmaxf(-e1 * (2.f + e1), 0.f);
                    const float xcv = bf2f(*(const LAS unsigned short*)(lds + LRU_XC + tl * LRU_XC_PITCH + c * 2));
                    Ad[tl * 128 + c] = 1.f + e1; Bd[tl * 128 + c] = __builtin_amdgcn_sqrtf(om) * ig * xcv;
                }
        } else {
#pragma unroll
            for (int mt = 0; mt < 2; ++mt)
#pragma unroll
                for (int r = 0; r < 16; ++r) {
                    const int tl = mt * 32 + crow(r, hi);
                    const float rg = fsigm(acc[0][mt][r] + bav), ig = fsigm(acc[1][mt][r] + bxv);
                    const float la = c8 * rg, a = __expf(la);
                    const float mult = sqrtf(fmaxf(-expm1f(2.f * la), 0.f));
                    const float xcv = bf2f(*(const LAS unsigned short*)(lds + LRU_XC + tl * LRU_XC_PITCH + c * 2));
                    Ad[tl * 128 + c] = a; Bd[tl * 128 + c] = mult * ig * xcv;
                }
        }
    }
    __syncthreads();
    if (tid < 256) {
        const int d = tid >> 7, c = tid & 127, C = C0 + c;
        const LAS float* Ad = (const LAS float*)(lds + (d ? LRU_A1 : LRU_A0)); LAS float* Bd = (LAS float*)(lds + (d ? LRU_B1 : LRU_B0));
        if (PASS == 1) {
            float h = 0.f, Pp = 1.f;
            if (d == 0) {
#pragma unroll 16
                for (int s = 0; s < 64; ++s) { const float a = Ad[s * 128 + c]; h = a * h + Bd[s * 128 + c]; Pp *= a; }
            } else {
#pragma unroll 16
                for (int s = 0; s < 64; ++s) { const float a = Ad[(63 - s) * 128 + c]; h = a * h + Bd[(63 - s) * 128 + c]; Pp *= a; }
            }
            *(float2*)(AGG + ((size_t)(ck * 2 + d) * D + C) * 2) = make_float2(Pp, h);
        } else {
            const int jc = t0 >> 6, nch = T >> 6;
            float carry = sample ? state_l[((size_t)b * DEPTH * 2 + d) * D + C] : 0.f;
            const float* ag = AGG + ((size_t)((ck - jc) * 2 + d) * D + C) * 2;
            if (nch == 4) {
                float2 pe[4];
#pragma unroll
                for (int jj = 0; jj < 4; ++jj) pe[jj] = *(const float2*)(ag + (size_t)jj * 4 * D);
                if (d == 0) {
#pragma unroll
                    for (int jj = 0; jj < 4; ++jj) if (jj < jc) carry = pe[jj].x * carry + pe[jj].y; }
                else {
#pragma unroll
                    for (int jj = 3; jj >= 0; --jj) if (jj > jc) carry = pe[jj].x * carry + pe[jj].y; }
            } else {
                float2 pe[32];
#pragma unroll
                for (int jj = 0; jj < 32; ++jj) pe[jj] = *(const float2*)(ag + (size_t)jj * 4 * D);
                if (d == 0) {
#pragma unroll
                    for (int jj = 0; jj < 32; ++jj) if (jj < jc) carry = pe[jj].x * carry + pe[jj].y; }
                else {
#pragma unroll
                    for (int jj = 31; jj >= 0; --jj) if (jj > jc) carry = pe[jj].x * carry + pe[jj].y; }
            }
            float h = carry;
            if (d == 0) {
#pragma unroll
                for (int s0 = 0; s0 < 64; s0 += 16) { float av[16], bv[16];
#pragma unroll
                    for (int i = 0; i < 16; ++i) { av[i] = Ad[(s0 + i) * 128 + c]; bv[i] = Bd[(s0 + i) * 128 + c]; }
#pragma unroll
                    for (int i = 0; i < 16; ++i) { h = av[i] * h + bv[i]; bv[i] = h; }
#pragma unroll
                    for (int i = 0; i < 16; ++i) Bd[(s0 + i) * 128 + c] = bv[i]; }
            } else {
#pragma unroll
                for (int s0 = 0; s0 < 64; s0 += 16) { float av[16], bv[16];
#pragma unroll
                    for (int i = 0; i < 16; ++i) { av[i] = Ad[(63 - s0 - i) * 128 + c]; bv[i] = Bd[(63 - s0 - i) * 128 + c]; }
#pragma unroll
                    for (int i = 0; i < 16; ++i) { h = av[i] * h + bv[i]; bv[i] = h; }
#pragma unroll
                    for (int i = 0; i < 16; ++i) Bd[(63 - s0 - i) * 128 + c] = bv[i]; }
            }
            if (!sample && ((d == 0 && jc == nch - 1) || (d == 1 && jc == 0))) F.new_s()[((size_t)(b * DEPTH + l) * 2 + d) * D + C] = h;
        }
    }
    if (PASS == 2) {
        __syncthreads();
        const int row = tid >> 3, c16 = (tid & 7) * 16;
        const LAS float* h0 = (const LAS float*)(lds + LRU_B0) + row * 128 + c16; const LAS float* h1 = (const LAS float*)(lds + LRU_B1) + row * 128 + c16;
        const bf16_t* gp = Zb + (size_t)(m0 + row) * INW + OFF_LG + C0 + c16;
        const u32x4 g0 = *(const u32x4*)gp, g1 = *(const u32x4*)(gp + 8);
        const unsigned gw[8] = {g0.x, g0.y, g0.z, g0.w, g1.x, g1.y, g1.z, g1.w};
        unsigned ow[8];
#pragma unroll
        for (int i = 0; i < 8; ++i) ow[i] = cvt_pk_bf16((h0[2 * i] + h1[2 * i]) * bflo(gw[i]), (h0[2 * i + 1] + h1[2 * i + 1]) * bfhi(gw[i]));
        bf16_t* yp = F.BR() + (size_t)1 * M * D + (size_t)(m0 + row) * D + C0 + c16;
        *(u32x4*)yp = (u32x4){ow[0], ow[1], ow[2], ow[3]}; *(u32x4*)(yp + 8) = (u32x4){ow[4], ow[5], ow[6], ow[7]};
    }
    __syncthreads();
}
template <int PASS>
__device__ __forceinline__ void lru_phase(const Frame& F, int l) {
    LruCtx X; int cur = -1;
    const float* state_l = inp<I_SL>(F) + (size_t)l * 2 * D;
    float* AGG = F.AGG();
    const float* cwl = inp<I_CW>(F) + (size_t)l * 4 * D; const float* cbl = inp<I_CB>(F) + (size_t)l * D;
    for (int u = F.bx; u < 384 * 16; u += F.G) {
        const int blk = u & 15, ck = u >> 4;
        if (blk != cur) { lru_ctx_load(F, l, blk, X); cur = blk; }
        lru_unit<PASS>(F, l, ck, blk, X, state_l, AGG, cwl, cbl);
    }
}
__device__ __forceinline__ void cm_unit(const Frame& F, int l, int cn, int g) {
    const int tid = F.tid, lane = F.lane, wave = F.wave, m0 = cn * 128, C0 = g * 128;
    LAS unsigned char* lds = F.lds;
    LAS float* RS = (LAS float*)(lds + CM_RS);
    if (tid < 128) { const float* st = F.CVSTAT() + (size_t)(m0 + tid) * 32; float s = 0.f;
#pragma unroll
        for (int i = 0; i < 32; i += 4) { const f32x4 v = *(const f32x4*)(st + i); s += (v.x + v.y) + (v.z + v.w); }
        RS[tid] = rsqrtf(s * (1.f / D) + EPS); }
    __syncthreads();
    {
        const int p = tid >> 2, c32 = (tid & 3) * 32; const float rs = RS[p];
        const bf16_t* vp = F.Z() + (size_t)(m0 + p) * INW + OFF_CV + C0 + c32; const float* gp = inp<I_CMG>(F) + (size_t)l * D + C0 + c32;
#pragma unroll
        for (int q4 = 0; q4 < 4; ++q4) {
            const u32x4 w = *(const u32x4*)(vp + q4 * 8); const f32x4 ga = *(const f32x4*)(gp + q4 * 8), gb = *(const f32x4*)(gp + q4 * 8 + 4);
            const float v[8] = {bflo(w.x) * ga.x, bfhi(w.x) * ga.y, bflo(w.y) * ga.z, bfhi(w.y) * ga.w, bflo(w.z) * gb.x, bfhi(w.z) * gb.y, bflo(w.w) * gb.z, bfhi(w.w) * gb.w};
#pragma unroll
            for (int i = 0; i < 8; ++i) *(LAS unsigned short*)(lds + CM_VT + (c32 + q4 * 8 + i) * CM_VT_PITCH + p * 2) = (unsigned short)(cvt_pk_bf16(v[i] * rs, 0.f) & 0xffffu);
        }
    }
    __syncthreads();
    {
        const int mt = wave >> 1, nt0 = (wave & 1) * 2, xl = lane & 31, hi = lane >> 5;
        f32x16 acc[2];
#pragma unroll
        for (int r = 0; r < 16; ++r) { acc[0][r] = 0.f; acc[1][r] = 0.f; }
        const bf16_t* wp = F.CMW() + ((size_t)g * 128 + mt * 32 + xl) * 128 + hi * 8;
        const LAS unsigned char* bp = lds + CM_VT + (nt0 * 32 + xl) * CM_VT_PITCH + hi * 16;
#pragma unroll
        for (int ks = 0; ks < 8; ++ks) {
            const bf16x8 a = *(const bf16x8*)(wp + ks * 16);
            const bf16x8 b0 = *(const LAS bf16x8*)(bp + ks * 32), b1 = *(const LAS bf16x8*)(bp + 32 * CM_VT_PITCH + ks * 32);
            acc[0] = __builtin_amdgcn_mfma_f32_32x32x16_bf16(a, b0, acc[0], 0, 0, 0);
            acc[1] = __builtin_amdgcn_mfma_f32_32x32x16_bf16(a, b1, acc[1], 0, 0, 0);
        }
        const float* bs = inp<I_CMBS>(F) + ((size_t)l * 16 + g) * 128;
#pragma unroll
        for (int nt = 0; nt < 2; ++nt)
#pragma unroll
            for (int r = 0; r < 16; ++r) {
                const int q = mt * 32 + crow(r, hi), c = (nt0 + nt) * 32 + xl;
                const float u = bf2f(F.Z()[(size_t)(m0 + q) * INW + OFF_CU + C0 + c]);
                const float o = u * (acc[nt][r] + bs[q]);
                F.BR()[(size_t)2 * M * D + (size_t)(m0 + q) * D + C0 + c] = (bf16_t)(cvt_pk_bf16(o, 0.f) & 0xffffu);
            }
    }
    __syncthreads();
}
__device__ __forceinline__ void attn_phase(const Frame& F) {
    char* lds = (char*)F.lds;
    const att::bf16* Z = (const att::bf16*)F.Z(); const att::bf16* K = (const att::bf16*)F.KALL(); const att::bf16* V = (const att::bf16*)F.VALL(); att::bf16* O = (att::bf16*)F.BR();
    for (int id = F.bx; id < 1536; id += F.G) {
        size_t qrow, kvrow; int h, nkeys;
        if (id < 1024) { const int qb = id & 7, b = id >> 7; h = (id >> 3) & 15; qrow = (size_t)MP + (size_t)b * 2048 + qb * 256; kvrow = (size_t)MP + (size_t)b * 2304; nkeys = 2304; }
        else { const int id2 = id - 1024, b = id2 >> 4; h = id2 & 15; qrow = (size_t)b * 256; kvrow = qrow; nkeys = 256; }
        att::attn_dense_body<att::bf16>(Z + qrow * INW + OFF_Q + h * 128, K + kvrow * 512 + (h >> 2) * 128, V + kvrow * 512 + (h >> 2) * 128, O + qrow * D + h * 128, nkeys, lds);
    }
    __syncthreads();
}
}
#ifndef REP_G
#define REP_G 1
#endif
#ifndef REP_A
#define REP_A 1
#endif
#ifndef REP_L
#define REP_L 1
#endif
#ifndef REP_V
#define REP_V 1
#endif
#ifndef REP_C
#define REP_C 1
#endif
namespace fk {
#if REP_G > 1
template <class Base> struct RepOrder {
    Base b; int n;
    __device__ void init_n() { Unit u; n = 0; while (b.next(n, u)) ++n; }
    __device__ bool next(int i, Unit& u) const { if (i >= 2 * n) return false; return b.next(i >= n ? i - n : i, u); }
    __device__ __forceinline__ void a_ready(const Unit&) const {}
    __device__ __forceinline__ void done(const Unit&) const {}
};
#define GEMM_CALL(EPI, ORD, g, S, E) do { RepOrder<ORD> RS_; RS_.b = S; RS_.init_n(); pg8::gemm_phase<EPI, RepOrder<ORD>, true, true>(P.lds, g, RS_, E); } while (0)
#else
#define GEMM_CALL(EPI, ORD, g, S, E) pg8::gemm_phase<EPI, ORD, true, true>(P.lds, g, S, E)
#endif
__global__ void __launch_bounds__(NWAVES * 64, 2) mega(Params p) {
    extern __shared__ __attribute__((aligned(16))) unsigned char lds_raw[];
    Frame F;
    F.lds = (LAS unsigned char*)lds_raw;
    F.tid = threadIdx.x; F.lane = F.tid & 63; F.wave = __builtin_amdgcn_readfirstlane(F.tid >> 6);
    F.G = gridDim.x; { const int bx = blockIdx.x; F.vcu = (F.G % 8 == 0) ? (bx % 8) * (F.G / 8) + bx / 8 : bx; }
    F.gw = F.vcu * NWAVES + F.wave; F.NGW = F.G * NWAVES; F.bx = blockIdx.x;
    F.out = p.out; F.ws = p.ws; F.ka = (kaptr_t)__builtin_amdgcn_kernarg_segment_ptr();
    unsigned char* ws = p.ws;
    volatile LAS unsigned* MISC = (volatile LAS unsigned*)(F.lds + MISC_OFF);
    for (int u = F.tid; u < (LDS_BYTES - MISC_OFF) / 4; u += NWAVES * 64) ((LAS unsigned*)(F.lds + MISC_OFF))[u] = 0u;
    __syncthreads();
    unsigned* barw = (unsigned*)(ws + WS_CTL) + CW_BAR + p.li * XCD_BAR_WORDS;
    XcdBarrier bar = xcd_barrier_post(barw, MISC + 8);
    const int lo = p.ph_lo, hi = p.ph_hi;
#define IN_PH(k) (lo <= (k) && (k) < hi)
#define SEAM(k) do { if ((k) + 1 < hi) xcd_barrier(bar); } while (0)

    if (IN_PH(0)) { const Frame P = phase_frame(F);
convert_layer(P, 0); mod_partials(P); rope_table(P);
#if REP_V > 1
        __syncthreads(); convert_layer(P, 0); mod_partials(P);
#endif
 SEAM(0); }
    if (IN_PH(1)) { const Frame P = phase_frame(F); mod_reduce(P); SEAM(1); }
    if (IN_PH(2)) { const Frame P = phase_frame(F); rowlocal_phase<0>(P, 0); SEAM(2); }
    for (int l = 0; l < DEPTH; ++l) {
        const int pb = 3 + 9 * l;
        if (IN_PH(pb + 0)) { const Frame P = phase_frame(F);
            pg8::Gemm g{P.H(), P.WIN(), M, INW, D}; pg8::StaticOrder S; S.init(M, INW, P.G, P.bx);
            EpiIn E{P.Z(), P.VALL(), P.new_v(), P.CVSTAT(), l};

GEMM_CALL(EpiIn, pg8::StaticOrder, g, S, E);

            SEAM(pb + 0);
        }
        if (IN_PH(pb + 1)) { const Frame P = phase_frame(F);

prep_phase(P, l);

            __syncthreads();

lru_phase<1>(P, l);
#if REP_L > 1
            lru_phase<1>(P, l);
#endif


for (int u = P.bx; u < 192 * 16; u += P.G) cm_unit(P, l, u >> 4, u & 15);
#if REP_C > 1
            for (int u = P.bx; u < 192 * 16; u += P.G) cm_unit(P, l, u >> 4, u & 15);
#endif

            SEAM(pb + 1);
        }
        if (IN_PH(pb + 2)) { const Frame P = phase_frame(F);

attn_phase(P);
#if REP_A > 1
            attn_phase(P);
#endif


lru_phase<2>(P, l);
#if REP_L > 1
            lru_phase<2>(P, l);
#endif

            SEAM(pb + 2);
        }
        if (IN_PH(pb + 3)) { const Frame P = phase_frame(F);
            pg8::Gemm g{P.BR(), P.WBR(), 3 * M, 3 * D, D}; MergeOrder S; S.init(P.G, P.bx);
            EpiMerge E{P.Z(), P.MSCR() + (size_t)P.bx * 65536, P.H()};

GEMM_CALL(EpiMerge, MergeOrder, g, S, E);

            SEAM(pb + 3);
        }
        if (IN_PH(pb + 4)) { const Frame P = phase_frame(F);
            pg8::Gemm g{P.H(), P.WOUT(), M, D, D}; pg8::StaticOrder S; S.init(M, D, P.G, P.bx);
            EpiF E{P.Fb(), P.FSTAT()};

GEMM_CALL(EpiF, pg8::StaticOrder, g, S, E);
            SEAM(pb + 4);

        }
        if (IN_PH(pb + 5)) { const Frame P = phase_frame(F);
rowlocal_phase<1>(P, l);
 SEAM(pb + 5); }
        if (IN_PH(pb + 6)) { const Frame P = phase_frame(F);
            pg8::Gemm g{P.H(), P.WFF1(), M, DFF, D}; pg8::StaticOrder S; S.init(M, DFF, P.G, P.bx);
            EpiRelu2 E{P.FFH(), DFF};

GEMM_CALL(EpiRelu2, pg8::StaticOrder, g, S, E);

            SEAM(pb + 6);
        }
        if (IN_PH(pb + 7)) { const Frame P = phase_frame(F);
            pg8::Gemm g{P.FFH(), P.WFF2(), M, D, DFF}; pg8::StaticOrder S; S.init(M, D, P.G, P.bx);
            EpiF E{P.Fb(), P.FSTAT()};

GEMM_CALL(EpiF, pg8::StaticOrder, g, S, E);
            SEAM(pb + 7);

        }
        if (IN_PH(pb + 8)) { const Frame P = phase_frame(F);

rowlocal_phase<2>(P, l);


if (l + 1 < DEPTH) { __syncthreads(); convert_layer(P, l + 1); }
#if REP_V > 1
            if (l + 1 < DEPTH) { __syncthreads(); convert_layer(P, l + 1); }
#endif

            SEAM(pb + 8);
        }
    }
#undef IN_PH
#undef SEAM
}
}
extern "C" void kernel_launch(void* const* d_in, const int* in_sizes, int n_in, void* d_out, int out_size, void* d_ws, size_t ws_size, hipStream_t stream) {
    static int grid = 0;
    if (grid == 0) {
        if (n_in != 32 || out_size != 84410368 || ws_size < fk::WS_END) { fprintf(stderr, "kernel_launch: unexpected shapes: n_in %d out %d ws %zu (need %zu)\n", n_in, out_size, ws_size, (size_t)fk::WS_END); grid = -1; return; }
        int dev = 0, cus = 0;
        if (hipGetDevice(&dev) != hipSuccess || hipDeviceGetAttribute(&cus, hipDeviceAttributeMultiprocessorCount, dev) != hipSuccess) { grid = -1; return; }
        if (hipFuncSetAttribute((const void*)fk::mega, hipFuncAttributeMaxDynamicSharedMemorySize, fk::LDS_BYTES) != hipSuccess) { fprintf(stderr, "kernel_launch: hipFuncSetAttribute failed\n"); grid = -1; return; }
        int per_cu = 0;
        if (hipOccupancyMaxActiveBlocksPerMultiprocessor(&per_cu, (const void*)fk::mega, fk::NWAVES * 64, fk::LDS_BYTES) != hipSuccess || per_cu < 1) fprintf(stderr, "kernel_launch: occupancy query says %d blocks per CU\n", per_cu);
        (void)hipGetLastError();
        grid = cus < 256 ? cus : 256;
    }
    if (grid < 0) return;
    (void)hipMemsetAsync((char*)d_ws + fk::WS_CTL, 0, fk::CTL_ZERO_BYTES, stream);
    fk::Params p{};
    for (int i = 0; i < 32; ++i) p.in[i] = (const float*)d_in[i];
    p.out = (float*)d_out; p.ws = (unsigned char*)d_ws; p.ph_lo = 0; p.ph_hi = fk::NPHASE; p.li = 0; p.pad = 0;
    hipLaunchKernelGGL(fk::mega, dim3(grid), dim3(fk::NWAVES * 64), fk::LDS_BYTES, stream, p);
}
```

```cpp
#include <hip/hip_runtime.h>
#include <hip/hip_bf16.h>
#include <cstdio>
#include <cstdint>
namespace pg8 {
#define PG8_LAS __attribute__((address_space(3)))
typedef unsigned short bf16_t;
typedef short bf16x8 __attribute__((ext_vector_type(8)));
typedef float f32x4 __attribute__((ext_vector_type(4)));
typedef unsigned u32x4 __attribute__((ext_vector_type(4)));
constexpr int BM = 256, BK = 64, HALF = 128, HTB = HALF * BK * 2  , STAGE_BYTES = 8 * HTB, NXCD = 8, WGM = 8;

__host__ __device__ __forceinline__ int lds_byte(int r, int c) { const int st = (r >> 4) * 2 + (c >> 5), rr = r & 15, cc = c & 31, ob = rr * 64 + cc * 2; return st * 1024 + (ob ^ (((ob >> 9) & 1) << 5)); }
__host__ __device__ __forceinline__ void stage_rc(int b, int& R, int& C) { const int st = b / 1024, sb = b % 1024, swz = sb ^ (((sb >> 9) & 1) << 5); R = (st >> 1) * 16 + swz / 64; C = (st & 1) * 32 + (swz % 64) / 2; }
__host__ __device__ __forceinline__ int perm32(int rho) { const int n = rho >> 4, i = rho & 15; return 8 * (i >> 2) + 4 * n + (i & 3); }

struct Unit { int pm, pn; };
struct Gemm { const bf16_t* A; const bf16_t* Bt; int M, N, K; };

struct StaticOrder {
    int nM, nN, nwg, G, c;
    __host__ __device__ void init(int M, int N, int G_, int c_) { nM = M / BM; nN = N / BM; nwg = nM * nN; G = G_; c = c_; }
    __host__ __device__ bool next(int i, Unit& u) const {
        const long L = (long)i * G + c; if (L >= nwg) return false;
        int wgid = (int)L; { const int q = nwg / NXCD, r = nwg % NXCD, xcd = wgid % NXCD, off = wgid / NXCD; wgid = (xcd < r ? xcd * (q + 1) : r * (q + 1) + (xcd - r) * q) + off; }
        const int nig = WGM * nN, gid = wgid / nig, fm = gid * WGM, gsz = (nM - fm) < WGM ? (nM - fm) : WGM;
        u.pm = fm + ((wgid % nig) % gsz); u.pn = (wgid % nig) / gsz; return true;
    }
    __device__ __forceinline__ void a_ready(const Unit&) const {}
    __device__ __forceinline__ void done(const Unit&) const {}
};
__device__ __forceinline__ unsigned cvt_pk_bf16(float lo, float hi) { unsigned r; asm volatile("v_cvt_pk_bf16_f32 %0, %1, %2" : "=v"(r) : "v"(lo), "v"(hi)); return r; }
template <class Epi, class Sched, bool ALIGN_EPI = false, bool SP2 = false>
__device__ __forceinline__ void gemm_phase(PG8_LAS unsigned char* lds, const Gemm g, const Sched& S, const Epi& E) {
    int tid_ = threadIdx.x; asm volatile("" : "+v"(tid_));
    const int tid = tid_, wid = __builtin_amdgcn_readfirstlane(tid >> 6), lane = tid & 63, wr = wid >> 2, wc = wid & 3, fr = lane & 15, fq = lane >> 4;
    const int K = g.K, nt = K / BK;
    unsigned voffA[2], voffB[2];
#pragma unroll
    for (int i = 0; i < 2; ++i) { int R, C; stage_rc(tid * 16 + i * 8192, R, C); const int Rb = Epi::PERM ? ((R & ~31) + perm32(R & 31)) : R;
        voffA[i] = (unsigned)(R * K + C) * 2u; voffB[i] = (unsigned)(Rb * K + C) * 2u; }
    const size_t kstep = (size_t)(BK * 2);
    const size_t hstep = (size_t)HALF * K * 2;
    const size_t tstep = 2 * hstep;
    const unsigned ldsw = (unsigned)wid * 1024u;
    const int aoff = lds_byte(wr * 64 + fr, fq * 8), boff = lds_byte(wc * 32 + fr, fq * 8);
#define PG8_SA(b, h) (((b) * 2 + (h)) * HTB)
#define PG8_SB(b, h) ((4 + (b) * 2 + (h)) * HTB)
#define PG8_STAGE(bufoff, gbase, voff) do { _Pragma("unroll") for (int _i = 0; _i < 2; ++_i) \
        __builtin_amdgcn_global_load_lds((const unsigned*)((const char*)(gbase) + (voff)[_i]), (PG8_LAS unsigned*)(lds + (bufoff) + ldsw + _i * 8192), 16, 0, 0); } while (0)
#define PG8_LDA(dst, b, h) do { _Pragma("unroll") for (int m = 0; m < 4; ++m) _Pragma("unroll") for (int k = 0; k < 2; ++k) dst[m][k] = *(const PG8_LAS bf16x8*)(lds + PG8_SA(b, h) + aoff + m * 2048 + k * 1024); } while (0)
#define PG8_LDB(dst, b, h) do { _Pragma("unroll") for (int n = 0; n < 2; ++n) _Pragma("unroll") for (int k = 0; k < 2; ++k) dst[n][k] = *(const PG8_LAS bf16x8*)(lds + PG8_SB(b, h) + boff + n * 2048 + k * 1024); } while (0)
#define PG8_MMA(ai, bj, At, Bt) do { __builtin_amdgcn_s_setprio(1); _Pragma("unroll") for (int m = 0; m < 4; ++m) _Pragma("unroll") for (int n = 0; n < 2; ++n) _Pragma("unroll") for (int k = 0; k < 2; ++k) \
        acc[ai][bj][m][n] = __builtin_amdgcn_mfma_f32_16x16x32_bf16(Bt[n][k], At[m][k], acc[ai][bj][m][n], 0, 0, 0); __builtin_amdgcn_s_setprio(0); } while (0)
#define PG8_WAIT_V(n) asm volatile("s_waitcnt vmcnt(" #n ")" ::: "memory")
#define PG8_WAIT_L(n) asm volatile("s_waitcnt lgkmcnt(" #n ")" ::: "memory")
#define PG8_BAR __builtin_amdgcn_s_barrier()
#define PG8_SCHED __builtin_amdgcn_sched_barrier(0)
    Unit cur, nxt; int ui = 0;
    if (!S.next(0, cur)) return;
    f32x4 acc[2][2][4][2];
#pragma unroll
    for (int a = 0; a < 2; ++a)
#pragma unroll
        for (int b = 0; b < 2; ++b)
#pragma unroll
            for (int m = 0; m < 4; ++m)
#pragma unroll
                for (int n = 0; n < 2; ++n) acc[a][b][m][n] = (f32x4){0.f, 0.f, 0.f, 0.f};
    bf16x8 At[4][2], B0[2][2], B1[2][2];
    const char* cA = (const char*)g.A + (size_t)cur.pm * tstep; const char* cB = (const char*)g.Bt + (size_t)cur.pn * tstep;
    S.a_ready(cur);
    if constexpr (SP2) {
        PG8_STAGE(PG8_SB(0, 0), cB, voffB); PG8_STAGE(PG8_SB(0, 1), cB + hstep, voffB); PG8_STAGE(PG8_SA(0, 0), cA, voffA); PG8_STAGE(PG8_SA(0, 1), cA + hstep, voffA);
        if (wr == 1) PG8_BAR;
        PG8_WAIT_V(2); PG8_BAR;
        PG8_STAGE(PG8_SB(1, 0), cB + kstep, voffB); PG8_STAGE(PG8_SA(1, 0), cA + kstep, voffA); PG8_STAGE(PG8_SB(1, 1), cB + hstep + kstep, voffB);
        PG8_WAIT_V(6); PG8_BAR;
    } else {
        PG8_STAGE(PG8_SB(0, 0), cB, voffB); PG8_STAGE(PG8_SA(0, 0), cA, voffA); PG8_STAGE(PG8_SB(0, 1), cB + hstep, voffB); PG8_STAGE(PG8_SA(0, 1), cA + hstep, voffA);
        if (wr == 1) PG8_BAR;
        PG8_WAIT_V(4); PG8_BAR;
        PG8_STAGE(PG8_SB(1, 0), cB + kstep, voffB); PG8_STAGE(PG8_SA(1, 0), cA + kstep, voffA); PG8_STAGE(PG8_SB(1, 1), cB + hstep + kstep, voffB);
        PG8_WAIT_V(6); PG8_BAR;
    }
    for (;;) {
        const bool has_next = S.next(ui + 1, nxt);
        const char* nA = has_next ? (const char*)g.A + (size_t)nxt.pm * tstep : cA; const char* nB = has_next ? (const char*)g.Bt + (size_t)nxt.pn * tstep : cB;
        for (int t = 0; t < nt; t += 2) {
            const bool last = (t == nt - 2);
            const char* a1 = cA + (size_t)(t + 1) * kstep;
            const char* a2 = last ? nA : cA + (size_t)(t + 2) * kstep; const char* b2 = last ? nB : cB + (size_t)(t + 2) * kstep;
            const char* a3 = a2 + kstep; const char* b3 = b2 + kstep;
            if (last && has_next) S.a_ready(nxt);
            if constexpr (SP2) {
            PG8_LDB(B0, 0, 0); PG8_LDB(B1, 0, 1); PG8_SCHED; PG8_LDA(At, 0, 0); PG8_STAGE(PG8_SA(1, 1), a1 + hstep, voffA);
            PG8_WAIT_V(8); PG8_WAIT_L(0); PG8_BAR; PG8_MMA(0, 0, At, B0); PG8_MMA(0, 1, At, B1); PG8_BAR; PG8_SCHED;
            PG8_LDA(At, 0, 1); PG8_STAGE(PG8_SB(0, 0), b2, voffB); PG8_STAGE(PG8_SB(0, 1), b2 + hstep, voffB); PG8_STAGE(PG8_SA(0, 0), a2, voffA);
            PG8_WAIT_V(8); PG8_WAIT_L(0); PG8_BAR; PG8_MMA(1, 0, At, B0); PG8_MMA(1, 1, At, B1); PG8_BAR; PG8_SCHED;
            PG8_LDB(B0, 1, 0); PG8_LDB(B1, 1, 1); PG8_SCHED; PG8_LDA(At, 1, 0); PG8_STAGE(PG8_SA(0, 1), a2 + hstep, voffA);
            PG8_WAIT_V(8); PG8_WAIT_L(0); PG8_BAR; PG8_MMA(0, 0, At, B0); PG8_MMA(0, 1, At, B1); PG8_BAR; PG8_SCHED;
            PG8_LDA(At, 1, 1); PG8_STAGE(PG8_SB(1, 0), b3, voffB); PG8_STAGE(PG8_SB(1, 1), b3 + hstep, voffB); PG8_STAGE(PG8_SA(1, 0), a3, voffA);
            PG8_WAIT_V(8); PG8_WAIT_L(0); PG8_BAR; PG8_MMA(1, 0, At, B0); PG8_MMA(1, 1, At, B1); PG8_BAR; PG8_SCHED;
            } else {
            PG8_LDB(B0, 0, 0); PG8_SCHED; PG8_LDA(At, 0, 0); PG8_STAGE(PG8_SA(1, 1), a1 + hstep, voffA);
            PG8_WAIT_L(8); PG8_BAR; PG8_WAIT_L(0); PG8_MMA(0, 0, At, B0); PG8_BAR; PG8_SCHED;
            PG8_LDB(B1, 0, 1); PG8_STAGE(PG8_SB(0, 0), b2, voffB);
            PG8_BAR; PG8_WAIT_L(0); PG8_MMA(0, 1, At, B1); PG8_BAR;
            PG8_LDA(At, 0, 1); PG8_STAGE(PG8_SA(0, 0), a2, voffA);
            PG8_BAR; PG8_WAIT_L(0); PG8_MMA(1, 0, At, B0); PG8_BAR; PG8_SCHED;
            PG8_STAGE(PG8_SB(0, 1), b2 + hstep, voffB);
            PG8_WAIT_V(6); PG8_BAR; PG8_MMA(1, 1, At, B1); PG8_BAR;
            PG8_LDB(B0, 1, 0); PG8_SCHED; PG8_LDA(At, 1, 0); PG8_STAGE(PG8_SA(0, 1), a2 + hstep, voffA);
            PG8_WAIT_L(8); PG8_BAR; PG8_WAIT_L(0); PG8_MMA(0, 0, At, B0); PG8_BAR; PG8_SCHED;
            PG8_LDB(B1, 1, 1); PG8_STAGE(PG8_SB(1, 0), b3, voffB);
            PG8_BAR; PG8_WAIT_L(0); PG8_MMA(0, 1, At, B1); PG8_BAR;
            PG8_LDA(At, 1, 1); PG8_STAGE(PG8_SA(1, 0), a3, voffA);
            PG8_BAR; PG8_WAIT_L(0); PG8_MMA(1, 0, At, B0); PG8_BAR; PG8_SCHED;
            PG8_STAGE(PG8_SB(1, 1), b3 + hstep, voffB);
            PG8_WAIT_V(6); PG8_BAR; PG8_MMA(1, 1, At, B1); PG8_BAR;
            }
        }
        if constexpr (ALIGN_EPI) { if (wr == 0) PG8_BAR; }
        if constexpr (!Epi::AFTER_DRAIN) { E(acc, cur, wr, wc, fr, fq); S.done(cur); }
        if (!has_next) break;
#pragma unroll
        for (int a = 0; a < 2; ++a)
#pragma unroll
            for (int b = 0; b < 2; ++b)
#pragma unroll
                for (int m = 0; m < 4; ++m)
#pragma unroll
                    for (int n = 0; n < 2; ++n) acc[a][b][m][n] = (f32x4){0.f, 0.f, 0.f, 0.f};
        cur = nxt; cA = nA; cB = nB; ++ui;
        if constexpr (ALIGN_EPI) { if (wr == 1) PG8_BAR; }
    }
    PG8_WAIT_V(0);
    if constexpr (!ALIGN_EPI) { if (wr == 0) PG8_BAR; }
    PG8_BAR;
    if constexpr (Epi::AFTER_DRAIN) { E.fused(acc, cur, wr, wc, fr, fq, lds, wid, lane); S.done(cur); }
#undef PG8_SA
#undef PG8_SB
#undef PG8_STAGE
#undef PG8_LDA
#undef PG8_LDB
#undef PG8_MMA
#undef PG8_WAIT_V
#undef PG8_WAIT_L
#undef PG8_BAR
#undef PG8_SCHED
}
}
#define GAS __attribute__((address_space(1)))
#define LAS __attribute__((address_space(3)))
typedef unsigned short bf16;
typedef unsigned v4u __attribute__((ext_vector_type(4)));
typedef float f32x4 __attribute__((ext_vector_type(4)));
typedef short bf16x8 __attribute__((ext_vector_type(8)));
typedef GAS unsigned gu32;
typedef GAS unsigned long long gu64;
#define RLX_AGENT __ATOMIC_RELAXED, __HIP_MEMORY_SCOPE_AGENT
#define LDS_WAIT() asm volatile("s_waitcnt lgkmcnt(0)" ::: "memory")
#define VM_WAIT() asm volatile("s_waitcnt vmcnt(0)" ::: "memory")
__device__ __forceinline__ unsigned long long rt() { return __builtin_amdgcn_s_memrealtime(); }
__device__ __forceinline__ unsigned f2bf(float f) { unsigned u = __builtin_bit_cast(unsigned, f); return (u + 0x7fffu + ((u >> 16) & 1u)) >> 16; }
__device__ __forceinline__ unsigned pk2(float lo, float hi) { return f2bf(lo) | (f2bf(hi) << 16); }

#define XB_TMO      128
#define XB_XCNT(j)  (256  + 64 * (j))
#define XB_XSUB(j)  (1280 + 64 * (j))
#define XB_XGEN(j)  (2304 + 64 * (j))
#define XB_TOP      3328
#define XB_TOPGEN   3392
#define XCD_BAR_WORDS 3456
#define XB_SPIN_CAP (1u << 18)

__device__ __forceinline__ unsigned xb_ld(unsigned* p)              { return __hip_atomic_load(p, __ATOMIC_RELAXED, __HIP_MEMORY_SCOPE_AGENT); }
__device__ __forceinline__ unsigned xb_add(unsigned* p, unsigned v) { return __hip_atomic_fetch_add(p, v, __ATOMIC_RELAXED, __HIP_MEMORY_SCOPE_AGENT); }
__device__ __forceinline__ unsigned xb_xcc_id() { return (unsigned)__builtin_amdgcn_s_getreg((3 << 11) | 20) & 0xFu; }
#define XB_SPIN(cond, bar) do { unsigned _sp = 0; while (cond) { __builtin_amdgcn_s_sleep(1); \
    if ((++_sp & 255u) == 0u) { if (xb_ld(&(bar)[XB_TMO])) break; if (_sp > XB_SPIN_CAP) { atomicAdd(&(bar)[XB_TMO], 1u); break; } } } } while (0)

struct XcdBarrier {
    unsigned* bar; unsigned x;
    volatile LAS unsigned* st;
};

__device__ __forceinline__ XcdBarrier xcd_barrier_post(unsigned* bar, volatile LAS unsigned* st) {
    XcdBarrier b; b.bar = bar; b.x = xb_xcc_id(); b.st = st;
    if (threadIdx.x == 0) (void)xb_add(&bar[XB_XCNT(b.x)], 1u);
    return b;
}
__device__ __forceinline__ void xcd_barrier_complete(unsigned* bar, unsigned x, unsigned& nloc, unsigned& nx) {
    const unsigned G = gridDim.x * gridDim.y * gridDim.z;
    unsigned sum, cnt, mine, sp = 0u;
    for (;;) {
        sum = 0u; cnt = 0u; mine = 0u;
#pragma unroll
        for (unsigned j = 0; j < 16; ++j) { const unsigned c = xb_ld(&bar[XB_XCNT(j)]); sum += c; cnt += (c > 0u) ? 1u : 0u; mine = (j == x) ? c : mine; }
        if (sum == G) break;
        __builtin_amdgcn_s_sleep(1);
        if ((++sp & 255u) == 0u) { if (xb_ld(&bar[XB_TMO])) break; if (sp > XB_SPIN_CAP) { atomicAdd(&bar[XB_TMO], 1u); break; } }
    }
    nloc = mine > 0u ? mine : 1u; nx = cnt > 0u ? cnt : 1u;
}

__device__ __forceinline__ void xcd_barrier(const XcdBarrier& b) {
    asm volatile("s_waitcnt vmcnt(0)" ::: "memory");
    __syncthreads();
    if (threadIdx.x == 0) {
        unsigned* bar = b.bar;
        __builtin_amdgcn_s_waitcnt(0);
        unsigned nloc = b.st[0], nx = b.st[1];
        if (nloc == 0u) { xcd_barrier_complete(bar, b.x, nloc, nx); b.st[0] = nloc; b.st[1] = nx; }
        const unsigned old = xb_add(&bar[XB_XSUB(b.x)], 1u);
        const unsigned gen = old / nloc;
        if (old + 1u == (gen + 1u) * nloc) {
            __builtin_amdgcn_fence(__ATOMIC_RELEASE, "agent");
            asm volatile("s_waitcnt vmcnt(0)" ::: "memory");
            const unsigned og = xb_add(&bar[XB_TOP], 1u);
            const unsigned tg = og / nx;
            if (og + 1u == (tg + 1u) * nx) xb_add(&bar[XB_TOPGEN], 1u);
            else XB_SPIN(xb_ld(&bar[XB_TOPGEN]) == tg, bar);
            __builtin_amdgcn_fence(__ATOMIC_ACQUIRE, "agent");
            xb_add(&bar[XB_XGEN(b.x)], 1u);
            asm volatile("s_waitcnt vmcnt(0)" ::: "memory");
        } else {
            XB_SPIN(xb_ld(&bar[XB_XGEN(b.x)]) == gen, bar);
            __builtin_amdgcn_fence(__ATOMIC_ACQUIRE, "agent");
            asm volatile("s_waitcnt vmcnt(0)" ::: "memory");
        }
    }
    __syncthreads();
}
namespace att {
constexpr int   D = 128, NW = 8, QBLK = 32, KVBLK = 64;
constexpr float SCALE = 0.088388347648318440f;
constexpr float THR = 8.f;
constexpr int SDEPTH = 2;
constexpr int LDQ = 17408, LDK = 512, LDO = 2048;
constexpr size_t SHM_V = KVBLK * D * 2, SHM_K = KVBLK * D * 2, SHM_ATTN = 2 * SHM_V + 2 * SHM_K + NW * 64 * 4;
using bf16 = __hip_bfloat16;
using bf16x8 = __attribute__((ext_vector_type(8))) short;
using s16x4  = __attribute__((ext_vector_type(4))) short;
using f32x16 = __attribute__((ext_vector_type(16))) float;
using f32x8  = __attribute__((ext_vector_type(8))) float;
using u32x4  = __attribute__((ext_vector_type(4))) unsigned;
#define KSWZ(row, colB) ((row) * 256 + ((colB) ^ (((row) & 7) << 4)))
#define SBAR() __builtin_amdgcn_sched_barrier(0)
__device__ __forceinline__ int crow(int r, int hi) { return (r & 3) + 8 * (r >> 2) + 4 * hi; }
__device__ __forceinline__ unsigned cvtpk(float lo, float hi) {
  unsigned r; asm volatile("v_cvt_pk_bf16_f32 %0, %1, %2" : "=v"(r) : "v"(lo), "v"(hi)); return r;
}
template <typename TIn> struct Stage;
template <> struct Stage<bf16>  { using T = bf16x8;
  __device__ static __forceinline__ T ld8(const bf16* p) { return *reinterpret_cast<const bf16x8*>(p); }
  __device__ static __forceinline__ bf16x8 tobf(T x) { return x; } };
template <> struct Stage<float> { using T = f32x8;
  __device__ static __forceinline__ T ld8(const float* p) { return *reinterpret_cast<const f32x8*>(p); }
  __device__ static __forceinline__ bf16x8 tobf(T x) {
    u32x4 w = {cvtpk(x[0], x[1]), cvtpk(x[2], x[3]), cvtpk(x[4], x[5]), cvtpk(x[6], x[7])}; return *reinterpret_cast<bf16x8*>(&w); } };

__device__ __forceinline__ void partialSM(f32x16& p0, f32x16& p1, float& m_reg, float& mn, float& alpha) {
  constexpr float C = SCALE * 1.4426950408889634f;
  float pmax = p0[0]; for (int r = 1; r < 16; ++r) pmax = fmaxf(pmax, p0[r]); for (int r = 0; r < 16; ++r) pmax = fmaxf(pmax, p1[r]);
  { auto rr = __builtin_amdgcn_permlane32_swap(__float_as_uint(pmax), __float_as_uint(pmax), false, false);
    pmax = fmaxf(__uint_as_float(rr[0]), __uint_as_float(rr[1])); }
  if (__builtin_expect(__all(pmax - m_reg <= THR / SCALE), 1)) { mn = m_reg; alpha = 1.f; }
  else { mn = fmaxf(m_reg, pmax); alpha = __builtin_amdgcn_exp2f((m_reg - mn) * C); m_reg = mn; }
  float mnC = -mn * C;
  for (int r = 0; r < 16; ++r) p0[r] = fmaf(p0[r], C, mnC); for (int r = 0; r < 16; ++r) p1[r] = fmaf(p1[r], C, mnC);
  for (int r = 0; r < 16; ++r) p0[r] = __builtin_amdgcn_exp2f(p0[r]);
}
__device__ __forceinline__ void finishSM(f32x16& p0, f32x16& p1, float alpha, float& l_reg, bf16x8& pa0, bf16x8& pa1, bf16x8& pa2, bf16x8& pa3) {
  for (int r = 0; r < 16; ++r) p1[r] = __builtin_amdgcn_exp2f(p1[r]);
  float ps = 0; for (int r = 0; r < 16; ++r) ps += p0[r]; for (int r = 0; r < 16; ++r) ps += p1[r];
  { auto rr = __builtin_amdgcn_permlane32_swap(__float_as_uint(ps), __float_as_uint(ps), false, false);
    ps = __uint_as_float(rr[0]) + __uint_as_float(rr[1]); }
  l_reg = l_reg * alpha + ps;
#define PK4(P, BASE, OUT) do { unsigned a0 = cvtpk(P[BASE + 0], P[BASE + 1]), a1 = cvtpk(P[BASE + 2], P[BASE + 3]);   \
    unsigned b0 = cvtpk(P[BASE + 4], P[BASE + 5]), b1 = cvtpk(P[BASE + 6], P[BASE + 7]);                              \
    auto r0 = __builtin_amdgcn_permlane32_swap(a0, b0, false, false); auto r1 = __builtin_amdgcn_permlane32_swap(a1, b1, false, false); \
    u32x4 w = {r0[0], r1[0], r0[1], r1[1]}; OUT = *reinterpret_cast<bf16x8*>(&w); } while (0)
  PK4(p0, 0, pa0); PK4(p0, 8, pa1); PK4(p1, 0, pa2); PK4(p1, 8, pa3);
#undef PK4
}
__device__ __forceinline__ void qkt(f32x16& p0, f32x16& p1, const bf16* Ks, const bf16x8* qr, int r32, int hi) {
  p0 = f32x16{}; p1 = f32x16{};
  for (int d0 = 0; d0 < 8; ++d0) { int cb = (d0 * 16 + hi * 8) * 2;
    bf16x8 b0 = *reinterpret_cast<const bf16x8*>((const char*)Ks + KSWZ(r32, cb));
    bf16x8 b1 = *reinterpret_cast<const bf16x8*>((const char*)Ks + KSWZ(32 + r32, cb));
    p0 = __builtin_amdgcn_mfma_f32_32x32x16_bf16(b0, qr[d0], p0, 0, 0, 0);
    p1 = __builtin_amdgcn_mfma_f32_32x32x16_bf16(b1, qr[d0], p1, 0, 0, 0); }
}
__device__ __forceinline__ int v_st(int k, int c) { const int kk = (k & ~0xC) | ((k & 4) << 1) | ((k & 8) >> 1); return ((kk >> 3) * 4 + (c >> 5)) * 512 + ((kk & 7) * 32 + (c & 31)) * 2; }
__device__ __forceinline__ int v_rd_base(int lane) { return ((lane & 3) << 3) | (((lane >> 2) & 3) << 6) | (((lane >> 4) & 1) << 5) | (((lane >> 5) & 1) << 8); }
constexpr int v_rd_off(int d0, int ks, int half) { return d0 * 512 + ks * 4096 + half * 2048; }
template <int OFF> __device__ __forceinline__ s16x4 tr_read(int vb) {
  s16x4 r; asm volatile("ds_read_b64_tr_b16 %0, %1 offset:%2" : "=&v"(r) : "v"(vb), "i"(OFF) : "memory"); return r;
}
template <int D0> __device__ __forceinline__ void pv_one(f32x16& od, int vb, bf16x8 pa0, bf16x8 pa1, bf16x8 pa2, bf16x8 pa3) {
  const s16x4 l0 = tr_read<v_rd_off(D0, 0, 0)>(vb), h0 = tr_read<v_rd_off(D0, 0, 1)>(vb), l1 = tr_read<v_rd_off(D0, 1, 0)>(vb), h1 = tr_read<v_rd_off(D0, 1, 1)>(vb);
  const s16x4 l2 = tr_read<v_rd_off(D0, 2, 0)>(vb), h2 = tr_read<v_rd_off(D0, 2, 1)>(vb), l3 = tr_read<v_rd_off(D0, 3, 0)>(vb), h3 = tr_read<v_rd_off(D0, 3, 1)>(vb);
  asm volatile("s_waitcnt lgkmcnt(0)" ::: "memory"); SBAR();
#define PK(L, H) (bf16x8){L[0], L[1], L[2], L[3], H[0], H[1], H[2], H[3]}
  od = __builtin_amdgcn_mfma_f32_32x32x16_bf16(pa0, PK(l0, h0), od, 0, 0, 0);
  od = __builtin_amdgcn_mfma_f32_32x32x16_bf16(pa1, PK(l1, h1), od, 0, 0, 0);
  od = __builtin_amdgcn_mfma_f32_32x32x16_bf16(pa2, PK(l2, h2), od, 0, 0, 0);
  od = __builtin_amdgcn_mfma_f32_32x32x16_bf16(pa3, PK(l3, h3), od, 0, 0, 0);
#undef PK
}
__device__ __forceinline__ void pv_d0(f32x16* o, int vb, bf16x8 pa0, bf16x8 pa1, bf16x8 pa2, bf16x8 pa3) {
  pv_one<0>(o[0], vb, pa0, pa1, pa2, pa3); pv_one<1>(o[1], vb, pa0, pa1, pa2, pa3); pv_one<2>(o[2], vb, pa0, pa1, pa2, pa3); pv_one<3>(o[3], vb, pa0, pa1, pa2, pa3);
}

template <typename TQ>
__device__ __forceinline__ void attn_dense_body(const TQ* __restrict__ Qb, const bf16* __restrict__ Kh, const bf16* __restrict__ Vh,
                                                bf16* __restrict__ Ob, int seq, char* lds) {
  using St = Stage<bf16>; using SQ = Stage<TQ>;
  int tid_ = threadIdx.x; asm volatile("" : "+v"(tid_));
  const int tid = tid_, wid = tid >> 6, lane = tid & 63, r32 = lane & 31, hi = lane >> 5;
  bf16* V_lds = (bf16*)lds; bf16* K_lds = (bf16*)(lds + 2 * SHM_V);
  float* ws = (float*)(lds + 2 * SHM_V + 2 * SHM_K) + wid * 64; float* li_l = ws; float* al_l = ws + 32;
  float m_reg = -1e30f, l_reg = 0; f32x16 o[4] = {}; bf16x8 qr[8];
  const TQ* Qw = Qb + (long)(wid * QBLK + r32) * LDQ + hi * 8;
#pragma unroll
  for (int d0 = 0; d0 < 8; ++d0) qr[d0] = SQ::tobf(SQ::ld8(Qw + d0 * 16));
  const int sr = tid >> 4, sc = (tid & 15) * 8, vst0 = v_st(sr, sc), vst1 = v_st(32 + sr, sc);
  const int vb0 = (int)(uintptr_t)V_lds + v_rd_base(lane);
  struct { typename St::T vs0, vs1, ks0, ks1; } sr_[SDEPTH];
#define SLOAD(i, k0) do { sr_[i].vs0 = St::ld8(&Vh[(long)((k0) + sr) * LDK + sc]); sr_[i].vs1 = St::ld8(&Vh[(long)((k0) + 32 + sr) * LDK + sc]); \
    sr_[i].ks0 = St::ld8(&Kh[(long)((k0) + sr) * LDK + sc]); sr_[i].ks1 = St::ld8(&Kh[(long)((k0) + 32 + sr) * LDK + sc]); } while (0)
#define SWRITE(b, i) do { *(bf16x8*)((char*)V_lds + (b) * SHM_V + vst0) = St::tobf(sr_[i].vs0);          \
    *(bf16x8*)((char*)V_lds + (b) * SHM_V + vst1) = St::tobf(sr_[i].vs1); int kc = sc * 2;               \
    *(bf16x8*)((char*)K_lds + (b) * SHM_K + KSWZ(sr, kc)) = St::tobf(sr_[i].ks0);                       \
    *(bf16x8*)((char*)K_lds + (b) * SHM_K + KSWZ(32 + sr, kc)) = St::tobf(sr_[i].ks1); } while (0)
#define SWAIT() do { if constexpr (SDEPTH == 2) asm volatile("s_waitcnt vmcnt(4)" ::: "memory"); else asm volatile("s_waitcnt vmcnt(0)" ::: "memory"); } while (0)
#define RESC(a) do { if (__any((a) < 1.f)) { if (hi == 0) al_l[r32] = (a); asm volatile("s_waitcnt lgkmcnt(0)" ::: "memory"); \
    for (int d = 0; d < 4; ++d) for (int r = 0; r < 16; ++r) o[d][r] *= al_l[crow(r, hi)]; } } while (0)
  f32x16 pA0, pA1, pB0, pB1; float mnA, mnB, alA, alB; bf16x8 pa0, pa1, pa2, pa3; const int NT = seq / KVBLK;
  constexpr int SE = 0, SO = SDEPTH - 1;
  SLOAD(SE, 0); asm volatile("s_waitcnt vmcnt(0)" ::: "memory"); SWRITE(0, SE); __syncthreads();
  qkt(pA0, pA1, K_lds, qr, r32, hi); partialSM(pA0, pA1, m_reg, mnA, alA);
  SLOAD(SO, KVBLK); if constexpr (SDEPTH == 2) { if (2 < NT) SLOAD(SE, 2 * KVBLK); }
  SWAIT(); SWRITE(1, SO); __syncthreads();
  for (int j = 1; j + 1 < NT; j += 2) {
    SBAR(); qkt(pB0, pB1, (bf16*)((char*)K_lds + SHM_K), qr, r32, hi);
    finishSM(pA0, pA1, alA, l_reg, pa0, pa1, pa2, pa3); SBAR();
    SLOAD(SO, (j + SDEPTH) * KVBLK); SBAR();
    pv_d0(o, vb0, pa0, pa1, pa2, pa3); partialSM(pB0, pB1, m_reg, mnB, alB);
    __syncthreads(); SWAIT(); SWRITE(0, SE);
    RESC(alB); __syncthreads();
    SBAR(); qkt(pA0, pA1, K_lds, qr, r32, hi);
    finishSM(pB0, pB1, alB, l_reg, pa0, pa1, pa2, pa3); SBAR();
    if (SDEPTH == 1 || j + 3 < NT) SLOAD(SE, (j + 1 + SDEPTH) * KVBLK); SBAR();
    pv_d0(o, vb0 + (int)SHM_V, pa0, pa1, pa2, pa3); partialSM(pA0, pA1, m_reg, mnA, alA);
    __syncthreads(); SWAIT(); SWRITE(1, SO);
    RESC(alA); __syncthreads();
  }
  SBAR(); qkt(pB0, pB1, (bf16*)((char*)K_lds + SHM_K), qr, r32, hi);
  finishSM(pA0, pA1, alA, l_reg, pa0, pa1, pa2, pa3); SBAR();
  pv_d0(o, vb0, pa0, pa1, pa2, pa3); partialSM(pB0, pB1, m_reg, mnB, alB);
  __syncthreads(); RESC(alB);
  finishSM(pB0, pB1, alB, l_reg, pa0, pa1, pa2, pa3); SBAR();
  pv_d0(o, vb0 + (int)SHM_V, pa0, pa1, pa2, pa3);
  if (hi == 0) li_l[r32] = l_reg; asm volatile("s_waitcnt lgkmcnt(0)" ::: "memory");
  float rli[16];
#pragma unroll
  for (int r = 0; r < 16; ++r) rli[r] = __builtin_amdgcn_rcpf(li_l[crow(r, hi)]);
  bf16* Ow = Ob + (long)(wid * QBLK) * LDO;
#pragma unroll
  for (int r = 0; r < 16; ++r) { int orow = crow(r, hi);
    for (int d0 = 0; d0 < 4; ++d0) Ow[(long)orow * LDO + d0 * 32 + r32] = __float2bfloat16(o[d0][r] * rli[r]); }
#undef SLOAD
#undef SWRITE
#undef SWAIT
#undef RESC
}
#undef KSWZ
#undef SBAR
}
namespace fk {
using pg8::bf16_t; using pg8::f32x4; using pg8::u32x4; using pg8::Unit; using pg8::cvt_pk_bf16;
typedef unsigned u32x2 __attribute__((ext_vector_type(2)));
typedef float f32x16 __attribute__((ext_vector_type(16)));
constexpr int M = 24576, MP = 8192, D = 2048, INW = 17408, DFF = 8192, DEPTH = 4, NWAVES = 8, NCOND = 9;
constexpr int OFF_Q = 0, OFF_K = 2048, OFF_V = 2560, OFF_LX = 3072, OFF_LG = 5120, OFF_CU = 7168, OFF_CV = 9216, OFF_G = 11264;
constexpr int NKVROWS = 26624;
constexpr float EPS = 1e-6f;
constexpr int NPHASE = 3 + 9 * DEPTH;
constexpr int NMODK = 32;
constexpr size_t MiB = 1u << 20;
constexpr size_t WS_CTL = 0, CTL_ZERO_BYTES = 1 * MiB;
constexpr size_t WS_MODP = 716 * MiB  , WS_MOD = 28 * MiB, WS_ROPE = 30 * MiB, WS_CVSTAT = 31 * MiB, WS_FSTAT = 34 * MiB, WS_AGG = 37 * MiB, WS_WLRU = 49 * MiB, WS_CMW = 51 * MiB;
constexpr size_t WS_WIN = 52 * MiB, WS_WBR = 120 * MiB, WS_WOUT = 144 * MiB, WS_WFF1 = 152 * MiB, WS_WFF2 = 184 * MiB;
constexpr size_t WS_H = 216 * MiB, WS_KALL = 312 * MiB, WS_VALL = 338 * MiB, WS_BR = 364 * MiB, WS_MSCR = 652 * MiB, WS_Z = 716 * MiB, WS_END = 1532 * MiB;
constexpr size_t WS_FFH = WS_Z, WS_F = WS_Z + 384 * MiB;
constexpr int CW_BAR = 4096;
constexpr int RING_BYTES = 131072;
constexpr int LRU_XC = 0, LRU_XC_PITCH = 272, LRU_A0 = 17408, LRU_B0 = LRU_A0 + 32768, LRU_A1 = LRU_B0 + 32768, LRU_B1 = LRU_A1 + 32768;
constexpr int CM_VT = 0, CM_VT_PITCH = 272, CM_RS = 128 * 272;
constexpr int MISC_OFF = 149504, LDS_BYTES = 150528;
static_assert(LRU_B1 + 32768 <= MISC_OFF, "lds map");

struct Params { const float* in[32]; float* out; unsigned char* ws; int ph_lo, ph_hi, li, pad; };

typedef const __attribute__((address_space(4))) void* kaptr_t;
struct Frame {
    LAS unsigned char* lds;
    int tid, lane, wave, vcu, G, gw, NGW, bx;
    float* out; unsigned char* ws; kaptr_t ka;
    __device__ __forceinline__ float* x() const { return out; }
    __device__ __forceinline__ float* new_k() const { return out + 50331648L; }
    __device__ __forceinline__ float* new_v() const { return out + 50331648L + 16777216L; }
    __device__ __forceinline__ float* new_s() const { return out + 50331648L + 2 * 16777216L; }
#define FK_WSP(name, type, off) __device__ __forceinline__ type* name() const { return (type*)(ws + (off)); }
    FK_WSP(MODP, float, WS_MODP) FK_WSP(MOD, float, WS_MOD) FK_WSP(ROPE, float, WS_ROPE) FK_WSP(CVSTAT, float, WS_CVSTAT) FK_WSP(FSTAT, float, WS_FSTAT) FK_WSP(AGG, float, WS_AGG) FK_WSP(MSCR, float, WS_MSCR)
    FK_WSP(WLRU, bf16_t, WS_WLRU) FK_WSP(CMW, bf16_t, WS_CMW) FK_WSP(WIN, bf16_t, WS_WIN) FK_WSP(WBR, bf16_t, WS_WBR) FK_WSP(WOUT, bf16_t, WS_WOUT) FK_WSP(WFF1, bf16_t, WS_WFF1) FK_WSP(WFF2, bf16_t, WS_WFF2)
    FK_WSP(H, bf16_t, WS_H) FK_WSP(KALL, bf16_t, WS_KALL) FK_WSP(VALL, bf16_t, WS_VALL) FK_WSP(BR, bf16_t, WS_BR) FK_WSP(Z, bf16_t, WS_Z) FK_WSP(FFH, bf16_t, WS_FFH) FK_WSP(Fb, bf16_t, WS_F)
#undef FK_WSP
};
enum { I_XP = 0, I_XS, I_CK, I_CV, I_SL, I_C, I_CCTX, I_WMOD, I_BMOD, I_GPM, I_GPOM, I_GPF, I_GPOF, I_WIN, I_GQ, I_GK, I_WAO, I_CW, I_CB, I_LWA, I_LBA, I_LWX, I_LBX, I_LAM, I_WLO, I_CMG, I_CMWS, I_CMBS, I_WCO, I_WOUT, I_WFF1, I_WFF2 };
template <int I> __device__ __forceinline__ const float* inp(const Frame& F) { const float* r; asm volatile("s_load_dwordx2 %0, %1, %2\n\ts_waitcnt lgkmcnt(0)" : "=s"(r) : "s"(F.ka), "i"(I * 8) : "memory"); return r; }


__device__ __forceinline__ Frame phase_frame(const Frame& F) {
    Frame P = F; int t = F.tid; int bx = blockIdx.x; int g = F.G; unsigned char* w = F.ws; float* o = F.out;
    asm volatile("" : "+v"(t)); asm volatile("" : "+s"(bx), "+s"(g), "+s"(w), "+s"(o));
    P.tid = t; P.lane = t & 63; P.wave = __builtin_amdgcn_readfirstlane(t >> 6); P.ws = w; P.out = o; P.bx = bx; P.G = g; P.NGW = g * NWAVES;
    P.vcu = (g % 8 == 0) ? (bx % 8) * (g / 8) + bx / 8 : bx; P.gw = P.vcu * NWAVES + P.wave;
    return P;
}
__device__ __forceinline__ float wave_sum(float v) {
#pragma unroll
    for (int o = 1; o < 64; o <<= 1) v += __shfl_xor(v, o);
    return v;
}
__device__ __forceinline__ float bf2f(unsigned short h) { return __uint_as_float((unsigned)h << 16); }
__device__ __forceinline__ float bflo(unsigned w) { return __uint_as_float(w << 16); }
__device__ __forceinline__ float bfhi(unsigned w) { return __uint_as_float(w & 0xffff0000u); }
__device__ __forceinline__ float fsigm(float x) { return __builtin_amdgcn_rcpf(1.f + __builtin_amdgcn_exp2f(-1.4426950408889634f * x)); }
__device__ __forceinline__ float fgelu(float x) { const float u = x * (1.5957691216057308f + 0.0713548162726009f * x * x); return x * fsigm(u); }

__device__ __forceinline__ void transpose_item(const float* __restrict__ W, int K, int N, bf16_t* __restrict__ WT, int row_off, LAS unsigned char* scr, int item, int lane) {
    const int nblk = N / 64, kb = item / nblk, nb = item % nblk, k0 = 64 * kb, n0 = 64 * nb;
    const int n4 = (lane & 15) * 4, kp = lane >> 4;
    const float* src = W + (size_t)(k0 + 2 * kp) * N + n0 + n4;
    f32x4 v[8][2];
#pragma unroll
    for (int i = 0; i < 8; ++i) { v[i][0] = *(const f32x4*)(src + (size_t)(8 * i) * N); v[i][1] = *(const f32x4*)(src + (size_t)(8 * i + 1) * N); }
#pragma unroll
    for (int i = 0; i < 8; ++i) { const int k = 8 * i + 2 * kp;
#pragma unroll
        for (int j = 0; j < 4; ++j) *(LAS unsigned*)(scr + (n4 + j) * 144 + k * 2) = cvt_pk_bf16(v[i][0][j], v[i][1][j]); }
    LDS_WAIT(); asm volatile("" ::: "memory");
    const int ch = lane & 7;
#pragma unroll
    for (int j = 0; j < 8; ++j) { const int n = (lane >> 3) + 8 * j;
        const v4u o = *(const LAS v4u*)(scr + n * 144 + ch * 16);
        *(GAS v4u*)(WT + (size_t)(row_off + n0 + n) * K + k0 + 8 * ch) = o; }
    LDS_WAIT(); asm volatile("" ::: "memory");
}
__device__ __forceinline__ void convert_layer(const Frame& F, int l) {
    LAS unsigned char* scr = F.lds + F.wave * 16384;
    constexpr int I_IN = 32 * 272, I_SQ = 32 * 32, I_F1 = 32 * 128, I_F2 = 128 * 32, I_LRU = 64 * 4;
    constexpr int NITEMS = I_IN + 4 * I_SQ + I_F1 + I_F2 + I_LRU;
    const float* w_in = inp<I_WIN>(F) + (size_t)l * D * INW; const float* w_ao = inp<I_WAO>(F) + (size_t)l * D * D; const float* w_lo = inp<I_WLO>(F) + (size_t)l * D * D;
    const float* w_co = inp<I_WCO>(F) + (size_t)l * D * D; const float* w_out = inp<I_WOUT>(F) + (size_t)l * D * D; const float* w_f1 = inp<I_WFF1>(F) + (size_t)l * D * DFF;
    const float* w_f2 = inp<I_WFF2>(F) + (size_t)l * DFF * D; const float* lwa = inp<I_LWA>(F) + (size_t)l * 2 * 16 * 16384; const float* lwx = inp<I_LWX>(F) + (size_t)l * 2 * 16 * 16384;
    for (int it = F.gw; it < NITEMS; it += F.NGW) {
        int r = it;
        if (r < I_IN) { transpose_item(w_in, D, INW, F.WIN(), 0, scr, r, F.lane); continue; } r -= I_IN;
        if (r < I_SQ) { transpose_item(w_ao, D, D, F.WBR(), 0, scr, r, F.lane); continue; } r -= I_SQ;
        if (r < I_SQ) { transpose_item(w_lo, D, D, F.WBR(), D, scr, r, F.lane); continue; } r -= I_SQ;
        if (r < I_SQ) { transpose_item(w_co, D, D, F.WBR(), 2 * D, scr, r, F.lane); continue; } r -= I_SQ;
        if (r < I_SQ) { transpose_item(w_out, D, D, F.WOUT(), 0, scr, r, F.lane); continue; } r -= I_SQ;
        if (r < I_F1) { transpose_item(w_f1, D, DFF, F.WFF1(), 0, scr, r, F.lane); continue; } r -= I_F1;
        if (r < I_F2) { transpose_item(w_f2, DFF, D, F.WFF2(), 0, scr, r, F.lane); continue; } r -= I_F2;
        { const int bi = r >> 2, sub = r & 3, d = bi >> 5, mat = (bi >> 4) & 1, blk = bi & 15;
          const float* src = (mat ? lwx : lwa) + ((size_t)d * 16 + blk) * 16384;
          transpose_item(src, 128, 128, F.WLRU() + (size_t)bi * 16384, 0, scr, sub, F.lane); }
    }
    const float* cw = inp<I_CMWS>(F) + (size_t)l * 16 * 16384;
    for (int i = (F.gw * 64 + F.lane) * 8; i < 16 * 16384; i += F.NGW * 64 * 8) {
        const f32x4 a = *(const f32x4*)(cw + i), b = *(const f32x4*)(cw + i + 4);
        v4u o; o.x = pk2(a.x, a.y); o.y = pk2(a.z, a.w); o.z = pk2(b.x, b.y); o.w = pk2(b.z, b.w);
        *(v4u*)(F.CMW() + i) = o;
    }
}
__device__ __forceinline__ void mod_partials(const Frame& F) {
    LAS float* scr = (LAS float*)(F.lds + F.wave * 16384);
    const float* cctx = inp<I_CCTX>(F); const float* cc = inp<I_C>(F); const float* wmod = inp<I_WMOD>(F);
    for (int it = F.gw; it < DEPTH * 48 * NMODK; it += F.NGW) {
        const int kc = it % NMODK, jb = (it / NMODK) % 48, l = it / (NMODK * 48), k0 = kc * 64;
        for (int e = F.lane; e < NCOND * 64; e += 64) { const int ci = e >> 6, kk = e & 63; const float v = ci == 0 ? cctx[k0 + kk] : cc[(ci - 1) * D + k0 + kk]; scr[e] = v * (1.f / (1.f + __expf(-v))); }
        LDS_WAIT(); asm volatile("" ::: "memory");
        f32x4 acc[NCOND];
#pragma unroll
        for (int ci = 0; ci < NCOND; ++ci) acc[ci] = (f32x4){0.f, 0.f, 0.f, 0.f};
        const float* wp = wmod + ((size_t)l * D + k0) * 12288 + jb * 256 + F.lane * 4;
#pragma unroll
        for (int kb = 0; kb < 64; kb += 16) {
            f32x4 w[16];
#pragma unroll
            for (int kk = 0; kk < 16; ++kk) w[kk] = *(const f32x4*)(wp + (size_t)(kb + kk) * 12288);
#pragma unroll
            for (int kk = 0; kk < 16; ++kk)
#pragma unroll
                for (int ci = 0; ci < NCOND; ++ci) acc[ci] += w[kk] * scr[ci * 64 + kb + kk];
        }
#pragma unroll
        for (int ci = 0; ci < NCOND; ++ci) *(f32x4*)(F.MODP() + (((size_t)kc * DEPTH + l) * NCOND + ci) * 12288 + jb * 256 + F.lane * 4) = acc[ci];
        LDS_WAIT(); asm volatile("" ::: "memory");
    }
}
__device__ __forceinline__ void mod_reduce(const Frame& F) {
    constexpr int NEL = DEPTH * NCOND * 12288;
    for (int i = (F.gw * 64 + F.lane) * 4; i < NEL; i += F.NGW * 64 * 4) {
        const int l = i / (NCOND * 12288), j = i % 12288;
        f32x4 s = *(const f32x4*)(inp<I_BMOD>(F) + (size_t)l * 12288 + j);
#pragma unroll
        for (int kc = 0; kc < NMODK; ++kc) s += *(const f32x4*)(F.MODP() + (size_t)kc * NEL + i);
        *(f32x4*)(F.MOD() + i) = s;
    }
}
__device__ __forceinline__ void rope_table(const Frame& F) {
    if (F.bx == 0) for (int e = F.tid; e < 2048; e += NWAVES * 64) {
        const int pos = e >> 5, f = e & 31; const float inv = exp2f(-(float)f * (13.287712379549449f / 32.f)); float s, c; sincosf((float)pos * inv, &s, &c);
        F.ROPE()[e] = c; F.ROPE()[2048 + e] = s; }
}
template <bool HAS_F, bool HAS_H>
__device__ __forceinline__ void rowlocal_row(const Frame& F, const float* xsrc, float* xdst, const bf16_t* frow, const float* fstat, const float* gate, const float* gpost,
                                             const float* gpre, const float* sc, const float* sh, bf16_t* hrow) {
    f32x4 xv[4][2];
#pragma unroll
    for (int j = 0; j < 4; ++j) { const int e = (j * 64 + F.lane) * 8; xv[j][0] = *(const f32x4*)(xsrc + e); xv[j][1] = *(const f32x4*)(xsrc + e + 4); }
    if (HAS_F) {
        const float st = F.lane < 32 ? fstat[F.lane] : 0.f;
        const float rs = rsqrtf(wave_sum(st) * (1.f / D) + EPS);
#pragma unroll
        for (int j = 0; j < 4; ++j) { const int e = (j * 64 + F.lane) * 8;
            const u32x4 fw = *(const u32x4*)(frow + e);
            const f32x4 g0 = *(const f32x4*)(gate + e), g1 = *(const f32x4*)(gate + e + 4), p0 = *(const f32x4*)(gpost + e), p1 = *(const f32x4*)(gpost + e + 4);
            const f32x4 f0 = {bflo(fw.x), bfhi(fw.x), bflo(fw.y), bfhi(fw.y)}, f1 = {bflo(fw.z), bfhi(fw.z), bflo(fw.w), bfhi(fw.w)};
            xv[j][0] += g0 * (f0 * rs * p0); xv[j][1] += g1 * (f1 * rs * p1); }
    }
#pragma unroll
    for (int j = 0; j < 4; ++j) { const int e = (j * 64 + F.lane) * 8; *(f32x4*)(xdst + e) = xv[j][0]; *(f32x4*)(xdst + e + 4) = xv[j][1]; }
    if (HAS_H) {
        float ss = 0.f;
#pragma unroll
        for (int j = 0; j < 4; ++j)
#pragma unroll
            for (int h = 0; h < 2; ++h) ss += (xv[j][h].x * xv[j][h].x + xv[j][h].y * xv[j][h].y) + (xv[j][h].z * xv[j][h].z + xv[j][h].w * xv[j][h].w);
        const float rs = rsqrtf(wave_sum(ss) * (1.f / D) + EPS);
#pragma unroll
        for (int j = 0; j < 4; ++j) { const int e = (j * 64 + F.lane) * 8;
            f32x4 o[2];
#pragma unroll
            for (int h = 0; h < 2; ++h) { const f32x4 g = *(const f32x4*)(gpre + e + 4 * h), s1 = *(const f32x4*)(sc + e + 4 * h), s0 = *(const f32x4*)(sh + e + 4 * h); o[h] = xv[j][h] * rs * g * (s1 + 1.f) + s0; }
            u32x4 w; w.x = cvt_pk_bf16(o[0].x, o[0].y); w.y = cvt_pk_bf16(o[0].z, o[0].w); w.z = cvt_pk_bf16(o[1].x, o[1].y); w.w = cvt_pk_bf16(o[1].z, o[1].w);
            *(u32x4*)(hrow + e) = w; }
    }
}
__device__ __forceinline__ int cond_of_row(int m) { return m < MP ? 0 : 1 + ((m - MP) >> 11); }
template <int MODE>
__device__ __forceinline__ void rowlocal_phase(const Frame& F, int l) {
    for (int m = F.gw; m < M; m += F.NGW) {
        const int ci = cond_of_row(m);
        float* xrow = F.x() + (size_t)m * D;
        const float* modl = F.MOD() + ((size_t)l * NCOND + ci) * 12288;
        if (MODE == 0) {
            const float* xs = m < MP ? inp<I_XP>(F) + (size_t)m * D : inp<I_XS>(F) + (size_t)(m - MP) * D;
            rowlocal_row<false, true>(F, xs, xrow, nullptr, nullptr, nullptr, nullptr, inp<I_GPM>(F), modl + 1 * D, modl + 0 * D, F.H() + (size_t)m * D);
        } else if (MODE == 1) {
            rowlocal_row<true, true>(F, xrow, xrow, F.Fb() + (size_t)m * D, F.FSTAT() + (size_t)m * 32, modl + 2 * D, inp<I_GPOM>(F) + (size_t)l * D,
                                     inp<I_GPF>(F) + (size_t)l * D, modl + 4 * D, modl + 3 * D, F.H() + (size_t)m * D);
        } else {
            if (l + 1 < DEPTH) { const float* modn = F.MOD() + ((size_t)(l + 1) * NCOND + ci) * 12288;
                rowlocal_row<true, true>(F, xrow, xrow, F.Fb() + (size_t)m * D, F.FSTAT() + (size_t)m * 32, modl + 5 * D, inp<I_GPOF>(F) + (size_t)l * D,
                                         inp<I_GPM>(F) + (size_t)(l + 1) * D, modn + 1 * D, modn + 0 * D, F.H() + (size_t)m * D); }
            else rowlocal_row<true, false>(F, xrow, xrow, F.Fb() + (size_t)m * D, F.FSTAT() + (size_t)m * 32, modl + 5 * D, inp<I_GPOF>(F) + (size_t)l * D, nullptr, nullptr, nullptr, nullptr);
        }
    }
}
__device__ __forceinline__ u32x4 pack8(const f32x4& a, const f32x4& b) { u32x4 w; w.x = cvt_pk_bf16(a[0], a[1]); w.y = cvt_pk_bf16(a[2], a[3]); w.z = cvt_pk_bf16(b[0], b[1]); w.w = cvt_pk_bf16(b[2], b[3]); return w; }
__device__ __forceinline__ f32x4 gelu4(const f32x4& v) { return (f32x4){fgelu(v[0]), fgelu(v[1]), fgelu(v[2]), fgelu(v[3])}; }
__device__ __forceinline__ f32x4 sigm4(const f32x4& v) { return (f32x4){fsigm(v[0]), fsigm(v[1]), fsigm(v[2]), fsigm(v[3])}; }
__device__ __forceinline__ int kv_row(int m) { return m < MP ? m : MP + ((m - MP) >> 11) * 2304 + ((m - MP) & 2047); }
struct EpiIn {
    static constexpr bool PERM = true, AFTER_DRAIN = false;
    bf16_t* Z; bf16_t* VALL; float* new_v; float* cvstat; int layer;
    __device__ __forceinline__ void operator()(const f32x4 (&acc)[2][2][4][2], const Unit& u, int wr, int wc, int fr, int fq) const {
        const int pn = u.pn, row0 = u.pm * 256 + wr * 64 + fr, cl = wc * 32 + 8 * fq;
        if (pn >= 10 && pn < 12) {
            const int colv = (pn - 10) * 256 + cl;
#pragma unroll
            for (int ai = 0; ai < 2; ++ai)
#pragma unroll
                for (int m = 0; m < 4; ++m) { const int row = row0 + ai * 128 + m * 16; bf16_t* dst = VALL + (size_t)kv_row(row) * 512 + colv;
#pragma unroll
                    for (int bj = 0; bj < 2; ++bj) { *(u32x4*)(dst + bj * 128) = pack8(acc[ai][bj][m][0], acc[ai][bj][m][1]);
                        if (row < MP) { float* nv = new_v + ((size_t)((row >> 8) * DEPTH + layer) * 256 + (row & 255)) * 512 + colv + bj * 128; *(f32x4*)nv = acc[ai][bj][m][0]; *(f32x4*)(nv + 4) = acc[ai][bj][m][1]; } } }
            return;
        }
        const int mode = (pn < 20) ? 0 : (pn < 36) ? 1 : (pn < 44) ? 2 : 3;
        const int col0 = pn * 256 + cl;
#pragma unroll
        for (int ai = 0; ai < 2; ++ai)
#pragma unroll
            for (int m = 0; m < 4; ++m) { const int row = row0 + ai * 128 + m * 16; bf16_t* dst = Z + (size_t)row * INW + col0; float ss = 0.f;
#pragma unroll
                for (int bj = 0; bj < 2; ++bj) { f32x4 v0 = acc[ai][bj][m][0], v1 = acc[ai][bj][m][1];
                    if (mode == 1 || mode == 2) { v0 = gelu4(v0); v1 = gelu4(v1); }
                    if (mode == 3) { v0 = sigm4(v0); v1 = sigm4(v1); }
                    if (mode == 2) ss += (v0[0] * v0[0] + v0[1] * v0[1]) + (v0[2] * v0[2] + v0[3] * v0[3]) + (v1[0] * v1[0] + v1[1] * v1[1]) + (v1[2] * v1[2] + v1[3] * v1[3]);
                    *(u32x4*)(dst + bj * 128) = pack8(v0, v1); }
                if (mode == 2) { ss += __shfl_xor(ss, 16); ss += __shfl_xor(ss, 32); if (fq == 0) cvstat[(size_t)row * 32 + (pn - 36) * 4 + wc] = ss; } }
    }
};
struct EpiRelu2 {
    static constexpr bool PERM = true, AFTER_DRAIN = false;
    bf16_t* O; int ldc;
    __device__ __forceinline__ void operator()(const f32x4 (&acc)[2][2][4][2], const Unit& u, int wr, int wc, int fr, int fq) const {
        const int row0 = u.pm * 256 + wr * 64 + fr, col0 = u.pn * 256 + wc * 32 + 8 * fq;
#pragma unroll
        for (int ai = 0; ai < 2; ++ai)
#pragma unroll
            for (int m = 0; m < 4; ++m) { bf16_t* dst = O + (size_t)(row0 + ai * 128 + m * 16) * ldc + col0;
#pragma unroll
                for (int bj = 0; bj < 2; ++bj) { f32x4 v0 = __builtin_elementwise_max(acc[ai][bj][m][0], (f32x4){0.f, 0.f, 0.f, 0.f}), v1 = __builtin_elementwise_max(acc[ai][bj][m][1], (f32x4){0.f, 0.f, 0.f, 0.f});
                    *(u32x4*)(dst + bj * 128) = pack8(v0 * v0, v1 * v1); } }
    }
};
struct EpiF {
    static constexpr bool PERM = true, AFTER_DRAIN = false;
    bf16_t* O; float* stat;
    __device__ __forceinline__ void operator()(const f32x4 (&acc)[2][2][4][2], const Unit& u, int wr, int wc, int fr, int fq) const {
        const int row0 = u.pm * 256 + wr * 64 + fr, col0 = u.pn * 256 + wc * 32 + 8 * fq;
#pragma unroll
        for (int ai = 0; ai < 2; ++ai)
#pragma unroll
            for (int m = 0; m < 4; ++m) { const int row = row0 + ai * 128 + m * 16; bf16_t* dst = O + (size_t)row * D + col0; float ss = 0.f;
#pragma unroll
                for (int bj = 0; bj < 2; ++bj) { const f32x4 v0 = acc[ai][bj][m][0], v1 = acc[ai][bj][m][1];
                    ss += (v0[0] * v0[0] + v0[1] * v0[1]) + (v0[2] * v0[2] + v0[3] * v0[3]) + (v1[0] * v1[0] + v1[1] * v1[1]) + (v1[2] * v1[2] + v1[3] * v1[3]);
                    *(u32x4*)(dst + bj * 128) = pack8(v0, v1); }
                ss += __shfl_xor(ss, 16); ss += __shfl_xor(ss, 32); if (fq == 0) stat[(size_t)row * 32 + u.pn * 4 + wc] = ss; }
    }
};
struct EpiMerge {
    static constexpr bool PERM = true, AFTER_DRAIN = false;
    const bf16_t* Z; float* scr  ; bf16_t* O;
    __device__ __forceinline__ void operator()(const f32x4 (&acc)[2][2][4][2], const Unit& u, int wr, int wc, int fr, int fq) const {
        const int br = u.pn >> 3, pn = u.pn & 7, pm = u.pm - 96 * br;
        const int rl0 = wr * 64 + fr, cl = wc * 32 + 8 * fq;
#pragma unroll
        for (int ai = 0; ai < 2; ++ai)
#pragma unroll
            for (int m = 0; m < 4; ++m) { const int rl = rl0 + ai * 128 + m * 16, row = pm * 256 + rl;
#pragma unroll
                for (int bj = 0; bj < 2; ++bj) { const int c = cl + bj * 128;
                    const u32x4 gw = *(const u32x4*)(Z + (size_t)row * INW + OFF_G + br * D + pn * 256 + c);
                    const f32x4 g0 = {bflo(gw.x), bfhi(gw.x), bflo(gw.y), bfhi(gw.y)}, g1 = {bflo(gw.z), bfhi(gw.z), bflo(gw.w), bfhi(gw.w)};
                    f32x4 v0 = g0 * acc[ai][bj][m][0], v1 = g1 * acc[ai][bj][m][1];
                    float* sp = scr + rl * 256 + c;
                    if (br > 0) { v0 += *(const f32x4*)sp; v1 += *(const f32x4*)(sp + 4); }
                    if (br < 2) { *(f32x4*)sp = v0; *(f32x4*)(sp + 4) = v1; }
                    else *(u32x4*)(O + (size_t)row * D + pn * 256 + c) = pack8(v0, v1); } }
    }
};
struct MergeOrder {
    pg8::StaticOrder so;
    __device__ void init(int G, int c) { so.init(M, D, G, c); }
    __device__ bool next(int i, Unit& u) const { const int br = i % 3; if (!so.next(i / 3, u)) return false; u.pm += 96 * br; u.pn += 8 * br; return true; }
    __device__ __forceinline__ void a_ready(const Unit&) const {}
    __device__ __forceinline__ void done(const Unit&) const {}
};
}
namespace fk {
typedef short bf16x8 __attribute__((ext_vector_type(8)));
__device__ __forceinline__ void prep_row(const Frame& F, int m, int l) {
    const bool sample = m >= MP; int b, t;
    if (!sample) { b = m >> 8; t = m & 255; } else { b = (m - MP) >> 11; t = (m - MP) & 2047; }
    const int kvrow = sample ? MP + b * 2304 + t : m;
    const int lane = F.lane, g8 = lane >> 3, j = lane & 7, axis = g8 & 1, hsel = lane >> 4;
    bf16_t* zrow = F.Z() + (size_t)m * INW;
    const int dA = axis * 64 + 4 * j, dB = dA + 32;
    const f32x4 gqa = *(const f32x4*)(inp<I_GQ>(F) + l * 128 + dA), gqb = *(const f32x4*)(inp<I_GQ>(F) + l * 128 + dB);
    const f32x4 gka = *(const f32x4*)(inp<I_GK>(F) + l * 128 + dA), gkb = *(const f32x4*)(inp<I_GK>(F) + l * 128 + dB);
    f32x4 cs = {1.f, 1.f, 1.f, 1.f}, sn = {0.f, 0.f, 0.f, 0.f};
    if (sample) { const int pos = axis == 0 ? (t >> 6) : (t & 63); cs = *(const f32x4*)(F.ROPE() + pos * 32 + 4 * j); sn = *(const f32x4*)(F.ROPE() + 2048 + pos * 32 + 4 * j); }
#pragma unroll
    for (int pass = 0; pass < 5; ++pass) {
        const bool isq = pass < 4;
        const int base = isq ? OFF_Q + (pass * 4 + hsel) * 128 + dA : OFF_K + hsel * 128 + dA;
        const u32x2 wa = *(const u32x2*)(zrow + base), wb = *(const u32x2*)(zrow + base + 32);
        const f32x4 xa = {bflo(wa.x), bfhi(wa.x), bflo(wa.y), bfhi(wa.y)}, xb = {bflo(wb.x), bfhi(wb.x), bflo(wb.y), bfhi(wb.y)};
        float ss = (xa.x * xa.x + xa.y * xa.y) + (xa.z * xa.z + xa.w * xa.w) + (xb.x * xb.x + xb.y * xb.y) + (xb.z * xb.z + xb.w * xb.w);
        ss += __shfl_xor(ss, 1); ss += __shfl_xor(ss, 2); ss += __shfl_xor(ss, 4); ss += __shfl_xor(ss, 8);
        const float rs = rsqrtf(ss * (1.f / 128.f) + EPS);
        const f32x4 na = xa * rs * (isq ? gqa : gka), nb = xb * rs * (isq ? gqb : gkb);
        const f32x4 ra = na * cs - nb * sn, rb = na * sn + nb * cs;
        u32x2 oa, ob; oa.x = cvt_pk_bf16(ra.x, ra.y); oa.y = cvt_pk_bf16(ra.z, ra.w); ob.x = cvt_pk_bf16(rb.x, rb.y); ob.y = cvt_pk_bf16(rb.z, rb.w);
        if (isq) { *(u32x2*)(zrow + base) = oa; *(u32x2*)(zrow + base + 32) = ob; }
        else {
            bf16_t* kd = F.KALL() + (size_t)kvrow * 512 + hsel * 128 + dA; *(u32x2*)kd = oa; *(u32x2*)(kd + 32) = ob;
            if (!sample) { float* nk = F.new_k() + ((size_t)(b * DEPTH + l) * 256 + t) * 512 + hsel * 128 + dA; *(f32x4*)nk = na; *(f32x4*)(nk + 32) = nb; }
        }
    }
}
__device__ __forceinline__ void prep_phase(const Frame& F, int l) {
    for (int m = F.gw; m < M; m += F.NGW) prep_row(F, m, l);
    for (int it = F.gw; it < 2 * 8 * 256; it += F.NGW) {
        const int which = it >> 11, b = (it >> 8) & 7, p = it & 255;
        const float* src = (which ? inp<I_CV>(F) : inp<I_CK>(F)) + ((size_t)(b * DEPTH + l) * 256 + p) * 512 + F.lane * 8;
        bf16_t* dst = (which ? F.VALL() : F.KALL()) + (size_t)(MP + b * 2304 + 2048 + p) * 512 + F.lane * 8;
        const f32x4 a = *(const f32x4*)src, c = *(const f32x4*)(src + 4);
        *(u32x4*)dst = pack8(a, c);
    }
}
__device__ __forceinline__ int crow(int r, int hi) { return (r & 3) + 8 * (r >> 2) + 4 * hi; }
struct LruCtx {
    bf16x8 bw0[8], bw1[8];
    float bav, bxv, c8;
    bool small;
};
__device__ __forceinline__ void lru_ctx_load(const Frame& F, int l, int blk, LruCtx& X) {
    const int lane = F.lane, wave = F.wave, d = wave >> 2, n0 = (wave & 3) * 32, nl = lane & 31, hi = lane >> 5, C = blk * 128 + n0 + nl;
    const bf16_t* wb0 = F.WLRU() + ((size_t)((d * 2 + 0) * 16 + blk) * 128 + n0 + nl) * 128 + hi * 8;
    const bf16_t* wb1 = F.WLRU() + ((size_t)((d * 2 + 1) * 16 + blk) * 128 + n0 + nl) * 128 + hi * 8;
#pragma unroll
    for (int ks = 0; ks < 8; ++ks) { X.bw0[ks] = *(const bf16x8*)(wb0 + ks * 16); X.bw1[ks] = *(const bf16x8*)(wb1 + ks * 16); }
    X.bav = inp<I_LBA>(F)[(size_t)(l * 2 + d) * D + C]; X.bxv = inp<I_LBX>(F)[(size_t)(l * 2 + d) * D + C];
    const float lam = inp<I_LAM>(F)[(size_t)(l * 2 + d) * D + C];
    X.c8 = -8.f * log1pf(__expf(-lam));
    X.small = __all(X.c8 > -0.5f);
}
template <int PASS>
__device__ __forceinline__ void lru_unit(const Frame& F, int l, int ck, int blk, const LruCtx& X, const float* __restrict__ state_l, float* __restrict__ AGG, const float* __restrict__ cwl, const float* __restrict__ cbl) {
    int tid_ = F.tid; asm volatile("" : "+v"(tid_));
    const int tid = tid_, lane = tid & 63, wave = __builtin_amdgcn_readfirstlane(tid >> 6);
    const int m0 = ck * 64; const bool sample = m0 >= MP;
    int b, t0, T; if (!sample) { b = m0 >> 8; t0 = m0 & 255; T = 256; } else { b = (m0 - MP) >> 11; t0 = (m0 - MP) & 2047; T = 2048; }
    const int C0 = blk * 128;
    LAS unsigned char* lds = F.lds;
    const bf16_t* Zb = F.Z();
    {
        const int c4 = (tid & 31) * 4, r0 = (tid >> 5) * 4;
        f32x4 cw[4];
#pragma unroll
        for (int j = 0; j < 4; ++j) cw[j] = *(const f32x4*)(cwl + (size_t)j * D + C0 + c4);
        const f32x4 cb = *(const f32x4*)(cbl + C0 + c4);
        f32x4 zr[7];
#pragma unroll
        for (int i = 0; i < 7; ++i) {
            const int tt = t0 + r0 + i - 2;
            if (tt >= 0 && tt < T) { const u32x2 z = *(const u32x2*)(Zb + (size_t)(m0 + r0 + i - 2) * INW + OFF_LX + C0 + c4); zr[i] = (f32x4){bflo(z.x), bfhi(z.x), bflo(z.y), bfhi(z.y)}; }
            else zr[i] = (f32x4){0.f, 0.f, 0.f, 0.f};
        }
#pragma unroll
        for (int r = 0; r < 4; ++r) {
            const f32x4 y = cb + zr[r] * cw[0] + zr[r + 1] * cw[1] + zr[r + 2] * cw[2] + zr[r + 3] * cw[3];
            u32x2 o; o.x = cvt_pk_bf16(y.x, y.y); o.y = cvt_pk_bf16(y.z, y.w);
            *(LAS u32x2*)(lds + LRU_XC + (r0 + r) * LRU_XC_PITCH + c4 * 2) = o;
        }
    }
    __syncthreads();
    {
        const int d = wave >> 2, n0 = (wave & 3) * 32, nl = lane & 31, hi = lane >> 5;
        f32x16 acc[2][2];
#pragma unroll
        for (int mat = 0; mat < 2; ++mat)
#pragma unroll
            for (int mt = 0; mt < 2; ++mt)
#pragma unroll
                for (int r = 0; r < 16; ++r) acc[mat][mt][r] = 0.f;
        const LAS unsigned char* ap = lds + LRU_XC + nl * LRU_XC_PITCH + hi * 16;
#pragma unroll
        for (int ks = 0; ks < 8; ++ks) {
            const bf16x8 a0 = *(const LAS bf16x8*)(ap + ks * 32), a1 = *(const LAS bf16x8*)(ap + 32 * LRU_XC_PITCH + ks * 32);
            acc[0][0] = __builtin_amdgcn_mfma_f32_32x32x16_bf16(a0, X.bw0[ks], acc[0][0], 0, 0, 0);
            acc[0][1] = __builtin_amdgcn_mfma_f32_32x32x16_bf16(a1, X.bw0[ks], acc[0][1], 0, 0, 0);
            acc[1][0] = __builtin_amdgcn_mfma_f32_32x32x16_bf16(a0, X.bw1[ks], acc[1][0], 0, 0, 0);
            acc[1][1] = __builtin_amdgcn_mfma_f32_32x32x16_bf16(a1, X.bw1[ks], acc[1][1], 0, 0, 0);
        }
        const int c = n0 + nl;
        LAS float* Ad = (LAS float*)(lds + (d ? LRU_A1 : LRU_A0)); LAS float* Bd = (LAS float*)(lds + (d ? LRU_B1 : LRU_B0));
        const float bav = X.bav, bxv = X.bxv, c8 = X.c8;
        if (X.small) {
#pragma unroll
            for (int mt = 0; mt < 2; ++mt)
#pragma unroll
                for (int r = 0; r < 16; ++r) {
                    const int tl = mt * 32 + crow(r, hi);
                    const float rg = fsigm(acc[0][mt][r] + bav), ig = fsigm(acc[1][mt][r] + bxv);
                    const float la = c8 * rg;
                    float q = 1.f + la * (1.f / 7.f); q = 1.f + la * (1.f / 6.f) * q; q = 1.f + la * 0.2f * q; q = 1.f + la * 0.25f * q; q = 1.f + la * (1.f / 3.f) * q; q = 1.f + la * 0.5f * q;
                    const float e1 = la * q;
                    const float om = fmaxf(-e1 * (2.f + e1), 0.f);
                    const float xcv = bf2f(*(const LAS unsigned short*)(lds + LRU_XC + tl * LRU_XC_PITCH + c * 2));
                    Ad[tl * 128 + c] = 1.f + e1; Bd[tl * 128 + c] = __builtin_amdgcn_sqrtf(om) * ig * xcv;
                }
        } else {
#pragma unroll
            for (int mt = 0; mt < 2; ++mt)
#pragma unroll
                for (int r = 0; r < 16; ++r) {
                    const int tl = mt * 32 + crow(r, hi);
                    const float rg = fsigm(acc[0][mt][r] + bav), ig = fsigm(acc[1][mt][r] + bxv);
                    const float la = c8 * rg, a = __expf(la);
                    const float mult = sqrtf(fmaxf(-expm1f(2.f * la), 0.f));
                    const float xcv = bf2f(*(const LAS unsigned short*)(lds + LRU_XC + tl * LRU_XC_PITCH + c * 2));
                    Ad[tl * 128 + c] = a; Bd[tl * 128 + c] = mult * ig * xcv;
                }
        }
    }
    __syncthreads();
    if (tid < 256) {
        const int d = tid >> 7, c = tid & 127, C = C0 + c;
        const LAS float* Ad = (const LAS float*)(lds + (d ? LRU_A1 : LRU_A0)); LAS float* Bd = (LAS float*)(lds + (d ? LRU_B1 : LRU_B0));
        if (PASS == 1) {
            float h = 0.f, Pp = 1.f;
            if (d == 0) {
#pragma unroll 16
                for (int s = 0; s < 64; ++s) { const float a = Ad[s * 128 + c]; h = a * h + Bd[s * 128 + c]; Pp *= a; }
            } else {
#pragma unroll 16
                for (int s = 0; s < 64; ++s) { const float a = Ad[(63 - s) * 128 + c]; h = a * h + Bd[(63 - s) * 128 + c]; Pp *= a; }
            }
            *(float2*)(AGG + ((size_t)(ck * 2 + d) * D + C) * 2) = make_float2(Pp, h);
        } else {
            const int jc = t0 >> 6, nch = T >> 6;
            float carry = sample ? state_l[((size_t)b * DEPTH * 2 + d) * D + C] : 0.f;
            const float* ag = AGG + ((size_t)((ck - jc) * 2 + d) * D + C) * 2;
            if (nch == 4) {
                float2 pe[4];
#pragma unroll
                for (int jj = 0; jj < 4; ++jj) pe[jj] = *(const float2*)(ag + (size_t)jj * 4 * D);
                if (d == 0) {
#pragma unroll
                    for (int jj = 0; jj < 4; ++jj) if (jj < jc) carry = pe[jj].x * carry + pe[jj].y; }
                else {
#pragma unroll
                    for (int jj = 3; jj >= 0; --jj) if (jj > jc) carry = pe[jj].x * carry + pe[jj].y; }
            } else {
                float2 pe[32];
#pragma unroll
                for (int jj = 0; jj < 32; ++jj) pe[jj] = *(const float2*)(ag + (size_t)jj * 4 * D);
                if (d == 0) {
#pragma unroll
                    for (int jj = 0; jj < 32; ++jj) if (jj < jc) carry = pe[jj].x * carry + pe[jj].y; }
                else {
#pragma unroll
                    for (int jj = 31; jj >= 0; --jj) if (jj > jc) carry = pe[jj].x * carry + pe[jj].y; }
            }
            float h = carry;
            if (d == 0) {
#pragma unroll
                for (int s0 = 0; s0 < 64; s0 += 16) { float av[16], bv[16];
#pragma unroll
                    for (int i = 0; i < 16; ++i) { av[i] = Ad[(s0 + i) * 128 + c]; bv[i] = Bd[(s0 + i) * 128 + c]; }
#pragma unroll
                    for (int i = 0; i < 16; ++i) { h = av[i] * h + bv[i]; bv[i] = h; }
#pragma unroll
                    for (int i = 0; i < 16; ++i) Bd[(s0 + i) * 128 + c] = bv[i]; }
            } else {
#pragma unroll
                for (int s0 = 0; s0 < 64; s0 += 16) { float av[16], bv[16];
#pragma unroll
                    for (int i = 0; i < 16; ++i) { av[i] = Ad[(63 - s0 - i) * 128 + c]; bv[i] = Bd[(63 - s0 - i) * 128 + c]; }
#pragma unroll
                    for (int i = 0; i < 16; ++i) { h = av[i] * h + bv[i]; bv[i] = h; }
#pragma unroll
                    for (int i = 0; i < 16; ++i) Bd[(63 - s0 - i) * 128 + c] = bv[i]; }
            }
            if (!sample && ((d == 0 && jc == nch - 1) || (d == 1 && jc == 0))) F.new_s()[((size_t)(b * DEPTH + l) * 2 + d) * D + C] = h;
        }
    }
    if (PASS == 2) {
        __syncthreads();
        const int row = tid >> 3, c16 = (tid & 7) * 16;
        const LAS float* h0 = (const LAS float*)(lds + LRU_B0) + row * 128 + c16; const LAS float* h1 = (const LAS float*)(lds + LRU_B1) + row * 128 + c16;
        const bf16_t* gp = Zb + (size_t)(m0 + row) * INW + OFF_LG + C0 + c16;
        const u32x4 g0 = *(const u32x4*)gp, g1 = *(const u32x4*)(gp + 8);
        const unsigned gw[8] = {g0.x, g0.y, g0.z, g0.w, g1.x, g1.y, g1.z, g1.w};
        unsigned ow[8];
#pragma unroll
        for (int i = 0; i < 8; ++i) ow[i] = cvt_pk_bf16((h0[2 * i] + h1[2 * i]) * bflo(gw[i]), (h0[2 * i + 1] + h1[2 * i + 1]) * bfhi(gw[i]));
        bf16_t* yp = F.BR() + (size_t)1 * M * D + (size_t)(m0 + row) * D + C0 + c16;
        *(u32x4*)yp = (u32x4){ow[0], ow[1], ow[2], ow[3]}; *(u32x4*)(yp + 8) = (u32x4){ow[4], ow[5], ow[6], ow[7]};
    }
    __syncthreads();
}
template <int PASS>
__device__ __forceinline__ void lru_phase(const Frame& F, int l) {
    LruCtx X; int cur = -1;
    const float* state_l = inp<I_SL>(F) + (size_t)l * 2 * D;
    float* AGG = F.AGG();
    const float* cwl = inp<I_CW>(F) + (size_t)l * 4 * D; const float* cbl = inp<I_CB>(F) + (size_t)l * D;
    for (int u = F.bx; u < 384 * 16; u += F.G) {
        const int blk = u & 15, ck = u >> 4;
        if (blk != cur) { lru_ctx_load(F, l, blk, X); cur = blk; }
        lru_unit<PASS>(F, l, ck, blk, X, state_l, AGG, cwl, cbl);
    }
}
__device__ __forceinline__ void cm_unit(const Frame& F, int l, int cn, int g) {
    const int tid = F.tid, lane = F.lane, wave = F.wave, m0 = cn * 128, C0 = g * 128;
    LAS unsigned char* lds = F.lds;
    LAS float* RS = (LAS float*)(lds + CM_RS);
    if (tid < 128) { const float* st = F.CVSTAT() + (size_t)(m0 + tid) * 32; float s = 0.f;
#pragma unroll
        for (int i = 0; i < 32; i += 4) { const f32x4 v = *(const f32x4*)(st + i); s += (v.x + v.y) + (v.z + v.w); }
        RS[tid] = rsqrtf(s * (1.f / D) + EPS); }
    __syncthreads();
    {
        const int p = tid >> 2, c32 = (tid & 3) * 32; const float rs = RS[p];
        const bf16_t* vp = F.Z() + (size_t)(m0 + p) * INW + OFF_CV + C0 + c32; const float* gp = inp<I_CMG>(F) + (size_t)l * D + C0 + c32;
#pragma unroll
        for (int q4 = 0; q4 < 4; ++q4) {
            const u32x4 w = *(const u32x4*)(vp + q4 * 8); const f32x4 ga = *(const f32x4*)(gp + q4 * 8), gb = *(const f32x4*)(gp + q4 * 8 + 4);
            const float v[8] = {bflo(w.x) * ga.x, bfhi(w.x) * ga.y, bflo(w.y) * ga.z, bfhi(w.y) * ga.w, bflo(w.z) * gb.x, bfhi(w.z) * gb.y, bflo(w.w) * gb.z, bfhi(w.w) * gb.w};
#pragma unroll
            for (int i = 0; i < 8; ++i) *(LAS unsigned short*)(lds + CM_VT + (c32 + q4 * 8 + i) * CM_VT_PITCH + p * 2) = (unsigned short)(cvt_pk_bf16(v[i] * rs, 0.f) & 0xffffu);
        }
    }
    __syncthreads();
    {
        const int mt = wave >> 1, nt0 = (wave & 1) * 2, xl = lane & 31, hi = lane >> 5;
        f32x16 acc[2];
#pragma unroll
        for (int r = 0; r < 16; ++r) { acc[0][r] = 0.f; acc[1][r] = 0.f; }
        const bf16_t* wp = F.CMW() + ((size_t)g * 128 + mt * 32 + xl) * 128 + hi * 8;
        const LAS unsigned char* bp = lds + CM_VT + (nt0 * 32 + xl) * CM_VT_PITCH + hi * 16;
#pragma unroll
        for (int ks = 0; ks < 8; ++ks) {
            const bf16x8 a = *(const bf16x8*)(wp + ks * 16);
            const bf16x8 b0 = *(const LAS bf16x8*)(bp + ks * 32), b1 = *(const LAS bf16x8*)(bp + 32 * CM_VT_PITCH + ks * 32);
            acc[0] = __builtin_amdgcn_mfma_f32_32x32x16_bf16(a, b0, acc[0], 0, 0, 0);
            acc[1] = __builtin_amdgcn_mfma_f32_32x32x16_bf16(a, b1, acc[1], 0, 0, 0);
        }
        const float* bs = inp<I_CMBS>(F) + ((size_t)l * 16 + g) * 128;
#pragma unroll
        for (int nt = 0; nt < 2; ++nt)
#pragma unroll
            for (int r = 0; r < 16; ++r) {
                const int q = mt * 32 + crow(r, hi), c = (nt0 + nt) * 32 + xl;
                const float u = bf2f(F.Z()[(size_t)(m0 + q) * INW + OFF_CU + C0 + c]);
                const float o = u * (acc[nt][r] + bs[q]);
                F.BR()[(size_t)2 * M * D + (size_t)(m0 + q) * D + C0 + c] = (bf16_t)(cvt_pk_bf16(o, 0.f) & 0xffffu);
            }
    }
    __syncthreads();
}
__device__ __forceinline__ void attn_phase(const Frame& F) {
    char* lds = (char*)F.lds;
    const att::bf16* Z = (const att::bf16*)F.Z(); const att::bf16* K = (const att::bf16*)F.KALL(); const att::bf16* V = (const att::bf16*)F.VALL(); att::bf16* O = (att::bf16*)F.BR();
    for (int id = F.bx; id < 1536; id += F.G) {
        size_t qrow, kvrow; int h, nkeys;
        if (id < 1024) { const int qb = id & 7, b = id >> 7; h = (id >> 3) & 15; qrow = (size_t)MP + (size_t)b * 2048 + qb * 256; kvrow = (size_t)MP + (size_t)b * 2304; nkeys = 2304; }
        else { const int id2 = id - 1024, b = id2 >> 4; h = id2 & 15; qrow = (size_t)b * 256; kvrow = qrow; nkeys = 256; }
        att::attn_dense_body<att::bf16>(Z + qrow * INW + OFF_Q + h * 128, K + kvrow * 512 + (h >> 2) * 128, V + kvrow * 512 + (h >> 2) * 128, O + qrow * D + h * 128, nkeys, lds);
    }
    __syncthreads();
}
}
#ifndef REP_G
#define REP_G 1
#endif
#ifndef REP_A
#define REP_A 1
#endif
#ifndef REP_L
#define REP_L 1
#endif
#ifndef REP_V
#define REP_V 1
#endif
#ifndef REP_C
#define REP_C 1
#endif
namespace fk {
#if REP_G > 1
template <class Base> struct RepOrder {
    Base b; int n;
    __device__ void init_n() { Unit u; n = 0; while (b.next(n, u)) ++n; }
    __device__ bool next(int i, Unit& u) const { if (i >= 2 * n) return false; return b.next(i >= n ? i - n : i, u); }
    __device__ __forceinline__ void a_ready(const Unit&) const {}
    __device__ __forceinline__ void done(const Unit&) const {}
};
#define GEMM_CALL(EPI, ORD, g, S, E) do { RepOrder<ORD> RS_; RS_.b = S; RS_.init_n(); pg8::gemm_phase<EPI, RepOrder<ORD>, true, true>(P.lds, g, RS_, E); } while (0)
#else
#define GEMM_CALL(EPI, ORD, g, S, E) pg8::gemm_phase<EPI, ORD, true, true>(P.lds, g, S, E)
#endif
__global__ void __launch_bounds__(NWAVES * 64, 2) mega(Params p) {
    extern __shared__ __attribute__((aligned(16))) unsigned char lds_raw[];
    Frame F;
    F.lds = (LAS unsigned char*)lds_raw;
    F.tid = threadIdx.x; F.lane = F.tid & 63; F.wave = __builtin_amdgcn_readfirstlane(F.tid >> 6);
    F.G = gridDim.x; { const int bx = blockIdx.x; F.vcu = (F.G % 8 == 0) ? (bx % 8) * (F.G / 8) + bx / 8 : bx; }
    F.gw = F.vcu * NWAVES + F.wave; F.NGW = F.G * NWAVES; F.bx = blockIdx.x;
    F.out = p.out; F.ws = p.ws; F.ka = (kaptr_t)__builtin_amdgcn_kernarg_segment_ptr();
    unsigned char* ws = p.ws;
    volatile LAS unsigned* MISC = (volatile LAS unsigned*)(F.lds + MISC_OFF);
    for (int u = F.tid; u < (LDS_BYTES - MISC_OFF) / 4; u += NWAVES * 64) ((LAS unsigned*)(F.lds + MISC_OFF))[u] = 0u;
    __syncthreads();
    unsigned* barw = (unsigned*)(ws + WS_CTL) + CW_BAR + p.li * XCD_BAR_WORDS;
    XcdBarrier bar = xcd_barrier_post(barw, MISC + 8);
    const int lo = p.ph_lo, hi = p.ph_hi;
#define IN_PH(k) (lo <= (k) && (k) < hi)
#define SEAM(k) do { if ((k) + 1 < hi) xcd_barrier(bar); } while (0)

    if (IN_PH(0)) { const Frame P = phase_frame(F);
convert_layer(P, 0); mod_partials(P); rope_table(P);
#if REP_V > 1
        __syncthreads(); convert_layer(P, 0); mod_partials(P);
#endif
 SEAM(0); }
    if (IN_PH(1)) { const Frame P = phase_frame(F); mod_reduce(P); SEAM(1); }
    if (IN_PH(2)) { const Frame P = phase_frame(F); rowlocal_phase<0>(P, 0); SEAM(2); }
    for (int l = 0; l < DEPTH; ++l) {
        const int pb = 3 + 9 * l;
        if (IN_PH(pb + 0)) { const Frame P = phase_frame(F);
            pg8::Gemm g{P.H(), P.WIN(), M, INW, D}; pg8::StaticOrder S; S.init(M, INW, P.G, P.bx);
            EpiIn E{P.Z(), P.VALL(), P.new_v(), P.CVSTAT(), l};

GEMM_CALL(EpiIn, pg8::StaticOrder, g, S, E);

            SEAM(pb + 0);
        }
        if (IN_PH(pb + 1)) { const Frame P = phase_frame(F);

prep_phase(P, l);

            __syncthreads();

lru_phase<1>(P, l);
#if REP_L > 1
            lru_phase<1>(P, l);
#endif


for (int u = P.bx; u < 192 * 16; u += P.G) cm_unit(P, l, u >> 4, u & 15);
#if REP_C > 1
            for (int u = P.bx; u < 192 * 16; u += P.G) cm_unit(P, l, u >> 4, u & 15);
#endif

            SEAM(pb + 1);
        }
        if (IN_PH(pb + 2)) { const Frame P = phase_frame(F);

attn_phase(P);
#if REP_A > 1
            attn_phase(P);
#endif


lru_phase<2>(P, l);
#if REP_L > 1
            lru_phase<2>(P, l);
#endif

            SEAM(pb + 2);
        }
        if (IN_PH(pb + 3)) { const Frame P = phase_frame(F);
            pg8::Gemm g{P.BR(), P.WBR(), 3 * M, 3 * D, D}; MergeOrder S; S.init(P.G, P.bx);
            EpiMerge E{P.Z(), P.MSCR() + (size_t)P.bx * 65536, P.H()};

GEMM_CALL(EpiMerge, MergeOrder, g, S, E);

            SEAM(pb + 3);
        }
        if (IN_PH(pb + 4)) { const Frame P = phase_frame(F);
            pg8::Gemm g{P.H(), P.WOUT(), M, D, D}; pg8::StaticOrder S; S.init(M, D, P.G, P.bx);
            EpiF E{P.Fb(), P.FSTAT()};

GEMM_CALL(EpiF, pg8::StaticOrder, g, S, E);
            SEAM(pb + 4);

        }
        if (IN_PH(pb + 5)) { const Frame P = phase_frame(F);
rowlocal_phase<1>(P, l);
 SEAM(pb + 5); }
        if (IN_PH(pb + 6)) { const Frame P = phase_frame(F);
            pg8::Gemm g{P.H(), P.WFF1(), M, DFF, D}; pg8::StaticOrder S; S.init(M, DFF, P.G, P.bx);
            EpiRelu2 E{P.FFH(), DFF};

GEMM_CALL(EpiRelu2, pg8::StaticOrder, g, S, E);

            SEAM(pb + 6);
        }
        if (IN_PH(pb + 7)) { const Frame P = phase_frame(F);
            pg8::Gemm g{P.FFH(), P.WFF2(), M, D, DFF}; pg8::StaticOrder S; S.init(M, D, P.G, P.bx);
            EpiF E{P.Fb(), P.FSTAT()};

GEMM_CALL(EpiF, pg8::StaticOrder, g, S, E);
            SEAM(pb + 7);

        }
        if (IN_PH(pb + 8)) { const Frame P = phase_frame(F);

rowlocal_phase<2>(P, l);


if (l + 1 < DEPTH) { __syncthreads(); convert_layer(P, l + 1); }
#if REP_V > 1
            if (l + 1 < DEPTH) { __syncthreads(); convert_layer(P, l + 1); }
#endif

            SEAM(pb + 8);
        }
    }
#undef IN_PH
#undef SEAM
}
}
extern "C" void kernel_launch(void* const* d_in, const int* in_sizes, int n_in, void* d_out, int out_size, void* d_ws, size_t ws_size, hipStream_t stream) {
    static int grid = 0;
    if (grid == 0) {
        if (n_in != 32 || out_size != 84410368 || ws_size < fk::WS_END) { fprintf(stderr, "kernel_launch: unexpected shapes: n_in %d out %d ws %zu (need %zu)\n", n_in, out_size, ws_size, (size_t)fk::WS_END); grid = -1; return; }
        int dev = 0, cus = 0;
        if (hipGetDevice(&dev) != hipSuccess || hipDeviceGetAttribute(&cus, hipDeviceAttributeMultiprocessorCount, dev) != hipSuccess) { grid = -1; return; }
        if (hipFuncSetAttribute((const void*)fk::mega, hipFuncAttributeMaxDynamicSharedMemorySize, fk::LDS_BYTES) != hipSuccess) { fprintf(stderr, "kernel_launch: hipFuncSetAttribute failed\n"); grid = -1; return; }
        int per_cu = 0;
        if (hipOccupancyMaxActiveBlocksPerMultiprocessor(&per_cu, (const void*)fk::mega, fk::NWAVES * 64, fk::LDS_BYTES) != hipSuccess || per_cu < 1) fprintf(stderr, "kernel_launch: occupancy query says %d blocks per CU\n", per_cu);
        (void)hipGetLastError();
        grid = cus < 256 ? cus : 256;
    }
    if (grid < 0) return;
    (void)hipMemsetAsync((char*)d_ws + fk::WS_CTL, 0, fk::CTL_ZERO_BYTES, stream);
    fk::Params p{};
    for (int i = 0; i < 32; ++i) p.in[i] = (const float*)d_in[i];
    p.out = (float*)d_out; p.ws = (unsigned char*)d_ws; p.ph_lo = 0; p.ph_hi = fk::NPHASE; p.li = 0; p.pad = 0;
    hipLaunchKernelGGL(fk::mega, dim3(grid), dim3(fk::NWAVES * 64), fk::LDS_BYTES, stream, p);
}
```

```cpp
#include <hip/hip_runtime.h>
#include <hip/hip_bf16.h>
#include <cstdio>
#include <cstdint>
namespace pg8 {
#define PG8_LAS __attribute__((address_space(3)))
typedef unsigned short bf16_t;
typedef short bf16x8 __attribute__((ext_vector_type(8)));
typedef float f32x4 __attribute__((ext_vector_type(4)));
typedef unsigned u32x4 __attribute__((ext_vector_type(4)));
constexpr int BM = 256, BK = 64, HALF = 128, HTB = HALF * BK * 2  , STAGE_BYTES = 8 * HTB, NXCD = 8, WGM = 8;

__host__ __device__ __forceinline__ int lds_byte(int r, int c) { const int st = (r >> 4) * 2 + (c >> 5), rr = r & 15, cc = c & 31, ob = rr * 64 + cc * 2; return st * 1024 + (ob ^ (((ob >> 9) & 1) << 5)); }
__host__ __device__ __forceinline__ void stage_rc(int b, int& R, int& C) { const int st = b / 1024, sb = b % 1024, swz = sb ^ (((sb >> 9) & 1) << 5); R = (st >> 1) * 16 + swz / 64; C = (st & 1) * 32 + (swz % 64) / 2; }
__host__ __device__ __forceinline__ int perm32(int rho) { const int n = rho >> 4, i = rho & 15; return 8 * (i >> 2) + 4 * n + (i & 3); }

struct Unit { int pm, pn; };
struct Gemm { const bf16_t* A; const bf16_t* Bt; int M, N, K; };

struct StaticOrder {
    int nM, nN, nwg, G, c;
    __host__ __device__ void init(int M, int N, int G_, int c_) { nM = M / BM; nN = N / BM; nwg = nM * nN; G = G_; c = c_; }
    __host__ __device__ bool next(int i, Unit& u) const {
        const long L = (long)i * G + c; if (L >= nwg) return false;
        int wgid = (int)L; { const int q = nwg / NXCD, r = nwg % NXCD, xcd = wgid % NXCD, off = wgid / NXCD; wgid = (xcd < r ? xcd * (q + 1) : r * (q + 1) + (xcd - r) * q) + off; }
        const int nig = WGM * nN, gid = wgid / nig, fm = gid * WGM, gsz = (nM - fm) < WGM ? (nM - fm) : WGM;
        u.pm = fm + ((wgid % nig) % gsz); u.pn = (wgid % nig) / gsz; return true;
    }
    __device__ __forceinline__ void a_ready(const Unit&) const {}
    __device__ __forceinline__ void done(const Unit&) const {}
};
__device__ __forceinline__ unsigned cvt_pk_bf16(float lo, float hi) { unsigned r; asm volatile("v_cvt_pk_bf16_f32 %0, %1, %2" : "=v"(r) : "v"(lo), "v"(hi)); return r; }
template <class Epi, class Sched, bool ALIGN_EPI = false, bool SP2 = false>
__device__ __forceinline__ void gemm_phase(PG8_LAS unsigned char* lds, const Gemm g, const Sched& S, const Epi& E) {
    int tid_ = threadIdx.x; asm volatile("" : "+v"(tid_));
    const int tid = tid_, wid = __builtin_amdgcn_readfirstlane(tid >> 6), lane = tid & 63, wr = wid >> 2, wc = wid & 3, fr = lane & 15, fq = lane >> 4;
    const int K = g.K, nt = K / BK;
    unsigned voffA[2], voffB[2];
#pragma unroll
    for (int i = 0; i < 2; ++i) { int R, C; stage_rc(tid * 16 + i * 8192, R, C); const int Rb = Epi::PERM ? ((R & ~31) + perm32(R & 31)) : R;
        voffA[i] = (unsigned)(R * K + C) * 2u; voffB[i] = (unsigned)(Rb * K + C) * 2u; }
    const size_t kstep = (size_t)(BK * 2);
    const size_t hstep = (size_t)HALF * K * 2;
    const size_t tstep = 2 * hstep;
    const unsigned ldsw = (unsigned)wid * 1024u;
    const int aoff = lds_byte(wr * 64 + fr, fq * 8), boff = lds_byte(wc * 32 + fr, fq * 8);
#define PG8_SA(b, h) (((b) * 2 + (h)) * HTB)
#define PG8_SB(b, h) ((4 + (b) * 2 + (h)) * HTB)
#define PG8_STAGE(bufoff, gbase, voff) do { _Pragma("unroll") for (int _i = 0; _i < 2; ++_i) \
        __builtin_amdgcn_global_load_lds((const unsigned*)((const char*)(gbase) + (voff)[_i]), (PG8_LAS unsigned*)(lds + (bufoff) + ldsw + _i * 8192), 16, 0, 0); } while (0)
#define PG8_LDA(dst, b, h) do { _Pragma("unroll") for (int m = 0; m < 4; ++m) _Pragma("unroll") for (int k = 0; k < 2; ++k) dst[m][k] = *(const PG8_LAS bf16x8*)(lds + PG8_SA(b, h) + aoff + m * 2048 + k * 1024); } while (0)
#define PG8_LDB(dst, b, h) do { _Pragma("unroll") for (int n = 0; n < 2; ++n) _Pragma("unroll") for (int k = 0; k < 2; ++k) dst[n][k] = *(const PG8_LAS bf16x8*)(lds + PG8_SB(b, h) + boff + n * 2048 + k * 1024); } while (0)
#define PG8_MMA(ai, bj, At, Bt) do { __builtin_amdgcn_s_setprio(1); _Pragma("unroll") for (int m = 0; m < 4; ++m) _Pragma("unroll") for (int n = 0; n < 2; ++n) _Pragma("unroll") for (int k = 0; k < 2; ++k) \
        acc[ai][bj][m][n] = __builtin_amdgcn_mfma_f32_16x16x32_bf16(Bt[n][k], At[m][k], acc[ai][bj][m][n], 0, 0, 0); __builtin_amdgcn_s_setprio(0); } while (0)
#define PG8_WAIT_V(n) asm volatile("s_waitcnt vmcnt(" #n ")" ::: "memory")
#define PG8_WAIT_L(n) asm volatile("s_waitcnt lgkmcnt(" #n ")" ::: "memory")
#define PG8_BAR __builtin_amdgcn_s_barrier()
#define PG8_SCHED __builtin_amdgcn_sched_barrier(0)
    Unit cur, nxt; int ui = 0;
    if (!S.next(0, cur)) return;
    f32x4 acc[2][2][4][2];
#pragma unroll
    for (int a = 0; a < 2; ++a)
#pragma unroll
        for (int b = 0; b < 2; ++b)
#pragma unroll
            for (int m = 0; m < 4; ++m)
#pragma unroll
                for (int n = 0; n < 2; ++n) acc[a][b][m][n] = (f32x4){0.f, 0.f, 0.f, 0.f};
    bf16x8 At[4][2], B0[2][2], B1[2][2];
    const char* cA = (const char*)g.A + (size_t)cur.pm * tstep; const char* cB = (const char*)g.Bt + (size_t)cur.pn * tstep;
    S.a_ready(cur);
    if constexpr (SP2) {
        PG8_STAGE(PG8_SB(0, 0), cB, voffB); PG8_STAGE(PG8_SB(0, 1), cB + hstep, voffB); PG8_STAGE(PG8_SA(0, 0), cA, voffA); PG8_STAGE(PG8_SA(0, 1), cA + hstep, voffA);
        if (wr == 1) PG8_BAR;
        PG8_WAIT_V(2); PG8_BAR;
        PG8_STAGE(PG8_SB(1, 0), cB + kstep, voffB); PG8_STAGE(PG8_SA(1, 0), cA + kstep, voffA); PG8_STAGE(PG8_SB(1, 1), cB + hstep + kstep, voffB);
        PG8_WAIT_V(6); PG8_BAR;
    } else {
        PG8_STAGE(PG8_SB(0, 0), cB, voffB); PG8_STAGE(PG8_SA(0, 0), cA, voffA); PG8_STAGE(PG8_SB(0, 1), cB + hstep, voffB); PG8_STAGE(PG8_SA(0, 1), cA + hstep, voffA);
        if (wr == 1) PG8_BAR;
        PG8_WAIT_V(4); PG8_BAR;
        PG8_STAGE(PG8_SB(1, 0), cB + kstep, voffB); PG8_STAGE(PG8_SA(1, 0), cA + kstep, voffA); PG8_STAGE(PG8_SB(1, 1), cB + hstep + kstep, voffB);
        PG8_WAIT_V(6); PG8_BAR;
    }
    for (;;) {
        const bool has_next = S.next(ui + 1, nxt);
        const char* nA = has_next ? (const char*)g.A + (size_t)nxt.pm * tstep : cA; const char* nB = has_next ? (const char*)g.Bt + (size_t)nxt.pn * tstep : cB;
        for (int t = 0; t < nt; t += 2) {
            const bool last = (t == nt - 2);
            const char* a1 = cA + (size_t)(t + 1) * kstep;
            const char* a2 = last ? nA : cA + (size_t)(t + 2) * kstep; const char* b2 = last ? nB : cB + (size_t)(t + 2) * kstep;
            const char* a3 = a2 + kstep; const char* b3 = b2 + kstep;
            if (last && has_next) S.a_ready(nxt);
            if constexpr (SP2) {
            PG8_LDB(B0, 0, 0); PG8_LDB(B1, 0, 1); PG8_SCHED; PG8_LDA(At, 0, 0); PG8_STAGE(PG8_SA(1, 1), a1 + hstep, voffA);
            PG8_WAIT_V(8); PG8_WAIT_L(0); PG8_BAR; PG8_MMA(0, 0, At, B0); PG8_MMA(0, 1, At, B1); PG8_BAR; PG8_SCHED;
            PG8_LDA(At, 0, 1); PG8_STAGE(PG8_SB(0, 0), b2, voffB); PG8_STAGE(PG8_SB(0, 1), b2 + hstep, voffB); PG8_STAGE(PG8_SA(0, 0), a2, voffA);
            PG8_WAIT_V(8); PG8_WAIT_L(0); PG8_BAR; PG8_MMA(1, 0, At, B0); PG8_MMA(1, 1, At, B1); PG8_BAR; PG8_SCHED;
            PG8_LDB(B0, 1, 0); PG8_LDB(B1, 1, 1); PG8_SCHED; PG8_LDA(At, 1, 0); PG8_STAGE(PG8_SA(0, 1), a2 + hstep, voffA);
            PG8_WAIT_V(8); PG8_WAIT_L(0); PG8_BAR; PG8_MMA(0, 0, At, B0); PG8_MMA(0, 1, At, B1); PG8_BAR; PG8_SCHED;
            PG8_LDA(At, 1, 1); PG8_STAGE(PG8_SB(1, 0), b3, voffB); PG8_STAGE(PG8_SB(1, 1), b3 + hstep, voffB); PG8_STAGE(PG8_SA(1, 0), a3, voffA);
            PG8_WAIT_V(8); PG8_WAIT_L(0); PG8_BAR; PG8_MMA(1, 0, At, B0); PG8_MMA(1, 1, At, B1); PG8_BAR; PG8_SCHED;
            } else {
            PG8_LDB(B0, 0, 0); PG8_SCHED; PG8_LDA(At, 0, 0); PG8_STAGE(PG8_SA(1, 1), a1 + hstep, voffA);
            PG8_WAIT_L(8); PG8_BAR; PG8_WAIT_L(0); PG8_MMA(0, 0, At, B0); PG8_BAR; PG8_SCHED;
            PG8_LDB(B1, 0, 1); PG8_STAGE(PG8_SB(0, 0), b2, voffB);
            PG8_BAR; PG8_WAIT_L(0); PG8_MMA(0, 1, At, B1); PG8_BAR;
            PG8_LDA(At, 0, 1); PG8_STAGE(PG8_SA(0, 0), a2, voffA);
            PG8_BAR; PG8_WAIT_L(0); PG8_MMA(1, 0, At, B0); PG8_BAR; PG8_SCHED;
            PG8_STAGE(PG8_SB(0, 1), b2 + hstep, voffB);
            PG8_WAIT_V(6); PG8_BAR; PG8_MMA(1, 1, At, B1); PG8_BAR;
            PG8_LDB(B0, 1, 0); PG8_SCHED; PG8_LDA(At, 1, 0); PG8_STAGE(PG8_SA(0, 1), a2 + hstep, voffA);
            PG8_WAIT_L(8); PG8_BAR; PG8_WAIT_L(0); PG8_MMA(0, 0, At, B0); PG8_BAR; PG8_SCHED;
            PG8_LDB(B1, 1, 1); PG8_STAGE(PG8_SB(1, 0), b3, voffB);
            PG8_BAR; PG8_WAIT_L(0); PG8_MMA(0, 1, At, B1); PG8_BAR;
            PG8_LDA(At, 1, 1); PG8_STAGE(PG8_SA(1, 0), a3, voffA);
            PG8_BAR; PG8_WAIT_L(0); PG8_MMA(1, 0, At, B0); PG8_BAR; PG8_SCHED;
            PG8_STAGE(PG8_SB(1, 1), b3 + hstep, voffB);
            PG8_WAIT_V(6); PG8_BAR; PG8_MMA(1, 1, At, B1); PG8_BAR;
            }
        }
        if constexpr (ALIGN_EPI) { if (wr == 0) PG8_BAR; }
        if constexpr (!Epi::AFTER_DRAIN) { E(acc, cur, wr, wc, fr, fq); S.done(cur); }
        if (!has_next) break;
#pragma unroll
        for (int a = 0; a < 2; ++a)
#pragma unroll
            for (int b = 0; b < 2; ++b)
#pragma unroll
                for (int m = 0; m < 4; ++m)
#pragma unroll
                    for (int n = 0; n < 2; ++n) acc[a][b][m][n] = (f32x4){0.f, 0.f, 0.f, 0.f};
        cur = nxt; cA = nA; cB = nB; ++ui;
        if constexpr (ALIGN_EPI) { if (wr == 1) PG8_BAR; }
    }
    PG8_WAIT_V(0);
    if constexpr (!ALIGN_EPI) { if (wr == 0) PG8_BAR; }
    PG8_BAR;
    if constexpr (Epi::AFTER_DRAIN) { E.fused(acc, cur, wr, wc, fr, fq, lds, wid, lane); S.done(cur); }
#undef PG8_SA
#undef PG8_SB
#undef PG8_STAGE
#undef PG8_LDA
#undef PG8_LDB
#undef PG8_MMA
#undef PG8_WAIT_V
#undef PG8_WAIT_L
#undef PG8_BAR
#undef PG8_SCHED
}
}
#define GAS __attribute__((address_space(1)))
#define LAS __attribute__((address_space(3)))
typedef unsigned short bf16;
typedef unsigned v4u __attribute__((ext_vector_type(4)));
typedef float f32x4 __attribute__((ext_vector_type(4)));
typedef short bf16x8 __attribute__((ext_vector_type(8)));
typedef GAS unsigned gu32;
typedef GAS unsigned long long gu64;
#define RLX_AGENT __ATOMIC_RELAXED, __HIP_MEMORY_SCOPE_AGENT
#define LDS_WAIT() asm volatile("s_waitcnt lgkmcnt(0)" ::: "memory")
#define VM_WAIT() asm volatile("s_waitcnt vmcnt(0)" ::: "memory")
__device__ __forceinline__ unsigned long long rt() { return __builtin_amdgcn_s_memrealtime(); }
__device__ __forceinline__ unsigned f2bf(float f) { unsigned u = __builtin_bit_cast(unsigned, f); return (u + 0x7fffu + ((u >> 16) & 1u)) >> 16; }
__device__ __forceinline__ unsigned pk2(float lo, float hi) { return f2bf(lo) | (f2bf(hi) << 16); }

#define XB_TMO      128
#define XB_XCNT(j)  (256  + 64 * (j))
#define XB_XSUB(j)  (1280 + 64 * (j))
#define XB_XGEN(j)  (2304 + 64 * (j))
#define XB_TOP      3328
#define XB_TOPGEN   3392
#define XCD_BAR_WORDS 3456
#define XB_SPIN_CAP (1u << 18)

__device__ __forceinline__ unsigned xb_ld(unsigned* p)              { return __hip_atomic_load(p, __ATOMIC_RELAXED, __HIP_MEMORY_SCOPE_AGENT); }
__device__ __forceinline__ unsigned xb_add(unsigned* p, unsigned v) { return __hip_atomic_fetch_add(p, v, __ATOMIC_RELAXED, __HIP_MEMORY_SCOPE_AGENT); }
__device__ __forceinline__ unsigned xb_xcc_id() { return (unsigned)__builtin_amdgcn_s_getreg((3 << 11) | 20) & 0xFu; }
#define XB_SPIN(cond, bar) do { unsigned _sp = 0; while (cond) { __builtin_amdgcn_s_sleep(1); \
    if ((++_sp & 255u) == 0u) { if (xb_ld(&(bar)[XB_TMO])) break; if (_sp > XB_SPIN_CAP) { atomicAdd(&(bar)[XB_TMO], 1u); break; } } } } while (0)

struct XcdBarrier {
    unsigned* bar; unsigned x;
    volatile LAS unsigned* st;
};

__device__ __forceinline__ XcdBarrier xcd_barrier_post(unsigned* bar, volatile LAS unsigned* st) {
    XcdBarrier b; b.bar = bar; b.x = xb_xcc_id(); b.st = st;
    if (threadIdx.x == 0) (void)xb_add(&bar[XB_XCNT(b.x)], 1u);
    return b;
}
__device__ __forceinline__ void xcd_barrier_complete(unsigned* bar, unsigned x, unsigned& nloc, unsigned& nx) {
    const unsigned G = gridDim.x * gridDim.y * gridDim.z;
    unsigned sum, cnt, mine, sp = 0u;
    for (;;) {
        sum = 0u; cnt = 0u; mine = 0u;
#pragma unroll
        for (unsigned j = 0; j < 16; ++j) { const unsigned c = xb_ld(&bar[XB_XCNT(j)]); sum += c; cnt += (c > 0u) ? 1u : 0u; mine = (j == x) ? c : mine; }
        if (sum == G) break;
        __builtin_amdgcn_s_sleep(1);
        if ((++sp & 255u) == 0u) { if (xb_ld(&bar[XB_TMO])) break; if (sp > XB_SPIN_CAP) { atomicAdd(&bar[XB_TMO], 1u); break; } }
    }
    nloc = mine > 0u ? mine : 1u; nx = cnt > 0u ? cnt : 1u;
}

__device__ __forceinline__ void xcd_barrier(const XcdBarrier& b) {
    asm volatile("s_waitcnt vmcnt(0)" ::: "memory");
    __syncthreads();
    if (threadIdx.x == 0) {
        unsigned* bar = b.bar;
        __builtin_amdgcn_s_waitcnt(0);
        unsigned nloc = b.st[0], nx = b.st[1];
        if (nloc == 0u) { xcd_barrier_complete(bar, b.x, nloc, nx); b.st[0] = nloc; b.st[1] = nx; }
        const unsigned old = xb_add(&bar[XB_XSUB(b.x)], 1u);
        const unsigned gen = old / nloc;
        if (old + 1u == (gen + 1u) * nloc) {
            __builtin_amdgcn_fence(__ATOMIC_RELEASE, "agent");
            asm volatile("s_waitcnt vmcnt(0)" ::: "memory");
            const unsigned og = xb_add(&bar[XB_TOP], 1u);
            const unsigned tg = og / nx;
            if (og + 1u == (tg + 1u) * nx) xb_add(&bar[XB_TOPGEN], 1u);
            else XB_SPIN(xb_ld(&bar[XB_TOPGEN]) == tg, bar);
            __builtin_amdgcn_fence(__ATOMIC_ACQUIRE, "agent");
            xb_add(&bar[XB_XGEN(b.x)], 1u);
            asm volatile("s_waitcnt vmcnt(0)" ::: "memory");
        } else {
            XB_SPIN(xb_ld(&bar[XB_XGEN(b.x)]) == gen, bar);
            __builtin_amdgcn_fence(__ATOMIC_ACQUIRE, "agent");
            asm volatile("s_waitcnt vmcnt(0)" ::: "memory");
        }
    }
    __syncthreads();
}
namespace att {
constexpr int   D = 128, NW = 8, QBLK = 32, KVBLK = 64;
constexpr float SCALE = 0.088388347648318440f;
constexpr float THR = 8.f;
constexpr int SDEPTH = 2;
constexpr int LDQ = 17408, LDK = 512, LDO = 2048;
constexpr size_t SHM_V = KVBLK * D * 2, SHM_K = KVBLK * D * 2, SHM_ATTN = 2 * SHM_V + 2 * SHM_K + NW * 64 * 4;
using bf16 = __hip_bfloat16;
using bf16x8 = __attribute__((ext_vector_type(8))) short;
using s16x4  = __attribute__((ext_vector_type(4))) short;
using f32x16 = __attribute__((ext_vector_type(16))) float;
using f32x8  = __attribute__((ext_vector_type(8))) float;
using u32x4  = __attribute__((ext_vector_type(4))) unsigned;
#define KSWZ(row, colB) ((row) * 256 + ((colB) ^ (((row) & 7) << 4)))
#define SBAR() __builtin_amdgcn_sched_barrier(0)
__device__ __forceinline__ int crow(int r, int hi) { return (r & 3) + 8 * (r >> 2) + 4 * hi; }
__device__ __forceinline__ unsigned cvtpk(float lo, float hi) {
  unsigned r; asm volatile("v_cvt_pk_bf16_f32 %0, %1, %2" : "=v"(r) : "v"(lo), "v"(hi)); return r;
}
template <typename TIn> struct Stage;
template <> struct Stage<bf16>  { using T = bf16x8;
  __device__ static __forceinline__ T ld8(const bf16* p) { return *reinterpret_cast<const bf16x8*>(p); }
  __device__ static __forceinline__ bf16x8 tobf(T x) { return x; } };
template <> struct Stage<float> { using T = f32x8;
  __device__ static __forceinline__ T ld8(const float* p) { return *reinterpret_cast<const f32x8*>(p); }
  __device__ static __forceinline__ bf16x8 tobf(T x) {
    u32x4 w = {cvtpk(x[0], x[1]), cvtpk(x[2], x[3]), cvtpk(x[4], x[5]), cvtpk(x[6], x[7])}; return *reinterpret_cast<bf16x8*>(&w); } };

__device__ __forceinline__ void partialSM(f32x16& p0, f32x16& p1, float& m_reg, float& mn, float& alpha) {
  constexpr float C = SCALE * 1.4426950408889634f;
  float pmax = p0[0]; for (int r = 1; r < 16; ++r) pmax = fmaxf(pmax, p0[r]); for (int r = 0; r < 16; ++r) pmax = fmaxf(pmax, p1[r]);
  { auto rr = __builtin_amdgcn_permlane32_swap(__float_as_uint(pmax), __float_as_uint(pmax), false, false);
    pmax = fmaxf(__uint_as_float(rr[0]), __uint_as_float(rr[1])); }
  if (__builtin_expect(__all(pmax - m_reg <= THR / SCALE), 1)) { mn = m_reg; alpha = 1.f; }
  else { mn = fmaxf(m_reg, pmax); alpha = __builtin_amdgcn_exp2f((m_reg - mn) * C); m_reg = mn; }
  float mnC = -mn * C;
  for (int r = 0; r < 16; ++r) p0[r] = fmaf(p0[r], C, mnC); for (int r = 0; r < 16; ++r) p1[r] = fmaf(p1[r], C, mnC);
  for (int r = 0; r < 16; ++r) p0[r] = __builtin_amdgcn_exp2f(p0[r]);
}
__device__ __forceinline__ void finishSM(f32x16& p0, f32x16& p1, float alpha, float& l_reg, bf16x8& pa0, bf16x8& pa1, bf16x8& pa2, bf16x8& pa3) {
  for (int r = 0; r < 16; ++r) p1[r] = __builtin_amdgcn_exp2f(p1[r]);
  float ps = 0; for (int r = 0; r < 16; ++r) ps += p0[r]; for (int r = 0; r < 16; ++r) ps += p1[r];
  { auto rr = __builtin_amdgcn_permlane32_swap(__float_as_uint(ps), __float_as_uint(ps), false, false);
    ps = __uint_as_float(rr[0]) + __uint_as_float(rr[1]); }
  l_reg = l_reg * alpha + ps;
#define PK4(P, BASE, OUT) do { unsigned a0 = cvtpk(P[BASE + 0], P[BASE + 1]), a1 = cvtpk(P[BASE + 2], P[BASE + 3]);   \
    unsigned b0 = cvtpk(P[BASE + 4], P[BASE + 5]), b1 = cvtpk(P[BASE + 6], P[BASE + 7]);                              \
    auto r0 = __builtin_amdgcn_permlane32_swap(a0, b0, false, false); auto r1 = __builtin_amdgcn_permlane32_swap(a1, b1, false, false); \
    u32x4 w = {r0[0], r1[0], r0[1], r1[1]}; OUT = *reinterpret_cast<bf16x8*>(&w); } while (0)
  PK4(p0, 0, pa0); PK4(p0, 8, pa1); PK4(p1, 0, pa2); PK4(p1, 8, pa3);
#undef PK4
}
__device__ __forceinline__ void qkt(f32x16& p0, f32x16& p1, const bf16* Ks, const bf16x8* qr, int r32, int hi) {
  p0 = f32x16{}; p1 = f32x16{};
  for (int d0 = 0; d0 < 8; ++d0) { int cb = (d0 * 16 + hi * 8) * 2;
    bf16x8 b0 = *reinterpret_cast<const bf16x8*>((const char*)Ks + KSWZ(r32, cb));
    bf16x8 b1 = *reinterpret_cast<const bf16x8*>((const char*)Ks + KSWZ(32 + r32, cb));
    p0 = __builtin_amdgcn_mfma_f32_32x32x16_bf16(b0, qr[d0], p0, 0, 0, 0);
    p1 = __builtin_amdgcn_mfma_f32_32x32x16_bf16(b1, qr[d0], p1, 0, 0, 0); }
}
__device__ __forceinline__ int v_st(int k, int c) { const int kk = (k & ~0xC) | ((k & 4) << 1) | ((k & 8) >> 1); return ((kk >> 3) * 4 + (c >> 5)) * 512 + ((kk & 7) * 32 + (c & 31)) * 2; }
__device__ __forceinline__ int v_rd_base(int lane) { return ((lane & 3) << 3) | (((lane >> 2) & 3) << 6) | (((lane >> 4) & 1) << 5) | (((lane >> 5) & 1) << 8); }
constexpr int v_rd_off(int d0, int ks, int half) { return d0 * 512 + ks * 4096 + half * 2048; }
template <int OFF> __device__ __forceinline__ s16x4 tr_read(int vb) {
  s16x4 r; asm volatile("ds_read_b64_tr_b16 %0, %1 offset:%2" : "=&v"(r) : "v"(vb), "i"(OFF) : "memory"); return r;
}
template <int D0> __device__ __forceinline__ void pv_one(f32x16& od, int vb, bf16x8 pa0, bf16x8 pa1, bf16x8 pa2, bf16x8 pa3) {
  const s16x4 l0 = tr_read<v_rd_off(D0, 0, 0)>(vb), h0 = tr_read<v_rd_off(D0, 0, 1)>(vb), l1 = tr_read<v_rd_off(D0, 1, 0)>(vb), h1 = tr_read<v_rd_off(D0, 1, 1)>(vb);
  const s16x4 l2 = tr_read<v_rd_off(D0, 2, 0)>(vb), h2 = tr_read<v_rd_off(D0, 2, 1)>(vb), l3 = tr_read<v_rd_off(D0, 3, 0)>(vb), h3 = tr_read<v_rd_off(D0, 3, 1)>(vb);
  asm volatile("s_waitcnt lgkmcnt(0)" ::: "memory"); SBAR();
#define PK(L, H) (bf16x8){L[0], L[1], L[2], L[3], H[0], H[1], H[2], H[3]}
  od = __builtin_amdgcn_mfma_f32_32x32x16_bf16(pa0, PK(l0, h0), od, 0, 0, 0);
  od = __builtin_amdgcn_mfma_f32_32x32x16_bf16(pa1, PK(l1, h1), od, 0, 0, 0);
  od = __builtin_amdgcn_mfma_f32_32x32x16_bf16(pa2, PK(l2, h2), od, 0, 0, 0);
  od = __builtin_amdgcn_mfma_f32_32x32x16_bf16(pa3, PK(l3, h3), od, 0, 0, 0);
#undef PK
}
__device__ __forceinline__ void pv_d0(f32x16* o, int vb, bf16x8 pa0, bf16x8 pa1, bf16x8 pa2, bf16x8 pa3) {
  pv_one<0>(o[0], vb, pa0, pa1, pa2, pa3); pv_one<1>(o[1], vb, pa0, pa1, pa2, pa3); pv_one<2>(o[2], vb, pa0, pa1, pa2, pa3); pv_one<3>(o[3], vb, pa0, pa1, pa2, pa3);
}

template <typename TQ>
__device__ __forceinline__ void attn_dense_body(const TQ* __restrict__ Qb, const bf16* __restrict__ Kh, const bf16* __restrict__ Vh,
                                                bf16* __restrict__ Ob, int seq, char* lds) {
  using St = Stage<bf16>; using SQ = Stage<TQ>;
  int tid_ = threadIdx.x; asm volatile("" : "+v"(tid_));
  const int tid = tid_, wid = tid >> 6, lane = tid & 63, r32 = lane & 31, hi = lane >> 5;
  bf16* V_lds = (bf16*)lds; bf16* K_lds = (bf16*)(lds + 2 * SHM_V);
  float* ws = (float*)(lds + 2 * SHM_V + 2 * SHM_K) + wid * 64; float* li_l = ws; float* al_l = ws + 32;
  float m_reg = -1e30f, l_reg = 0; f32x16 o[4] = {}; bf16x8 qr[8];
  const TQ* Qw = Qb + (long)(wid * QBLK + r32) * LDQ + hi * 8;
#pragma unroll
  for (int d0 = 0; d0 < 8; ++d0) qr[d0] = SQ::tobf(SQ::ld8(Qw + d0 * 16));
  const int sr = tid >> 4, sc = (tid & 15) * 8, vst0 = v_st(sr, sc), vst1 = v_st(32 + sr, sc);
  const int vb0 = (int)(uintptr_t)V_lds + v_rd_base(lane);
  struct { typename St::T vs0, vs1, ks0, ks1; } sr_[SDEPTH];
#define SLOAD(i, k0) do { sr_[i].vs0 = St::ld8(&Vh[(long)((k0) + sr) * LDK + sc]); sr_[i].vs1 = St::ld8(&Vh[(long)((k0) + 32 + sr) * LDK + sc]); \
    sr_[i].ks0 = St::ld8(&Kh[(long)((k0) + sr) * LDK + sc]); sr_[i].ks1 = St::ld8(&Kh[(long)((k0) + 32 + sr) * LDK + sc]); } while (0)
#define SWRITE(b, i) do { *(bf16x8*)((char*)V_lds + (b) * SHM_V + vst0) = St::tobf(sr_[i].vs0);          \
    *(bf16x8*)((char*)V_lds + (b) * SHM_V + vst1) = St::tobf(sr_[i].vs1); int kc = sc * 2;               \
    *(bf16x8*)((char*)K_lds + (b) * SHM_K + KSWZ(sr, kc)) = St::tobf(sr_[i].ks0);                       \
    *(bf16x8*)((char*)K_lds + (b) * SHM_K + KSWZ(32 + sr, kc)) = St::tobf(sr_[i].ks1); } while (0)
#define SWAIT() do { if constexpr (SDEPTH == 2) asm volatile("s_waitcnt vmcnt(4)" ::: "memory"); else asm volatile("s_waitcnt vmcnt(0)" ::: "memory"); } while (0)
#define RESC(a) do { if (__any((a) < 1.f)) { if (hi == 0) al_l[r32] = (a); asm volatile("s_waitcnt lgkmcnt(0)" ::: "memory"); \
    for (int d = 0; d < 4; ++d) for (int r = 0; r < 16; ++r) o[d][r] *= al_l[crow(r, hi)]; } } while (0)
  f32x16 pA0, pA1, pB0, pB1; float mnA, mnB, alA, alB; bf16x8 pa0, pa1, pa2, pa3; const int NT = seq / KVBLK;
  constexpr int SE = 0, SO = SDEPTH - 1;
  SLOAD(SE, 0); asm volatile("s_waitcnt vmcnt(0)" ::: "memory"); SWRITE(0, SE); __syncthreads();
  qkt(pA0, pA1, K_lds, qr, r32, hi); partialSM(pA0, pA1, m_reg, mnA, alA);
  SLOAD(SO, KVBLK); if constexpr (SDEPTH == 2) { if (2 < NT) SLOAD(SE, 2 * KVBLK); }
  SWAIT(); SWRITE(1, SO); __syncthreads();
  for (int j = 1; j + 1 < NT; j += 2) {
    SBAR(); qkt(pB0, pB1, (bf16*)((char*)K_lds + SHM_K), qr, r32, hi);
    finishSM(pA0, pA1, alA, l_reg, pa0, pa1, pa2, pa3); SBAR();
    SLOAD(SO, (j + SDEPTH) * KVBLK); SBAR();
    pv_d0(o, vb0, pa0, pa1, pa2, pa3); partialSM(pB0, pB1, m_reg, mnB, alB);
    __syncthreads(); SWAIT(); SWRITE(0, SE);
    RESC(alB); __syncthreads();
    SBAR(); qkt(pA0, pA1, K_lds, qr, r32, hi);
    finishSM(pB0, pB1, alB, l_reg, pa0, pa1, pa2, pa3); SBAR();
    if (SDEPTH == 1 || j + 3 < NT) SLOAD(SE, (j + 1 + SDEPTH) * KVBLK); SBAR();
    pv_d0(o, vb0 + (int)SHM_V, pa0, pa1, pa2, pa3); partialSM(pA0, pA1, m_reg, mnA, alA);
    __syncthreads(); SWAIT(); SWRITE(1, SO);
    RESC(alA); __syncthreads();
  }
  SBAR(); qkt(pB0, pB1, (bf16*)((char*)K_lds + SHM_K), qr, r32, hi);
  finishSM(pA0, pA1, alA, l_reg, pa0, pa1, pa2, pa3); SBAR();
  pv_d0(o, vb0, pa0, pa1, pa2, pa3); partialSM(pB0, pB1, m_reg, mnB, alB);
  __syncthreads(); RESC(alB);
  finishSM(pB0, pB1, alB, l_reg, pa0, pa1, pa2, pa3); SBAR();
  pv_d0(o, vb0 + (int)SHM_V, pa0, pa1, pa2, pa3);
  if (hi == 0) li_l[r32] = l_reg; asm volatile("s_waitcnt lgkmcnt(0)" ::: "memory");
  float rli[16];
#pragma unroll
  for (int r = 0; r < 16; ++r) rli[r] = __builtin_amdgcn_rcpf(li_l[crow(r, hi)]);
  bf16* Ow = Ob + (long)(wid * QBLK) * LDO;
#pragma unroll
  for (int r = 0; r < 16; ++r) { int orow = crow(r, hi);
    for (int d0 = 0; d0 < 4; ++d0) Ow[(long)orow * LDO + d0 * 32 + r32] = __float2bfloat16(o[d0][r] * rli[r]); }
#undef SLOAD
#undef SWRITE
#undef SWAIT
#undef RESC
}
#undef KSWZ
#undef SBAR
}
namespace fk {
using pg8::bf16_t; using pg8::f32x4; using pg8::u32x4; using pg8::Unit; using pg8::cvt_pk_bf16;
typedef unsigned u32x2 __attribute__((ext_vector_type(2)));
typedef float f32x16 __attribute__((ext_vector_type(16)));
constexpr int M = 24576, MP = 8192, D = 2048, INW = 17408, DFF = 8192, DEPTH = 4, NWAVES = 8, NCOND = 9;
constexpr int OFF_Q = 0, OFF_K = 2048, OFF_V = 2560, OFF_LX = 3072, OFF_LG = 5120, OFF_CU = 7168, OFF_CV = 9216, OFF_G = 11264;
constexpr int NKVROWS = 26624;
constexpr float EPS = 1e-6f;
constexpr int NPHASE = 3 + 9 * DEPTH;
constexpr int NMODK = 32;
constexpr size_t MiB = 1u << 20;
constexpr size_t WS_CTL = 0, CTL_ZERO_BYTES = 1 * MiB;
constexpr size_t WS_MODP = 716 * MiB  , WS_MOD = 28 * MiB, WS_ROPE = 30 * MiB, WS_CVSTAT = 31 * MiB, WS_FSTAT = 34 * MiB, WS_AGG = 37 * MiB, WS_WLRU = 49 * MiB, WS_CMW = 51 * MiB;
constexpr size_t WS_WIN = 52 * MiB, WS_WBR = 120 * MiB, WS_WOUT = 144 * MiB, WS_WFF1 = 152 * MiB, WS_WFF2 = 184 * MiB;
constexpr size_t WS_H = 216 * MiB, WS_KALL = 312 * MiB, WS_VALL = 338 * MiB, WS_BR = 364 * MiB, WS_MSCR = 652 * MiB, WS_Z = 716 * MiB, WS_END = 1532 * MiB;
constexpr size_t WS_FFH = WS_Z, WS_F = WS_Z + 384 * MiB;
constexpr int CW_BAR = 4096;
constexpr int RING_BYTES = 131072;
constexpr int LRU_XC = 0, LRU_XC_PITCH = 272, LRU_A0 = 17408, LRU_B0 = LRU_A0 + 32768, LRU_A1 = LRU_B0 + 32768, LRU_B1 = LRU_A1 + 32768;
constexpr int CM_VT = 0, CM_VT_PITCH = 272, CM_RS = 128 * 272;
constexpr int MISC_OFF = 149504, LDS_BYTES = 150528;
static_assert(LRU_B1 + 32768 <= MISC_OFF, "lds map");

struct Params { const float* in[32]; float* out; unsigned char* ws; int ph_lo, ph_hi, li, pad; };

typedef const __attribute__((address_space(4))) void* kaptr_t;
struct Frame {
    LAS unsigned char* lds;
    int tid, lane, wave, vcu, G, gw, NGW, bx;
    float* out; unsigned char* ws; kaptr_t ka;
    __device__ __forceinline__ float* x() const { return out; }
    __device__ __forceinline__ float* new_k() const { return out + 50331648L; }
    __device__ __forceinline__ float* new_v() const { return out + 50331648L + 16777216L; }
    __device__ __forceinline__ float* new_s() const { return out + 50331648L + 2 * 16777216L; }
#define FK_WSP(name, type, off) __device__ __forceinline__ type* name() const { return (type*)(ws + (off)); }
    FK_WSP(MODP, float, WS_MODP) FK_WSP(MOD, float, WS_MOD) FK_WSP(ROPE, float, WS_ROPE) FK_WSP(CVSTAT, float, WS_CVSTAT) FK_WSP(FSTAT, float, WS_FSTAT) FK_WSP(AGG, float, WS_AGG) FK_WSP(MSCR, float, WS_MSCR)
    FK_WSP(WLRU, bf16_t, WS_WLRU) FK_WSP(CMW, bf16_t, WS_CMW) FK_WSP(WIN, bf16_t, WS_WIN) FK_WSP(WBR, bf16_t, WS_WBR) FK_WSP(WOUT, bf16_t, WS_WOUT) FK_WSP(WFF1, bf16_t, WS_WFF1) FK_WSP(WFF2, bf16_t, WS_WFF2)
    FK_WSP(H, bf16_t, WS_H) FK_WSP(KALL, bf16_t, WS_KALL) FK_WSP(VALL, bf16_t, WS_VALL) FK_WSP(BR, bf16_t, WS_BR) FK_WSP(Z, bf16_t, WS_Z) FK_WSP(FFH, bf16_t, WS_FFH) FK_WSP(Fb, bf16_t, WS_F)
#undef FK_WSP
};
enum { I_XP = 0, I_XS, I_CK, I_CV, I_SL, I_C, I_CCTX, I_WMOD, I_BMOD, I_GPM, I_GPOM, I_GPF, I_GPOF, I_WIN, I_GQ, I_GK, I_WAO, I_CW, I_CB, I_LWA, I_LBA, I_LWX, I_LBX, I_LAM, I_WLO, I_CMG, I_CMWS, I_CMBS, I_WCO, I_WOUT, I_WFF1, I_WFF2 };
template <int I> __device__ __forceinline__ const float* inp(const Frame& F) { const float* r; asm volatile("s_load_dwordx2 %0, %1, %2\n\ts_waitcnt lgkmcnt(0)" : "=s"(r) : "s"(F.ka), "i"(I * 8) : "memory"); return r; }


__device__ __forceinline__ Frame phase_frame(const Frame& F) {
    Frame P = F; int t = F.tid; int bx = blockIdx.x; int g = F.G; unsigned char* w = F.ws; float* o = F.out;
    asm volatile("" : "+v"(t)); asm volatile("" : "+s"(bx), "+s"(g), "+s"(w), "+s"(o));
    P.tid = t; P.lane = t & 63; P.wave = __builtin_amdgcn_readfirstlane(t >> 6); P.ws = w; P.out = o; P.bx = bx; P.G = g; P.NGW = g * NWAVES;
    P.vcu = (g % 8 == 0) ? (bx % 8) * (g / 8) + bx / 8 : bx; P.gw = P.vcu * NWAVES + P.wave;
    return P;
}
__device__ __forceinline__ float wave_sum(float v) {
#pragma unroll
    for (int o = 1; o < 64; o <<= 1) v += __shfl_xor(v, o);
    return v;
}
__device__ __forceinline__ float bf2f(unsigned short h) { return __uint_as_float((unsigned)h << 16); }
__device__ __forceinline__ float bflo(unsigned w) { return __uint_as_float(w << 16); }
__device__ __forceinline__ float bfhi(unsigned w) { return __uint_as_float(w & 0xffff0000u); }
__device__ __forceinline__ float fsigm(float x) { return __builtin_amdgcn_rcpf(1.f + __builtin_amdgcn_exp2f(-1.4426950408889634f * x)); }
__device__ __forceinline__ float fgelu(float x) { const float u = x * (1.5957691216057308f + 0.0713548162726009f * x * x); return x * fsigm(u); }

__device__ __forceinline__ void transpose_item(const float* __restrict__ W, int K, int N, bf16_t* __restrict__ WT, int row_off, LAS unsigned char* scr, int item, int lane) {
    const int nblk = N / 64, kb = item / nblk, nb = item % nblk, k0 = 64 * kb, n0 = 64 * nb;
    const int n4 = (lane & 15) * 4, kp = lane >> 4;
    const float* src = W + (size_t)(k0 + 2 * kp) * N + n0 + n4;
    f32x4 v[8][2];
#pragma unroll
    for (int i = 0; i < 8; ++i) { v[i][0] = *(const f32x4*)(src + (size_t)(8 * i) * N); v[i][1] = *(const f32x4*)(src + (size_t)(8 * i + 1) * N); }
#pragma unroll
    for (int i = 0; i < 8; ++i) { const int k = 8 * i + 2 * kp;
#pragma unroll
        for (int j = 0; j < 4; ++j) *(LAS unsigned*)(scr + (n4 + j) * 144 + k * 2) = cvt_pk_bf16(v[i][0][j], v[i][1][j]); }
    LDS_WAIT(); asm volatile("" ::: "memory");
    const int ch = lane & 7;
#pragma unroll
    for (int j = 0; j < 8; ++j) { const int n = (lane >> 3) + 8 * j;
        const v4u o = *(const LAS v4u*)(scr + n * 144 + ch * 16);
        *(GAS v4u*)(WT + (size_t)(row_off + n0 + n) * K + k0 + 8 * ch) = o; }
    LDS_WAIT(); asm volatile("" ::: "memory");
}
__device__ __forceinline__ void convert_layer(const Frame& F, int l) {
    LAS unsigned char* scr = F.lds + F.wave * 16384;
    constexpr int I_IN = 32 * 272, I_SQ = 32 * 32, I_F1 = 32 * 128, I_F2 = 128 * 32, I_LRU = 64 * 4;
    constexpr int NITEMS = I_IN + 4 * I_SQ + I_F1 + I_F2 + I_LRU;
    const float* w_in = inp<I_WIN>(F) + (size_t)l * D * INW; const float* w_ao = inp<I_WAO>(F) + (size_t)l * D * D; const float* w_lo = inp<I_WLO>(F) + (size_t)l * D * D;
    const float* w_co = inp<I_WCO>(F) + (size_t)l * D * D; const float* w_out = inp<I_WOUT>(F) + (size_t)l * D * D; const float* w_f1 = inp<I_WFF1>(F) + (size_t)l * D * DFF;
    const float* w_f2 = inp<I_WFF2>(F) + (size_t)l * DFF * D; const float* lwa = inp<I_LWA>(F) + (size_t)l * 2 * 16 * 16384; const float* lwx = inp<I_LWX>(F) + (size_t)l * 2 * 16 * 16384;
    for (int it = F.gw; it < NITEMS; it += F.NGW) {
        int r = it;
        if (r < I_IN) { transpose_item(w_in, D, INW, F.WIN(), 0, scr, r, F.lane); continue; } r -= I_IN;
        if (r < I_SQ) { transpose_item(w_ao, D, D, F.WBR(), 0, scr, r, F.lane); continue; } r -= I_SQ;
        if (r < I_SQ) { transpose_item(w_lo, D, D, F.WBR(), D, scr, r, F.lane); continue; } r -= I_SQ;
        if (r < I_SQ) { transpose_item(w_co, D, D, F.WBR(), 2 * D, scr, r, F.lane); continue; } r -= I_SQ;
        if (r < I_SQ) { transpose_item(w_out, D, D, F.WOUT(), 0, scr, r, F.lane); continue; } r -= I_SQ;
        if (r < I_F1) { transpose_item(w_f1, D, DFF, F.WFF1(), 0, scr, r, F.lane); continue; } r -= I_F1;
        if (r < I_F2) { transpose_item(w_f2, DFF, D, F.WFF2(), 0, scr, r, F.lane); continue; } r -= I_F2;
        { const int bi = r >> 2, sub = r & 3, d = bi >> 5, mat = (bi >> 4) & 1, blk = bi & 15;
          const float* src = (mat ? lwx : lwa) + ((size_t)d * 16 + blk) * 16384;
          transpose_item(src, 128, 128, F.WLRU() + (size_t)bi * 16384, 0, scr, sub, F.lane); }
    }
    const float* cw = inp<I_CMWS>(F) + (size_t)l * 16 * 16384;
    for (int i = (F.gw * 64 + F.lane) * 8; i < 16 * 16384; i += F.NGW * 64 * 8) {
        const f32x4 a = *(const f32x4*)(cw + i), b = *(const f32x4*)(cw + i + 4);
        v4u o; o.x = pk2(a.x, a.y); o.y = pk2(a.z, a.w); o.z = pk2(b.x, b.y); o.w = pk2(b.z, b.w);
        *(v4u*)(F.CMW() + i) = o;
    }
}
__device__ __forceinline__ void mod_partials(const Frame& F) {
    LAS float* scr = (LAS float*)(F.lds + F.wave * 16384);
    const float* cctx = inp<I_CCTX>(F); const float* cc = inp<I_C>(F); const float* wmod = inp<I_WMOD>(F);
    for (int it = F.gw; it < DEPTH * 48 * NMODK; it += F.NGW) {
        const int kc = it % NMODK, jb = (it / NMODK) % 48, l = it / (NMODK * 48), k0 = kc * 64;
        for (int e = F.lane; e < NCOND * 64; e += 64) { const int ci = e >> 6, kk = e & 63; const float v = ci == 0 ? cctx[k0 + kk] : cc[(ci - 1) * D + k0 + kk]; scr[e] = v * (1.f / (1.f + __expf(-v))); }
        LDS_WAIT(); asm volatile("" ::: "memory");
        f32x4 acc[NCOND];
#pragma unroll
        for (int ci = 0; ci < NCOND; ++ci) acc[ci] = (f32x4){0.f, 0.f, 0.f, 0.f};
        const float* wp = wmod + ((size_t)l * D + k0) * 12288 + jb * 256 + F.lane * 4;
#pragma unroll
        for (int kb = 0; kb < 64; kb += 16) {
            f32x4 w[16];
#pragma unroll
            for (int kk = 0; kk < 16; ++kk) w[kk] = *(const f32x4*)(wp + (size_t)(kb + kk) * 12288);
#pragma unroll
            for (int kk = 0; kk < 16; ++kk)
#pragma unroll
                for (int ci = 0; ci < NCOND; ++ci) acc[ci] += w[kk] * scr[ci * 64 + kb + kk];
        }
#pragma unroll
        for (int ci = 0; ci < NCOND; ++ci) *(f32x4*)(F.MODP() + (((size_t)kc * DEPTH + l) * NCOND + ci) * 12288 + jb * 256 + F.lane * 4) = acc[ci];
        LDS_WAIT(); asm volatile("" ::: "memory");
    }
}
__device__ __forceinline__ void mod_reduce(const Frame& F) {
    constexpr int NEL = DEPTH * NCOND * 12288;
    for (int i = (F.gw * 64 + F.lane) * 4; i < NEL; i += F.NGW * 64 * 4) {
        const int l = i / (NCOND * 12288), j = i % 12288;
        f32x4 s = *(const f32x4*)(inp<I_BMOD>(F) + (size_t)l * 12288 + j);
#pragma unroll
        for (int kc = 0; kc < NMODK; ++kc) s += *(const f32x4*)(F.MODP() + (size_t)kc * NEL + i);
        *(f32x4*)(F.MOD() + i) = s;
    }
}
__device__ __forceinline__ void rope_table(const Frame& F) {
    if (F.bx == 0) for (int e = F.tid; e < 2048; e += NWAVES * 64) {
        const int pos = e >> 5, f = e & 31; const float inv = exp2f(-(float)f * (13.287712379549449f / 32.f)); float s, c; sincosf((float)pos * inv, &s, &c);
        F.ROPE()[e] = c; F.ROPE()[2048 + e] = s; }
}
template <bool HAS_F, bool HAS_H>
__device__ __forceinline__ void rowlocal_row(const Frame& F, const float* xsrc, float* xdst, const bf16_t* frow, const float* fstat, const float* gate, const float* gpost,
                                             const float* gpre, const float* sc, const float* sh, bf16_t* hrow) {
    f32x4 xv[4][2];
#pragma unroll
    for (int j = 0; j < 4; ++j) { const int e = (j * 64 + F.lane) * 8; xv[j][0] = *(const f32x4*)(xsrc + e); xv[j][1] = *(const f32x4*)(xsrc + e + 4); }
    if (HAS_F) {
        const float st = F.lane < 32 ? fstat[F.lane] : 0.f;
        const float rs = rsqrtf(wave_sum(st) * (1.f / D) + EPS);
#pragma unroll
        for (int j = 0; j < 4; ++j) { const int e = (j * 64 + F.lane) * 8;
            const u32x4 fw = *(const u32x4*)(frow + e);
            const f32x4 g0 = *(const f32x4*)(gate + e), g1 = *(const f32x4*)(gate + e + 4), p0 = *(const f32x4*)(gpost + e), p1 = *(const f32x4*)(gpost + e + 4);
            const f32x4 f0 = {bflo(fw.x), bfhi(fw.x), bflo(fw.y), bfhi(fw.y)}, f1 = {bflo(fw.z), bfhi(fw.z), bflo(fw.w), bfhi(fw.w)};
            xv[j][0] += g0 * (f0 * rs * p0); xv[j][1] += g1 * (f1 * rs * p1); }
    }
#pragma unroll
    for (int j = 0; j < 4; ++j) { const int e = (j * 64 + F.lane) * 8; *(f32x4*)(xdst + e) = xv[j][0]; *(f32x4*)(xdst + e + 4) = xv[j][1]; }
    if (HAS_H) {
        float ss = 0.f;
#pragma unroll
        for (int j = 0; j < 4; ++j)
#pragma unroll
            for (int h = 0; h < 2; ++h) ss += (xv[j][h].x * xv[j][h].x + xv[j][h].y * xv[j][h].y) + (xv[j][h].z * xv[j][h].z + xv[j][h].w * xv[j][h].w);
        const float rs = rsqrtf(wave_sum(ss) * (1.f / D) + EPS);
#pragma unroll
        for (int j = 0; j < 4; ++j) { const int e = (j * 64 + F.lane) * 8;
            f32x4 o[2];
#pragma unroll
            for (int h = 0; h < 2; ++h) { const f32x4 g = *(const f32x4*)(gpre + e + 4 * h), s1 = *(const f32x4*)(sc + e + 4 * h), s0 = *(const f32x4*)(sh + e + 4 * h); o[h] = xv[j][h] * rs * g * (s1 + 1.f) + s0; }
            u32x4 w; w.x = cvt_pk_bf16(o[0].x, o[0].y); w.y = cvt_pk_bf16(o[0].z, o[0].w); w.z = cvt_pk_bf16(o[1].x, o[1].y); w.w = cvt_pk_bf16(o[1].z, o[1].w);
            *(u32x4*)(hrow + e) = w; }
    }
}
__device__ __forceinline__ int cond_of_row(int m) { return m < MP ? 0 : 1 + ((m - MP) >> 11); }
template <int MODE>
__device__ __forceinline__ void rowlocal_phase(const Frame& F, int l) {
    for (int m = F.gw; m < M; m += F.NGW) {
        const int ci = cond_of_row(m);
        float* xrow = F.x() + (size_t)m * D;
        const float* modl = F.MOD() + ((size_t)l * NCOND + ci) * 12288;
        if (MODE == 0) {
            const float* xs = m < MP ? inp<I_XP>(F) + (size_t)m * D : inp<I_XS>(F) + (size_t)(m - MP) * D;
            rowlocal_row<false, true>(F, xs, xrow, nullptr, nullptr, nullptr, nullptr, inp<I_GPM>(F), modl + 1 * D, modl + 0 * D, F.H() + (size_t)m * D);
        } else if (MODE == 1) {
            rowlocal_row<true, true>(F, xrow, xrow, F.Fb() + (size_t)m * D, F.FSTAT() + (size_t)m * 32, modl + 2 * D, inp<I_GPOM>(F) + (size_t)l * D,
                                     inp<I_GPF>(F) + (size_t)l * D, modl + 4 * D, modl + 3 * D, F.H() + (size_t)m * D);
        } else {
            if (l + 1 < DEPTH) { const float* modn = F.MOD() + ((size_t)(l + 1) * NCOND + ci) * 12288;
                rowlocal_row<true, true>(F, xrow, xrow, F.Fb() + (size_t)m * D, F.FSTAT() + (size_t)m * 32, modl + 5 * D, inp<I_GPOF>(F) + (size_t)l * D,
                                         inp<I_GPM>(F) + (size_t)(l + 1) * D, modn + 1 * D, modn + 0 * D, F.H() + (size_t)m * D); }
            else rowlocal_row<true, false>(F, xrow, xrow, F.Fb() + (size_t)m * D, F.FSTAT() + (size_t)m * 32, modl + 5 * D, inp<I_GPOF>(F) + (size_t)l * D, nullptr, nullptr, nullptr, nullptr);
        }
    }
}
__device__ __forceinline__ u32x4 pack8(const f32x4& a, const f32x4& b) { u32x4 w; w.x = cvt_pk_bf16(a[0], a[1]); w.y = cvt_pk_bf16(a[2], a[3]); w.z = cvt_pk_bf16(b[0], b[1]); w.w = cvt_pk_bf16(b[2], b[3]); return w; }
__device__ __forceinline__ f32x4 gelu4(const f32x4& v) { return (f32x4){fgelu(v[0]), fgelu(v[1]), fgelu(v[2]), fgelu(v[3])}; }
__device__ __forceinline__ f32x4 sigm4(const f32x4& v) { return (f32x4){fsigm(v[0]), fsigm(v[1]), fsigm(v[2]), fsigm(v[3])}; }
__device__ __forceinline__ int kv_row(int m) { return m < MP ? m : MP + ((m - MP) >> 11) * 2304 + ((m - MP) & 2047); }
struct EpiIn {
    static constexpr bool PERM = true, AFTER_DRAIN = false;
    bf16_t* Z; bf16_t* VALL; float* new_v; float* cvstat; int layer;
    __device__ __forceinline__ void operator()(const f32x4 (&acc)[2][2][4][2], const Unit& u, int wr, int wc, int fr, int fq) const {
        const int pn = u.pn, row0 = u.pm * 256 + wr * 64 + fr, cl = wc * 32 + 8 * fq;
        if (pn >= 10 && pn < 12) {
            const int colv = (pn - 10) * 256 + cl;
#pragma unroll
            for (int ai = 0; ai < 2; ++ai)
#pragma unroll
                for (int m = 0; m < 4; ++m) { const int row = row0 + ai * 128 + m * 16; bf16_t* dst = VALL + (size_t)kv_row(row) * 512 + colv;
#pragma unroll
                    for (int bj = 0; bj < 2; ++bj) { *(u32x4*)(dst + bj * 128) = pack8(acc[ai][bj][m][0], acc[ai][bj][m][1]);
                        if (row < MP) { float* nv = new_v + ((size_t)((row >> 8) * DEPTH + layer) * 256 + (row & 255)) * 512 + colv + bj * 128; *(f32x4*)nv = acc[ai][bj][m][0]; *(f32x4*)(nv + 4) = acc[ai][bj][m][1]; } } }
            return;
        }
        const int mode = (pn < 20) ? 0 : (pn < 36) ? 1 : (pn < 44) ? 2 : 3;
        const int col0 = pn * 256 + cl;
#pragma unroll
        for (int ai = 0; ai < 2; ++ai)
#pragma unroll
            for (int m = 0; m < 4; ++m) { const int row = row0 + ai * 128 + m * 16; bf16_t* dst = Z + (size_t)row * INW + col0; float ss = 0.f;
#pragma unroll
                for (int bj = 0; bj < 2; ++bj) { f32x4 v0 = acc[ai][bj][m][0], v1 = acc[ai][bj][m][1];
                    if (mode == 1 || mode == 2) { v0 = gelu4(v0); v1 = gelu4(v1); }
                    if (mode == 3) { v0 = sigm4(v0); v1 = sigm4(v1); }
                    if (mode == 2) ss += (v0[0] * v0[0] + v0[1] * v0[1]) + (v0[2] * v0[2] + v0[3] * v0[3]) + (v1[0] * v1[0] + v1[1] * v1[1]) + (v1[2] * v1[2] + v1[3] * v1[3]);
                    *(u32x4*)(dst + bj * 128) = pack8(v0, v1); }
                if (mode == 2) { ss += __shfl_xor(ss, 16); ss += __shfl_xor(ss, 32); if (fq == 0) cvstat[(size_t)row * 32 + (pn - 36) * 4 + wc] = ss; } }
    }
};
struct EpiRelu2 {
    static constexpr bool PERM = true, AFTER_DRAIN = false;
    bf16_t* O; int ldc;
    __device__ __forceinline__ void operator()(const f32x4 (&acc)[2][2][4][2], const Unit& u, int wr, int wc, int fr, int fq) const {
        const int row0 = u.pm * 256 + wr * 64 + fr, col0 = u.pn * 256 + wc * 32 + 8 * fq;
#pragma unroll
        for (int ai = 0; ai < 2; ++ai)
#pragma unroll
            for (int m = 0; m < 4; ++m) { bf16_t* dst = O + (size_t)(row0 + ai * 128 + m * 16) * ldc + col0;
#pragma unroll
                for (int bj = 0; bj < 2; ++bj) { f32x4 v0 = __builtin_elementwise_max(acc[ai][bj][m][0], (f32x4){0.f, 0.f, 0.f, 0.f}), v1 = __builtin_elementwise_max(acc[ai][bj][m][1], (f32x4){0.f, 0.f, 0.f, 0.f});
                    *(u32x4*)(dst + bj * 128) = pack8(v0 * v0, v1 * v1); } }
    }
};
struct EpiF {
    static constexpr bool PERM = true, AFTER_DRAIN = false;
    bf16_t* O; float* stat;
    __device__ __forceinline__ void operator()(const f32x4 (&acc)[2][2][4][2], const Unit& u, int wr, int wc, int fr, int fq) const {
        const int row0 = u.pm * 256 + wr * 64 + fr, col0 = u.pn * 256 + wc * 32 + 8 * fq;
#pragma unroll
        for (int ai = 0; ai < 2; ++ai)
#pragma unroll
            for (int m = 0; m < 4; ++m) { const int row = row0 + ai * 128 + m * 16; bf16_t* dst = O + (size_t)row * D + col0; float ss = 0.f;
#pragma unroll
                for (int bj = 0; bj < 2; ++bj) { const f32x4 v0 = acc[ai][bj][m][0], v1 = acc[ai][bj][m][1];
                    ss += (v0[0] * v0[0] + v0[1] * v0[1]) + (v0[2] * v0[2] + v0[3] * v0[3]) + (v1[0] * v1[0] + v1[1] * v1[1]) + (v1[2] * v1[2] + v1[3] * v1[3]);
                    *(u32x4*)(dst + bj * 128) = pack8(v0, v1); }
                ss += __shfl_xor(ss, 16); ss += __shfl_xor(ss, 32); if (fq == 0) stat[(size_t)row * 32 + u.pn * 4 + wc] = ss; }
    }
};
struct EpiMerge {
    static constexpr bool PERM = true, AFTER_DRAIN = false;
    const bf16_t* Z; float* scr  ; bf16_t* O;
    __device__ __forceinline__ void operator()(const f32x4 (&acc)[2][2][4][2], const Unit& u, int wr, int wc, int fr, int fq) const {
        const int br = u.pn >> 3, pn = u.pn & 7, pm = u.pm - 96 * br;
        const int rl0 = wr * 64 + fr, cl = wc * 32 + 8 * fq;
#pragma unroll
        for (int ai = 0; ai < 2; ++ai)
#pragma unroll
            for (int m = 0; m < 4; ++m) { const int rl = rl0 + ai * 128 + m * 16, row = pm * 256 + rl;
#pragma unroll
                for (int bj = 0; bj < 2; ++bj) { const int c = cl + bj * 128;
                    const u32x4 gw = *(const u32x4*)(Z + (size_t)row * INW + OFF_G + br * D + pn * 256 + c);
                    const f32x4 g0 = {bflo(gw.x), bfhi(gw.x), bflo(gw.y), bfhi(gw.y)}, g1 = {bflo(gw.z), bfhi(gw.z), bflo(gw.w), bfhi(gw.w)};
                    f32x4 v0 = g0 * acc[ai][bj][m][0], v1 = g1 * acc[ai][bj][m][1];
                    float* sp = scr + rl * 256 + c;
                    if (br > 0) { v0 += *(const f32x4*)sp; v1 += *(const f32x4*)(sp + 4); }
                    if (br < 2) { *(f32x4*)sp = v0; *(f32x4*)(sp + 4) = v1; }
                    else *(u32x4*)(O + (size_t)row * D + pn * 256 + c) = pack8(v0, v1); } }
    }
};
struct MergeOrder {
    pg8::StaticOrder so;
    __device__ void init(int G, int c) { so.init(M, D, G, c); }
    __device__ bool next(int i, Unit& u) const { const int br = i % 3; if (!so.next(i / 3, u)) return false; u.pm += 96 * br; u.pn += 8 * br; return true; }
    __device__ __forceinline__ void a_ready(const Unit&) const {}
    __device__ __forceinline__ void done(const Unit&) const {}
};
}
namespace fk {
typedef short bf16x8 __attribute__((ext_vector_type(8)));
__device__ __forceinline__ void prep_row(const Frame& F, int m, int l) {
    const bool sample = m >= MP; int b, t;
    if (!sample) { b = m >> 8; t = m & 255; } else { b = (m - MP) >> 11; t = (m - MP) & 2047; }
    const int kvrow = sample ? MP + b * 2304 + t : m;
    const int lane = F.lane, g8 = lane >> 3, j = lane & 7, axis = g8 & 1, hsel = lane >> 4;
    bf16_t* zrow = F.Z() + (size_t)m * INW;
    const int dA = axis * 64 + 4 * j, dB = dA + 32;
    const f32x4 gqa = *(const f32x4*)(inp<I_GQ>(F) + l * 128 + dA), gqb = *(const f32x4*)(inp<I_GQ>(F) + l * 128 + dB);
    const f32x4 gka = *(const f32x4*)(inp<I_GK>(F) + l * 128 + dA), gkb = *(const f32x4*)(inp<I_GK>(F) + l * 128 + dB);
    f32x4 cs = {1.f, 1.f, 1.f, 1.f}, sn = {0.f, 0.f, 0.f, 0.f};
    if (sample) { const int pos = axis == 0 ? (t >> 6) : (t & 63); cs = *(const f32x4*)(F.ROPE() + pos * 32 + 4 * j); sn = *(const f32x4*)(F.ROPE() + 2048 + pos * 32 + 4 * j); }
#pragma unroll
    for (int pass = 0; pass < 5; ++pass) {
        const bool isq = pass < 4;
        const int base = isq ? OFF_Q + (pass * 4 + hsel) * 128 + dA : OFF_K + hsel * 128 + dA;
        const u32x2 wa = *(const u32x2*)(zrow + base), wb = *(const u32x2*)(zrow + base + 32);
        const f32x4 xa = {bflo(wa.x), bfhi(wa.x), bflo(wa.y), bfhi(wa.y)}, xb = {bflo(wb.x), bfhi(wb.x), bflo(wb.y), bfhi(wb.y)};
        float ss = (xa.x * xa.x + xa.y * xa.y) + (xa.z * xa.z + xa.w * xa.w) + (xb.x * xb.x + xb.y * xb.y) + (xb.z * xb.z + xb.w * xb.w);
        ss += __shfl_xor(ss, 1); ss += __shfl_xor(ss, 2); ss += __shfl_xor(ss, 4); ss += __shfl_xor(ss, 8);
        const float rs = rsqrtf(ss * (1.f / 128.f) + EPS);
        const f32x4 na = xa * rs * (isq ? gqa : gka), nb = xb * rs * (isq ? gqb : gkb);
        const f32x4 ra = na * cs - nb * sn, rb = na * sn + nb * cs;
        u32x2 oa, ob; oa.x = cvt_pk_bf16(ra.x, ra.y); oa.y = cvt_pk_bf16(ra.z, ra.w); ob.x = cvt_pk_bf16(rb.x, rb.y); ob.y = cvt_pk_bf16(rb.z, rb.w);
        if (isq) { *(u32x2*)(zrow + base) = oa; *(u32x2*)(zrow + base + 32) = ob; }
        else {
            bf16_t* kd = F.KALL() + (size_t)kvrow * 512 + hsel * 128 + dA; *(u32x2*)kd = oa; *(u32x2*)(kd + 32) = ob;
            if (!sample) { float* nk = F.new_k() + ((size_t)(b * DEPTH + l) * 256 + t) * 512 + hsel * 128 + dA; *(f32x4*)nk = na; *(f32x4*)(nk + 32) = nb; }
        }
    }
}
__device__ __forceinline__ void prep_phase(const Frame& F, int l) {
    for (int m = F.gw; m < M; m += F.NGW) prep_row(F, m, l);
    for (int it = F.gw; it < 2 * 8 * 256; it += F.NGW) {
        const int which = it >> 11, b = (it >> 8) & 7, p = it & 255;
        const float* src = (which ? inp<I_CV>(F) : inp<I_CK>(F)) + ((size_t)(b * DEPTH + l) * 256 + p) * 512 + F.lane * 8;
        bf16_t* dst = (which ? F.VALL() : F.KALL()) + (size_t)(MP + b * 2304 + 2048 + p) * 512 + F.lane * 8;
        const f32x4 a = *(const f32x4*)src, c = *(const f32x4*)(src + 4);
        *(u32x4*)dst = pack8(a, c);
    }
}
__device__ __forceinline__ int crow(int r, int hi) { return (r & 3) + 8 * (r >> 2) + 4 * hi; }
struct LruCtx {
    bf16x8 bw0[8], bw1[8];
    float bav, bxv, c8;
    bool small;
};
__device__ __forceinline__ void lru_ctx_load(const Frame& F, int l, int blk, LruCtx& X) {
    const int lane = F.lane, wave = F.wave, d = wave >> 2, n0 = (wave & 3) * 32, nl = lane & 31, hi = lane >> 5, C = blk * 128 + n0 + nl;
    const bf16_t* wb0 = F.WLRU() + ((size_t)((d * 2 + 0) * 16 + blk) * 128 + n0 + nl) * 128 + hi * 8;
    const bf16_t* wb1 = F.WLRU() + ((size_t)((d * 2 + 1) * 16 + blk) * 128 + n0 + nl) * 128 + hi * 8;
#pragma unroll
    for (int ks = 0; ks < 8; ++ks) { X.bw0[ks] = *(const bf16x8*)(wb0 + ks * 16); X.bw1[ks] = *(const bf16x8*)(wb1 + ks * 16); }
    X.bav = inp<I_LBA>(F)[(size_t)(l * 2 + d) * D + C]; X.bxv = inp<I_LBX>(F)[(size_t)(l * 2 + d) * D + C];
    const float lam = inp<I_LAM>(F)[(size_t)(l * 2 + d) * D + C];
    X.c8 = -8.f * log1pf(__expf(-lam));
    X.small = __all(X.c8 > -0.5f);
}
template <int PASS>
__device__ __forceinline__ void lru_unit(const Frame& F, int l, int ck, int blk, const LruCtx& X, const float* __restrict__ state_l, float* __restrict__ AGG, const float* __restrict__ cwl, const float* __restrict__ cbl) {
    int tid_ = F.tid; asm volatile("" : "+v"(tid_));
    const int tid = tid_, lane = tid & 63, wave = __builtin_amdgcn_readfirstlane(tid >> 6);
    const int m0 = ck * 64; const bool sample = m0 >= MP;
    int b, t0, T; if (!sample) { b = m0 >> 8; t0 = m0 & 255; T = 256; } else { b = (m0 - MP) >> 11; t0 = (m0 - MP) & 2047; T = 2048; }
    const int C0 = blk * 128;
    LAS unsigned char* lds = F.lds;
    const bf16_t* Zb = F.Z();
    {
        const int c4 = (tid & 31) * 4, r0 = (tid >> 5) * 4;
        f32x4 cw[4];
#pragma unroll
        for (int j = 0; j < 4; ++j) cw[j] = *(const f32x4*)(cwl + (size_t)j * D + C0 + c4);
        const f32x4 cb = *(const f32x4*)(cbl + C0 + c4);
        f32x4 zr[7];
#pragma unroll
        for (int i = 0; i < 7; ++i) {
            const int tt = t0 + r0 + i - 2;
            if (tt >= 0 && tt < T) { const u32x2 z = *(const u32x2*)(Zb + (size_t)(m0 + r0 + i - 2) * INW + OFF_LX + C0 + c4); zr[i] = (f32x4){bflo(z.x), bfhi(z.x), bflo(z.y), bfhi(z.y)}; }
            else zr[i] = (f32x4){0.f, 0.f, 0.f, 0.f};
        }
#pragma unroll
        for (int r = 0; r < 4; ++r) {
            const f32x4 y = cb + zr[r] * cw[0] + zr[r + 1] * cw[1] + zr[r + 2] * cw[2] + zr[r + 3] * cw[3];
            u32x2 o; o.x = cvt_pk_bf16(y.x, y.y); o.y = cvt_pk_bf16(y.z, y.w);
            *(LAS u32x2*)(lds + LRU_XC + (r0 + r) * LRU_XC_PITCH + c4 * 2) = o;
        }
    }
    __syncthreads();
    {
        const int d = wave >> 2, n0 = (wave & 3) * 32, nl = lane & 31, hi = lane >> 5;
        f32x16 acc[2][2];
#pragma unroll
        for (int mat = 0; mat < 2; ++mat)
#pragma unroll
            for (int mt = 0; mt < 2; ++mt)
#pragma unroll
                for (int r = 0; r < 16; ++r) acc[mat][mt][r] = 0.f;
        const LAS unsigned char* ap = lds + LRU_XC + nl * LRU_XC_PITCH + hi * 16;
#pragma unroll
        for (int ks = 0; ks < 8; ++ks) {
            const bf16x8 a0 = *(const LAS bf16x8*)(ap + ks * 32), a1 = *(const LAS bf16x8*)(ap + 32 * LRU_XC_PITCH + ks * 32);
            acc[0][0] = __builtin_amdgcn_mfma_f32_32x32x16_bf16(a0, X.bw0[ks], acc[0][0], 0, 0, 0);
            acc[0][1] = __builtin_amdgcn_mfma_f32_32x32x16_bf16(a1, X.bw0[ks], acc[0][1], 0, 0, 0);
            acc[1][0] = __builtin_amdgcn_mfma_f32_32x32x16_bf16(a0, X.bw1[ks], acc[1][0], 0, 0, 0);
            acc[1][1] = __builtin_amdgcn_mfma_f32_32x32x16_bf16(a1, X.bw1[ks], acc[1][1], 0, 0, 0);
        }
        const int c = n0 + nl;
        LAS float* Ad = (LAS float*)(lds + (d ? LRU_A1 : LRU_A0)); LAS float* Bd = (LAS float*)(lds + (d ? LRU_B1 : LRU_B0));
        const float bav = X.bav, bxv = X.bxv, c8 = X.c8;
        if (X.small) {
#pragma unroll
            for (int mt = 0; mt < 2; ++mt)
#pragma unroll
                for (int r = 0; r < 16; ++r) {
                    const int tl = mt * 32 + crow(r, hi);
                    const float rg = fsigm(acc[0][mt][r] + bav), ig = fsigm(acc[1][mt][r] + bxv);
                    const float la = c8 * rg;
                    float q = 1.f + la * (1.f / 7.f); q = 1.f + la * (1.f / 6.f) * q; q = 1.f + la * 0.2f * q; q = 1.f + la * 0.25f * q; q = 1.f + la * (1.f / 3.f) * q; q = 1.f + la * 0.5f * q;
                    const float e1 = la * q;
                    const float om = fmaxf(-e1 * (2.f + e1), 0.f);
                    const float xcv = bf2f(*(const LAS unsigned short*)(lds + LRU_XC + tl * LRU_XC_PITCH + c * 2));
                    Ad[tl * 128 + c] = 1.f + e1; Bd[tl * 128 + c] = __builtin_amdgcn_sqrtf(om) * ig * xcv;
                }
        } else {
#pragma unroll
            for (int mt = 0; mt < 2; ++mt)
#pragma unroll
                for (int r = 0; r < 16; ++r) {
                    const int tl = mt * 32 + crow(r, hi);
                    const float rg = fsigm(acc[0][mt][r] + bav), ig = fsigm(acc[1][mt][r] + bxv);
                    const float la = c8 * rg, a = __expf(la);
                    const float mult = sqrtf(fmaxf(-expm1f(2.f * la), 0.f));
                    const float xcv = bf2f(*(const LAS unsigned short*)(lds + LRU_XC + tl * LRU_XC_PITCH + c * 2));
                    Ad[tl * 128 + c] = a; Bd[tl * 128 + c] = mult * ig * xcv;
                }
        }
    }
    __syncthreads();
    if (tid < 256) {
        const int d = tid >> 7, c = tid & 127, C = C0 + c;
        const LAS float* Ad = (const LAS float*)(lds + (d ? LRU_A1 : LRU_A0)); LAS float* Bd = (LAS float*)(lds + (d ? LRU_B1 : LRU_B0));
        if (PASS == 1) {
            float h = 0.f, Pp = 1.f;
            if (d == 0) {
#pragma unroll 16
                for (int s = 0; s < 64; ++s) { const float a = Ad[s * 128 + c]; h = a * h + Bd[s * 128 + c]; Pp *= a; }
            } else {
#pragma unroll 16
                for (int s = 0; s < 64; ++s) { const float a = Ad[(63 - s) * 128 + c]; h = a * h + Bd[(63 - s) * 128 + c]; Pp *= a; }
            }
            *(float2*)(AGG + ((size_t)(ck * 2 + d) * D + C) * 2) = make_float2(Pp, h);
        } else {
            const int jc = t0 >> 6, nch = T >> 6;
            float carry = sample ? state_l[((size_t)b * DEPTH * 2 + d) * D + C] : 0.f;
            const float* ag = AGG + ((size_t)((ck - jc) * 2 + d) * D + C) * 2;
            if (nch == 4) {
                float2 pe[4];
#pragma unroll
                for (int jj = 0; jj < 4; ++jj) pe[jj] = *(const float2*)(ag + (size_t)jj * 4 * D);
                if (d == 0) {
#pragma unroll
                    for (int jj = 0; jj < 4; ++jj) if (jj < jc) carry = pe[jj].x * carry + pe[jj].y; }
                else {
#pragma unroll
                    for (int jj = 3; jj >= 0; --jj) if (jj > jc) carry = pe[jj].x * carry + pe[jj].y; }
            } else {
                float2 pe[32];
#pragma unroll
                for (int jj = 0; jj < 32; ++jj) pe[jj] = *(const float2*)(ag + (size_t)jj * 4 * D);
                if (d == 0) {
#pragma unroll
                    for (int jj = 0; jj < 32; ++jj) if (jj < jc) carry = pe[jj].x * carry + pe[jj].y; }
                else {
#pragma unroll
                    for (int jj = 31; jj >= 0; --jj) if (jj > jc) carry = pe[jj].x * carry + pe[jj].y; }
            }
            float h = carry;
            if (d == 0) {
#pragma unroll
                for (int s0 = 0; s0 < 64; s0 += 16) { float av[16], bv[16];
#pragma unroll
                    for (int i = 0; i < 16; ++i) { av[i] = Ad[(s0 + i) * 128 + c]; bv[i] = Bd[(s0 + i) * 128 + c]; }
#pragma unroll
                    for (int i = 0; i < 16; ++i) { h = av[i] * h + bv[i]; bv[i] = h; }
#pragma unroll
                    for (int i = 0; i < 16; ++i) Bd[(s0 + i) * 128 + c] = bv[i]; }
            } else {
#pragma unroll
                for (int s0 = 0; s0 < 64; s0 += 16) { float av[16], bv[16];
#pragma unroll
                    for (int i = 0; i < 16; ++i) { av[i] = Ad[(63 - s0 - i) * 128 + c]; bv[i] = Bd[(63 - s0 - i) * 128 + c]; }
#pragma unroll
                    for (int i = 0; i < 16; ++i) { h = av[i] * h + bv[i]; bv[i] = h; }
#pragma unroll
                    for (int i = 0; i < 16; ++i) Bd[(63 - s0 - i) * 128 + c] = bv[i]; }
            }
            if (!sample && ((d == 0 && jc == nch - 1) || (d == 1 && jc == 0))) F.new_s()[((size_t)(b * DEPTH + l) * 2 + d) * D + C] = h;
        }
    }
    if (PASS == 2) {
        __syncthreads();
        const int row = tid >> 3, c16 = (tid & 7) * 16;
        const LAS float* h0 = (const LAS float*)(lds + LRU_B0) + row * 128 + c16; const LAS float* h1 = (const LAS float*)(lds + LRU_B1) + row * 128 + c16;
        const bf16_t* gp = Zb + (size_t)(m0 + row) * INW + OFF_LG + C0 + c16;
        const u32x4 g0 = *(const u32x4*)gp, g1 = *(const u32x4*)(gp + 8);
        const unsigned gw[8] = {g0.x, g0.y, g0.z, g0.w, g1.x, g1.y, g1.z, g1.w};
        unsigned ow[8];
#pragma unroll
        for (int i = 0; i < 8; ++i) ow[i] = cvt_pk_bf16((h0[2 * i] + h1[2 * i]) * bflo(gw[i]), (h0[2 * i + 1] + h1[2 * i + 1]) * bfhi(gw[i]));
        bf16_t* yp = F.BR() + (size_t)1 * M * D + (size_t)(m0 + row) * D + C0 + c16;
        *(u32x4*)yp = (u32x4){ow[0], ow[1], ow[2], ow[3]}; *(u32x4*)(yp + 8) = (u32x4){ow[4], ow[5], ow[6], ow[7]};
    }
    __syncthreads();
}
template <int PASS>
__device__ __forceinline__ void lru_phase(const Frame& F, int l) {
    LruCtx X; int cur = -1;
    const float* state_l = inp<I_SL>(F) + (size_t)l * 2 * D;
    float* AGG = F.AGG();
    const float* cwl = inp<I_CW>(F) + (size_t)l * 4 * D; const float* cbl = inp<I_CB>(F) + (size_t)l * D;
    for (int u = F.bx; u < 384 * 16; u += F.G) {
        const int blk = u & 15, ck = u >> 4;
        if (blk != cur) { lru_ctx_load(F, l, blk, X); cur = blk; }
        lru_unit<PASS>(F, l, ck, blk, X, state_l, AGG, cwl, cbl);
    }
}
constexpr int CM_V = 0, CM_OUT = 32768, CM_OUT_PITCH = 528, CM_RS2 = CM_OUT + 128 * CM_OUT_PITCH;
static_assert(CM_RS2 + 512 <= MISC_OFF, "cm lds map");
struct CmCtx { bf16x8 wa[8]; };
__device__ __forceinline__ void cm_ctx_load(const Frame& F, int g, CmCtx& X) {
    const int qt = F.wave & 3, xl = F.lane & 31, hi = F.lane >> 5;
    const bf16_t* wp = F.CMW() + ((size_t)g * 128 + qt * 32 + xl) * 128 + hi * 8;
#pragma unroll
    for (int i = 0; i < 8; ++i) X.wa[i] = *(const bf16x8*)(wp + i * 16);
}
__device__ __forceinline__ void cm_unit(const Frame& F, int cn, int g, const CmCtx& X, const float* __restrict__ cmg, const float* __restrict__ bsg) {
    int tid_ = F.tid; asm volatile("" : "+v"(tid_));
    const int tid = tid_, lane = tid & 63, wave = __builtin_amdgcn_readfirstlane(tid >> 6), m0 = cn * 128, C0 = g * 128;
    LAS unsigned char* lds = F.lds;
    LAS float* RS = (LAS float*)(lds + CM_RS2);
    const bf16_t* Zb = F.Z();
    if (tid < 128) { const float* st = F.CVSTAT() + (size_t)(m0 + tid) * 32; float s = 0.f;
#pragma unroll
        for (int i = 0; i < 32; i += 4) { const f32x4 v = *(const f32x4*)(st + i); s += (v.x + v.y) + (v.z + v.w); }
        RS[tid] = rsqrtf(s * (1.f / D) + EPS); }
    __syncthreads();
    {
        const int sr = tid >> 4, sc = (tid & 15) * 8;
        const f32x4 ga = *(const f32x4*)(cmg + C0 + sc), gb = *(const f32x4*)(cmg + C0 + sc + 4);
#pragma unroll
        for (int i = 0; i < 4; ++i) {
            const int p = (i >> 1) * 64 + (i & 1) * 32 + sr; const float rs = RS[p];
            const u32x4 w = *(const u32x4*)(Zb + (size_t)(m0 + p) * INW + OFF_CV + C0 + sc);
            const f32x4 v0 = (f32x4){bflo(w.x), bfhi(w.x), bflo(w.y), bfhi(w.y)} * ga * rs, v1 = (f32x4){bflo(w.z), bfhi(w.z), bflo(w.w), bfhi(w.w)} * gb * rs;
            *(LAS u32x4*)(lds + CM_V + (i >> 1) * 16384 + att::v_st((i & 1) * 32 + sr, sc)) = pack8(v0, v1);
        }
    }
    __syncthreads();
    {
        const int qt = wave & 3, chh = wave >> 2, xl = lane & 31, hi = lane >> 5;
        f32x16 o0, o1;
#pragma unroll
        for (int r = 0; r < 16; ++r) { o0[r] = 0.f; o1[r] = 0.f; }
        const int vb = (int)(unsigned)(uintptr_t)(lds + CM_V) + att::v_rd_base(lane);
        if (chh == 0) {
            att::pv_one<0>(o0, vb, X.wa[0], X.wa[1], X.wa[2], X.wa[3]); att::pv_one<1>(o1, vb, X.wa[0], X.wa[1], X.wa[2], X.wa[3]);
            att::pv_one<0>(o0, vb + 16384, X.wa[4], X.wa[5], X.wa[6], X.wa[7]); att::pv_one<1>(o1, vb + 16384, X.wa[4], X.wa[5], X.wa[6], X.wa[7]);
        } else {
            att::pv_one<2>(o0, vb, X.wa[0], X.wa[1], X.wa[2], X.wa[3]); att::pv_one<3>(o1, vb, X.wa[0], X.wa[1], X.wa[2], X.wa[3]);
            att::pv_one<2>(o0, vb + 16384, X.wa[4], X.wa[5], X.wa[6], X.wa[7]); att::pv_one<3>(o1, vb + 16384, X.wa[4], X.wa[5], X.wa[6], X.wa[7]);
        }
#pragma unroll
        for (int r = 0; r < 16; ++r) { const int q = qt * 32 + crow(r, hi);
            *(LAS float*)(lds + CM_OUT + q * CM_OUT_PITCH + (chh * 64 + xl) * 4) = o0[r];
            *(LAS float*)(lds + CM_OUT + q * CM_OUT_PITCH + (chh * 64 + 32 + xl) * 4) = o1[r]; }
    }
    __syncthreads();
    {
        const int q = tid >> 2, c32 = (tid & 3) * 32; const float bias = bsg[q];
        const bf16_t* up = Zb + (size_t)(m0 + q) * INW + OFF_CU + C0 + c32;
        bf16_t* op = F.BR() + (size_t)2 * M * D + (size_t)(m0 + q) * D + C0 + c32;
#pragma unroll
        for (int i = 0; i < 4; ++i) {
            const u32x4 uw = *(const u32x4*)(up + i * 8);
            const f32x4 a = *(const LAS f32x4*)(lds + CM_OUT + q * CM_OUT_PITCH + (c32 + i * 8) * 4), b2 = *(const LAS f32x4*)(lds + CM_OUT + q * CM_OUT_PITCH + (c32 + i * 8 + 4) * 4);
            const f32x4 u0 = {bflo(uw.x), bfhi(uw.x), bflo(uw.y), bfhi(uw.y)}, u1 = {bflo(uw.z), bfhi(uw.z), bflo(uw.w), bfhi(uw.w)};
            *(u32x4*)(op + i * 8) = pack8(u0 * (a + bias), u1 * (b2 + bias));
        }
    }
}
__device__ __forceinline__ void cm_phase(const Frame& F, int l) {
    CmCtx X; int cur = -1;
    const float* cmg = inp<I_CMG>(F) + (size_t)l * D; const float* bs = inp<I_CMBS>(F) + (size_t)l * 16 * 128;
    for (int u = F.bx; u < 192 * 16; u += F.G) {
        const int g = u & 15, cn = u >> 4;
        if (g != cur) { cm_ctx_load(F, g, X); cur = g; }
        cm_unit(F, cn, g, X, cmg, bs + g * 128);
    }
    __syncthreads();
}
__device__ __forceinline__ void attn_phase(const Frame& F) {
    char* lds = (char*)F.lds;
    const att::bf16* Z = (const att::bf16*)F.Z(); const att::bf16* K = (const att::bf16*)F.KALL(); const att::bf16* V = (const att::bf16*)F.VALL(); att::bf16* O = (att::bf16*)F.BR();
    for (int id = F.bx; id < 1536; id += F.G) {
        size_t qrow, kvrow; int h, nkeys;
        if (id < 1024) { const int qb = id & 7, b = id >> 7; h = (id >> 3) & 15; qrow = (size_t)MP + (size_t)b * 2048 + qb * 256; kvrow = (size_t)MP + (size_t)b * 2304; nkeys = 2304; }
        else { const int id2 = id - 1024, b = id2 >> 4; h = id2 & 15; qrow = (size_t)b * 256; kvrow = qrow; nkeys = 256; }
        att::attn_dense_body<att::bf16>(Z + qrow * INW + OFF_Q + h * 128, K + kvrow * 512 + (h >> 2) * 128, V + kvrow * 512 + (h >> 2) * 128, O + qrow * D + h * 128, nkeys, lds);
    }
    __syncthreads();
}
}
#ifndef REP_G
#define REP_G 1
#endif
#ifndef REP_A
#define REP_A 1
#endif
#ifndef REP_L
#define REP_L 1
#endif
#ifndef REP_V
#define REP_V 1
#endif
#ifndef REP_C
#define REP_C 1
#endif
namespace fk {
#if REP_G > 1
template <class Base> struct RepOrder {
    Base b; int n;
    __device__ void init_n() { Unit u; n = 0; while (b.next(n, u)) ++n; }
    __device__ bool next(int i, Unit& u) const { if (i >= 2 * n) return false; return b.next(i >= n ? i - n : i, u); }
    __device__ __forceinline__ void a_ready(const Unit&) const {}
    __device__ __forceinline__ void done(const Unit&) const {}
};
#define GEMM_CALL(EPI, ORD, g, S, E) do { RepOrder<ORD> RS_; RS_.b = S; RS_.init_n(); pg8::gemm_phase<EPI, RepOrder<ORD>, true, true>(P.lds, g, RS_, E); } while (0)
#else
#define GEMM_CALL(EPI, ORD, g, S, E) pg8::gemm_phase<EPI, ORD, true, true>(P.lds, g, S, E)
#endif
__global__ void __launch_bounds__(NWAVES * 64, 2) mega(Params p) {
    extern __shared__ __attribute__((aligned(16))) unsigned char lds_raw[];
    Frame F;
    F.lds = (LAS unsigned char*)lds_raw;
    F.tid = threadIdx.x; F.lane = F.tid & 63; F.wave = __builtin_amdgcn_readfirstlane(F.tid >> 6);
    F.G = gridDim.x; { const int bx = blockIdx.x; F.vcu = (F.G % 8 == 0) ? (bx % 8) * (F.G / 8) + bx / 8 : bx; }
    F.gw = F.vcu * NWAVES + F.wave; F.NGW = F.G * NWAVES; F.bx = blockIdx.x;
    F.out = p.out; F.ws = p.ws; F.ka = (kaptr_t)__builtin_amdgcn_kernarg_segment_ptr();
    unsigned char* ws = p.ws;
    volatile LAS unsigned* MISC = (volatile LAS unsigned*)(F.lds + MISC_OFF);
    for (int u = F.tid; u < (LDS_BYTES - MISC_OFF) / 4; u += NWAVES * 64) ((LAS unsigned*)(F.lds + MISC_OFF))[u] = 0u;
    __syncthreads();
    unsigned* barw = (unsigned*)(ws + WS_CTL) + CW_BAR + p.li * XCD_BAR_WORDS;
    XcdBarrier bar = xcd_barrier_post(barw, MISC + 8);
    const int lo = p.ph_lo, hi = p.ph_hi;
#define IN_PH(k) (lo <= (k) && (k) < hi)
#define SEAM(k) do { if ((k) + 1 < hi) xcd_barrier(bar); } while (0)

    if (IN_PH(0)) { const Frame P = phase_frame(F);
convert_layer(P, 0); mod_partials(P); rope_table(P);
#if REP_V > 1
        __syncthreads(); convert_layer(P, 0); mod_partials(P);
#endif
 SEAM(0); }
    if (IN_PH(1)) { const Frame P = phase_frame(F); mod_reduce(P); SEAM(1); }
    if (IN_PH(2)) { const Frame P = phase_frame(F); rowlocal_phase<0>(P, 0); SEAM(2); }
    for (int l = 0; l < DEPTH; ++l) {
        const int pb = 3 + 9 * l;
        if (IN_PH(pb + 0)) { const Frame P = phase_frame(F);
            pg8::Gemm g{P.H(), P.WIN(), M, INW, D}; pg8::StaticOrder S; S.init(M, INW, P.G, P.bx);
            EpiIn E{P.Z(), P.VALL(), P.new_v(), P.CVSTAT(), l};

GEMM_CALL(EpiIn, pg8::StaticOrder, g, S, E);

            SEAM(pb + 0);
        }
        if (IN_PH(pb + 1)) { const Frame P = phase_frame(F);

prep_phase(P, l);

            __syncthreads();

lru_phase<1>(P, l);
#if REP_L > 1
            lru_phase<1>(P, l);
#endif


cm_phase(P, l);
#if REP_C > 1
            cm_phase(P, l);
#endif

            SEAM(pb + 1);
        }
        if (IN_PH(pb + 2)) { const Frame P = phase_frame(F);

attn_phase(P);
#if REP_A > 1
            attn_phase(P);
#endif


lru_phase<2>(P, l);
#if REP_L > 1
            lru_phase<2>(P, l);
#endif

            SEAM(pb + 2);
        }
        if (IN_PH(pb + 3)) { const Frame P = phase_frame(F);
            pg8::Gemm g{P.BR(), P.WBR(), 3 * M, 3 * D, D}; MergeOrder S; S.init(P.G, P.bx);
            EpiMerge E{P.Z(), P.MSCR() + (size_t)P.bx * 65536, P.H()};

GEMM_CALL(EpiMerge, MergeOrder, g, S, E);

            SEAM(pb + 3);
        }
        if (IN_PH(pb + 4)) { const Frame P = phase_frame(F);
            pg8::Gemm g{P.H(), P.WOUT(), M, D, D}; pg8::StaticOrder S; S.init(M, D, P.G, P.bx);
            EpiF E{P.Fb(), P.FSTAT()};

GEMM_CALL(EpiF, pg8::StaticOrder, g, S, E);
            SEAM(pb + 4);

        }
        if (IN_PH(pb + 5)) { const Frame P = phase_frame(F);
rowlocal_phase<1>(P, l);
 SEAM(pb + 5); }
        if (IN_PH(pb + 6)) { const Frame P = phase_frame(F);
            pg8::Gemm g{P.H(), P.WFF1(), M, DFF, D}; pg8::StaticOrder S; S.init(M, DFF, P.G, P.bx);
            EpiRelu2 E{P.FFH(), DFF};

GEMM_CALL(EpiRelu2, pg8::StaticOrder, g, S, E);

            SEAM(pb + 6);
        }
        if (IN_PH(pb + 7)) { const Frame P = phase_frame(F);
            pg8::Gemm g{P.FFH(), P.WFF2(), M, D, DFF}; pg8::StaticOrder S; S.init(M, D, P.G, P.bx);
            EpiF E{P.Fb(), P.FSTAT()};

GEMM_CALL(EpiF, pg8::StaticOrder, g, S, E);
            SEAM(pb + 7);

        }
        if (IN_PH(pb + 8)) { const Frame P = phase_frame(F);

rowlocal_phase<2>(P, l);


if (l + 1 < DEPTH) { __syncthreads(); convert_layer(P, l + 1); }
#if REP_V > 1
            if (l + 1 < DEPTH) { __syncthreads(); convert_layer(P, l + 1); }
#endif

            SEAM(pb + 8);
        }
    }
#undef IN_PH
#undef SEAM
}
}
extern "C" void kernel_launch(void* const* d_in, const int* in_sizes, int n_in, void* d_out, int out_size, void* d_ws, size_t ws_size, hipStream_t stream) {
    static int grid = 0;
    if (grid == 0) {
        if (n_in != 32 || out_size != 84410368 || ws_size < fk::WS_END) { fprintf(stderr, "kernel_launch: unexpected shapes: n_in %d out %d ws %zu (need %zu)\n", n_in, out_size, ws_size, (size_t)fk::WS_END); grid = -1; return; }
        int dev = 0, cus = 0;
        if (hipGetDevice(&dev) != hipSuccess || hipDeviceGetAttribute(&cus, hipDeviceAttributeMultiprocessorCount, dev) != hipSuccess) { grid = -1; return; }
        if (hipFuncSetAttribute((const void*)fk::mega, hipFuncAttributeMaxDynamicSharedMemorySize, fk::LDS_BYTES) != hipSuccess) { fprintf(stderr, "kernel_launch: hipFuncSetAttribute failed\n"); grid = -1; return; }
        int per_cu = 0;
        if (hipOccupancyMaxActiveBlocksPerMultiprocessor(&per_cu, (const void*)fk::mega, fk::NWAVES * 64, fk::LDS_BYTES) != hipSuccess || per_cu < 1) fprintf(stderr, "kernel_launch: occupancy query says %d blocks per CU\n", per_cu);
        (void)hipGetLastError();
        grid = cus < 256 ? cus : 256;
    }
    if (grid < 0) return;
    (void)hipMemsetAsync((char*)d_ws + fk::WS_CTL, 0, fk::CTL_ZERO_BYTES, stream);
    fk::Params p{};
    for (int i = 0; i < 32; ++i) p.in[i] = (const float*)d_in[i];
    p.out = (float*)d_out; p.ws = (unsigned char*)d_ws; p.ph_lo = 0; p.ph_hi = fk::NPHASE; p.li = 0; p.pad = 0;
    hipLaunchKernelGGL(fk::mega, dim3(grid), dim3(fk::NWAVES * 64), fk::LDS_BYTES, stream, p);
}
```

```cpp
#include <hip/hip_runtime.h>
#include <hip/hip_bf16.h>
#include <cstdio>
#include <cstdint>
namespace pg8 {
#define PG8_LAS __attribute__((address_space(3)))
typedef unsigned short bf16_t;
typedef short bf16x8 __attribute__((ext_vector_type(8)));
typedef float f32x4 __attribute__((ext_vector_type(4)));
typedef unsigned u32x4 __attribute__((ext_vector_type(4)));
constexpr int BM = 256, BK = 64, HALF = 128, HTB = HALF * BK * 2  , STAGE_BYTES = 8 * HTB, NXCD = 8, WGM = 8;

__host__ __device__ __forceinline__ int lds_byte(int r, int c) { const int st = (r >> 4) * 2 + (c >> 5), rr = r & 15, cc = c & 31, ob = rr * 64 + cc * 2; return st * 1024 + (ob ^ (((ob >> 9) & 1) << 5)); }
__host__ __device__ __forceinline__ void stage_rc(int b, int& R, int& C) { const int st = b / 1024, sb = b % 1024, swz = sb ^ (((sb >> 9) & 1) << 5); R = (st >> 1) * 16 + swz / 64; C = (st & 1) * 32 + (swz % 64) / 2; }
__host__ __device__ __forceinline__ int perm32(int rho) { const int n = rho >> 4, i = rho & 15; return 8 * (i >> 2) + 4 * n + (i & 3); }

struct Unit { int pm, pn; };
struct Gemm { const bf16_t* A; const bf16_t* Bt; int M, N, K; };

struct StaticOrder {
    int nM, nN, nwg, G, c;
    __host__ __device__ void init(int M, int N, int G_, int c_) { nM = M / BM; nN = N / BM; nwg = nM * nN; G = G_; c = c_; }
    __host__ __device__ bool next(int i, Unit& u) const {
        const long L = (long)i * G + c; if (L >= nwg) return false;
        int wgid = (int)L; { const int q = nwg / NXCD, r = nwg % NXCD, xcd = wgid % NXCD, off = wgid / NXCD; wgid = (xcd < r ? xcd * (q + 1) : r * (q + 1) + (xcd - r) * q) + off; }
        const int nig = WGM * nN, gid = wgid / nig, fm = gid * WGM, gsz = (nM - fm) < WGM ? (nM - fm) : WGM;
        u.pm = fm + ((wgid % nig) % gsz); u.pn = (wgid % nig) / gsz; return true;
    }
    __device__ __forceinline__ void a_ready(const Unit&) const {}
    __device__ __forceinline__ void done(const Unit&) const {}
};
__device__ __forceinline__ unsigned cvt_pk_bf16(float lo, float hi) { unsigned r; asm volatile("v_cvt_pk_bf16_f32 %0, %1, %2" : "=v"(r) : "v"(lo), "v"(hi)); return r; }
template <class Epi, class Sched, bool ALIGN_EPI = false, bool SP2 = false>
__device__ __forceinline__ void gemm_phase(PG8_LAS unsigned char* lds, const Gemm g, const Sched& S, const Epi& E) {
    int tid_ = threadIdx.x; asm volatile("" : "+v"(tid_));
    const int tid = tid_, wid = __builtin_amdgcn_readfirstlane(tid >> 6), lane = tid & 63, wr = wid >> 2, wc = wid & 3, fr = lane & 15, fq = lane >> 4;
    const int K = g.K, nt = K / BK;
    unsigned voffA[2], voffB[2];
#pragma unroll
    for (int i = 0; i < 2; ++i) { int R, C; stage_rc(tid * 16 + i * 8192, R, C); const int Rb = Epi::PERM ? ((R & ~31) + perm32(R & 31)) : R;
        voffA[i] = (unsigned)(R * K + C) * 2u; voffB[i] = (unsigned)(Rb * K + C) * 2u; }
    const size_t kstep = (size_t)(BK * 2);
    const size_t hstep = (size_t)HALF * K * 2;
    const size_t tstep = 2 * hstep;
    const unsigned ldsw = (unsigned)wid * 1024u;
    const int aoff = lds_byte(wr * 64 + fr, fq * 8), boff = lds_byte(wc * 32 + fr, fq * 8);
#define PG8_SA(b, h) (((b) * 2 + (h)) * HTB)
#define PG8_SB(b, h) ((4 + (b) * 2 + (h)) * HTB)
#define PG8_STAGE(bufoff, gbase, voff) do { _Pragma("unroll") for (int _i = 0; _i < 2; ++_i) \
        __builtin_amdgcn_global_load_lds((const unsigned*)((const char*)(gbase) + (voff)[_i]), (PG8_LAS unsigned*)(lds + (bufoff) + ldsw + _i * 8192), 16, 0, 0); } while (0)
#define PG8_LDA(dst, b, h) do { _Pragma("unroll") for (int m = 0; m < 4; ++m) _Pragma("unroll") for (int k = 0; k < 2; ++k) dst[m][k] = *(const PG8_LAS bf16x8*)(lds + PG8_SA(b, h) + aoff + m * 2048 + k * 1024); } while (0)
#define PG8_LDB(dst, b, h) do { _Pragma("unroll") for (int n = 0; n < 2; ++n) _Pragma("unroll") for (int k = 0; k < 2; ++k) dst[n][k] = *(const PG8_LAS bf16x8*)(lds + PG8_SB(b, h) + boff + n * 2048 + k * 1024); } while (0)
#define PG8_MMA(ai, bj, At, Bt) do { __builtin_amdgcn_s_setprio(1); _Pragma("unroll") for (int m = 0; m < 4; ++m) _Pragma("unroll") for (int n = 0; n < 2; ++n) _Pragma("unroll") for (int k = 0; k < 2; ++k) \
        acc[ai][bj][m][n] = __builtin_amdgcn_mfma_f32_16x16x32_bf16(Bt[n][k], At[m][k], acc[ai][bj][m][n], 0, 0, 0); __builtin_amdgcn_s_setprio(0); } while (0)
#define PG8_WAIT_V(n) asm volatile("s_waitcnt vmcnt(" #n ")" ::: "memory")
#define PG8_WAIT_L(n) asm volatile("s_waitcnt lgkmcnt(" #n ")" ::: "memory")
#define PG8_BAR __builtin_amdgcn_s_barrier()
#define PG8_SCHED __builtin_amdgcn_sched_barrier(0)
    Unit cur, nxt; int ui = 0;
    if (!S.next(0, cur)) return;
    f32x4 acc[2][2][4][2];
#pragma unroll
    for (int a = 0; a < 2; ++a)
#pragma unroll
        for (int b = 0; b < 2; ++b)
#pragma unroll
            for (int m = 0; m < 4; ++m)
#pragma unroll
                for (int n = 0; n < 2; ++n) acc[a][b][m][n] = (f32x4){0.f, 0.f, 0.f, 0.f};
    bf16x8 At[4][2], B0[2][2], B1[2][2];
    const char* cA = (const char*)g.A + (size_t)cur.pm * tstep; const char* cB = (const char*)g.Bt + (size_t)cur.pn * tstep;
    S.a_ready(cur);
    if constexpr (SP2) {
        PG8_STAGE(PG8_SB(0, 0), cB, voffB); PG8_STAGE(PG8_SB(0, 1), cB + hstep, voffB); PG8_STAGE(PG8_SA(0, 0), cA, voffA); PG8_STAGE(PG8_SA(0, 1), cA + hstep, voffA);
        if (wr == 1) PG8_BAR;
        PG8_WAIT_V(2); PG8_BAR;
        PG8_STAGE(PG8_SB(1, 0), cB + kstep, voffB); PG8_STAGE(PG8_SA(1, 0), cA + kstep, voffA); PG8_STAGE(PG8_SB(1, 1), cB + hstep + kstep, voffB);
        PG8_WAIT_V(6); PG8_BAR;
    } else {
        PG8_STAGE(PG8_SB(0, 0), cB, voffB); PG8_STAGE(PG8_SA(0, 0), cA, voffA); PG8_STAGE(PG8_SB(0, 1), cB + hstep, voffB); PG8_STAGE(PG8_SA(0, 1), cA + hstep, voffA);
        if (wr == 1) PG8_BAR;
        PG8_WAIT_V(4); PG8_BAR;
        PG8_STAGE(PG8_SB(1, 0), cB + kstep, voffB); PG8_STAGE(PG8_SA(1, 0), cA + kstep, voffA); PG8_STAGE(PG8_SB(1, 1), cB + hstep + kstep, voffB);
        PG8_WAIT_V(6); PG8_BAR;
    }
    for (;;) {
        const bool has_next = S.next(ui + 1, nxt);
        const char* nA = has_next ? (const char*)g.A + (size_t)nxt.pm * tstep : cA; const char* nB = has_next ? (const char*)g.Bt + (size_t)nxt.pn * tstep : cB;
        for (int t = 0; t < nt; t += 2) {
            const bool last = (t == nt - 2);
            const char* a1 = cA + (size_t)(t + 1) * kstep;
            const char* a2 = last ? nA : cA + (size_t)(t + 2) * kstep; const char* b2 = last ? nB : cB + (size_t)(t + 2) * kstep;
            const char* a3 = a2 + kstep; const char* b3 = b2 + kstep;
            if (last && has_next) S.a_ready(nxt);
            if constexpr (SP2) {
            PG8_LDB(B0, 0, 0); PG8_LDB(B1, 0, 1); PG8_SCHED; PG8_LDA(At, 0, 0); PG8_STAGE(PG8_SA(1, 1), a1 + hstep, voffA);
            PG8_WAIT_V(8); PG8_WAIT_L(0); PG8_BAR; PG8_MMA(0, 0, At, B0); PG8_MMA(0, 1, At, B1); PG8_BAR; PG8_SCHED;
            PG8_LDA(At, 0, 1); PG8_STAGE(PG8_SB(0, 0), b2, voffB); PG8_STAGE(PG8_SB(0, 1), b2 + hstep, voffB); PG8_STAGE(PG8_SA(0, 0), a2, voffA);
            PG8_WAIT_V(8); PG8_WAIT_L(0); PG8_BAR; PG8_MMA(1, 0, At, B0); PG8_MMA(1, 1, At, B1); PG8_BAR; PG8_SCHED;
            PG8_LDB(B0, 1, 0); PG8_LDB(B1, 1, 1); PG8_SCHED; PG8_LDA(At, 1, 0); PG8_STAGE(PG8_SA(0, 1), a2 + hstep, voffA);
            PG8_WAIT_V(8); PG8_WAIT_L(0); PG8_BAR; PG8_MMA(0, 0, At, B0); PG8_MMA(0, 1, At, B1); PG8_BAR; PG8_SCHED;
            PG8_LDA(At, 1, 1); PG8_STAGE(PG8_SB(1, 0), b3, voffB); PG8_STAGE(PG8_SB(1, 1), b3 + hstep, voffB); PG8_STAGE(PG8_SA(1, 0), a3, voffA);
            PG8_WAIT_V(8); PG8_WAIT_L(0); PG8_BAR; PG8_MMA(1, 0, At, B0); PG8_MMA(1, 1, At, B1); PG8_BAR; PG8_SCHED;
            } else {
            PG8_LDB(B0, 0, 0); PG8_SCHED; PG8_LDA(At, 0, 0); PG8_STAGE(PG8_SA(1, 1), a1 + hstep, voffA);
            PG8_WAIT_L(8); PG8_BAR; PG8_WAIT_L(0); PG8_MMA(0, 0, At, B0); PG8_BAR; PG8_SCHED;
            PG8_LDB(B1, 0, 1); PG8_STAGE(PG8_SB(0, 0), b2, voffB);
            PG8_BAR; PG8_WAIT_L(0); PG8_MMA(0, 1, At, B1); PG8_BAR;
            PG8_LDA(At, 0, 1); PG8_STAGE(PG8_SA(0, 0), a2, voffA);
            PG8_BAR; PG8_WAIT_L(0); PG8_MMA(1, 0, At, B0); PG8_BAR; PG8_SCHED;
            PG8_STAGE(PG8_SB(0, 1), b2 + hstep, voffB);
            PG8_WAIT_V(6); PG8_BAR; PG8_MMA(1, 1, At, B1); PG8_BAR;
            PG8_LDB(B0, 1, 0); PG8_SCHED; PG8_LDA(At, 1, 0); PG8_STAGE(PG8_SA(0, 1), a2 + hstep, voffA);
            PG8_WAIT_L(8); PG8_BAR; PG8_WAIT_L(0); PG8_MMA(0, 0, At, B0); PG8_BAR; PG8_SCHED;
            PG8_LDB(B1, 1, 1); PG8_STAGE(PG8_SB(1, 0), b3, voffB);
            PG8_BAR; PG8_WAIT_L(0); PG8_MMA(0, 1, At, B1); PG8_BAR;
            PG8_LDA(At, 1, 1); PG8_STAGE(PG8_SA(1, 0), a3, voffA);
            PG8_BAR; PG8_WAIT_L(0); PG8_MMA(1, 0, At, B0); PG8_BAR; PG8_SCHED;
            PG8_STAGE(PG8_SB(1, 1), b3 + hstep, voffB);
            PG8_WAIT_V(6); PG8_BAR; PG8_MMA(1, 1, At, B1); PG8_BAR;
            }
        }
        if constexpr (ALIGN_EPI) { if (wr == 0) PG8_BAR; }
        if constexpr (!Epi::AFTER_DRAIN) { E(acc, cur, wr, wc, fr, fq); S.done(cur); }
        if (!has_next) break;
#pragma unroll
        for (int a = 0; a < 2; ++a)
#pragma unroll
            for (int b = 0; b < 2; ++b)
#pragma unroll
                for (int m = 0; m < 4; ++m)
#pragma unroll
                    for (int n = 0; n < 2; ++n) acc[a][b][m][n] = (f32x4){0.f, 0.f, 0.f, 0.f};
        cur = nxt; cA = nA; cB = nB; ++ui;
        if constexpr (ALIGN_EPI) { if (wr == 1) PG8_BAR; }
    }
    PG8_WAIT_V(0);
    if constexpr (!ALIGN_EPI) { if (wr == 0) PG8_BAR; }
    PG8_BAR;
    if constexpr (Epi::AFTER_DRAIN) { E.fused(acc, cur, wr, wc, fr, fq, lds, wid, lane); S.done(cur); }
#undef PG8_SA
#undef PG8_SB
#undef PG8_STAGE
#undef PG8_LDA
#undef PG8_LDB
#undef PG8_MMA
#undef PG8_WAIT_V
#undef PG8_WAIT_L
#undef PG8_BAR
#undef PG8_SCHED
}
}
#define GAS __attribute__((address_space(1)))
#define LAS __attribute__((address_space(3)))
typedef unsigned short bf16;
typedef unsigned v4u __attribute__((ext_vector_type(4)));
typedef float f32x4 __attribute__((ext_vector_type(4)));
typedef short bf16x8 __attribute__((ext_vector_type(8)));
typedef GAS unsigned gu32;
typedef GAS unsigned long long gu64;
#define RLX_AGENT __ATOMIC_RELAXED, __HIP_MEMORY_SCOPE_AGENT
#define LDS_WAIT() asm volatile("s_waitcnt lgkmcnt(0)" ::: "memory")
#define VM_WAIT() asm volatile("s_waitcnt vmcnt(0)" ::: "memory")
__device__ __forceinline__ unsigned long long rt() { return __builtin_amdgcn_s_memrealtime(); }
__device__ __forceinline__ unsigned f2bf(float f) { unsigned u = __builtin_bit_cast(unsigned, f); return (u + 0x7fffu + ((u >> 16) & 1u)) >> 16; }
__device__ __forceinline__ unsigned pk2(float lo, float hi) { return f2bf(lo) | (f2bf(hi) << 16); }

#define XB_TMO      128
#define XB_XCNT(j)  (256  + 64 * (j))
#define XB_XSUB(j)  (1280 + 64 * (j))
#define XB_XGEN(j)  (2304 + 64 * (j))
#define XB_TOP      3328
#define XB_TOPGEN   3392
#define XCD_BAR_WORDS 3456
#define XB_SPIN_CAP (1u << 18)

__device__ __forceinline__ unsigned xb_ld(unsigned* p)              { return __hip_atomic_load(p, __ATOMIC_RELAXED, __HIP_MEMORY_SCOPE_AGENT); }
__device__ __forceinline__ unsigned xb_add(unsigned* p, unsigned v) { return __hip_atomic_fetch_add(p, v, __ATOMIC_RELAXED, __HIP_MEMORY_SCOPE_AGENT); }
__device__ __forceinline__ unsigned xb_xcc_id() { return (unsigned)__builtin_amdgcn_s_getreg((3 << 11) | 20) & 0xFu; }
#define XB_SPIN(cond, bar) do { unsigned _sp = 0; while (cond) { __builtin_amdgcn_s_sleep(1); \
    if ((++_sp & 255u) == 0u) { if (xb_ld(&(bar)[XB_TMO])) break; if (_sp > XB_SPIN_CAP) { atomicAdd(&(bar)[XB_TMO], 1u); break; } } } } while (0)

struct XcdBarrier {
    unsigned* bar; unsigned x;
    volatile LAS unsigned* st;
};

__device__ __forceinline__ XcdBarrier xcd_barrier_post(unsigned* bar, volatile LAS unsigned* st) {
    XcdBarrier b; b.bar = bar; b.x = xb_xcc_id(); b.st = st;
    if (threadIdx.x == 0) (void)xb_add(&bar[XB_XCNT(b.x)], 1u);
    return b;
}
__device__ __forceinline__ void xcd_barrier_complete(unsigned* bar, unsigned x, unsigned& nloc, unsigned& nx) {
    const unsigned G = gridDim.x * gridDim.y * gridDim.z;
    unsigned sum, cnt, mine, sp = 0u;
    for (;;) {
        sum = 0u; cnt = 0u; mine = 0u;
#pragma unroll
        for (unsigned j = 0; j < 16; ++j) { const unsigned c = xb_ld(&bar[XB_XCNT(j)]); sum += c; cnt += (c > 0u) ? 1u : 0u; mine = (j == x) ? c : mine; }
        if (sum == G) break;
        __builtin_amdgcn_s_sleep(1);
        if ((++sp & 255u) == 0u) { if (xb_ld(&bar[XB_TMO])) break; if (sp > XB_SPIN_CAP) { atomicAdd(&bar[XB_TMO], 1u); break; } }
    }
    nloc = mine > 0u ? mine : 1u; nx = cnt > 0u ? cnt : 1u;
}

__device__ __forceinline__ void xcd_barrier(const XcdBarrier& b) {
    asm volatile("s_waitcnt vmcnt(0)" ::: "memory");
    __syncthreads();
    if (threadIdx.x == 0) {
        unsigned* bar = b.bar;
        __builtin_amdgcn_s_waitcnt(0);
        unsigned nloc = b.st[0], nx = b.st[1];
        if (nloc == 0u) { xcd_barrier_complete(bar, b.x, nloc, nx); b.st[0] = nloc; b.st[1] = nx; }
        const unsigned old = xb_add(&bar[XB_XSUB(b.x)], 1u);
        const unsigned gen = old / nloc;
        if (old + 1u == (gen + 1u) * nloc) {
            __builtin_amdgcn_fence(__ATOMIC_RELEASE, "agent");
            asm volatile("s_waitcnt vmcnt(0)" ::: "memory");
            const unsigned og = xb_add(&bar[XB_TOP], 1u);
            const unsigned tg = og / nx;
            if (og + 1u == (tg + 1u) * nx) xb_add(&bar[XB_TOPGEN], 1u);
            else XB_SPIN(xb_ld(&bar[XB_TOPGEN]) == tg, bar);
            __builtin_amdgcn_fence(__ATOMIC_ACQUIRE, "agent");
            xb_add(&bar[XB_XGEN(b.x)], 1u);
            asm volatile("s_waitcnt vmcnt(0)" ::: "memory");
        } else {
            XB_SPIN(xb_ld(&bar[XB_XGEN(b.x)]) == gen, bar);
            __builtin_amdgcn_fence(__ATOMIC_ACQUIRE, "agent");
            asm volatile("s_waitcnt vmcnt(0)" ::: "memory");
        }
    }
    __syncthreads();
}
namespace att {
constexpr int   D = 128, NW = 8, QBLK = 32, KVBLK = 64;
constexpr float SCALE = 0.088388347648318440f;
constexpr float THR = 8.f;
constexpr int SDEPTH = 2;
constexpr int LDQ = 17408, LDK = 512, LDO = 2048;
constexpr size_t SHM_V = KVBLK * D * 2, SHM_K = KVBLK * D * 2, SHM_ATTN = 2 * SHM_V + 2 * SHM_K + NW * 64 * 4;
using bf16 = __hip_bfloat16;
using bf16x8 = __attribute__((ext_vector_type(8))) short;
using s16x4  = __attribute__((ext_vector_type(4))) short;
using f32x16 = __attribute__((ext_vector_type(16))) float;
using f32x8  = __attribute__((ext_vector_type(8))) float;
using u32x4  = __attribute__((ext_vector_type(4))) unsigned;
#define KSWZ(row, colB) ((row) * 256 + ((colB) ^ (((row) & 7) << 4)))
#define SBAR() __builtin_amdgcn_sched_barrier(0)
__device__ __forceinline__ int crow(int r, int hi) { return (r & 3) + 8 * (r >> 2) + 4 * hi; }
__device__ __forceinline__ unsigned cvtpk(float lo, float hi) {
  unsigned r; asm volatile("v_cvt_pk_bf16_f32 %0, %1, %2" : "=v"(r) : "v"(lo), "v"(hi)); return r;
}
template <typename TIn> struct Stage;
template <> struct Stage<bf16>  { using T = bf16x8;
  __device__ static __forceinline__ T ld8(const bf16* p) { return *reinterpret_cast<const bf16x8*>(p); }
  __device__ static __forceinline__ bf16x8 tobf(T x) { return x; } };
template <> struct Stage<float> { using T = f32x8;
  __device__ static __forceinline__ T ld8(const float* p) { return *reinterpret_cast<const f32x8*>(p); }
  __device__ static __forceinline__ bf16x8 tobf(T x) {
    u32x4 w = {cvtpk(x[0], x[1]), cvtpk(x[2], x[3]), cvtpk(x[4], x[5]), cvtpk(x[6], x[7])}; return *reinterpret_cast<bf16x8*>(&w); } };

__device__ __forceinline__ void partialSM(f32x16& p0, f32x16& p1, float& m_reg, float& mn, float& alpha) {
  constexpr float C = SCALE * 1.4426950408889634f;
  float pmax = p0[0]; for (int r = 1; r < 16; ++r) pmax = fmaxf(pmax, p0[r]); for (int r = 0; r < 16; ++r) pmax = fmaxf(pmax, p1[r]);
  { auto rr = __builtin_amdgcn_permlane32_swap(__float_as_uint(pmax), __float_as_uint(pmax), false, false);
    pmax = fmaxf(__uint_as_float(rr[0]), __uint_as_float(rr[1])); }
  if (__builtin_expect(__all(pmax - m_reg <= THR / SCALE), 1)) { mn = m_reg; alpha = 1.f; }
  else { mn = fmaxf(m_reg, pmax); alpha = __builtin_amdgcn_exp2f((m_reg - mn) * C); m_reg = mn; }
  float mnC = -mn * C;
  for (int r = 0; r < 16; ++r) p0[r] = fmaf(p0[r], C, mnC); for (int r = 0; r < 16; ++r) p1[r] = fmaf(p1[r], C, mnC);
  for (int r = 0; r < 16; ++r) p0[r] = __builtin_amdgcn_exp2f(p0[r]);
}
__device__ __forceinline__ void finishSM(f32x16& p0, f32x16& p1, float alpha, float& l_reg, bf16x8& pa0, bf16x8& pa1, bf16x8& pa2, bf16x8& pa3) {
  for (int r = 0; r < 16; ++r) p1[r] = __builtin_amdgcn_exp2f(p1[r]);
  float ps = 0; for (int r = 0; r < 16; ++r) ps += p0[r]; for (int r = 0; r < 16; ++r) ps += p1[r];
  { auto rr = __builtin_amdgcn_permlane32_swap(__float_as_uint(ps), __float_as_uint(ps), false, false);
    ps = __uint_as_float(rr[0]) + __uint_as_float(rr[1]); }
  l_reg = l_reg * alpha + ps;
#define PK4(P, BASE, OUT) do { unsigned a0 = cvtpk(P[BASE + 0], P[BASE + 1]), a1 = cvtpk(P[BASE + 2], P[BASE + 3]);   \
    unsigned b0 = cvtpk(P[BASE + 4], P[BASE + 5]), b1 = cvtpk(P[BASE + 6], P[BASE + 7]);                              \
    auto r0 = __builtin_amdgcn_permlane32_swap(a0, b0, false, false); auto r1 = __builtin_amdgcn_permlane32_swap(a1, b1, false, false); \
    u32x4 w = {r0[0], r1[0], r0[1], r1[1]}; OUT = *reinterpret_cast<bf16x8*>(&w); } while (0)
  PK4(p0, 0, pa0); PK4(p0, 8, pa1); PK4(p1, 0, pa2); PK4(p1, 8, pa3);
#undef PK4
}
__device__ __forceinline__ void qkt(f32x16& p0, f32x16& p1, const bf16* Ks, const bf16x8* qr, int r32, int hi) {
  p0 = f32x16{}; p1 = f32x16{};
  for (int d0 = 0; d0 < 8; ++d0) { int cb = (d0 * 16 + hi * 8) * 2;
    bf16x8 b0 = *reinterpret_cast<const bf16x8*>((const char*)Ks + KSWZ(r32, cb));
    bf16x8 b1 = *reinterpret_cast<const bf16x8*>((const char*)Ks + KSWZ(32 + r32, cb));
    p0 = __builtin_amdgcn_mfma_f32_32x32x16_bf16(b0, qr[d0], p0, 0, 0, 0);
    p1 = __builtin_amdgcn_mfma_f32_32x32x16_bf16(b1, qr[d0], p1, 0, 0, 0); }
}
__device__ __forceinline__ int v_st(int k, int c) { const int kk = (k & ~0xC) | ((k & 4) << 1) | ((k & 8) >> 1); return ((kk >> 3) * 4 + (c >> 5)) * 512 + ((kk & 7) * 32 + (c & 31)) * 2; }
__device__ __forceinline__ int v_rd_base(int lane) { return ((lane & 3) << 3) | (((lane >> 2) & 3) << 6) | (((lane >> 4) & 1) << 5) | (((lane >> 5) & 1) << 8); }
constexpr int v_rd_off(int d0, int ks, int half) { return d0 * 512 + ks * 4096 + half * 2048; }
template <int OFF> __device__ __forceinline__ s16x4 tr_read(int vb) {
  s16x4 r; asm volatile("ds_read_b64_tr_b16 %0, %1 offset:%2" : "=&v"(r) : "v"(vb), "i"(OFF) : "memory"); return r;
}
template <int D0> __device__ __forceinline__ void pv_one(f32x16& od, int vb, bf16x8 pa0, bf16x8 pa1, bf16x8 pa2, bf16x8 pa3) {
  const s16x4 l0 = tr_read<v_rd_off(D0, 0, 0)>(vb), h0 = tr_read<v_rd_off(D0, 0, 1)>(vb), l1 = tr_read<v_rd_off(D0, 1, 0)>(vb), h1 = tr_read<v_rd_off(D0, 1, 1)>(vb);
  const s16x4 l2 = tr_read<v_rd_off(D0, 2, 0)>(vb), h2 = tr_read<v_rd_off(D0, 2, 1)>(vb), l3 = tr_read<v_rd_off(D0, 3, 0)>(vb), h3 = tr_read<v_rd_off(D0, 3, 1)>(vb);
  asm volatile("s_waitcnt lgkmcnt(0)" ::: "memory"); SBAR();
#define PK(L, H) (bf16x8){L[0], L[1], L[2], L[3], H[0], H[1], H[2], H[3]}
  od = __builtin_amdgcn_mfma_f32_32x32x16_bf16(pa0, PK(l0, h0), od, 0, 0, 0);
  od = __builtin_amdgcn_mfma_f32_32x32x16_bf16(pa1, PK(l1, h1), od, 0, 0, 0);
  od = __builtin_amdgcn_mfma_f32_32x32x16_bf16(pa2, PK(l2, h2), od, 0, 0, 0);
  od = __builtin_amdgcn_mfma_f32_32x32x16_bf16(pa3, PK(l3, h3), od, 0, 0, 0);
#undef PK
}
__device__ __forceinline__ void pv_d0(f32x16* o, int vb, bf16x8 pa0, bf16x8 pa1, bf16x8 pa2, bf16x8 pa3) {
  pv_one<0>(o[0], vb, pa0, pa1, pa2, pa3); pv_one<1>(o[1], vb, pa0, pa1, pa2, pa3); pv_one<2>(o[2], vb, pa0, pa1, pa2, pa3); pv_one<3>(o[3], vb, pa0, pa1, pa2, pa3);
}

template <typename TQ>
__device__ __forceinline__ void attn_dense_body(const TQ* __restrict__ Qb, const bf16* __restrict__ Kh, const bf16* __restrict__ Vh,
                                                bf16* __restrict__ Ob, int seq, char* lds) {
  using St = Stage<bf16>; using SQ = Stage<TQ>;
  int tid_ = threadIdx.x; asm volatile("" : "+v"(tid_));
  const int tid = tid_, wid = tid >> 6, lane = tid & 63, r32 = lane & 31, hi = lane >> 5;
  bf16* V_lds = (bf16*)lds; bf16* K_lds = (bf16*)(lds + 2 * SHM_V);
  float* ws = (float*)(lds + 2 * SHM_V + 2 * SHM_K) + wid * 64; float* li_l = ws; float* al_l = ws + 32;
  float m_reg = -1e30f, l_reg = 0; f32x16 o[4] = {}; bf16x8 qr[8];
  const TQ* Qw = Qb + (long)(wid * QBLK + r32) * LDQ + hi * 8;
#pragma unroll
  for (int d0 = 0; d0 < 8; ++d0) qr[d0] = SQ::tobf(SQ::ld8(Qw + d0 * 16));
  const int sr = tid >> 4, sc = (tid & 15) * 8, vst0 = v_st(sr, sc), vst1 = v_st(32 + sr, sc);
  const int vb0 = (int)(uintptr_t)V_lds + v_rd_base(lane);
  struct { typename St::T vs0, vs1, ks0, ks1; } sr_[SDEPTH];
#define SLOAD(i, k0) do { sr_[i].vs0 = St::ld8(&Vh[(long)((k0) + sr) * LDK + sc]); sr_[i].vs1 = St::ld8(&Vh[(long)((k0) + 32 + sr) * LDK + sc]); \
    sr_[i].ks0 = St::ld8(&Kh[(long)((k0) + sr) * LDK + sc]); sr_[i].ks1 = St::ld8(&Kh[(long)((k0) + 32 + sr) * LDK + sc]); } while (0)
#define SWRITE(b, i) do { *(bf16x8*)((char*)V_lds + (b) * SHM_V + vst0) = St::tobf(sr_[i].vs0);          \
    *(bf16x8*)((char*)V_lds + (b) * SHM_V + vst1) = St::tobf(sr_[i].vs1); int kc = sc * 2;               \
    *(bf16x8*)((char*)K_lds + (b) * SHM_K + KSWZ(sr, kc)) = St::tobf(sr_[i].ks0);                       \
    *(bf16x8*)((char*)K_lds + (b) * SHM_K + KSWZ(32 + sr, kc)) = St::tobf(sr_[i].ks1); } while (0)
#define SWAIT() do { if constexpr (SDEPTH == 2) asm volatile("s_waitcnt vmcnt(4)" ::: "memory"); else asm volatile("s_waitcnt vmcnt(0)" ::: "memory"); } while (0)
#define RESC(a) do { if (__any((a) < 1.f)) { if (hi == 0) al_l[r32] = (a); asm volatile("s_waitcnt lgkmcnt(0)" ::: "memory"); \
    for (int d = 0; d < 4; ++d) for (int r = 0; r < 16; ++r) o[d][r] *= al_l[crow(r, hi)]; } } while (0)
  f32x16 pA0, pA1, pB0, pB1; float mnA, mnB, alA, alB; bf16x8 pa0, pa1, pa2, pa3; const int NT = seq / KVBLK;
  constexpr int SE = 0, SO = SDEPTH - 1;
  SLOAD(SE, 0); asm volatile("s_waitcnt vmcnt(0)" ::: "memory"); SWRITE(0, SE); __syncthreads();
  qkt(pA0, pA1, K_lds, qr, r32, hi); partialSM(pA0, pA1, m_reg, mnA, alA);
  SLOAD(SO, KVBLK); if constexpr (SDEPTH == 2) { if (2 < NT) SLOAD(SE, 2 * KVBLK); }
  SWAIT(); SWRITE(1, SO); __syncthreads();
  for (int j = 1; j + 1 < NT; j += 2) {
    SBAR(); qkt(pB0, pB1, (bf16*)((char*)K_lds + SHM_K), qr, r32, hi);
    finishSM(pA0, pA1, alA, l_reg, pa0, pa1, pa2, pa3); SBAR();
    SLOAD(SO, (j + SDEPTH) * KVBLK); SBAR();
    pv_d0(o, vb0, pa0, pa1, pa2, pa3); partialSM(pB0, pB1, m_reg, mnB, alB);
    __syncthreads(); SWAIT(); SWRITE(0, SE);
    RESC(alB); __syncthreads();
    SBAR(); qkt(pA0, pA1, K_lds, qr, r32, hi);
    finishSM(pB0, pB1, alB, l_reg, pa0, pa1, pa2, pa3); SBAR();
    if (SDEPTH == 1 || j + 3 < NT) SLOAD(SE, (j + 1 + SDEPTH) * KVBLK); SBAR();
    pv_d0(o, vb0 + (int)SHM_V, pa0, pa1, pa2, pa3); partialSM(pA0, pA1, m_reg, mnA, alA);
    __syncthreads(); SWAIT(); SWRITE(1, SO);
    RESC(alA); __syncthreads();
  }
  SBAR(); qkt(pB0, pB1, (bf16*)((char*)K_lds + SHM_K), qr, r32, hi);
  finishSM(pA0, pA1, alA, l_reg, pa0, pa1, pa2, pa3); SBAR();
  pv_d0(o, vb0, pa0, pa1, pa2, pa3); partialSM(pB0, pB1, m_reg, mnB, alB);
  __syncthreads(); RESC(alB);
  finishSM(pB0, pB1, alB, l_reg, pa0, pa1, pa2, pa3); SBAR();
  pv_d0(o, vb0 + (int)SHM_V, pa0, pa1, pa2, pa3);
  if (hi == 0) li_l[r32] = l_reg; asm volatile("s_waitcnt lgkmcnt(0)" ::: "memory");
  float rli[16];
#pragma unroll
  for (int r = 0; r < 16; ++r) rli[r] = __builtin_amdgcn_rcpf(li_l[crow(r, hi)]);
  bf16* Ow = Ob + (long)(wid * QBLK) * LDO;
#pragma unroll
  for (int r = 0; r < 16; ++r) { int orow = crow(r, hi);
    for (int d0 = 0; d0 < 4; ++d0) Ow[(long)orow * LDO + d0 * 32 + r32] = __float2bfloat16(o[d0][r] * rli[r]); }
#undef SLOAD
#undef SWRITE
#undef SWAIT
#undef RESC
}
#undef KSWZ
#undef SBAR
}
namespace fk {
using pg8::bf16_t; using pg8::f32x4; using pg8::u32x4; using pg8::Unit; using pg8::cvt_pk_bf16;
typedef unsigned u32x2 __attribute__((ext_vector_type(2)));
typedef float f32x16 __attribute__((ext_vector_type(16)));
constexpr int M = 24576, MP = 8192, D = 2048, INW = 17408, DFF = 8192, DEPTH = 4, NWAVES = 8, NCOND = 9;
constexpr int OFF_Q = 0, OFF_K = 2048, OFF_V = 2560, OFF_LX = 3072, OFF_LG = 5120, OFF_CU = 7168, OFF_CV = 9216, OFF_G = 11264;
constexpr int NKVROWS = 26624;
constexpr float EPS = 1e-6f;
constexpr int NPHASE = 3 + 9 * DEPTH;
constexpr int NMODK = 32;
constexpr size_t MiB = 1u << 20;
constexpr size_t WS_CTL = 0, CTL_ZERO_BYTES = 1 * MiB;
constexpr size_t WS_MODP = 716 * MiB  , WS_MOD = 28 * MiB, WS_ROPE = 30 * MiB, WS_CVSTAT = 31 * MiB, WS_FSTAT = 34 * MiB, WS_AGG = 37 * MiB, WS_WLRU = 49 * MiB, WS_CMW = 51 * MiB;
constexpr size_t WS_WIN = 52 * MiB, WS_WBR = 120 * MiB, WS_WOUT = 144 * MiB, WS_WFF1 = 152 * MiB, WS_WFF2 = 184 * MiB;
constexpr size_t WS_H = 216 * MiB, WS_KALL = 312 * MiB, WS_VALL = 338 * MiB, WS_BR = 364 * MiB, WS_MSCR = 652 * MiB, WS_Z = 716 * MiB, WS_END = 1532 * MiB;
constexpr size_t WS_FFH = WS_Z, WS_F = WS_Z + 384 * MiB;
constexpr int CW_BAR = 4096;
constexpr int RING_BYTES = 131072;
constexpr int LRU_XC = 0, LRU_XC_PITCH = 272, LRU_A0 = 17408, LRU_B0 = LRU_A0 + 32768, LRU_A1 = LRU_B0 + 32768, LRU_B1 = LRU_A1 + 32768, LRU_CARRY = LRU_B1 + 32768;
constexpr int CM_VT = 0, CM_VT_PITCH = 272, CM_RS = 128 * 272;
constexpr int MISC_OFF = 150528, LDS_BYTES = 151552;
static_assert(LRU_CARRY + 2048 <= MISC_OFF, "lds map");

struct Params { const float* in[32]; float* out; unsigned char* ws; int ph_lo, ph_hi, li, pad; };

typedef const __attribute__((address_space(4))) void* kaptr_t;
struct Frame {
    LAS unsigned char* lds;
    int tid, lane, wave, vcu, G, gw, NGW, bx;
    float* out; unsigned char* ws; kaptr_t ka;
    __device__ __forceinline__ float* x() const { return out; }
    __device__ __forceinline__ float* new_k() const { return out + 50331648L; }
    __device__ __forceinline__ float* new_v() const { return out + 50331648L + 16777216L; }
    __device__ __forceinline__ float* new_s() const { return out + 50331648L + 2 * 16777216L; }
#define FK_WSP(name, type, off) __device__ __forceinline__ type* name() const { return (type*)(ws + (off)); }
    FK_WSP(MODP, float, WS_MODP) FK_WSP(MOD, float, WS_MOD) FK_WSP(ROPE, float, WS_ROPE) FK_WSP(CVSTAT, float, WS_CVSTAT) FK_WSP(FSTAT, float, WS_FSTAT) FK_WSP(AGG, float, WS_AGG) FK_WSP(MSCR, float, WS_MSCR)
    FK_WSP(WLRU, bf16_t, WS_WLRU) FK_WSP(CMW, bf16_t, WS_CMW) FK_WSP(WIN, bf16_t, WS_WIN) FK_WSP(WBR, bf16_t, WS_WBR) FK_WSP(WOUT, bf16_t, WS_WOUT) FK_WSP(WFF1, bf16_t, WS_WFF1) FK_WSP(WFF2, bf16_t, WS_WFF2)
    FK_WSP(H, bf16_t, WS_H) FK_WSP(KALL, bf16_t, WS_KALL) FK_WSP(VALL, bf16_t, WS_VALL) FK_WSP(BR, bf16_t, WS_BR) FK_WSP(Z, bf16_t, WS_Z) FK_WSP(FFH, bf16_t, WS_FFH) FK_WSP(Fb, bf16_t, WS_F)
#undef FK_WSP
};
enum { I_XP = 0, I_XS, I_CK, I_CV, I_SL, I_C, I_CCTX, I_WMOD, I_BMOD, I_GPM, I_GPOM, I_GPF, I_GPOF, I_WIN, I_GQ, I_GK, I_WAO, I_CW, I_CB, I_LWA, I_LBA, I_LWX, I_LBX, I_LAM, I_WLO, I_CMG, I_CMWS, I_CMBS, I_WCO, I_WOUT, I_WFF1, I_WFF2 };
template <int I> __device__ __forceinline__ const float* inp(const Frame& F) { const float* r; asm volatile("s_load_dwordx2 %0, %1, %2\n\ts_waitcnt lgkmcnt(0)" : "=s"(r) : "s"(F.ka), "i"(I * 8) : "memory"); return r; }


__device__ __forceinline__ Frame phase_frame(const Frame& F) {
    Frame P = F; int t = F.tid; int bx = blockIdx.x; int g = F.G; unsigned char* w = F.ws; float* o = F.out;
    asm volatile("" : "+v"(t)); asm volatile("" : "+s"(bx), "+s"(g), "+s"(w), "+s"(o));
    P.tid = t; P.lane = t & 63; P.wave = __builtin_amdgcn_readfirstlane(t >> 6); P.ws = w; P.out = o; P.bx = bx; P.G = g; P.NGW = g * NWAVES;
    P.vcu = (g % 8 == 0) ? (bx % 8) * (g / 8) + bx / 8 : bx; P.gw = P.vcu * NWAVES + P.wave;
    return P;
}
__device__ __forceinline__ float wave_sum(float v) {
#pragma unroll
    for (int o = 1; o < 64; o <<= 1) v += __shfl_xor(v, o);
    return v;
}
__device__ __forceinline__ float bf2f(unsigned short h) { return __uint_as_float((unsigned)h << 16); }
__device__ __forceinline__ float bflo(unsigned w) { return __uint_as_float(w << 16); }
__device__ __forceinline__ float bfhi(unsigned w) { return __uint_as_float(w & 0xffff0000u); }
__device__ __forceinline__ float fsigm(float x) { return __builtin_amdgcn_rcpf(1.f + __builtin_amdgcn_exp2f(-1.4426950408889634f * x)); }
__device__ __forceinline__ float fgelu(float x) { const float u = x * (1.5957691216057308f + 0.0713548162726009f * x * x); return x * fsigm(u); }

__device__ __forceinline__ void transpose_item(const float* __restrict__ W, int K, int N, bf16_t* __restrict__ WT, int row_off, LAS unsigned char* scr, int item, int lane) {
    const int nblk = N / 64, kb = item / nblk, nb = item % nblk, k0 = 64 * kb, n0 = 64 * nb;
    const int n4 = (lane & 15) * 4, kp = lane >> 4;
    const float* src = W + (size_t)(k0 + 2 * kp) * N + n0 + n4;
    f32x4 v[8][2];
#pragma unroll
    for (int i = 0; i < 8; ++i) { v[i][0] = *(const f32x4*)(src + (size_t)(8 * i) * N); v[i][1] = *(const f32x4*)(src + (size_t)(8 * i + 1) * N); }
#pragma unroll
    for (int i = 0; i < 8; ++i) { const int k = 8 * i + 2 * kp;
#pragma unroll
        for (int j = 0; j < 4; ++j) *(LAS unsigned*)(scr + (n4 + j) * 144 + k * 2) = cvt_pk_bf16(v[i][0][j], v[i][1][j]); }
    LDS_WAIT(); asm volatile("" ::: "memory");
    const int ch = lane & 7;
#pragma unroll
    for (int j = 0; j < 8; ++j) { const int n = (lane >> 3) + 8 * j;
        const v4u o = *(const LAS v4u*)(scr + n * 144 + ch * 16);
        *(GAS v4u*)(WT + (size_t)(row_off + n0 + n) * K + k0 + 8 * ch) = o; }
    LDS_WAIT(); asm volatile("" ::: "memory");
}
__device__ __forceinline__ void convert_layer(const Frame& F, int l) {
    LAS unsigned char* scr = F.lds + F.wave * 16384;
    constexpr int I_IN = 32 * 272, I_SQ = 32 * 32, I_F1 = 32 * 128, I_F2 = 128 * 32, I_LRU = 64 * 4;
    constexpr int NITEMS = I_IN + 4 * I_SQ + I_F1 + I_F2 + I_LRU;
    const float* w_in = inp<I_WIN>(F) + (size_t)l * D * INW; const float* w_ao = inp<I_WAO>(F) + (size_t)l * D * D; const float* w_lo = inp<I_WLO>(F) + (size_t)l * D * D;
    const float* w_co = inp<I_WCO>(F) + (size_t)l * D * D; const float* w_out = inp<I_WOUT>(F) + (size_t)l * D * D; const float* w_f1 = inp<I_WFF1>(F) + (size_t)l * D * DFF;
    const float* w_f2 = inp<I_WFF2>(F) + (size_t)l * DFF * D; const float* lwa = inp<I_LWA>(F) + (size_t)l * 2 * 16 * 16384; const float* lwx = inp<I_LWX>(F) + (size_t)l * 2 * 16 * 16384;
    for (int it = F.gw; it < NITEMS; it += F.NGW) {
        int r = it;
        if (r < I_IN) { transpose_item(w_in, D, INW, F.WIN(), 0, scr, r, F.lane); continue; } r -= I_IN;
        if (r < I_SQ) { transpose_item(w_ao, D, D, F.WBR(), 0, scr, r, F.lane); continue; } r -= I_SQ;
        if (r < I_SQ) { transpose_item(w_lo, D, D, F.WBR(), D, scr, r, F.lane); continue; } r -= I_SQ;
        if (r < I_SQ) { transpose_item(w_co, D, D, F.WBR(), 2 * D, scr, r, F.lane); continue; } r -= I_SQ;
        if (r < I_SQ) { transpose_item(w_out, D, D, F.WOUT(), 0, scr, r, F.lane); continue; } r -= I_SQ;
        if (r < I_F1) { transpose_item(w_f1, D, DFF, F.WFF1(), 0, scr, r, F.lane); continue; } r -= I_F1;
        if (r < I_F2) { transpose_item(w_f2, DFF, D, F.WFF2(), 0, scr, r, F.lane); continue; } r -= I_F2;
        { const int bi = r >> 2, sub = r & 3, d = bi >> 5, mat = (bi >> 4) & 1, blk = bi & 15;
          const float* src = (mat ? lwx : lwa) + ((size_t)d * 16 + blk) * 16384;
          transpose_item(src, 128, 128, F.WLRU() + (size_t)bi * 16384, 0, scr, sub, F.lane); }
    }
    const float* cw = inp<I_CMWS>(F) + (size_t)l * 16 * 16384;
    for (int i = (F.gw * 64 + F.lane) * 8; i < 16 * 16384; i += F.NGW * 64 * 8) {
        const f32x4 a = *(const f32x4*)(cw + i), b = *(const f32x4*)(cw + i + 4);
        v4u o; o.x = pk2(a.x, a.y); o.y = pk2(a.z, a.w); o.z = pk2(b.x, b.y); o.w = pk2(b.z, b.w);
        *(v4u*)(F.CMW() + i) = o;
    }
}
__device__ __forceinline__ void mod_partials(const Frame& F) {
    LAS float* scr = (LAS float*)(F.lds + F.wave * 16384);
    const float* cctx = inp<I_CCTX>(F); const float* cc = inp<I_C>(F); const float* wmod = inp<I_WMOD>(F);
    for (int it = F.gw; it < DEPTH * 48 * NMODK; it += F.NGW) {
        const int kc = it % NMODK, jb = (it / NMODK) % 48, l = it / (NMODK * 48), k0 = kc * 64;
        for (int e = F.lane; e < NCOND * 64; e += 64) { const int ci = e >> 6, kk = e & 63; const float v = ci == 0 ? cctx[k0 + kk] : cc[(ci - 1) * D + k0 + kk]; scr[e] = v * (1.f / (1.f + __expf(-v))); }
        LDS_WAIT(); asm volatile("" ::: "memory");
        f32x4 acc[NCOND];
#pragma unroll
        for (int ci = 0; ci < NCOND; ++ci) acc[ci] = (f32x4){0.f, 0.f, 0.f, 0.f};
        const float* wp = wmod + ((size_t)l * D + k0) * 12288 + jb * 256 + F.lane * 4;
#pragma unroll
        for (int kb = 0; kb < 64; kb += 16) {
            f32x4 w[16];
#pragma unroll
            for (int kk = 0; kk < 16; ++kk) w[kk] = *(const f32x4*)(wp + (size_t)(kb + kk) * 12288);
#pragma unroll
            for (int kk = 0; kk < 16; ++kk)
#pragma unroll
                for (int ci = 0; ci < NCOND; ++ci) acc[ci] += w[kk] * scr[ci * 64 + kb + kk];
        }
#pragma unroll
        for (int ci = 0; ci < NCOND; ++ci) *(f32x4*)(F.MODP() + (((size_t)kc * DEPTH + l) * NCOND + ci) * 12288 + jb * 256 + F.lane * 4) = acc[ci];
        LDS_WAIT(); asm volatile("" ::: "memory");
    }
}
__device__ __forceinline__ void mod_reduce(const Frame& F) {
    constexpr int NEL = DEPTH * NCOND * 12288;
    for (int i = (F.gw * 64 + F.lane) * 4; i < NEL; i += F.NGW * 64 * 4) {
        const int l = i / (NCOND * 12288), j = i % 12288;
        f32x4 s = *(const f32x4*)(inp<I_BMOD>(F) + (size_t)l * 12288 + j);
#pragma unroll
        for (int kc = 0; kc < NMODK; ++kc) s += *(const f32x4*)(F.MODP() + (size_t)kc * NEL + i);
        *(f32x4*)(F.MOD() + i) = s;
    }
}
__device__ __forceinline__ void rope_table(const Frame& F) {
    if (F.bx == 0) for (int e = F.tid; e < 2048; e += NWAVES * 64) {
        const int pos = e >> 5, f = e & 31; const float inv = exp2f(-(float)f * (13.287712379549449f / 32.f)); float s, c; sincosf((float)pos * inv, &s, &c);
        F.ROPE()[e] = c; F.ROPE()[2048 + e] = s; }
}
struct RowIn { f32x4 x[4][2]; u32x4 f[4]; float st; };
template <bool HAS_F>
__device__ __forceinline__ void row_load(const Frame& F, RowIn& R, const float* xsrc, const bf16_t* frow, const float* fstat) {
#pragma unroll
    for (int j = 0; j < 4; ++j) { const int e = (j * 64 + F.lane) * 8; R.x[j][0] = *(const f32x4*)(xsrc + e); R.x[j][1] = *(const f32x4*)(xsrc + e + 4); }
    if (HAS_F) {
#pragma unroll
        for (int j = 0; j < 4; ++j) R.f[j] = *(const u32x4*)(frow + (j * 64 + F.lane) * 8);
        R.st = F.lane < 32 ? fstat[F.lane] : 0.f;
    }
}
template <bool HAS_F, bool HAS_H>
__device__ __forceinline__ void row_apply(const Frame& F, RowIn& R, float* xdst, const float* gate, const float* gpost, const float* gpre, const float* sc, const float* sh, bf16_t* hrow, float gs) {
    if (HAS_F) {
        const float rs = rsqrtf(wave_sum(R.st) * (1.f / D) + EPS) * gs;
#pragma unroll
        for (int j = 0; j < 4; ++j) { const int e = (j * 64 + F.lane) * 8; const u32x4 fw = R.f[j];
            const f32x4 g0 = *(const f32x4*)(gate + e), g1 = *(const f32x4*)(gate + e + 4), p0 = *(const f32x4*)(gpost + e), p1 = *(const f32x4*)(gpost + e + 4);
            const f32x4 f0 = {bflo(fw.x), bfhi(fw.x), bflo(fw.y), bfhi(fw.y)}, f1 = {bflo(fw.z), bfhi(fw.z), bflo(fw.w), bfhi(fw.w)};
            R.x[j][0] += g0 * (f0 * rs * p0); R.x[j][1] += g1 * (f1 * rs * p1); }
    }
#pragma unroll
    for (int j = 0; j < 4; ++j) { const int e = (j * 64 + F.lane) * 8; *(f32x4*)(xdst + e) = R.x[j][0]; *(f32x4*)(xdst + e + 4) = R.x[j][1]; }
    if (HAS_H) {
        float ss = 0.f;
#pragma unroll
        for (int j = 0; j < 4; ++j)
#pragma unroll
            for (int h = 0; h < 2; ++h) ss += (R.x[j][h].x * R.x[j][h].x + R.x[j][h].y * R.x[j][h].y) + (R.x[j][h].z * R.x[j][h].z + R.x[j][h].w * R.x[j][h].w);
        const float rs = rsqrtf(wave_sum(ss) * (1.f / D) + EPS);
#pragma unroll
        for (int j = 0; j < 4; ++j) { const int e = (j * 64 + F.lane) * 8;
            f32x4 o[2];
#pragma unroll
            for (int h = 0; h < 2; ++h) { const f32x4 g = *(const f32x4*)(gpre + e + 4 * h), s1 = *(const f32x4*)(sc + e + 4 * h), s0 = *(const f32x4*)(sh + e + 4 * h); o[h] = R.x[j][h] * rs * g * (s1 + 1.f) + s0; }
            u32x4 w; w.x = cvt_pk_bf16(o[0].x, o[0].y); w.y = cvt_pk_bf16(o[0].z, o[0].w); w.z = cvt_pk_bf16(o[1].x, o[1].y); w.w = cvt_pk_bf16(o[1].z, o[1].w);
            *(u32x4*)(hrow + e) = w; }
    }
}
__device__ __forceinline__ int cond_of_row(int m) { return m < MP ? 0 : 1 + ((m - MP) >> 11); }
template <int MODE>
__device__ __forceinline__ void rowlocal_phase(const Frame& F, int l, float gs = 1.f) {
    const float* xp = inp<I_XP>(F); const float* xs = inp<I_XS>(F);
    const float* gpost = MODE == 1 ? inp<I_GPOM>(F) + (size_t)l * D : inp<I_GPOF>(F) + (size_t)l * D;
    const float* gpre = MODE == 0 ? inp<I_GPM>(F) : MODE == 1 ? inp<I_GPF>(F) + (size_t)l * D : inp<I_GPM>(F) + (size_t)(l + 1 < DEPTH ? l + 1 : l) * D;
    float* X = F.x(); const bf16_t* Fb = F.Fb(); const float* FS = F.FSTAT(); bf16_t* H = F.H(); const float* MODb = F.MOD();
    constexpr bool HAS_F = MODE != 0;
    RowIn A, B;
    auto src = [&](int m) -> const float* { return MODE == 0 ? (m < MP ? xp + (size_t)m * D : xs + (size_t)(m - MP) * D) : X + (size_t)m * D; };
    int m = F.gw;
    if (m < M) row_load<HAS_F>(F, A, src(m), Fb + (size_t)m * D, FS + (size_t)m * 32);
    for (; m < M; m += 2 * F.NGW) {
#pragma unroll
        for (int half = 0; half < 2; ++half) {
            const int mc = m + half * F.NGW, mn = mc + F.NGW;
            if (mc >= M) break;
            RowIn& cur = half ? B : A; RowIn& nxt = half ? A : B;
            if (mn < M) row_load<HAS_F>(F, nxt, src(mn), Fb + (size_t)mn * D, FS + (size_t)mn * 32);
            const int ci = cond_of_row(mc);
            const float* modl = MODb + ((size_t)l * NCOND + ci) * 12288;
            float* xrow = X + (size_t)mc * D; bf16_t* hrow = H + (size_t)mc * D;
            if (MODE == 0) row_apply<false, true>(F, cur, xrow, nullptr, nullptr, gpre, modl + 1 * D, modl + 0 * D, hrow, gs);
            else if (MODE == 1) row_apply<true, true>(F, cur, xrow, modl + 2 * D, gpost, gpre, modl + 4 * D, modl + 3 * D, hrow, gs);
            else if (l + 1 < DEPTH) { const float* modn = MODb + ((size_t)(l + 1) * NCOND + ci) * 12288; row_apply<true, true>(F, cur, xrow, modl + 5 * D, gpost, gpre, modn + 1 * D, modn + 0 * D, hrow, gs); }
            else row_apply<true, false>(F, cur, xrow, modl + 5 * D, gpost, nullptr, nullptr, nullptr, nullptr, gs);
        }
    }
}
__device__ __forceinline__ u32x4 pack8(const f32x4& a, const f32x4& b) { u32x4 w; w.x = cvt_pk_bf16(a[0], a[1]); w.y = cvt_pk_bf16(a[2], a[3]); w.z = cvt_pk_bf16(b[0], b[1]); w.w = cvt_pk_bf16(b[2], b[3]); return w; }
typedef float f32x2 __attribute__((ext_vector_type(2)));
__device__ __forceinline__ f32x2 sigm2(f32x2 x) { const f32x2 t = x * -1.4426950408889634f; const f32x2 e = (f32x2){__builtin_amdgcn_exp2f(t.x), __builtin_amdgcn_exp2f(t.y)} + 1.f; return (f32x2){__builtin_amdgcn_rcpf(e.x), __builtin_amdgcn_rcpf(e.y)}; }
__device__ __forceinline__ f32x2 gelu2(f32x2 x) { const f32x2 t = x * ((x * x) * -0.10294324f + -2.3022082f);
    const f32x2 e = (f32x2){__builtin_amdgcn_exp2f(t.x), __builtin_amdgcn_exp2f(t.y)} + 1.f; return x * (f32x2){__builtin_amdgcn_rcpf(e.x), __builtin_amdgcn_rcpf(e.y)}; }
__device__ __forceinline__ f32x4 gelu4(const f32x4& v) { const f32x2 a = gelu2((f32x2){v[0], v[1]}), b = gelu2((f32x2){v[2], v[3]}); return (f32x4){a.x, a.y, b.x, b.y}; }
__device__ __forceinline__ f32x4 sigm4(const f32x4& v) { const f32x2 a = sigm2((f32x2){v[0], v[1]}), b = sigm2((f32x2){v[2], v[3]}); return (f32x4){a.x, a.y, b.x, b.y}; }
__device__ __forceinline__ int kv_row(int m) { return m < MP ? m : MP + ((m - MP) >> 11) * 2304 + ((m - MP) & 2047); }
struct EpiIn {
    static constexpr bool PERM = true, AFTER_DRAIN = false;
    bf16_t* Z; bf16_t* VALL; float* new_v; float* cvstat; int layer;
    __device__ __forceinline__ void operator()(const f32x4 (&acc)[2][2][4][2], const Unit& u, int wr, int wc, int fr, int fq) const {
        const int pn = u.pn, row0 = u.pm * 256 + wr * 64 + fr, cl = wc * 32 + 8 * fq;
        if (pn >= 10 && pn < 12) {
            const int colv = (pn - 10) * 256 + cl;
#pragma unroll
            for (int ai = 0; ai < 2; ++ai)
#pragma unroll
                for (int m = 0; m < 4; ++m) { const int row = row0 + ai * 128 + m * 16; bf16_t* dst = VALL + (size_t)kv_row(row) * 512 + colv;
#pragma unroll
                    for (int bj = 0; bj < 2; ++bj) { *(u32x4*)(dst + bj * 128) = pack8(acc[ai][bj][m][0], acc[ai][bj][m][1]);
                        if (row < MP) { float* nv = new_v + ((size_t)((row >> 8) * DEPTH + layer) * 256 + (row & 255)) * 512 + colv + bj * 128; *(f32x4*)nv = acc[ai][bj][m][0]; *(f32x4*)(nv + 4) = acc[ai][bj][m][1]; } } }
            return;
        }
        const int mode = (pn < 20) ? 0 : (pn < 36) ? 1 : (pn < 44) ? 2 : 3;
        const int col0 = pn * 256 + cl;
#pragma unroll
        for (int ai = 0; ai < 2; ++ai)
#pragma unroll
            for (int m = 0; m < 4; ++m) { const int row = row0 + ai * 128 + m * 16; bf16_t* dst = Z + (size_t)row * INW + col0; float ss = 0.f;
#pragma unroll
                for (int bj = 0; bj < 2; ++bj) { f32x4 v0 = acc[ai][bj][m][0], v1 = acc[ai][bj][m][1];
                    if (mode == 1 || mode == 2) { v0 = gelu4(v0); v1 = gelu4(v1); }
                    if (mode == 3) { v0 = sigm4(v0); v1 = sigm4(v1); }
                    if (mode == 2) ss += (v0[0] * v0[0] + v0[1] * v0[1]) + (v0[2] * v0[2] + v0[3] * v0[3]) + (v1[0] * v1[0] + v1[1] * v1[1]) + (v1[2] * v1[2] + v1[3] * v1[3]);
                    *(u32x4*)(dst + bj * 128) = pack8(v0, v1); }
                if (mode == 2) { ss += __shfl_xor(ss, 16); ss += __shfl_xor(ss, 32); if (fq == 0) cvstat[(size_t)row * 32 + (pn - 36) * 4 + wc] = ss; } }
    }
};
struct EpiRelu2 {
    static constexpr bool PERM = true, AFTER_DRAIN = false;
    bf16_t* O; int ldc;
    __device__ __forceinline__ void operator()(const f32x4 (&acc)[2][2][4][2], const Unit& u, int wr, int wc, int fr, int fq) const {
        const int row0 = u.pm * 256 + wr * 64 + fr, col0 = u.pn * 256 + wc * 32 + 8 * fq;
#pragma unroll
        for (int ai = 0; ai < 2; ++ai)
#pragma unroll
            for (int m = 0; m < 4; ++m) { bf16_t* dst = O + (size_t)(row0 + ai * 128 + m * 16) * ldc + col0;
#pragma unroll
                for (int bj = 0; bj < 2; ++bj) { f32x4 v0 = __builtin_elementwise_max(acc[ai][bj][m][0], (f32x4){0.f, 0.f, 0.f, 0.f}), v1 = __builtin_elementwise_max(acc[ai][bj][m][1], (f32x4){0.f, 0.f, 0.f, 0.f});
                    *(u32x4*)(dst + bj * 128) = pack8(v0 * v0, v1 * v1); } }
    }
};
struct EpiF {
    static constexpr bool PERM = true, AFTER_DRAIN = false;
    bf16_t* O; float* stat;
    __device__ __forceinline__ void operator()(const f32x4 (&acc)[2][2][4][2], const Unit& u, int wr, int wc, int fr, int fq) const {
        const int row0 = u.pm * 256 + wr * 64 + fr, col0 = u.pn * 256 + wc * 32 + 8 * fq;
#pragma unroll
        for (int ai = 0; ai < 2; ++ai)
#pragma unroll
            for (int m = 0; m < 4; ++m) { const int row = row0 + ai * 128 + m * 16; bf16_t* dst = O + (size_t)row * D + col0; float ss = 0.f;
#pragma unroll
                for (int bj = 0; bj < 2; ++bj) { const f32x4 v0 = acc[ai][bj][m][0], v1 = acc[ai][bj][m][1];
                    ss += (v0[0] * v0[0] + v0[1] * v0[1]) + (v0[2] * v0[2] + v0[3] * v0[3]) + (v1[0] * v1[0] + v1[1] * v1[1]) + (v1[2] * v1[2] + v1[3] * v1[3]);
                    *(u32x4*)(dst + bj * 128) = pack8(v0, v1); }
                ss += __shfl_xor(ss, 16); ss += __shfl_xor(ss, 32); if (fq == 0) stat[(size_t)row * 32 + u.pn * 4 + wc] = ss; }
    }
};
struct EpiMerge {
    static constexpr bool PERM = true, AFTER_DRAIN = false;
    const bf16_t* Z; float* scr  ; bf16_t* O;
    __device__ __forceinline__ void operator()(const f32x4 (&acc)[2][2][4][2], const Unit& u, int wr, int wc, int fr, int fq) const {
        const int br = u.pn >> 3, pn = u.pn & 7, pm = u.pm - 96 * br;
        const int rl0 = wr * 64 + fr, cl = wc * 32 + 8 * fq;
#pragma unroll
        for (int ai = 0; ai < 2; ++ai)
#pragma unroll
            for (int m = 0; m < 4; ++m) { const int rl = rl0 + ai * 128 + m * 16, row = pm * 256 + rl;
#pragma unroll
                for (int bj = 0; bj < 2; ++bj) { const int c = cl + bj * 128;
                    const u32x4 gw = *(const u32x4*)(Z + (size_t)row * INW + OFF_G + br * D + pn * 256 + c);
                    const f32x4 g0 = {bflo(gw.x), bfhi(gw.x), bflo(gw.y), bfhi(gw.y)}, g1 = {bflo(gw.z), bfhi(gw.z), bflo(gw.w), bfhi(gw.w)};
                    f32x4 v0 = g0 * acc[ai][bj][m][0], v1 = g1 * acc[ai][bj][m][1];
                    float* sp = scr + rl * 256 + c;
                    if (br > 0) { v0 += *(const f32x4*)sp; v1 += *(const f32x4*)(sp + 4); }
                    if (br < 2) { *(f32x4*)sp = v0; *(f32x4*)(sp + 4) = v1; }
                    else *(u32x4*)(O + (size_t)row * D + pn * 256 + c) = pack8(v0, v1); } }
    }
};
struct MergeOrder {
    pg8::StaticOrder so;
    __device__ void init(int G, int c) { so.init(M, D, G, c); }
    __device__ bool next(int i, Unit& u) const { const int br = i % 3; if (!so.next(i / 3, u)) return false; u.pm += 96 * br; u.pn += 8 * br; return true; }
    __device__ __forceinline__ void a_ready(const Unit&) const {}
    __device__ __forceinline__ void done(const Unit&) const {}
};
}
namespace fk {
typedef short bf16x8 __attribute__((ext_vector_type(8)));
__device__ __forceinline__ void prep_row(const Frame& F, int m, int l) {
    const bool sample = m >= MP; int b, t;
    if (!sample) { b = m >> 8; t = m & 255; } else { b = (m - MP) >> 11; t = (m - MP) & 2047; }
    const int kvrow = sample ? MP + b * 2304 + t : m;
    const int lane = F.lane, g8 = lane >> 3, j = lane & 7, axis = g8 & 1, hsel = lane >> 4;
    bf16_t* zrow = F.Z() + (size_t)m * INW;
    const int dA = axis * 64 + 4 * j, dB = dA + 32;
    const f32x4 gqa = *(const f32x4*)(inp<I_GQ>(F) + l * 128 + dA), gqb = *(const f32x4*)(inp<I_GQ>(F) + l * 128 + dB);
    const f32x4 gka = *(const f32x4*)(inp<I_GK>(F) + l * 128 + dA), gkb = *(const f32x4*)(inp<I_GK>(F) + l * 128 + dB);
    f32x4 cs = {1.f, 1.f, 1.f, 1.f}, sn = {0.f, 0.f, 0.f, 0.f};
    if (sample) { const int pos = axis == 0 ? (t >> 6) : (t & 63); cs = *(const f32x4*)(F.ROPE() + pos * 32 + 4 * j); sn = *(const f32x4*)(F.ROPE() + 2048 + pos * 32 + 4 * j); }
#pragma unroll
    for (int pass = 0; pass < 5; ++pass) {
        const bool isq = pass < 4;
        const int base = isq ? OFF_Q + (pass * 4 + hsel) * 128 + dA : OFF_K + hsel * 128 + dA;
        const u32x2 wa = *(const u32x2*)(zrow + base), wb = *(const u32x2*)(zrow + base + 32);
        const f32x4 xa = {bflo(wa.x), bfhi(wa.x), bflo(wa.y), bfhi(wa.y)}, xb = {bflo(wb.x), bfhi(wb.x), bflo(wb.y), bfhi(wb.y)};
        float ss = (xa.x * xa.x + xa.y * xa.y) + (xa.z * xa.z + xa.w * xa.w) + (xb.x * xb.x + xb.y * xb.y) + (xb.z * xb.z + xb.w * xb.w);
        ss += __shfl_xor(ss, 1); ss += __shfl_xor(ss, 2); ss += __shfl_xor(ss, 4); ss += __shfl_xor(ss, 8);
        const float rs = rsqrtf(ss * (1.f / 128.f) + EPS);
        const f32x4 na = xa * rs * (isq ? gqa : gka), nb = xb * rs * (isq ? gqb : gkb);
        const f32x4 ra = na * cs - nb * sn, rb = na * sn + nb * cs;
        u32x2 oa, ob; oa.x = cvt_pk_bf16(ra.x, ra.y); oa.y = cvt_pk_bf16(ra.z, ra.w); ob.x = cvt_pk_bf16(rb.x, rb.y); ob.y = cvt_pk_bf16(rb.z, rb.w);
        if (isq) { *(u32x2*)(zrow + base) = oa; *(u32x2*)(zrow + base + 32) = ob; }
        else {
            bf16_t* kd = F.KALL() + (size_t)kvrow * 512 + hsel * 128 + dA; *(u32x2*)kd = oa; *(u32x2*)(kd + 32) = ob;
            if (!sample) { float* nk = F.new_k() + ((size_t)(b * DEPTH + l) * 256 + t) * 512 + hsel * 128 + dA; *(f32x4*)nk = na; *(f32x4*)(nk + 32) = nb; }
        }
    }
}
__device__ __forceinline__ void prep_phase(const Frame& F, int l) {
    for (int m = F.gw; m < M; m += F.NGW) prep_row(F, m, l);
    for (int it = F.gw; it < 2 * 8 * 256; it += F.NGW) {
        const int which = it >> 11, b = (it >> 8) & 7, p = it & 255;
        const float* src = (which ? inp<I_CV>(F) : inp<I_CK>(F)) + ((size_t)(b * DEPTH + l) * 256 + p) * 512 + F.lane * 8;
        bf16_t* dst = (which ? F.VALL() : F.KALL()) + (size_t)(MP + b * 2304 + 2048 + p) * 512 + F.lane * 8;
        const f32x4 a = *(const f32x4*)src, c = *(const f32x4*)(src + 4);
        *(u32x4*)dst = pack8(a, c);
    }
}
__device__ __forceinline__ int crow(int r, int hi) { return (r & 3) + 8 * (r >> 2) + 4 * hi; }
struct LruCtx {
    bf16x8 bw0[8], bw1[8];
    float bav, bxv, c8;
    bool small;
};
__device__ __forceinline__ void lru_ctx_load(const Frame& F, int l, int blk, LruCtx& X) {
    const int lane = F.lane, wave = F.wave, d = wave >> 2, n0 = (wave & 3) * 32, nl = lane & 31, hi = lane >> 5, C = blk * 128 + n0 + nl;
    const bf16_t* wb0 = F.WLRU() + ((size_t)((d * 2 + 0) * 16 + blk) * 128 + n0 + nl) * 128 + hi * 8;
    const bf16_t* wb1 = F.WLRU() + ((size_t)((d * 2 + 1) * 16 + blk) * 128 + n0 + nl) * 128 + hi * 8;
#pragma unroll
    for (int ks = 0; ks < 8; ++ks) { X.bw0[ks] = *(const bf16x8*)(wb0 + ks * 16); X.bw1[ks] = *(const bf16x8*)(wb1 + ks * 16); }
    X.bav = inp<I_LBA>(F)[(size_t)(l * 2 + d) * D + C]; X.bxv = inp<I_LBX>(F)[(size_t)(l * 2 + d) * D + C];
    const float lam = inp<I_LAM>(F)[(size_t)(l * 2 + d) * D + C];
    X.c8 = -8.f * log1pf(__expf(-lam));
    X.small = __all(X.c8 > -0.5f);
}
struct LruGeo { int m0, b, t0, T; bool sample; };
__device__ __forceinline__ LruGeo lru_geo(int ck) { LruGeo g; g.m0 = ck * 64; g.sample = g.m0 >= MP;
    if (!g.sample) { g.b = g.m0 >> 8; g.t0 = g.m0 & 255; g.T = 256; } else { g.b = (g.m0 - MP) >> 11; g.t0 = (g.m0 - MP) & 2047; g.T = 2048; } return g; }
template <int PASS>
__device__ __forceinline__ void lru_conv(const Frame& F, int t2  , int par  , int ck, int blk, const float* __restrict__ state_l, const float* __restrict__ AGG, const float* __restrict__ cwl, const float* __restrict__ cbl) {
    const LruGeo G = lru_geo(ck); const int C0 = blk * 128; LAS unsigned char* lds = F.lds; const bf16_t* Zb = F.Z();
    const int c4 = (t2 & 31) * 4, r0 = (t2 >> 5) * 8;
    f32x4 cw[4];
#pragma unroll
    for (int j = 0; j < 4; ++j) cw[j] = *(const f32x4*)(cwl + (size_t)j * D + C0 + c4);
    const f32x4 cb = *(const f32x4*)(cbl + C0 + c4);
    f32x4 zr[11];
#pragma unroll
    for (int i = 0; i < 11; ++i) {
        const int tt = G.t0 + r0 + i - 2;
        if (tt >= 0 && tt < G.T) { const u32x2 z = *(const u32x2*)(Zb + (size_t)(G.m0 + r0 + i - 2) * INW + OFF_LX + C0 + c4); zr[i] = (f32x4){bflo(z.x), bfhi(z.x), bflo(z.y), bfhi(z.y)}; }
        else zr[i] = (f32x4){0.f, 0.f, 0.f, 0.f};
    }
    if (PASS == 2) {
        const int d = t2 >> 7, C = C0 + (t2 & 127), jc = G.t0 >> 6, nch = G.T >> 6;
        float carry = G.sample ? state_l[((size_t)G.b * DEPTH * 2 + d) * D + C] : 0.f;
        const float* ag = AGG + ((size_t)((ck - jc) * 2 + d) * D + C) * 2;
        if (nch == 4) {
            float2 pe[4];
#pragma unroll
            for (int jj = 0; jj < 4; ++jj) pe[jj] = *(const float2*)(ag + (size_t)jj * 4 * D);
            if (d == 0) {
#pragma unroll
                for (int jj = 0; jj < 4; ++jj) if (jj < jc) carry = pe[jj].x * carry + pe[jj].y; }
            else {
#pragma unroll
                for (int jj = 3; jj >= 0; --jj) if (jj > jc) carry = pe[jj].x * carry + pe[jj].y; }
        } else {
            float2 pe[32];
#pragma unroll
            for (int jj = 0; jj < 32; ++jj) pe[jj] = *(const float2*)(ag + (size_t)jj * 4 * D);
            if (d == 0) {
#pragma unroll
                for (int jj = 0; jj < 32; ++jj) if (jj < jc) carry = pe[jj].x * carry + pe[jj].y; }
            else {
#pragma unroll
                for (int jj = 31; jj >= 0; --jj) if (jj > jc) carry = pe[jj].x * carry + pe[jj].y; }
        }
        *(LAS float*)(lds + LRU_CARRY + par * 1024 + t2 * 4) = carry;
    }
#pragma unroll
    for (int r = 0; r < 8; ++r) {
        const f32x4 y = cb + zr[r] * cw[0] + zr[r + 1] * cw[1] + zr[r + 2] * cw[2] + zr[r + 3] * cw[3];
        u32x2 o; o.x = cvt_pk_bf16(y.x, y.y); o.y = cvt_pk_bf16(y.z, y.w);
        *(LAS u32x2*)(lds + LRU_XC + (r0 + r) * LRU_XC_PITCH + c4 * 2) = o;
    }
}
__device__ __forceinline__ void lru_gates(const Frame& F, int lane, int wave, const LruCtx& X) {
    LAS unsigned char* lds = F.lds;
    const int d = wave >> 2, n0 = (wave & 3) * 32, nl = lane & 31, hi = lane >> 5;
    f32x16 acc[2][2];
#pragma unroll
    for (int mat = 0; mat < 2; ++mat)
#pragma unroll
        for (int mt = 0; mt < 2; ++mt)
#pragma unroll
            for (int r = 0; r < 16; ++r) acc[mat][mt][r] = 0.f;
    const LAS unsigned char* ap = lds + LRU_XC + nl * LRU_XC_PITCH + hi * 16;
#pragma unroll
    for (int ks = 0; ks < 8; ++ks) {
        const bf16x8 a0 = *(const LAS bf16x8*)(ap + ks * 32), a1 = *(const LAS bf16x8*)(ap + 32 * LRU_XC_PITCH + ks * 32);
        acc[0][0] = __builtin_amdgcn_mfma_f32_32x32x16_bf16(a0, X.bw0[ks], acc[0][0], 0, 0, 0);
        acc[0][1] = __builtin_amdgcn_mfma_f32_32x32x16_bf16(a1, X.bw0[ks], acc[0][1], 0, 0, 0);
        acc[1][0] = __builtin_amdgcn_mfma_f32_32x32x16_bf16(a0, X.bw1[ks], acc[1][0], 0, 0, 0);
        acc[1][1] = __builtin_amdgcn_mfma_f32_32x32x16_bf16(a1, X.bw1[ks], acc[1][1], 0, 0, 0);
    }
    const int c = n0 + nl;
    LAS float* Ad = (LAS float*)(lds + (d ? LRU_A1 : LRU_A0)); LAS float* Bd = (LAS float*)(lds + (d ? LRU_B1 : LRU_B0));
    const float bav = X.bav, bxv = X.bxv, c8 = X.c8;
    if (X.small) {
        typedef float f32x2 __attribute__((ext_vector_type(2)));
#pragma unroll
        for (int mt = 0; mt < 2; ++mt)
#pragma unroll
            for (int r = 0; r < 16; r += 2) {
                const int tl = mt * 32 + crow(r, hi);
                const f32x2 pa = (f32x2){acc[0][mt][r], acc[0][mt][r + 1]} + bav, px = (f32x2){acc[1][mt][r], acc[1][mt][r + 1]} + bxv;
                const f32x2 ta = pa * -1.4426950408889634f, tx = px * -1.4426950408889634f;
                const f32x2 ea = (f32x2){__builtin_amdgcn_exp2f(ta.x), __builtin_amdgcn_exp2f(ta.y)} + 1.f, ex = (f32x2){__builtin_amdgcn_exp2f(tx.x), __builtin_amdgcn_exp2f(tx.y)} + 1.f;
                const f32x2 rg = {__builtin_amdgcn_rcpf(ea.x), __builtin_amdgcn_rcpf(ea.y)}, ig = {__builtin_amdgcn_rcpf(ex.x), __builtin_amdgcn_rcpf(ex.y)};
                const f32x2 la = rg * c8;
                f32x2 p = la * (1.f / 720.f) + (1.f / 120.f); p = p * la + (1.f / 24.f); p = p * la + (1.f / 6.f); p = p * la + 0.5f; p = p * la + 1.f;
                const f32x2 e1 = la * p;
                const f32x2 omr = (e1 + 2.f) * e1;
                const f32x2 sq = {__builtin_amdgcn_sqrtf(fmaxf(-omr.x, 0.f)), __builtin_amdgcn_sqrtf(fmaxf(-omr.y, 0.f))};
                const f32x2 xcv = {bf2f(*(const LAS unsigned short*)(lds + LRU_XC + tl * LRU_XC_PITCH + c * 2)), bf2f(*(const LAS unsigned short*)(lds + LRU_XC + (tl + 1) * LRU_XC_PITCH + c * 2))};
                const f32x2 av = e1 + 1.f, bt = sq * ig * xcv;
                Ad[tl * 128 + c] = av.x; Ad[(tl + 1) * 128 + c] = av.y; Bd[tl * 128 + c] = bt.x; Bd[(tl + 1) * 128 + c] = bt.y;
            }
    } else {
#pragma unroll
        for (int mt = 0; mt < 2; ++mt)
#pragma unroll
            for (int r = 0; r < 16; ++r) {
                const int tl = mt * 32 + crow(r, hi);
                const float rg = fsigm(acc[0][mt][r] + bav), ig = fsigm(acc[1][mt][r] + bxv);
                const float la = c8 * rg, a = __expf(la);
                const float mult = sqrtf(fmaxf(-expm1f(2.f * la), 0.f));
                const float xcv = bf2f(*(const LAS unsigned short*)(lds + LRU_XC + tl * LRU_XC_PITCH + c * 2));
                Ad[tl * 128 + c] = a; Bd[tl * 128 + c] = mult * ig * xcv;
            }
    }
}
template <int PASS>
__device__ __forceinline__ void lru_scan(const Frame& F, int tid, int par, int l, int ck, int blk, float* __restrict__ AGG) {
    LAS unsigned char* lds = F.lds; const LruGeo G = lru_geo(ck);
    const int d = tid >> 7, c = tid & 127, C = blk * 128 + c;
    const LAS float* Ad = (const LAS float*)(lds + (d ? LRU_A1 : LRU_A0)); LAS float* Bd = (LAS float*)(lds + (d ? LRU_B1 : LRU_B0));
    if (PASS == 1) {
        float h = 0.f, Pp = 1.f;
        if (d == 0) {
#pragma unroll 16
            for (int s = 0; s < 64; ++s) { const float a = Ad[s * 128 + c]; h = a * h + Bd[s * 128 + c]; Pp *= a; }
        } else {
#pragma unroll 16
            for (int s = 0; s < 64; ++s) { const float a = Ad[(63 - s) * 128 + c]; h = a * h + Bd[(63 - s) * 128 + c]; Pp *= a; }
        }
        *(float2*)(AGG + ((size_t)(ck * 2 + d) * D + C) * 2) = make_float2(Pp, h);
    } else {
        const int jc = G.t0 >> 6, nch = G.T >> 6;
        float h = *(const LAS float*)(lds + LRU_CARRY + par * 1024 + tid * 4);
        if (d == 0) {
#pragma unroll
            for (int s0 = 0; s0 < 64; s0 += 16) { float av[16], bv[16];
#pragma unroll
                for (int i = 0; i < 16; ++i) { av[i] = Ad[(s0 + i) * 128 + c]; bv[i] = Bd[(s0 + i) * 128 + c]; }
#pragma unroll
                for (int i = 0; i < 16; ++i) { h = av[i] * h + bv[i]; bv[i] = h; }
#pragma unroll
                for (int i = 0; i < 16; ++i) Bd[(s0 + i) * 128 + c] = bv[i]; }
        } else {
#pragma unroll
            for (int s0 = 0; s0 < 64; s0 += 16) { float av[16], bv[16];
#pragma unroll
                for (int i = 0; i < 16; ++i) { av[i] = Ad[(63 - s0 - i) * 128 + c]; bv[i] = Bd[(63 - s0 - i) * 128 + c]; }
#pragma unroll
                for (int i = 0; i < 16; ++i) { h = av[i] * h + bv[i]; bv[i] = h; }
#pragma unroll
                for (int i = 0; i < 16; ++i) Bd[(63 - s0 - i) * 128 + c] = bv[i]; }
        }
        if (!G.sample && ((d == 0 && jc == nch - 1) || (d == 1 && jc == 0))) F.new_s()[((size_t)(G.b * DEPTH + l) * 2 + d) * D + C] = h;
    }
}
__device__ __forceinline__ void lru_out(const Frame& F, int tid, int ck, int blk) {
    LAS unsigned char* lds = F.lds; const int m0 = ck * 64, C0 = blk * 128;
    const int row = tid >> 3, c16 = (tid & 7) * 16;
    const LAS float* h0 = (const LAS float*)(lds + LRU_B0) + row * 128 + c16; const LAS float* h1 = (const LAS float*)(lds + LRU_B1) + row * 128 + c16;
    const bf16_t* gp = F.Z() + (size_t)(m0 + row) * INW + OFF_LG + C0 + c16;
    const u32x4 g0 = *(const u32x4*)gp, g1 = *(const u32x4*)(gp + 8);
    const unsigned gw[8] = {g0.x, g0.y, g0.z, g0.w, g1.x, g1.y, g1.z, g1.w};
    unsigned ow[8];
#pragma unroll
    for (int i = 0; i < 8; ++i) ow[i] = cvt_pk_bf16((h0[2 * i] + h1[2 * i]) * bflo(gw[i]), (h0[2 * i + 1] + h1[2 * i + 1]) * bfhi(gw[i]));
    bf16_t* yp = F.BR() + (size_t)1 * M * D + (size_t)(m0 + row) * D + C0 + c16;
    *(u32x4*)yp = (u32x4){ow[0], ow[1], ow[2], ow[3]}; *(u32x4*)(yp + 8) = (u32x4){ow[4], ow[5], ow[6], ow[7]};
}
template <int PASS>
__device__ __forceinline__ void lru_phase(const Frame& F, int l) {
    LruCtx X; int cur = -1;
    const float* state_l = inp<I_SL>(F) + (size_t)l * 2 * D;
    float* AGG = F.AGG();
    const float* cwl = inp<I_CW>(F) + (size_t)l * 4 * D; const float* cbl = inp<I_CB>(F) + (size_t)l * D;
    constexpr int NU = 384 * 16;
    int u = F.bx;
    if (u < NU && F.tid >= 256) lru_conv<PASS>(F, F.tid - 256, 0, u >> 4, u & 15, state_l, AGG, cwl, cbl);
    __syncthreads();
    for (int par = 0; u < NU; u += F.G, par ^= 1) {
        int tid_ = F.tid; asm volatile("" : "+v"(tid_));
        const int tid = tid_, lane = tid & 63, wave = __builtin_amdgcn_readfirstlane(tid >> 6);
        const int blk = u & 15, ck = u >> 4;
        if (blk != cur) { lru_ctx_load(F, l, blk, X); cur = blk; }
        lru_gates(F, lane, wave, X);
        __syncthreads();
        if (tid < 256) lru_scan<PASS>(F, tid, par, l, ck, blk, AGG);
        else if (u + F.G < NU) lru_conv<PASS>(F, tid - 256, par ^ 1, (u + F.G) >> 4, (u + F.G) & 15, state_l, AGG, cwl, cbl);
        __syncthreads();
        if (PASS == 2) { lru_out(F, tid, ck, blk); __syncthreads(); }
    }
}
constexpr int CM_V = 0, CM_OUT = 32768, CM_OUT_PITCH = 528, CM_RS2 = CM_OUT + 128 * CM_OUT_PITCH;
static_assert(CM_RS2 + 512 <= MISC_OFF, "cm lds map");
struct CmCtx { bf16x8 wa[8]; };
__device__ __forceinline__ void cm_ctx_load(const Frame& F, int g, CmCtx& X) {
    const int qt = F.wave & 3, xl = F.lane & 31, hi = F.lane >> 5;
    const bf16_t* wp = F.CMW() + ((size_t)g * 128 + qt * 32 + xl) * 128 + hi * 8;
#pragma unroll
    for (int i = 0; i < 8; ++i) X.wa[i] = *(const bf16x8*)(wp + i * 16);
}
__device__ __forceinline__ void cm_unit(const Frame& F, int cn, int g, const CmCtx& X, const float* __restrict__ cmg, const float* __restrict__ bsg) {
    int tid_ = F.tid; asm volatile("" : "+v"(tid_));
    const int tid = tid_, lane = tid & 63, wave = __builtin_amdgcn_readfirstlane(tid >> 6), m0 = cn * 128, C0 = g * 128;
    LAS unsigned char* lds = F.lds;
    LAS float* RS = (LAS float*)(lds + CM_RS2);
    const bf16_t* Zb = F.Z();
    if (tid < 128) { const float* st = F.CVSTAT() + (size_t)(m0 + tid) * 32; float s = 0.f;
#pragma unroll
        for (int i = 0; i < 32; i += 4) { const f32x4 v = *(const f32x4*)(st + i); s += (v.x + v.y) + (v.z + v.w); }
        RS[tid] = rsqrtf(s * (1.f / D) + EPS); }
    __syncthreads();
    {
        const int sr = tid >> 4, sc = (tid & 15) * 8;
        const f32x4 ga = *(const f32x4*)(cmg + C0 + sc), gb = *(const f32x4*)(cmg + C0 + sc + 4);
#pragma unroll
        for (int i = 0; i < 4; ++i) {
            const int p = (i >> 1) * 64 + (i & 1) * 32 + sr; const float rs = RS[p];
            const u32x4 w = *(const u32x4*)(Zb + (size_t)(m0 + p) * INW + OFF_CV + C0 + sc);
            const f32x4 v0 = (f32x4){bflo(w.x), bfhi(w.x), bflo(w.y), bfhi(w.y)} * ga * rs, v1 = (f32x4){bflo(w.z), bfhi(w.z), bflo(w.w), bfhi(w.w)} * gb * rs;
            *(LAS u32x4*)(lds + CM_V + (i >> 1) * 16384 + att::v_st((i & 1) * 32 + sr, sc)) = pack8(v0, v1);
        }
    }
    __syncthreads();
    {
        const int qt = wave & 3, chh = wave >> 2, xl = lane & 31, hi = lane >> 5;
        f32x16 o0, o1;
#pragma unroll
        for (int r = 0; r < 16; ++r) { o0[r] = 0.f; o1[r] = 0.f; }
        const int vb = (int)(unsigned)(uintptr_t)(lds + CM_V) + att::v_rd_base(lane);
        if (chh == 0) {
            att::pv_one<0>(o0, vb, X.wa[0], X.wa[1], X.wa[2], X.wa[3]); att::pv_one<1>(o1, vb, X.wa[0], X.wa[1], X.wa[2], X.wa[3]);
            att::pv_one<0>(o0, vb + 16384, X.wa[4], X.wa[5], X.wa[6], X.wa[7]); att::pv_one<1>(o1, vb + 16384, X.wa[4], X.wa[5], X.wa[6], X.wa[7]);
        } else {
            att::pv_one<2>(o0, vb, X.wa[0], X.wa[1], X.wa[2], X.wa[3]); att::pv_one<3>(o1, vb, X.wa[0], X.wa[1], X.wa[2], X.wa[3]);
            att::pv_one<2>(o0, vb + 16384, X.wa[4], X.wa[5], X.wa[6], X.wa[7]); att::pv_one<3>(o1, vb + 16384, X.wa[4], X.wa[5], X.wa[6], X.wa[7]);
        }
#pragma unroll
        for (int r = 0; r < 16; ++r) { const int q = qt * 32 + crow(r, hi);
            *(LAS float*)(lds + CM_OUT + q * CM_OUT_PITCH + (chh * 64 + xl) * 4) = o0[r];
            *(LAS float*)(lds + CM_OUT + q * CM_OUT_PITCH + (chh * 64 + 32 + xl) * 4) = o1[r]; }
    }
    __syncthreads();
    {
        const int q = tid >> 2, c32 = (tid & 3) * 32; const float bias = bsg[q];
        const bf16_t* up = Zb + (size_t)(m0 + q) * INW + OFF_CU + C0 + c32;
        bf16_t* op = F.BR() + (size_t)2 * M * D + (size_t)(m0 + q) * D + C0 + c32;
#pragma unroll
        for (int i = 0; i < 4; ++i) {
            const u32x4 uw = *(const u32x4*)(up + i * 8);
            const f32x4 a = *(const LAS f32x4*)(lds + CM_OUT + q * CM_OUT_PITCH + (c32 + i * 8) * 4), b2 = *(const LAS f32x4*)(lds + CM_OUT + q * CM_OUT_PITCH + (c32 + i * 8 + 4) * 4);
            const f32x4 u0 = {bflo(uw.x), bfhi(uw.x), bflo(uw.y), bfhi(uw.y)}, u1 = {bflo(uw.z), bfhi(uw.z), bflo(uw.w), bfhi(uw.w)};
            *(u32x4*)(op + i * 8) = pack8(u0 * (a + bias), u1 * (b2 + bias));
        }
    }
}
__device__ __forceinline__ void cm_phase(const Frame& F, int l) {
    CmCtx X; int cur = -1;
    const float* cmg = inp<I_CMG>(F) + (size_t)l * D; const float* bs = inp<I_CMBS>(F) + (size_t)l * 16 * 128;
    for (int u = F.bx; u < 192 * 16; u += F.G) {
        const int g = u & 15, cn = u >> 4;
        if (g != cur) { cm_ctx_load(F, g, X); cur = g; }
        cm_unit(F, cn, g, X, cmg, bs + g * 128);
    }
    __syncthreads();
}
__device__ __forceinline__ void attn_phase(const Frame& F) {
    char* lds = (char*)F.lds;
    const att::bf16* Z = (const att::bf16*)F.Z(); const att::bf16* K = (const att::bf16*)F.KALL(); const att::bf16* V = (const att::bf16*)F.VALL(); att::bf16* O = (att::bf16*)F.BR();
    for (int id = F.bx; id < 1536; id += F.G) {
        size_t qrow, kvrow; int h, nkeys;
        if (id < 1024) { const int qb = id & 7, b = id >> 7; h = (id >> 3) & 15; qrow = (size_t)MP + (size_t)b * 2048 + qb * 256; kvrow = (size_t)MP + (size_t)b * 2304; nkeys = 2304; }
        else { const int id2 = id - 1024, b = id2 >> 4; h = id2 & 15; qrow = (size_t)b * 256; kvrow = qrow; nkeys = 256; }
        att::attn_dense_body<att::bf16>(Z + qrow * INW + OFF_Q + h * 128, K + kvrow * 512 + (h >> 2) * 128, V + kvrow * 512 + (h >> 2) * 128, O + qrow * D + h * 128, nkeys, lds);
    }
    __syncthreads();
}
}
#ifndef REP_G
#define REP_G 1
#endif
#ifndef REP_A
#define REP_A 1
#endif
#ifndef REP_L
#define REP_L 1
#endif
#ifndef REP_V
#define REP_V 1
#endif
#ifndef REP_R
#define REP_R 1
#endif
#ifndef REP_GSEL
#define REP_GSEL 0
#endif
#ifndef REP_C
#define REP_C 1
#endif
namespace fk {
#if REP_G > 1 || REP_GSEL > 0
template <class Base> struct RepOrder {
    Base b; int n;
    __device__ void init_n() { Unit u; n = 0; while (b.next(n, u)) ++n; }
    __device__ bool next(int i, Unit& u) const { if (i >= 2 * n) return false; return b.next(i >= n ? i - n : i, u); }
    __device__ __forceinline__ void a_ready(const Unit&) const {}
    __device__ __forceinline__ void done(const Unit&) const {}
};
#define GEMM_REP(EPI, ORD, g, S, E) do { RepOrder<ORD> RS_; RS_.b = S; RS_.init_n(); pg8::gemm_phase<EPI, RepOrder<ORD>, true, true>(P.lds, g, RS_, E); } while (0)
#endif
#define GEMM_ONE(EPI, ORD, g, S, E) pg8::gemm_phase<EPI, ORD, true, true>(P.lds, g, S, E)
#if REP_G > 1
#define GEMM_CALL(ID, EPI, ORD, g, S, E) GEMM_REP(EPI, ORD, g, S, E)
#elif REP_GSEL > 0
#define GEMM_CALL(ID, EPI, ORD, g, S, E) do { if (ID == REP_GSEL) GEMM_REP(EPI, ORD, g, S, E); else GEMM_ONE(EPI, ORD, g, S, E); } while (0)
#else
#define GEMM_CALL(ID, EPI, ORD, g, S, E) GEMM_ONE(EPI, ORD, g, S, E)
#endif
__global__ void __launch_bounds__(NWAVES * 64, 2) mega(Params p) {
    extern __shared__ __attribute__((aligned(16))) unsigned char lds_raw[];
    Frame F;
    F.lds = (LAS unsigned char*)lds_raw;
    F.tid = threadIdx.x; F.lane = F.tid & 63; F.wave = __builtin_amdgcn_readfirstlane(F.tid >> 6);
    F.G = gridDim.x; { const int bx = blockIdx.x; F.vcu = (F.G % 8 == 0) ? (bx % 8) * (F.G / 8) + bx / 8 : bx; }
    F.gw = F.vcu * NWAVES + F.wave; F.NGW = F.G * NWAVES; F.bx = blockIdx.x;
    F.out = p.out; F.ws = p.ws; F.ka = (kaptr_t)__builtin_amdgcn_kernarg_segment_ptr();
    unsigned char* ws = p.ws;
    volatile LAS unsigned* MISC = (volatile LAS unsigned*)(F.lds + MISC_OFF);
    for (int u = F.tid; u < (LDS_BYTES - MISC_OFF) / 4; u += NWAVES * 64) ((LAS unsigned*)(F.lds + MISC_OFF))[u] = 0u;
    __syncthreads();
    unsigned* barw = (unsigned*)(ws + WS_CTL) + CW_BAR + p.li * XCD_BAR_WORDS;
    XcdBarrier bar = xcd_barrier_post(barw, MISC + 8);
    const int lo = p.ph_lo, hi = p.ph_hi;
#define IN_PH(k) (lo <= (k) && (k) < hi)
#define SEAM(k) do { if ((k) + 1 < hi) xcd_barrier(bar); } while (0)

    if (IN_PH(0)) { const Frame P = phase_frame(F);
convert_layer(P, 0); mod_partials(P); rope_table(P);
#if REP_V > 1
        __syncthreads(); convert_layer(P, 0); mod_partials(P);
#endif
 SEAM(0); }
    if (IN_PH(1)) { const Frame P = phase_frame(F); mod_reduce(P); SEAM(1); }
    if (IN_PH(2)) { const Frame P = phase_frame(F); rowlocal_phase<0>(P, 0); SEAM(2); }
    for (int l = 0; l < DEPTH; ++l) {
        const int pb = 3 + 9 * l;
        if (IN_PH(pb + 0)) { const Frame P = phase_frame(F);
            pg8::Gemm g{P.H(), P.WIN(), M, INW, D}; pg8::StaticOrder S; S.init(M, INW, P.G, P.bx);
            EpiIn E{P.Z(), P.VALL(), P.new_v(), P.CVSTAT(), l};

GEMM_CALL(1, EpiIn, pg8::StaticOrder, g, S, E);

            SEAM(pb + 0);
        }
        if (IN_PH(pb + 1)) { const Frame P = phase_frame(F);

prep_phase(P, l);

            __syncthreads();

lru_phase<1>(P, l);
#if REP_L > 1
            lru_phase<1>(P, l);
#endif


cm_phase(P, l);
#if REP_C > 1
            cm_phase(P, l);
#endif

            SEAM(pb + 1);
        }
        if (IN_PH(pb + 2)) { const Frame P = phase_frame(F);

attn_phase(P);
#if REP_A > 1
            attn_phase(P);
#endif


lru_phase<2>(P, l);
#if REP_L > 1
            lru_phase<2>(P, l);
#endif

            SEAM(pb + 2);
        }
        if (IN_PH(pb + 3)) { const Frame P = phase_frame(F);
            pg8::Gemm g{P.BR(), P.WBR(), 3 * M, 3 * D, D}; MergeOrder S; S.init(P.G, P.bx);
            EpiMerge E{P.Z(), P.MSCR() + (size_t)P.bx * 65536, P.H()};

GEMM_CALL(2, EpiMerge, MergeOrder, g, S, E);

            SEAM(pb + 3);
        }
        if (IN_PH(pb + 4)) { const Frame P = phase_frame(F);
            pg8::Gemm g{P.H(), P.WOUT(), M, D, D}; pg8::StaticOrder S; S.init(M, D, P.G, P.bx);
            EpiF E{P.Fb(), P.FSTAT()};

GEMM_CALL(3, EpiF, pg8::StaticOrder, g, S, E);
            SEAM(pb + 4);

        }
        if (IN_PH(pb + 5)) { const Frame P = phase_frame(F);

#if REP_R > 1
            rowlocal_phase<1>(P, l, 0.f);
#endif
            rowlocal_phase<1>(P, l);
 SEAM(pb + 5); }
        if (IN_PH(pb + 6)) { const Frame P = phase_frame(F);
            pg8::Gemm g{P.H(), P.WFF1(), M, DFF, D}; pg8::StaticOrder S; S.init(M, DFF, P.G, P.bx);
            EpiRelu2 E{P.FFH(), DFF};

GEMM_CALL(4, EpiRelu2, pg8::StaticOrder, g, S, E);

            SEAM(pb + 6);
        }
        if (IN_PH(pb + 7)) { const Frame P = phase_frame(F);
            pg8::Gemm g{P.FFH(), P.WFF2(), M, D, DFF}; pg8::StaticOrder S; S.init(M, D, P.G, P.bx);
            EpiF E{P.Fb(), P.FSTAT()};

GEMM_CALL(5, EpiF, pg8::StaticOrder, g, S, E);
            SEAM(pb + 7);

        }
        if (IN_PH(pb + 8)) { const Frame P = phase_frame(F);


#if REP_R > 1
            rowlocal_phase<2>(P, l, 0.f);
#endif
            rowlocal_phase<2>(P, l);


if (l + 1 < DEPTH) { __syncthreads(); convert_layer(P, l + 1); }
#if REP_V > 1
            if (l + 1 < DEPTH) { __syncthreads(); convert_layer(P, l + 1); }
#endif

            SEAM(pb + 8);
        }
    }
#undef IN_PH
#undef SEAM
}
}
extern "C" void kernel_launch(void* const* d_in, const int* in_sizes, int n_in, void* d_out, int out_size, void* d_ws, size_t ws_size, hipStream_t stream) {
    static int grid = 0;
    if (grid == 0) {
        if (n_in != 32 || out_size != 84410368 || ws_size < fk::WS_END) { fprintf(stderr, "kernel_launch: unexpected shapes: n_in %d out %d ws %zu (need %zu)\n", n_in, out_size, ws_size, (size_t)fk::WS_END); grid = -1; return; }
        int dev = 0, cus = 0;
        if (hipGetDevice(&dev) != hipSuccess || hipDeviceGetAttribute(&cus, hipDeviceAttributeMultiprocessorCount, dev) != hipSuccess) { grid = -1; return; }
        if (hipFuncSetAttribute((const void*)fk::mega, hipFuncAttributeMaxDynamicSharedMemorySize, fk::LDS_BYTES) != hipSuccess) { fprintf(stderr, "kernel_launch: hipFuncSetAttribute failed\n"); grid = -1; return; }
        int per_cu = 0;
        if (hipOccupancyMaxActiveBlocksPerMultiprocessor(&per_cu, (const void*)fk::mega, fk::NWAVES * 64, fk::LDS_BYTES) != hipSuccess || per_cu < 1) fprintf(stderr, "kernel_launch: occupancy query says %d blocks per CU\n", per_cu);
        (void)hipGetLastError();
        grid = cus < 256 ? cus : 256;
    }
    if (grid < 0) return;
    (void)hipMemsetAsync((char*)d_ws + fk::WS_CTL, 0, fk::CTL_ZERO_BYTES, stream);
    fk::Params p{};
    for (int i = 0; i < 32; ++i) p.in[i] = (const float*)d_in[i];
    p.out = (float*)d_out; p.ws = (unsigned char*)d_ws; p.ph_lo = 0; p.ph_hi = fk::NPHASE; p.li = 0; p.pad = 0;
    hipLaunchKernelGGL(fk::mega, dim3(grid), dim3(fk::NWAVES * 64), fk::LDS_BYTES, stream, p);
}
```

```cpp
#include <hip/hip_runtime.h>
#include <hip/hip_bf16.h>
#include <cstdio>
#include <cstdint>
namespace pg8 {
#define PG8_LAS __attribute__((address_space(3)))
typedef unsigned short bf16_t;
typedef short bf16x8 __attribute__((ext_vector_type(8)));
typedef float f32x4 __attribute__((ext_vector_type(4)));
typedef unsigned u32x4 __attribute__((ext_vector_type(4)));
constexpr int BM = 256, BK = 64, HALF = 128, HTB = HALF * BK * 2  , STAGE_BYTES = 8 * HTB, NXCD = 8, WGM = 8;

__host__ __device__ __forceinline__ int lds_byte(int r, int c) { const int st = (r >> 4) * 2 + (c >> 5), rr = r & 15, cc = c & 31, ob = rr * 64 + cc * 2; return st * 1024 + (ob ^ (((ob >> 9) & 1) << 5)); }
__host__ __device__ __forceinline__ void stage_rc(int b, int& R, int& C) { const int st = b / 1024, sb = b % 1024, swz = sb ^ (((sb >> 9) & 1) << 5); R = (st >> 1) * 16 + swz / 64; C = (st & 1) * 32 + (swz % 64) / 2; }
__host__ __device__ __forceinline__ int perm32(int rho) { const int n = rho >> 4, i = rho & 15; return 8 * (i >> 2) + 4 * n + (i & 3); }

struct Unit { int pm, pn; };
struct Gemm { const bf16_t* A; const bf16_t* Bt; int M, N, K; };

struct StaticOrder {
    int nM, nN, nwg, G, c;
    __host__ __device__ void init(int M, int N, int G_, int c_) { nM = M / BM; nN = N / BM; nwg = nM * nN; G = G_; c = c_; }
    __host__ __device__ bool next(int i, Unit& u) const {
        const long L = (long)i * G + c; if (L >= nwg) return false;
        int wgid = (int)L; { const int q = nwg / NXCD, r = nwg % NXCD, xcd = wgid % NXCD, off = wgid / NXCD; wgid = (xcd < r ? xcd * (q + 1) : r * (q + 1) + (xcd - r) * q) + off; }
        const int nig = WGM * nN, gid = wgid / nig, fm = gid * WGM, gsz = (nM - fm) < WGM ? (nM - fm) : WGM;
        u.pm = fm + ((wgid % nig) % gsz); u.pn = (wgid % nig) / gsz; return true;
    }
    __device__ __forceinline__ void a_ready(const Unit&) const {}
    __device__ __forceinline__ void done(const Unit&) const {}
};
__device__ __forceinline__ unsigned cvt_pk_bf16(float lo, float hi) { unsigned r; asm volatile("v_cvt_pk_bf16_f32 %0, %1, %2" : "=v"(r) : "v"(lo), "v"(hi)); return r; }
template <class Epi, class Sched, bool ALIGN_EPI = false, bool SP2 = false>
__device__ __forceinline__ void gemm_phase(PG8_LAS unsigned char* lds, const Gemm g, const Sched& S, const Epi& E) {
    int tid_ = threadIdx.x; asm volatile("" : "+v"(tid_));
    const int tid = tid_, wid = __builtin_amdgcn_readfirstlane(tid >> 6), lane = tid & 63, wr = wid >> 2, wc = wid & 3, fr = lane & 15, fq = lane >> 4;
    const int K = g.K, nt = K / BK;
    unsigned voffA[2], voffB[2];
#pragma unroll
    for (int i = 0; i < 2; ++i) { int R, C; stage_rc(tid * 16 + i * 8192, R, C); const int Rb = Epi::PERM ? ((R & ~31) + perm32(R & 31)) : R;
        voffA[i] = (unsigned)(R * K + C) * 2u; voffB[i] = (unsigned)(Rb * K + C) * 2u; }
    const size_t kstep = (size_t)(BK * 2);
    const size_t hstep = (size_t)HALF * K * 2;
    const size_t tstep = 2 * hstep;
    const unsigned ldsw = (unsigned)wid * 1024u;
    const int aoff = lds_byte(wr * 64 + fr, fq * 8), boff = lds_byte(wc * 32 + fr, fq * 8);
#define PG8_SA(b, h) (((b) * 2 + (h)) * HTB)
#define PG8_SB(b, h) ((4 + (b) * 2 + (h)) * HTB)
#define PG8_STAGE(bufoff, gbase, voff) do { _Pragma("unroll") for (int _i = 0; _i < 2; ++_i) \
        __builtin_amdgcn_global_load_lds((const unsigned*)((const char*)(gbase) + (voff)[_i]), (PG8_LAS unsigned*)(lds + (bufoff) + ldsw + _i * 8192), 16, 0, 0); } while (0)
#define PG8_LDA(dst, b, h) do { _Pragma("unroll") for (int m = 0; m < 4; ++m) _Pragma("unroll") for (int k = 0; k < 2; ++k) dst[m][k] = *(const PG8_LAS bf16x8*)(lds + PG8_SA(b, h) + aoff + m * 2048 + k * 1024); } while (0)
#define PG8_LDB(dst, b, h) do { _Pragma("unroll") for (int n = 0; n < 2; ++n) _Pragma("unroll") for (int k = 0; k < 2; ++k) dst[n][k] = *(const PG8_LAS bf16x8*)(lds + PG8_SB(b, h) + boff + n * 2048 + k * 1024); } while (0)
#define PG8_MMA(ai, bj, At, Bt) do { __builtin_amdgcn_s_setprio(1); _Pragma("unroll") for (int m = 0; m < 4; ++m) _Pragma("unroll") for (int n = 0; n < 2; ++n) _Pragma("unroll") for (int k = 0; k < 2; ++k) \
        acc[ai][bj][m][n] = __builtin_amdgcn_mfma_f32_16x16x32_bf16(Bt[n][k], At[m][k], acc[ai][bj][m][n], 0, 0, 0); __builtin_amdgcn_s_setprio(0); } while (0)
#define PG8_WAIT_V(n) asm volatile("s_waitcnt vmcnt(" #n ")" ::: "memory")
#define PG8_WAIT_L(n) asm volatile("s_waitcnt lgkmcnt(" #n ")" ::: "memory")
#define PG8_BAR __builtin_amdgcn_s_barrier()
#define PG8_SCHED __builtin_amdgcn_sched_barrier(0)
    Unit cur, nxt; int ui = 0;
    if (!S.next(0, cur)) return;
    f32x4 acc[2][2][4][2];
#pragma unroll
    for (int a = 0; a < 2; ++a)
#pragma unroll
        for (int b = 0; b < 2; ++b)
#pragma unroll
            for (int m = 0; m < 4; ++m)
#pragma unroll
                for (int n = 0; n < 2; ++n) acc[a][b][m][n] = (f32x4){0.f, 0.f, 0.f, 0.f};
    bf16x8 At[4][2], B0[2][2], B1[2][2];
    const char* cA = (const char*)g.A + (size_t)cur.pm * tstep; const char* cB = (const char*)g.Bt + (size_t)cur.pn * tstep;
    S.a_ready(cur);
    if constexpr (SP2) {
        PG8_STAGE(PG8_SB(0, 0), cB, voffB); PG8_STAGE(PG8_SB(0, 1), cB + hstep, voffB); PG8_STAGE(PG8_SA(0, 0), cA, voffA); PG8_STAGE(PG8_SA(0, 1), cA + hstep, voffA);
        if (wr == 1) PG8_BAR;
        PG8_WAIT_V(2); PG8_BAR;
        PG8_STAGE(PG8_SB(1, 0), cB + kstep, voffB); PG8_STAGE(PG8_SA(1, 0), cA + kstep, voffA); PG8_STAGE(PG8_SB(1, 1), cB + hstep + kstep, voffB);
        PG8_WAIT_V(6); PG8_BAR;
    } else {
        PG8_STAGE(PG8_SB(0, 0), cB, voffB); PG8_STAGE(PG8_SA(0, 0), cA, voffA); PG8_STAGE(PG8_SB(0, 1), cB + hstep, voffB); PG8_STAGE(PG8_SA(0, 1), cA + hstep, voffA);
        if (wr == 1) PG8_BAR;
        PG8_WAIT_V(4); PG8_BAR;
        PG8_STAGE(PG8_SB(1, 0), cB + kstep, voffB); PG8_STAGE(PG8_SA(1, 0), cA + kstep, voffA); PG8_STAGE(PG8_SB(1, 1), cB + hstep + kstep, voffB);
        PG8_WAIT_V(6); PG8_BAR;
    }
    for (;;) {
        const bool has_next = S.next(ui + 1, nxt);
        const char* nA = has_next ? (const char*)g.A + (size_t)nxt.pm * tstep : cA; const char* nB = has_next ? (const char*)g.Bt + (size_t)nxt.pn * tstep : cB;
        for (int t = 0; t < nt; t += 2) {
            const bool last = (t == nt - 2);
            const char* a1 = cA + (size_t)(t + 1) * kstep;
            const char* a2 = last ? nA : cA + (size_t)(t + 2) * kstep; const char* b2 = last ? nB : cB + (size_t)(t + 2) * kstep;
            const char* a3 = a2 + kstep; const char* b3 = b2 + kstep;
            if (last && has_next) S.a_ready(nxt);
            if constexpr (SP2) {
            PG8_LDB(B0, 0, 0); PG8_LDB(B1, 0, 1); PG8_SCHED; PG8_LDA(At, 0, 0); PG8_STAGE(PG8_SA(1, 1), a1 + hstep, voffA);
            PG8_WAIT_V(8); PG8_WAIT_L(0); PG8_BAR; PG8_MMA(0, 0, At, B0); PG8_MMA(0, 1, At, B1); PG8_BAR; PG8_SCHED;
            PG8_LDA(At, 0, 1); PG8_STAGE(PG8_SB(0, 0), b2, voffB); PG8_STAGE(PG8_SB(0, 1), b2 + hstep, voffB); PG8_STAGE(PG8_SA(0, 0), a2, voffA);
            PG8_WAIT_V(8); PG8_WAIT_L(0); PG8_BAR; PG8_MMA(1, 0, At, B0); PG8_MMA(1, 1, At, B1); PG8_BAR; PG8_SCHED;
            PG8_LDB(B0, 1, 0); PG8_LDB(B1, 1, 1); PG8_SCHED; PG8_LDA(At, 1, 0); PG8_STAGE(PG8_SA(0, 1), a2 + hstep, voffA);
            PG8_WAIT_V(8); PG8_WAIT_L(0); PG8_BAR; PG8_MMA(0, 0, At, B0); PG8_MMA(0, 1, At, B1); PG8_BAR; PG8_SCHED;
            PG8_LDA(At, 1, 1); PG8_STAGE(PG8_SB(1, 0), b3, voffB); PG8_STAGE(PG8_SB(1, 1), b3 + hstep, voffB); PG8_STAGE(PG8_SA(1, 0), a3, voffA);
            PG8_WAIT_V(8); PG8_WAIT_L(0); PG8_BAR; PG8_MMA(1, 0, At, B0); PG8_MMA(1, 1, At, B1); PG8_BAR; PG8_SCHED;
            } else {
            PG8_LDB(B0, 0, 0); PG8_SCHED; PG8_LDA(At, 0, 0); PG8_STAGE(PG8_SA(1, 1), a1 + hstep, voffA);
            PG8_WAIT_L(8); PG8_BAR; PG8_WAIT_L(0); PG8_MMA(0, 0, At, B0); PG8_BAR; PG8_SCHED;
            PG8_LDB(B1, 0, 1); PG8_STAGE(PG8_SB(0, 0), b2, voffB);
            PG8_BAR; PG8_WAIT_L(0); PG8_MMA(0, 1, At, B1); PG8_BAR;
            PG8_LDA(At, 0, 1); PG8_STAGE(PG8_SA(0, 0), a2, voffA);
            PG8_BAR; PG8_WAIT_L(0); PG8_MMA(1, 0, At, B0); PG8_BAR; PG8_SCHED;
            PG8_STAGE(PG8_SB(0, 1), b2 + hstep, voffB);
            PG8_WAIT_V(6); PG8_BAR; PG8_MMA(1, 1, At, B1); PG8_BAR;
            PG8_LDB(B0, 1, 0); PG8_SCHED; PG8_LDA(At, 1, 0); PG8_STAGE(PG8_SA(0, 1), a2 + hstep, voffA);
            PG8_WAIT_L(8); PG8_BAR; PG8_WAIT_L(0); PG8_MMA(0, 0, At, B0); PG8_BAR; PG8_SCHED;
            PG8_LDB(B1, 1, 1); PG8_STAGE(PG8_SB(1, 0), b3, voffB);
            PG8_BAR; PG8_WAIT_L(0); PG8_MMA(0, 1, At, B1); PG8_BAR;
            PG8_LDA(At, 1, 1); PG8_STAGE(PG8_SA(1, 0), a3, voffA);
            PG8_BAR; PG8_WAIT_L(0); PG8_MMA(1, 0, At, B0); PG8_BAR; PG8_SCHED;
            PG8_STAGE(PG8_SB(1, 1), b3 + hstep, voffB);
            PG8_WAIT_V(6); PG8_BAR; PG8_MMA(1, 1, At, B1); PG8_BAR;
            }
        }
        if constexpr (ALIGN_EPI) { if (wr == 0) PG8_BAR; }
        if constexpr (!Epi::AFTER_DRAIN) { E(acc, cur, wr, wc, fr, fq); S.done(cur); }
        if (!has_next) break;
#pragma unroll
        for (int a = 0; a < 2; ++a)
#pragma unroll
            for (int b = 0; b < 2; ++b)
#pragma unroll
                for (int m = 0; m < 4; ++m)
#pragma unroll
                    for (int n = 0; n < 2; ++n) acc[a][b][m][n] = (f32x4){0.f, 0.f, 0.f, 0.f};
        cur = nxt; cA = nA; cB = nB; ++ui;
        if constexpr (ALIGN_EPI) { if (wr == 1) PG8_BAR; }
    }
    PG8_WAIT_V(0);
    if constexpr (!ALIGN_EPI) { if (wr == 0) PG8_BAR; }
    PG8_BAR;
    if constexpr (Epi::AFTER_DRAIN) { E.fused(acc, cur, wr, wc, fr, fq, lds, wid, lane); S.done(cur); }
#undef PG8_SA
#undef PG8_SB
#undef PG8_STAGE
#undef PG8_LDA
#undef PG8_LDB
#undef PG8_MMA
#undef PG8_WAIT_V
#undef PG8_WAIT_L
#undef PG8_BAR
#undef PG8_SCHED
}
}
#define GAS __attribute__((address_space(1)))
#define LAS __attribute__((address_space(3)))
typedef unsigned short bf16;
typedef unsigned v4u __attribute__((ext_vector_type(4)));
typedef float f32x4 __attribute__((ext_vector_type(4)));
typedef short bf16x8 __attribute__((ext_vector_type(8)));
typedef GAS unsigned gu32;
typedef GAS unsigned long long gu64;
#define RLX_AGENT __ATOMIC_RELAXED, __HIP_MEMORY_SCOPE_AGENT
#define LDS_WAIT() asm volatile("s_waitcnt lgkmcnt(0)" ::: "memory")
#define VM_WAIT() asm volatile("s_waitcnt vmcnt(0)" ::: "memory")
__device__ __forceinline__ unsigned long long rt() { return __builtin_amdgcn_s_memrealtime(); }
__device__ __forceinline__ unsigned f2bf(float f) { unsigned u = __builtin_bit_cast(unsigned, f); return (u + 0x7fffu + ((u >> 16) & 1u)) >> 16; }
__device__ __forceinline__ unsigned pk2(float lo, float hi) { return f2bf(lo) | (f2bf(hi) << 16); }

#define XB_TMO      128
#define XB_XCNT(j)  (256  + 64 * (j))
#define XB_XSUB(j)  (1280 + 64 * (j))
#define XB_XGEN(j)  (2304 + 64 * (j))
#define XB_TOP      3328
#define XB_TOPGEN   3392
#define XCD_BAR_WORDS 3456
#define XB_SPIN_CAP (1u << 18)

__device__ __forceinline__ unsigned xb_ld(unsigned* p)              { return __hip_atomic_load(p, __ATOMIC_RELAXED, __HIP_MEMORY_SCOPE_AGENT); }
__device__ __forceinline__ unsigned xb_add(unsigned* p, unsigned v) { return __hip_atomic_fetch_add(p, v, __ATOMIC_RELAXED, __HIP_MEMORY_SCOPE_AGENT); }
__device__ __forceinline__ unsigned xb_xcc_id() { return (unsigned)__builtin_amdgcn_s_getreg((3 << 11) | 20) & 0xFu; }
#define XB_SPIN(cond, bar) do { unsigned _sp = 0; while (cond) { __builtin_amdgcn_s_sleep(1); \
    if ((++_sp & 255u) == 0u) { if (xb_ld(&(bar)[XB_TMO])) break; if (_sp > XB_SPIN_CAP) { atomicAdd(&(bar)[XB_TMO], 1u); break; } } } } while (0)

struct XcdBarrier {
    unsigned* bar; unsigned x;
    volatile LAS unsigned* st;
};

__device__ __forceinline__ XcdBarrier xcd_barrier_post(unsigned* bar, volatile LAS unsigned* st) {
    XcdBarrier b; b.bar = bar; b.x = xb_xcc_id(); b.st = st;
    if (threadIdx.x == 0) (void)xb_add(&bar[XB_XCNT(b.x)], 1u);
    return b;
}
__device__ __forceinline__ void xcd_barrier_complete(unsigned* bar, unsigned x, unsigned& nloc, unsigned& nx) {
    const unsigned G = gridDim.x * gridDim.y * gridDim.z;
    unsigned sum, cnt, mine, sp = 0u;
    for (;;) {
        sum = 0u; cnt = 0u; mine = 0u;
#pragma unroll
        for (unsigned j = 0; j < 16; ++j) { const unsigned c = xb_ld(&bar[XB_XCNT(j)]); sum += c; cnt += (c > 0u) ? 1u : 0u; mine = (j == x) ? c : mine; }
        if (sum == G) break;
        __builtin_amdgcn_s_sleep(1);
        if ((++sp & 255u) == 0u) { if (xb_ld(&bar[XB_TMO])) break; if (sp > XB_SPIN_CAP) { atomicAdd(&bar[XB_TMO], 1u); break; } }
    }
    nloc = mine > 0u ? mine : 1u; nx = cnt > 0u ? cnt : 1u;
}

__device__ __forceinline__ void xcd_barrier(const XcdBarrier& b) {
    asm volatile("s_waitcnt vmcnt(0)" ::: "memory");
    __syncthreads();
    if (threadIdx.x == 0) {
        unsigned* bar = b.bar;
        __builtin_amdgcn_s_waitcnt(0);
        unsigned nloc = b.st[0], nx = b.st[1];
        if (nloc == 0u) { xcd_barrier_complete(bar, b.x, nloc, nx); b.st[0] = nloc; b.st[1] = nx; }
        const unsigned old = xb_add(&bar[XB_XSUB(b.x)], 1u);
        const unsigned gen = old / nloc;
        if (old + 1u == (gen + 1u) * nloc) {
            __builtin_amdgcn_fence(__ATOMIC_RELEASE, "agent");
            asm volatile("s_waitcnt vmcnt(0)" ::: "memory");
            const unsigned og = xb_add(&bar[XB_TOP], 1u);
            const unsigned tg = og / nx;
            if (og + 1u == (tg + 1u) * nx) xb_add(&bar[XB_TOPGEN], 1u);
            else XB_SPIN(xb_ld(&bar[XB_TOPGEN]) == tg, bar);
            __builtin_amdgcn_fence(__ATOMIC_ACQUIRE, "agent");
            xb_add(&bar[XB_XGEN(b.x)], 1u);
            asm volatile("s_waitcnt vmcnt(0)" ::: "memory");
        } else {
            XB_SPIN(xb_ld(&bar[XB_XGEN(b.x)]) == gen, bar);
            __builtin_amdgcn_fence(__ATOMIC_ACQUIRE, "agent");
            asm volatile("s_waitcnt vmcnt(0)" ::: "memory");
        }
    }
    __syncthreads();
}
namespace att {
constexpr int   D = 128, NW = 8, QBLK = 32, KVBLK = 64;
constexpr float SCALE = 0.088388347648318440f;
constexpr float THR = 8.f;
constexpr int SDEPTH = 2;
constexpr int LDQ = 17408, LDK = 512, LDO = 2048;
constexpr size_t SHM_V = KVBLK * D * 2, SHM_K = KVBLK * D * 2, SHM_ATTN = 2 * SHM_V + 2 * SHM_K + NW * 64 * 4;
using bf16 = __hip_bfloat16;
using bf16x8 = __attribute__((ext_vector_type(8))) short;
using s16x4  = __attribute__((ext_vector_type(4))) short;
using f32x16 = __attribute__((ext_vector_type(16))) float;
using f32x8  = __attribute__((ext_vector_type(8))) float;
using u32x4  = __attribute__((ext_vector_type(4))) unsigned;
#define KSWZ(row, colB) ((row) * 256 + ((colB) ^ (((row) & 7) << 4)))
#define SBAR() __builtin_amdgcn_sched_barrier(0)
__device__ __forceinline__ int crow(int r, int hi) { return (r & 3) + 8 * (r >> 2) + 4 * hi; }
__device__ __forceinline__ unsigned cvtpk(float lo, float hi) {
  unsigned r; asm volatile("v_cvt_pk_bf16_f32 %0, %1, %2" : "=v"(r) : "v"(lo), "v"(hi)); return r;
}
template <typename TIn> struct Stage;
template <> struct Stage<bf16>  { using T = bf16x8;
  __device__ static __forceinline__ T ld8(const bf16* p) { return *reinterpret_cast<const bf16x8*>(p); }
  __device__ static __forceinline__ bf16x8 tobf(T x) { return x; } };
template <> struct Stage<float> { using T = f32x8;
  __device__ static __forceinline__ T ld8(const float* p) { return *reinterpret_cast<const f32x8*>(p); }
  __device__ static __forceinline__ bf16x8 tobf(T x) {
    u32x4 w = {cvtpk(x[0], x[1]), cvtpk(x[2], x[3]), cvtpk(x[4], x[5]), cvtpk(x[6], x[7])}; return *reinterpret_cast<bf16x8*>(&w); } };

__device__ __forceinline__ void partialSM(f32x16& p0, f32x16& p1, float& m_reg, float& mn, float& alpha) {
  constexpr float C = SCALE * 1.4426950408889634f;
  float pmax = p0[0]; for (int r = 1; r < 16; ++r) pmax = fmaxf(pmax, p0[r]); for (int r = 0; r < 16; ++r) pmax = fmaxf(pmax, p1[r]);
  { auto rr = __builtin_amdgcn_permlane32_swap(__float_as_uint(pmax), __float_as_uint(pmax), false, false);
    pmax = fmaxf(__uint_as_float(rr[0]), __uint_as_float(rr[1])); }
  if (__builtin_expect(__all(pmax - m_reg <= THR / SCALE), 1)) { mn = m_reg; alpha = 1.f; }
  else { mn = fmaxf(m_reg, pmax); alpha = __builtin_amdgcn_exp2f((m_reg - mn) * C); m_reg = mn; }
  float mnC = -mn * C;
  for (int r = 0; r < 16; ++r) p0[r] = fmaf(p0[r], C, mnC); for (int r = 0; r < 16; ++r) p1[r] = fmaf(p1[r], C, mnC);
  for (int r = 0; r < 16; ++r) p0[r] = __builtin_amdgcn_exp2f(p0[r]);
}
__device__ __forceinline__ void finishSM(f32x16& p0, f32x16& p1, float alpha, float& l_reg, bf16x8& pa0, bf16x8& pa1, bf16x8& pa2, bf16x8& pa3) {
  for (int r = 0; r < 16; ++r) p1[r] = __builtin_amdgcn_exp2f(p1[r]);
  float ps = 0; for (int r = 0; r < 16; ++r) ps += p0[r]; for (int r = 0; r < 16; ++r) ps += p1[r];
  { auto rr = __builtin_amdgcn_permlane32_swap(__float_as_uint(ps), __float_as_uint(ps), false, false);
    ps = __uint_as_float(rr[0]) + __uint_as_float(rr[1]); }
  l_reg = l_reg * alpha + ps;
#define PK4(P, BASE, OUT) do { unsigned a0 = cvtpk(P[BASE + 0], P[BASE + 1]), a1 = cvtpk(P[BASE + 2], P[BASE + 3]);   \
    unsigned b0 = cvtpk(P[BASE + 4], P[BASE + 5]), b1 = cvtpk(P[BASE + 6], P[BASE + 7]);                              \
    auto r0 = __builtin_amdgcn_permlane32_swap(a0, b0, false, false); auto r1 = __builtin_amdgcn_permlane32_swap(a1, b1, false, false); \
    u32x4 w = {r0[0], r1[0], r0[1], r1[1]}; OUT = *reinterpret_cast<bf16x8*>(&w); } while (0)
  PK4(p0, 0, pa0); PK4(p0, 8, pa1); PK4(p1, 0, pa2); PK4(p1, 8, pa3);
#undef PK4
}
__device__ __forceinline__ void qkt(f32x16& p0, f32x16& p1, const bf16* Ks, const bf16x8* qr, int r32, int hi) {
  p0 = f32x16{}; p1 = f32x16{};
  for (int d0 = 0; d0 < 8; ++d0) { int cb = (d0 * 16 + hi * 8) * 2;
    bf16x8 b0 = *reinterpret_cast<const bf16x8*>((const char*)Ks + KSWZ(r32, cb));
    bf16x8 b1 = *reinterpret_cast<const bf16x8*>((const char*)Ks + KSWZ(32 + r32, cb));
    p0 = __builtin_amdgcn_mfma_f32_32x32x16_bf16(b0, qr[d0], p0, 0, 0, 0);
    p1 = __builtin_amdgcn_mfma_f32_32x32x16_bf16(b1, qr[d0], p1, 0, 0, 0); }
}
__device__ __forceinline__ int v_st(int k, int c) { const int kk = (k & ~0xC) | ((k & 4) << 1) | ((k & 8) >> 1); return ((kk >> 3) * 4 + (c >> 5)) * 512 + ((kk & 7) * 32 + (c & 31)) * 2; }
__device__ __forceinline__ int v_rd_base(int lane) { return ((lane & 3) << 3) | (((lane >> 2) & 3) << 6) | (((lane >> 4) & 1) << 5) | (((lane >> 5) & 1) << 8); }
constexpr int v_rd_off(int d0, int ks, int half) { return d0 * 512 + ks * 4096 + half * 2048; }
template <int OFF> __device__ __forceinline__ s16x4 tr_read(int vb) {
  s16x4 r; asm volatile("ds_read_b64_tr_b16 %0, %1 offset:%2" : "=&v"(r) : "v"(vb), "i"(OFF) : "memory"); return r;
}
template <int D0> __device__ __forceinline__ void pv_one(f32x16& od, int vb, bf16x8 pa0, bf16x8 pa1, bf16x8 pa2, bf16x8 pa3) {
  const s16x4 l0 = tr_read<v_rd_off(D0, 0, 0)>(vb), h0 = tr_read<v_rd_off(D0, 0, 1)>(vb), l1 = tr_read<v_rd_off(D0, 1, 0)>(vb), h1 = tr_read<v_rd_off(D0, 1, 1)>(vb);
  const s16x4 l2 = tr_read<v_rd_off(D0, 2, 0)>(vb), h2 = tr_read<v_rd_off(D0, 2, 1)>(vb), l3 = tr_read<v_rd_off(D0, 3, 0)>(vb), h3 = tr_read<v_rd_off(D0, 3, 1)>(vb);
  asm volatile("s_waitcnt lgkmcnt(0)" ::: "memory"); SBAR();
#define PK(L, H) (bf16x8){L[0], L[1], L[2], L[3], H[0], H[1], H[2], H[3]}
  od = __builtin_amdgcn_mfma_f32_32x32x16_bf16(pa0, PK(l0, h0), od, 0, 0, 0);
  od = __builtin_amdgcn_mfma_f32_32x32x16_bf16(pa1, PK(l1, h1), od, 0, 0, 0);
  od = __builtin_amdgcn_mfma_f32_32x32x16_bf16(pa2, PK(l2, h2), od, 0, 0, 0);
  od = __builtin_amdgcn_mfma_f32_32x32x16_bf16(pa3, PK(l3, h3), od, 0, 0, 0);
#undef PK
}
__device__ __forceinline__ void pv_d0(f32x16* o, int vb, bf16x8 pa0, bf16x8 pa1, bf16x8 pa2, bf16x8 pa3) {
  pv_one<0>(o[0], vb, pa0, pa1, pa2, pa3); pv_one<1>(o[1], vb, pa0, pa1, pa2, pa3); pv_one<2>(o[2], vb, pa0, pa1, pa2, pa3); pv_one<3>(o[3], vb, pa0, pa1, pa2, pa3);
}

template <typename TQ>
__device__ __forceinline__ void attn_dense_body(const TQ* __restrict__ Qb, const bf16* __restrict__ Kh, const bf16* __restrict__ Vh,
                                                bf16* __restrict__ Ob, int seq, char* lds) {
  using St = Stage<bf16>; using SQ = Stage<TQ>;
  int tid_ = threadIdx.x; asm volatile("" : "+v"(tid_));
  const int tid = tid_, wid = tid >> 6, lane = tid & 63, r32 = lane & 31, hi = lane >> 5;
  bf16* V_lds = (bf16*)lds; bf16* K_lds = (bf16*)(lds + 2 * SHM_V);
  float* ws = (float*)(lds + 2 * SHM_V + 2 * SHM_K) + wid * 64; float* li_l = ws; float* al_l = ws + 32;
  float m_reg = -1e30f, l_reg = 0; f32x16 o[4] = {}; bf16x8 qr[8];
  const TQ* Qw = Qb + (long)(wid * QBLK + r32) * LDQ + hi * 8;
#pragma unroll
  for (int d0 = 0; d0 < 8; ++d0) qr[d0] = SQ::tobf(SQ::ld8(Qw + d0 * 16));
  const int sr = tid >> 4, sc = (tid & 15) * 8, vst0 = v_st(sr, sc), vst1 = v_st(32 + sr, sc);
  const int vb0 = (int)(uintptr_t)V_lds + v_rd_base(lane);
  struct { typename St::T vs0, vs1, ks0, ks1; } sr_[SDEPTH];
#define SLOAD(i, k0) do { sr_[i].vs0 = St::ld8(&Vh[(long)((k0) + sr) * LDK + sc]); sr_[i].vs1 = St::ld8(&Vh[(long)((k0) + 32 + sr) * LDK + sc]); \
    sr_[i].ks0 = St::ld8(&Kh[(long)((k0) + sr) * LDK + sc]); sr_[i].ks1 = St::ld8(&Kh[(long)((k0) + 32 + sr) * LDK + sc]); } while (0)
#define SWRITE(b, i) do { *(bf16x8*)((char*)V_lds + (b) * SHM_V + vst0) = St::tobf(sr_[i].vs0);          \
    *(bf16x8*)((char*)V_lds + (b) * SHM_V + vst1) = St::tobf(sr_[i].vs1); int kc = sc * 2;               \
    *(bf16x8*)((char*)K_lds + (b) * SHM_K + KSWZ(sr, kc)) = St::tobf(sr_[i].ks0);                       \
    *(bf16x8*)((char*)K_lds + (b) * SHM_K + KSWZ(32 + sr, kc)) = St::tobf(sr_[i].ks1); } while (0)
#define SWAIT() do { if constexpr (SDEPTH == 2) asm volatile("s_waitcnt vmcnt(4)" ::: "memory"); else asm volatile("s_waitcnt vmcnt(0)" ::: "memory"); } while (0)
#define RESC(a) do { if (__any((a) < 1.f)) { if (hi == 0) al_l[r32] = (a); asm volatile("s_waitcnt lgkmcnt(0)" ::: "memory"); \
    for (int d = 0; d < 4; ++d) for (int r = 0; r < 16; ++r) o[d][r] *= al_l[crow(r, hi)]; } } while (0)
  f32x16 pA0, pA1, pB0, pB1; float mnA, mnB, alA, alB; bf16x8 pa0, pa1, pa2, pa3; const int NT = seq / KVBLK;
  constexpr int SE = 0, SO = SDEPTH - 1;
  SLOAD(SE, 0); asm volatile("s_waitcnt vmcnt(0)" ::: "memory"); SWRITE(0, SE); __syncthreads();
  qkt(pA0, pA1, K_lds, qr, r32, hi); partialSM(pA0, pA1, m_reg, mnA, alA);
  SLOAD(SO, KVBLK); if constexpr (SDEPTH == 2) { if (2 < NT) SLOAD(SE, 2 * KVBLK); }
  SWAIT(); SWRITE(1, SO); __syncthreads();
  for (int j = 1; j + 1 < NT; j += 2) {
    SBAR(); qkt(pB0, pB1, (bf16*)((char*)K_lds + SHM_K), qr, r32, hi);
    finishSM(pA0, pA1, alA, l_reg, pa0, pa1, pa2, pa3); SBAR();
    SLOAD(SO, (j + SDEPTH) * KVBLK); SBAR();
    pv_d0(o, vb0, pa0, pa1, pa2, pa3); partialSM(pB0, pB1, m_reg, mnB, alB);
    __syncthreads(); SWAIT(); SWRITE(0, SE);
    RESC(alB); __syncthreads();
    SBAR(); qkt(pA0, pA1, K_lds, qr, r32, hi);
    finishSM(pB0, pB1, alB, l_reg, pa0, pa1, pa2, pa3); SBAR();
    if (SDEPTH == 1 || j + 3 < NT) SLOAD(SE, (j + 1 + SDEPTH) * KVBLK); SBAR();
    pv_d0(o, vb0 + (int)SHM_V, pa0, pa1, pa2, pa3); partialSM(pA0, pA1, m_reg, mnA, alA);
    __syncthreads(); SWAIT(); SWRITE(1, SO);
    RESC(alA); __syncthreads();
  }
  SBAR(); qkt(pB0, pB1, (bf16*)((char*)K_lds + SHM_K), qr, r32, hi);
  finishSM(pA0, pA1, alA, l_reg, pa0, pa1, pa2, pa3); SBAR();
  pv_d0(o, vb0, pa0, pa1, pa2, pa3); partialSM(pB0, pB1, m_reg, mnB, alB);
  __syncthreads(); RESC(alB);
  finishSM(pB0, pB1, alB, l_reg, pa0, pa1, pa2, pa3); SBAR();
  pv_d0(o, vb0 + (int)SHM_V, pa0, pa1, pa2, pa3);
  if (hi == 0) li_l[r32] = l_reg; asm volatile("s_waitcnt lgkmcnt(0)" ::: "memory");
  float rli[16];
#pragma unroll
  for (int r = 0; r < 16; ++r) rli[r] = __builtin_amdgcn_rcpf(li_l[crow(r, hi)]);
  bf16* Ow = Ob + (long)(wid * QBLK) * LDO;
#pragma unroll
  for (int r = 0; r < 16; ++r) { int orow = crow(r, hi);
    for (int d0 = 0; d0 < 4; ++d0) Ow[(long)orow * LDO + d0 * 32 + r32] = __float2bfloat16(o[d0][r] * rli[r]); }
#undef SLOAD
#undef SWRITE
#undef SWAIT
#undef RESC
}
#undef KSWZ
#undef SBAR
}
namespace fk {
using pg8::bf16_t; using pg8::f32x4; using pg8::u32x4; using pg8::Unit; using pg8::cvt_pk_bf16;
typedef unsigned u32x2 __attribute__((ext_vector_type(2)));
typedef float f32x16 __attribute__((ext_vector_type(16)));
constexpr int M = 24576, MP = 8192, D = 2048, INW = 17408, DFF = 8192, DEPTH = 4, NWAVES = 8, NCOND = 9;
constexpr int OFF_Q = 0, OFF_K = 2048, OFF_V = 2560, OFF_LX = 3072, OFF_LG = 5120, OFF_CU = 7168, OFF_CV = 9216, OFF_G = 11264;
constexpr int NKVROWS = 26624;
constexpr float EPS = 1e-6f;
constexpr int NPHASE = 3 + 9 * DEPTH;
constexpr int NMODK = 32;
constexpr size_t MiB = 1u << 20;
constexpr size_t WS_CTL = 0, CTL_ZERO_BYTES = 1 * MiB;
constexpr size_t WS_MODP = 716 * MiB  , WS_MOD = 28 * MiB, WS_ROPE = 30 * MiB, WS_CVSTAT = 31 * MiB, WS_FSTAT = 34 * MiB, WS_AGG = 37 * MiB, WS_WLRU = 49 * MiB, WS_CMW = 51 * MiB;
constexpr size_t WS_WIN = 52 * MiB, WS_WBR = 120 * MiB, WS_WOUT = 144 * MiB, WS_WFF1 = 152 * MiB, WS_WFF2 = 184 * MiB;
constexpr size_t WS_H = 216 * MiB, WS_KALL = 312 * MiB, WS_VALL = 338 * MiB, WS_BR = 364 * MiB, WS_MSCR = 652 * MiB, WS_Z = 716 * MiB, WS_END = 1532 * MiB;
constexpr size_t WS_FFH = WS_Z, WS_F = WS_Z + 384 * MiB;
constexpr int CW_BAR = 4096;
constexpr int RING_BYTES = 131072;
constexpr int LRU_XC = 0, LRU_XC_PITCH = 272, LRU_A0 = 17408, LRU_B0 = LRU_A0 + 32768, LRU_A1 = LRU_B0 + 32768, LRU_B1 = LRU_A1 + 32768, LRU_CARRY = LRU_B1 + 32768;
constexpr int CM_VT = 0, CM_VT_PITCH = 272, CM_RS = 128 * 272;
constexpr int MISC_OFF = 150528, LDS_BYTES = 151552;
static_assert(LRU_CARRY + 2048 <= MISC_OFF, "lds map");

struct Params { const float* in[32]; float* out; unsigned char* ws; int ph_lo, ph_hi, li, pad; };

typedef const __attribute__((address_space(4))) void* kaptr_t;
struct Frame {
    LAS unsigned char* lds;
    int tid, lane, wave, vcu, G, gw, NGW, bx;
    float* out; unsigned char* ws; kaptr_t ka;
    __device__ __forceinline__ float* x() const { return out; }
    __device__ __forceinline__ float* new_k() const { return out + 50331648L; }
    __device__ __forceinline__ float* new_v() const { return out + 50331648L + 16777216L; }
    __device__ __forceinline__ float* new_s() const { return out + 50331648L + 2 * 16777216L; }
#define FK_WSP(name, type, off) __device__ __forceinline__ type* name() const { return (type*)(ws + (off)); }
    FK_WSP(MODP, float, WS_MODP) FK_WSP(MOD, float, WS_MOD) FK_WSP(ROPE, float, WS_ROPE) FK_WSP(CVSTAT, float, WS_CVSTAT) FK_WSP(FSTAT, float, WS_FSTAT) FK_WSP(AGG, float, WS_AGG) FK_WSP(MSCR, float, WS_MSCR)
    FK_WSP(WLRU, bf16_t, WS_WLRU) FK_WSP(CMW, bf16_t, WS_CMW) FK_WSP(WIN, bf16_t, WS_WIN) FK_WSP(WBR, bf16_t, WS_WBR) FK_WSP(WOUT, bf16_t, WS_WOUT) FK_WSP(WFF1, bf16_t, WS_WFF1) FK_WSP(WFF2, bf16_t, WS_WFF2)
    FK_WSP(H, bf16_t, WS_H) FK_WSP(KALL, bf16_t, WS_KALL) FK_WSP(VALL, bf16_t, WS_VALL) FK_WSP(BR, bf16_t, WS_BR) FK_WSP(Z, bf16_t, WS_Z) FK_WSP(FFH, bf16_t, WS_FFH) FK_WSP(Fb, bf16_t, WS_F)
#undef FK_WSP
};
enum { I_XP = 0, I_XS, I_CK, I_CV, I_SL, I_C, I_CCTX, I_WMOD, I_BMOD, I_GPM, I_GPOM, I_GPF, I_GPOF, I_WIN, I_GQ, I_GK, I_WAO, I_CW, I_CB, I_LWA, I_LBA, I_LWX, I_LBX, I_LAM, I_WLO, I_CMG, I_CMWS, I_CMBS, I_WCO, I_WOUT, I_WFF1, I_WFF2 };
template <int I> __device__ __forceinline__ const float* inp(const Frame& F) { const GAS float* r; asm volatile("s_load_dwordx2 %0, %1, %2\n\ts_waitcnt lgkmcnt(0)" : "=s"(r) : "s"(F.ka), "i"(I * 8) : "memory"); return (const float*)r; }


__device__ __forceinline__ Frame phase_frame(const Frame& F) {
    Frame P = F; int t = F.tid; int bx = blockIdx.x; int g = F.G; GAS unsigned char* w = (GAS unsigned char*)F.ws; GAS float* o = (GAS float*)F.out;
    asm volatile("" : "+v"(t)); asm volatile("" : "+s"(bx), "+s"(g), "+s"(w), "+s"(o));
    P.tid = t; P.lane = t & 63; P.wave = __builtin_amdgcn_readfirstlane(t >> 6); P.ws = (unsigned char*)w; P.out = (float*)o; P.bx = bx; P.G = g; P.NGW = g * NWAVES;
    P.vcu = (g % 8 == 0) ? (bx % 8) * (g / 8) + bx / 8 : bx; P.gw = P.vcu * NWAVES + P.wave;
    return P;
}
__device__ __forceinline__ float wave_sum(float v) {
#pragma unroll
    for (int o = 1; o < 64; o <<= 1) v += __shfl_xor(v, o);
    return v;
}
__device__ __forceinline__ float bf2f(unsigned short h) { return __uint_as_float((unsigned)h << 16); }
__device__ __forceinline__ float bflo(unsigned w) { return __uint_as_float(w << 16); }
__device__ __forceinline__ float bfhi(unsigned w) { return __uint_as_float(w & 0xffff0000u); }
__device__ __forceinline__ float fsigm(float x) { return __builtin_amdgcn_rcpf(1.f + __builtin_amdgcn_exp2f(-1.4426950408889634f * x)); }
__device__ __forceinline__ float fgelu(float x) { const float u = x * (1.5957691216057308f + 0.0713548162726009f * x * x); return x * fsigm(u); }

__device__ __forceinline__ void transpose_item(const float* __restrict__ W, int K, int N, bf16_t* __restrict__ WT, int row_off, LAS unsigned char* scr, int item, int lane) {
    const int nblk = N / 64, kb = item / nblk, nb = item % nblk, k0 = 64 * kb, n0 = 64 * nb;
    const int n4 = (lane & 15) * 4, kp = lane >> 4;
    const float* src = W + (size_t)(k0 + 2 * kp) * N + n0 + n4;
    f32x4 v[8][2];
#pragma unroll
    for (int i = 0; i < 8; ++i) { v[i][0] = __builtin_nontemporal_load((const f32x4*)(src + (size_t)(8 * i) * N)); v[i][1] = __builtin_nontemporal_load((const f32x4*)(src + (size_t)(8 * i + 1) * N)); }
#pragma unroll
    for (int i = 0; i < 8; ++i) { const int k = 8 * i + 2 * kp;
#pragma unroll
        for (int j = 0; j < 4; ++j) *(LAS unsigned*)(scr + (n4 + j) * 144 + k * 2) = cvt_pk_bf16(v[i][0][j], v[i][1][j]); }
    LDS_WAIT(); asm volatile("" ::: "memory");
    const int ch = lane & 7;
#pragma unroll
    for (int j = 0; j < 8; ++j) { const int n = (lane >> 3) + 8 * j;
        const v4u o = *(const LAS v4u*)(scr + n * 144 + ch * 16);
        *(GAS v4u*)(WT + (size_t)(row_off + n0 + n) * K + k0 + 8 * ch) = o; }
    LDS_WAIT(); asm volatile("" ::: "memory");
}
__device__ __forceinline__ void convert_layer(const Frame& F, int l) {
    LAS unsigned char* scr = F.lds + F.wave * 16384;
    constexpr int I_IN = 32 * 272, I_SQ = 32 * 32, I_F1 = 32 * 128, I_F2 = 128 * 32, I_LRU = 64 * 4;
    constexpr int NITEMS = I_IN + 4 * I_SQ + I_F1 + I_F2 + I_LRU;
    const float* w_in = inp<I_WIN>(F) + (size_t)l * D * INW; const float* w_ao = inp<I_WAO>(F) + (size_t)l * D * D; const float* w_lo = inp<I_WLO>(F) + (size_t)l * D * D;
    const float* w_co = inp<I_WCO>(F) + (size_t)l * D * D; const float* w_out = inp<I_WOUT>(F) + (size_t)l * D * D; const float* w_f1 = inp<I_WFF1>(F) + (size_t)l * D * DFF;
    const float* w_f2 = inp<I_WFF2>(F) + (size_t)l * DFF * D; const float* lwa = inp<I_LWA>(F) + (size_t)l * 2 * 16 * 16384; const float* lwx = inp<I_LWX>(F) + (size_t)l * 2 * 16 * 16384;
    for (int it = F.gw; it < NITEMS; it += F.NGW) {
        int r = it;
        if (r < I_IN) { transpose_item(w_in, D, INW, F.WIN(), 0, scr, r, F.lane); continue; } r -= I_IN;
        if (r < I_SQ) { transpose_item(w_ao, D, D, F.WBR(), 0, scr, r, F.lane); continue; } r -= I_SQ;
        if (r < I_SQ) { transpose_item(w_lo, D, D, F.WBR(), D, scr, r, F.lane); continue; } r -= I_SQ;
        if (r < I_SQ) { transpose_item(w_co, D, D, F.WBR(), 2 * D, scr, r, F.lane); continue; } r -= I_SQ;
        if (r < I_SQ) { transpose_item(w_out, D, D, F.WOUT(), 0, scr, r, F.lane); continue; } r -= I_SQ;
        if (r < I_F1) { transpose_item(w_f1, D, DFF, F.WFF1(), 0, scr, r, F.lane); continue; } r -= I_F1;
        if (r < I_F2) { transpose_item(w_f2, DFF, D, F.WFF2(), 0, scr, r, F.lane); continue; } r -= I_F2;
        { const int bi = r >> 2, sub = r & 3, d = bi >> 5, mat = (bi >> 4) & 1, blk = bi & 15;
          const float* src = (mat ? lwx : lwa) + ((size_t)d * 16 + blk) * 16384;
          transpose_item(src, 128, 128, F.WLRU() + (size_t)bi * 16384, 0, scr, sub, F.lane); }
    }
    const float* cw = inp<I_CMWS>(F) + (size_t)l * 16 * 16384;
    for (int i = (F.gw * 64 + F.lane) * 8; i < 16 * 16384; i += F.NGW * 64 * 8) {
        const f32x4 a = *(const f32x4*)(cw + i), b = *(const f32x4*)(cw + i + 4);
        v4u o; o.x = pk2(a.x, a.y); o.y = pk2(a.z, a.w); o.z = pk2(b.x, b.y); o.w = pk2(b.z, b.w);
        *(v4u*)(F.CMW() + i) = o;
    }
}
__device__ __forceinline__ void mod_partials(const Frame& F) {
    LAS float* scr = (LAS float*)(F.lds + F.wave * 16384);
    const float* cctx = inp<I_CCTX>(F); const float* cc = inp<I_C>(F); const float* wmod = inp<I_WMOD>(F);
    for (int it = F.gw; it < DEPTH * 48 * NMODK; it += F.NGW) {
        const int kc = it % NMODK, jb = (it / NMODK) % 48, l = it / (NMODK * 48), k0 = kc * 64;
        for (int e = F.lane; e < NCOND * 64; e += 64) { const int ci = e >> 6, kk = e & 63; const float v = ci == 0 ? cctx[k0 + kk] : cc[(ci - 1) * D + k0 + kk]; scr[e] = v * (1.f / (1.f + __expf(-v))); }
        LDS_WAIT(); asm volatile("" ::: "memory");
        f32x4 acc[NCOND];
#pragma unroll
        for (int ci = 0; ci < NCOND; ++ci) acc[ci] = (f32x4){0.f, 0.f, 0.f, 0.f};
        const float* wp = wmod + ((size_t)l * D + k0) * 12288 + jb * 256 + F.lane * 4;
#pragma unroll
        for (int kb = 0; kb < 64; kb += 16) {
            f32x4 w[16];
#pragma unroll
            for (int kk = 0; kk < 16; ++kk) w[kk] = *(const f32x4*)(wp + (size_t)(kb + kk) * 12288);
#pragma unroll
            for (int kk = 0; kk < 16; ++kk)
#pragma unroll
                for (int ci = 0; ci < NCOND; ++ci) acc[ci] += w[kk] * scr[ci * 64 + kb + kk];
        }
#pragma unroll
        for (int ci = 0; ci < NCOND; ++ci) *(f32x4*)(F.MODP() + (((size_t)kc * DEPTH + l) * NCOND + ci) * 12288 + jb * 256 + F.lane * 4) = acc[ci];
        LDS_WAIT(); asm volatile("" ::: "memory");
    }
}
__device__ __forceinline__ void mod_reduce(const Frame& F) {
    constexpr int NEL = DEPTH * NCOND * 12288;
    for (int i = (F.gw * 64 + F.lane) * 4; i < NEL; i += F.NGW * 64 * 4) {
        const int l = i / (NCOND * 12288), j = i % 12288;
        f32x4 s = *(const f32x4*)(inp<I_BMOD>(F) + (size_t)l * 12288 + j);
#pragma unroll
        for (int kc = 0; kc < NMODK; ++kc) s += *(const f32x4*)(F.MODP() + (size_t)kc * NEL + i);
        *(f32x4*)(F.MOD() + i) = s;
    }
}
__device__ __forceinline__ void rope_table(const Frame& F) {
    if (F.bx == 0) for (int e = F.tid; e < 2048; e += NWAVES * 64) {
        const int pos = e >> 5, f = e & 31; const float inv = exp2f(-(float)f * (13.287712379549449f / 32.f)); float s, c; sincosf((float)pos * inv, &s, &c);
        F.ROPE()[e] = c; F.ROPE()[2048 + e] = s; }
}
struct RowIn { f32x4 x[4][2]; u32x4 f[4]; float st; };
template <bool HAS_F>
__device__ __forceinline__ void row_load(const Frame& F, RowIn& R, const float* xsrc, const bf16_t* frow, const float* fstat) {
#pragma unroll
    for (int j = 0; j < 4; ++j) { const int e = (j * 64 + F.lane) * 8; R.x[j][0] = __builtin_nontemporal_load((const f32x4*)(xsrc + e)); R.x[j][1] = __builtin_nontemporal_load((const f32x4*)(xsrc + e + 4)); }
    if (HAS_F) {
#pragma unroll
        for (int j = 0; j < 4; ++j) R.f[j] = __builtin_nontemporal_load((const u32x4*)(frow + (j * 64 + F.lane) * 8));
        R.st = F.lane < 32 ? fstat[F.lane] : 0.f;
    }
}
template <bool HAS_F, bool HAS_H>
__device__ __forceinline__ void row_apply(const Frame& F, RowIn& R, float* xdst, const float* gate, const float* gpost, const float* gpre, const float* sc, const float* sh, bf16_t* hrow, float gs) {
    if (HAS_F) {
        const float rs = rsqrtf(wave_sum(R.st) * (1.f / D) + EPS) * gs;
#pragma unroll
        for (int j = 0; j < 4; ++j) { const int e = (j * 64 + F.lane) * 8; const u32x4 fw = R.f[j];
            const f32x4 g0 = *(const f32x4*)(gate + e), g1 = *(const f32x4*)(gate + e + 4), p0 = *(const f32x4*)(gpost + e), p1 = *(const f32x4*)(gpost + e + 4);
            const f32x4 f0 = {bflo(fw.x), bfhi(fw.x), bflo(fw.y), bfhi(fw.y)}, f1 = {bflo(fw.z), bfhi(fw.z), bflo(fw.w), bfhi(fw.w)};
            R.x[j][0] += g0 * (f0 * rs * p0); R.x[j][1] += g1 * (f1 * rs * p1); }
    }
#pragma unroll
    for (int j = 0; j < 4; ++j) { const int e = (j * 64 + F.lane) * 8; __builtin_nontemporal_store(R.x[j][0], (f32x4*)(xdst + e)); __builtin_nontemporal_store(R.x[j][1], (f32x4*)(xdst + e + 4)); }
    if (HAS_H) {
        float ss = 0.f;
#pragma unroll
        for (int j = 0; j < 4; ++j)
#pragma unroll
            for (int h = 0; h < 2; ++h) ss += (R.x[j][h].x * R.x[j][h].x + R.x[j][h].y * R.x[j][h].y) + (R.x[j][h].z * R.x[j][h].z + R.x[j][h].w * R.x[j][h].w);
        const float rs = rsqrtf(wave_sum(ss) * (1.f / D) + EPS);
#pragma unroll
        for (int j = 0; j < 4; ++j) { const int e = (j * 64 + F.lane) * 8;
            f32x4 o[2];
#pragma unroll
            for (int h = 0; h < 2; ++h) { const f32x4 g = *(const f32x4*)(gpre + e + 4 * h), s1 = *(const f32x4*)(sc + e + 4 * h), s0 = *(const f32x4*)(sh + e + 4 * h); o[h] = R.x[j][h] * rs * g * (s1 + 1.f) + s0; }
            u32x4 w; w.x = cvt_pk_bf16(o[0].x, o[0].y); w.y = cvt_pk_bf16(o[0].z, o[0].w); w.z = cvt_pk_bf16(o[1].x, o[1].y); w.w = cvt_pk_bf16(o[1].z, o[1].w);
            *(u32x4*)(hrow + e) = w; }
    }
}
__device__ __forceinline__ int cond_of_row(int m) { return m < MP ? 0 : 1 + ((m - MP) >> 11); }
template <int MODE>
__device__ __forceinline__ void rowlocal_phase(const Frame& F, int l, float gs = 1.f) {
    const float* xp = inp<I_XP>(F); const float* xs = inp<I_XS>(F);
    const float* gpost = MODE == 1 ? inp<I_GPOM>(F) + (size_t)l * D : inp<I_GPOF>(F) + (size_t)l * D;
    const float* gpre = MODE == 0 ? inp<I_GPM>(F) : MODE == 1 ? inp<I_GPF>(F) + (size_t)l * D : inp<I_GPM>(F) + (size_t)(l + 1 < DEPTH ? l + 1 : l) * D;
    float* X = F.x(); const bf16_t* Fb = F.Fb(); const float* FS = F.FSTAT(); bf16_t* H = F.H(); const float* MODb = F.MOD();
    constexpr bool HAS_F = MODE != 0;
    RowIn A, B;
    auto src = [&](int m) -> const float* { return MODE == 0 ? (m < MP ? xp + (size_t)m * D : xs + (size_t)(m - MP) * D) : X + (size_t)m * D; };
    int m = F.gw;
    if (m < M) row_load<HAS_F>(F, A, src(m), Fb + (size_t)m * D, FS + (size_t)m * 32);
    for (; m < M; m += 2 * F.NGW) {
#pragma unroll
        for (int half = 0; half < 2; ++half) {
            const int mc = m + half * F.NGW, mn = mc + F.NGW;
            if (mc >= M) break;
            RowIn& cur = half ? B : A; RowIn& nxt = half ? A : B;
            if (mn < M) row_load<HAS_F>(F, nxt, src(mn), Fb + (size_t)mn * D, FS + (size_t)mn * 32);
            const int ci = cond_of_row(mc);
            const float* modl = MODb + ((size_t)l * NCOND + ci) * 12288;
            float* xrow = X + (size_t)mc * D; bf16_t* hrow = H + (size_t)mc * D;
            if (MODE == 0) row_apply<false, true>(F, cur, xrow, nullptr, nullptr, gpre, modl + 1 * D, modl + 0 * D, hrow, gs);
            else if (MODE == 1) row_apply<true, true>(F, cur, xrow, modl + 2 * D, gpost, gpre, modl + 4 * D, modl + 3 * D, hrow, gs);
            else if (l + 1 < DEPTH) { const float* modn = MODb + ((size_t)(l + 1) * NCOND + ci) * 12288; row_apply<true, true>(F, cur, xrow, modl + 5 * D, gpost, gpre, modn + 1 * D, modn + 0 * D, hrow, gs); }
            else row_apply<true, false>(F, cur, xrow, modl + 5 * D, gpost, nullptr, nullptr, nullptr, nullptr, gs);
        }
    }
}
__device__ __forceinline__ u32x4 pack8(const f32x4& a, const f32x4& b) { u32x4 w; w.x = cvt_pk_bf16(a[0], a[1]); w.y = cvt_pk_bf16(a[2], a[3]); w.z = cvt_pk_bf16(b[0], b[1]); w.w = cvt_pk_bf16(b[2], b[3]); return w; }
typedef float f32x2 __attribute__((ext_vector_type(2)));
__device__ __forceinline__ f32x2 sigm2(f32x2 x) { const f32x2 t = x * -1.4426950408889634f; const f32x2 e = (f32x2){__builtin_amdgcn_exp2f(t.x), __builtin_amdgcn_exp2f(t.y)} + 1.f; return (f32x2){__builtin_amdgcn_rcpf(e.x), __builtin_amdgcn_rcpf(e.y)}; }
__device__ __forceinline__ f32x2 gelu2(f32x2 x) { const f32x2 t = x * ((x * x) * -0.10294324f + -2.3022082f);
    const f32x2 e = (f32x2){__builtin_amdgcn_exp2f(t.x), __builtin_amdgcn_exp2f(t.y)} + 1.f; return x * (f32x2){__builtin_amdgcn_rcpf(e.x), __builtin_amdgcn_rcpf(e.y)}; }
__device__ __forceinline__ f32x4 gelu4(const f32x4& v) { const f32x2 a = gelu2((f32x2){v[0], v[1]}), b = gelu2((f32x2){v[2], v[3]}); return (f32x4){a.x, a.y, b.x, b.y}; }
__device__ __forceinline__ f32x4 sigm4(const f32x4& v) { const f32x2 a = sigm2((f32x2){v[0], v[1]}), b = sigm2((f32x2){v[2], v[3]}); return (f32x4){a.x, a.y, b.x, b.y}; }
__device__ __forceinline__ int kv_row(int m) { return m < MP ? m : MP + ((m - MP) >> 11) * 2304 + ((m - MP) & 2047); }
struct EpiIn {
    static constexpr bool PERM = true, AFTER_DRAIN = false;
    bf16_t* Z; bf16_t* VALL; float* new_v; float* cvstat; int layer;
    __device__ __forceinline__ void operator()(const f32x4 (&acc)[2][2][4][2], const Unit& u, int wr, int wc, int fr, int fq) const {
        const int pn = u.pn, row0 = u.pm * 256 + wr * 64 + fr, cl = wc * 32 + 8 * fq;
        if (pn >= 10 && pn < 12) {
            const int colv = (pn - 10) * 256 + cl;
#pragma unroll
            for (int ai = 0; ai < 2; ++ai)
#pragma unroll
                for (int m = 0; m < 4; ++m) { const int row = row0 + ai * 128 + m * 16; bf16_t* dst = VALL + (size_t)kv_row(row) * 512 + colv;
#pragma unroll
                    for (int bj = 0; bj < 2; ++bj) { *(u32x4*)(dst + bj * 128) = pack8(acc[ai][bj][m][0], acc[ai][bj][m][1]);
                        if (row < MP) { float* nv = new_v + ((size_t)((row >> 8) * DEPTH + layer) * 256 + (row & 255)) * 512 + colv + bj * 128; *(f32x4*)nv = acc[ai][bj][m][0]; *(f32x4*)(nv + 4) = acc[ai][bj][m][1]; } } }
            return;
        }
        const int mode = (pn < 20) ? 0 : (pn < 36) ? 1 : (pn < 44) ? 2 : 3;
        const int col0 = pn * 256 + cl;
#pragma unroll
        for (int ai = 0; ai < 2; ++ai)
#pragma unroll
            for (int m = 0; m < 4; ++m) { const int row = row0 + ai * 128 + m * 16; bf16_t* dst = Z + (size_t)row * INW + col0; float ss = 0.f;
#pragma unroll
                for (int bj = 0; bj < 2; ++bj) { f32x4 v0 = acc[ai][bj][m][0], v1 = acc[ai][bj][m][1];
                    if (mode == 1 || mode == 2) { v0 = gelu4(v0); v1 = gelu4(v1); }
                    if (mode == 3) { v0 = sigm4(v0); v1 = sigm4(v1); }
                    if (mode == 2) ss += (v0[0] * v0[0] + v0[1] * v0[1]) + (v0[2] * v0[2] + v0[3] * v0[3]) + (v1[0] * v1[0] + v1[1] * v1[1]) + (v1[2] * v1[2] + v1[3] * v1[3]);
                    *(u32x4*)(dst + bj * 128) = pack8(v0, v1); }
                if (mode == 2) { ss += __shfl_xor(ss, 16); ss += __shfl_xor(ss, 32); if (fq == 0) cvstat[(size_t)row * 32 + (pn - 36) * 4 + wc] = ss; } }
    }
};
struct EpiRelu2 {
    static constexpr bool PERM = true, AFTER_DRAIN = false;
    bf16_t* O; int ldc;
    __device__ __forceinline__ void operator()(const f32x4 (&acc)[2][2][4][2], const Unit& u, int wr, int wc, int fr, int fq) const {
        const int row0 = u.pm * 256 + wr * 64 + fr, col0 = u.pn * 256 + wc * 32 + 8 * fq;
#pragma unroll
        for (int ai = 0; ai < 2; ++ai)
#pragma unroll
            for (int m = 0; m < 4; ++m) { bf16_t* dst = O + (size_t)(row0 + ai * 128 + m * 16) * ldc + col0;
#pragma unroll
                for (int bj = 0; bj < 2; ++bj) { f32x4 v0 = __builtin_elementwise_max(acc[ai][bj][m][0], (f32x4){0.f, 0.f, 0.f, 0.f}), v1 = __builtin_elementwise_max(acc[ai][bj][m][1], (f32x4){0.f, 0.f, 0.f, 0.f});
                    *(u32x4*)(dst + bj * 128) = pack8(v0 * v0, v1 * v1); } }
    }
};
struct EpiF {
    static constexpr bool PERM = true, AFTER_DRAIN = false;
    bf16_t* O; float* stat;
    __device__ __forceinline__ void operator()(const f32x4 (&acc)[2][2][4][2], const Unit& u, int wr, int wc, int fr, int fq) const {
        const int row0 = u.pm * 256 + wr * 64 + fr, col0 = u.pn * 256 + wc * 32 + 8 * fq;
#pragma unroll
        for (int ai = 0; ai < 2; ++ai)
#pragma unroll
            for (int m = 0; m < 4; ++m) { const int row = row0 + ai * 128 + m * 16; bf16_t* dst = O + (size_t)row * D + col0; float ss = 0.f;
#pragma unroll
                for (int bj = 0; bj < 2; ++bj) { const f32x4 v0 = acc[ai][bj][m][0], v1 = acc[ai][bj][m][1];
                    ss += (v0[0] * v0[0] + v0[1] * v0[1]) + (v0[2] * v0[2] + v0[3] * v0[3]) + (v1[0] * v1[0] + v1[1] * v1[1]) + (v1[2] * v1[2] + v1[3] * v1[3]);
                    *(u32x4*)(dst + bj * 128) = pack8(v0, v1); }
                ss += __shfl_xor(ss, 16); ss += __shfl_xor(ss, 32); if (fq == 0) stat[(size_t)row * 32 + u.pn * 4 + wc] = ss; }
    }
};
struct EpiMerge {
    static constexpr bool PERM = true, AFTER_DRAIN = false;
    const bf16_t* Z; float* scr  ; bf16_t* O;
    __device__ __forceinline__ void operator()(const f32x4 (&acc)[2][2][4][2], const Unit& u, int wr, int wc, int fr, int fq) const {
        const int br = u.pn >> 3, pn = u.pn & 7, pm = u.pm - 96 * br;
        const int rl0 = wr * 64 + fr, cl = wc * 32 + 8 * fq;
#pragma unroll
        for (int ai = 0; ai < 2; ++ai)
#pragma unroll
            for (int m = 0; m < 4; ++m) { const int rl = rl0 + ai * 128 + m * 16, row = pm * 256 + rl;
#pragma unroll
                for (int bj = 0; bj < 2; ++bj) { const int c = cl + bj * 128;
                    const u32x4 gw = *(const u32x4*)(Z + (size_t)row * INW + OFF_G + br * D + pn * 256 + c);
                    const f32x4 g0 = {bflo(gw.x), bfhi(gw.x), bflo(gw.y), bfhi(gw.y)}, g1 = {bflo(gw.z), bfhi(gw.z), bflo(gw.w), bfhi(gw.w)};
                    f32x4 v0 = g0 * acc[ai][bj][m][0], v1 = g1 * acc[ai][bj][m][1];
                    float* sp = scr + rl * 256 + c;
                    if (br > 0) { v0 += *(const f32x4*)sp; v1 += *(const f32x4*)(sp + 4); }
                    if (br < 2) { *(f32x4*)sp = v0; *(f32x4*)(sp + 4) = v1; }
                    else *(u32x4*)(O + (size_t)row * D + pn * 256 + c) = pack8(v0, v1); } }
    }
};
struct MergeOrder {
    pg8::StaticOrder so;
    __device__ void init(int G, int c) { so.init(M, D, G, c); }
    __device__ bool next(int i, Unit& u) const { const int br = i % 3; if (!so.next(i / 3, u)) return false; u.pm += 96 * br; u.pn += 8 * br; return true; }
    __device__ __forceinline__ void a_ready(const Unit&) const {}
    __device__ __forceinline__ void done(const Unit&) const {}
};
}
namespace fk {
typedef short bf16x8 __attribute__((ext_vector_type(8)));
__device__ __forceinline__ void prep_row(const Frame& F, int m, int l) {
    const bool sample = m >= MP; int b, t;
    if (!sample) { b = m >> 8; t = m & 255; } else { b = (m - MP) >> 11; t = (m - MP) & 2047; }
    const int kvrow = sample ? MP + b * 2304 + t : m;
    const int lane = F.lane, g8 = lane >> 3, j = lane & 7, axis = g8 & 1, hsel = lane >> 4;
    bf16_t* zrow = F.Z() + (size_t)m * INW;
    const int dA = axis * 64 + 4 * j, dB = dA + 32;
    const f32x4 gqa = *(const f32x4*)(inp<I_GQ>(F) + l * 128 + dA), gqb = *(const f32x4*)(inp<I_GQ>(F) + l * 128 + dB);
    const f32x4 gka = *(const f32x4*)(inp<I_GK>(F) + l * 128 + dA), gkb = *(const f32x4*)(inp<I_GK>(F) + l * 128 + dB);
    f32x4 cs = {1.f, 1.f, 1.f, 1.f}, sn = {0.f, 0.f, 0.f, 0.f};
    if (sample) { const int pos = axis == 0 ? (t >> 6) : (t & 63); cs = *(const f32x4*)(F.ROPE() + pos * 32 + 4 * j); sn = *(const f32x4*)(F.ROPE() + 2048 + pos * 32 + 4 * j); }
#pragma unroll
    for (int pass = 0; pass < 5; ++pass) {
        const bool isq = pass < 4;
        const int base = isq ? OFF_Q + (pass * 4 + hsel) * 128 + dA : OFF_K + hsel * 128 + dA;
        const u32x2 wa = *(const u32x2*)(zrow + base), wb = *(const u32x2*)(zrow + base + 32);
        const f32x4 xa = {bflo(wa.x), bfhi(wa.x), bflo(wa.y), bfhi(wa.y)}, xb = {bflo(wb.x), bfhi(wb.x), bflo(wb.y), bfhi(wb.y)};
        float ss = (xa.x * xa.x + xa.y * xa.y) + (xa.z * xa.z + xa.w * xa.w) + (xb.x * xb.x + xb.y * xb.y) + (xb.z * xb.z + xb.w * xb.w);
        ss += __shfl_xor(ss, 1); ss += __shfl_xor(ss, 2); ss += __shfl_xor(ss, 4); ss += __shfl_xor(ss, 8);
        const float rs = rsqrtf(ss * (1.f / 128.f) + EPS);
        const f32x4 na = xa * rs * (isq ? gqa : gka), nb = xb * rs * (isq ? gqb : gkb);
        const f32x4 ra = na * cs - nb * sn, rb = na * sn + nb * cs;
        u32x2 oa, ob; oa.x = cvt_pk_bf16(ra.x, ra.y); oa.y = cvt_pk_bf16(ra.z, ra.w); ob.x = cvt_pk_bf16(rb.x, rb.y); ob.y = cvt_pk_bf16(rb.z, rb.w);
        if (isq) { *(u32x2*)(zrow + base) = oa; *(u32x2*)(zrow + base + 32) = ob; }
        else {
            bf16_t* kd = F.KALL() + (size_t)kvrow * 512 + hsel * 128 + dA; *(u32x2*)kd = oa; *(u32x2*)(kd + 32) = ob;
            if (!sample) { float* nk = F.new_k() + ((size_t)(b * DEPTH + l) * 256 + t) * 512 + hsel * 128 + dA; *(f32x4*)nk = na; *(f32x4*)(nk + 32) = nb; }
        }
    }
}
__device__ __forceinline__ void prep_phase(const Frame& F, int l) {
    for (int m = F.gw; m < M; m += F.NGW) prep_row(F, m, l);
    for (int it = F.gw; it < 2 * 8 * 256; it += F.NGW) {
        const int which = it >> 11, b = (it >> 8) & 7, p = it & 255;
        const float* src = (which ? inp<I_CV>(F) : inp<I_CK>(F)) + ((size_t)(b * DEPTH + l) * 256 + p) * 512 + F.lane * 8;
        bf16_t* dst = (which ? F.VALL() : F.KALL()) + (size_t)(MP + b * 2304 + 2048 + p) * 512 + F.lane * 8;
        const f32x4 a = *(const f32x4*)src, c = *(const f32x4*)(src + 4);
        *(u32x4*)dst = pack8(a, c);
    }
}
__device__ __forceinline__ int crow(int r, int hi) { return (r & 3) + 8 * (r >> 2) + 4 * hi; }
struct LruCtx {
    bf16x8 bw0[8], bw1[8];
    float bav, bxv, c8;
    bool small;
};
__device__ __forceinline__ void lru_ctx_load(const Frame& F, int l, int blk, LruCtx& X) {
    const int lane = F.lane, wave = F.wave, d = wave >> 2, n0 = (wave & 3) * 32, nl = lane & 31, hi = lane >> 5, C = blk * 128 + n0 + nl;
    const bf16_t* wb0 = F.WLRU() + ((size_t)((d * 2 + 0) * 16 + blk) * 128 + n0 + nl) * 128 + hi * 8;
    const bf16_t* wb1 = F.WLRU() + ((size_t)((d * 2 + 1) * 16 + blk) * 128 + n0 + nl) * 128 + hi * 8;
#pragma unroll
    for (int ks = 0; ks < 8; ++ks) { X.bw0[ks] = *(const bf16x8*)(wb0 + ks * 16); X.bw1[ks] = *(const bf16x8*)(wb1 + ks * 16); }
    X.bav = inp<I_LBA>(F)[(size_t)(l * 2 + d) * D + C]; X.bxv = inp<I_LBX>(F)[(size_t)(l * 2 + d) * D + C];
    const float lam = inp<I_LAM>(F)[(size_t)(l * 2 + d) * D + C];
    X.c8 = -8.f * log1pf(__expf(-lam));
    X.small = __all(X.c8 > -0.5f);
}
struct LruGeo { int m0, b, t0, T; bool sample; };
__device__ __forceinline__ LruGeo lru_geo(int ck) { LruGeo g; g.m0 = ck * 64; g.sample = g.m0 >= MP;
    if (!g.sample) { g.b = g.m0 >> 8; g.t0 = g.m0 & 255; g.T = 256; } else { g.b = (g.m0 - MP) >> 11; g.t0 = (g.m0 - MP) & 2047; g.T = 2048; } return g; }
template <int PASS>
__device__ __forceinline__ void lru_conv(const Frame& F, int t2  , int par  , int ck, int blk, const float* __restrict__ state_l, const float* __restrict__ AGG, const float* __restrict__ cwl, const float* __restrict__ cbl) {
    const LruGeo G = lru_geo(ck); const int C0 = blk * 128; LAS unsigned char* lds = F.lds; const bf16_t* Zb = F.Z();
    const int c4 = (t2 & 31) * 4, r0 = (t2 >> 5) * 8;
    f32x4 cw[4];
#pragma unroll
    for (int j = 0; j < 4; ++j) cw[j] = *(const f32x4*)(cwl + (size_t)j * D + C0 + c4);
    const f32x4 cb = *(const f32x4*)(cbl + C0 + c4);
    f32x4 zr[11];
#pragma unroll
    for (int i = 0; i < 11; ++i) {
        const int tt = G.t0 + r0 + i - 2;
        if (tt >= 0 && tt < G.T) { const u32x2 z = *(const u32x2*)(Zb + (size_t)(G.m0 + r0 + i - 2) * INW + OFF_LX + C0 + c4); zr[i] = (f32x4){bflo(z.x), bfhi(z.x), bflo(z.y), bfhi(z.y)}; }
        else zr[i] = (f32x4){0.f, 0.f, 0.f, 0.f};
    }
    if (PASS == 2) {
        const int d = t2 >> 7, C = C0 + (t2 & 127), jc = G.t0 >> 6, nch = G.T >> 6;
        float carry = G.sample ? state_l[((size_t)G.b * DEPTH * 2 + d) * D + C] : 0.f;
        const float* ag = AGG + ((size_t)((ck - jc) * 2 + d) * D + C) * 2;
        if (nch == 4) {
            float2 pe[4];
#pragma unroll
            for (int jj = 0; jj < 4; ++jj) pe[jj] = *(const float2*)(ag + (size_t)jj * 4 * D);
            if (d == 0) {
#pragma unroll
                for (int jj = 0; jj < 4; ++jj) if (jj < jc) carry = pe[jj].x * carry + pe[jj].y; }
            else {
#pragma unroll
                for (int jj = 3; jj >= 0; --jj) if (jj > jc) carry = pe[jj].x * carry + pe[jj].y; }
        } else {
            float2 pe[32];
#pragma unroll
            for (int jj = 0; jj < 32; ++jj) pe[jj] = *(const float2*)(ag + (size_t)jj * 4 * D);
            if (d == 0) {
#pragma unroll
                for (int jj = 0; jj < 32; ++jj) if (jj < jc) carry = pe[jj].x * carry + pe[jj].y; }
            else {
#pragma unroll
                for (int jj = 31; jj >= 0; --jj) if (jj > jc) carry = pe[jj].x * carry + pe[jj].y; }
        }
        *(LAS float*)(lds + LRU_CARRY + par * 1024 + t2 * 4) = carry;
    }
#pragma unroll
    for (int r = 0; r < 8; ++r) {
        const f32x4 y = cb + zr[r] * cw[0] + zr[r + 1] * cw[1] + zr[r + 2] * cw[2] + zr[r + 3] * cw[3];
        u32x2 o; o.x = cvt_pk_bf16(y.x, y.y); o.y = cvt_pk_bf16(y.z, y.w);
        *(LAS u32x2*)(lds + LRU_XC + (r0 + r) * LRU_XC_PITCH + c4 * 2) = o;
    }
}
__device__ __forceinline__ void lru_gates(const Frame& F, int lane, int wave, const LruCtx& X) {
    LAS unsigned char* lds = F.lds;
    const int d = wave >> 2, n0 = (wave & 3) * 32, nl = lane & 31, hi = lane >> 5;
    f32x16 acc[2][2];
#pragma unroll
    for (int mat = 0; mat < 2; ++mat)
#pragma unroll
        for (int mt = 0; mt < 2; ++mt)
#pragma unroll
            for (int r = 0; r < 16; ++r) acc[mat][mt][r] = 0.f;
    const LAS unsigned char* ap = lds + LRU_XC + nl * LRU_XC_PITCH + hi * 16;
#pragma unroll
    for (int ks = 0; ks < 8; ++ks) {
        const bf16x8 a0 = *(const LAS bf16x8*)(ap + ks * 32), a1 = *(const LAS bf16x8*)(ap + 32 * LRU_XC_PITCH + ks * 32);
        acc[0][0] = __builtin_amdgcn_mfma_f32_32x32x16_bf16(a0, X.bw0[ks], acc[0][0], 0, 0, 0);
        acc[0][1] = __builtin_amdgcn_mfma_f32_32x32x16_bf16(a1, X.bw0[ks], acc[0][1], 0, 0, 0);
        acc[1][0] = __builtin_amdgcn_mfma_f32_32x32x16_bf16(a0, X.bw1[ks], acc[1][0], 0, 0, 0);
        acc[1][1] = __builtin_amdgcn_mfma_f32_32x32x16_bf16(a1, X.bw1[ks], acc[1][1], 0, 0, 0);
    }
    const int c = n0 + nl;
    LAS float* Ad = (LAS float*)(lds + (d ? LRU_A1 : LRU_A0)); LAS float* Bd = (LAS float*)(lds + (d ? LRU_B1 : LRU_B0));
    const float bav = X.bav, bxv = X.bxv, c8 = X.c8;
    if (X.small) {
        typedef float f32x2 __attribute__((ext_vector_type(2)));
#pragma unroll
        for (int mt = 0; mt < 2; ++mt)
#pragma unroll
            for (int r = 0; r < 16; r += 2) {
                const int tl = mt * 32 + crow(r, hi);
                const f32x2 pa = (f32x2){acc[0][mt][r], acc[0][mt][r + 1]} + bav, px = (f32x2){acc[1][mt][r], acc[1][mt][r + 1]} + bxv;
                const f32x2 ta = pa * -1.4426950408889634f, tx = px * -1.4426950408889634f;
                const f32x2 ea = (f32x2){__builtin_amdgcn_exp2f(ta.x), __builtin_amdgcn_exp2f(ta.y)} + 1.f, ex = (f32x2){__builtin_amdgcn_exp2f(tx.x), __builtin_amdgcn_exp2f(tx.y)} + 1.f;
                const f32x2 rg = {__builtin_amdgcn_rcpf(ea.x), __builtin_amdgcn_rcpf(ea.y)}, ig = {__builtin_amdgcn_rcpf(ex.x), __builtin_amdgcn_rcpf(ex.y)};
                const f32x2 la = rg * c8;
                f32x2 p = la * (1.f / 720.f) + (1.f / 120.f); p = p * la + (1.f / 24.f); p = p * la + (1.f / 6.f); p = p * la + 0.5f; p = p * la + 1.f;
                const f32x2 e1 = la * p;
                const f32x2 omr = (e1 + 2.f) * e1;
                const f32x2 sq = {__builtin_amdgcn_sqrtf(fmaxf(-omr.x, 0.f)), __builtin_amdgcn_sqrtf(fmaxf(-omr.y, 0.f))};
                const f32x2 xcv = {bf2f(*(const LAS unsigned short*)(lds + LRU_XC + tl * LRU_XC_PITCH + c * 2)), bf2f(*(const LAS unsigned short*)(lds + LRU_XC + (tl + 1) * LRU_XC_PITCH + c * 2))};
                const f32x2 av = e1 + 1.f, bt = sq * ig * xcv;
                Ad[tl * 128 + c] = av.x; Ad[(tl + 1) * 128 + c] = av.y; Bd[tl * 128 + c] = bt.x; Bd[(tl + 1) * 128 + c] = bt.y;
            }
    } else {
#pragma unroll
        for (int mt = 0; mt < 2; ++mt)
#pragma unroll
            for (int r = 0; r < 16; ++r) {
                const int tl = mt * 32 + crow(r, hi);
                const float rg = fsigm(acc[0][mt][r] + bav), ig = fsigm(acc[1][mt][r] + bxv);
                const float la = c8 * rg, a = __expf(la);
                const float mult = sqrtf(fmaxf(-expm1f(2.f * la), 0.f));
                const float xcv = bf2f(*(const LAS unsigned short*)(lds + LRU_XC + tl * LRU_XC_PITCH + c * 2));
                Ad[tl * 128 + c] = a; Bd[tl * 128 + c] = mult * ig * xcv;
            }
    }
}
template <int PASS>
__device__ __forceinline__ void lru_scan(const Frame& F, int tid, int par, int l, int ck, int blk, float* __restrict__ AGG) {
    LAS unsigned char* lds = F.lds; const LruGeo G = lru_geo(ck);
    const int d = tid >> 7, c = tid & 127, C = blk * 128 + c;
    const LAS float* Ad = (const LAS float*)(lds + (d ? LRU_A1 : LRU_A0)); LAS float* Bd = (LAS float*)(lds + (d ? LRU_B1 : LRU_B0));
    if (PASS == 1) {
        float h = 0.f, Pp = 1.f;
        if (d == 0) {
#pragma unroll 16
            for (int s = 0; s < 64; ++s) { const float a = Ad[s * 128 + c]; h = a * h + Bd[s * 128 + c]; Pp *= a; }
        } else {
#pragma unroll 16
            for (int s = 0; s < 64; ++s) { const float a = Ad[(63 - s) * 128 + c]; h = a * h + Bd[(63 - s) * 128 + c]; Pp *= a; }
        }
        *(float2*)(AGG + ((size_t)(ck * 2 + d) * D + C) * 2) = make_float2(Pp, h);
    } else {
        const int jc = G.t0 >> 6, nch = G.T >> 6;
        float h = *(const LAS float*)(lds + LRU_CARRY + par * 1024 + tid * 4);
        if (d == 0) {
#pragma unroll
            for (int s0 = 0; s0 < 64; s0 += 16) { float av[16], bv[16];
#pragma unroll
                for (int i = 0; i < 16; ++i) { av[i] = Ad[(s0 + i) * 128 + c]; bv[i] = Bd[(s0 + i) * 128 + c]; }
#pragma unroll
                for (int i = 0; i < 16; ++i) { h = av[i] * h + bv[i]; bv[i] = h; }
#pragma unroll
                for (int i = 0; i < 16; ++i) Bd[(s0 + i) * 128 + c] = bv[i]; }
        } else {
#pragma unroll
            for (int s0 = 0; s0 < 64; s0 += 16) { float av[16], bv[16];
#pragma unroll
                for (int i = 0; i < 16; ++i) { av[i] = Ad[(63 - s0 - i) * 128 + c]; bv[i] = Bd[(63 - s0 - i) * 128 + c]; }
#pragma unroll
                for (int i = 0; i < 16; ++i) { h = av[i] * h + bv[i]; bv[i] = h; }
#pragma unroll
                for (int i = 0; i < 16; ++i) Bd[(63 - s0 - i) * 128 + c] = bv[i]; }
        }
        if (!G.sample && ((d == 0 && jc == nch - 1) || (d == 1 && jc == 0))) F.new_s()[((size_t)(G.b * DEPTH + l) * 2 + d) * D + C] = h;
    }
}
__device__ __forceinline__ void lru_out(const Frame& F, int tid, int ck, int blk) {
    LAS unsigned char* lds = F.lds; const int m0 = ck * 64, C0 = blk * 128;
    const int row = tid >> 3, c16 = (tid & 7) * 16;
    const LAS float* h0 = (const LAS float*)(lds + LRU_B0) + row * 128 + c16; const LAS float* h1 = (const LAS float*)(lds + LRU_B1) + row * 128 + c16;
    const bf16_t* gp = F.Z() + (size_t)(m0 + row) * INW + OFF_LG + C0 + c16;
    const u32x4 g0 = *(const u32x4*)gp, g1 = *(const u32x4*)(gp + 8);
    const unsigned gw[8] = {g0.x, g0.y, g0.z, g0.w, g1.x, g1.y, g1.z, g1.w};
    unsigned ow[8];
#pragma unroll
    for (int i = 0; i < 8; ++i) ow[i] = cvt_pk_bf16((h0[2 * i] + h1[2 * i]) * bflo(gw[i]), (h0[2 * i + 1] + h1[2 * i + 1]) * bfhi(gw[i]));
    bf16_t* yp = F.BR() + (size_t)1 * M * D + (size_t)(m0 + row) * D + C0 + c16;
    *(u32x4*)yp = (u32x4){ow[0], ow[1], ow[2], ow[3]}; *(u32x4*)(yp + 8) = (u32x4){ow[4], ow[5], ow[6], ow[7]};
}
template <int PASS>
__device__ __forceinline__ void lru_phase(const Frame& F, int l) {
    LruCtx X; int cur = -1;
    const float* state_l = inp<I_SL>(F) + (size_t)l * 2 * D;
    float* AGG = F.AGG();
    const float* cwl = inp<I_CW>(F) + (size_t)l * 4 * D; const float* cbl = inp<I_CB>(F) + (size_t)l * D;
    constexpr int NU = 384 * 16;
    int u = F.bx;
    if (u < NU && F.tid >= 256) lru_conv<PASS>(F, F.tid - 256, 0, u >> 4, u & 15, state_l, AGG, cwl, cbl);
    __syncthreads();
    for (int par = 0; u < NU; u += F.G, par ^= 1) {
        int tid_ = F.tid; asm volatile("" : "+v"(tid_));
        const int tid = tid_, lane = tid & 63, wave = __builtin_amdgcn_readfirstlane(tid >> 6);
        const int blk = u & 15, ck = u >> 4;
        if (blk != cur) { lru_ctx_load(F, l, blk, X); cur = blk; }
        lru_gates(F, lane, wave, X);
        __syncthreads();
        if (tid < 256) lru_scan<PASS>(F, tid, par, l, ck, blk, AGG);
        else if (u + F.G < NU) lru_conv<PASS>(F, tid - 256, par ^ 1, (u + F.G) >> 4, (u + F.G) & 15, state_l, AGG, cwl, cbl);
        __syncthreads();
        if (PASS == 2) { lru_out(F, tid, ck, blk); __syncthreads(); }
    }
}
constexpr int CM_V = 0, CM_OUT = 32768, CM_OUT_PITCH = 528, CM_RS2 = CM_OUT + 128 * CM_OUT_PITCH;
static_assert(CM_RS2 + 512 <= MISC_OFF, "cm lds map");
struct CmCtx { bf16x8 wa[8]; };
__device__ __forceinline__ void cm_ctx_load(const Frame& F, int g, CmCtx& X) {
    const int qt = F.wave & 3, xl = F.lane & 31, hi = F.lane >> 5;
    const bf16_t* wp = F.CMW() + ((size_t)g * 128 + qt * 32 + xl) * 128 + hi * 8;
#pragma unroll
    for (int i = 0; i < 8; ++i) X.wa[i] = *(const bf16x8*)(wp + i * 16);
}
__device__ __forceinline__ void cm_unit(const Frame& F, int cn, int g, const CmCtx& X, const float* __restrict__ cmg, const float* __restrict__ bsg) {
    int tid_ = F.tid; asm volatile("" : "+v"(tid_));
    const int tid = tid_, lane = tid & 63, wave = __builtin_amdgcn_readfirstlane(tid >> 6), m0 = cn * 128, C0 = g * 128;
    LAS unsigned char* lds = F.lds;
    LAS float* RS = (LAS float*)(lds + CM_RS2);
    const bf16_t* Zb = F.Z();
    if (tid < 128) { const float* st = F.CVSTAT() + (size_t)(m0 + tid) * 32; float s = 0.f;
#pragma unroll
        for (int i = 0; i < 32; i += 4) { const f32x4 v = *(const f32x4*)(st + i); s += (v.x + v.y) + (v.z + v.w); }
        RS[tid] = rsqrtf(s * (1.f / D) + EPS); }
    __syncthreads();
    {
        const int sr = tid >> 4, sc = (tid & 15) * 8;
        const f32x4 ga = *(const f32x4*)(cmg + C0 + sc), gb = *(const f32x4*)(cmg + C0 + sc + 4);
#pragma unroll
        for (int i = 0; i < 4; ++i) {
            const int p = (i >> 1) * 64 + (i & 1) * 32 + sr; const float rs = RS[p];
            const u32x4 w = *(const u32x4*)(Zb + (size_t)(m0 + p) * INW + OFF_CV + C0 + sc);
            const f32x4 v0 = (f32x4){bflo(w.x), bfhi(w.x), bflo(w.y), bfhi(w.y)} * ga * rs, v1 = (f32x4){bflo(w.z), bfhi(w.z), bflo(w.w), bfhi(w.w)} * gb * rs;
            *(LAS u32x4*)(lds + CM_V + (i >> 1) * 16384 + att::v_st((i & 1) * 32 + sr, sc)) = pack8(v0, v1);
        }
    }
    __syncthreads();
    {
        const int qt = wave & 3, chh = wave >> 2, xl = lane & 31, hi = lane >> 5;
        f32x16 o0, o1;
#pragma unroll
        for (int r = 0; r < 16; ++r) { o0[r] = 0.f; o1[r] = 0.f; }
        const int vb = (int)(unsigned)(uintptr_t)(lds + CM_V) + att::v_rd_base(lane);
        if (chh == 0) {
            att::pv_one<0>(o0, vb, X.wa[0], X.wa[1], X.wa[2], X.wa[3]); att::pv_one<1>(o1, vb, X.wa[0], X.wa[1], X.wa[2], X.wa[3]);
            att::pv_one<0>(o0, vb + 16384, X.wa[4], X.wa[5], X.wa[6], X.wa[7]); att::pv_one<1>(o1, vb + 16384, X.wa[4], X.wa[5], X.wa[6], X.wa[7]);
        } else {
            att::pv_one<2>(o0, vb, X.wa[0], X.wa[1], X.wa[2], X.wa[3]); att::pv_one<3>(o1, vb, X.wa[0], X.wa[1], X.wa[2], X.wa[3]);
            att::pv_one<2>(o0, vb + 16384, X.wa[4], X.wa[5], X.wa[6], X.wa[7]); att::pv_one<3>(o1, vb + 16384, X.wa[4], X.wa[5], X.wa[6], X.wa[7]);
        }
#pragma unroll
        for (int r = 0; r < 16; ++r) { const int q = qt * 32 + crow(r, hi);
            *(LAS float*)(lds + CM_OUT + q * CM_OUT_PITCH + (chh * 64 + xl) * 4) = o0[r];
            *(LAS float*)(lds + CM_OUT + q * CM_OUT_PITCH + (chh * 64 + 32 + xl) * 4) = o1[r]; }
    }
    __syncthreads();
    {
        const int q = tid >> 2, c32 = (tid & 3) * 32; const float bias = bsg[q];
        const bf16_t* up = Zb + (size_t)(m0 + q) * INW + OFF_CU + C0 + c32;
        bf16_t* op = F.BR() + (size_t)2 * M * D + (size_t)(m0 + q) * D + C0 + c32;
#pragma unroll
        for (int i = 0; i < 4; ++i) {
            const u32x4 uw = *(const u32x4*)(up + i * 8);
            const f32x4 a = *(const LAS f32x4*)(lds + CM_OUT + q * CM_OUT_PITCH + (c32 + i * 8) * 4), b2 = *(const LAS f32x4*)(lds + CM_OUT + q * CM_OUT_PITCH + (c32 + i * 8 + 4) * 4);
            const f32x4 u0 = {bflo(uw.x), bfhi(uw.x), bflo(uw.y), bfhi(uw.y)}, u1 = {bflo(uw.z), bfhi(uw.z), bflo(uw.w), bfhi(uw.w)};
            *(u32x4*)(op + i * 8) = pack8(u0 * (a + bias), u1 * (b2 + bias));
        }
    }
}
__device__ __forceinline__ void cm_phase(const Frame& F, int l) {
    CmCtx X; int cur = -1;
    const float* cmg = inp<I_CMG>(F) + (size_t)l * D; const float* bs = inp<I_CMBS>(F) + (size_t)l * 16 * 128;
    for (int u = F.bx; u < 192 * 16; u += F.G) {
        const int g = u & 15, cn = u >> 4;
        if (g != cur) { cm_ctx_load(F, g, X); cur = g; }
        cm_unit(F, cn, g, X, cmg, bs + g * 128);
    }
    __syncthreads();
}
__device__ __forceinline__ void attn_phase(const Frame& F) {
    char* lds = (char*)F.lds;
    const att::bf16* Z = (const att::bf16*)F.Z(); const att::bf16* K = (const att::bf16*)F.KALL(); const att::bf16* V = (const att::bf16*)F.VALL(); att::bf16* O = (att::bf16*)F.BR();
    for (int id = F.bx; id < 1536; id += F.G) {
        size_t qrow, kvrow; int h, nkeys;
        if (id < 1024) { const int qb = id & 7, b = id >> 7; h = (id >> 3) & 15; qrow = (size_t)MP + (size_t)b * 2048 + qb * 256; kvrow = (size_t)MP + (size_t)b * 2304; nkeys = 2304; }
        else { const int id2 = id - 1024, b = id2 >> 4; h = id2 & 15; qrow = (size_t)b * 256; kvrow = qrow; nkeys = 256; }
        att::attn_dense_body<att::bf16>(Z + qrow * INW + OFF_Q + h * 128, K + kvrow * 512 + (h >> 2) * 128, V + kvrow * 512 + (h >> 2) * 128, O + qrow * D + h * 128, nkeys, lds);
    }
    __syncthreads();
}
}
#ifndef REP_G
#define REP_G 1
#endif
#ifndef REP_A
#define REP_A 1
#endif
#ifndef REP_L
#define REP_L 1
#endif
#ifndef REP_V
#define REP_V 1
#endif
#ifndef REP_R
#define REP_R 1
#endif
#ifndef REP_GSEL
#define REP_GSEL 0
#endif
#ifndef REP_B
#define REP_B 1
#endif
#ifndef REP_C
#define REP_C 1
#endif
namespace fk {
#if REP_G > 1 || REP_GSEL > 0
template <class Base> struct RepOrder {
    Base b; int n;
    __device__ void init_n() { Unit u; n = 0; while (b.next(n, u)) ++n; }
    __device__ bool next(int i, Unit& u) const { if (i >= 2 * n) return false; return b.next(i >= n ? i - n : i, u); }
    __device__ __forceinline__ void a_ready(const Unit&) const {}
    __device__ __forceinline__ void done(const Unit&) const {}
};
#define GEMM_REP(EPI, ORD, g, S, E) do { RepOrder<ORD> RS_; RS_.b = S; RS_.init_n(); pg8::gemm_phase<EPI, RepOrder<ORD>, true, true>(P.lds, g, RS_, E); } while (0)
#endif
#define GEMM_ONE(EPI, ORD, g, S, E) pg8::gemm_phase<EPI, ORD, true, true>(P.lds, g, S, E)
#if REP_G > 1
#define GEMM_CALL(ID, EPI, ORD, g, S, E) GEMM_REP(EPI, ORD, g, S, E)
#elif REP_GSEL > 0
#define GEMM_CALL(ID, EPI, ORD, g, S, E) do { if (ID == REP_GSEL) GEMM_REP(EPI, ORD, g, S, E); else GEMM_ONE(EPI, ORD, g, S, E); } while (0)
#else
#define GEMM_CALL(ID, EPI, ORD, g, S, E) GEMM_ONE(EPI, ORD, g, S, E)
#endif
__global__ void __launch_bounds__(NWAVES * 64, 2) mega(Params p) {
    extern __shared__ __attribute__((aligned(16))) unsigned char lds_raw[];
    Frame F;
    F.lds = (LAS unsigned char*)lds_raw;
    F.tid = threadIdx.x; F.lane = F.tid & 63; F.wave = __builtin_amdgcn_readfirstlane(F.tid >> 6);
    F.G = gridDim.x; { const int bx = blockIdx.x; F.vcu = (F.G % 8 == 0) ? (bx % 8) * (F.G / 8) + bx / 8 : bx; }
    F.gw = F.vcu * NWAVES + F.wave; F.NGW = F.G * NWAVES; F.bx = blockIdx.x;
    F.out = p.out; F.ws = p.ws; F.ka = (kaptr_t)__builtin_amdgcn_kernarg_segment_ptr();
    unsigned char* ws = p.ws;
    volatile LAS unsigned* MISC = (volatile LAS unsigned*)(F.lds + MISC_OFF);
    for (int u = F.tid; u < (LDS_BYTES - MISC_OFF) / 4; u += NWAVES * 64) ((LAS unsigned*)(F.lds + MISC_OFF))[u] = 0u;
    __syncthreads();
    unsigned* barw = (unsigned*)(ws + WS_CTL) + CW_BAR + p.li * XCD_BAR_WORDS;
    XcdBarrier bar = xcd_barrier_post(barw, MISC + 8);
    const int lo = p.ph_lo, hi = p.ph_hi;
#define IN_PH(k) (lo <= (k) && (k) < hi)
#if REP_B > 1
#define SEAM(k) do { if ((k) + 1 < hi) { xcd_barrier(bar); xcd_barrier(bar); } } while (0)
#else
#define SEAM(k) do { if ((k) + 1 < hi) xcd_barrier(bar); } while (0)
#endif

    if (IN_PH(0)) { const Frame P = phase_frame(F);
convert_layer(P, 0); mod_partials(P); rope_table(P);
#if REP_V > 1
        __syncthreads(); convert_layer(P, 0); mod_partials(P);
#endif
 SEAM(0); }
    if (IN_PH(1)) { const Frame P = phase_frame(F); mod_reduce(P); SEAM(1); }
    if (IN_PH(2)) { const Frame P = phase_frame(F); rowlocal_phase<0>(P, 0); SEAM(2); }
    for (int l = 0; l < DEPTH; ++l) {
        const int pb = 3 + 9 * l;
        if (IN_PH(pb + 0)) { const Frame P = phase_frame(F);
            pg8::Gemm g{P.H(), P.WIN(), M, INW, D}; pg8::StaticOrder S; S.init(M, INW, P.G, P.bx);
            EpiIn E{P.Z(), P.VALL(), P.new_v(), P.CVSTAT(), l};

GEMM_CALL(1, EpiIn, pg8::StaticOrder, g, S, E);

            SEAM(pb + 0);
        }
        if (IN_PH(pb + 1)) { const Frame P = phase_frame(F);

prep_phase(P, l);

            __syncthreads();

lru_phase<1>(P, l);
#if REP_L > 1
            lru_phase<1>(P, l);
#endif


cm_phase(P, l);
#if REP_C > 1
            cm_phase(P, l);
#endif

            SEAM(pb + 1);
        }
        if (IN_PH(pb + 2)) { const Frame P = phase_frame(F);

attn_phase(P);
#if REP_A > 1
            attn_phase(P);
#endif


lru_phase<2>(P, l);
#if REP_L > 1
            lru_phase<2>(P, l);
#endif

            SEAM(pb + 2);
        }
        if (IN_PH(pb + 3)) { const Frame P = phase_frame(F);
            pg8::Gemm g{P.BR(), P.WBR(), 3 * M, 3 * D, D}; MergeOrder S; S.init(P.G, P.bx);
            EpiMerge E{P.Z(), P.MSCR() + (size_t)P.bx * 65536, P.H()};

GEMM_CALL(2, EpiMerge, MergeOrder, g, S, E);

            SEAM(pb + 3);
        }
        if (IN_PH(pb + 4)) { const Frame P = phase_frame(F);
            pg8::Gemm g{P.H(), P.WOUT(), M, D, D}; pg8::StaticOrder S; S.init(M, D, P.G, P.bx);
            EpiF E{P.Fb(), P.FSTAT()};

GEMM_CALL(3, EpiF, pg8::StaticOrder, g, S, E);
            SEAM(pb + 4);

        }
        if (IN_PH(pb + 5)) { const Frame P = phase_frame(F);

#if REP_R > 1
            rowlocal_phase<1>(P, l, 0.f);
#endif
            rowlocal_phase<1>(P, l);
 SEAM(pb + 5); }
        if (IN_PH(pb + 6)) { const Frame P = phase_frame(F);
            pg8::Gemm g{P.H(), P.WFF1(), M, DFF, D}; pg8::StaticOrder S; S.init(M, DFF, P.G, P.bx);
            EpiRelu2 E{P.FFH(), DFF};

GEMM_CALL(4, EpiRelu2, pg8::StaticOrder, g, S, E);

            SEAM(pb + 6);
        }
        if (IN_PH(pb + 7)) { const Frame P = phase_frame(F);
            pg8::Gemm g{P.FFH(), P.WFF2(), M, D, DFF}; pg8::StaticOrder S; S.init(M, D, P.G, P.bx);
            EpiF E{P.Fb(), P.FSTAT()};

GEMM_CALL(5, EpiF, pg8::StaticOrder, g, S, E);
            SEAM(pb + 7);

        }
        if (IN_PH(pb + 8)) { const Frame P = phase_frame(F);


#if REP_R > 1
            rowlocal_phase<2>(P, l, 0.f);
#endif
            rowlocal_phase<2>(P, l);


if (l + 1 < DEPTH) { __syncthreads(); convert_layer(P, l + 1); }
#if REP_V > 1
            if (l + 1 < DEPTH) { __syncthreads(); convert_layer(P, l + 1); }
#endif

            SEAM(pb + 8);
        }
    }
#undef IN_PH
#undef SEAM
}
}
extern "C" void kernel_launch(void* const* d_in, const int* in_sizes, int n_in, void* d_out, int out_size, void* d_ws, size_t ws_size, hipStream_t stream) {
    static int grid = 0;
    if (grid == 0) {
        if (n_in != 32 || out_size != 84410368 || ws_size < fk::WS_END) { fprintf(stderr, "kernel_launch: unexpected shapes: n_in %d out %d ws %zu (need %zu)\n", n_in, out_size, ws_size, (size_t)fk::WS_END); grid = -1; return; }
        int dev = 0, cus = 0;
        if (hipGetDevice(&dev) != hipSuccess || hipDeviceGetAttribute(&cus, hipDeviceAttributeMultiprocessorCount, dev) != hipSuccess) { grid = -1; return; }
        if (hipFuncSetAttribute((const void*)fk::mega, hipFuncAttributeMaxDynamicSharedMemorySize, fk::LDS_BYTES) != hipSuccess) { fprintf(stderr, "kernel_launch: hipFuncSetAttribute failed\n"); grid = -1; return; }
        int per_cu = 0;
        if (hipOccupancyMaxActiveBlocksPerMultiprocessor(&per_cu, (const void*)fk::mega, fk::NWAVES * 64, fk::LDS_BYTES) != hipSuccess || per_cu < 1) fprintf(stderr, "kernel_launch: occupancy query says %d blocks per CU\n", per_cu);
        (void)hipGetLastError();
        grid = cus < 256 ? cus : 256;
    }
    if (grid < 0) return;
    (void)hipMemsetAsync((char*)d_ws + fk::WS_CTL, 0, fk::CTL_ZERO_BYTES, stream);
    fk::Params p{};
    for (int i = 0; i < 32; ++i) p.in[i] = (const float*)d_in[i];
    p.out = (float*)d_out; p.ws = (unsigned char*)d_ws; p.ph_lo = 0; p.ph_hi = fk::NPHASE; p.li = 0; p.pad = 0;
    hipLaunchKernelGGL(fk::mega, dim3(grid), dim3(fk::NWAVES * 64), fk::LDS_BYTES, stream, p);
}
```

```cpp
#include <hip/hip_runtime.h>
#include <hip/hip_bf16.h>
#include <cstdio>
#include <cstdint>
namespace pg8 {
#define PG8_LAS __attribute__((address_space(3)))
typedef unsigned short bf16_t;
typedef short bf16x8 __attribute__((ext_vector_type(8)));
typedef float f32x4 __attribute__((ext_vector_type(4)));
typedef unsigned u32x4 __attribute__((ext_vector_type(4)));
constexpr int BM = 256, BK = 64, HALF = 128, HTB = HALF * BK * 2  , STAGE_BYTES = 8 * HTB, NXCD = 8, WGM = 8;

__host__ __device__ __forceinline__ int lds_byte(int r, int c) { const int st = (r >> 4) * 2 + (c >> 5), rr = r & 15, cc = c & 31, ob = rr * 64 + cc * 2; return st * 1024 + (ob ^ (((ob >> 9) & 1) << 5)); }
__host__ __device__ __forceinline__ void stage_rc(int b, int& R, int& C) { const int st = b / 1024, sb = b % 1024, swz = sb ^ (((sb >> 9) & 1) << 5); R = (st >> 1) * 16 + swz / 64; C = (st & 1) * 32 + (swz % 64) / 2; }
__host__ __device__ __forceinline__ int perm32(int rho) { const int n = rho >> 4, i = rho & 15; return 8 * (i >> 2) + 4 * n + (i & 3); }

struct Unit { int pm, pn; };
struct Gemm { const bf16_t* A; const bf16_t* Bt; int M, N, K; };

struct StaticOrder {
    int nM, nN, nwg, G, c;
    __host__ __device__ void init(int M, int N, int G_, int c_) { nM = M / BM; nN = N / BM; nwg = nM * nN; G = G_; c = c_; }
    __host__ __device__ bool next(int i, Unit& u) const {
        const long L = (long)i * G + c; if (L >= nwg) return false;
        int wgid = (int)L; { const int q = nwg / NXCD, r = nwg % NXCD, xcd = wgid % NXCD, off = wgid / NXCD; wgid = (xcd < r ? xcd * (q + 1) : r * (q + 1) + (xcd - r) * q) + off; }
        const int nig = WGM * nN, gid = wgid / nig, fm = gid * WGM, gsz = (nM - fm) < WGM ? (nM - fm) : WGM;
        u.pm = fm + ((wgid % nig) % gsz); u.pn = (wgid % nig) / gsz; return true;
    }
    __device__ __forceinline__ void a_ready(const Unit&) const {}
    __device__ __forceinline__ void done(const Unit&) const {}
};
__device__ __forceinline__ unsigned cvt_pk_bf16(float lo, float hi) { unsigned r; asm volatile("v_cvt_pk_bf16_f32 %0, %1, %2" : "=v"(r) : "v"(lo), "v"(hi)); return r; }
template <class Epi, class Sched, bool ALIGN_EPI = false, bool SP2 = false>
__device__ __forceinline__ void gemm_phase(PG8_LAS unsigned char* lds, const Gemm g, const Sched& S, const Epi& E) {
    int tid_ = threadIdx.x; asm volatile("" : "+v"(tid_));
    const int tid = tid_, wid = __builtin_amdgcn_readfirstlane(tid >> 6), lane = tid & 63, wr = wid >> 2, wc = wid & 3, fr = lane & 15, fq = lane >> 4;
    const int K = g.K, nt = K / BK;
    unsigned voffA[2], voffB[2];
#pragma unroll
    for (int i = 0; i < 2; ++i) { int R, C; stage_rc(tid * 16 + i * 8192, R, C); const int Rb = Epi::PERM ? ((R & ~31) + perm32(R & 31)) : R;
        voffA[i] = (unsigned)(R * K + C) * 2u; voffB[i] = (unsigned)(Rb * K + C) * 2u; }
    const size_t kstep = (size_t)(BK * 2);
    const size_t hstep = (size_t)HALF * K * 2;
    const size_t tstep = 2 * hstep;
    const unsigned ldsw = (unsigned)wid * 1024u;
    const int aoff = lds_byte(wr * 64 + fr, fq * 8), boff = lds_byte(wc * 32 + fr, fq * 8);
#define PG8_SA(b, h) (((b) * 2 + (h)) * HTB)
#define PG8_SB(b, h) ((4 + (b) * 2 + (h)) * HTB)
#define PG8_STAGE(bufoff, gbase, voff) do { _Pragma("unroll") for (int _i = 0; _i < 2; ++_i) \
        __builtin_amdgcn_global_load_lds((const unsigned*)((const char*)(gbase) + (voff)[_i]), (PG8_LAS unsigned*)(lds + (bufoff) + ldsw + _i * 8192), 16, 0, 0); } while (0)
#define PG8_LDA(dst, b, h) do { _Pragma("unroll") for (int m = 0; m < 4; ++m) _Pragma("unroll") for (int k = 0; k < 2; ++k) dst[m][k] = *(const PG8_LAS bf16x8*)(lds + PG8_SA(b, h) + aoff + m * 2048 + k * 1024); } while (0)
#define PG8_LDB(dst, b, h) do { _Pragma("unroll") for (int n = 0; n < 2; ++n) _Pragma("unroll") for (int k = 0; k < 2; ++k) dst[n][k] = *(const PG8_LAS bf16x8*)(lds + PG8_SB(b, h) + boff + n * 2048 + k * 1024); } while (0)
#define PG8_MMA(ai, bj, At, Bt) do { __builtin_amdgcn_s_setprio(1); _Pragma("unroll") for (int m = 0; m < 4; ++m) _Pragma("unroll") for (int n = 0; n < 2; ++n) _Pragma("unroll") for (int k = 0; k < 2; ++k) \
        acc[ai][bj][m][n] = __builtin_amdgcn_mfma_f32_16x16x32_bf16(Bt[n][k], At[m][k], acc[ai][bj][m][n], 0, 0, 0); __builtin_amdgcn_s_setprio(0); } while (0)
#define PG8_WAIT_V(n) asm volatile("s_waitcnt vmcnt(" #n ")" ::: "memory")
#define PG8_WAIT_L(n) asm volatile("s_waitcnt lgkmcnt(" #n ")" ::: "memory")
#define PG8_BAR __builtin_amdgcn_s_barrier()
#define PG8_SCHED __builtin_amdgcn_sched_barrier(0)
    Unit cur, nxt; int ui = 0;
    if (!S.next(0, cur)) return;
    f32x4 acc[2][2][4][2];
#pragma unroll
    for (int a = 0; a < 2; ++a)
#pragma unroll
        for (int b = 0; b < 2; ++b)
#pragma unroll
            for (int m = 0; m < 4; ++m)
#pragma unroll
                for (int n = 0; n < 2; ++n) acc[a][b][m][n] = (f32x4){0.f, 0.f, 0.f, 0.f};
    bf16x8 At[4][2], B0[2][2], B1[2][2];
    const char* cA = (const char*)g.A + (size_t)cur.pm * tstep; const char* cB = (const char*)g.Bt + (size_t)cur.pn * tstep;
    S.a_ready(cur);
    if constexpr (SP2) {
        PG8_STAGE(PG8_SB(0, 0), cB, voffB); PG8_STAGE(PG8_SB(0, 1), cB + hstep, voffB); PG8_STAGE(PG8_SA(0, 0), cA, voffA); PG8_STAGE(PG8_SA(0, 1), cA + hstep, voffA);
        if (wr == 1) PG8_BAR;
        PG8_WAIT_V(2); PG8_BAR;
        PG8_STAGE(PG8_SB(1, 0), cB + kstep, voffB); PG8_STAGE(PG8_SA(1, 0), cA + kstep, voffA); PG8_STAGE(PG8_SB(1, 1), cB + hstep + kstep, voffB);
        PG8_WAIT_V(6); PG8_BAR;
    } else {
        PG8_STAGE(PG8_SB(0, 0), cB, voffB); PG8_STAGE(PG8_SA(0, 0), cA, voffA); PG8_STAGE(PG8_SB(0, 1), cB + hstep, voffB); PG8_STAGE(PG8_SA(0, 1), cA + hstep, voffA);
        if (wr == 1) PG8_BAR;
        PG8_WAIT_V(4); PG8_BAR;
        PG8_STAGE(PG8_SB(1, 0), cB + kstep, voffB); PG8_STAGE(PG8_SA(1, 0), cA + kstep, voffA); PG8_STAGE(PG8_SB(1, 1), cB + hstep + kstep, voffB);
        PG8_WAIT_V(6); PG8_BAR;
    }
    for (;;) {
        const bool has_next = S.next(ui + 1, nxt);
        const char* nA = has_next ? (const char*)g.A + (size_t)nxt.pm * tstep : cA; const char* nB = has_next ? (const char*)g.Bt + (size_t)nxt.pn * tstep : cB;
        for (int t = 0; t < nt; t += 2) {
            const bool last = (t == nt - 2);
            const char* a1 = cA + (size_t)(t + 1) * kstep;
            const char* a2 = last ? nA : cA + (size_t)(t + 2) * kstep; const char* b2 = last ? nB : cB + (size_t)(t + 2) * kstep;
            const char* a3 = a2 + kstep; const char* b3 = b2 + kstep;
            if (last && has_next) S.a_ready(nxt);
            if constexpr (SP2) {
            PG8_LDB(B0, 0, 0); PG8_LDB(B1, 0, 1); PG8_SCHED; PG8_LDA(At, 0, 0); PG8_STAGE(PG8_SA(1, 1), a1 + hstep, voffA);
            PG8_WAIT_V(8); PG8_WAIT_L(0); PG8_BAR; PG8_MMA(0, 0, At, B0); PG8_MMA(0, 1, At, B1); PG8_BAR; PG8_SCHED;
            PG8_LDA(At, 0, 1); PG8_STAGE(PG8_SB(0, 0), b2, voffB); PG8_STAGE(PG8_SB(0, 1), b2 + hstep, voffB); PG8_STAGE(PG8_SA(0, 0), a2, voffA);
            PG8_WAIT_V(8); PG8_WAIT_L(0); PG8_BAR; PG8_MMA(1, 0, At, B0); PG8_MMA(1, 1, At, B1); PG8_BAR; PG8_SCHED;
            PG8_LDB(B0, 1, 0); PG8_LDB(B1, 1, 1); PG8_SCHED; PG8_LDA(At, 1, 0); PG8_STAGE(PG8_SA(0, 1), a2 + hstep, voffA);
            PG8_WAIT_V(8); PG8_WAIT_L(0); PG8_BAR; PG8_MMA(0, 0, At, B0); PG8_MMA(0, 1, At, B1); PG8_BAR; PG8_SCHED;
            PG8_LDA(At, 1, 1); PG8_STAGE(PG8_SB(1, 0), b3, voffB); PG8_STAGE(PG8_SB(1, 1), b3 + hstep, voffB); PG8_STAGE(PG8_SA(1, 0), a3, voffA);
            PG8_WAIT_V(8); PG8_WAIT_L(0); PG8_BAR; PG8_MMA(1, 0, At, B0); PG8_MMA(1, 1, At, B1); PG8_BAR; PG8_SCHED;
            } else {
            PG8_LDB(B0, 0, 0); PG8_SCHED; PG8_LDA(At, 0, 0); PG8_STAGE(PG8_SA(1, 1), a1 + hstep, voffA);
            PG8_WAIT_L(8); PG8_BAR; PG8_WAIT_L(0); PG8_MMA(0, 0, At, B0); PG8_BAR; PG8_SCHED;
            PG8_LDB(B1, 0, 1); PG8_STAGE(PG8_SB(0, 0), b2, voffB);
            PG8_BAR; PG8_WAIT_L(0); PG8_MMA(0, 1, At, B1); PG8_BAR;
            PG8_LDA(At, 0, 1); PG8_STAGE(PG8_SA(0, 0), a2, voffA);
            PG8_BAR; PG8_WAIT_L(0); PG8_MMA(1, 0, At, B0); PG8_BAR; PG8_SCHED;
            PG8_STAGE(PG8_SB(0, 1), b2 + hstep, voffB);
            PG8_WAIT_V(6); PG8_BAR; PG8_MMA(1, 1, At, B1); PG8_BAR;
            PG8_LDB(B0, 1, 0); PG8_SCHED; PG8_LDA(At, 1, 0); PG8_STAGE(PG8_SA(0, 1), a2 + hstep, voffA);
            PG8_WAIT_L(8); PG8_BAR; PG8_WAIT_L(0); PG8_MMA(0, 0, At, B0); PG8_BAR; PG8_SCHED;
            PG8_LDB(B1, 1, 1); PG8_STAGE(PG8_SB(1, 0), b3, voffB);
            PG8_BAR; PG8_WAIT_L(0); PG8_MMA(0, 1, At, B1); PG8_BAR;
            PG8_LDA(At, 1, 1); PG8_STAGE(PG8_SA(1, 0), a3, voffA);
            PG8_BAR; PG8_WAIT_L(0); PG8_MMA(1, 0, At, B0); PG8_BAR; PG8_SCHED;
            PG8_STAGE(PG8_SB(1, 1), b3 + hstep, voffB);
            PG8_WAIT_V(6); PG8_BAR; PG8_MMA(1, 1, At, B1); PG8_BAR;
            }
        }
        if constexpr (ALIGN_EPI) { if (wr == 0) PG8_BAR; }
        if constexpr (!Epi::AFTER_DRAIN) { E(acc, cur, wr, wc, fr, fq); S.done(cur); }
        if (!has_next) break;
#pragma unroll
        for (int a = 0; a < 2; ++a)
#pragma unroll
            for (int b = 0; b < 2; ++b)
#pragma unroll
                for (int m = 0; m < 4; ++m)
#pragma unroll
                    for (int n = 0; n < 2; ++n) acc[a][b][m][n] = (f32x4){0.f, 0.f, 0.f, 0.f};
        cur = nxt; cA = nA; cB = nB; ++ui;
        if constexpr (ALIGN_EPI) { if (wr == 1) PG8_BAR; }
    }
    PG8_WAIT_V(0);
    if constexpr (!ALIGN_EPI) { if (wr == 0) PG8_BAR; }
    PG8_BAR;
    if constexpr (Epi::AFTER_DRAIN) { E.fused(acc, cur, wr, wc, fr, fq, lds, wid, lane); S.done(cur); }
#undef PG8_SA
#undef PG8_SB
#undef PG8_STAGE
#undef PG8_LDA
#undef PG8_LDB
#undef PG8_MMA
#undef PG8_WAIT_V
#undef PG8_WAIT_L
#undef PG8_BAR
#undef PG8_SCHED
}
}
#define GAS __attribute__((address_space(1)))
#define LAS __attribute__((address_space(3)))
typedef unsigned short bf16;
typedef unsigned v4u __attribute__((ext_vector_type(4)));
typedef float f32x4 __attribute__((ext_vector_type(4)));
typedef short bf16x8 __attribute__((ext_vector_type(8)));
typedef GAS unsigned gu32;
typedef GAS unsigned long long gu64;
#define RLX_AGENT __ATOMIC_RELAXED, __HIP_MEMORY_SCOPE_AGENT
#define LDS_WAIT() asm volatile("s_waitcnt lgkmcnt(0)" ::: "memory")
#define VM_WAIT() asm volatile("s_waitcnt vmcnt(0)" ::: "memory")
__device__ __forceinline__ unsigned long long rt() { return __builtin_amdgcn_s_memrealtime(); }
__device__ __forceinline__ unsigned f2bf(float f) { unsigned u = __builtin_bit_cast(unsigned, f); return (u + 0x7fffu + ((u >> 16) & 1u)) >> 16; }
__device__ __forceinline__ unsigned pk2(float lo, float hi) { return f2bf(lo) | (f2bf(hi) << 16); }

#define XB_TMO      128
#define XB_XCNT(j)  (256  + 64 * (j))
#define XB_XSUB(j)  (1280 + 64 * (j))
#define XB_XGEN(j)  (2304 + 64 * (j))
#define XB_TOP      3328
#define XB_TOPGEN   3392
#define XCD_BAR_WORDS 3456
#define XB_SPIN_CAP (1u << 18)

__device__ __forceinline__ unsigned xb_ld(unsigned* p)              { return __hip_atomic_load(p, __ATOMIC_RELAXED, __HIP_MEMORY_SCOPE_AGENT); }
__device__ __forceinline__ unsigned xb_add(unsigned* p, unsigned v) { return __hip_atomic_fetch_add(p, v, __ATOMIC_RELAXED, __HIP_MEMORY_SCOPE_AGENT); }
__device__ __forceinline__ unsigned xb_xcc_id() { return (unsigned)__builtin_amdgcn_s_getreg((3 << 11) | 20) & 0xFu; }
#define XB_SPIN(cond, bar) do { unsigned _sp = 0; while (cond) { __builtin_amdgcn_s_sleep(1); \
    if ((++_sp & 255u) == 0u) { if (xb_ld(&(bar)[XB_TMO])) break; if (_sp > XB_SPIN_CAP) { atomicAdd(&(bar)[XB_TMO], 1u); break; } } } } while (0)

struct XcdBarrier {
    unsigned* bar; unsigned x;
    volatile LAS unsigned* st;
};

__device__ __forceinline__ XcdBarrier xcd_barrier_post(unsigned* bar, volatile LAS unsigned* st) {
    XcdBarrier b; b.bar = bar; b.x = xb_xcc_id(); b.st = st;
    if (threadIdx.x == 0) (void)xb_add(&bar[XB_XCNT(b.x)], 1u);
    return b;
}
__device__ __forceinline__ void xcd_barrier_complete(unsigned* bar, unsigned x, unsigned& nloc, unsigned& nx) {
    const unsigned G = gridDim.x * gridDim.y * gridDim.z;
    unsigned sum, cnt, mine, sp = 0u;
    for (;;) {
        sum = 0u; cnt = 0u; mine = 0u;
#pragma unroll
        for (unsigned j = 0; j < 16; ++j) { const unsigned c = xb_ld(&bar[XB_XCNT(j)]); sum += c; cnt += (c > 0u) ? 1u : 0u; mine = (j == x) ? c : mine; }
        if (sum == G) break;
        __builtin_amdgcn_s_sleep(1);
        if ((++sp & 255u) == 0u) { if (xb_ld(&bar[XB_TMO])) break; if (sp > XB_SPIN_CAP) { atomicAdd(&bar[XB_TMO], 1u); break; } }
    }
    nloc = mine > 0u ? mine : 1u; nx = cnt > 0u ? cnt : 1u;
}

__device__ __forceinline__ void xcd_barrier(const XcdBarrier& b) {
    asm volatile("s_waitcnt vmcnt(0)" ::: "memory");
    __syncthreads();
    if (threadIdx.x == 0) {
        unsigned* bar = b.bar;
        __builtin_amdgcn_s_waitcnt(0);
        unsigned nloc = b.st[0], nx = b.st[1];
        if (nloc == 0u) { xcd_barrier_complete(bar, b.x, nloc, nx); b.st[0] = nloc; b.st[1] = nx; }
        const unsigned old = xb_add(&bar[XB_XSUB(b.x)], 1u);
        const unsigned gen = old / nloc;
        if (old + 1u == (gen + 1u) * nloc) {
            __builtin_amdgcn_fence(__ATOMIC_RELEASE, "agent");
            asm volatile("s_waitcnt vmcnt(0)" ::: "memory");
            const unsigned og = xb_add(&bar[XB_TOP], 1u);
            const unsigned tg = og / nx;
            if (og + 1u == (tg + 1u) * nx) xb_add(&bar[XB_TOPGEN], 1u);
            else XB_SPIN(xb_ld(&bar[XB_TOPGEN]) == tg, bar);
            __builtin_amdgcn_fence(__ATOMIC_ACQUIRE, "agent");
            xb_add(&bar[XB_XGEN(b.x)], 1u);
            asm volatile("s_waitcnt vmcnt(0)" ::: "memory");
        } else {
            XB_SPIN(xb_ld(&bar[XB_XGEN(b.x)]) == gen, bar);
            __builtin_amdgcn_fence(__ATOMIC_ACQUIRE, "agent");
            asm volatile("s_waitcnt vmcnt(0)" ::: "memory");
        }
    }
    __syncthreads();
}
namespace att {
constexpr int   D = 128, NW = 8, QBLK = 32, KVBLK = 64;
constexpr float SCALE = 0.088388347648318440f;
constexpr float THR = 8.f;
constexpr int SDEPTH = 2;
constexpr int LDQ = 17408, LDK = 512, LDO = 2048;
constexpr size_t SHM_V = KVBLK * D * 2, SHM_K = KVBLK * D * 2, SHM_ATTN = 2 * SHM_V + 2 * SHM_K + NW * 64 * 4;
using bf16 = __hip_bfloat16;
using bf16x8 = __attribute__((ext_vector_type(8))) short;
using s16x4  = __attribute__((ext_vector_type(4))) short;
using f32x16 = __attribute__((ext_vector_type(16))) float;
using f32x8  = __attribute__((ext_vector_type(8))) float;
using u32x4  = __attribute__((ext_vector_type(4))) unsigned;
#define KSWZ(row, colB) ((row) * 256 + ((colB) ^ (((row) & 7) << 4)))
#define SBAR() __builtin_amdgcn_sched_barrier(0)
__device__ __forceinline__ int crow(int r, int hi) { return (r & 3) + 8 * (r >> 2) + 4 * hi; }
__device__ __forceinline__ unsigned cvtpk(float lo, float hi) {
  unsigned r; asm volatile("v_cvt_pk_bf16_f32 %0, %1, %2" : "=v"(r) : "v"(lo), "v"(hi)); return r;
}
template <typename TIn> struct Stage;
template <> struct Stage<bf16>  { using T = bf16x8;
  __device__ static __forceinline__ T ld8(const bf16* p) { return *reinterpret_cast<const bf16x8*>(p); }
  __device__ static __forceinline__ bf16x8 tobf(T x) { return x; } };
template <> struct Stage<float> { using T = f32x8;
  __device__ static __forceinline__ T ld8(const float* p) { return *reinterpret_cast<const f32x8*>(p); }
  __device__ static __forceinline__ bf16x8 tobf(T x) {
    u32x4 w = {cvtpk(x[0], x[1]), cvtpk(x[2], x[3]), cvtpk(x[4], x[5]), cvtpk(x[6], x[7])}; return *reinterpret_cast<bf16x8*>(&w); } };

__device__ __forceinline__ void partialSM(f32x16& p0, f32x16& p1, float& m_reg, float& mn, float& alpha) {
  constexpr float C = SCALE * 1.4426950408889634f;
  float pmax = p0[0]; for (int r = 1; r < 16; ++r) pmax = fmaxf(pmax, p0[r]); for (int r = 0; r < 16; ++r) pmax = fmaxf(pmax, p1[r]);
  { auto rr = __builtin_amdgcn_permlane32_swap(__float_as_uint(pmax), __float_as_uint(pmax), false, false);
    pmax = fmaxf(__uint_as_float(rr[0]), __uint_as_float(rr[1])); }
  if (__builtin_expect(__all(pmax - m_reg <= THR / SCALE), 1)) { mn = m_reg; alpha = 1.f; }
  else { mn = fmaxf(m_reg, pmax); alpha = __builtin_amdgcn_exp2f((m_reg - mn) * C); m_reg = mn; }
  float mnC = -mn * C;
  for (int r = 0; r < 16; ++r) p0[r] = fmaf(p0[r], C, mnC); for (int r = 0; r < 16; ++r) p1[r] = fmaf(p1[r], C, mnC);
  for (int r = 0; r < 16; ++r) p0[r] = __builtin_amdgcn_exp2f(p0[r]);
}
__device__ __forceinline__ void finishSM(f32x16& p0, f32x16& p1, float alpha, float& l_reg, bf16x8& pa0, bf16x8& pa1, bf16x8& pa2, bf16x8& pa3) {
  for (int r = 0; r < 16; ++r) p1[r] = __builtin_amdgcn_exp2f(p1[r]);
  float ps = 0; for (int r = 0; r < 16; ++r) ps += p0[r]; for (int r = 0; r < 16; ++r) ps += p1[r];
  { auto rr = __builtin_amdgcn_permlane32_swap(__float_as_uint(ps), __float_as_uint(ps), false, false);
    ps = __uint_as_float(rr[0]) + __uint_as_float(rr[1]); }
  l_reg = l_reg * alpha + ps;
#define PK4(P, BASE, OUT) do { unsigned a0 = cvtpk(P[BASE + 0], P[BASE + 1]), a1 = cvtpk(P[BASE + 2], P[BASE + 3]);   \
    unsigned b0 = cvtpk(P[BASE + 4], P[BASE + 5]), b1 = cvtpk(P[BASE + 6], P[BASE + 7]);                              \
    auto r0 = __builtin_amdgcn_permlane32_swap(a0, b0, false, false); auto r1 = __builtin_amdgcn_permlane32_swap(a1, b1, false, false); \
    u32x4 w = {r0[0], r1[0], r0[1], r1[1]}; OUT = *reinterpret_cast<bf16x8*>(&w); } while (0)
  PK4(p0, 0, pa0); PK4(p0, 8, pa1); PK4(p1, 0, pa2); PK4(p1, 8, pa3);
#undef PK4
}
__device__ __forceinline__ void qkt(f32x16& p0, f32x16& p1, const bf16* Ks, const bf16x8* qr, int r32, int hi) {
  p0 = f32x16{}; p1 = f32x16{};
  for (int d0 = 0; d0 < 8; ++d0) { int cb = (d0 * 16 + hi * 8) * 2;
    bf16x8 b0 = *reinterpret_cast<const bf16x8*>((const char*)Ks + KSWZ(r32, cb));
    bf16x8 b1 = *reinterpret_cast<const bf16x8*>((const char*)Ks + KSWZ(32 + r32, cb));
    p0 = __builtin_amdgcn_mfma_f32_32x32x16_bf16(b0, qr[d0], p0, 0, 0, 0);
    p1 = __builtin_amdgcn_mfma_f32_32x32x16_bf16(b1, qr[d0], p1, 0, 0, 0); }
}
__device__ __forceinline__ int v_st(int k, int c) { const int kk = (k & ~0xC) | ((k & 4) << 1) | ((k & 8) >> 1); return ((kk >> 3) * 4 + (c >> 5)) * 512 + ((kk & 7) * 32 + (c & 31)) * 2; }
__device__ __forceinline__ int v_rd_base(int lane) { return ((lane & 3) << 3) | (((lane >> 2) & 3) << 6) | (((lane >> 4) & 1) << 5) | (((lane >> 5) & 1) << 8); }
constexpr int v_rd_off(int d0, int ks, int half) { return d0 * 512 + ks * 4096 + half * 2048; }
template <int OFF> __device__ __forceinline__ s16x4 tr_read(int vb) {
  s16x4 r; asm volatile("ds_read_b64_tr_b16 %0, %1 offset:%2" : "=&v"(r) : "v"(vb), "i"(OFF) : "memory"); return r;
}
template <int D0> __device__ __forceinline__ void pv_one(f32x16& od, int vb, bf16x8 pa0, bf16x8 pa1, bf16x8 pa2, bf16x8 pa3) {
  const s16x4 l0 = tr_read<v_rd_off(D0, 0, 0)>(vb), h0 = tr_read<v_rd_off(D0, 0, 1)>(vb), l1 = tr_read<v_rd_off(D0, 1, 0)>(vb), h1 = tr_read<v_rd_off(D0, 1, 1)>(vb);
  const s16x4 l2 = tr_read<v_rd_off(D0, 2, 0)>(vb), h2 = tr_read<v_rd_off(D0, 2, 1)>(vb), l3 = tr_read<v_rd_off(D0, 3, 0)>(vb), h3 = tr_read<v_rd_off(D0, 3, 1)>(vb);
  asm volatile("s_waitcnt lgkmcnt(0)" ::: "memory"); SBAR();
#define PK(L, H) (bf16x8){L[0], L[1], L[2], L[3], H[0], H[1], H[2], H[3]}
  od = __builtin_amdgcn_mfma_f32_32x32x16_bf16(pa0, PK(l0, h0), od, 0, 0, 0);
  od = __builtin_amdgcn_mfma_f32_32x32x16_bf16(pa1, PK(l1, h1), od, 0, 0, 0);
  od = __builtin_amdgcn_mfma_f32_32x32x16_bf16(pa2, PK(l2, h2), od, 0, 0, 0);
  od = __builtin_amdgcn_mfma_f32_32x32x16_bf16(pa3, PK(l3, h3), od, 0, 0, 0);
#undef PK
}
__device__ __forceinline__ void pv_d0(f32x16* o, int vb, bf16x8 pa0, bf16x8 pa1, bf16x8 pa2, bf16x8 pa3) {
  pv_one<0>(o[0], vb, pa0, pa1, pa2, pa3); pv_one<1>(o[1], vb, pa0, pa1, pa2, pa3); pv_one<2>(o[2], vb, pa0, pa1, pa2, pa3); pv_one<3>(o[3], vb, pa0, pa1, pa2, pa3);
}

template <typename TQ>
__device__ __forceinline__ void attn_dense_body(const TQ* __restrict__ Qb, const bf16* __restrict__ Kh, const bf16* __restrict__ Vh,
                                                bf16* __restrict__ Ob, int seq, char* lds) {
  using St = Stage<bf16>; using SQ = Stage<TQ>;
  int tid_ = threadIdx.x; asm volatile("" : "+v"(tid_));
  const int tid = tid_, wid = tid >> 6, lane = tid & 63, r32 = lane & 31, hi = lane >> 5;
  bf16* V_lds = (bf16*)lds; bf16* K_lds = (bf16*)(lds + 2 * SHM_V);
  float* ws = (float*)(lds + 2 * SHM_V + 2 * SHM_K) + wid * 64; float* li_l = ws; float* al_l = ws + 32;
  float m_reg = -1e30f, l_reg = 0; f32x16 o[4] = {}; bf16x8 qr[8];
  const TQ* Qw = Qb + (long)(wid * QBLK + r32) * LDQ + hi * 8;
#pragma unroll
  for (int d0 = 0; d0 < 8; ++d0) qr[d0] = SQ::tobf(SQ::ld8(Qw + d0 * 16));
  const int sr = tid >> 4, sc = (tid & 15) * 8, vst0 = v_st(sr, sc), vst1 = v_st(32 + sr, sc);
  const int vb0 = (int)(uintptr_t)V_lds + v_rd_base(lane);
  struct { typename St::T vs0, vs1, ks0, ks1; } sr_[SDEPTH];
#define SLOAD(i, k0) do { sr_[i].vs0 = St::ld8(&Vh[(long)((k0) + sr) * LDK + sc]); sr_[i].vs1 = St::ld8(&Vh[(long)((k0) + 32 + sr) * LDK + sc]); \
    sr_[i].ks0 = St::ld8(&Kh[(long)((k0) + sr) * LDK + sc]); sr_[i].ks1 = St::ld8(&Kh[(long)((k0) + 32 + sr) * LDK + sc]); } while (0)
#define SWRITE(b, i) do { *(bf16x8*)((char*)V_lds + (b) * SHM_V + vst0) = St::tobf(sr_[i].vs0);          \
    *(bf16x8*)((char*)V_lds + (b) * SHM_V + vst1) = St::tobf(sr_[i].vs1); int kc = sc * 2;               \
    *(bf16x8*)((char*)K_lds + (b) * SHM_K + KSWZ(sr, kc)) = St::tobf(sr_[i].ks0);                       \
    *(bf16x8*)((char*)K_lds + (b) * SHM_K + KSWZ(32 + sr, kc)) = St::tobf(sr_[i].ks1); } while (0)
#define SWAIT() do { if constexpr (SDEPTH == 2) asm volatile("s_waitcnt vmcnt(4)" ::: "memory"); else asm volatile("s_waitcnt vmcnt(0)" ::: "memory"); } while (0)
#define RESC(a) do { if (__any((a) < 1.f)) { if (hi == 0) al_l[r32] = (a); asm volatile("s_waitcnt lgkmcnt(0)" ::: "memory"); \
    for (int d = 0; d < 4; ++d) for (int r = 0; r < 16; ++r) o[d][r] *= al_l[crow(r, hi)]; } } while (0)
  f32x16 pA0, pA1, pB0, pB1; float mnA, mnB, alA, alB; bf16x8 pa0, pa1, pa2, pa3; const int NT = seq / KVBLK;
  constexpr int SE = 0, SO = SDEPTH - 1;
  SLOAD(SE, 0); asm volatile("s_waitcnt vmcnt(0)" ::: "memory"); SWRITE(0, SE); __syncthreads();
  qkt(pA0, pA1, K_lds, qr, r32, hi); partialSM(pA0, pA1, m_reg, mnA, alA);
  SLOAD(SO, KVBLK); if constexpr (SDEPTH == 2) { if (2 < NT) SLOAD(SE, 2 * KVBLK); }
  SWAIT(); SWRITE(1, SO); __syncthreads();
  for (int j = 1; j + 1 < NT; j += 2) {
    SBAR(); qkt(pB0, pB1, (bf16*)((char*)K_lds + SHM_K), qr, r32, hi);
    finishSM(pA0, pA1, alA, l_reg, pa0, pa1, pa2, pa3); SBAR();
    SLOAD(SO, (j + SDEPTH) * KVBLK); SBAR();
    pv_d0(o, vb0, pa0, pa1, pa2, pa3); partialSM(pB0, pB1, m_reg, mnB, alB);
    __syncthreads(); SWAIT(); SWRITE(0, SE);
    RESC(alB); __syncthreads();
    SBAR(); qkt(pA0, pA1, K_lds, qr, r32, hi);
    finishSM(pB0, pB1, alB, l_reg, pa0, pa1, pa2, pa3); SBAR();
    if (SDEPTH == 1 || j + 3 < NT) SLOAD(SE, (j + 1 + SDEPTH) * KVBLK); SBAR();
    pv_d0(o, vb0 + (int)SHM_V, pa0, pa1, pa2, pa3); partialSM(pA0, pA1, m_reg, mnA, alA);
    __syncthreads(); SWAIT(); SWRITE(1, SO);
    RESC(alA); __syncthreads();
  }
  SBAR(); qkt(pB0, pB1, (bf16*)((char*)K_lds + SHM_K), qr, r32, hi);
  finishSM(pA0, pA1, alA, l_reg, pa0, pa1, pa2, pa3); SBAR();
  pv_d0(o, vb0, pa0, pa1, pa2, pa3); partialSM(pB0, pB1, m_reg, mnB, alB);
  __syncthreads(); RESC(alB);
  finishSM(pB0, pB1, alB, l_reg, pa0, pa1, pa2, pa3); SBAR();
  pv_d0(o, vb0 + (int)SHM_V, pa0, pa1, pa2, pa3);
  if (hi == 0) li_l[r32] = l_reg; asm volatile("s_waitcnt lgkmcnt(0)" ::: "memory");
  float rli[16];
#pragma unroll
  for (int r = 0; r < 16; ++r) rli[r] = __builtin_amdgcn_rcpf(li_l[crow(r, hi)]);
  bf16* Ow = Ob + (long)(wid * QBLK) * LDO;
#pragma unroll
  for (int r = 0; r < 16; ++r) { int orow = crow(r, hi);
    for (int d0 = 0; d0 < 4; ++d0) Ow[(long)orow * LDO + d0 * 32 + r32] = __float2bfloat16(o[d0][r] * rli[r]); }
#undef SLOAD
#undef SWRITE
#undef SWAIT
#undef RESC
}
#undef KSWZ
#undef SBAR
}
namespace fk {
using pg8::bf16_t; using pg8::f32x4; using pg8::u32x4; using pg8::Unit; using pg8::cvt_pk_bf16;
typedef unsigned u32x2 __attribute__((ext_vector_type(2)));
typedef float f32x16 __attribute__((ext_vector_type(16)));
constexpr int M = 24576, MP = 8192, D = 2048, INW = 17408, DFF = 8192, DEPTH = 4, NWAVES = 8, NCOND = 9;
constexpr int OFF_Q = 0, OFF_K = 2048, OFF_V = 2560, OFF_LX = 3072, OFF_LG = 5120, OFF_CU = 7168, OFF_CV = 9216, OFF_G = 11264;
constexpr int NKVROWS = 26624;
constexpr float EPS = 1e-6f;
constexpr int NPHASE = 3 + 9 * DEPTH;
constexpr int NMODK = 32;
constexpr size_t MiB = 1u << 20;
constexpr size_t WS_CTL = 0, CTL_ZERO_BYTES = 1 * MiB;
constexpr size_t WS_CIN = 1 * MiB  , WS_MODP = 716 * MiB  , WS_MOD = 28 * MiB, WS_ROPE = 30 * MiB, WS_CVSTAT = 31 * MiB, WS_FSTAT = 34 * MiB, WS_AGG = 37 * MiB, WS_WLRU = 49 * MiB, WS_CMW = 51 * MiB;
constexpr size_t WS_WIN = 52 * MiB, WS_WBR = 120 * MiB, WS_WOUT = 144 * MiB, WS_WFF1 = 152 * MiB, WS_WFF2 = 184 * MiB;
constexpr size_t WS_H = 216 * MiB, WS_KALL = 312 * MiB, WS_VALL = 338 * MiB, WS_BR = 364 * MiB, WS_MSCR = 652 * MiB, WS_Z = 716 * MiB, WS_END = 1532 * MiB;
constexpr size_t WS_FFH = WS_Z, WS_F = WS_Z + 384 * MiB;
constexpr int CW_SPLIT = 2048;
constexpr int CW_BAR = 4096;
constexpr int RING_BYTES = 131072;
constexpr int LRU_XC = 0, LRU_XC_PITCH = 272, LRU_A0 = 17408, LRU_B0 = LRU_A0 + 32768, LRU_A1 = LRU_B0 + 32768, LRU_B1 = LRU_A1 + 32768, LRU_CARRY = LRU_B1 + 32768;
constexpr int CM_VT = 0, CM_VT_PITCH = 272, CM_RS = 128 * 272;
constexpr int MISC_OFF = 150528, LDS_BYTES = 151552;
static_assert(LRU_CARRY + 2048 <= MISC_OFF, "lds map");

struct Params { const float* in[32]; float* out; unsigned char* ws; int ph_lo, ph_hi, li, pad; };

typedef const __attribute__((address_space(4))) void* kaptr_t;
struct Frame {
    LAS unsigned char* lds;
    int tid, lane, wave, vcu, G, gw, NGW, bx;
    float* out; unsigned char* ws; kaptr_t ka;
    __device__ __forceinline__ float* x() const { return out; }
    __device__ __forceinline__ float* new_k() const { return out + 50331648L; }
    __device__ __forceinline__ float* new_v() const { return out + 50331648L + 16777216L; }
    __device__ __forceinline__ float* new_s() const { return out + 50331648L + 2 * 16777216L; }
#define FK_WSP(name, type, off) __device__ __forceinline__ type* name() const { return (type*)(ws + (off)); }
    FK_WSP(MODP, float, WS_MODP) FK_WSP(MOD, float, WS_MOD) FK_WSP(ROPE, float, WS_ROPE) FK_WSP(CVSTAT, float, WS_CVSTAT) FK_WSP(FSTAT, float, WS_FSTAT) FK_WSP(AGG, float, WS_AGG) FK_WSP(CIN, float, WS_CIN) FK_WSP(MSCR, float, WS_MSCR)
    FK_WSP(WLRU, bf16_t, WS_WLRU) FK_WSP(CMW, bf16_t, WS_CMW) FK_WSP(WIN, bf16_t, WS_WIN) FK_WSP(WBR, bf16_t, WS_WBR) FK_WSP(WOUT, bf16_t, WS_WOUT) FK_WSP(WFF1, bf16_t, WS_WFF1) FK_WSP(WFF2, bf16_t, WS_WFF2)
    FK_WSP(H, bf16_t, WS_H) FK_WSP(KALL, bf16_t, WS_KALL) FK_WSP(VALL, bf16_t, WS_VALL) FK_WSP(BR, bf16_t, WS_BR) FK_WSP(Z, bf16_t, WS_Z) FK_WSP(FFH, bf16_t, WS_FFH) FK_WSP(Fb, bf16_t, WS_F)
#undef FK_WSP
};
enum { I_XP = 0, I_XS, I_CK, I_CV, I_SL, I_C, I_CCTX, I_WMOD, I_BMOD, I_GPM, I_GPOM, I_GPF, I_GPOF, I_WIN, I_GQ, I_GK, I_WAO, I_CW, I_CB, I_LWA, I_LBA, I_LWX, I_LBX, I_LAM, I_WLO, I_CMG, I_CMWS, I_CMBS, I_WCO, I_WOUT, I_WFF1, I_WFF2 };
template <int I> __device__ __forceinline__ const float* inp(const Frame& F) { const GAS float* r; asm volatile("s_load_dwordx2 %0, %1, %2\n\ts_waitcnt lgkmcnt(0)" : "=s"(r) : "s"(F.ka), "i"(I * 8) : "memory"); return (const float*)r; }


__device__ __forceinline__ Frame phase_frame(const Frame& F) {
    Frame P = F; int t = F.tid; int bx = blockIdx.x; int g = F.G; GAS unsigned char* w = (GAS unsigned char*)F.ws; GAS float* o = (GAS float*)F.out;
    asm volatile("" : "+v"(t)); asm volatile("" : "+s"(bx), "+s"(g), "+s"(w), "+s"(o));
    P.tid = t; P.lane = t & 63; P.wave = __builtin_amdgcn_readfirstlane(t >> 6); P.ws = (unsigned char*)w; P.out = (float*)o; P.bx = bx; P.G = g; P.NGW = g * NWAVES;
    P.vcu = (g % 8 == 0) ? (bx % 8) * (g / 8) + bx / 8 : bx; P.gw = P.vcu * NWAVES + P.wave;
    return P;
}
__device__ __forceinline__ float wave_sum(float v) {
#pragma unroll
    for (int o = 1; o < 64; o <<= 1) v += __shfl_xor(v, o);
    return v;
}
__device__ __forceinline__ float bf2f(unsigned short h) { return __uint_as_float((unsigned)h << 16); }
__device__ __forceinline__ float bflo(unsigned w) { return __uint_as_float(w << 16); }
__device__ __forceinline__ float bfhi(unsigned w) { return __uint_as_float(w & 0xffff0000u); }
__device__ __forceinline__ float fsigm(float x) { return __builtin_amdgcn_rcpf(1.f + __builtin_amdgcn_exp2f(-1.4426950408889634f * x)); }
__device__ __forceinline__ float fgelu(float x) { const float u = x * (1.5957691216057308f + 0.0713548162726009f * x * x); return x * fsigm(u); }

__device__ __forceinline__ void transpose_item(const float* __restrict__ W, int K, int N, bf16_t* __restrict__ WT, int row_off, LAS unsigned char* scr, int item, int lane) {
    const int nblk = N / 64, kb = item / nblk, nb = item % nblk, k0 = 64 * kb, n0 = 64 * nb;
    const int n4 = (lane & 15) * 4, kp = lane >> 4;
    const float* src = W + (size_t)(k0 + 2 * kp) * N + n0 + n4;
    f32x4 v[8][2];
#pragma unroll
    for (int i = 0; i < 8; ++i) { v[i][0] = __builtin_nontemporal_load((const f32x4*)(src + (size_t)(8 * i) * N)); v[i][1] = __builtin_nontemporal_load((const f32x4*)(src + (size_t)(8 * i + 1) * N)); }
#pragma unroll
    for (int i = 0; i < 8; ++i) { const int k = 8 * i + 2 * kp;
#pragma unroll
        for (int j = 0; j < 4; ++j) *(LAS unsigned*)(scr + (n4 + j) * 144 + k * 2) = cvt_pk_bf16(v[i][0][j], v[i][1][j]); }
    LDS_WAIT(); asm volatile("" ::: "memory");
    const int ch = lane & 7;
#pragma unroll
    for (int j = 0; j < 8; ++j) { const int n = (lane >> 3) + 8 * j;
        const v4u o = *(const LAS v4u*)(scr + n * 144 + ch * 16);
        *(GAS v4u*)(WT + (size_t)(row_off + n0 + n) * K + k0 + 8 * ch) = o; }
    LDS_WAIT(); asm volatile("" ::: "memory");
}
__device__ __forceinline__ void convert_layer(const Frame& F, int l) {
    LAS unsigned char* scr = F.lds + F.wave * 16384;
    constexpr int I_IN = 32 * 272, I_SQ = 32 * 32, I_F1 = 32 * 128, I_F2 = 128 * 32, I_LRU = 64 * 4;
    constexpr int NITEMS = I_IN + 4 * I_SQ + I_F1 + I_F2 + I_LRU;
    const float* w_in = inp<I_WIN>(F) + (size_t)l * D * INW; const float* w_ao = inp<I_WAO>(F) + (size_t)l * D * D; const float* w_lo = inp<I_WLO>(F) + (size_t)l * D * D;
    const float* w_co = inp<I_WCO>(F) + (size_t)l * D * D; const float* w_out = inp<I_WOUT>(F) + (size_t)l * D * D; const float* w_f1 = inp<I_WFF1>(F) + (size_t)l * D * DFF;
    const float* w_f2 = inp<I_WFF2>(F) + (size_t)l * DFF * D; const float* lwa = inp<I_LWA>(F) + (size_t)l * 2 * 16 * 16384; const float* lwx = inp<I_LWX>(F) + (size_t)l * 2 * 16 * 16384;
    for (int it = F.gw; it < NITEMS; it += F.NGW) {
        int r = it;
        if (r < I_IN) { transpose_item(w_in, D, INW, F.WIN(), 0, scr, r, F.lane); continue; } r -= I_IN;
        if (r < I_SQ) { transpose_item(w_ao, D, D, F.WBR(), 0, scr, r, F.lane); continue; } r -= I_SQ;
        if (r < I_SQ) { transpose_item(w_lo, D, D, F.WBR(), D, scr, r, F.lane); continue; } r -= I_SQ;
        if (r < I_SQ) { transpose_item(w_co, D, D, F.WBR(), 2 * D, scr, r, F.lane); continue; } r -= I_SQ;
        if (r < I_SQ) { transpose_item(w_out, D, D, F.WOUT(), 0, scr, r, F.lane); continue; } r -= I_SQ;
        if (r < I_F1) { transpose_item(w_f1, D, DFF, F.WFF1(), 0, scr, r, F.lane); continue; } r -= I_F1;
        if (r < I_F2) { transpose_item(w_f2, DFF, D, F.WFF2(), 0, scr, r, F.lane); continue; } r -= I_F2;
        { const int bi = r >> 2, sub = r & 3, d = bi >> 5, mat = (bi >> 4) & 1, blk = bi & 15;
          const float* src = (mat ? lwx : lwa) + ((size_t)d * 16 + blk) * 16384;
          transpose_item(src, 128, 128, F.WLRU() + (size_t)bi * 16384, 0, scr, sub, F.lane); }
    }
    const float* cw = inp<I_CMWS>(F) + (size_t)l * 16 * 16384;
    for (int i = (F.gw * 64 + F.lane) * 8; i < 16 * 16384; i += F.NGW * 64 * 8) {
        const f32x4 a = *(const f32x4*)(cw + i), b = *(const f32x4*)(cw + i + 4);
        v4u o; o.x = pk2(a.x, a.y); o.y = pk2(a.z, a.w); o.z = pk2(b.x, b.y); o.w = pk2(b.z, b.w);
        *(v4u*)(F.CMW() + i) = o;
    }
}
__device__ __forceinline__ void mod_partials(const Frame& F) {
    LAS float* scr = (LAS float*)(F.lds + F.wave * 16384);
    const float* cctx = inp<I_CCTX>(F); const float* cc = inp<I_C>(F); const float* wmod = inp<I_WMOD>(F);
    for (int it = F.gw; it < DEPTH * 48 * NMODK; it += F.NGW) {
        const int kc = it % NMODK, jb = (it / NMODK) % 48, l = it / (NMODK * 48), k0 = kc * 64;
        for (int e = F.lane; e < NCOND * 64; e += 64) { const int ci = e >> 6, kk = e & 63; const float v = ci == 0 ? cctx[k0 + kk] : cc[(ci - 1) * D + k0 + kk]; scr[e] = v * (1.f / (1.f + __expf(-v))); }
        LDS_WAIT(); asm volatile("" ::: "memory");
        f32x4 acc[NCOND];
#pragma unroll
        for (int ci = 0; ci < NCOND; ++ci) acc[ci] = (f32x4){0.f, 0.f, 0.f, 0.f};
        const float* wp = wmod + ((size_t)l * D + k0) * 12288 + jb * 256 + F.lane * 4;
#pragma unroll
        for (int kb = 0; kb < 64; kb += 16) {
            f32x4 w[16];
#pragma unroll
            for (int kk = 0; kk < 16; ++kk) w[kk] = *(const f32x4*)(wp + (size_t)(kb + kk) * 12288);
#pragma unroll
            for (int kk = 0; kk < 16; ++kk)
#pragma unroll
                for (int ci = 0; ci < NCOND; ++ci) acc[ci] += w[kk] * scr[ci * 64 + kb + kk];
        }
#pragma unroll
        for (int ci = 0; ci < NCOND; ++ci) *(f32x4*)(F.MODP() + (((size_t)kc * DEPTH + l) * NCOND + ci) * 12288 + jb * 256 + F.lane * 4) = acc[ci];
        LDS_WAIT(); asm volatile("" ::: "memory");
    }
}
__device__ __forceinline__ void mod_reduce(const Frame& F) {
    constexpr int NEL = DEPTH * NCOND * 12288;
    for (int i = (F.gw * 64 + F.lane) * 4; i < NEL; i += F.NGW * 64 * 4) {
        const int l = i / (NCOND * 12288), j = i % 12288;
        f32x4 s = *(const f32x4*)(inp<I_BMOD>(F) + (size_t)l * 12288 + j);
#pragma unroll
        for (int kc = 0; kc < NMODK; ++kc) s += *(const f32x4*)(F.MODP() + (size_t)kc * NEL + i);
        *(f32x4*)(F.MOD() + i) = s;
    }
}
__device__ __forceinline__ void rope_table(const Frame& F) {
    if (F.bx == 0) for (int e = F.tid; e < 2048; e += NWAVES * 64) {
        const int pos = e >> 5, f = e & 31; const float inv = exp2f(-(float)f * (13.287712379549449f / 32.f)); float s, c; sincosf((float)pos * inv, &s, &c);
        F.ROPE()[e] = c; F.ROPE()[2048 + e] = s; }
}
struct RowIn { f32x4 x[4][2]; u32x4 f[4]; float st; };
template <bool HAS_F>
__device__ __forceinline__ void row_load(const Frame& F, RowIn& R, const float* xsrc, const bf16_t* frow, const float* fstat) {
#pragma unroll
    for (int j = 0; j < 4; ++j) { const int e = (j * 64 + F.lane) * 8; R.x[j][0] = __builtin_nontemporal_load((const f32x4*)(xsrc + e)); R.x[j][1] = __builtin_nontemporal_load((const f32x4*)(xsrc + e + 4)); }
    if (HAS_F) {
#pragma unroll
        for (int j = 0; j < 4; ++j) R.f[j] = __builtin_nontemporal_load((const u32x4*)(frow + (j * 64 + F.lane) * 8));
        R.st = F.lane < 32 ? fstat[F.lane] : 0.f;
    }
}
template <bool HAS_F, bool HAS_H>
__device__ __forceinline__ void row_apply(const Frame& F, RowIn& R, float* xdst, const float* gate, const float* gpost, const float* gpre, const float* sc, const float* sh, bf16_t* hrow, float gs) {
    if (HAS_F) {
        const float rs = rsqrtf(wave_sum(R.st) * (1.f / D) + EPS) * gs;
#pragma unroll
        for (int j = 0; j < 4; ++j) { const int e = (j * 64 + F.lane) * 8; const u32x4 fw = R.f[j];
            const f32x4 g0 = *(const f32x4*)(gate + e), g1 = *(const f32x4*)(gate + e + 4), p0 = *(const f32x4*)(gpost + e), p1 = *(const f32x4*)(gpost + e + 4);
            const f32x4 f0 = {bflo(fw.x), bfhi(fw.x), bflo(fw.y), bfhi(fw.y)}, f1 = {bflo(fw.z), bfhi(fw.z), bflo(fw.w), bfhi(fw.w)};
            R.x[j][0] += g0 * (f0 * rs * p0); R.x[j][1] += g1 * (f1 * rs * p1); }
    }
#pragma unroll
    for (int j = 0; j < 4; ++j) { const int e = (j * 64 + F.lane) * 8; __builtin_nontemporal_store(R.x[j][0], (f32x4*)(xdst + e)); __builtin_nontemporal_store(R.x[j][1], (f32x4*)(xdst + e + 4)); }
    if (HAS_H) {
        float ss = 0.f;
#pragma unroll
        for (int j = 0; j < 4; ++j)
#pragma unroll
            for (int h = 0; h < 2; ++h) ss += (R.x[j][h].x * R.x[j][h].x + R.x[j][h].y * R.x[j][h].y) + (R.x[j][h].z * R.x[j][h].z + R.x[j][h].w * R.x[j][h].w);
        const float rs = rsqrtf(wave_sum(ss) * (1.f / D) + EPS);
#pragma unroll
        for (int j = 0; j < 4; ++j) { const int e = (j * 64 + F.lane) * 8;
            f32x4 o[2];
#pragma unroll
            for (int h = 0; h < 2; ++h) { const f32x4 g = *(const f32x4*)(gpre + e + 4 * h), s1 = *(const f32x4*)(sc + e + 4 * h), s0 = *(const f32x4*)(sh + e + 4 * h); o[h] = R.x[j][h] * rs * g * (s1 + 1.f) + s0; }
            u32x4 w; w.x = cvt_pk_bf16(o[0].x, o[0].y); w.y = cvt_pk_bf16(o[0].z, o[0].w); w.z = cvt_pk_bf16(o[1].x, o[1].y); w.w = cvt_pk_bf16(o[1].z, o[1].w);
            *(u32x4*)(hrow + e) = w; }
    }
}
__device__ __forceinline__ int cond_of_row(int m) { return m < MP ? 0 : 1 + ((m - MP) >> 11); }
template <int MODE>
__device__ __forceinline__ void rowlocal_phase(const Frame& F, int l, float gs = 1.f) {
    const float* xp = inp<I_XP>(F); const float* xs = inp<I_XS>(F);
    const float* gpost = MODE == 1 ? inp<I_GPOM>(F) + (size_t)l * D : inp<I_GPOF>(F) + (size_t)l * D;
    const float* gpre = MODE == 0 ? inp<I_GPM>(F) : MODE == 1 ? inp<I_GPF>(F) + (size_t)l * D : inp<I_GPM>(F) + (size_t)(l + 1 < DEPTH ? l + 1 : l) * D;
    float* X = F.x(); const bf16_t* Fb = F.Fb(); const float* FS = F.FSTAT(); bf16_t* H = F.H(); const float* MODb = F.MOD();
    constexpr bool HAS_F = MODE != 0;
    RowIn A, B;
    auto src = [&](int m) -> const float* { return MODE == 0 ? (m < MP ? xp + (size_t)m * D : xs + (size_t)(m - MP) * D) : X + (size_t)m * D; };
    int m = F.gw;
    if (m < M) row_load<HAS_F>(F, A, src(m), Fb + (size_t)m * D, FS + (size_t)m * 32);
    for (; m < M; m += 2 * F.NGW) {
#pragma unroll
        for (int half = 0; half < 2; ++half) {
            const int mc = m + half * F.NGW, mn = mc + F.NGW;
            if (mc >= M) break;
            RowIn& cur = half ? B : A; RowIn& nxt = half ? A : B;
            if (mn < M) row_load<HAS_F>(F, nxt, src(mn), Fb + (size_t)mn * D, FS + (size_t)mn * 32);
            const int ci = cond_of_row(mc);
            const float* modl = MODb + ((size_t)l * NCOND + ci) * 12288;
            float* xrow = X + (size_t)mc * D; bf16_t* hrow = H + (size_t)mc * D;
            if (MODE == 0) row_apply<false, true>(F, cur, xrow, nullptr, nullptr, gpre, modl + 1 * D, modl + 0 * D, hrow, gs);
            else if (MODE == 1) row_apply<true, true>(F, cur, xrow, modl + 2 * D, gpost, gpre, modl + 4 * D, modl + 3 * D, hrow, gs);
            else if (l + 1 < DEPTH) { const float* modn = MODb + ((size_t)(l + 1) * NCOND + ci) * 12288; row_apply<true, true>(F, cur, xrow, modl + 5 * D, gpost, gpre, modn + 1 * D, modn + 0 * D, hrow, gs); }
            else row_apply<true, false>(F, cur, xrow, modl + 5 * D, gpost, nullptr, nullptr, nullptr, nullptr, gs);
        }
    }
}
__device__ __forceinline__ u32x4 pack8(const f32x4& a, const f32x4& b) { u32x4 w; w.x = cvt_pk_bf16(a[0], a[1]); w.y = cvt_pk_bf16(a[2], a[3]); w.z = cvt_pk_bf16(b[0], b[1]); w.w = cvt_pk_bf16(b[2], b[3]); return w; }
typedef float f32x2 __attribute__((ext_vector_type(2)));
__device__ __forceinline__ f32x2 sigm2(f32x2 x) { const f32x2 t = x * -1.4426950408889634f; const f32x2 e = (f32x2){__builtin_amdgcn_exp2f(t.x), __builtin_amdgcn_exp2f(t.y)} + 1.f; return (f32x2){__builtin_amdgcn_rcpf(e.x), __builtin_amdgcn_rcpf(e.y)}; }
__device__ __forceinline__ f32x2 gelu2(f32x2 x) { const f32x2 t = x * ((x * x) * -0.10294324f + -2.3022082f);
    const f32x2 e = (f32x2){__builtin_amdgcn_exp2f(t.x), __builtin_amdgcn_exp2f(t.y)} + 1.f; return x * (f32x2){__builtin_amdgcn_rcpf(e.x), __builtin_amdgcn_rcpf(e.y)}; }
__device__ __forceinline__ f32x4 gelu4(const f32x4& v) { const f32x2 a = gelu2((f32x2){v[0], v[1]}), b = gelu2((f32x2){v[2], v[3]}); return (f32x4){a.x, a.y, b.x, b.y}; }
__device__ __forceinline__ f32x4 sigm4(const f32x4& v) { const f32x2 a = sigm2((f32x2){v[0], v[1]}), b = sigm2((f32x2){v[2], v[3]}); return (f32x4){a.x, a.y, b.x, b.y}; }
__device__ __forceinline__ int kv_row(int m) { return m < MP ? m : MP + ((m - MP) >> 11) * 2304 + ((m - MP) & 2047); }
struct EpiIn {
    static constexpr bool PERM = true, AFTER_DRAIN = false;
    bf16_t* Z; bf16_t* VALL; float* new_v; float* cvstat; int layer;
    __device__ __forceinline__ void operator()(const f32x4 (&acc)[2][2][4][2], const Unit& u, int wr, int wc, int fr, int fq) const {
        const int pn = u.pn, row0 = u.pm * 256 + wr * 64 + fr, cl = wc * 32 + 8 * fq;
        if (pn >= 10 && pn < 12) {
            const int colv = (pn - 10) * 256 + cl;
#pragma unroll
            for (int ai = 0; ai < 2; ++ai)
#pragma unroll
                for (int m = 0; m < 4; ++m) { const int row = row0 + ai * 128 + m * 16; bf16_t* dst = VALL + (size_t)kv_row(row) * 512 + colv;
#pragma unroll
                    for (int bj = 0; bj < 2; ++bj) { *(u32x4*)(dst + bj * 128) = pack8(acc[ai][bj][m][0], acc[ai][bj][m][1]);
                        if (row < MP) { float* nv = new_v + ((size_t)((row >> 8) * DEPTH + layer) * 256 + (row & 255)) * 512 + colv + bj * 128; *(f32x4*)nv = acc[ai][bj][m][0]; *(f32x4*)(nv + 4) = acc[ai][bj][m][1]; } } }
            return;
        }
        const int mode = (pn < 20) ? 0 : (pn < 36) ? 1 : (pn < 44) ? 2 : 3;
        const int col0 = pn * 256 + cl;
#pragma unroll
        for (int ai = 0; ai < 2; ++ai)
#pragma unroll
            for (int m = 0; m < 4; ++m) { const int row = row0 + ai * 128 + m * 16; bf16_t* dst = Z + (size_t)row * INW + col0; float ss = 0.f;
#pragma unroll
                for (int bj = 0; bj < 2; ++bj) { f32x4 v0 = acc[ai][bj][m][0], v1 = acc[ai][bj][m][1];
                    if (mode == 1 || mode == 2) { v0 = gelu4(v0); v1 = gelu4(v1); }
                    if (mode == 3) { v0 = sigm4(v0); v1 = sigm4(v1); }
                    if (mode == 2) ss += (v0[0] * v0[0] + v0[1] * v0[1]) + (v0[2] * v0[2] + v0[3] * v0[3]) + (v1[0] * v1[0] + v1[1] * v1[1]) + (v1[2] * v1[2] + v1[3] * v1[3]);
                    *(u32x4*)(dst + bj * 128) = pack8(v0, v1); }
                if (mode == 2) { ss += __shfl_xor(ss, 16); ss += __shfl_xor(ss, 32); if (fq == 0) cvstat[(size_t)row * 32 + (pn - 36) * 4 + wc] = ss; } }
    }
};
struct EpiRelu2 {
    static constexpr bool PERM = true, AFTER_DRAIN = false;
    bf16_t* O; int ldc;
    __device__ __forceinline__ void operator()(const f32x4 (&acc)[2][2][4][2], const Unit& u, int wr, int wc, int fr, int fq) const {
        const int row0 = u.pm * 256 + wr * 64 + fr, col0 = u.pn * 256 + wc * 32 + 8 * fq;
#pragma unroll
        for (int ai = 0; ai < 2; ++ai)
#pragma unroll
            for (int m = 0; m < 4; ++m) { bf16_t* dst = O + (size_t)(row0 + ai * 128 + m * 16) * ldc + col0;
#pragma unroll
                for (int bj = 0; bj < 2; ++bj) { f32x4 v0 = __builtin_elementwise_max(acc[ai][bj][m][0], (f32x4){0.f, 0.f, 0.f, 0.f}), v1 = __builtin_elementwise_max(acc[ai][bj][m][1], (f32x4){0.f, 0.f, 0.f, 0.f});
                    *(u32x4*)(dst + bj * 128) = pack8(v0 * v0, v1 * v1); } }
    }
};
struct EpiF {
    static constexpr bool PERM = true, AFTER_DRAIN = false;
    bf16_t* O; float* stat;
    __device__ __forceinline__ void operator()(const f32x4 (&acc)[2][2][4][2], const Unit& u, int wr, int wc, int fr, int fq) const {
        const int row0 = u.pm * 256 + wr * 64 + fr, col0 = u.pn * 256 + wc * 32 + 8 * fq;
#pragma unroll
        for (int ai = 0; ai < 2; ++ai)
#pragma unroll
            for (int m = 0; m < 4; ++m) { const int row = row0 + ai * 128 + m * 16; bf16_t* dst = O + (size_t)row * D + col0; float ss = 0.f;
#pragma unroll
                for (int bj = 0; bj < 2; ++bj) { const f32x4 v0 = acc[ai][bj][m][0], v1 = acc[ai][bj][m][1];
                    ss += (v0[0] * v0[0] + v0[1] * v0[1]) + (v0[2] * v0[2] + v0[3] * v0[3]) + (v1[0] * v1[0] + v1[1] * v1[1]) + (v1[2] * v1[2] + v1[3] * v1[3]);
                    *(u32x4*)(dst + bj * 128) = pack8(v0, v1); }
                ss += __shfl_xor(ss, 16); ss += __shfl_xor(ss, 32); if (fq == 0) stat[(size_t)row * 32 + u.pn * 4 + wc] = ss; }
    }
};
struct EpiMerge {
    static constexpr bool PERM = true, AFTER_DRAIN = false;
    const bf16_t* Z; float* scr  ; bf16_t* O;
    __device__ __forceinline__ void operator()(const f32x4 (&acc)[2][2][4][2], const Unit& u, int wr, int wc, int fr, int fq) const {
        const int br = u.pn >> 3, pn = u.pn & 7, pm = u.pm - 96 * br;
        const int rl0 = wr * 64 + fr, cl = wc * 32 + 8 * fq;
#pragma unroll
        for (int ai = 0; ai < 2; ++ai)
#pragma unroll
            for (int m = 0; m < 4; ++m) { const int rl = rl0 + ai * 128 + m * 16, row = pm * 256 + rl;
#pragma unroll
                for (int bj = 0; bj < 2; ++bj) { const int c = cl + bj * 128;
                    const u32x4 gw = *(const u32x4*)(Z + (size_t)row * INW + OFF_G + br * D + pn * 256 + c);
                    const f32x4 g0 = {bflo(gw.x), bfhi(gw.x), bflo(gw.y), bfhi(gw.y)}, g1 = {bflo(gw.z), bfhi(gw.z), bflo(gw.w), bfhi(gw.w)};
                    f32x4 v0 = g0 * acc[ai][bj][m][0], v1 = g1 * acc[ai][bj][m][1];
                    float* sp = scr + rl * 256 + c;
                    if (br > 0) { v0 += *(const f32x4*)sp; v1 += *(const f32x4*)(sp + 4); }
                    if (br < 2) { *(f32x4*)sp = v0; *(f32x4*)(sp + 4) = v1; }
                    else *(u32x4*)(O + (size_t)row * D + pn * 256 + c) = pack8(v0, v1); } }
    }
};
struct MergeOrder {
    pg8::StaticOrder so;
    __device__ void init(int G, int c) { so.init(M, D, G, c); }
    __device__ bool next(int i, Unit& u) const { const int br = i % 3; if (!so.next(i / 3, u)) return false; u.pm += 96 * br; u.pn += 8 * br; return true; }
    __device__ __forceinline__ void a_ready(const Unit&) const {}
    __device__ __forceinline__ void done(const Unit&) const {}
};
}
namespace fk {
typedef short bf16x8 __attribute__((ext_vector_type(8)));
__device__ __forceinline__ void prep_row(const Frame& F, int m, int l) {
    const bool sample = m >= MP; int b, t;
    if (!sample) { b = m >> 8; t = m & 255; } else { b = (m - MP) >> 11; t = (m - MP) & 2047; }
    const int kvrow = sample ? MP + b * 2304 + t : m;
    const int lane = F.lane, g8 = lane >> 3, j = lane & 7, axis = g8 & 1, hsel = lane >> 4;
    bf16_t* zrow = F.Z() + (size_t)m * INW;
    const int dA = axis * 64 + 4 * j, dB = dA + 32;
    const f32x4 gqa = *(const f32x4*)(inp<I_GQ>(F) + l * 128 + dA), gqb = *(const f32x4*)(inp<I_GQ>(F) + l * 128 + dB);
    const f32x4 gka = *(const f32x4*)(inp<I_GK>(F) + l * 128 + dA), gkb = *(const f32x4*)(inp<I_GK>(F) + l * 128 + dB);
    f32x4 cs = {1.f, 1.f, 1.f, 1.f}, sn = {0.f, 0.f, 0.f, 0.f};
    if (sample) { const int pos = axis == 0 ? (t >> 6) : (t & 63); cs = *(const f32x4*)(F.ROPE() + pos * 32 + 4 * j); sn = *(const f32x4*)(F.ROPE() + 2048 + pos * 32 + 4 * j); }
#pragma unroll
    for (int pass = 0; pass < 5; ++pass) {
        const bool isq = pass < 4;
        const int base = isq ? OFF_Q + (pass * 4 + hsel) * 128 + dA : OFF_K + hsel * 128 + dA;
        const u32x2 wa = *(const u32x2*)(zrow + base), wb = *(const u32x2*)(zrow + base + 32);
        const f32x4 xa = {bflo(wa.x), bfhi(wa.x), bflo(wa.y), bfhi(wa.y)}, xb = {bflo(wb.x), bfhi(wb.x), bflo(wb.y), bfhi(wb.y)};
        float ss = (xa.x * xa.x + xa.y * xa.y) + (xa.z * xa.z + xa.w * xa.w) + (xb.x * xb.x + xb.y * xb.y) + (xb.z * xb.z + xb.w * xb.w);
        ss += __shfl_xor(ss, 1); ss += __shfl_xor(ss, 2); ss += __shfl_xor(ss, 4); ss += __shfl_xor(ss, 8);
        const float rs = rsqrtf(ss * (1.f / 128.f) + EPS);
        const f32x4 na = xa * rs * (isq ? gqa : gka), nb = xb * rs * (isq ? gqb : gkb);
        const f32x4 ra = na * cs - nb * sn, rb = na * sn + nb * cs;
        u32x2 oa, ob; oa.x = cvt_pk_bf16(ra.x, ra.y); oa.y = cvt_pk_bf16(ra.z, ra.w); ob.x = cvt_pk_bf16(rb.x, rb.y); ob.y = cvt_pk_bf16(rb.z, rb.w);
        if (isq) { *(u32x2*)(zrow + base) = oa; *(u32x2*)(zrow + base + 32) = ob; }
        else {
            bf16_t* kd = F.KALL() + (size_t)kvrow * 512 + hsel * 128 + dA; *(u32x2*)kd = oa; *(u32x2*)(kd + 32) = ob;
            if (!sample) { float* nk = F.new_k() + ((size_t)(b * DEPTH + l) * 256 + t) * 512 + hsel * 128 + dA; *(f32x4*)nk = na; *(f32x4*)(nk + 32) = nb; }
        }
    }
}
__device__ __forceinline__ void prep_phase(const Frame& F, int l) {
    for (int m = F.gw; m < M; m += F.NGW) prep_row(F, m, l);
    for (int it = F.gw; it < 2 * 8 * 256; it += F.NGW) {
        const int which = it >> 11, b = (it >> 8) & 7, p = it & 255;
        const float* src = (which ? inp<I_CV>(F) : inp<I_CK>(F)) + ((size_t)(b * DEPTH + l) * 256 + p) * 512 + F.lane * 8;
        bf16_t* dst = (which ? F.VALL() : F.KALL()) + (size_t)(MP + b * 2304 + 2048 + p) * 512 + F.lane * 8;
        const f32x4 a = *(const f32x4*)src, c = *(const f32x4*)(src + 4);
        *(u32x4*)dst = pack8(a, c);
    }
}
__device__ __forceinline__ int crow(int r, int hi) { return (r & 3) + 8 * (r >> 2) + 4 * hi; }
struct LruCtx {
    bf16x8 bw0[8], bw1[8];
    float bav, bxv, c8;
    bool small;
};
__device__ __forceinline__ void lru_ctx_load(const Frame& F, int l, int blk, LruCtx& X) {
    const int lane = F.lane, wave = F.wave, d = wave >> 2, n0 = (wave & 3) * 32, nl = lane & 31, hi = lane >> 5, C = blk * 128 + n0 + nl;
    const bf16_t* wb0 = F.WLRU() + ((size_t)((d * 2 + 0) * 16 + blk) * 128 + n0 + nl) * 128 + hi * 8;
    const bf16_t* wb1 = F.WLRU() + ((size_t)((d * 2 + 1) * 16 + blk) * 128 + n0 + nl) * 128 + hi * 8;
#pragma unroll
    for (int ks = 0; ks < 8; ++ks) { X.bw0[ks] = *(const bf16x8*)(wb0 + ks * 16); X.bw1[ks] = *(const bf16x8*)(wb1 + ks * 16); }
    X.bav = inp<I_LBA>(F)[(size_t)(l * 2 + d) * D + C]; X.bxv = inp<I_LBX>(F)[(size_t)(l * 2 + d) * D + C];
    const float lam = inp<I_LAM>(F)[(size_t)(l * 2 + d) * D + C];
    const float ex = __expf(-lam);
    const float sp = lam < -20.f ? -lam : ex < 0.05f ? ex * (1.f + ex * (-0.5f + ex * ((1.f / 3.f) + ex * (-0.25f + ex * 0.2f)))) : __logf(1.f + ex);
    X.c8 = -8.f * sp;
    X.small = __all(X.c8 > -0.5f);
}
struct LruGeo { int m0, b, t0, T; bool sample; };
__device__ __forceinline__ LruGeo lru_geo(int ck) { LruGeo g; g.m0 = ck * 64; g.sample = g.m0 >= MP;
    if (!g.sample) { g.b = g.m0 >> 8; g.t0 = g.m0 & 255; g.T = 256; } else { g.b = (g.m0 - MP) >> 11; g.t0 = (g.m0 - MP) & 2047; g.T = 2048; } return g; }
__device__ __forceinline__ void lru_conv_load(const Frame& F, f32x4 (&PF)[16], int t2, int ck, int blk, const float* __restrict__ cwl, const float* __restrict__ cbl) {
    const LruGeo G = lru_geo(ck); const int C0 = blk * 128; const bf16_t* Zb = F.Z();
    const int c4 = (t2 & 31) * 4, r0 = (t2 >> 5) * 8;
#pragma unroll
    for (int i = 0; i < 11; ++i) {
        const int tt = G.t0 + r0 + i - 2; u32x2 z = {0u, 0u};
        if (tt >= 0 && tt < G.T) z = *(const u32x2*)(Zb + (size_t)(G.m0 + r0 + i - 2) * INW + OFF_LX + C0 + c4);
        PF[i].x = __uint_as_float(z.x); PF[i].y = __uint_as_float(z.y);
    }
#pragma unroll
    for (int j = 0; j < 4; ++j) PF[11 + j] = *(const f32x4*)(cwl + (size_t)j * D + C0 + c4);
    PF[15] = *(const f32x4*)(cbl + C0 + c4);
}
__device__ __forceinline__ void lru_conv_math(const Frame& F, const f32x4 (&PF)[16], int t2) {
    LAS unsigned char* lds = F.lds; const int c4 = (t2 & 31) * 4, r0 = (t2 >> 5) * 8;
    f32x4 zr[11];
#pragma unroll
    for (int i = 0; i < 11; ++i) { const unsigned zx = __float_as_uint(PF[i].x), zy = __float_as_uint(PF[i].y); zr[i] = (f32x4){bflo(zx), bfhi(zx), bflo(zy), bfhi(zy)}; }
#pragma unroll
    for (int r = 0; r < 8; ++r) {
        const f32x4 y = PF[15] + zr[r] * PF[11] + zr[r + 1] * PF[12] + zr[r + 2] * PF[13] + zr[r + 3] * PF[14];
        u32x2 o; o.x = cvt_pk_bf16(y.x, y.y); o.y = cvt_pk_bf16(y.z, y.w);
        *(LAS u32x2*)(lds + LRU_XC + (r0 + r) * LRU_XC_PITCH + c4 * 2) = o;
    }
}
__device__ __forceinline__ void split_arrive(unsigned* cnt) {
    asm volatile("s_waitcnt vmcnt(0)" ::: "memory");
    __syncthreads();
    if (threadIdx.x == 0) { __builtin_amdgcn_fence(__ATOMIC_RELEASE, "agent"); asm volatile("s_waitcnt vmcnt(0)" ::: "memory"); (void)xb_add(cnt, 1u); }
}
__device__ __forceinline__ void split_wait(unsigned* cnt, unsigned G, unsigned* tmo) {
    if (threadIdx.x == 0) {
        unsigned sp = 0;
        while (xb_ld(cnt) < G) { __builtin_amdgcn_s_sleep(1); if ((++sp & 255u) == 0u) { if (xb_ld(tmo)) break; if (sp > XB_SPIN_CAP) { atomicAdd(tmo, 1u); break; } } }
        __builtin_amdgcn_fence(__ATOMIC_ACQUIRE, "agent"); asm volatile("s_waitcnt vmcnt(0)" ::: "memory");
    }
    __syncthreads();
}
__device__ __forceinline__ void lru_carry_phase(const Frame& F, int l) {
    const float* state_l = inp<I_SL>(F) + (size_t)l * 2 * D;
    const float* AGG = F.AGG(); float* CIN = F.CIN();
    for (int id = F.gw * 64 + F.lane; id < 40 * 2 * D; id += F.NGW * 64) {
        const int c = id & (D - 1), d = (id >> 11) & 1, sq = id >> 12;
        const bool sample = sq >= 32; const int ck0 = sample ? 128 + (sq - 32) * 32 : sq * 4;
        float carry = sample ? state_l[((size_t)(sq - 32) * DEPTH * 2 + d) * D + c] : 0.f;
        const float* ag = AGG + ((size_t)(ck0 * 2 + d) * D + c) * 2; float* ci = CIN + (size_t)(ck0 * 2 + d) * D + c;
        if (!sample) {
            float2 pe[4];
#pragma unroll
            for (int jj = 0; jj < 4; ++jj) pe[jj] = *(const float2*)(ag + (size_t)jj * 4 * D);
            if (d == 0) {
#pragma unroll
                for (int jj = 0; jj < 4; ++jj) { ci[(size_t)jj * 2 * D] = carry; carry = pe[jj].x * carry + pe[jj].y; } }
            else {
#pragma unroll
                for (int jj = 3; jj >= 0; --jj) { ci[(size_t)jj * 2 * D] = carry; carry = pe[jj].x * carry + pe[jj].y; } }
        } else {
            float2 pe[32];
#pragma unroll
            for (int jj = 0; jj < 32; ++jj) pe[jj] = *(const float2*)(ag + (size_t)jj * 4 * D);
            if (d == 0) {
#pragma unroll
                for (int jj = 0; jj < 32; ++jj) { ci[(size_t)jj * 2 * D] = carry; carry = pe[jj].x * carry + pe[jj].y; } }
            else {
#pragma unroll
                for (int jj = 31; jj >= 0; --jj) { ci[(size_t)jj * 2 * D] = carry; carry = pe[jj].x * carry + pe[jj].y; } }
        }
    }
}
__device__ __forceinline__ void lru_gates(const Frame& F, int lane, int wave, const LruCtx& X) {
    typedef float f32x2 __attribute__((ext_vector_type(2)));
    LAS unsigned char* lds = F.lds;
    const int d = wave >> 2, n0 = (wave & 3) * 32, nl = lane & 31, hi = lane >> 5, c = n0 + nl;
    LAS float* Ad = (LAS float*)(lds + (d ? LRU_A1 : LRU_A0)); LAS float* Bd = (LAS float*)(lds + (d ? LRU_B1 : LRU_B0));
    const float bav = X.bav, bxv = X.bxv, c8 = X.c8;
#pragma unroll
    for (int mt = 0; mt < 2; ++mt) {
        f32x16 acc0, acc1;
#pragma unroll
        for (int r = 0; r < 16; ++r) { acc0[r] = 0.f; acc1[r] = 0.f; }
        const LAS unsigned char* ap = lds + LRU_XC + (mt * 32 + nl) * LRU_XC_PITCH + hi * 16;
#pragma unroll
        for (int ks = 0; ks < 8; ++ks) {
            const bf16x8 a0 = *(const LAS bf16x8*)(ap + ks * 32);
            acc0 = __builtin_amdgcn_mfma_f32_32x32x16_bf16(a0, X.bw0[ks], acc0, 0, 0, 0);
            acc1 = __builtin_amdgcn_mfma_f32_32x32x16_bf16(a0, X.bw1[ks], acc1, 0, 0, 0);
        }
        if (X.small) {
#pragma unroll
            for (int r = 0; r < 16; r += 2) {
                const int tl = mt * 32 + crow(r, hi);
                const f32x2 pa = (f32x2){acc0[r], acc0[r + 1]} + bav, px = (f32x2){acc1[r], acc1[r + 1]} + bxv;
                const f32x2 ta = pa * -1.4426950408889634f, tx = px * -1.4426950408889634f;
                const f32x2 ea = (f32x2){__builtin_amdgcn_exp2f(ta.x), __builtin_amdgcn_exp2f(ta.y)} + 1.f, ex = (f32x2){__builtin_amdgcn_exp2f(tx.x), __builtin_amdgcn_exp2f(tx.y)} + 1.f;
                const f32x2 rg = {__builtin_amdgcn_rcpf(ea.x), __builtin_amdgcn_rcpf(ea.y)}, ig = {__builtin_amdgcn_rcpf(ex.x), __builtin_amdgcn_rcpf(ex.y)};
                const f32x2 la = rg * c8;
                f32x2 p = la * (1.f / 720.f) + (1.f / 120.f); p = p * la + (1.f / 24.f); p = p * la + (1.f / 6.f); p = p * la + 0.5f; p = p * la + 1.f;
                const f32x2 e1 = la * p;
                const f32x2 omr = (e1 + 2.f) * e1;
                const f32x2 sq = {__builtin_amdgcn_sqrtf(fmaxf(-omr.x, 0.f)), __builtin_amdgcn_sqrtf(fmaxf(-omr.y, 0.f))};
                const f32x2 xcv = {bf2f(*(const LAS unsigned short*)(lds + LRU_XC + tl * LRU_XC_PITCH + c * 2)), bf2f(*(const LAS unsigned short*)(lds + LRU_XC + (tl + 1) * LRU_XC_PITCH + c * 2))};
                const f32x2 av = e1 + 1.f, bt = sq * ig * xcv;
                Ad[tl * 128 + c] = av.x; Ad[(tl + 1) * 128 + c] = av.y; Bd[tl * 128 + c] = bt.x; Bd[(tl + 1) * 128 + c] = bt.y;
            }
        } else {
#pragma unroll
            for (int r = 0; r < 16; ++r) {
                const int tl = mt * 32 + crow(r, hi);
                const float rg = fsigm(acc0[r] + bav), ig = fsigm(acc1[r] + bxv);
                const float la = c8 * rg, a = __expf(la);
                const float mult = sqrtf(fmaxf(-expm1f(2.f * la), 0.f));
                const float xcv = bf2f(*(const LAS unsigned short*)(lds + LRU_XC + tl * LRU_XC_PITCH + c * 2));
                Ad[tl * 128 + c] = a; Bd[tl * 128 + c] = mult * ig * xcv;
            }
        }
    }
}
template <int PASS>
__device__ __forceinline__ void lru_scan(const Frame& F, int tid, float carry, int l, int ck, int blk, float* __restrict__ AGG) {
    LAS unsigned char* lds = F.lds; const LruGeo G = lru_geo(ck);
    const int d = tid >> 7, c = tid & 127, C = blk * 128 + c;
    const LAS float* Ad = (const LAS float*)(lds + (d ? LRU_A1 : LRU_A0)); LAS float* Bd = (LAS float*)(lds + (d ? LRU_B1 : LRU_B0));
    if (PASS == 1) {
        float h = 0.f, Pp = 1.f;
        if (d == 0) {
#pragma unroll 16
            for (int s = 0; s < 64; ++s) { const float a = Ad[s * 128 + c]; h = a * h + Bd[s * 128 + c]; Pp *= a; }
        } else {
#pragma unroll 16
            for (int s = 0; s < 64; ++s) { const float a = Ad[(63 - s) * 128 + c]; h = a * h + Bd[(63 - s) * 128 + c]; Pp *= a; }
        }
        *(float2*)(AGG + ((size_t)(ck * 2 + d) * D + C) * 2) = make_float2(Pp, h);
    } else {
        const int jc = G.t0 >> 6, nch = G.T >> 6;
        float h = carry;
        if (d == 0) {
#pragma unroll
            for (int s0 = 0; s0 < 64; s0 += 16) { float av[16], bv[16];
#pragma unroll
                for (int i = 0; i < 16; ++i) { av[i] = Ad[(s0 + i) * 128 + c]; bv[i] = Bd[(s0 + i) * 128 + c]; }
#pragma unroll
                for (int i = 0; i < 16; ++i) { h = av[i] * h + bv[i]; bv[i] = h; }
#pragma unroll
                for (int i = 0; i < 16; ++i) Bd[(s0 + i) * 128 + c] = bv[i]; }
        } else {
#pragma unroll
            for (int s0 = 0; s0 < 64; s0 += 16) { float av[16], bv[16];
#pragma unroll
                for (int i = 0; i < 16; ++i) { av[i] = Ad[(63 - s0 - i) * 128 + c]; bv[i] = Bd[(63 - s0 - i) * 128 + c]; }
#pragma unroll
                for (int i = 0; i < 16; ++i) { h = av[i] * h + bv[i]; bv[i] = h; }
#pragma unroll
                for (int i = 0; i < 16; ++i) Bd[(63 - s0 - i) * 128 + c] = bv[i]; }
        }
        if (!G.sample && ((d == 0 && jc == nch - 1) || (d == 1 && jc == 0))) F.new_s()[((size_t)(G.b * DEPTH + l) * 2 + d) * D + C] = h;
    }
}
__device__ __forceinline__ void lru_out(const Frame& F, int tid, int ck, int blk, const u32x4& g0, const u32x4& g1) {
    LAS unsigned char* lds = F.lds; const int m0 = ck * 64, C0 = blk * 128;
    const int row = tid >> 3, c16 = (tid & 7) * 16;
    const LAS float* h0 = (const LAS float*)(lds + LRU_B0) + row * 128 + c16; const LAS float* h1 = (const LAS float*)(lds + LRU_B1) + row * 128 + c16;
    const unsigned gw[8] = {g0.x, g0.y, g0.z, g0.w, g1.x, g1.y, g1.z, g1.w};
    unsigned ow[8];
#pragma unroll
    for (int i = 0; i < 8; ++i) ow[i] = cvt_pk_bf16((h0[2 * i] + h1[2 * i]) * bflo(gw[i]), (h0[2 * i + 1] + h1[2 * i + 1]) * bfhi(gw[i]));
    bf16_t* yp = F.BR() + (size_t)1 * M * D + (size_t)(m0 + row) * D + C0 + c16;
    *(u32x4*)yp = (u32x4){ow[0], ow[1], ow[2], ow[3]}; *(u32x4*)(yp + 8) = (u32x4){ow[4], ow[5], ow[6], ow[7]};
}
template <int PASS>
__device__ __forceinline__ void lru_phase(const Frame& F, int l) {
    LruCtx X; int cur = -1;
    float* AGG = F.AGG(); const float* CIN = F.CIN();
    const float* cwl = inp<I_CW>(F) + (size_t)l * 4 * D; const float* cbl = inp<I_CB>(F) + (size_t)l * D;
    constexpr int NU = 384 * 16;
    int u = F.bx;
    if (u < NU && F.tid >= 256) { f32x4 PF[16]; lru_conv_load(F, PF, F.tid - 256, u >> 4, u & 15, cwl, cbl); lru_conv_math(F, PF, F.tid - 256); }
    __syncthreads();
    for (; u < NU; u += F.G) {
        int tid_ = F.tid; asm volatile("" : "+v"(tid_));
        const int tid = tid_, lane = tid & 63, wave = __builtin_amdgcn_readfirstlane(tid >> 6);
        const int blk = u & 15, ck = u >> 4, un = u + F.G;
        if (blk != cur) { lru_ctx_load(F, l, blk, X); cur = blk; }
        u32x4 g0 = {0u, 0u, 0u, 0u}, g1 = {0u, 0u, 0u, 0u};
        const bf16_t* gp = F.Z() + (size_t)(ck * 64 + (tid >> 3)) * INW + OFF_LG + blk * 128 + (tid & 7) * 16;
        if (wave < 4) {
            float carry = 0.f;
            if (PASS == 2) carry = CIN[(size_t)(ck * 2 + (tid >> 7)) * D + blk * 128 + (tid & 127)];
            lru_gates(F, lane, wave, X);
            __syncthreads();
            if (PASS == 2) { g0 = *(const u32x4*)gp; g1 = *(const u32x4*)(gp + 8); }
            lru_scan<PASS>(F, tid, carry, l, ck, blk, AGG);
            __syncthreads();
        } else {
            f32x4 PF[16];
            if (un < NU) lru_conv_load(F, PF, tid - 256, un >> 4, un & 15, cwl, cbl);
            lru_gates(F, lane, wave, X);
            __syncthreads();
            if (PASS == 2) { g0 = *(const u32x4*)gp; g1 = *(const u32x4*)(gp + 8); }
            if (un < NU) lru_conv_math(F, PF, tid - 256);
            __syncthreads();
        }
        if (PASS == 2) { lru_out(F, tid, ck, blk, g0, g1); __syncthreads(); }
    }
}
constexpr int CM_V = 0, CM_OUT = 32768, CM_OUT_PITCH = 528, CM_RS2 = CM_OUT + 128 * CM_OUT_PITCH;
static_assert(CM_RS2 + 512 <= MISC_OFF, "cm lds map");
struct CmCtx { bf16x8 wa[8]; };
__device__ __forceinline__ void cm_ctx_load(const Frame& F, int g, CmCtx& X) {
    const int qt = F.wave & 3, xl = F.lane & 31, hi = F.lane >> 5;
    const bf16_t* wp = F.CMW() + ((size_t)g * 128 + qt * 32 + xl) * 128 + hi * 8;
#pragma unroll
    for (int i = 0; i < 8; ++i) X.wa[i] = *(const bf16x8*)(wp + i * 16);
}
__device__ __forceinline__ void cm_unit(const Frame& F, int cn, int g, const CmCtx& X, const float* __restrict__ cmg, const float* __restrict__ bsg) {
    int tid_ = F.tid; asm volatile("" : "+v"(tid_));
    const int tid = tid_, lane = tid & 63, wave = __builtin_amdgcn_readfirstlane(tid >> 6), m0 = cn * 128, C0 = g * 128;
    LAS unsigned char* lds = F.lds;
    LAS float* RS = (LAS float*)(lds + CM_RS2);
    const bf16_t* Zb = F.Z();
    if (tid < 128) { const float* st = F.CVSTAT() + (size_t)(m0 + tid) * 32; float s = 0.f;
#pragma unroll
        for (int i = 0; i < 32; i += 4) { const f32x4 v = *(const f32x4*)(st + i); s += (v.x + v.y) + (v.z + v.w); }
        RS[tid] = rsqrtf(s * (1.f / D) + EPS); }
    __syncthreads();
    {
        const int sr = tid >> 4, sc = (tid & 15) * 8;
        const f32x4 ga = *(const f32x4*)(cmg + C0 + sc), gb = *(const f32x4*)(cmg + C0 + sc + 4);
#pragma unroll
        for (int i = 0; i < 4; ++i) {
            const int p = (i >> 1) * 64 + (i & 1) * 32 + sr; const float rs = RS[p];
            const u32x4 w = *(const u32x4*)(Zb + (size_t)(m0 + p) * INW + OFF_CV + C0 + sc);
            const f32x4 v0 = (f32x4){bflo(w.x), bfhi(w.x), bflo(w.y), bfhi(w.y)} * ga * rs, v1 = (f32x4){bflo(w.z), bfhi(w.z), bflo(w.w), bfhi(w.w)} * gb * rs;
            *(LAS u32x4*)(lds + CM_V + (i >> 1) * 16384 + att::v_st((i & 1) * 32 + sr, sc)) = pack8(v0, v1);
        }
    }
    __syncthreads();
    {
        const int qt = wave & 3, chh = wave >> 2, xl = lane & 31, hi = lane >> 5;
        f32x16 o0, o1;
#pragma unroll
        for (int r = 0; r < 16; ++r) { o0[r] = 0.f; o1[r] = 0.f; }
        const int vb = (int)(unsigned)(uintptr_t)(lds + CM_V) + att::v_rd_base(lane);
        if (chh == 0) {
            att::pv_one<0>(o0, vb, X.wa[0], X.wa[1], X.wa[2], X.wa[3]); att::pv_one<1>(o1, vb, X.wa[0], X.wa[1], X.wa[2], X.wa[3]);
            att::pv_one<0>(o0, vb + 16384, X.wa[4], X.wa[5], X.wa[6], X.wa[7]); att::pv_one<1>(o1, vb + 16384, X.wa[4], X.wa[5], X.wa[6], X.wa[7]);
        } else {
            att::pv_one<2>(o0, vb, X.wa[0], X.wa[1], X.wa[2], X.wa[3]); att::pv_one<3>(o1, vb, X.wa[0], X.wa[1], X.wa[2], X.wa[3]);
            att::pv_one<2>(o0, vb + 16384, X.wa[4], X.wa[5], X.wa[6], X.wa[7]); att::pv_one<3>(o1, vb + 16384, X.wa[4], X.wa[5], X.wa[6], X.wa[7]);
        }
#pragma unroll
        for (int r = 0; r < 16; ++r) { const int q = qt * 32 + crow(r, hi);
            *(LAS float*)(lds + CM_OUT + q * CM_OUT_PITCH + (chh * 64 + xl) * 4) = o0[r];
            *(LAS float*)(lds + CM_OUT + q * CM_OUT_PITCH + (chh * 64 + 32 + xl) * 4) = o1[r]; }
    }
    __syncthreads();
    {
        const int q = tid >> 2, c32 = (tid & 3) * 32; const float bias = bsg[q];
        const bf16_t* up = Zb + (size_t)(m0 + q) * INW + OFF_CU + C0 + c32;
        bf16_t* op = F.BR() + (size_t)2 * M * D + (size_t)(m0 + q) * D + C0 + c32;
#pragma unroll
        for (int i = 0; i < 4; ++i) {
            const u32x4 uw = *(const u32x4*)(up + i * 8);
            const f32x4 a = *(const LAS f32x4*)(lds + CM_OUT + q * CM_OUT_PITCH + (c32 + i * 8) * 4), b2 = *(const LAS f32x4*)(lds + CM_OUT + q * CM_OUT_PITCH + (c32 + i * 8 + 4) * 4);
            const f32x4 u0 = {bflo(uw.x), bfhi(uw.x), bflo(uw.y), bfhi(uw.y)}, u1 = {bflo(uw.z), bfhi(uw.z), bflo(uw.w), bfhi(uw.w)};
            *(u32x4*)(op + i * 8) = pack8(u0 * (a + bias), u1 * (b2 + bias));
        }
    }
}
__device__ __forceinline__ void cm_phase(const Frame& F, int l) {
    CmCtx X; int cur = -1;
    const float* cmg = inp<I_CMG>(F) + (size_t)l * D; const float* bs = inp<I_CMBS>(F) + (size_t)l * 16 * 128;
    for (int u = F.bx; u < 192 * 16; u += F.G) {
        const int g = u & 15, cn = u >> 4;
        if (g != cur) { cm_ctx_load(F, g, X); cur = g; }
        cm_unit(F, cn, g, X, cmg, bs + g * 128);
    }
    __syncthreads();
}
__device__ __forceinline__ void attn_phase(const Frame& F) {
    char* lds = (char*)F.lds;
    const att::bf16* Z = (const att::bf16*)F.Z(); const att::bf16* K = (const att::bf16*)F.KALL(); const att::bf16* V = (const att::bf16*)F.VALL(); att::bf16* O = (att::bf16*)F.BR();
    for (int id = F.vcu; id < 1536; id += F.G) {
        size_t qrow, kvrow; int h, nkeys;
        if (id < 1024) { const int qb = id & 7, b = id >> 7; h = (id >> 3) & 15; qrow = (size_t)MP + (size_t)b * 2048 + qb * 256; kvrow = (size_t)MP + (size_t)b * 2304; nkeys = 2304; }
        else { const int id2 = id - 1024, b = id2 >> 4; h = id2 & 15; qrow = (size_t)b * 256; kvrow = qrow; nkeys = 256; }
        att::attn_dense_body<att::bf16>(Z + qrow * INW + OFF_Q + h * 128, K + kvrow * 512 + (h >> 2) * 128, V + kvrow * 512 + (h >> 2) * 128, O + qrow * D + h * 128, nkeys, lds);
    }
    __syncthreads();
}
}
#ifndef REP_G
#define REP_G 1
#endif
#ifndef REP_A
#define REP_A 1
#endif
#ifndef REP_L
#define REP_L 1
#endif
#ifndef REP_V
#define REP_V 1
#endif
#ifndef REP_R
#define REP_R 1
#endif
#ifndef REP_GSEL
#define REP_GSEL 0
#endif
#ifndef REP_B
#define REP_B 1
#endif
#ifndef PG_ALIGN
#define PG_ALIGN true
#endif
#ifndef REP_C
#define REP_C 1
#endif
namespace fk {
#if REP_G > 1 || REP_GSEL > 0
template <class Base> struct RepOrder {
    Base b; int n;
    __device__ void init_n() { Unit u; n = 0; while (b.next(n, u)) ++n; }
    __device__ bool next(int i, Unit& u) const { if (i >= 2 * n) return false; return b.next(i >= n ? i - n : i, u); }
    __device__ __forceinline__ void a_ready(const Unit&) const {}
    __device__ __forceinline__ void done(const Unit&) const {}
};
#define GEMM_REP(EPI, ORD, g, S, E) do { RepOrder<ORD> RS_; RS_.b = S; RS_.init_n(); pg8::gemm_phase<EPI, RepOrder<ORD>, PG_ALIGN, true>(P.lds, g, RS_, E); } while (0)
#endif
#define GEMM_ONE(EPI, ORD, g, S, E) pg8::gemm_phase<EPI, ORD, PG_ALIGN, true>(P.lds, g, S, E)
#if REP_G > 1
#define GEMM_CALL(ID, EPI, ORD, g, S, E) GEMM_REP(EPI, ORD, g, S, E)
#elif REP_GSEL > 0
#define GEMM_CALL(ID, EPI, ORD, g, S, E) do { if (ID == REP_GSEL) GEMM_REP(EPI, ORD, g, S, E); else GEMM_ONE(EPI, ORD, g, S, E); } while (0)
#else
#define GEMM_CALL(ID, EPI, ORD, g, S, E) GEMM_ONE(EPI, ORD, g, S, E)
#endif
__global__ void __launch_bounds__(NWAVES * 64, 2) mega(Params p) {
    extern __shared__ __attribute__((aligned(16))) unsigned char lds_raw[];
    Frame F;
    F.lds = (LAS unsigned char*)lds_raw;
    F.tid = threadIdx.x; F.lane = F.tid & 63; F.wave = __builtin_amdgcn_readfirstlane(F.tid >> 6);
    F.G = gridDim.x; { const int bx = blockIdx.x; F.vcu = (F.G % 8 == 0) ? (bx % 8) * (F.G / 8) + bx / 8 : bx; }
    F.gw = F.vcu * NWAVES + F.wave; F.NGW = F.G * NWAVES; F.bx = blockIdx.x;
    F.out = p.out; F.ws = p.ws; F.ka = (kaptr_t)__builtin_amdgcn_kernarg_segment_ptr();
    unsigned char* ws = p.ws;
    volatile LAS unsigned* MISC = (volatile LAS unsigned*)(F.lds + MISC_OFF);
    for (int u = F.tid; u < (LDS_BYTES - MISC_OFF) / 4; u += NWAVES * 64) ((LAS unsigned*)(F.lds + MISC_OFF))[u] = 0u;
    __syncthreads();
    unsigned* barw = (unsigned*)(ws + WS_CTL) + CW_BAR + p.li * XCD_BAR_WORDS;
    XcdBarrier bar = xcd_barrier_post(barw, MISC + 8);
    const int lo = p.ph_lo, hi = p.ph_hi;
#define IN_PH(k) (lo <= (k) && (k) < hi)
#if REP_B > 1
#define SEAM(k) do { if ((k) + 1 < hi) { xcd_barrier(bar); xcd_barrier(bar); } } while (0)
#else
#define SEAM(k) do { if ((k) + 1 < hi) xcd_barrier(bar); } while (0)
#endif

    if (IN_PH(0)) { const Frame P = phase_frame(F);
convert_layer(P, 0); mod_partials(P); rope_table(P);
#if REP_V > 1
        __syncthreads(); convert_layer(P, 0); mod_partials(P);
#endif
 SEAM(0); }
    if (IN_PH(1)) { const Frame P = phase_frame(F); mod_reduce(P); SEAM(1); }
    if (IN_PH(2)) { const Frame P = phase_frame(F); rowlocal_phase<0>(P, 0); SEAM(2); }
    for (int l = 0; l < DEPTH; ++l) {
        const int pb = 3 + 9 * l;
        if (IN_PH(pb + 0)) { const Frame P = phase_frame(F);
            pg8::Gemm g{P.H(), P.WIN(), M, INW, D}; pg8::StaticOrder S; S.init(M, INW, P.G, P.bx);
            EpiIn E{P.Z(), P.VALL(), P.new_v(), P.CVSTAT(), l};

GEMM_CALL(1, EpiIn, pg8::StaticOrder, g, S, E);

            SEAM(pb + 0);
        }
        if (IN_PH(pb + 1)) { const Frame P = phase_frame(F);
            unsigned* ctl = (unsigned*)(P.ws + WS_CTL);
            lru_phase<1>(P, l);
#if REP_L > 1
            lru_phase<1>(P, l);
#endif
            split_arrive(ctl + CW_SPLIT + 64 * l);
            prep_phase(P, l);
            __syncthreads();
            cm_phase(P, l);
#if REP_C > 1
            cm_phase(P, l);
#endif
            split_wait(ctl + CW_SPLIT + 64 * l, (unsigned)P.G, barw + XB_TMO);
            lru_carry_phase(P, l);
            SEAM(pb + 1);
        }
        if (IN_PH(pb + 2)) { const Frame P = phase_frame(F);

attn_phase(P);
#if REP_A > 1
            attn_phase(P);
#endif


lru_phase<2>(P, l);
#if REP_L > 1
            lru_phase<2>(P, l);
#endif

            SEAM(pb + 2);
        }
        if (IN_PH(pb + 3)) { const Frame P = phase_frame(F);
            pg8::Gemm g{P.BR(), P.WBR(), 3 * M, 3 * D, D}; MergeOrder S; S.init(P.G, P.bx);
            EpiMerge E{P.Z(), P.MSCR() + (size_t)P.bx * 65536, P.H()};

GEMM_CALL(2, EpiMerge, MergeOrder, g, S, E);

            SEAM(pb + 3);
        }
        if (IN_PH(pb + 4)) { const Frame P = phase_frame(F);
            pg8::Gemm g{P.H(), P.WOUT(), M, D, D}; pg8::StaticOrder S; S.init(M, D, P.G, P.bx);
            EpiF E{P.Fb(), P.FSTAT()};

GEMM_CALL(3, EpiF, pg8::StaticOrder, g, S, E);
            SEAM(pb + 4);

        }
        if (IN_PH(pb + 5)) { const Frame P = phase_frame(F);

#if REP_R > 1
            rowlocal_phase<1>(P, l, 0.f);
#endif
            rowlocal_phase<1>(P, l);
 SEAM(pb + 5); }
        if (IN_PH(pb + 6)) { const Frame P = phase_frame(F);
            pg8::Gemm g{P.H(), P.WFF1(), M, DFF, D}; pg8::StaticOrder S; S.init(M, DFF, P.G, P.bx);
            EpiRelu2 E{P.FFH(), DFF};

GEMM_CALL(4, EpiRelu2, pg8::StaticOrder, g, S, E);

            SEAM(pb + 6);
        }
        if (IN_PH(pb + 7)) { const Frame P = phase_frame(F);
            pg8::Gemm g{P.FFH(), P.WFF2(), M, D, DFF}; pg8::StaticOrder S; S.init(M, D, P.G, P.bx);
            EpiF E{P.Fb(), P.FSTAT()};

GEMM_CALL(5, EpiF, pg8::StaticOrder, g, S, E);
            SEAM(pb + 7);

        }
        if (IN_PH(pb + 8)) { const Frame P = phase_frame(F);


#if REP_R > 1
            rowlocal_phase<2>(P, l, 0.f);
#endif
            rowlocal_phase<2>(P, l);


if (l + 1 < DEPTH) { __syncthreads(); convert_layer(P, l + 1); }
#if REP_V > 1
            if (l + 1 < DEPTH) { __syncthreads(); convert_layer(P, l + 1); }
#endif

            SEAM(pb + 8);
        }
    }
#undef IN_PH
#undef SEAM
}
}
extern "C" void kernel_launch(void* const* d_in, const int* in_sizes, int n_in, void* d_out, int out_size, void* d_ws, size_t ws_size, hipStream_t stream) {
    static int grid = 0;
    if (grid == 0) {
        if (n_in != 32 || out_size != 84410368 || ws_size < fk::WS_END) { fprintf(stderr, "kernel_launch: unexpected shapes: n_in %d out %d ws %zu (need %zu)\n", n_in, out_size, ws_size, (size_t)fk::WS_END); grid = -1; return; }
        int dev = 0, cus = 0;
        if (hipGetDevice(&dev) != hipSuccess || hipDeviceGetAttribute(&cus, hipDeviceAttributeMultiprocessorCount, dev) != hipSuccess) { grid = -1; return; }
        if (hipFuncSetAttribute((const void*)fk::mega, hipFuncAttributeMaxDynamicSharedMemorySize, fk::LDS_BYTES) != hipSuccess) { fprintf(stderr, "kernel_launch: hipFuncSetAttribute failed\n"); grid = -1; return; }
        int per_cu = 0;
        if (hipOccupancyMaxActiveBlocksPerMultiprocessor(&per_cu, (const void*)fk::mega, fk::NWAVES * 64, fk::LDS_BYTES) != hipSuccess || per_cu < 1) fprintf(stderr, "kernel_launch: occupancy query says %d blocks per CU\n", per_cu);
        (void)hipGetLastError();
        grid = cus < 256 ? cus : 256;
    }
    if (grid < 0) return;
    (void)hipMemsetAsync((char*)d_ws + fk::WS_CTL, 0, fk::CTL_ZERO_BYTES, stream);
    fk::Params p{};
    for (int i = 0; i < 32; ++i) p.in[i] = (const float*)d_in[i];
    p.out = (float*)d_out; p.ws = (unsigned char*)d_ws; p.ph_lo = 0; p.ph_hi = fk::NPHASE; p.li = 0; p.pad = 0;
    hipLaunchKernelGGL(fk::mega, dim3(grid), dim3(fk::NWAVES * 64), fk::LDS_BYTES, stream, p);
}
```

```cpp
#include <hip/hip_runtime.h>
#include <hip/hip_bf16.h>
#include <cstdio>
#include <cstdint>
namespace pg8 {
#define PG8_LAS __attribute__((address_space(3)))
typedef unsigned short bf16_t;
typedef short bf16x8 __attribute__((ext_vector_type(8)));
typedef float f32x4 __attribute__((ext_vector_type(4)));
typedef unsigned u32x4 __attribute__((ext_vector_type(4)));
constexpr int BM = 256, BK = 64, HALF = 128, HTB = HALF * BK * 2  , STAGE_BYTES = 8 * HTB, NXCD = 8, WGM = 8;

__host__ __device__ __forceinline__ int lds_byte(int r, int c) { const int st = (r >> 4) * 2 + (c >> 5), rr = r & 15, cc = c & 31, ob = rr * 64 + cc * 2; return st * 1024 + (ob ^ (((ob >> 9) & 1) << 5)); }
__host__ __device__ __forceinline__ void stage_rc(int b, int& R, int& C) { const int st = b / 1024, sb = b % 1024, swz = sb ^ (((sb >> 9) & 1) << 5); R = (st >> 1) * 16 + swz / 64; C = (st & 1) * 32 + (swz % 64) / 2; }
__host__ __device__ __forceinline__ int perm32(int rho) { const int n = rho >> 4, i = rho & 15; return 8 * (i >> 2) + 4 * n + (i & 3); }

struct Unit { int pm, pn; };
struct Gemm { const bf16_t* A; const bf16_t* Bt; int M, N, K; };

struct StaticOrder {
    int nM, nN, nwg, G, c;
    __host__ __device__ void init(int M, int N, int G_, int c_) { nM = M / BM; nN = N / BM; nwg = nM * nN; G = G_; c = c_; }
    __host__ __device__ bool next(int i, Unit& u) const {
        const long L = (long)i * G + c; if (L >= nwg) return false;
        int wgid = (int)L; { const int q = nwg / NXCD, r = nwg % NXCD, xcd = wgid % NXCD, off = wgid / NXCD; wgid = (xcd < r ? xcd * (q + 1) : r * (q + 1) + (xcd - r) * q) + off; }
        const int nig = WGM * nN, gid = wgid / nig, fm = gid * WGM, gsz = (nM - fm) < WGM ? (nM - fm) : WGM;
        u.pm = fm + ((wgid % nig) % gsz); u.pn = (wgid % nig) / gsz; return true;
    }
    __device__ __forceinline__ void a_ready(const Unit&) const {}
    __device__ __forceinline__ void done(const Unit&) const {}
};
__device__ __forceinline__ unsigned cvt_pk_bf16(float lo, float hi) { unsigned r; asm volatile("v_cvt_pk_bf16_f32 %0, %1, %2" : "=v"(r) : "v"(lo), "v"(hi)); return r; }
template <class Epi, class Sched, bool ALIGN_EPI = false, bool SP2 = false>
__device__ __forceinline__ void gemm_phase(PG8_LAS unsigned char* lds, const Gemm g, const Sched& S, const Epi& E) {
    int tid_ = threadIdx.x; asm volatile("" : "+v"(tid_));
    const int tid = tid_, wid = __builtin_amdgcn_readfirstlane(tid >> 6), lane = tid & 63, wr = wid >> 2, wc = wid & 3, fr = lane & 15, fq = lane >> 4;
    const int K = g.K, nt = K / BK;
    unsigned voffA[2], voffB[2];
#pragma unroll
    for (int i = 0; i < 2; ++i) { int R, C; stage_rc(tid * 16 + i * 8192, R, C); const int Rb = Epi::PERM ? ((R & ~31) + perm32(R & 31)) : R;
        voffA[i] = (unsigned)(R * K + C) * 2u; voffB[i] = (unsigned)(Rb * K + C) * 2u; }
    const size_t kstep = (size_t)(BK * 2);
    const size_t hstep = (size_t)HALF * K * 2;
    const size_t tstep = 2 * hstep;
    const unsigned ldsw = (unsigned)wid * 1024u;
    const int aoff = lds_byte(wr * 64 + fr, fq * 8), boff = lds_byte(wc * 32 + fr, fq * 8);
#define PG8_SA(b, h) (((b) * 2 + (h)) * HTB)
#define PG8_SB(b, h) ((4 + (b) * 2 + (h)) * HTB)
#define PG8_STAGE(bufoff, gbase, voff) do { _Pragma("unroll") for (int _i = 0; _i < 2; ++_i) \
        __builtin_amdgcn_global_load_lds((const unsigned*)((const char*)(gbase) + (voff)[_i]), (PG8_LAS unsigned*)(lds + (bufoff) + ldsw + _i * 8192), 16, 0, 0); } while (0)
#define PG8_LDA(dst, b, h) do { _Pragma("unroll") for (int m = 0; m < 4; ++m) _Pragma("unroll") for (int k = 0; k < 2; ++k) dst[m][k] = *(const PG8_LAS bf16x8*)(lds + PG8_SA(b, h) + aoff + m * 2048 + k * 1024); } while (0)
#define PG8_LDB(dst, b, h) do { _Pragma("unroll") for (int n = 0; n < 2; ++n) _Pragma("unroll") for (int k = 0; k < 2; ++k) dst[n][k] = *(const PG8_LAS bf16x8*)(lds + PG8_SB(b, h) + boff + n * 2048 + k * 1024); } while (0)
#define PG8_MMA(ai, bj, At, Bt) do { __builtin_amdgcn_s_setprio(1); _Pragma("unroll") for (int m = 0; m < 4; ++m) _Pragma("unroll") for (int n = 0; n < 2; ++n) _Pragma("unroll") for (int k = 0; k < 2; ++k) \
        acc[ai][bj][m][n] = __builtin_amdgcn_mfma_f32_16x16x32_bf16(Bt[n][k], At[m][k], acc[ai][bj][m][n], 0, 0, 0); __builtin_amdgcn_s_setprio(0); } while (0)
#define PG8_WAIT_V(n) asm volatile("s_waitcnt vmcnt(" #n ")" ::: "memory")
#define PG8_WAIT_L(n) asm volatile("s_waitcnt lgkmcnt(" #n ")" ::: "memory")
#define PG8_BAR __builtin_amdgcn_s_barrier()
#define PG8_SCHED __builtin_amdgcn_sched_barrier(0)
    Unit cur, nxt; int ui = 0;
    if (!S.next(0, cur)) return;
    f32x4 acc[2][2][4][2];
#pragma unroll
    for (int a = 0; a < 2; ++a)
#pragma unroll
        for (int b = 0; b < 2; ++b)
#pragma unroll
            for (int m = 0; m < 4; ++m)
#pragma unroll
                for (int n = 0; n < 2; ++n) acc[a][b][m][n] = (f32x4){0.f, 0.f, 0.f, 0.f};
    bf16x8 At[4][2], B0[2][2], B1[2][2];
    const char* cA = (const char*)g.A + (size_t)cur.pm * tstep; const char* cB = (const char*)g.Bt + (size_t)cur.pn * tstep;
    S.a_ready(cur);
    if constexpr (SP2) {
        PG8_STAGE(PG8_SB(0, 0), cB, voffB); PG8_STAGE(PG8_SB(0, 1), cB + hstep, voffB); PG8_STAGE(PG8_SA(0, 0), cA, voffA); PG8_STAGE(PG8_SA(0, 1), cA + hstep, voffA);
        if (wr == 1) PG8_BAR;
        PG8_WAIT_V(2); PG8_BAR;
        PG8_STAGE(PG8_SB(1, 0), cB + kstep, voffB); PG8_STAGE(PG8_SA(1, 0), cA + kstep, voffA); PG8_STAGE(PG8_SB(1, 1), cB + hstep + kstep, voffB);
        PG8_WAIT_V(6); PG8_BAR;
    } else {
        PG8_STAGE(PG8_SB(0, 0), cB, voffB); PG8_STAGE(PG8_SA(0, 0), cA, voffA); PG8_STAGE(PG8_SB(0, 1), cB + hstep, voffB); PG8_STAGE(PG8_SA(0, 1), cA + hstep, voffA);
        if (wr == 1) PG8_BAR;
        PG8_WAIT_V(4); PG8_BAR;
        PG8_STAGE(PG8_SB(1, 0), cB + kstep, voffB); PG8_STAGE(PG8_SA(1, 0), cA + kstep, voffA); PG8_STAGE(PG8_SB(1, 1), cB + hstep + kstep, voffB);
        PG8_WAIT_V(6); PG8_BAR;
    }
    for (;;) {
        const bool has_next = S.next(ui + 1, nxt);
        const char* nA = has_next ? (const char*)g.A + (size_t)nxt.pm * tstep : cA; const char* nB = has_next ? (const char*)g.Bt + (size_t)nxt.pn * tstep : cB;
        for (int t = 0; t < nt; t += 2) {
            const bool last = (t == nt - 2);
            const char* a1 = cA + (size_t)(t + 1) * kstep;
            const char* a2 = last ? nA : cA + (size_t)(t + 2) * kstep; const char* b2 = last ? nB : cB + (size_t)(t + 2) * kstep;
            const char* a3 = a2 + kstep; const char* b3 = b2 + kstep;
            if (last && has_next) S.a_ready(nxt);
            if constexpr (SP2) {
            PG8_LDB(B0, 0, 0); PG8_LDB(B1, 0, 1); PG8_SCHED; PG8_LDA(At, 0, 0); PG8_STAGE(PG8_SA(1, 1), a1 + hstep, voffA);
            PG8_WAIT_V(8); PG8_WAIT_L(0); PG8_BAR; PG8_MMA(0, 0, At, B0); PG8_MMA(0, 1, At, B1); PG8_BAR; PG8_SCHED;
            PG8_LDA(At, 0, 1); PG8_STAGE(PG8_SB(0, 0), b2, voffB); PG8_STAGE(PG8_SB(0, 1), b2 + hstep, voffB); PG8_STAGE(PG8_SA(0, 0), a2, voffA);
            PG8_WAIT_V(8); PG8_WAIT_L(0); PG8_BAR; PG8_MMA(1, 0, At, B0); PG8_MMA(1, 1, At, B1); PG8_BAR; PG8_SCHED;
            PG8_LDB(B0, 1, 0); PG8_LDB(B1, 1, 1); PG8_SCHED; PG8_LDA(At, 1, 0); PG8_STAGE(PG8_SA(0, 1), a2 + hstep, voffA);
            PG8_WAIT_V(8); PG8_WAIT_L(0); PG8_BAR; PG8_MMA(0, 0, At, B0); PG8_MMA(0, 1, At, B1); PG8_BAR; PG8_SCHED;
            PG8_LDA(At, 1, 1); PG8_STAGE(PG8_SB(1, 0), b3, voffB); PG8_STAGE(PG8_SB(1, 1), b3 + hstep, voffB); PG8_STAGE(PG8_SA(1, 0), a3, voffA);
            PG8_WAIT_V(8); PG8_WAIT_L(0); PG8_BAR; PG8_MMA(1, 0, At, B0); PG8_MMA(1, 1, At, B1); PG8_BAR; PG8_SCHED;
            } else {
            PG8_LDB(B0, 0, 0); PG8_SCHED; PG8_LDA(At, 0, 0); PG8_STAGE(PG8_SA(1, 1), a1 + hstep, voffA);
            PG8_WAIT_L(8); PG8_BAR; PG8_WAIT_L(0); PG8_MMA(0, 0, At, B0); PG8_BAR; PG8_SCHED;
            PG8_LDB(B1, 0, 1); PG8_STAGE(PG8_SB(0, 0), b2, voffB);
            PG8_BAR; PG8_WAIT_L(0); PG8_MMA(0, 1, At, B1); PG8_BAR;
            PG8_LDA(At, 0, 1); PG8_STAGE(PG8_SA(0, 0), a2, voffA);
            PG8_BAR; PG8_WAIT_L(0); PG8_MMA(1, 0, At, B0); PG8_BAR; PG8_SCHED;
            PG8_STAGE(PG8_SB(0, 1), b2 + hstep, voffB);
            PG8_WAIT_V(6); PG8_BAR; PG8_MMA(1, 1, At, B1); PG8_BAR;
            PG8_LDB(B0, 1, 0); PG8_SCHED; PG8_LDA(At, 1, 0); PG8_STAGE(PG8_SA(0, 1), a2 + hstep, voffA);
            PG8_WAIT_L(8); PG8_BAR; PG8_WAIT_L(0); PG8_MMA(0, 0, At, B0); PG8_BAR; PG8_SCHED;
            PG8_LDB(B1, 1, 1); PG8_STAGE(PG8_SB(1, 0), b3, voffB);
            PG8_BAR; PG8_WAIT_L(0); PG8_MMA(0, 1, At, B1); PG8_BAR;
            PG8_LDA(At, 1, 1); PG8_STAGE(PG8_SA(1, 0), a3, voffA);
            PG8_BAR; PG8_WAIT_L(0); PG8_MMA(1, 0, At, B0); PG8_BAR; PG8_SCHED;
            PG8_STAGE(PG8_SB(1, 1), b3 + hstep, voffB);
            PG8_WAIT_V(6); PG8_BAR; PG8_MMA(1, 1, At, B1); PG8_BAR;
            }
        }
        if constexpr (ALIGN_EPI) { if (wr == 0) PG8_BAR; }
        if constexpr (!Epi::AFTER_DRAIN) { E(acc, cur, wr, wc, fr, fq); S.done(cur); }
        if (!has_next) break;
#pragma unroll
        for (int a = 0; a < 2; ++a)
#pragma unroll
            for (int b = 0; b < 2; ++b)
#pragma unroll
                for (int m = 0; m < 4; ++m)
#pragma unroll
                    for (int n = 0; n < 2; ++n) acc[a][b][m][n] = (f32x4){0.f, 0.f, 0.f, 0.f};
        cur = nxt; cA = nA; cB = nB; ++ui;
        if constexpr (ALIGN_EPI) { if (wr == 1) PG8_BAR; }
    }
    PG8_WAIT_V(0);
    if constexpr (!ALIGN_EPI) { if (wr == 0) PG8_BAR; }
    PG8_BAR;
    if constexpr (Epi::AFTER_DRAIN) { E.fused(acc, cur, wr, wc, fr, fq, lds, wid, lane); S.done(cur); }
#undef PG8_SA
#undef PG8_SB
#undef PG8_STAGE
#undef PG8_LDA
#undef PG8_LDB
#undef PG8_MMA
#undef PG8_WAIT_V
#undef PG8_WAIT_L
#undef PG8_BAR
#undef PG8_SCHED
}
}
#define GAS __attribute__((address_space(1)))
#define LAS __attribute__((address_space(3)))
typedef unsigned short bf16;
typedef unsigned v4u __attribute__((ext_vector_type(4)));
typedef float f32x4 __attribute__((ext_vector_type(4)));
typedef short bf16x8 __attribute__((ext_vector_type(8)));
typedef GAS unsigned gu32;
typedef GAS unsigned long long gu64;
#define RLX_AGENT __ATOMIC_RELAXED, __HIP_MEMORY_SCOPE_AGENT
#define LDS_WAIT() asm volatile("s_waitcnt lgkmcnt(0)" ::: "memory")
#define VM_WAIT() asm volatile("s_waitcnt vmcnt(0)" ::: "memory")
__device__ __forceinline__ unsigned long long rt() { return __builtin_amdgcn_s_memrealtime(); }
__device__ __forceinline__ unsigned f2bf(float f) { unsigned u = __builtin_bit_cast(unsigned, f); return (u + 0x7fffu + ((u >> 16) & 1u)) >> 16; }
__device__ __forceinline__ unsigned pk2(float lo, float hi) { return f2bf(lo) | (f2bf(hi) << 16); }

#define XB_TMO      128
#define XB_XCNT(j)  (256  + 64 * (j))
#define XB_XSUB(j)  (1280 + 64 * (j))
#define XB_XGEN(j)  (2304 + 64 * (j))
#define XB_TOP      3328
#define XB_TOPGEN   3392
#define XCD_BAR_WORDS 3456
#define XB_SPIN_CAP (1u << 18)

__device__ __forceinline__ unsigned xb_ld(unsigned* p)              { return __hip_atomic_load(p, __ATOMIC_RELAXED, __HIP_MEMORY_SCOPE_AGENT); }
__device__ __forceinline__ unsigned xb_add(unsigned* p, unsigned v) { return __hip_atomic_fetch_add(p, v, __ATOMIC_RELAXED, __HIP_MEMORY_SCOPE_AGENT); }
__device__ __forceinline__ unsigned xb_xcc_id() { return (unsigned)__builtin_amdgcn_s_getreg((3 << 11) | 20) & 0xFu; }
#define XB_SPIN(cond, bar) do { unsigned _sp = 0; while (cond) { __builtin_amdgcn_s_sleep(1); \
    if ((++_sp & 255u) == 0u) { if (xb_ld(&(bar)[XB_TMO])) break; if (_sp > XB_SPIN_CAP) { atomicAdd(&(bar)[XB_TMO], 1u); break; } } } } while (0)

struct XcdBarrier {
    unsigned* bar; unsigned x;
    volatile LAS unsigned* st;
};

__device__ __forceinline__ XcdBarrier xcd_barrier_post(unsigned* bar, volatile LAS unsigned* st) {
    XcdBarrier b; b.bar = bar; b.x = xb_xcc_id(); b.st = st;
    if (threadIdx.x == 0) (void)xb_add(&bar[XB_XCNT(b.x)], 1u);
    return b;
}
__device__ __forceinline__ void xcd_barrier_complete(unsigned* bar, unsigned x, unsigned& nloc, unsigned& nx) {
    const unsigned G = gridDim.x * gridDim.y * gridDim.z;
    unsigned sum, cnt, mine, sp = 0u;
    for (;;) {
        sum = 0u; cnt = 0u; mine = 0u;
#pragma unroll
        for (unsigned j = 0; j < 16; ++j) { const unsigned c = xb_ld(&bar[XB_XCNT(j)]); sum += c; cnt += (c > 0u) ? 1u : 0u; mine = (j == x) ? c : mine; }
        if (sum == G) break;
        __builtin_amdgcn_s_sleep(1);
        if ((++sp & 255u) == 0u) { if (xb_ld(&bar[XB_TMO])) break; if (sp > XB_SPIN_CAP) { atomicAdd(&bar[XB_TMO], 1u); break; } }
    }
    nloc = mine > 0u ? mine : 1u; nx = cnt > 0u ? cnt : 1u;
}

__device__ __forceinline__ void xcd_barrier(const XcdBarrier& b) {
    asm volatile("s_waitcnt vmcnt(0)" ::: "memory");
    __syncthreads();
    if (threadIdx.x == 0) {
        unsigned* bar = b.bar;
        __builtin_amdgcn_s_waitcnt(0);
        unsigned nloc = b.st[0], nx = b.st[1];
        if (nloc == 0u) { xcd_barrier_complete(bar, b.x, nloc, nx); b.st[0] = nloc; b.st[1] = nx; }
        const unsigned old = xb_add(&bar[XB_XSUB(b.x)], 1u);
        const unsigned gen = old / nloc;
        if (old + 1u == (gen + 1u) * nloc) {
            __builtin_amdgcn_fence(__ATOMIC_RELEASE, "agent");
            asm volatile("s_waitcnt vmcnt(0)" ::: "memory");
            const unsigned og = xb_add(&bar[XB_TOP], 1u);
            const unsigned tg = og / nx;
            if (og + 1u == (tg + 1u) * nx) xb_add(&bar[XB_TOPGEN], 1u);
            else XB_SPIN(xb_ld(&bar[XB_TOPGEN]) == tg, bar);
            __builtin_amdgcn_fence(__ATOMIC_ACQUIRE, "agent");
            xb_add(&bar[XB_XGEN(b.x)], 1u);
            asm volatile("s_waitcnt vmcnt(0)" ::: "memory");
        } else {
            XB_SPIN(xb_ld(&bar[XB_XGEN(b.x)]) == gen, bar);
            __builtin_amdgcn_fence(__ATOMIC_ACQUIRE, "agent");
            asm volatile("s_waitcnt vmcnt(0)" ::: "memory");
        }
    }
    __syncthreads();
}
namespace att {
constexpr int   D = 128, NW = 8, QBLK = 32, KVBLK = 64;
constexpr float SCALE = 0.088388347648318440f;
constexpr float THR = 8.f;
constexpr int SDEPTH = 2;
constexpr int LDQ = 17408, LDK = 512, LDO = 2048;
constexpr size_t SHM_V = KVBLK * D * 2, SHM_K = KVBLK * D * 2, SHM_ATTN = 2 * SHM_V + 2 * SHM_K + NW * 64 * 4;
using bf16 = __hip_bfloat16;
using bf16x8 = __attribute__((ext_vector_type(8))) short;
using s16x4  = __attribute__((ext_vector_type(4))) short;
using f32x16 = __attribute__((ext_vector_type(16))) float;
using f32x8  = __attribute__((ext_vector_type(8))) float;
using u32x4  = __attribute__((ext_vector_type(4))) unsigned;
#define KSWZ(row, colB) ((row) * 256 + ((colB) ^ (((row) & 7) << 4)))
#define SBAR() __builtin_amdgcn_sched_barrier(0)
__device__ __forceinline__ int crow(int r, int hi) { return (r & 3) + 8 * (r >> 2) + 4 * hi; }
__device__ __forceinline__ unsigned cvtpk(float lo, float hi) {
  unsigned r; asm volatile("v_cvt_pk_bf16_f32 %0, %1, %2" : "=v"(r) : "v"(lo), "v"(hi)); return r;
}
template <typename TIn> struct Stage;
template <> struct Stage<bf16>  { using T = bf16x8;
  __device__ static __forceinline__ T ld8(const bf16* p) { return *reinterpret_cast<const bf16x8*>(p); }
  __device__ static __forceinline__ bf16x8 tobf(T x) { return x; } };
template <> struct Stage<float> { using T = f32x8;
  __device__ static __forceinline__ T ld8(const float* p) { return *reinterpret_cast<const f32x8*>(p); }
  __device__ static __forceinline__ bf16x8 tobf(T x) {
    u32x4 w = {cvtpk(x[0], x[1]), cvtpk(x[2], x[3]), cvtpk(x[4], x[5]), cvtpk(x[6], x[7])}; return *reinterpret_cast<bf16x8*>(&w); } };

__device__ __forceinline__ void partialSM(f32x16& p0, f32x16& p1, float& m_reg, float& mn, float& alpha) {
  constexpr float C = SCALE * 1.4426950408889634f;
  float pmax = p0[0]; for (int r = 1; r < 16; ++r) pmax = fmaxf(pmax, p0[r]); for (int r = 0; r < 16; ++r) pmax = fmaxf(pmax, p1[r]);
  { auto rr = __builtin_amdgcn_permlane32_swap(__float_as_uint(pmax), __float_as_uint(pmax), false, false);
    pmax = fmaxf(__uint_as_float(rr[0]), __uint_as_float(rr[1])); }
  if (__builtin_expect(__all(pmax - m_reg <= THR / SCALE), 1)) { mn = m_reg; alpha = 1.f; }
  else { mn = fmaxf(m_reg, pmax); alpha = __builtin_amdgcn_exp2f((m_reg - mn) * C); m_reg = mn; }
  float mnC = -mn * C;
  for (int r = 0; r < 16; ++r) p0[r] = fmaf(p0[r], C, mnC); for (int r = 0; r < 16; ++r) p1[r] = fmaf(p1[r], C, mnC);
  for (int r = 0; r < 16; ++r) p0[r] = __builtin_amdgcn_exp2f(p0[r]);
}
__device__ __forceinline__ void finishSM(f32x16& p0, f32x16& p1, float alpha, float& l_reg, bf16x8& pa0, bf16x8& pa1, bf16x8& pa2, bf16x8& pa3) {
  for (int r = 0; r < 16; ++r) p1[r] = __builtin_amdgcn_exp2f(p1[r]);
  float ps = 0; for (int r = 0; r < 16; ++r) ps += p0[r]; for (int r = 0; r < 16; ++r) ps += p1[r];
  { auto rr = __builtin_amdgcn_permlane32_swap(__float_as_uint(ps), __float_as_uint(ps), false, false);
    ps = __uint_as_float(rr[0]) + __uint_as_float(rr[1]); }
  l_reg = l_reg * alpha + ps;
#define PK4(P, BASE, OUT) do { unsigned a0 = cvtpk(P[BASE + 0], P[BASE + 1]), a1 = cvtpk(P[BASE + 2], P[BASE + 3]);   \
    unsigned b0 = cvtpk(P[BASE + 4], P[BASE + 5]), b1 = cvtpk(P[BASE + 6], P[BASE + 7]);                              \
    auto r0 = __builtin_amdgcn_permlane32_swap(a0, b0, false, false); auto r1 = __builtin_amdgcn_permlane32_swap(a1, b1, false, false); \
    u32x4 w = {r0[0], r1[0], r0[1], r1[1]}; OUT = *reinterpret_cast<bf16x8*>(&w); } while (0)
  PK4(p0, 0, pa0); PK4(p0, 8, pa1); PK4(p1, 0, pa2); PK4(p1, 8, pa3);
#undef PK4
}
__device__ __forceinline__ void qkt(f32x16& p0, f32x16& p1, const bf16* Ks, const bf16x8* qr, int r32, int hi) {
  p0 = f32x16{}; p1 = f32x16{};
  for (int d0 = 0; d0 < 8; ++d0) { int cb = (d0 * 16 + hi * 8) * 2;
    bf16x8 b0 = *reinterpret_cast<const bf16x8*>((const char*)Ks + KSWZ(r32, cb));
    bf16x8 b1 = *reinterpret_cast<const bf16x8*>((const char*)Ks + KSWZ(32 + r32, cb));
    p0 = __builtin_amdgcn_mfma_f32_32x32x16_bf16(b0, qr[d0], p0, 0, 0, 0);
    p1 = __builtin_amdgcn_mfma_f32_32x32x16_bf16(b1, qr[d0], p1, 0, 0, 0); }
}
__device__ __forceinline__ int v_st(int k, int c) { const int kk = (k & ~0xC) | ((k & 4) << 1) | ((k & 8) >> 1); return ((kk >> 3) * 4 + (c >> 5)) * 512 + ((kk & 7) * 32 + (c & 31)) * 2; }
__device__ __forceinline__ int v_rd_base(int lane) { return ((lane & 3) << 3) | (((lane >> 2) & 3) << 6) | (((lane >> 4) & 1) << 5) | (((lane >> 5) & 1) << 8); }
constexpr int v_rd_off(int d0, int ks, int half) { return d0 * 512 + ks * 4096 + half * 2048; }
template <int OFF> __device__ __forceinline__ s16x4 tr_read(int vb) {
  s16x4 r; asm volatile("ds_read_b64_tr_b16 %0, %1 offset:%2" : "=&v"(r) : "v"(vb), "i"(OFF) : "memory"); return r;
}
template <int D0> __device__ __forceinline__ void pv_one(f32x16& od, int vb, bf16x8 pa0, bf16x8 pa1, bf16x8 pa2, bf16x8 pa3) {
  const s16x4 l0 = tr_read<v_rd_off(D0, 0, 0)>(vb), h0 = tr_read<v_rd_off(D0, 0, 1)>(vb), l1 = tr_read<v_rd_off(D0, 1, 0)>(vb), h1 = tr_read<v_rd_off(D0, 1, 1)>(vb);
  const s16x4 l2 = tr_read<v_rd_off(D0, 2, 0)>(vb), h2 = tr_read<v_rd_off(D0, 2, 1)>(vb), l3 = tr_read<v_rd_off(D0, 3, 0)>(vb), h3 = tr_read<v_rd_off(D0, 3, 1)>(vb);
  asm volatile("s_waitcnt lgkmcnt(0)" ::: "memory"); SBAR();
#define PK(L, H) (bf16x8){L[0], L[1], L[2], L[3], H[0], H[1], H[2], H[3]}
  od = __builtin_amdgcn_mfma_f32_32x32x16_bf16(pa0, PK(l0, h0), od, 0, 0, 0);
  od = __builtin_amdgcn_mfma_f32_32x32x16_bf16(pa1, PK(l1, h1), od, 0, 0, 0);
  od = __builtin_amdgcn_mfma_f32_32x32x16_bf16(pa2, PK(l2, h2), od, 0, 0, 0);
  od = __builtin_amdgcn_mfma_f32_32x32x16_bf16(pa3, PK(l3, h3), od, 0, 0, 0);
#undef PK
}
__device__ __forceinline__ void pv_d0(f32x16* o, int vb, bf16x8 pa0, bf16x8 pa1, bf16x8 pa2, bf16x8 pa3) {
  pv_one<0>(o[0], vb, pa0, pa1, pa2, pa3); pv_one<1>(o[1], vb, pa0, pa1, pa2, pa3); pv_one<2>(o[2], vb, pa0, pa1, pa2, pa3); pv_one<3>(o[3], vb, pa0, pa1, pa2, pa3);
}

template <typename TQ>
__device__ __forceinline__ void attn_dense_body(const TQ* __restrict__ Qb, const bf16* __restrict__ Kh, const bf16* __restrict__ Vh,
                                                bf16* __restrict__ Ob, int seq, char* lds) {
  using St = Stage<bf16>; using SQ = Stage<TQ>;
  int tid_ = threadIdx.x; asm volatile("" : "+v"(tid_));
  const int tid = tid_, wid = tid >> 6, lane = tid & 63, r32 = lane & 31, hi = lane >> 5;
  bf16* V_lds = (bf16*)lds; bf16* K_lds = (bf16*)(lds + 2 * SHM_V);
  float* ws = (float*)(lds + 2 * SHM_V + 2 * SHM_K) + wid * 64; float* li_l = ws; float* al_l = ws + 32;
  float m_reg = -1e30f, l_reg = 0; f32x16 o[4] = {}; bf16x8 qr[8];
  const TQ* Qw = Qb + (long)(wid * QBLK + r32) * LDQ + hi * 8;
#pragma unroll
  for (int d0 = 0; d0 < 8; ++d0) qr[d0] = SQ::tobf(SQ::ld8(Qw + d0 * 16));
  const int sr = tid >> 4, sc = (tid & 15) * 8, vst0 = v_st(sr, sc), vst1 = v_st(32 + sr, sc);
  const int vb0 = (int)(uintptr_t)V_lds + v_rd_base(lane);
  struct { typename St::T vs0, vs1, ks0, ks1; } sr_[SDEPTH];
#define SLOAD(i, k0) do { sr_[i].vs0 = St::ld8(&Vh[(long)((k0) + sr) * LDK + sc]); sr_[i].vs1 = St::ld8(&Vh[(long)((k0) + 32 + sr) * LDK + sc]); \
    sr_[i].ks0 = St::ld8(&Kh[(long)((k0) + sr) * LDK + sc]); sr_[i].ks1 = St::ld8(&Kh[(long)((k0) + 32 + sr) * LDK + sc]); } while (0)
#define SWRITE(b, i) do { *(bf16x8*)((char*)V_lds + (b) * SHM_V + vst0) = St::tobf(sr_[i].vs0);          \
    *(bf16x8*)((char*)V_lds + (b) * SHM_V + vst1) = St::tobf(sr_[i].vs1); int kc = sc * 2;               \
    *(bf16x8*)((char*)K_lds + (b) * SHM_K + KSWZ(sr, kc)) = St::tobf(sr_[i].ks0);                       \
    *(bf16x8*)((char*)K_lds + (b) * SHM_K + KSWZ(32 + sr, kc)) = St::tobf(sr_[i].ks1); } while (0)
#define SWAIT() do { if constexpr (SDEPTH == 2) asm volatile("s_waitcnt vmcnt(4)" ::: "memory"); else asm volatile("s_waitcnt vmcnt(0)" ::: "memory"); } while (0)
#define RESC(a) do { if (__any((a) < 1.f)) { if (hi == 0) al_l[r32] = (a); asm volatile("s_waitcnt lgkmcnt(0)" ::: "memory"); \
    for (int d = 0; d < 4; ++d) for (int r = 0; r < 16; ++r) o[d][r] *= al_l[crow(r, hi)]; } } while (0)
  f32x16 pA0, pA1, pB0, pB1; float mnA, mnB, alA, alB; bf16x8 pa0, pa1, pa2, pa3; const int NT = seq / KVBLK;
  constexpr int SE = 0, SO = SDEPTH - 1;
  SLOAD(SE, 0); asm volatile("s_waitcnt vmcnt(0)" ::: "memory"); SWRITE(0, SE); __syncthreads();
  qkt(pA0, pA1, K_lds, qr, r32, hi); partialSM(pA0, pA1, m_reg, mnA, alA);
  SLOAD(SO, KVBLK); if constexpr (SDEPTH == 2) { if (2 < NT) SLOAD(SE, 2 * KVBLK); }
  SWAIT(); SWRITE(1, SO); __syncthreads();
  for (int j = 1; j + 1 < NT; j += 2) {
    SBAR(); qkt(pB0, pB1, (bf16*)((char*)K_lds + SHM_K), qr, r32, hi);
    finishSM(pA0, pA1, alA, l_reg, pa0, pa1, pa2, pa3); SBAR();
    SLOAD(SO, (j + SDEPTH) * KVBLK); SBAR();
    pv_d0(o, vb0, pa0, pa1, pa2, pa3); partialSM(pB0, pB1, m_reg, mnB, alB);
    __syncthreads(); SWAIT(); SWRITE(0, SE);
    RESC(alB); __syncthreads();
    SBAR(); qkt(pA0, pA1, K_lds, qr, r32, hi);
    finishSM(pB0, pB1, alB, l_reg, pa0, pa1, pa2, pa3); SBAR();
    if (SDEPTH == 1 || j + 3 < NT) SLOAD(SE, (j + 1 + SDEPTH) * KVBLK); SBAR();
    pv_d0(o, vb0 + (int)SHM_V, pa0, pa1, pa2, pa3); partialSM(pA0, pA1, m_reg, mnA, alA);
    __syncthreads(); SWAIT(); SWRITE(1, SO);
    RESC(alA); __syncthreads();
  }
  SBAR(); qkt(pB0, pB1, (bf16*)((char*)K_lds + SHM_K), qr, r32, hi);
  finishSM(pA0, pA1, alA, l_reg, pa0, pa1, pa2, pa3); SBAR();
  pv_d0(o, vb0, pa0, pa1, pa2, pa3); partialSM(pB0, pB1, m_reg, mnB, alB);
  __syncthreads(); RESC(alB);
  finishSM(pB0, pB1, alB, l_reg, pa0, pa1, pa2, pa3); SBAR();
  pv_d0(o, vb0 + (int)SHM_V, pa0, pa1, pa2, pa3);
  if (hi == 0) li_l[r32] = l_reg; asm volatile("s_waitcnt lgkmcnt(0)" ::: "memory");
  float rli[16];
#pragma unroll
  for (int r = 0; r < 16; ++r) rli[r] = __builtin_amdgcn_rcpf(li_l[crow(r, hi)]);
  bf16* Ow = Ob + (long)(wid * QBLK) * LDO;
#pragma unroll
  for (int r = 0; r < 16; ++r) { int orow = crow(r, hi);
    for (int d0 = 0; d0 < 4; ++d0) Ow[(long)orow * LDO + d0 * 32 + r32] = __float2bfloat16(o[d0][r] * rli[r]); }
#undef SLOAD
#undef SWRITE
#undef SWAIT
#undef RESC
}
#undef KSWZ
#undef SBAR
}
namespace fk {
using pg8::bf16_t; using pg8::f32x4; using pg8::u32x4; using pg8::Unit; using pg8::cvt_pk_bf16;
typedef unsigned u32x2 __attribute__((ext_vector_type(2)));
typedef float f32x16 __attribute__((ext_vector_type(16)));
constexpr int M = 24576, MP = 8192, D = 2048, INW = 17408, DFF = 8192, DEPTH = 4, NWAVES = 8, NCOND = 9;
constexpr int OFF_Q = 0, OFF_K = 2048, OFF_V = 2560, OFF_LX = 3072, OFF_LG = 5120, OFF_CU = 7168, OFF_CV = 9216, OFF_G = 11264;
constexpr int NKVROWS = 26624;
constexpr float EPS = 1e-6f;
constexpr int NPHASE = 3 + 9 * DEPTH;
constexpr int NMODK = 32;
constexpr size_t MiB = 1u << 20;
constexpr size_t WS_CTL = 0, CTL_ZERO_BYTES = 1 * MiB;
constexpr size_t WS_CIN = 1 * MiB  , WS_MODP = 716 * MiB  , WS_MOD = 28 * MiB, WS_ROPE = 30 * MiB, WS_CVSTAT = 31 * MiB, WS_FSTAT = 34 * MiB, WS_AGG = 37 * MiB, WS_WLRU = 49 * MiB, WS_CMW = 51 * MiB;
constexpr size_t WS_WIN = 52 * MiB, WS_WBR = 120 * MiB, WS_WOUT = 144 * MiB, WS_WFF1 = 152 * MiB, WS_WFF2 = 184 * MiB;
constexpr size_t WS_H = 216 * MiB, WS_KALL = 312 * MiB, WS_VALL = 338 * MiB, WS_BR = 364 * MiB, WS_MSCR = 652 * MiB, WS_Z = 716 * MiB, WS_END = 1532 * MiB;
constexpr size_t WS_FFH = WS_Z, WS_F = WS_Z + 384 * MiB;
constexpr int CW_SPLIT = 2048;
constexpr int CW_BAR = 4096;
constexpr int RING_BYTES = 131072;
constexpr int LRU_XC = 0, LRU_XC_PITCH = 272, LRU_A0 = 17408, LRU_B0 = LRU_A0 + 32768, LRU_A1 = LRU_B0 + 32768, LRU_B1 = LRU_A1 + 32768, LRU_CARRY = LRU_B1 + 32768;
constexpr int CM_VT = 0, CM_VT_PITCH = 272, CM_RS = 128 * 272;
constexpr int MISC_OFF = 150528, LDS_BYTES = 151552;
static_assert(LRU_CARRY + 2048 <= MISC_OFF, "lds map");

struct Params { const float* in[32]; float* out; unsigned char* ws; int ph_lo, ph_hi, li, pad; };

typedef const __attribute__((address_space(4))) void* kaptr_t;
struct Frame {
    LAS unsigned char* lds;
    int tid, lane, wave, vcu, G, gw, NGW, bx;
    float* out; unsigned char* ws; kaptr_t ka;
    __device__ __forceinline__ float* x() const { return out; }
    __device__ __forceinline__ float* new_k() const { return out + 50331648L; }
    __device__ __forceinline__ float* new_v() const { return out + 50331648L + 16777216L; }
    __device__ __forceinline__ float* new_s() const { return out + 50331648L + 2 * 16777216L; }
#define FK_WSP(name, type, off) __device__ __forceinline__ type* name() const { return (type*)(ws + (off)); }
    FK_WSP(MODP, float, WS_MODP) FK_WSP(MOD, float, WS_MOD) FK_WSP(ROPE, float, WS_ROPE) FK_WSP(CVSTAT, float, WS_CVSTAT) FK_WSP(FSTAT, float, WS_FSTAT) FK_WSP(AGG, float, WS_AGG) FK_WSP(CIN, float, WS_CIN) FK_WSP(MSCR, float, WS_MSCR)
    FK_WSP(WLRU, bf16_t, WS_WLRU) FK_WSP(CMW, bf16_t, WS_CMW) FK_WSP(WIN, bf16_t, WS_WIN) FK_WSP(WBR, bf16_t, WS_WBR) FK_WSP(WOUT, bf16_t, WS_WOUT) FK_WSP(WFF1, bf16_t, WS_WFF1) FK_WSP(WFF2, bf16_t, WS_WFF2)
    FK_WSP(H, bf16_t, WS_H) FK_WSP(KALL, bf16_t, WS_KALL) FK_WSP(VALL, bf16_t, WS_VALL) FK_WSP(BR, bf16_t, WS_BR) FK_WSP(Z, bf16_t, WS_Z) FK_WSP(FFH, bf16_t, WS_FFH) FK_WSP(Fb, bf16_t, WS_F)
#undef FK_WSP
};
enum { I_XP = 0, I_XS, I_CK, I_CV, I_SL, I_C, I_CCTX, I_WMOD, I_BMOD, I_GPM, I_GPOM, I_GPF, I_GPOF, I_WIN, I_GQ, I_GK, I_WAO, I_CW, I_CB, I_LWA, I_LBA, I_LWX, I_LBX, I_LAM, I_WLO, I_CMG, I_CMWS, I_CMBS, I_WCO, I_WOUT, I_WFF1, I_WFF2 };
template <int I> __device__ __forceinline__ const float* inp(const Frame& F) { const GAS float* r; asm volatile("s_load_dwordx2 %0, %1, %2\n\ts_waitcnt lgkmcnt(0)" : "=s"(r) : "s"(F.ka), "i"(I * 8) : "memory"); return (const float*)r; }


__device__ __forceinline__ Frame phase_frame(const Frame& F) {
    Frame P = F; int t = F.tid; int bx = blockIdx.x; int g = F.G; GAS unsigned char* w = (GAS unsigned char*)F.ws; GAS float* o = (GAS float*)F.out;
    asm volatile("" : "+v"(t)); asm volatile("" : "+s"(bx), "+s"(g), "+s"(w), "+s"(o));
    P.tid = t; P.lane = t & 63; P.wave = __builtin_amdgcn_readfirstlane(t >> 6); P.ws = (unsigned char*)w; P.out = (float*)o; P.bx = bx; P.G = g; P.NGW = g * NWAVES;
    P.vcu = (g % 8 == 0) ? (bx % 8) * (g / 8) + bx / 8 : bx; P.gw = P.vcu * NWAVES + P.wave;
    return P;
}
__device__ __forceinline__ float wave_sum(float v) {
#pragma unroll
    for (int o = 1; o < 64; o <<= 1) v += __shfl_xor(v, o);
    return v;
}
__device__ __forceinline__ float bf2f(unsigned short h) { return __uint_as_float((unsigned)h << 16); }
__device__ __forceinline__ float bflo(unsigned w) { return __uint_as_float(w << 16); }
__device__ __forceinline__ float bfhi(unsigned w) { return __uint_as_float(w & 0xffff0000u); }
__device__ __forceinline__ float fsigm(float x) { return __builtin_amdgcn_rcpf(1.f + __builtin_amdgcn_exp2f(-1.4426950408889634f * x)); }
__device__ __forceinline__ float fgelu(float x) { const float u = x * (1.5957691216057308f + 0.0713548162726009f * x * x); return x * fsigm(u); }

__device__ __forceinline__ void transpose_item(const float* __restrict__ W, int K, int N, bf16_t* __restrict__ WT, int row_off, LAS unsigned char* scr, int item, int lane) {
    const int nblk = N / 64, kb = item / nblk, nb = item % nblk, k0 = 64 * kb, n0 = 64 * nb;
    const int n4 = (lane & 15) * 4, kp = lane >> 4;
    const float* src = W + (size_t)(k0 + 2 * kp) * N + n0 + n4;
    f32x4 v[8][2];
#pragma unroll
    for (int i = 0; i < 8; ++i) { v[i][0] = __builtin_nontemporal_load((const f32x4*)(src + (size_t)(8 * i) * N)); v[i][1] = __builtin_nontemporal_load((const f32x4*)(src + (size_t)(8 * i + 1) * N)); }
#pragma unroll
    for (int i = 0; i < 8; ++i) { const int k = 8 * i + 2 * kp;
#pragma unroll
        for (int j = 0; j < 4; ++j) *(LAS unsigned*)(scr + (n4 + j) * 144 + k * 2) = cvt_pk_bf16(v[i][0][j], v[i][1][j]); }
    LDS_WAIT(); asm volatile("" ::: "memory");
    const int ch = lane & 7;
#pragma unroll
    for (int j = 0; j < 8; ++j) { const int n = (lane >> 3) + 8 * j;
        const v4u o = *(const LAS v4u*)(scr + n * 144 + ch * 16);
        *(GAS v4u*)(WT + (size_t)(row_off + n0 + n) * K + k0 + 8 * ch) = o; }
    LDS_WAIT(); asm volatile("" ::: "memory");
}
__device__ __forceinline__ void convert_layer(const Frame& F, int l) {
    LAS unsigned char* scr = F.lds + F.wave * 16384;
    constexpr int I_IN = 32 * 272, I_SQ = 32 * 32, I_F1 = 32 * 128, I_F2 = 128 * 32, I_LRU = 64 * 4;
    constexpr int NITEMS = I_IN + 4 * I_SQ + I_F1 + I_F2 + I_LRU;
    const float* w_in = inp<I_WIN>(F) + (size_t)l * D * INW; const float* w_ao = inp<I_WAO>(F) + (size_t)l * D * D; const float* w_lo = inp<I_WLO>(F) + (size_t)l * D * D;
    const float* w_co = inp<I_WCO>(F) + (size_t)l * D * D; const float* w_out = inp<I_WOUT>(F) + (size_t)l * D * D; const float* w_f1 = inp<I_WFF1>(F) + (size_t)l * D * DFF;
    const float* w_f2 = inp<I_WFF2>(F) + (size_t)l * DFF * D; const float* lwa = inp<I_LWA>(F) + (size_t)l * 2 * 16 * 16384; const float* lwx = inp<I_LWX>(F) + (size_t)l * 2 * 16 * 16384;
    for (int it = F.gw; it < NITEMS; it += F.NGW) {
        int r = it;
        if (r < I_IN) { transpose_item(w_in, D, INW, F.WIN(), 0, scr, r, F.lane); continue; } r -= I_IN;
        if (r < I_SQ) { transpose_item(w_ao, D, D, F.WBR(), 0, scr, r, F.lane); continue; } r -= I_SQ;
        if (r < I_SQ) { transpose_item(w_lo, D, D, F.WBR(), D, scr, r, F.lane); continue; } r -= I_SQ;
        if (r < I_SQ) { transpose_item(w_co, D, D, F.WBR(), 2 * D, scr, r, F.lane); continue; } r -= I_SQ;
        if (r < I_SQ) { transpose_item(w_out, D, D, F.WOUT(), 0, scr, r, F.lane); continue; } r -= I_SQ;
        if (r < I_F1) { transpose_item(w_f1, D, DFF, F.WFF1(), 0, scr, r, F.lane); continue; } r -= I_F1;
        if (r < I_F2) { transpose_item(w_f2, DFF, D, F.WFF2(), 0, scr, r, F.lane); continue; } r -= I_F2;
        { const int bi = r >> 2, sub = r & 3, d = bi >> 5, mat = (bi >> 4) & 1, blk = bi & 15;
          const float* src = (mat ? lwx : lwa) + ((size_t)d * 16 + blk) * 16384;
          transpose_item(src, 128, 128, F.WLRU() + (size_t)bi * 16384, 0, scr, sub, F.lane); }
    }
    const float* cw = inp<I_CMWS>(F) + (size_t)l * 16 * 16384;
    for (int i = (F.gw * 64 + F.lane) * 8; i < 16 * 16384; i += F.NGW * 64 * 8) {
        const f32x4 a = *(const f32x4*)(cw + i), b = *(const f32x4*)(cw + i + 4);
        v4u o; o.x = pk2(a.x, a.y); o.y = pk2(a.z, a.w); o.z = pk2(b.x, b.y); o.w = pk2(b.z, b.w);
        *(v4u*)(F.CMW() + i) = o;
    }
}
__device__ __forceinline__ void mod_partials(const Frame& F) {
    LAS float* scr = (LAS float*)(F.lds + F.wave * 16384);
    const float* cctx = inp<I_CCTX>(F); const float* cc = inp<I_C>(F); const float* wmod = inp<I_WMOD>(F);
    for (int it = F.gw; it < DEPTH * 48 * NMODK; it += F.NGW) {
        const int kc = it % NMODK, jb = (it / NMODK) % 48, l = it / (NMODK * 48), k0 = kc * 64;
        for (int e = F.lane; e < NCOND * 64; e += 64) { const int ci = e >> 6, kk = e & 63; const float v = ci == 0 ? cctx[k0 + kk] : cc[(ci - 1) * D + k0 + kk]; scr[e] = v * (1.f / (1.f + __expf(-v))); }
        LDS_WAIT(); asm volatile("" ::: "memory");
        f32x4 acc[NCOND];
#pragma unroll
        for (int ci = 0; ci < NCOND; ++ci) acc[ci] = (f32x4){0.f, 0.f, 0.f, 0.f};
        const float* wp = wmod + ((size_t)l * D + k0) * 12288 + jb * 256 + F.lane * 4;
#pragma unroll
        for (int kb = 0; kb < 64; kb += 16) {
            f32x4 w[16];
#pragma unroll
            for (int kk = 0; kk < 16; ++kk) w[kk] = *(const f32x4*)(wp + (size_t)(kb + kk) * 12288);
#pragma unroll
            for (int kk = 0; kk < 16; ++kk)
#pragma unroll
                for (int ci = 0; ci < NCOND; ++ci) acc[ci] += w[kk] * scr[ci * 64 + kb + kk];
        }
#pragma unroll
        for (int ci = 0; ci < NCOND; ++ci) *(f32x4*)(F.MODP() + (((size_t)kc * DEPTH + l) * NCOND + ci) * 12288 + jb * 256 + F.lane * 4) = acc[ci];
        LDS_WAIT(); asm volatile("" ::: "memory");
    }
}
__device__ __forceinline__ void mod_reduce(const Frame& F) {
    constexpr int NEL = DEPTH * NCOND * 12288;
    for (int i = (F.gw * 64 + F.lane) * 4; i < NEL; i += F.NGW * 64 * 4) {
        const int l = i / (NCOND * 12288), j = i % 12288;
        f32x4 s = *(const f32x4*)(inp<I_BMOD>(F) + (size_t)l * 12288 + j);
#pragma unroll
        for (int kc = 0; kc < NMODK; ++kc) s += *(const f32x4*)(F.MODP() + (size_t)kc * NEL + i);
        *(f32x4*)(F.MOD() + i) = s;
    }
}
__device__ __forceinline__ void rope_table(const Frame& F) {
    if (F.bx == 0) for (int e = F.tid; e < 2048; e += NWAVES * 64) {
        const int pos = e >> 5, f = e & 31; const float inv = exp2f(-(float)f * (13.287712379549449f / 32.f)); float s, c; sincosf((float)pos * inv, &s, &c);
        F.ROPE()[e] = c; F.ROPE()[2048 + e] = s; }
}
struct RowIn { f32x4 x[4][2]; u32x4 f[4]; float st; };
template <bool HAS_F>
__device__ __forceinline__ void row_load(const Frame& F, RowIn& R, const float* xsrc, const bf16_t* frow, const float* fstat) {
#pragma unroll
    for (int j = 0; j < 4; ++j) { const int e = (j * 64 + F.lane) * 8; R.x[j][0] = __builtin_nontemporal_load((const f32x4*)(xsrc + e)); R.x[j][1] = __builtin_nontemporal_load((const f32x4*)(xsrc + e + 4)); }
    if (HAS_F) {
#pragma unroll
        for (int j = 0; j < 4; ++j) R.f[j] = __builtin_nontemporal_load((const u32x4*)(frow + (j * 64 + F.lane) * 8));
        R.st = F.lane < 32 ? fstat[F.lane] : 0.f;
    }
}
template <bool HAS_F, bool HAS_H>
__device__ __forceinline__ void row_apply(const Frame& F, RowIn& R, float* xdst, const float* gate, const float* gpost, const float* gpre, const float* sc, const float* sh, bf16_t* hrow, float gs) {
    if (HAS_F) {
        const float rs = rsqrtf(wave_sum(R.st) * (1.f / D) + EPS) * gs;
#pragma unroll
        for (int j = 0; j < 4; ++j) { const int e = (j * 64 + F.lane) * 8; const u32x4 fw = R.f[j];
            const f32x4 g0 = *(const f32x4*)(gate + e), g1 = *(const f32x4*)(gate + e + 4), p0 = *(const f32x4*)(gpost + e), p1 = *(const f32x4*)(gpost + e + 4);
            const f32x4 f0 = {bflo(fw.x), bfhi(fw.x), bflo(fw.y), bfhi(fw.y)}, f1 = {bflo(fw.z), bfhi(fw.z), bflo(fw.w), bfhi(fw.w)};
            R.x[j][0] += g0 * (f0 * rs * p0); R.x[j][1] += g1 * (f1 * rs * p1); }
    }
#pragma unroll
    for (int j = 0; j < 4; ++j) { const int e = (j * 64 + F.lane) * 8; __builtin_nontemporal_store(R.x[j][0], (f32x4*)(xdst + e)); __builtin_nontemporal_store(R.x[j][1], (f32x4*)(xdst + e + 4)); }
    if (HAS_H) {
        float ss = 0.f;
#pragma unroll
        for (int j = 0; j < 4; ++j)
#pragma unroll
            for (int h = 0; h < 2; ++h) ss += (R.x[j][h].x * R.x[j][h].x + R.x[j][h].y * R.x[j][h].y) + (R.x[j][h].z * R.x[j][h].z + R.x[j][h].w * R.x[j][h].w);
        const float rs = rsqrtf(wave_sum(ss) * (1.f / D) + EPS);
#pragma unroll
        for (int j = 0; j < 4; ++j) { const int e = (j * 64 + F.lane) * 8;
            f32x4 o[2];
#pragma unroll
            for (int h = 0; h < 2; ++h) { const f32x4 g = *(const f32x4*)(gpre + e + 4 * h), s1 = *(const f32x4*)(sc + e + 4 * h), s0 = *(const f32x4*)(sh + e + 4 * h); o[h] = R.x[j][h] * rs * g * (s1 + 1.f) + s0; }
            u32x4 w; w.x = cvt_pk_bf16(o[0].x, o[0].y); w.y = cvt_pk_bf16(o[0].z, o[0].w); w.z = cvt_pk_bf16(o[1].x, o[1].y); w.w = cvt_pk_bf16(o[1].z, o[1].w);
            *(u32x4*)(hrow + e) = w; }
    }
}
__device__ __forceinline__ int cond_of_row(int m) { return m < MP ? 0 : 1 + ((m - MP) >> 11); }
template <int MODE>
__device__ __forceinline__ void rowlocal_phase(const Frame& F, int l, float gs = 1.f) {
    const float* xp = inp<I_XP>(F); const float* xs = inp<I_XS>(F);
    const float* gpost = MODE == 1 ? inp<I_GPOM>(F) + (size_t)l * D : inp<I_GPOF>(F) + (size_t)l * D;
    const float* gpre = MODE == 0 ? inp<I_GPM>(F) : MODE == 1 ? inp<I_GPF>(F) + (size_t)l * D : inp<I_GPM>(F) + (size_t)(l + 1 < DEPTH ? l + 1 : l) * D;
    float* X = F.x(); const bf16_t* Fb = F.Fb(); const float* FS = F.FSTAT(); bf16_t* H = F.H(); const float* MODb = F.MOD();
    constexpr bool HAS_F = MODE != 0;
    RowIn A, B;
    auto src = [&](int m) -> const float* { return MODE == 0 ? (m < MP ? xp + (size_t)m * D : xs + (size_t)(m - MP) * D) : X + (size_t)m * D; };
    int m = F.gw;
    if (m < M) row_load<HAS_F>(F, A, src(m), Fb + (size_t)m * D, FS + (size_t)m * 32);
    for (; m < M; m += 2 * F.NGW) {
#pragma unroll
        for (int half = 0; half < 2; ++half) {
            const int mc = m + half * F.NGW, mn = mc + F.NGW;
            if (mc >= M) break;
            RowIn& cur = half ? B : A; RowIn& nxt = half ? A : B;
            if (mn < M) row_load<HAS_F>(F, nxt, src(mn), Fb + (size_t)mn * D, FS + (size_t)mn * 32);
            const int ci = cond_of_row(mc);
            const float* modl = MODb + ((size_t)l * NCOND + ci) * 12288;
            float* xrow = X + (size_t)mc * D; bf16_t* hrow = H + (size_t)mc * D;
            if (MODE == 0) row_apply<false, true>(F, cur, xrow, nullptr, nullptr, gpre, modl + 1 * D, modl + 0 * D, hrow, gs);
            else if (MODE == 1) row_apply<true, true>(F, cur, xrow, modl + 2 * D, gpost, gpre, modl + 4 * D, modl + 3 * D, hrow, gs);
            else if (l + 1 < DEPTH) { const float* modn = MODb + ((size_t)(l + 1) * NCOND + ci) * 12288; row_apply<true, true>(F, cur, xrow, modl + 5 * D, gpost, gpre, modn + 1 * D, modn + 0 * D, hrow, gs); }
            else row_apply<true, false>(F, cur, xrow, modl + 5 * D, gpost, nullptr, nullptr, nullptr, nullptr, gs);
        }
    }
}
__device__ __forceinline__ u32x4 pack8(const f32x4& a, const f32x4& b) { u32x4 w; w.x = cvt_pk_bf16(a[0], a[1]); w.y = cvt_pk_bf16(a[2], a[3]); w.z = cvt_pk_bf16(b[0], b[1]); w.w = cvt_pk_bf16(b[2], b[3]); return w; }
typedef float f32x2 __attribute__((ext_vector_type(2)));
__device__ __forceinline__ f32x2 sigm2(f32x2 x) { const f32x2 t = x * -1.4426950408889634f; const f32x2 e = (f32x2){__builtin_amdgcn_exp2f(t.x), __builtin_amdgcn_exp2f(t.y)} + 1.f; return (f32x2){__builtin_amdgcn_rcpf(e.x), __builtin_amdgcn_rcpf(e.y)}; }
__device__ __forceinline__ f32x2 gelu2(f32x2 x) { const f32x2 t = x * ((x * x) * -0.10294324f + -2.3022082f);
    const f32x2 e = (f32x2){__builtin_amdgcn_exp2f(t.x), __builtin_amdgcn_exp2f(t.y)} + 1.f; return x * (f32x2){__builtin_amdgcn_rcpf(e.x), __builtin_amdgcn_rcpf(e.y)}; }
__device__ __forceinline__ f32x4 gelu4(const f32x4& v) { const f32x2 a = gelu2((f32x2){v[0], v[1]}), b = gelu2((f32x2){v[2], v[3]}); return (f32x4){a.x, a.y, b.x, b.y}; }
__device__ __forceinline__ f32x4 sigm4(const f32x4& v) { const f32x2 a = sigm2((f32x2){v[0], v[1]}), b = sigm2((f32x2){v[2], v[3]}); return (f32x4){a.x, a.y, b.x, b.y}; }
__device__ __forceinline__ int kv_row(int m) { return m < MP ? m : MP + ((m - MP) >> 11) * 2304 + ((m - MP) & 2047); }
struct EpiIn {
    static constexpr bool PERM = true, AFTER_DRAIN = false;
    bf16_t* Z; bf16_t* VALL; float* new_v; float* cvstat; int layer;
    __device__ __forceinline__ void operator()(const f32x4 (&acc)[2][2][4][2], const Unit& u, int wr, int wc, int fr, int fq) const {
        const int pn = u.pn, row0 = u.pm * 256 + wr * 64 + fr, cl = wc * 32 + 8 * fq;
        if (pn >= 10 && pn < 12) {
            const int colv = (pn - 10) * 256 + cl;
#pragma unroll
            for (int ai = 0; ai < 2; ++ai)
#pragma unroll
                for (int m = 0; m < 4; ++m) { const int row = row0 + ai * 128 + m * 16; bf16_t* dst = VALL + (size_t)kv_row(row) * 512 + colv;
#pragma unroll
                    for (int bj = 0; bj < 2; ++bj) { *(u32x4*)(dst + bj * 128) = pack8(acc[ai][bj][m][0], acc[ai][bj][m][1]);
                        if (row < MP) { float* nv = new_v + ((size_t)((row >> 8) * DEPTH + layer) * 256 + (row & 255)) * 512 + colv + bj * 128; *(f32x4*)nv = acc[ai][bj][m][0]; *(f32x4*)(nv + 4) = acc[ai][bj][m][1]; } } }
            return;
        }
        const int mode = (pn < 20) ? 0 : (pn < 36) ? 1 : (pn < 44) ? 2 : 3;
        const int col0 = pn * 256 + cl;
#pragma unroll
        for (int ai = 0; ai < 2; ++ai)
#pragma unroll
            for (int m = 0; m < 4; ++m) { const int row = row0 + ai * 128 + m * 16; bf16_t* dst = Z + (size_t)row * INW + col0; float ss = 0.f;
#pragma unroll
                for (int bj = 0; bj < 2; ++bj) { f32x4 v0 = acc[ai][bj][m][0], v1 = acc[ai][bj][m][1];
                    if (mode == 1 || mode == 2) { v0 = gelu4(v0); v1 = gelu4(v1); }
                    if (mode == 3) { v0 = sigm4(v0); v1 = sigm4(v1); }
                    if (mode == 2) ss += (v0[0] * v0[0] + v0[1] * v0[1]) + (v0[2] * v0[2] + v0[3] * v0[3]) + (v1[0] * v1[0] + v1[1] * v1[1]) + (v1[2] * v1[2] + v1[3] * v1[3]);
                    *(u32x4*)(dst + bj * 128) = pack8(v0, v1); }
                if (mode == 2) { ss += __shfl_xor(ss, 16); ss += __shfl_xor(ss, 32); if (fq == 0) cvstat[(size_t)row * 32 + (pn - 36) * 4 + wc] = ss; } }
    }
};
struct EpiRelu2 {
    static constexpr bool PERM = true, AFTER_DRAIN = false;
    bf16_t* O; int ldc;
    __device__ __forceinline__ void operator()(const f32x4 (&acc)[2][2][4][2], const Unit& u, int wr, int wc, int fr, int fq) const {
        const int row0 = u.pm * 256 + wr * 64 + fr, col0 = u.pn * 256 + wc * 32 + 8 * fq;
#pragma unroll
        for (int ai = 0; ai < 2; ++ai)
#pragma unroll
            for (int m = 0; m < 4; ++m) { bf16_t* dst = O + (size_t)(row0 + ai * 128 + m * 16) * ldc + col0;
#pragma unroll
                for (int bj = 0; bj < 2; ++bj) { f32x4 v0 = __builtin_elementwise_max(acc[ai][bj][m][0], (f32x4){0.f, 0.f, 0.f, 0.f}), v1 = __builtin_elementwise_max(acc[ai][bj][m][1], (f32x4){0.f, 0.f, 0.f, 0.f});
                    *(u32x4*)(dst + bj * 128) = pack8(v0 * v0, v1 * v1); } }
    }
};
struct EpiF {
    static constexpr bool PERM = true, AFTER_DRAIN = false;
    bf16_t* O; float* stat;
    __device__ __forceinline__ void operator()(const f32x4 (&acc)[2][2][4][2], const Unit& u, int wr, int wc, int fr, int fq) const {
        const int row0 = u.pm * 256 + wr * 64 + fr, col0 = u.pn * 256 + wc * 32 + 8 * fq;
#pragma unroll
        for (int ai = 0; ai < 2; ++ai)
#pragma unroll
            for (int m = 0; m < 4; ++m) { const int row = row0 + ai * 128 + m * 16; bf16_t* dst = O + (size_t)row * D + col0; float ss = 0.f;
#pragma unroll
                for (int bj = 0; bj < 2; ++bj) { const f32x4 v0 = acc[ai][bj][m][0], v1 = acc[ai][bj][m][1];
                    ss += (v0[0] * v0[0] + v0[1] * v0[1]) + (v0[2] * v0[2] + v0[3] * v0[3]) + (v1[0] * v1[0] + v1[1] * v1[1]) + (v1[2] * v1[2] + v1[3] * v1[3]);
                    *(u32x4*)(dst + bj * 128) = pack8(v0, v1); }
                ss += __shfl_xor(ss, 16); ss += __shfl_xor(ss, 32); if (fq == 0) stat[(size_t)row * 32 + u.pn * 4 + wc] = ss; }
    }
};
struct EpiMerge {
    static constexpr bool PERM = true, AFTER_DRAIN = false;
    const bf16_t* Z; float* scr  ; bf16_t* O;
    __device__ __forceinline__ void operator()(const f32x4 (&acc)[2][2][4][2], const Unit& u, int wr, int wc, int fr, int fq) const {
        const int br = u.pn >> 3, pn = u.pn & 7, pm = u.pm - 96 * br;
        const int rl0 = wr * 64 + fr, cl = wc * 32 + 8 * fq;
#pragma unroll
        for (int ai = 0; ai < 2; ++ai)
#pragma unroll
            for (int m = 0; m < 4; ++m) { const int rl = rl0 + ai * 128 + m * 16, row = pm * 256 + rl;
#pragma unroll
                for (int bj = 0; bj < 2; ++bj) { const int c = cl + bj * 128;
                    const u32x4 gw = *(const u32x4*)(Z + (size_t)row * INW + OFF_G + br * D + pn * 256 + c);
                    const f32x4 g0 = {bflo(gw.x), bfhi(gw.x), bflo(gw.y), bfhi(gw.y)}, g1 = {bflo(gw.z), bfhi(gw.z), bflo(gw.w), bfhi(gw.w)};
                    f32x4 v0 = g0 * acc[ai][bj][m][0], v1 = g1 * acc[ai][bj][m][1];
                    float* sp = scr + rl * 256 + c;
                    if (br > 0) { v0 += *(const f32x4*)sp; v1 += *(const f32x4*)(sp + 4); }
                    if (br < 2) { *(f32x4*)sp = v0; *(f32x4*)(sp + 4) = v1; }
                    else *(u32x4*)(O + (size_t)row * D + pn * 256 + c) = pack8(v0, v1); } }
    }
};
struct MergeOrder {
    pg8::StaticOrder so;
    __device__ void init(int G, int c) { so.init(M, D, G, c); }
    __device__ bool next(int i, Unit& u) const { const int br = i % 3; if (!so.next(i / 3, u)) return false; u.pm += 96 * br; u.pn += 8 * br; return true; }
    __device__ __forceinline__ void a_ready(const Unit&) const {}
    __device__ __forceinline__ void done(const Unit&) const {}
};
}
namespace fk {
typedef short bf16x8 __attribute__((ext_vector_type(8)));
__device__ __forceinline__ void prep_row(const Frame& F, int m, int l) {
    const bool sample = m >= MP; int b, t;
    if (!sample) { b = m >> 8; t = m & 255; } else { b = (m - MP) >> 11; t = (m - MP) & 2047; }
    const int kvrow = sample ? MP + b * 2304 + t : m;
    const int lane = F.lane, g8 = lane >> 3, j = lane & 7, axis = g8 & 1, hsel = lane >> 4;
    bf16_t* zrow = F.Z() + (size_t)m * INW;
    const int dA = axis * 64 + 4 * j, dB = dA + 32;
    const f32x4 gqa = *(const f32x4*)(inp<I_GQ>(F) + l * 128 + dA), gqb = *(const f32x4*)(inp<I_GQ>(F) + l * 128 + dB);
    const f32x4 gka = *(const f32x4*)(inp<I_GK>(F) + l * 128 + dA), gkb = *(const f32x4*)(inp<I_GK>(F) + l * 128 + dB);
    f32x4 cs = {1.f, 1.f, 1.f, 1.f}, sn = {0.f, 0.f, 0.f, 0.f};
    if (sample) { const int pos = axis == 0 ? (t >> 6) : (t & 63); cs = *(const f32x4*)(F.ROPE() + pos * 32 + 4 * j); sn = *(const f32x4*)(F.ROPE() + 2048 + pos * 32 + 4 * j); }
#pragma unroll
    for (int pass = 0; pass < 5; ++pass) {
        const bool isq = pass < 4;
        const int base = isq ? OFF_Q + (pass * 4 + hsel) * 128 + dA : OFF_K + hsel * 128 + dA;
        const u32x2 wa = *(const u32x2*)(zrow + base), wb = *(const u32x2*)(zrow + base + 32);
        const f32x4 xa = {bflo(wa.x), bfhi(wa.x), bflo(wa.y), bfhi(wa.y)}, xb = {bflo(wb.x), bfhi(wb.x), bflo(wb.y), bfhi(wb.y)};
        float ss = (xa.x * xa.x + xa.y * xa.y) + (xa.z * xa.z + xa.w * xa.w) + (xb.x * xb.x + xb.y * xb.y) + (xb.z * xb.z + xb.w * xb.w);
        ss += __shfl_xor(ss, 1); ss += __shfl_xor(ss, 2); ss += __shfl_xor(ss, 4); ss += __shfl_xor(ss, 8);
        const float rs = rsqrtf(ss * (1.f / 128.f) + EPS);
        const f32x4 na = xa * rs * (isq ? gqa : gka), nb = xb * rs * (isq ? gqb : gkb);
        const f32x4 ra = na * cs - nb * sn, rb = na * sn + nb * cs;
        u32x2 oa, ob; oa.x = cvt_pk_bf16(ra.x, ra.y); oa.y = cvt_pk_bf16(ra.z, ra.w); ob.x = cvt_pk_bf16(rb.x, rb.y); ob.y = cvt_pk_bf16(rb.z, rb.w);
        if (isq) { *(u32x2*)(zrow + base) = oa; *(u32x2*)(zrow + base + 32) = ob; }
        else {
            bf16_t* kd = F.KALL() + (size_t)kvrow * 512 + hsel * 128 + dA; *(u32x2*)kd = oa; *(u32x2*)(kd + 32) = ob;
            if (!sample) { float* nk = F.new_k() + ((size_t)(b * DEPTH + l) * 256 + t) * 512 + hsel * 128 + dA; *(f32x4*)nk = na; *(f32x4*)(nk + 32) = nb; }
        }
    }
}
__device__ __forceinline__ void prep_phase(const Frame& F, int l) {
    for (int m = F.gw; m < M; m += F.NGW) prep_row(F, m, l);
    for (int it = F.gw; it < 2 * 8 * 256; it += F.NGW) {
        const int which = it >> 11, b = (it >> 8) & 7, p = it & 255;
        const float* src = (which ? inp<I_CV>(F) : inp<I_CK>(F)) + ((size_t)(b * DEPTH + l) * 256 + p) * 512 + F.lane * 8;
        bf16_t* dst = (which ? F.VALL() : F.KALL()) + (size_t)(MP + b * 2304 + 2048 + p) * 512 + F.lane * 8;
        const f32x4 a = *(const f32x4*)src, c = *(const f32x4*)(src + 4);
        *(u32x4*)dst = pack8(a, c);
    }
}
__device__ __forceinline__ int crow(int r, int hi) { return (r & 3) + 8 * (r >> 2) + 4 * hi; }
struct LruCtx {
    bf16x8 bw0[8], bw1[8];
    float bav, bxv, c8;
    bool small;
};
__device__ __forceinline__ void lru_ctx_load(const Frame& F, int l, int blk, LruCtx& X) {
    const int lane = F.lane, wave = F.wave, d = wave >> 2, n0 = (wave & 3) * 32, nl = lane & 31, hi = lane >> 5, C = blk * 128 + n0 + nl;
    const bf16_t* wb0 = F.WLRU() + ((size_t)((d * 2 + 0) * 16 + blk) * 128 + n0 + nl) * 128 + hi * 8;
    const bf16_t* wb1 = F.WLRU() + ((size_t)((d * 2 + 1) * 16 + blk) * 128 + n0 + nl) * 128 + hi * 8;
#pragma unroll
    for (int ks = 0; ks < 8; ++ks) { X.bw0[ks] = *(const bf16x8*)(wb0 + ks * 16); X.bw1[ks] = *(const bf16x8*)(wb1 + ks * 16); }
    X.bav = inp<I_LBA>(F)[(size_t)(l * 2 + d) * D + C]; X.bxv = inp<I_LBX>(F)[(size_t)(l * 2 + d) * D + C];
    const float lam = inp<I_LAM>(F)[(size_t)(l * 2 + d) * D + C];
    const float ex = __expf(-lam);
    const float sp = lam < -20.f ? -lam : ex < 0.05f ? ex * (1.f + ex * (-0.5f + ex * ((1.f / 3.f) + ex * (-0.25f + ex * 0.2f)))) : __logf(1.f + ex);
    X.c8 = -8.f * sp;
    X.small = __all(X.c8 > -0.5f);
}
struct LruGeo { int m0, b, t0, T; bool sample; };
__device__ __forceinline__ LruGeo lru_geo(int ck) { LruGeo g; g.m0 = ck * 64; g.sample = g.m0 >= MP;
    if (!g.sample) { g.b = g.m0 >> 8; g.t0 = g.m0 & 255; g.T = 256; } else { g.b = (g.m0 - MP) >> 11; g.t0 = (g.m0 - MP) & 2047; g.T = 2048; } return g; }
__device__ __forceinline__ void lru_conv_load(const Frame& F, f32x4 (&PF)[16], int t2, int ck, int blk, const float* __restrict__ cwl, const float* __restrict__ cbl) {
    const LruGeo G = lru_geo(ck); const int C0 = blk * 128; const bf16_t* Zb = F.Z();
    const int c4 = (t2 & 31) * 4, r0 = (t2 >> 5) * 8;
#pragma unroll
    for (int i = 0; i < 11; ++i) {
        const int tt = G.t0 + r0 + i - 2; u32x2 z = {0u, 0u};
        if (tt >= 0 && tt < G.T) z = *(const u32x2*)(Zb + (size_t)(G.m0 + r0 + i - 2) * INW + OFF_LX + C0 + c4);
        PF[i].x = __uint_as_float(z.x); PF[i].y = __uint_as_float(z.y);
    }
#pragma unroll
    for (int j = 0; j < 4; ++j) PF[11 + j] = *(const f32x4*)(cwl + (size_t)j * D + C0 + c4);
    PF[15] = *(const f32x4*)(cbl + C0 + c4);
}
__device__ __forceinline__ void lru_conv_math(const Frame& F, const f32x4 (&PF)[16], int t2) {
    LAS unsigned char* lds = F.lds; const int c4 = (t2 & 31) * 4, r0 = (t2 >> 5) * 8;
    f32x4 zr[11];
#pragma unroll
    for (int i = 0; i < 11; ++i) { const unsigned zx = __float_as_uint(PF[i].x), zy = __float_as_uint(PF[i].y); zr[i] = (f32x4){bflo(zx), bfhi(zx), bflo(zy), bfhi(zy)}; }
#pragma unroll
    for (int r = 0; r < 8; ++r) {
        const f32x4 y = PF[15] + zr[r] * PF[11] + zr[r + 1] * PF[12] + zr[r + 2] * PF[13] + zr[r + 3] * PF[14];
        u32x2 o; o.x = cvt_pk_bf16(y.x, y.y); o.y = cvt_pk_bf16(y.z, y.w);
        *(LAS u32x2*)(lds + LRU_XC + (r0 + r) * LRU_XC_PITCH + c4 * 2) = o;
    }
}
__device__ __forceinline__ void split_arrive(unsigned* cnt) {
    asm volatile("s_waitcnt vmcnt(0)" ::: "memory");
    __syncthreads();
    if (threadIdx.x == 0) { __builtin_amdgcn_fence(__ATOMIC_RELEASE, "agent"); asm volatile("s_waitcnt vmcnt(0)" ::: "memory"); (void)xb_add(cnt, 1u); }
}
__device__ __forceinline__ void split_wait(unsigned* cnt, unsigned G, unsigned* tmo) {
    if (threadIdx.x == 0) {
        unsigned sp = 0;
        while (xb_ld(cnt) < G) { __builtin_amdgcn_s_sleep(1); if ((++sp & 255u) == 0u) { if (xb_ld(tmo)) break; if (sp > XB_SPIN_CAP) { atomicAdd(tmo, 1u); break; } } }
        __builtin_amdgcn_fence(__ATOMIC_ACQUIRE, "agent"); asm volatile("s_waitcnt vmcnt(0)" ::: "memory");
    }
    __syncthreads();
}
__device__ __forceinline__ void lru_carry_phase(const Frame& F, int l) {
    const float* state_l = inp<I_SL>(F) + (size_t)l * 2 * D;
    const float* AGG = F.AGG(); float* CIN = F.CIN();
    for (int id = F.gw * 64 + F.lane; id < 40 * 2 * D; id += F.NGW * 64) {
        const int c = id & (D - 1), d = (id >> 11) & 1, sq = id >> 12;
        const bool sample = sq >= 32; const int ck0 = sample ? 128 + (sq - 32) * 32 : sq * 4;
        float carry = sample ? state_l[((size_t)(sq - 32) * DEPTH * 2 + d) * D + c] : 0.f;
        const float* ag = AGG + ((size_t)(ck0 * 2 + d) * D + c) * 2; float* ci = CIN + (size_t)(ck0 * 2 + d) * D + c;
        if (!sample) {
            float2 pe[4];
#pragma unroll
            for (int jj = 0; jj < 4; ++jj) pe[jj] = *(const float2*)(ag + (size_t)jj * 4 * D);
            if (d == 0) {
#pragma unroll
                for (int jj = 0; jj < 4; ++jj) { ci[(size_t)jj * 2 * D] = carry; carry = pe[jj].x * carry + pe[jj].y; } }
            else {
#pragma unroll
                for (int jj = 3; jj >= 0; --jj) { ci[(size_t)jj * 2 * D] = carry; carry = pe[jj].x * carry + pe[jj].y; } }
        } else {
            float2 pe[32];
#pragma unroll
            for (int jj = 0; jj < 32; ++jj) pe[jj] = *(const float2*)(ag + (size_t)jj * 4 * D);
            if (d == 0) {
#pragma unroll
                for (int jj = 0; jj < 32; ++jj) { ci[(size_t)jj * 2 * D] = carry; carry = pe[jj].x * carry + pe[jj].y; } }
            else {
#pragma unroll
                for (int jj = 31; jj >= 0; --jj) { ci[(size_t)jj * 2 * D] = carry; carry = pe[jj].x * carry + pe[jj].y; } }
        }
    }
}
__device__ __forceinline__ void lru_gates(const Frame& F, int lane, int wave, const LruCtx& X) {
    typedef float f32x2 __attribute__((ext_vector_type(2)));
    LAS unsigned char* lds = F.lds;
    const int d = wave >> 2, n0 = (wave & 3) * 32, nl = lane & 31, hi = lane >> 5, c = n0 + nl;
    LAS float* Ad = (LAS float*)(lds + (d ? LRU_A1 : LRU_A0)); LAS float* Bd = (LAS float*)(lds + (d ? LRU_B1 : LRU_B0));
    const float bav = X.bav, bxv = X.bxv, c8 = X.c8;
#pragma unroll
    for (int mt = 0; mt < 2; ++mt) {
        f32x16 acc0, acc1;
#pragma unroll
        for (int r = 0; r < 16; ++r) { acc0[r] = 0.f; acc1[r] = 0.f; }
        const LAS unsigned char* ap = lds + LRU_XC + (mt * 32 + nl) * LRU_XC_PITCH + hi * 16;
#pragma unroll
        for (int ks = 0; ks < 8; ++ks) {
            const bf16x8 a0 = *(const LAS bf16x8*)(ap + ks * 32);
            acc0 = __builtin_amdgcn_mfma_f32_32x32x16_bf16(a0, X.bw0[ks], acc0, 0, 0, 0);
            acc1 = __builtin_amdgcn_mfma_f32_32x32x16_bf16(a0, X.bw1[ks], acc1, 0, 0, 0);
        }
        if (X.small) {
#pragma unroll
            for (int r = 0; r < 16; r += 2) {
                const int tl = mt * 32 + crow(r, hi);
                const f32x2 pa = (f32x2){acc0[r], acc0[r + 1]} + bav, px = (f32x2){acc1[r], acc1[r + 1]} + bxv;
                const f32x2 ta = pa * -1.4426950408889634f, tx = px * -1.4426950408889634f;
                const f32x2 ea = (f32x2){__builtin_amdgcn_exp2f(ta.x), __builtin_amdgcn_exp2f(ta.y)} + 1.f, ex = (f32x2){__builtin_amdgcn_exp2f(tx.x), __builtin_amdgcn_exp2f(tx.y)} + 1.f;
                const f32x2 rg = {__builtin_amdgcn_rcpf(ea.x), __builtin_amdgcn_rcpf(ea.y)}, ig = {__builtin_amdgcn_rcpf(ex.x), __builtin_amdgcn_rcpf(ex.y)};
                const f32x2 la = rg * c8;
                f32x2 p = la * (1.f / 720.f) + (1.f / 120.f); p = p * la + (1.f / 24.f); p = p * la + (1.f / 6.f); p = p * la + 0.5f; p = p * la + 1.f;
                const f32x2 e1 = la * p;
                const f32x2 omr = (e1 + 2.f) * e1;
                const f32x2 sq = {__builtin_amdgcn_sqrtf(fmaxf(-omr.x, 0.f)), __builtin_amdgcn_sqrtf(fmaxf(-omr.y, 0.f))};
                const f32x2 xcv = {bf2f(*(const LAS unsigned short*)(lds + LRU_XC + tl * LRU_XC_PITCH + c * 2)), bf2f(*(const LAS unsigned short*)(lds + LRU_XC + (tl + 1) * LRU_XC_PITCH + c * 2))};
                const f32x2 av = e1 + 1.f, bt = sq * ig * xcv;
                Ad[tl * 128 + c] = av.x; Ad[(tl + 1) * 128 + c] = av.y; Bd[tl * 128 + c] = bt.x; Bd[(tl + 1) * 128 + c] = bt.y;
            }
        } else {
#pragma unroll
            for (int r = 0; r < 16; ++r) {
                const int tl = mt * 32 + crow(r, hi);
                const float rg = fsigm(acc0[r] + bav), ig = fsigm(acc1[r] + bxv);
                const float la = c8 * rg, a = __expf(la);
                const float mult = sqrtf(fmaxf(-expm1f(2.f * la), 0.f));
                const float xcv = bf2f(*(const LAS unsigned short*)(lds + LRU_XC + tl * LRU_XC_PITCH + c * 2));
                Ad[tl * 128 + c] = a; Bd[tl * 128 + c] = mult * ig * xcv;
            }
        }
    }
}
template <int PASS>
__device__ __forceinline__ void lru_scan(const Frame& F, int tid, float carry, int l, int ck, int blk, float* __restrict__ AGG) {
    LAS unsigned char* lds = F.lds; const LruGeo G = lru_geo(ck);
    const int d = tid >> 7, c = tid & 127, C = blk * 128 + c;
    const LAS float* Ad = (const LAS float*)(lds + (d ? LRU_A1 : LRU_A0)); LAS float* Bd = (LAS float*)(lds + (d ? LRU_B1 : LRU_B0));
    if (PASS == 1) {
        float h = 0.f, Pp = 1.f;
        if (d == 0) {
#pragma unroll 16
            for (int s = 0; s < 64; ++s) { const float a = Ad[s * 128 + c]; h = a * h + Bd[s * 128 + c]; Pp *= a; }
        } else {
#pragma unroll 16
            for (int s = 0; s < 64; ++s) { const float a = Ad[(63 - s) * 128 + c]; h = a * h + Bd[(63 - s) * 128 + c]; Pp *= a; }
        }
        *(float2*)(AGG + ((size_t)(ck * 2 + d) * D + C) * 2) = make_float2(Pp, h);
    } else {
        const int jc = G.t0 >> 6, nch = G.T >> 6;
        float h = carry;
        if (d == 0) {
#pragma unroll
            for (int s0 = 0; s0 < 64; s0 += 16) { float av[16], bv[16];
#pragma unroll
                for (int i = 0; i < 16; ++i) { av[i] = Ad[(s0 + i) * 128 + c]; bv[i] = Bd[(s0 + i) * 128 + c]; }
#pragma unroll
                for (int i = 0; i < 16; ++i) { h = av[i] * h + bv[i]; bv[i] = h; }
#pragma unroll
                for (int i = 0; i < 16; ++i) Bd[(s0 + i) * 128 + c] = bv[i]; }
        } else {
#pragma unroll
            for (int s0 = 0; s0 < 64; s0 += 16) { float av[16], bv[16];
#pragma unroll
                for (int i = 0; i < 16; ++i) { av[i] = Ad[(63 - s0 - i) * 128 + c]; bv[i] = Bd[(63 - s0 - i) * 128 + c]; }
#pragma unroll
                for (int i = 0; i < 16; ++i) { h = av[i] * h + bv[i]; bv[i] = h; }
#pragma unroll
                for (int i = 0; i < 16; ++i) Bd[(63 - s0 - i) * 128 + c] = bv[i]; }
        }
        if (!G.sample && ((d == 0 && jc == nch - 1) || (d == 1 && jc == 0))) F.new_s()[((size_t)(G.b * DEPTH + l) * 2 + d) * D + C] = h;
    }
}
__device__ __forceinline__ void lru_out(const Frame& F, int tid, int ck, int blk, const u32x4& g0, const u32x4& g1) {
    LAS unsigned char* lds = F.lds; const int m0 = ck * 64, C0 = blk * 128;
    const int row = tid >> 3, c16 = (tid & 7) * 16;
    const LAS float* h0 = (const LAS float*)(lds + LRU_B0) + row * 128 + c16; const LAS float* h1 = (const LAS float*)(lds + LRU_B1) + row * 128 + c16;
    const unsigned gw[8] = {g0.x, g0.y, g0.z, g0.w, g1.x, g1.y, g1.z, g1.w};
    unsigned ow[8];
#pragma unroll
    for (int i = 0; i < 8; ++i) ow[i] = cvt_pk_bf16((h0[2 * i] + h1[2 * i]) * bflo(gw[i]), (h0[2 * i + 1] + h1[2 * i + 1]) * bfhi(gw[i]));
    bf16_t* yp = F.BR() + (size_t)1 * M * D + (size_t)(m0 + row) * D + C0 + c16;
    *(u32x4*)yp = (u32x4){ow[0], ow[1], ow[2], ow[3]}; *(u32x4*)(yp + 8) = (u32x4){ow[4], ow[5], ow[6], ow[7]};
}
template <int PASS>
__device__ __forceinline__ void lru_phase(const Frame& F, int l) {
    LruCtx X; int cur = -1;
    float* AGG = F.AGG(); const float* CIN = F.CIN();
    const float* cwl = inp<I_CW>(F) + (size_t)l * 4 * D; const float* cbl = inp<I_CB>(F) + (size_t)l * D;
    constexpr int NU = 384 * 16;
    int u = F.bx;
    if (u < NU && F.tid >= 256) { f32x4 PF[16]; lru_conv_load(F, PF, F.tid - 256, u >> 4, u & 15, cwl, cbl); lru_conv_math(F, PF, F.tid - 256); }
    __syncthreads();
    for (; u < NU; u += F.G) {
        int tid_ = F.tid; asm volatile("" : "+v"(tid_));
        const int tid = tid_, lane = tid & 63, wave = __builtin_amdgcn_readfirstlane(tid >> 6);
        const int blk = u & 15, ck = u >> 4, un = u + F.G;
        if (blk != cur) { lru_ctx_load(F, l, blk, X); cur = blk; }
        u32x4 g0 = {0u, 0u, 0u, 0u}, g1 = {0u, 0u, 0u, 0u};
        const bf16_t* gp = F.Z() + (size_t)(ck * 64 + (tid >> 3)) * INW + OFF_LG + blk * 128 + (tid & 7) * 16;
        if (wave < 4) {
            float carry = 0.f;
            if (PASS == 2) carry = CIN[(size_t)(ck * 2 + (tid >> 7)) * D + blk * 128 + (tid & 127)];
            lru_gates(F, lane, wave, X);
            __syncthreads();
            if (PASS == 2) { g0 = *(const u32x4*)gp; g1 = *(const u32x4*)(gp + 8); }
            lru_scan<PASS>(F, tid, carry, l, ck, blk, AGG);
            __syncthreads();
        } else {
            f32x4 PF[16];
            if (un < NU) lru_conv_load(F, PF, tid - 256, un >> 4, un & 15, cwl, cbl);
            lru_gates(F, lane, wave, X);
            __syncthreads();
            if (PASS == 2) { g0 = *(const u32x4*)gp; g1 = *(const u32x4*)(gp + 8); }
            if (un < NU) lru_conv_math(F, PF, tid - 256);
            __syncthreads();
        }
        if (PASS == 2) { lru_out(F, tid, ck, blk, g0, g1); __syncthreads(); }
    }
}
constexpr int CM_V = 0, CM_OUT = 32768, CM_OUT_PITCH = 528, CM_RS2 = CM_OUT + 128 * CM_OUT_PITCH;
static_assert(CM_RS2 + 512 <= MISC_OFF, "cm lds map");
struct CmCtx { bf16x8 wa[8]; f32x4 ga, gb; };
__device__ __forceinline__ void cm_ctx_load(const Frame& F, int g, CmCtx& X, const float* __restrict__ cmg) {
    const int qt = F.wave & 3, xl = F.lane & 31, hi = F.lane >> 5;
    const bf16_t* wp = F.CMW() + ((size_t)g * 128 + qt * 32 + xl) * 128 + hi * 8;
#pragma unroll
    for (int i = 0; i < 8; ++i) X.wa[i] = *(const bf16x8*)(wp + i * 16);
    const int sc = (F.tid & 15) * 8;
    X.ga = *(const f32x4*)(cmg + g * 128 + sc); X.gb = *(const f32x4*)(cmg + g * 128 + sc + 4);
}
struct CmPre { u32x4 v[4]; float2 st[4]; };
__device__ __forceinline__ void cm_prefetch(const Frame& F, CmPre& R, int tid, int cn, int g) {
    const int sr = tid >> 4, q16 = tid & 15, sc = q16 * 8, m0 = cn * 128;
    const bf16_t* Zb = F.Z(); const float* ST = F.CVSTAT();
#pragma unroll
    for (int i = 0; i < 4; ++i) { const int p = (i >> 1) * 64 + (i & 1) * 32 + sr;
        R.v[i] = *(const u32x4*)(Zb + (size_t)(m0 + p) * INW + OFF_CV + g * 128 + sc);
        R.st[i] = *(const float2*)(ST + (size_t)(m0 + p) * 32 + q16 * 2); }
}
__device__ __forceinline__ void cm_stage(const Frame& F, const CmPre& R, const CmCtx& X, int tid) {
    LAS unsigned char* lds = F.lds; const int sr = tid >> 4, sc = (tid & 15) * 8;
#pragma unroll
    for (int i = 0; i < 4; ++i) {
        float s = R.st[i].x + R.st[i].y;
        s += __shfl_xor(s, 1); s += __shfl_xor(s, 2); s += __shfl_xor(s, 4); s += __shfl_xor(s, 8);
        const float rs = rsqrtf(s * (1.f / D) + EPS);
        const u32x4 w = R.v[i];
        const f32x4 v0 = (f32x4){bflo(w.x), bfhi(w.x), bflo(w.y), bfhi(w.y)} * X.ga * rs, v1 = (f32x4){bflo(w.z), bfhi(w.z), bflo(w.w), bfhi(w.w)} * X.gb * rs;
        *(LAS u32x4*)(lds + CM_V + (i >> 1) * 16384 + att::v_st((i & 1) * 32 + sr, sc)) = pack8(v0, v1);
    }
}
__device__ __forceinline__ void cm_mfma(const Frame& F, const CmCtx& X, int lane, int wave) {
    LAS unsigned char* lds = F.lds;
    const int qt = wave & 3, chh = wave >> 2, xl = lane & 31, hi = lane >> 5;
    f32x16 o0, o1;
#pragma unroll
    for (int r = 0; r < 16; ++r) { o0[r] = 0.f; o1[r] = 0.f; }
    const int vb = (int)(unsigned)(uintptr_t)(lds + CM_V) + att::v_rd_base(lane);
    if (chh == 0) {
        att::pv_one<0>(o0, vb, X.wa[0], X.wa[1], X.wa[2], X.wa[3]); att::pv_one<1>(o1, vb, X.wa[0], X.wa[1], X.wa[2], X.wa[3]);
        att::pv_one<0>(o0, vb + 16384, X.wa[4], X.wa[5], X.wa[6], X.wa[7]); att::pv_one<1>(o1, vb + 16384, X.wa[4], X.wa[5], X.wa[6], X.wa[7]);
    } else {
        att::pv_one<2>(o0, vb, X.wa[0], X.wa[1], X.wa[2], X.wa[3]); att::pv_one<3>(o1, vb, X.wa[0], X.wa[1], X.wa[2], X.wa[3]);
        att::pv_one<2>(o0, vb + 16384, X.wa[4], X.wa[5], X.wa[6], X.wa[7]); att::pv_one<3>(o1, vb + 16384, X.wa[4], X.wa[5], X.wa[6], X.wa[7]);
    }
#pragma unroll
    for (int r = 0; r < 16; ++r) { const int q = qt * 32 + crow(r, hi);
        *(LAS float*)(lds + CM_OUT + q * CM_OUT_PITCH + (chh * 64 + xl) * 4) = o0[r];
        *(LAS float*)(lds + CM_OUT + q * CM_OUT_PITCH + (chh * 64 + 32 + xl) * 4) = o1[r]; }
}
__device__ __forceinline__ void cm_epilogue(const Frame& F, int tid, int cn, int g, const float* __restrict__ bsg, const u32x4 (&uw)[4]) {
    LAS unsigned char* lds = F.lds; const int q = tid >> 2, c32 = (tid & 3) * 32, m0 = cn * 128; const float bias = bsg[q];
    bf16_t* op = F.BR() + (size_t)2 * M * D + (size_t)(m0 + q) * D + g * 128 + c32;
#pragma unroll
    for (int i = 0; i < 4; ++i) {
        const f32x4 a = *(const LAS f32x4*)(lds + CM_OUT + q * CM_OUT_PITCH + (c32 + i * 8) * 4), b2 = *(const LAS f32x4*)(lds + CM_OUT + q * CM_OUT_PITCH + (c32 + i * 8 + 4) * 4);
        const f32x4 u0 = {bflo(uw[i].x), bfhi(uw[i].x), bflo(uw[i].y), bfhi(uw[i].y)}, u1 = {bflo(uw[i].z), bfhi(uw[i].z), bflo(uw[i].w), bfhi(uw[i].w)};
        *(u32x4*)(op + i * 8) = pack8(u0 * (a + bias), u1 * (b2 + bias));
    }
}
__device__ __forceinline__ void cm_phase(const Frame& F, int l) {
    CmCtx X; int cur = -1;
    const float* cmg = inp<I_CMG>(F) + (size_t)l * D; const float* bs = inp<I_CMBS>(F) + (size_t)l * 16 * 128;
    constexpr int NU = 192 * 16;
    int u = F.bx;
    if (u < NU) { const int g = u & 15; cm_ctx_load(F, g, X, cmg); cur = g; CmPre R; cm_prefetch(F, R, F.tid, u >> 4, g); cm_stage(F, R, X, F.tid); }
    __syncthreads();
    for (; u < NU; u += F.G) {
        int tid_ = F.tid; asm volatile("" : "+v"(tid_));
        const int tid = tid_, lane = tid & 63, wave = __builtin_amdgcn_readfirstlane(tid >> 6);
        const int g = u & 15, cn = u >> 4, un = u + F.G;
        CmPre R;
        if (un < NU) cm_prefetch(F, R, tid, un >> 4, un & 15);
        u32x4 uw[4];
        { const bf16_t* up = F.Z() + (size_t)(cn * 128 + (tid >> 2)) * INW + OFF_CU + g * 128 + (tid & 3) * 32;
#pragma unroll
          for (int i = 0; i < 4; ++i) uw[i] = *(const u32x4*)(up + i * 8); }
        cm_mfma(F, X, lane, wave);
        __syncthreads();
        cm_epilogue(F, tid, cn, g, bs + g * 128, uw);
        if (un < NU) { const int gn = un & 15; if (gn != cur) { cm_ctx_load(F, gn, X, cmg); cur = gn; } cm_stage(F, R, X, tid); }
        __syncthreads();
    }
}
__device__ __forceinline__ void attn_phase(const Frame& F) {
    char* lds = (char*)F.lds;
    const att::bf16* Z = (const att::bf16*)F.Z(); const att::bf16* K = (const att::bf16*)F.KALL(); const att::bf16* V = (const att::bf16*)F.VALL(); att::bf16* O = (att::bf16*)F.BR();
    for (int id = F.vcu; id < 1536; id += F.G) {
        size_t qrow, kvrow; int h, nkeys;
        if (id < 1024) { const int qb = id & 7, b = id >> 7; h = (id >> 3) & 15; qrow = (size_t)MP + (size_t)b * 2048 + qb * 256; kvrow = (size_t)MP + (size_t)b * 2304; nkeys = 2304; }
        else { const int id2 = id - 1024, b = id2 >> 4; h = id2 & 15; qrow = (size_t)b * 256; kvrow = qrow; nkeys = 256; }
        att::attn_dense_body<att::bf16>(Z + qrow * INW + OFF_Q + h * 128, K + kvrow * 512 + (h >> 2) * 128, V + kvrow * 512 + (h >> 2) * 128, O + qrow * D + h * 128, nkeys, lds);
    }
    __syncthreads();
}
}
#ifndef REP_G
#define REP_G 1
#endif
#ifndef REP_A
#define REP_A 1
#endif
#ifndef REP_L
#define REP_L 1
#endif
#ifndef REP_V
#define REP_V 1
#endif
#ifndef REP_R
#define REP_R 1
#endif
#ifndef REP_GSEL
#define REP_GSEL 0
#endif
#ifndef REP_B
#define REP_B 1
#endif
#ifndef PG_ALIGN
#define PG_ALIGN true
#endif
#ifndef REP_C
#define REP_C 1
#endif
namespace fk {
#if REP_G > 1 || REP_GSEL > 0
template <class Base> struct RepOrder {
    Base b; int n;
    __device__ void init_n() { Unit u; n = 0; while (b.next(n, u)) ++n; }
    __device__ bool next(int i, Unit& u) const { if (i >= 2 * n) return false; return b.next(i >= n ? i - n : i, u); }
    __device__ __forceinline__ void a_ready(const Unit&) const {}
    __device__ __forceinline__ void done(const Unit&) const {}
};
#define GEMM_REP(EPI, ORD, g, S, E) do { RepOrder<ORD> RS_; RS_.b = S; RS_.init_n(); pg8::gemm_phase<EPI, RepOrder<ORD>, PG_ALIGN, true>(P.lds, g, RS_, E); } while (0)
#endif
#define GEMM_ONE(EPI, ORD, g, S, E) pg8::gemm_phase<EPI, ORD, PG_ALIGN, true>(P.lds, g, S, E)
#if REP_G > 1
#define GEMM_CALL(ID, EPI, ORD, g, S, E) GEMM_REP(EPI, ORD, g, S, E)
#elif REP_GSEL > 0
#define GEMM_CALL(ID, EPI, ORD, g, S, E) do { if (ID == REP_GSEL) GEMM_REP(EPI, ORD, g, S, E); else GEMM_ONE(EPI, ORD, g, S, E); } while (0)
#else
#define GEMM_CALL(ID, EPI, ORD, g, S, E) GEMM_ONE(EPI, ORD, g, S, E)
#endif
__global__ void __launch_bounds__(NWAVES * 64, 2) mega(Params p) {
    extern __shared__ __attribute__((aligned(16))) unsigned char lds_raw[];
    Frame F;
    F.lds = (LAS unsigned char*)lds_raw;
    F.tid = threadIdx.x; F.lane = F.tid & 63; F.wave = __builtin_amdgcn_readfirstlane(F.tid >> 6);
    F.G = gridDim.x; { const int bx = blockIdx.x; F.vcu = (F.G % 8 == 0) ? (bx % 8) * (F.G / 8) + bx / 8 : bx; }
    F.gw = F.vcu * NWAVES + F.wave; F.NGW = F.G * NWAVES; F.bx = blockIdx.x;
    F.out = p.out; F.ws = p.ws; F.ka = (kaptr_t)__builtin_amdgcn_kernarg_segment_ptr();
    unsigned char* ws = p.ws;
    volatile LAS unsigned* MISC = (volatile LAS unsigned*)(F.lds + MISC_OFF);
    for (int u = F.tid; u < (LDS_BYTES - MISC_OFF) / 4; u += NWAVES * 64) ((LAS unsigned*)(F.lds + MISC_OFF))[u] = 0u;
    __syncthreads();
    unsigned* barw = (unsigned*)(ws + WS_CTL) + CW_BAR + p.li * XCD_BAR_WORDS;
    XcdBarrier bar = xcd_barrier_post(barw, MISC + 8);
    const int lo = p.ph_lo, hi = p.ph_hi;
#define IN_PH(k) (lo <= (k) && (k) < hi)
#if REP_B > 1
#define SEAM(k) do { if ((k) + 1 < hi) { xcd_barrier(bar); xcd_barrier(bar); } } while (0)
#else
#define SEAM(k) do { if ((k) + 1 < hi) xcd_barrier(bar); } while (0)
#endif

    if (IN_PH(0)) { const Frame P = phase_frame(F);
convert_layer(P, 0); mod_partials(P); rope_table(P);
#if REP_V > 1
        __syncthreads(); convert_layer(P, 0); mod_partials(P);
#endif
 SEAM(0); }
    if (IN_PH(1)) { const Frame P = phase_frame(F); mod_reduce(P); SEAM(1); }
    if (IN_PH(2)) { const Frame P = phase_frame(F); rowlocal_phase<0>(P, 0); SEAM(2); }
    for (int l = 0; l < DEPTH; ++l) {
        const int pb = 3 + 9 * l;
        if (IN_PH(pb + 0)) { const Frame P = phase_frame(F);
            pg8::Gemm g{P.H(), P.WIN(), M, INW, D}; pg8::StaticOrder S; S.init(M, INW, P.G, P.bx);
            EpiIn E{P.Z(), P.VALL(), P.new_v(), P.CVSTAT(), l};

GEMM_CALL(1, EpiIn, pg8::StaticOrder, g, S, E);

            SEAM(pb + 0);
        }
        if (IN_PH(pb + 1)) { const Frame P = phase_frame(F);
            unsigned* ctl = (unsigned*)(P.ws + WS_CTL);
            lru_phase<1>(P, l);
#if REP_L > 1
            lru_phase<1>(P, l);
#endif
            split_arrive(ctl + CW_SPLIT + 64 * l);
            prep_phase(P, l);
            __syncthreads();
            cm_phase(P, l);
#if REP_C > 1
            cm_phase(P, l);
#endif
            split_wait(ctl + CW_SPLIT + 64 * l, (unsigned)P.G, barw + XB_TMO);
            lru_carry_phase(P, l);
            SEAM(pb + 1);
        }
        if (IN_PH(pb + 2)) { const Frame P = phase_frame(F);

attn_phase(P);
#if REP_A > 1
            attn_phase(P);
#endif


lru_phase<2>(P, l);
#if REP_L > 1
            lru_phase<2>(P, l);
#endif

            SEAM(pb + 2);
        }
        if (IN_PH(pb + 3)) { const Frame P = phase_frame(F);
            pg8::Gemm g{P.BR(), P.WBR(), 3 * M, 3 * D, D}; MergeOrder S; S.init(P.G, P.bx);
            EpiMerge E{P.Z(), P.MSCR() + (size_t)P.bx * 65536, P.H()};

GEMM_CALL(2, EpiMerge, MergeOrder, g, S, E);

            SEAM(pb + 3);
        }
        if (IN_PH(pb + 4)) { const Frame P = phase_frame(F);
            pg8::Gemm g{P.H(), P.WOUT(), M, D, D}; pg8::StaticOrder S; S.init(M, D, P.G, P.bx);
            EpiF E{P.Fb(), P.FSTAT()};

GEMM_CALL(3, EpiF, pg8::StaticOrder, g, S, E);
            SEAM(pb + 4);

        }
        if (IN_PH(pb + 5)) { const Frame P = phase_frame(F);

#if REP_R > 1
            rowlocal_phase<1>(P, l, 0.f);
#endif
            rowlocal_phase<1>(P, l);
 SEAM(pb + 5); }
        if (IN_PH(pb + 6)) { const Frame P = phase_frame(F);
            pg8::Gemm g{P.H(), P.WFF1(), M, DFF, D}; pg8::StaticOrder S; S.init(M, DFF, P.G, P.bx);
            EpiRelu2 E{P.FFH(), DFF};

GEMM_CALL(4, EpiRelu2, pg8::StaticOrder, g, S, E);

            SEAM(pb + 6);
        }
        if (IN_PH(pb + 7)) { const Frame P = phase_frame(F);
            pg8::Gemm g{P.FFH(), P.WFF2(), M, D, DFF}; pg8::StaticOrder S; S.init(M, D, P.G, P.bx);
            EpiF E{P.Fb(), P.FSTAT()};

GEMM_CALL(5, EpiF, pg8::StaticOrder, g, S, E);
            SEAM(pb + 7);

        }
        if (IN_PH(pb + 8)) { const Frame P = phase_frame(F);


#if REP_R > 1
            rowlocal_phase<2>(P, l, 0.f);
#endif
            rowlocal_phase<2>(P, l);


if (l + 1 < DEPTH) { __syncthreads(); convert_layer(P, l + 1); }
#if REP_V > 1
            if (l + 1 < DEPTH) { __syncthreads(); convert_layer(P, l + 1); }
#endif

            SEAM(pb + 8);
        }
    }
#undef IN_PH
#undef SEAM
}
}
extern "C" void kernel_launch(void* const* d_in, const int* in_sizes, int n_in, void* d_out, int out_size, void* d_ws, size_t ws_size, hipStream_t stream) {
    static int grid = 0;
    if (grid == 0) {
        if (n_in != 32 || out_size != 84410368 || ws_size < fk::WS_END) { fprintf(stderr, "kernel_launch: unexpected shapes: n_in %d out %d ws %zu (need %zu)\n", n_in, out_size, ws_size, (size_t)fk::WS_END); grid = -1; return; }
        int dev = 0, cus = 0;
        if (hipGetDevice(&dev) != hipSuccess || hipDeviceGetAttribute(&cus, hipDeviceAttributeMultiprocessorCount, dev) != hipSuccess) { grid = -1; return; }
        if (hipFuncSetAttribute((const void*)fk::mega, hipFuncAttributeMaxDynamicSharedMemorySize, fk::LDS_BYTES) != hipSuccess) { fprintf(stderr, "kernel_launch: hipFuncSetAttribute failed\n"); grid = -1; return; }
        int per_cu = 0;
        if (hipOccupancyMaxActiveBlocksPerMultiprocessor(&per_cu, (const void*)fk::mega, fk::NWAVES * 64, fk::LDS_BYTES) != hipSuccess || per_cu < 1) fprintf(stderr, "kernel_launch: occupancy query says %d blocks per CU\n", per_cu);
        (void)hipGetLastError();
        grid = cus < 256 ? cus : 256;
    }
    if (grid < 0) return;
    (void)hipMemsetAsync((char*)d_ws + fk::WS_CTL, 0, fk::CTL_ZERO_BYTES, stream);
    fk::Params p{};
    for (int i = 0; i < 32; ++i) p.in[i] = (const float*)d_in[i];
    p.out = (float*)d_out; p.ws = (unsigned char*)d_ws; p.ph_lo = 0; p.ph_hi = fk::NPHASE; p.li = 0; p.pad = 0;
    hipLaunchKernelGGL(fk::mega, dim3(grid), dim3(fk::NWAVES * 64), fk::LDS_BYTES, stream, p);
}
```

```cpp
#include <hip/hip_runtime.h>
#include <hip/hip_bf16.h>
#include <cstdio>
#include <cstdint>
namespace pg8 {
#define PG8_LAS __attribute__((address_space(3)))
typedef unsigned short bf16_t;
typedef short bf16x8 __attribute__((ext_vector_type(8)));
typedef float f32x4 __attribute__((ext_vector_type(4)));
typedef unsigned u32x4 __attribute__((ext_vector_type(4)));
constexpr int BM = 256, BK = 64, HALF = 128, HTB = HALF * BK * 2  , STAGE_BYTES = 8 * HTB, NXCD = 8, WGM = 8;

__host__ __device__ __forceinline__ int lds_byte(int r, int c) { const int st = (r >> 4) * 2 + (c >> 5), rr = r & 15, cc = c & 31, ob = rr * 64 + cc * 2; return st * 1024 + (ob ^ (((ob >> 9) & 1) << 5)); }
__host__ __device__ __forceinline__ void stage_rc(int b, int& R, int& C) { const int st = b / 1024, sb = b % 1024, swz = sb ^ (((sb >> 9) & 1) << 5); R = (st >> 1) * 16 + swz / 64; C = (st & 1) * 32 + (swz % 64) / 2; }
__host__ __device__ __forceinline__ int perm32(int rho) { const int n = rho >> 4, i = rho & 15; return 8 * (i >> 2) + 4 * n + (i & 3); }

struct Unit { int pm, pn; };
struct Gemm { const bf16_t* A; const bf16_t* Bt; int M, N, K; };

struct StaticOrder {
    int nM, nN, nwg, G, c;
    __host__ __device__ void init(int M, int N, int G_, int c_) { nM = M / BM; nN = N / BM; nwg = nM * nN; G = G_; c = c_; }
    __host__ __device__ bool next(int i, Unit& u) const {
        const long L = (long)i * G + c; if (L >= nwg) return false;
        int wgid = (int)L; { const int q = nwg / NXCD, r = nwg % NXCD, xcd = wgid % NXCD, off = wgid / NXCD; wgid = (xcd < r ? xcd * (q + 1) : r * (q + 1) + (xcd - r) * q) + off; }
        const int nig = WGM * nN, gid = wgid / nig, fm = gid * WGM, gsz = (nM - fm) < WGM ? (nM - fm) : WGM;
        u.pm = fm + ((wgid % nig) % gsz); u.pn = (wgid % nig) / gsz; return true;
    }
    __device__ __forceinline__ void a_ready(const Unit&) const {}
    __device__ __forceinline__ void done(const Unit&) const {}
};
__device__ __forceinline__ unsigned cvt_pk_bf16(float lo, float hi) { unsigned r; asm volatile("v_cvt_pk_bf16_f32 %0, %1, %2" : "=v"(r) : "v"(lo), "v"(hi)); return r; }
template <class Epi, class Sched, bool ALIGN_EPI = false, bool SP2 = false>
__device__ __forceinline__ void gemm_phase(PG8_LAS unsigned char* lds, const Gemm g, const Sched& S, const Epi& E) {
    int tid_ = threadIdx.x; asm volatile("" : "+v"(tid_));
    const int tid = tid_, wid = __builtin_amdgcn_readfirstlane(tid >> 6), lane = tid & 63, wr = wid >> 2, wc = wid & 3, fr = lane & 15, fq = lane >> 4;
    const int K = g.K, nt = K / BK;
    unsigned voffA[2], voffB[2];
#pragma unroll
    for (int i = 0; i < 2; ++i) { int R, C; stage_rc(tid * 16 + i * 8192, R, C); const int Rb = Epi::PERM ? ((R & ~31) + perm32(R & 31)) : R;
        voffA[i] = (unsigned)(R * K + C) * 2u; voffB[i] = (unsigned)(Rb * K + C) * 2u; }
    const size_t kstep = (size_t)(BK * 2);
    const size_t hstep = (size_t)HALF * K * 2;
    const size_t tstep = 2 * hstep;
    const unsigned ldsw = (unsigned)wid * 1024u;
    const int aoff = lds_byte(wr * 64 + fr, fq * 8), boff = lds_byte(wc * 32 + fr, fq * 8);
#define PG8_SA(b, h) (((b) * 2 + (h)) * HTB)
#define PG8_SB(b, h) ((4 + (b) * 2 + (h)) * HTB)
#define PG8_STAGE(bufoff, gbase, voff) do { _Pragma("unroll") for (int _i = 0; _i < 2; ++_i) \
        __builtin_amdgcn_global_load_lds((const unsigned*)((const char*)(gbase) + (voff)[_i]), (PG8_LAS unsigned*)(lds + (bufoff) + ldsw + _i * 8192), 16, 0, 0); } while (0)
#define PG8_LDA(dst, b, h) do { _Pragma("unroll") for (int m = 0; m < 4; ++m) _Pragma("unroll") for (int k = 0; k < 2; ++k) dst[m][k] = *(const PG8_LAS bf16x8*)(lds + PG8_SA(b, h) + aoff + m * 2048 + k * 1024); } while (0)
#define PG8_LDB(dst, b, h) do { _Pragma("unroll") for (int n = 0; n < 2; ++n) _Pragma("unroll") for (int k = 0; k < 2; ++k) dst[n][k] = *(const PG8_LAS bf16x8*)(lds + PG8_SB(b, h) + boff + n * 2048 + k * 1024); } while (0)
#define PG8_MMA(ai, bj, At, Bt) do { __builtin_amdgcn_s_setprio(1); _Pragma("unroll") for (int m = 0; m < 4; ++m) _Pragma("unroll") for (int n = 0; n < 2; ++n) _Pragma("unroll") for (int k = 0; k < 2; ++k) \
        acc[ai][bj][m][n] = __builtin_amdgcn_mfma_f32_16x16x32_bf16(Bt[n][k], At[m][k], acc[ai][bj][m][n], 0, 0, 0); __builtin_amdgcn_s_setprio(0); } while (0)
#define PG8_WAIT_V(n) asm volatile("s_waitcnt vmcnt(" #n ")" ::: "memory")
#define PG8_WAIT_L(n) asm volatile("s_waitcnt lgkmcnt(" #n ")" ::: "memory")
#define PG8_BAR __builtin_amdgcn_s_barrier()
#define PG8_SCHED __builtin_amdgcn_sched_barrier(0)
    Unit cur, nxt; int ui = 0;
    if (!S.next(0, cur)) return;
    f32x4 acc[2][2][4][2];
#pragma unroll
    for (int a = 0; a < 2; ++a)
#pragma unroll
        for (int b = 0; b < 2; ++b)
#pragma unroll
            for (int m = 0; m < 4; ++m)
#pragma unroll
                for (int n = 0; n < 2; ++n) acc[a][b][m][n] = (f32x4){0.f, 0.f, 0.f, 0.f};
    bf16x8 At[4][2], B0[2][2], B1[2][2];
    const char* cA = (const char*)g.A + (size_t)cur.pm * tstep; const char* cB = (const char*)g.Bt + (size_t)cur.pn * tstep;
    S.a_ready(cur);
    if constexpr (SP2) {
        PG8_STAGE(PG8_SB(0, 0), cB, voffB); PG8_STAGE(PG8_SB(0, 1), cB + hstep, voffB); PG8_STAGE(PG8_SA(0, 0), cA, voffA); PG8_STAGE(PG8_SA(0, 1), cA + hstep, voffA);
        if (wr == 1) PG8_BAR;
        PG8_WAIT_V(2); PG8_BAR;
        PG8_STAGE(PG8_SB(1, 0), cB + kstep, voffB); PG8_STAGE(PG8_SA(1, 0), cA + kstep, voffA); PG8_STAGE(PG8_SB(1, 1), cB + hstep + kstep, voffB);
        PG8_WAIT_V(6); PG8_BAR;
    } else {
        PG8_STAGE(PG8_SB(0, 0), cB, voffB); PG8_STAGE(PG8_SA(0, 0), cA, voffA); PG8_STAGE(PG8_SB(0, 1), cB + hstep, voffB); PG8_STAGE(PG8_SA(0, 1), cA + hstep, voffA);
        if (wr == 1) PG8_BAR;
        PG8_WAIT_V(4); PG8_BAR;
        PG8_STAGE(PG8_SB(1, 0), cB + kstep, voffB); PG8_STAGE(PG8_SA(1, 0), cA + kstep, voffA); PG8_STAGE(PG8_SB(1, 1), cB + hstep + kstep, voffB);
        PG8_WAIT_V(6); PG8_BAR;
    }
    for (;;) {
        const bool has_next = S.next(ui + 1, nxt);
        const char* nA = has_next ? (const char*)g.A + (size_t)nxt.pm * tstep : cA; const char* nB = has_next ? (const char*)g.Bt + (size_t)nxt.pn * tstep : cB;
        for (int t = 0; t < nt; t += 2) {
            const bool last = (t == nt - 2);
            const char* a1 = cA + (size_t)(t + 1) * kstep;
            const char* a2 = last ? nA : cA + (size_t)(t + 2) * kstep; const char* b2 = last ? nB : cB + (size_t)(t + 2) * kstep;
            const char* a3 = a2 + kstep; const char* b3 = b2 + kstep;
            if (last && has_next) S.a_ready(nxt);
            if constexpr (SP2) {
            PG8_LDB(B0, 0, 0); PG8_LDB(B1, 0, 1); PG8_SCHED; PG8_LDA(At, 0, 0); PG8_STAGE(PG8_SA(1, 1), a1 + hstep, voffA);
            PG8_WAIT_V(8); PG8_WAIT_L(0); PG8_BAR; PG8_MMA(0, 0, At, B0); PG8_MMA(0, 1, At, B1); PG8_BAR; PG8_SCHED;
            PG8_LDA(At, 0, 1); PG8_STAGE(PG8_SB(0, 0), b2, voffB); PG8_STAGE(PG8_SB(0, 1), b2 + hstep, voffB); PG8_STAGE(PG8_SA(0, 0), a2, voffA);
            PG8_WAIT_V(8); PG8_WAIT_L(0); PG8_BAR; PG8_MMA(1, 0, At, B0); PG8_MMA(1, 1, At, B1); PG8_BAR; PG8_SCHED;
            PG8_LDB(B0, 1, 0); PG8_LDB(B1, 1, 1); PG8_SCHED; PG8_LDA(At, 1, 0); PG8_STAGE(PG8_SA(0, 1), a2 + hstep, voffA);
            PG8_WAIT_V(8); PG8_WAIT_L(0); PG8_BAR; PG8_MMA(0, 0, At, B0); PG8_MMA(0, 1, At, B1); PG8_BAR; PG8_SCHED;
            PG8_LDA(At, 1, 1); PG8_STAGE(PG8_SB(1, 0), b3, voffB); PG8_STAGE(PG8_SB(1, 1), b3 + hstep, voffB); PG8_STAGE(PG8_SA(1, 0), a3, voffA);
            PG8_WAIT_V(8); PG8_WAIT_L(0); PG8_BAR; PG8_MMA(1, 0, At, B0); PG8_MMA(1, 1, At, B1); PG8_BAR; PG8_SCHED;
            } else {
            PG8_LDB(B0, 0, 0); PG8_SCHED; PG8_LDA(At, 0, 0); PG8_STAGE(PG8_SA(1, 1), a1 + hstep, voffA);
            PG8_WAIT_L(8); PG8_BAR; PG8_WAIT_L(0); PG8_MMA(0, 0, At, B0); PG8_BAR; PG8_SCHED;
            PG8_LDB(B1, 0, 1); PG8_STAGE(PG8_SB(0, 0), b2, voffB);
            PG8_BAR; PG8_WAIT_L(0); PG8_MMA(0, 1, At, B1); PG8_BAR;
            PG8_LDA(At, 0, 1); PG8_STAGE(PG8_SA(0, 0), a2, voffA);
            PG8_BAR; PG8_WAIT_L(0); PG8_MMA(1, 0, At, B0); PG8_BAR; PG8_SCHED;
            PG8_STAGE(PG8_SB(0, 1), b2 + hstep, voffB);
            PG8_WAIT_V(6); PG8_BAR; PG8_MMA(1, 1, At, B1); PG8_BAR;
            PG8_LDB(B0, 1, 0); PG8_SCHED; PG8_LDA(At, 1, 0); PG8_STAGE(PG8_SA(0, 1), a2 + hstep, voffA);
            PG8_WAIT_L(8); PG8_BAR; PG8_WAIT_L(0); PG8_MMA(0, 0, At, B0); PG8_BAR; PG8_SCHED;
            PG8_LDB(B1, 1, 1); PG8_STAGE(PG8_SB(1, 0), b3, voffB);
            PG8_BAR; PG8_WAIT_L(0); PG8_MMA(0, 1, At, B1); PG8_BAR;
            PG8_LDA(At, 1, 1); PG8_STAGE(PG8_SA(1, 0), a3, voffA);
            PG8_BAR; PG8_WAIT_L(0); PG8_MMA(1, 0, At, B0); PG8_BAR; PG8_SCHED;
            PG8_STAGE(PG8_SB(1, 1), b3 + hstep, voffB);
            PG8_WAIT_V(6); PG8_BAR; PG8_MMA(1, 1, At, B1); PG8_BAR;
            }
        }
        if constexpr (ALIGN_EPI) { if (wr == 0) PG8_BAR; }
        if constexpr (!Epi::AFTER_DRAIN) { E(acc, cur, wr, wc, fr, fq); S.done(cur); }
        if (!has_next) break;
#pragma unroll
        for (int a = 0; a < 2; ++a)
#pragma unroll
            for (int b = 0; b < 2; ++b)
#pragma unroll
                for (int m = 0; m < 4; ++m)
#pragma unroll
                    for (int n = 0; n < 2; ++n) acc[a][b][m][n] = (f32x4){0.f, 0.f, 0.f, 0.f};
        cur = nxt; cA = nA; cB = nB; ++ui;
        if constexpr (ALIGN_EPI) { if (wr == 1) PG8_BAR; }
    }
    PG8_WAIT_V(0);
    if constexpr (!ALIGN_EPI) { if (wr == 0) PG8_BAR; }
    PG8_BAR;
    if constexpr (Epi::AFTER_DRAIN) { E.fused(acc, cur, wr, wc, fr, fq, lds, wid, lane); S.done(cur); }
#undef PG8_SA
#undef PG8_SB
#undef PG8_STAGE
#undef PG8_LDA
#undef PG8_LDB
#undef PG8_MMA
#undef PG8_WAIT_V
#undef PG8_WAIT_L
#undef PG8_BAR
#undef PG8_SCHED
}
}
#define GAS __attribute__((address_space(1)))
#define LAS __attribute__((address_space(3)))
typedef unsigned short bf16;
typedef unsigned v4u __attribute__((ext_vector_type(4)));
typedef float f32x4 __attribute__((ext_vector_type(4)));
typedef short bf16x8 __attribute__((ext_vector_type(8)));
typedef GAS unsigned gu32;
typedef GAS unsigned long long gu64;
#define RLX_AGENT __ATOMIC_RELAXED, __HIP_MEMORY_SCOPE_AGENT
#define LDS_WAIT() asm volatile("s_waitcnt lgkmcnt(0)" ::: "memory")
#define VM_WAIT() asm volatile("s_waitcnt vmcnt(0)" ::: "memory")
__device__ __forceinline__ unsigned long long rt() { return __builtin_amdgcn_s_memrealtime(); }
__device__ __forceinline__ unsigned f2bf(float f) { unsigned u = __builtin_bit_cast(unsigned, f); return (u + 0x7fffu + ((u >> 16) & 1u)) >> 16; }
__device__ __forceinline__ unsigned pk2(float lo, float hi) { return f2bf(lo) | (f2bf(hi) << 16); }

#define XB_TMO      128
#define XB_XCNT(j)  (256  + 64 * (j))
#define XB_XSUB(j)  (1280 + 64 * (j))
#define XB_XGEN(j)  (2304 + 64 * (j))
#define XB_TOP      3328
#define XB_TOPGEN   3392
#define XCD_BAR_WORDS 3456
#define XB_SPIN_CAP (1u << 18)

__device__ __forceinline__ unsigned xb_ld(unsigned* p)              { return __hip_atomic_load(p, __ATOMIC_RELAXED, __HIP_MEMORY_SCOPE_AGENT); }
__device__ __forceinline__ unsigned xb_add(unsigned* p, unsigned v) { return __hip_atomic_fetch_add(p, v, __ATOMIC_RELAXED, __HIP_MEMORY_SCOPE_AGENT); }
__device__ __forceinline__ unsigned xb_xcc_id() { return (unsigned)__builtin_amdgcn_s_getreg((3 << 11) | 20) & 0xFu; }
#define XB_SPIN(cond, bar) do { unsigned _sp = 0; while (cond) { __builtin_amdgcn_s_sleep(1); \
    if ((++_sp & 255u) == 0u) { if (xb_ld(&(bar)[XB_TMO])) break; if (_sp > XB_SPIN_CAP) { atomicAdd(&(bar)[XB_TMO], 1u); break; } } } } while (0)

struct XcdBarrier {
    unsigned* bar; unsigned x;
    volatile LAS unsigned* st;
};

__device__ __forceinline__ XcdBarrier xcd_barrier_post(unsigned* bar, volatile LAS unsigned* st) {
    XcdBarrier b; b.bar = bar; b.x = xb_xcc_id(); b.st = st;
    if (threadIdx.x == 0) (void)xb_add(&bar[XB_XCNT(b.x)], 1u);
    return b;
}
__device__ __forceinline__ void xcd_barrier_complete(unsigned* bar, unsigned x, unsigned& nloc, unsigned& nx) {
    const unsigned G = gridDim.x * gridDim.y * gridDim.z;
    unsigned sum, cnt, mine, sp = 0u;
    for (;;) {
        sum = 0u; cnt = 0u; mine = 0u;
#pragma unroll
        for (unsigned j = 0; j < 16; ++j) { const unsigned c = xb_ld(&bar[XB_XCNT(j)]); sum += c; cnt += (c > 0u) ? 1u : 0u; mine = (j == x) ? c : mine; }
        if (sum == G) break;
        __builtin_amdgcn_s_sleep(1);
        if ((++sp & 255u) == 0u) { if (xb_ld(&bar[XB_TMO])) break; if (sp > XB_SPIN_CAP) { atomicAdd(&bar[XB_TMO], 1u); break; } }
    }
    nloc = mine > 0u ? mine : 1u; nx = cnt > 0u ? cnt : 1u;
}

__device__ __forceinline__ void xcd_barrier(const XcdBarrier& b) {
    asm volatile("s_waitcnt vmcnt(0)" ::: "memory");
    __syncthreads();
    if (threadIdx.x == 0) {
        unsigned* bar = b.bar;
        __builtin_amdgcn_s_waitcnt(0);
        unsigned nloc = b.st[0], nx = b.st[1];
        if (nloc == 0u) { xcd_barrier_complete(bar, b.x, nloc, nx); b.st[0] = nloc; b.st[1] = nx; }
        const unsigned old = xb_add(&bar[XB_XSUB(b.x)], 1u);
        const unsigned gen = old / nloc;
        if (old + 1u == (gen + 1u) * nloc) {
            __builtin_amdgcn_fence(__ATOMIC_RELEASE, "agent");
            asm volatile("s_waitcnt vmcnt(0)" ::: "memory");
            const unsigned og = xb_add(&bar[XB_TOP], 1u);
            const unsigned tg = og / nx;
            if (og + 1u == (tg + 1u) * nx) xb_add(&bar[XB_TOPGEN], 1u);
            else XB_SPIN(xb_ld(&bar[XB_TOPGEN]) == tg, bar);
            __builtin_amdgcn_fence(__ATOMIC_ACQUIRE, "agent");
            xb_add(&bar[XB_XGEN(b.x)], 1u);
            asm volatile("s_waitcnt vmcnt(0)" ::: "memory");
        } else {
            XB_SPIN(xb_ld(&bar[XB_XGEN(b.x)]) == gen, bar);
            __builtin_amdgcn_fence(__ATOMIC_ACQUIRE, "agent");
            asm volatile("s_waitcnt vmcnt(0)" ::: "memory");
        }
    }
    __syncthreads();
}
namespace att {
constexpr int   D = 128, NW = 8, QBLK = 32, KVBLK = 64;
constexpr float SCALE = 0.088388347648318440f;
constexpr float THR = 8.f;
constexpr int SDEPTH = 2;
constexpr int LDQ = 17408, LDK = 512, LDO = 2048;
constexpr size_t SHM_V = KVBLK * D * 2, SHM_K = KVBLK * D * 2, SHM_ATTN = 2 * SHM_V + 2 * SHM_K + NW * 64 * 4;
using bf16 = __hip_bfloat16;
using bf16x8 = __attribute__((ext_vector_type(8))) short;
using s16x4  = __attribute__((ext_vector_type(4))) short;
using f32x16 = __attribute__((ext_vector_type(16))) float;
using f32x8  = __attribute__((ext_vector_type(8))) float;
using u32x4  = __attribute__((ext_vector_type(4))) unsigned;
#define KSWZ(row, colB) ((row) * 256 + ((colB) ^ (((row) & 7) << 4)))
#define SBAR() __builtin_amdgcn_sched_barrier(0)
__device__ __forceinline__ int crow(int r, int hi) { return (r & 3) + 8 * (r >> 2) + 4 * hi; }
__device__ __forceinline__ unsigned cvtpk(float lo, float hi) {
  unsigned r; asm volatile("v_cvt_pk_bf16_f32 %0, %1, %2" : "=v"(r) : "v"(lo), "v"(hi)); return r;
}
template <typename TIn> struct Stage;
template <> struct Stage<bf16>  { using T = bf16x8;
  __device__ static __forceinline__ T ld8(const bf16* p) { return *reinterpret_cast<const bf16x8*>(p); }
  __device__ static __forceinline__ bf16x8 tobf(T x) { return x; } };
template <> struct Stage<float> { using T = f32x8;
  __device__ static __forceinline__ T ld8(const float* p) { return *reinterpret_cast<const f32x8*>(p); }
  __device__ static __forceinline__ bf16x8 tobf(T x) {
    u32x4 w = {cvtpk(x[0], x[1]), cvtpk(x[2], x[3]), cvtpk(x[4], x[5]), cvtpk(x[6], x[7])}; return *reinterpret_cast<bf16x8*>(&w); } };

__device__ __forceinline__ void partialSM(f32x16& p0, f32x16& p1, float& m_reg, float& mn, float& alpha) {
  constexpr float C = SCALE * 1.4426950408889634f;
  float pmax = p0[0]; for (int r = 1; r < 16; ++r) pmax = fmaxf(pmax, p0[r]); for (int r = 0; r < 16; ++r) pmax = fmaxf(pmax, p1[r]);
  { auto rr = __builtin_amdgcn_permlane32_swap(__float_as_uint(pmax), __float_as_uint(pmax), false, false);
    pmax = fmaxf(__uint_as_float(rr[0]), __uint_as_float(rr[1])); }
  if (__builtin_expect(__all(pmax - m_reg <= THR / SCALE), 1)) { mn = m_reg; alpha = 1.f; }
  else { mn = fmaxf(m_reg, pmax); alpha = __builtin_amdgcn_exp2f((m_reg - mn) * C); m_reg = mn; }
  float mnC = -mn * C;
  for (int r = 0; r < 16; ++r) p0[r] = fmaf(p0[r], C, mnC); for (int r = 0; r < 16; ++r) p1[r] = fmaf(p1[r], C, mnC);
  for (int r = 0; r < 16; ++r) p0[r] = __builtin_amdgcn_exp2f(p0[r]);
}
__device__ __forceinline__ void finishSM(f32x16& p0, f32x16& p1, float alpha, float& l_reg, bf16x8& pa0, bf16x8& pa1, bf16x8& pa2, bf16x8& pa3) {
  for (int r = 0; r < 16; ++r) p1[r] = __builtin_amdgcn_exp2f(p1[r]);
  float ps = 0; for (int r = 0; r < 16; ++r) ps += p0[r]; for (int r = 0; r < 16; ++r) ps += p1[r];
  { auto rr = __builtin_amdgcn_permlane32_swap(__float_as_uint(ps), __float_as_uint(ps), false, false);
    ps = __uint_as_float(rr[0]) + __uint_as_float(rr[1]); }
  l_reg = l_reg * alpha + ps;
#define PK4(P, BASE, OUT) do { unsigned a0 = cvtpk(P[BASE + 0], P[BASE + 1]), a1 = cvtpk(P[BASE + 2], P[BASE + 3]);   \
    unsigned b0 = cvtpk(P[BASE + 4], P[BASE + 5]), b1 = cvtpk(P[BASE + 6], P[BASE + 7]);                              \
    auto r0 = __builtin_amdgcn_permlane32_swap(a0, b0, false, false); auto r1 = __builtin_amdgcn_permlane32_swap(a1, b1, false, false); \
    u32x4 w = {r0[0], r1[0], r0[1], r1[1]}; OUT = *reinterpret_cast<bf16x8*>(&w); } while (0)
  PK4(p0, 0, pa0); PK4(p0, 8, pa1); PK4(p1, 0, pa2); PK4(p1, 8, pa3);
#undef PK4
}
__device__ __forceinline__ void qkt(f32x16& p0, f32x16& p1, const bf16* Ks, const bf16x8* qr, int r32, int hi) {
  p0 = f32x16{}; p1 = f32x16{};
  for (int d0 = 0; d0 < 8; ++d0) { int cb = (d0 * 16 + hi * 8) * 2;
    bf16x8 b0 = *reinterpret_cast<const bf16x8*>((const char*)Ks + KSWZ(r32, cb));
    bf16x8 b1 = *reinterpret_cast<const bf16x8*>((const char*)Ks + KSWZ(32 + r32, cb));
    p0 = __builtin_amdgcn_mfma_f32_32x32x16_bf16(b0, qr[d0], p0, 0, 0, 0);
    p1 = __builtin_amdgcn_mfma_f32_32x32x16_bf16(b1, qr[d0], p1, 0, 0, 0); }
}
__device__ __forceinline__ int v_st(int k, int c) { const int kk = (k & ~0xC) | ((k & 4) << 1) | ((k & 8) >> 1); return ((kk >> 3) * 4 + (c >> 5)) * 512 + ((kk & 7) * 32 + (c & 31)) * 2; }
__device__ __forceinline__ int v_rd_base(int lane) { return ((lane & 3) << 3) | (((lane >> 2) & 3) << 6) | (((lane >> 4) & 1) << 5) | (((lane >> 5) & 1) << 8); }
constexpr int v_rd_off(int d0, int ks, int half) { return d0 * 512 + ks * 4096 + half * 2048; }
template <int OFF> __device__ __forceinline__ s16x4 tr_read(int vb) {
  s16x4 r; asm volatile("ds_read_b64_tr_b16 %0, %1 offset:%2" : "=&v"(r) : "v"(vb), "i"(OFF) : "memory"); return r;
}
template <int D0> __device__ __forceinline__ void pv_one(f32x16& od, int vb, bf16x8 pa0, bf16x8 pa1, bf16x8 pa2, bf16x8 pa3) {
  const s16x4 l0 = tr_read<v_rd_off(D0, 0, 0)>(vb), h0 = tr_read<v_rd_off(D0, 0, 1)>(vb), l1 = tr_read<v_rd_off(D0, 1, 0)>(vb), h1 = tr_read<v_rd_off(D0, 1, 1)>(vb);
  const s16x4 l2 = tr_read<v_rd_off(D0, 2, 0)>(vb), h2 = tr_read<v_rd_off(D0, 2, 1)>(vb), l3 = tr_read<v_rd_off(D0, 3, 0)>(vb), h3 = tr_read<v_rd_off(D0, 3, 1)>(vb);
  asm volatile("s_waitcnt lgkmcnt(0)" ::: "memory"); SBAR();
#define PK(L, H) (bf16x8){L[0], L[1], L[2], L[3], H[0], H[1], H[2], H[3]}
  od = __builtin_amdgcn_mfma_f32_32x32x16_bf16(pa0, PK(l0, h0), od, 0, 0, 0);
  od = __builtin_amdgcn_mfma_f32_32x32x16_bf16(pa1, PK(l1, h1), od, 0, 0, 0);
  od = __builtin_amdgcn_mfma_f32_32x32x16_bf16(pa2, PK(l2, h2), od, 0, 0, 0);
  od = __builtin_amdgcn_mfma_f32_32x32x16_bf16(pa3, PK(l3, h3), od, 0, 0, 0);
#undef PK
}
__device__ __forceinline__ void pv_d0(f32x16* o, int vb, bf16x8 pa0, bf16x8 pa1, bf16x8 pa2, bf16x8 pa3) {
  pv_one<0>(o[0], vb, pa0, pa1, pa2, pa3); pv_one<1>(o[1], vb, pa0, pa1, pa2, pa3); pv_one<2>(o[2], vb, pa0, pa1, pa2, pa3); pv_one<3>(o[3], vb, pa0, pa1, pa2, pa3);
}

template <typename TQ>
__device__ __forceinline__ void attn_dense_body(const TQ* __restrict__ Qb, const bf16* __restrict__ Kh, const bf16* __restrict__ Vh,
                                                bf16* __restrict__ Ob, int seq, char* lds) {
  using St = Stage<bf16>; using SQ = Stage<TQ>;
  int tid_ = threadIdx.x; asm volatile("" : "+v"(tid_));
  const int tid = tid_, wid = tid >> 6, lane = tid & 63, r32 = lane & 31, hi = lane >> 5;
  bf16* V_lds = (bf16*)lds; bf16* K_lds = (bf16*)(lds + 2 * SHM_V);
  float* ws = (float*)(lds + 2 * SHM_V + 2 * SHM_K) + wid * 64; float* li_l = ws; float* al_l = ws + 32;
  float m_reg = -1e30f, l_reg = 0; f32x16 o[4] = {}; bf16x8 qr[8];
  const TQ* Qw = Qb + (long)(wid * QBLK + r32) * LDQ + hi * 8;
#pragma unroll
  for (int d0 = 0; d0 < 8; ++d0) qr[d0] = SQ::tobf(SQ::ld8(Qw + d0 * 16));
  const int sr = tid >> 4, sc = (tid & 15) * 8, vst0 = v_st(sr, sc), vst1 = v_st(32 + sr, sc);
  const int vb0 = (int)(uintptr_t)V_lds + v_rd_base(lane);
  struct { typename St::T vs0, vs1, ks0, ks1; } sr_[SDEPTH];
#define SLOAD(i, k0) do { sr_[i].vs0 = St::ld8(&Vh[(long)((k0) + sr) * LDK + sc]); sr_[i].vs1 = St::ld8(&Vh[(long)((k0) + 32 + sr) * LDK + sc]); \
    sr_[i].ks0 = St::ld8(&Kh[(long)((k0) + sr) * LDK + sc]); sr_[i].ks1 = St::ld8(&Kh[(long)((k0) + 32 + sr) * LDK + sc]); } while (0)
#define SWRITE(b, i) do { *(bf16x8*)((char*)V_lds + (b) * SHM_V + vst0) = St::tobf(sr_[i].vs0);          \
    *(bf16x8*)((char*)V_lds + (b) * SHM_V + vst1) = St::tobf(sr_[i].vs1); int kc = sc * 2;               \
    *(bf16x8*)((char*)K_lds + (b) * SHM_K + KSWZ(sr, kc)) = St::tobf(sr_[i].ks0);                       \
    *(bf16x8*)((char*)K_lds + (b) * SHM_K + KSWZ(32 + sr, kc)) = St::tobf(sr_[i].ks1); } while (0)
#define SWAIT() do { if constexpr (SDEPTH == 2) asm volatile("s_waitcnt vmcnt(4)" ::: "memory"); else asm volatile("s_waitcnt vmcnt(0)" ::: "memory"); } while (0)
#define RESC(a) do { if (__any((a) < 1.f)) { if (hi == 0) al_l[r32] = (a); asm volatile("s_waitcnt lgkmcnt(0)" ::: "memory"); \
    for (int d = 0; d < 4; ++d) for (int r = 0; r < 16; ++r) o[d][r] *= al_l[crow(r, hi)]; } } while (0)
  f32x16 pA0, pA1, pB0, pB1; float mnA, mnB, alA, alB; bf16x8 pa0, pa1, pa2, pa3; const int NT = seq / KVBLK;
  constexpr int SE = 0, SO = SDEPTH - 1;
  SLOAD(SE, 0); asm volatile("s_waitcnt vmcnt(0)" ::: "memory"); SWRITE(0, SE); __syncthreads();
  qkt(pA0, pA1, K_lds, qr, r32, hi); partialSM(pA0, pA1, m_reg, mnA, alA);
  SLOAD(SO, KVBLK); if constexpr (SDEPTH == 2) { if (2 < NT) SLOAD(SE, 2 * KVBLK); }
  SWAIT(); SWRITE(1, SO); __syncthreads();
  for (int j = 1; j + 1 < NT; j += 2) {
    SBAR(); qkt(pB0, pB1, (bf16*)((char*)K_lds + SHM_K), qr, r32, hi);
    finishSM(pA0, pA1, alA, l_reg, pa0, pa1, pa2, pa3); SBAR();
    SLOAD(SO, (j + SDEPTH) * KVBLK); SBAR();
    pv_d0(o, vb0, pa0, pa1, pa2, pa3); partialSM(pB0, pB1, m_reg, mnB, alB);
    __syncthreads(); SWAIT(); SWRITE(0, SE);
    RESC(alB); __syncthreads();
    SBAR(); qkt(pA0, pA1, K_lds, qr, r32, hi);
    finishSM(pB0, pB1, alB, l_reg, pa0, pa1, pa2, pa3); SBAR();
    if (SDEPTH == 1 || j + 3 < NT) SLOAD(SE, (j + 1 + SDEPTH) * KVBLK); SBAR();
    pv_d0(o, vb0 + (int)SHM_V, pa0, pa1, pa2, pa3); partialSM(pA0, pA1, m_reg, mnA, alA);
    __syncthreads(); SWAIT(); SWRITE(1, SO);
    RESC(alA); __syncthreads();
  }
  SBAR(); qkt(pB0, pB1, (bf16*)((char*)K_lds + SHM_K), qr, r32, hi);
  finishSM(pA0, pA1, alA, l_reg, pa0, pa1, pa2, pa3); SBAR();
  pv_d0(o, vb0, pa0, pa1, pa2, pa3); partialSM(pB0, pB1, m_reg, mnB, alB);
  __syncthreads(); RESC(alB);
  finishSM(pB0, pB1, alB, l_reg, pa0, pa1, pa2, pa3); SBAR();
  pv_d0(o, vb0 + (int)SHM_V, pa0, pa1, pa2, pa3);
  if (hi == 0) li_l[r32] = l_reg; asm volatile("s_waitcnt lgkmcnt(0)" ::: "memory");
  float rli[16];
#pragma unroll
  for (int r = 0; r < 16; ++r) rli[r] = __builtin_amdgcn_rcpf(li_l[crow(r, hi)]);
  bf16* Ow = Ob + (long)(wid * QBLK) * LDO;
#pragma unroll
  for (int r = 0; r < 16; ++r) { int orow = crow(r, hi);
    for (int d0 = 0; d0 < 4; ++d0) Ow[(long)orow * LDO + d0 * 32 + r32] = __float2bfloat16(o[d0][r] * rli[r]); }
#undef SLOAD
#undef SWRITE
#undef SWAIT
#undef RESC
}
#undef KSWZ
#undef SBAR
}
namespace fk {
using pg8::bf16_t; using pg8::f32x4; using pg8::u32x4; using pg8::Unit; using pg8::cvt_pk_bf16;
typedef unsigned u32x2 __attribute__((ext_vector_type(2)));
typedef float f32x16 __attribute__((ext_vector_type(16)));
constexpr int M = 24576, MP = 8192, D = 2048, INW = 17408, DFF = 8192, DEPTH = 4, NWAVES = 8, NCOND = 9;
constexpr int OFF_Q = 0, OFF_K = 2048, OFF_V = 2560, OFF_LX = 3072, OFF_LG = 5120, OFF_CU = 7168, OFF_CV = 9216, OFF_G = 11264;
constexpr int NKVROWS = 26624;
constexpr float EPS = 1e-6f;
constexpr int NPHASE = 3 + 9 * DEPTH;
constexpr int NMODK = 32;
constexpr size_t MiB = 1u << 20;
constexpr size_t WS_CTL = 0, CTL_ZERO_BYTES = 1 * MiB;
constexpr size_t WS_CIN = 1 * MiB  , WS_MODP = 716 * MiB  , WS_MOD = 28 * MiB, WS_ROPE = 30 * MiB, WS_CVSTAT = 31 * MiB, WS_FSTAT = 34 * MiB, WS_AGG = 37 * MiB, WS_WLRU = 49 * MiB, WS_CMW = 51 * MiB;
constexpr size_t WS_WIN = 52 * MiB, WS_WBR = 120 * MiB, WS_WOUT = 144 * MiB, WS_WFF1 = 152 * MiB, WS_WFF2 = 184 * MiB;
constexpr size_t WS_H = 216 * MiB, WS_KALL = 312 * MiB, WS_VALL = 338 * MiB, WS_BR = 364 * MiB, WS_MSCR = 652 * MiB, WS_Z = 716 * MiB, WS_XB = 1532 * MiB  , WS_END = 1628 * MiB;
constexpr size_t WS_FFH = WS_Z, WS_F = WS_Z + 384 * MiB;
constexpr int CW_SPLIT = 2048;
constexpr int CW_BAR = 4096;
constexpr int RING_BYTES = 131072;
constexpr int LRU_XC = 0, LRU_XC_PITCH = 272, LRU_A0 = 17408, LRU_B0 = LRU_A0 + 32768, LRU_A1 = LRU_B0 + 32768, LRU_B1 = LRU_A1 + 32768, LRU_CARRY = LRU_B1 + 32768;
constexpr int CM_VT = 0, CM_VT_PITCH = 272, CM_RS = 128 * 272;
constexpr int MISC_OFF = 150528, LDS_BYTES = 151552;
static_assert(LRU_CARRY + 2048 <= MISC_OFF, "lds map");

struct Params { const float* in[32]; float* out; unsigned char* ws; int ph_lo, ph_hi, li, pad; };

typedef const __attribute__((address_space(4))) void* kaptr_t;
struct Frame {
    LAS unsigned char* lds;
    int tid, lane, wave, vcu, G, gw, NGW, bx;
    float* out; unsigned char* ws; kaptr_t ka;
    __device__ __forceinline__ float* x() const { return out; }
    __device__ __forceinline__ float* new_k() const { return out + 50331648L; }
    __device__ __forceinline__ float* new_v() const { return out + 50331648L + 16777216L; }
    __device__ __forceinline__ float* new_s() const { return out + 50331648L + 2 * 16777216L; }
#define FK_WSP(name, type, off) __device__ __forceinline__ type* name() const { return (type*)(ws + (off)); }
    FK_WSP(MODP, float, WS_MODP) FK_WSP(MOD, float, WS_MOD) FK_WSP(ROPE, float, WS_ROPE) FK_WSP(CVSTAT, float, WS_CVSTAT) FK_WSP(FSTAT, float, WS_FSTAT) FK_WSP(AGG, float, WS_AGG) FK_WSP(CIN, float, WS_CIN) FK_WSP(MSCR, float, WS_MSCR)
    FK_WSP(WLRU, bf16_t, WS_WLRU) FK_WSP(CMW, bf16_t, WS_CMW) FK_WSP(WIN, bf16_t, WS_WIN) FK_WSP(WBR, bf16_t, WS_WBR) FK_WSP(WOUT, bf16_t, WS_WOUT) FK_WSP(WFF1, bf16_t, WS_WFF1) FK_WSP(WFF2, bf16_t, WS_WFF2)
    FK_WSP(H, bf16_t, WS_H) FK_WSP(KALL, bf16_t, WS_KALL) FK_WSP(VALL, bf16_t, WS_VALL) FK_WSP(BR, bf16_t, WS_BR) FK_WSP(Z, bf16_t, WS_Z) FK_WSP(FFH, bf16_t, WS_FFH) FK_WSP(XB, bf16_t, WS_XB) FK_WSP(Fb, bf16_t, WS_F)
#undef FK_WSP
};
enum { I_XP = 0, I_XS, I_CK, I_CV, I_SL, I_C, I_CCTX, I_WMOD, I_BMOD, I_GPM, I_GPOM, I_GPF, I_GPOF, I_WIN, I_GQ, I_GK, I_WAO, I_CW, I_CB, I_LWA, I_LBA, I_LWX, I_LBX, I_LAM, I_WLO, I_CMG, I_CMWS, I_CMBS, I_WCO, I_WOUT, I_WFF1, I_WFF2 };
template <int I> __device__ __forceinline__ const float* inp(const Frame& F) { const GAS float* r; asm volatile("s_load_dwordx2 %0, %1, %2\n\ts_waitcnt lgkmcnt(0)" : "=s"(r) : "s"(F.ka), "i"(I * 8) : "memory"); return (const float*)r; }


__device__ __forceinline__ Frame phase_frame(const Frame& F) {
    Frame P = F; int t = F.tid; int bx = blockIdx.x; int g = F.G; GAS unsigned char* w = (GAS unsigned char*)F.ws; GAS float* o = (GAS float*)F.out;
    asm volatile("" : "+v"(t)); asm volatile("" : "+s"(bx), "+s"(g), "+s"(w), "+s"(o));
    P.tid = t; P.lane = t & 63; P.wave = __builtin_amdgcn_readfirstlane(t >> 6); P.ws = (unsigned char*)w; P.out = (float*)o; P.bx = bx; P.G = g; P.NGW = g * NWAVES;
    P.vcu = (g % 8 == 0) ? (bx % 8) * (g / 8) + bx / 8 : bx; P.gw = P.vcu * NWAVES + P.wave;
    return P;
}
__device__ __forceinline__ float wave_sum(float v) {
#pragma unroll
    for (int o = 1; o < 64; o <<= 1) v += __shfl_xor(v, o);
    return v;
}
__device__ __forceinline__ float bf2f(unsigned short h) { return __uint_as_float((unsigned)h << 16); }
__device__ __forceinline__ float bflo(unsigned w) { return __uint_as_float(w << 16); }
__device__ __forceinline__ float bfhi(unsigned w) { return __uint_as_float(w & 0xffff0000u); }
__device__ __forceinline__ float fsigm(float x) { return __builtin_amdgcn_rcpf(1.f + __builtin_amdgcn_exp2f(-1.4426950408889634f * x)); }
__device__ __forceinline__ float fgelu(float x) { const float u = x * (1.5957691216057308f + 0.0713548162726009f * x * x); return x * fsigm(u); }

__device__ __forceinline__ void transpose_item(const float* __restrict__ W, int K, int N, bf16_t* __restrict__ WT, int row_off, LAS unsigned char* scr, int item, int lane) {
    const int nblk = N / 64, kb = item / nblk, nb = item % nblk, k0 = 64 * kb, n0 = 64 * nb;
    const int n4 = (lane & 15) * 4, kp = lane >> 4;
    const float* src = W + (size_t)(k0 + 2 * kp) * N + n0 + n4;
    f32x4 v[8][2];
#pragma unroll
    for (int i = 0; i < 8; ++i) { v[i][0] = __builtin_nontemporal_load((const f32x4*)(src + (size_t)(8 * i) * N)); v[i][1] = __builtin_nontemporal_load((const f32x4*)(src + (size_t)(8 * i + 1) * N)); }
#pragma unroll
    for (int i = 0; i < 8; ++i) { const int k = 8 * i + 2 * kp;
#pragma unroll
        for (int j = 0; j < 4; ++j) *(LAS unsigned*)(scr + (n4 + j) * 144 + k * 2) = cvt_pk_bf16(v[i][0][j], v[i][1][j]); }
    LDS_WAIT(); asm volatile("" ::: "memory");
    const int ch = lane & 7;
#pragma unroll
    for (int j = 0; j < 8; ++j) { const int n = (lane >> 3) + 8 * j;
        const v4u o = *(const LAS v4u*)(scr + n * 144 + ch * 16);
        *(GAS v4u*)(WT + (size_t)(row_off + n0 + n) * K + k0 + 8 * ch) = o; }
    LDS_WAIT(); asm volatile("" ::: "memory");
}
__device__ __forceinline__ void convert_layer(const Frame& F, int l) {
    LAS unsigned char* scr = F.lds + F.wave * 16384;
    constexpr int I_IN = 32 * 272, I_SQ = 32 * 32, I_F1 = 32 * 128, I_F2 = 128 * 32, I_LRU = 64 * 4;
    constexpr int NITEMS = I_IN + 4 * I_SQ + I_F1 + I_F2 + I_LRU;
    const float* w_in = inp<I_WIN>(F) + (size_t)l * D * INW; const float* w_ao = inp<I_WAO>(F) + (size_t)l * D * D; const float* w_lo = inp<I_WLO>(F) + (size_t)l * D * D;
    const float* w_co = inp<I_WCO>(F) + (size_t)l * D * D; const float* w_out = inp<I_WOUT>(F) + (size_t)l * D * D; const float* w_f1 = inp<I_WFF1>(F) + (size_t)l * D * DFF;
    const float* w_f2 = inp<I_WFF2>(F) + (size_t)l * DFF * D; const float* lwa = inp<I_LWA>(F) + (size_t)l * 2 * 16 * 16384; const float* lwx = inp<I_LWX>(F) + (size_t)l * 2 * 16 * 16384;
    for (int it = F.gw; it < NITEMS; it += F.NGW) {
        int r = it;
        if (r < I_IN) { transpose_item(w_in, D, INW, F.WIN(), 0, scr, r, F.lane); continue; } r -= I_IN;
        if (r < I_SQ) { transpose_item(w_ao, D, D, F.WBR(), 0, scr, r, F.lane); continue; } r -= I_SQ;
        if (r < I_SQ) { transpose_item(w_lo, D, D, F.WBR(), D, scr, r, F.lane); continue; } r -= I_SQ;
        if (r < I_SQ) { transpose_item(w_co, D, D, F.WBR(), 2 * D, scr, r, F.lane); continue; } r -= I_SQ;
        if (r < I_SQ) { transpose_item(w_out, D, D, F.WOUT(), 0, scr, r, F.lane); continue; } r -= I_SQ;
        if (r < I_F1) { transpose_item(w_f1, D, DFF, F.WFF1(), 0, scr, r, F.lane); continue; } r -= I_F1;
        if (r < I_F2) { transpose_item(w_f2, DFF, D, F.WFF2(), 0, scr, r, F.lane); continue; } r -= I_F2;
        { const int bi = r >> 2, sub = r & 3, d = bi >> 5, mat = (bi >> 4) & 1, blk = bi & 15;
          const float* src = (mat ? lwx : lwa) + ((size_t)d * 16 + blk) * 16384;
          transpose_item(src, 128, 128, F.WLRU() + (size_t)bi * 16384, 0, scr, sub, F.lane); }
    }
    const float* cw = inp<I_CMWS>(F) + (size_t)l * 16 * 16384;
    for (int i = (F.gw * 64 + F.lane) * 8; i < 16 * 16384; i += F.NGW * 64 * 8) {
        const f32x4 a = *(const f32x4*)(cw + i), b = *(const f32x4*)(cw + i + 4);
        v4u o; o.x = pk2(a.x, a.y); o.y = pk2(a.z, a.w); o.z = pk2(b.x, b.y); o.w = pk2(b.z, b.w);
        *(v4u*)(F.CMW() + i) = o;
    }
}
__device__ __forceinline__ void mod_partials(const Frame& F) {
    LAS float* scr = (LAS float*)(F.lds + F.wave * 16384);
    const float* cctx = inp<I_CCTX>(F); const float* cc = inp<I_C>(F); const float* wmod = inp<I_WMOD>(F);
    for (int it = F.gw; it < DEPTH * 48 * NMODK; it += F.NGW) {
        const int kc = it % NMODK, jb = (it / NMODK) % 48, l = it / (NMODK * 48), k0 = kc * 64;
        for (int e = F.lane; e < NCOND * 64; e += 64) { const int ci = e >> 6, kk = e & 63; const float v = ci == 0 ? cctx[k0 + kk] : cc[(ci - 1) * D + k0 + kk]; scr[e] = v * (1.f / (1.f + __expf(-v))); }
        LDS_WAIT(); asm volatile("" ::: "memory");
        f32x4 acc[NCOND];
#pragma unroll
        for (int ci = 0; ci < NCOND; ++ci) acc[ci] = (f32x4){0.f, 0.f, 0.f, 0.f};
        const float* wp = wmod + ((size_t)l * D + k0) * 12288 + jb * 256 + F.lane * 4;
#pragma unroll
        for (int kb = 0; kb < 64; kb += 16) {
            f32x4 w[16];
#pragma unroll
            for (int kk = 0; kk < 16; ++kk) w[kk] = *(const f32x4*)(wp + (size_t)(kb + kk) * 12288);
#pragma unroll
            for (int kk = 0; kk < 16; ++kk)
#pragma unroll
                for (int ci = 0; ci < NCOND; ++ci) acc[ci] += w[kk] * scr[ci * 64 + kb + kk];
        }
#pragma unroll
        for (int ci = 0; ci < NCOND; ++ci) *(f32x4*)(F.MODP() + (((size_t)kc * DEPTH + l) * NCOND + ci) * 12288 + jb * 256 + F.lane * 4) = acc[ci];
        LDS_WAIT(); asm volatile("" ::: "memory");
    }
}
__device__ __forceinline__ void mod_reduce(const Frame& F) {
    constexpr int NEL = DEPTH * NCOND * 12288;
    for (int i = (F.gw * 64 + F.lane) * 4; i < NEL; i += F.NGW * 64 * 4) {
        const int l = i / (NCOND * 12288), j = i % 12288;
        f32x4 s = *(const f32x4*)(inp<I_BMOD>(F) + (size_t)l * 12288 + j);
#pragma unroll
        for (int kc = 0; kc < NMODK; ++kc) s += *(const f32x4*)(F.MODP() + (size_t)kc * NEL + i);
        *(f32x4*)(F.MOD() + i) = s;
    }
}
__device__ __forceinline__ void rope_table(const Frame& F) {
    if (F.bx == 0) for (int e = F.tid; e < 2048; e += NWAVES * 64) {
        const int pos = e >> 5, f = e & 31; const float inv = exp2f(-(float)f * (13.287712379549449f / 32.f)); float s, c; sincosf((float)pos * inv, &s, &c);
        F.ROPE()[e] = c; F.ROPE()[2048 + e] = s; }
}
__device__ __forceinline__ u32x4 pack8(const f32x4& a, const f32x4& b) { u32x4 w; w.x = cvt_pk_bf16(a[0], a[1]); w.y = cvt_pk_bf16(a[2], a[3]); w.z = cvt_pk_bf16(b[0], b[1]); w.w = cvt_pk_bf16(b[2], b[3]); return w; }
struct RowIn { f32x4 x[4][2]; u32x4 xb[4]; u32x4 f[4]; float st; };
template <bool XF32, bool HAS_F>
__device__ __forceinline__ void row_load(const Frame& F, RowIn& R, const float* xsrc, const bf16_t* xbsrc, const bf16_t* frow, const float* fstat) {
    if (XF32) {
#pragma unroll
        for (int j = 0; j < 4; ++j) { const int e = (j * 64 + F.lane) * 8; R.x[j][0] = __builtin_nontemporal_load((const f32x4*)(xsrc + e)); R.x[j][1] = __builtin_nontemporal_load((const f32x4*)(xsrc + e + 4)); }
    } else {
#pragma unroll
        for (int j = 0; j < 4; ++j) R.xb[j] = __builtin_nontemporal_load((const u32x4*)(xbsrc + (j * 64 + F.lane) * 8));
    }
    if (HAS_F) {
#pragma unroll
        for (int j = 0; j < 4; ++j) R.f[j] = __builtin_nontemporal_load((const u32x4*)(frow + (j * 64 + F.lane) * 8));
        R.st = F.lane < 32 ? fstat[F.lane] : 0.f;
    }
}
template <bool XF32, bool HAS_F, bool HAS_H, bool OUTF32>
__device__ __forceinline__ void row_apply(const Frame& F, RowIn& R, float* xdst, bf16_t* xbdst, const float* gate, const float* gpost, const float* gpre, const float* sc, const float* sh, bf16_t* hrow, float gs) {
    if (!XF32) {
#pragma unroll
        for (int j = 0; j < 4; ++j) { const u32x4 w = R.xb[j]; R.x[j][0] = (f32x4){bflo(w.x), bfhi(w.x), bflo(w.y), bfhi(w.y)}; R.x[j][1] = (f32x4){bflo(w.z), bfhi(w.z), bflo(w.w), bfhi(w.w)}; }
    }
    if (HAS_F) {
        const float rs = rsqrtf(wave_sum(R.st) * (1.f / D) + EPS) * gs;
#pragma unroll
        for (int j = 0; j < 4; ++j) { const int e = (j * 64 + F.lane) * 8; const u32x4 fw = R.f[j];
            const f32x4 g0 = *(const f32x4*)(gate + e), g1 = *(const f32x4*)(gate + e + 4), p0 = *(const f32x4*)(gpost + e), p1 = *(const f32x4*)(gpost + e + 4);
            const f32x4 f0 = {bflo(fw.x), bfhi(fw.x), bflo(fw.y), bfhi(fw.y)}, f1 = {bflo(fw.z), bfhi(fw.z), bflo(fw.w), bfhi(fw.w)};
            R.x[j][0] += g0 * (f0 * rs * p0); R.x[j][1] += g1 * (f1 * rs * p1); }
    }
    if (OUTF32) {
#pragma unroll
        for (int j = 0; j < 4; ++j) { const int e = (j * 64 + F.lane) * 8; __builtin_nontemporal_store(R.x[j][0], (f32x4*)(xdst + e)); __builtin_nontemporal_store(R.x[j][1], (f32x4*)(xdst + e + 4)); }
    } else {
#pragma unroll
        for (int j = 0; j < 4; ++j) __builtin_nontemporal_store(pack8(R.x[j][0], R.x[j][1]), (u32x4*)(xbdst + (j * 64 + F.lane) * 8));
    }
    if (HAS_H) {
        float ss = 0.f;
#pragma unroll
        for (int j = 0; j < 4; ++j)
#pragma unroll
            for (int h = 0; h < 2; ++h) ss += (R.x[j][h].x * R.x[j][h].x + R.x[j][h].y * R.x[j][h].y) + (R.x[j][h].z * R.x[j][h].z + R.x[j][h].w * R.x[j][h].w);
        const float rs = rsqrtf(wave_sum(ss) * (1.f / D) + EPS);
#pragma unroll
        for (int j = 0; j < 4; ++j) { const int e = (j * 64 + F.lane) * 8;
            f32x4 o[2];
#pragma unroll
            for (int h = 0; h < 2; ++h) { const f32x4 g = *(const f32x4*)(gpre + e + 4 * h), s1 = *(const f32x4*)(sc + e + 4 * h), s0 = *(const f32x4*)(sh + e + 4 * h); o[h] = R.x[j][h] * rs * g * (s1 + 1.f) + s0; }
            u32x4 w; w.x = cvt_pk_bf16(o[0].x, o[0].y); w.y = cvt_pk_bf16(o[0].z, o[0].w); w.z = cvt_pk_bf16(o[1].x, o[1].y); w.w = cvt_pk_bf16(o[1].z, o[1].w);
            *(u32x4*)(hrow + e) = w; }
    }
}
__device__ __forceinline__ int cond_of_row(int m) { return m < MP ? 0 : 1 + ((m - MP) >> 11); }
template <int MODE>
__device__ __forceinline__ void rowlocal_phase(const Frame& F, int l, float gs = 1.f) {
    const float* xp = inp<I_XP>(F); const float* xs = inp<I_XS>(F);
    const float* gpost = MODE == 1 ? inp<I_GPOM>(F) + (size_t)l * D : inp<I_GPOF>(F) + (size_t)l * D;
    const float* gpre = MODE == 0 ? inp<I_GPM>(F) : MODE == 1 ? inp<I_GPF>(F) + (size_t)l * D : inp<I_GPM>(F) + (size_t)(l + 1 < DEPTH ? l + 1 : l) * D;
    float* X = F.x(); bf16_t* XB = F.XB(); const bf16_t* Fb = F.Fb(); const float* FS = F.FSTAT(); bf16_t* H = F.H(); const float* MODb = F.MOD();
    constexpr bool HAS_F = MODE != 0, XF32 = MODE == 0;
    RowIn A, B;
    auto src = [&](int m) -> const float* { return m < MP ? xp + (size_t)m * D : xs + (size_t)(m - MP) * D; };
    int m = F.gw;
    if (m < M) row_load<XF32, HAS_F>(F, A, src(m), XB + (size_t)m * D, Fb + (size_t)m * D, FS + (size_t)m * 32);
    for (; m < M; m += 2 * F.NGW) {
#pragma unroll
        for (int half = 0; half < 2; ++half) {
            const int mc = m + half * F.NGW, mn = mc + F.NGW;
            if (mc >= M) break;
            RowIn& cur = half ? B : A; RowIn& nxt = half ? A : B;
            if (mn < M) row_load<XF32, HAS_F>(F, nxt, src(mn), XB + (size_t)mn * D, Fb + (size_t)mn * D, FS + (size_t)mn * 32);
            const int ci = cond_of_row(mc);
            const float* modl = MODb + ((size_t)l * NCOND + ci) * 12288;
            float* xrow = X + (size_t)mc * D; bf16_t* xbrow = XB + (size_t)mc * D; bf16_t* hrow = H + (size_t)mc * D;
            if (MODE == 0) row_apply<true, false, true, false>(F, cur, xrow, xbrow, nullptr, nullptr, gpre, modl + 1 * D, modl + 0 * D, hrow, gs);
            else if (MODE == 1) row_apply<false, true, true, false>(F, cur, xrow, xbrow, modl + 2 * D, gpost, gpre, modl + 4 * D, modl + 3 * D, hrow, gs);
            else if (MODE == 2) { const float* modn = MODb + ((size_t)(l + 1) * NCOND + ci) * 12288; row_apply<false, true, true, false>(F, cur, xrow, xbrow, modl + 5 * D, gpost, gpre, modn + 1 * D, modn + 0 * D, hrow, gs); }
            else row_apply<false, true, false, true>(F, cur, xrow, xbrow, modl + 5 * D, gpost, nullptr, nullptr, nullptr, nullptr, gs);
        }
    }
}
typedef float f32x2 __attribute__((ext_vector_type(2)));
__device__ __forceinline__ f32x2 sigm2(f32x2 x) { const f32x2 t = x * -1.4426950408889634f; const f32x2 e = (f32x2){__builtin_amdgcn_exp2f(t.x), __builtin_amdgcn_exp2f(t.y)} + 1.f; return (f32x2){__builtin_amdgcn_rcpf(e.x), __builtin_amdgcn_rcpf(e.y)}; }
__device__ __forceinline__ f32x2 gelu2(f32x2 x) { const f32x2 t = x * ((x * x) * -0.10294324f + -2.3022082f);
    const f32x2 e = (f32x2){__builtin_amdgcn_exp2f(t.x), __builtin_amdgcn_exp2f(t.y)} + 1.f; return x * (f32x2){__builtin_amdgcn_rcpf(e.x), __builtin_amdgcn_rcpf(e.y)}; }
__device__ __forceinline__ f32x4 gelu4(const f32x4& v) { const f32x2 a = gelu2((f32x2){v[0], v[1]}), b = gelu2((f32x2){v[2], v[3]}); return (f32x4){a.x, a.y, b.x, b.y}; }
__device__ __forceinline__ f32x4 sigm4(const f32x4& v) { const f32x2 a = sigm2((f32x2){v[0], v[1]}), b = sigm2((f32x2){v[2], v[3]}); return (f32x4){a.x, a.y, b.x, b.y}; }
__device__ __forceinline__ int kv_row(int m) { return m < MP ? m : MP + ((m - MP) >> 11) * 2304 + ((m - MP) & 2047); }
struct EpiIn {
    static constexpr bool PERM = true, AFTER_DRAIN = false;
    bf16_t* Z; bf16_t* VALL; float* new_v; float* cvstat; int layer;
    __device__ __forceinline__ void operator()(const f32x4 (&acc)[2][2][4][2], const Unit& u, int wr, int wc, int fr, int fq) const {
        const int pn = u.pn, row0 = u.pm * 256 + wr * 64 + fr, cl = wc * 32 + 8 * fq;
        if (pn >= 10 && pn < 12) {
            const int colv = (pn - 10) * 256 + cl;
#pragma unroll
            for (int ai = 0; ai < 2; ++ai)
#pragma unroll
                for (int m = 0; m < 4; ++m) { const int row = row0 + ai * 128 + m * 16; bf16_t* dst = VALL + (size_t)kv_row(row) * 512 + colv;
#pragma unroll
                    for (int bj = 0; bj < 2; ++bj) { *(u32x4*)(dst + bj * 128) = pack8(acc[ai][bj][m][0], acc[ai][bj][m][1]);
                        if (row < MP) { float* nv = new_v + ((size_t)((row >> 8) * DEPTH + layer) * 256 + (row & 255)) * 512 + colv + bj * 128; *(f32x4*)nv = acc[ai][bj][m][0]; *(f32x4*)(nv + 4) = acc[ai][bj][m][1]; } } }
            return;
        }
        const int mode = (pn < 20) ? 0 : (pn < 36) ? 1 : (pn < 44) ? 2 : 3;
        const int col0 = pn * 256 + cl;
#pragma unroll
        for (int ai = 0; ai < 2; ++ai)
#pragma unroll
            for (int m = 0; m < 4; ++m) { const int row = row0 + ai * 128 + m * 16; bf16_t* dst = Z + (size_t)row * INW + col0; float ss = 0.f;
#pragma unroll
                for (int bj = 0; bj < 2; ++bj) { f32x4 v0 = acc[ai][bj][m][0], v1 = acc[ai][bj][m][1];
                    if (mode == 1 || mode == 2) { v0 = gelu4(v0); v1 = gelu4(v1); }
                    if (mode == 3) { v0 = sigm4(v0); v1 = sigm4(v1); }
                    if (mode == 2) ss += (v0[0] * v0[0] + v0[1] * v0[1]) + (v0[2] * v0[2] + v0[3] * v0[3]) + (v1[0] * v1[0] + v1[1] * v1[1]) + (v1[2] * v1[2] + v1[3] * v1[3]);
                    *(u32x4*)(dst + bj * 128) = pack8(v0, v1); }
                if (mode == 2) { ss += __shfl_xor(ss, 16); ss += __shfl_xor(ss, 32); if (fq == 0) cvstat[(size_t)row * 32 + (pn - 36) * 4 + wc] = ss; } }
    }
};
struct EpiRelu2 {
    static constexpr bool PERM = true, AFTER_DRAIN = false;
    bf16_t* O; int ldc;
    __device__ __forceinline__ void operator()(const f32x4 (&acc)[2][2][4][2], const Unit& u, int wr, int wc, int fr, int fq) const {
        const int row0 = u.pm * 256 + wr * 64 + fr, col0 = u.pn * 256 + wc * 32 + 8 * fq;
#pragma unroll
        for (int ai = 0; ai < 2; ++ai)
#pragma unroll
            for (int m = 0; m < 4; ++m) { bf16_t* dst = O + (size_t)(row0 + ai * 128 + m * 16) * ldc + col0;
#pragma unroll
                for (int bj = 0; bj < 2; ++bj) { f32x4 v0 = __builtin_elementwise_max(acc[ai][bj][m][0], (f32x4){0.f, 0.f, 0.f, 0.f}), v1 = __builtin_elementwise_max(acc[ai][bj][m][1], (f32x4){0.f, 0.f, 0.f, 0.f});
                    *(u32x4*)(dst + bj * 128) = pack8(v0 * v0, v1 * v1); } }
    }
};
struct EpiF {
    static constexpr bool PERM = true, AFTER_DRAIN = false;
    bf16_t* O; float* stat;
    __device__ __forceinline__ void operator()(const f32x4 (&acc)[2][2][4][2], const Unit& u, int wr, int wc, int fr, int fq) const {
        const int row0 = u.pm * 256 + wr * 64 + fr, col0 = u.pn * 256 + wc * 32 + 8 * fq;
#pragma unroll
        for (int ai = 0; ai < 2; ++ai)
#pragma unroll
            for (int m = 0; m < 4; ++m) { const int row = row0 + ai * 128 + m * 16; bf16_t* dst = O + (size_t)row * D + col0; float ss = 0.f;
#pragma unroll
                for (int bj = 0; bj < 2; ++bj) { const f32x4 v0 = acc[ai][bj][m][0], v1 = acc[ai][bj][m][1];
                    ss += (v0[0] * v0[0] + v0[1] * v0[1]) + (v0[2] * v0[2] + v0[3] * v0[3]) + (v1[0] * v1[0] + v1[1] * v1[1]) + (v1[2] * v1[2] + v1[3] * v1[3]);
                    *(u32x4*)(dst + bj * 128) = pack8(v0, v1); }
                ss += __shfl_xor(ss, 16); ss += __shfl_xor(ss, 32); if (fq == 0) stat[(size_t)row * 32 + u.pn * 4 + wc] = ss; }
    }
};
struct EpiMerge {
    static constexpr bool PERM = true, AFTER_DRAIN = false;
    const bf16_t* Z; float* scr  ; bf16_t* O;
    __device__ __forceinline__ void operator()(const f32x4 (&acc)[2][2][4][2], const Unit& u, int wr, int wc, int fr, int fq) const {
        const int br = u.pn >> 3, pn = u.pn & 7, pm = u.pm - 96 * br;
        const int rl0 = wr * 64 + fr, cl = wc * 32 + 8 * fq;
#pragma unroll
        for (int ai = 0; ai < 2; ++ai)
#pragma unroll
            for (int m = 0; m < 4; ++m) { const int rl = rl0 + ai * 128 + m * 16, row = pm * 256 + rl;
#pragma unroll
                for (int bj = 0; bj < 2; ++bj) { const int c = cl + bj * 128;
                    const u32x4 gw = *(const u32x4*)(Z + (size_t)row * INW + OFF_G + br * D + pn * 256 + c);
                    const f32x4 g0 = {bflo(gw.x), bfhi(gw.x), bflo(gw.y), bfhi(gw.y)}, g1 = {bflo(gw.z), bfhi(gw.z), bflo(gw.w), bfhi(gw.w)};
                    f32x4 v0 = g0 * acc[ai][bj][m][0], v1 = g1 * acc[ai][bj][m][1];
                    float* sp = scr + rl * 256 + c;
                    if (br > 0) { v0 += *(const f32x4*)sp; v1 += *(const f32x4*)(sp + 4); }
                    if (br < 2) { *(f32x4*)sp = v0; *(f32x4*)(sp + 4) = v1; }
                    else *(u32x4*)(O + (size_t)row * D + pn * 256 + c) = pack8(v0, v1); } }
    }
};
struct MergeOrder {
    pg8::StaticOrder so;
    __device__ void init(int G, int c) { so.init(M, D, G, c); }
    __device__ bool next(int i, Unit& u) const { const int br = i % 3; if (!so.next(i / 3, u)) return false; u.pm += 96 * br; u.pn += 8 * br; return true; }
    __device__ __forceinline__ void a_ready(const Unit&) const {}
    __device__ __forceinline__ void done(const Unit&) const {}
};
}
namespace fk {
typedef short bf16x8 __attribute__((ext_vector_type(8)));
__device__ __forceinline__ void prep_row(const Frame& F, int m, int l) {
    const bool sample = m >= MP; int b, t;
    if (!sample) { b = m >> 8; t = m & 255; } else { b = (m - MP) >> 11; t = (m - MP) & 2047; }
    const int kvrow = sample ? MP + b * 2304 + t : m;
    const int lane = F.lane, g8 = lane >> 3, j = lane & 7, axis = g8 & 1, hsel = lane >> 4;
    bf16_t* zrow = F.Z() + (size_t)m * INW;
    const int dA = axis * 64 + 4 * j, dB = dA + 32;
    const f32x4 gqa = *(const f32x4*)(inp<I_GQ>(F) + l * 128 + dA), gqb = *(const f32x4*)(inp<I_GQ>(F) + l * 128 + dB);
    const f32x4 gka = *(const f32x4*)(inp<I_GK>(F) + l * 128 + dA), gkb = *(const f32x4*)(inp<I_GK>(F) + l * 128 + dB);
    f32x4 cs = {1.f, 1.f, 1.f, 1.f}, sn = {0.f, 0.f, 0.f, 0.f};
    if (sample) { const int pos = axis == 0 ? (t >> 6) : (t & 63); cs = *(const f32x4*)(F.ROPE() + pos * 32 + 4 * j); sn = *(const f32x4*)(F.ROPE() + 2048 + pos * 32 + 4 * j); }
#pragma unroll
    for (int pass = 0; pass < 5; ++pass) {
        const bool isq = pass < 4;
        const int base = isq ? OFF_Q + (pass * 4 + hsel) * 128 + dA : OFF_K + hsel * 128 + dA;
        const u32x2 wa = *(const u32x2*)(zrow + base), wb = *(const u32x2*)(zrow + base + 32);
        const f32x4 xa = {bflo(wa.x), bfhi(wa.x), bflo(wa.y), bfhi(wa.y)}, xb = {bflo(wb.x), bfhi(wb.x), bflo(wb.y), bfhi(wb.y)};
        float ss = (xa.x * xa.x + xa.y * xa.y) + (xa.z * xa.z + xa.w * xa.w) + (xb.x * xb.x + xb.y * xb.y) + (xb.z * xb.z + xb.w * xb.w);
        ss += __shfl_xor(ss, 1); ss += __shfl_xor(ss, 2); ss += __shfl_xor(ss, 4); ss += __shfl_xor(ss, 8);
        const float rs = rsqrtf(ss * (1.f / 128.f) + EPS);
        const f32x4 na = xa * rs * (isq ? gqa : gka), nb = xb * rs * (isq ? gqb : gkb);
        const f32x4 ra = na * cs - nb * sn, rb = na * sn + nb * cs;
        u32x2 oa, ob; oa.x = cvt_pk_bf16(ra.x, ra.y); oa.y = cvt_pk_bf16(ra.z, ra.w); ob.x = cvt_pk_bf16(rb.x, rb.y); ob.y = cvt_pk_bf16(rb.z, rb.w);
        if (isq) { *(u32x2*)(zrow + base) = oa; *(u32x2*)(zrow + base + 32) = ob; }
        else {
            bf16_t* kd = F.KALL() + (size_t)kvrow * 512 + hsel * 128 + dA; *(u32x2*)kd = oa; *(u32x2*)(kd + 32) = ob;
            if (!sample) { float* nk = F.new_k() + ((size_t)(b * DEPTH + l) * 256 + t) * 512 + hsel * 128 + dA; *(f32x4*)nk = na; *(f32x4*)(nk + 32) = nb; }
        }
    }
}
__device__ __forceinline__ void prep_phase(const Frame& F, int l) {
    for (int m = F.gw; m < M; m += F.NGW) prep_row(F, m, l);
    for (int it = F.gw; it < 2 * 8 * 256; it += F.NGW) {
        const int which = it >> 11, b = (it >> 8) & 7, p = it & 255;
        const float* src = (which ? inp<I_CV>(F) : inp<I_CK>(F)) + ((size_t)(b * DEPTH + l) * 256 + p) * 512 + F.lane * 8;
        bf16_t* dst = (which ? F.VALL() : F.KALL()) + (size_t)(MP + b * 2304 + 2048 + p) * 512 + F.lane * 8;
        const f32x4 a = *(const f32x4*)src, c = *(const f32x4*)(src + 4);
        *(u32x4*)dst = pack8(a, c);
    }
}
__device__ __forceinline__ int crow(int r, int hi) { return (r & 3) + 8 * (r >> 2) + 4 * hi; }
struct LruCtx {
    bf16x8 bw0[8], bw1[8];
    float bav, bxv, c8;
    bool small;
};
__device__ __forceinline__ void lru_ctx_load(const Frame& F, int l, int blk, LruCtx& X) {
    const int lane = F.lane, wave = F.wave, d = wave >> 2, n0 = (wave & 3) * 32, nl = lane & 31, hi = lane >> 5, C = blk * 128 + n0 + nl;
    const bf16_t* wb0 = F.WLRU() + ((size_t)((d * 2 + 0) * 16 + blk) * 128 + n0 + nl) * 128 + hi * 8;
    const bf16_t* wb1 = F.WLRU() + ((size_t)((d * 2 + 1) * 16 + blk) * 128 + n0 + nl) * 128 + hi * 8;
#pragma unroll
    for (int ks = 0; ks < 8; ++ks) { X.bw0[ks] = *(const bf16x8*)(wb0 + ks * 16); X.bw1[ks] = *(const bf16x8*)(wb1 + ks * 16); }
    X.bav = inp<I_LBA>(F)[(size_t)(l * 2 + d) * D + C]; X.bxv = inp<I_LBX>(F)[(size_t)(l * 2 + d) * D + C];
    const float lam = inp<I_LAM>(F)[(size_t)(l * 2 + d) * D + C];
    const float ex = __expf(-lam);
    const float sp = lam < -20.f ? -lam : ex < 0.05f ? ex * (1.f + ex * (-0.5f + ex * ((1.f / 3.f) + ex * (-0.25f + ex * 0.2f)))) : __logf(1.f + ex);
    X.c8 = -8.f * sp;
    X.small = __all(X.c8 > -0.5f);
}
struct LruGeo { int m0, b, t0, T; bool sample; };
__device__ __forceinline__ LruGeo lru_geo(int ck) { LruGeo g; g.m0 = ck * 64; g.sample = g.m0 >= MP;
    if (!g.sample) { g.b = g.m0 >> 8; g.t0 = g.m0 & 255; g.T = 256; } else { g.b = (g.m0 - MP) >> 11; g.t0 = (g.m0 - MP) & 2047; g.T = 2048; } return g; }
__device__ __forceinline__ void lru_conv_load(const Frame& F, f32x4 (&PF)[16], int t2, int ck, int blk, const float* __restrict__ cwl, const float* __restrict__ cbl) {
    const LruGeo G = lru_geo(ck); const int C0 = blk * 128; const bf16_t* Zb = F.Z();
    const int c4 = (t2 & 31) * 4, r0 = (t2 >> 5) * 8;
#pragma unroll
    for (int i = 0; i < 11; ++i) {
        const int tt = G.t0 + r0 + i - 2; u32x2 z = {0u, 0u};
        if (tt >= 0 && tt < G.T) z = *(const u32x2*)(Zb + (size_t)(G.m0 + r0 + i - 2) * INW + OFF_LX + C0 + c4);
        PF[i].x = __uint_as_float(z.x); PF[i].y = __uint_as_float(z.y);
    }
#pragma unroll
    for (int j = 0; j < 4; ++j) PF[11 + j] = *(const f32x4*)(cwl + (size_t)j * D + C0 + c4);
    PF[15] = *(const f32x4*)(cbl + C0 + c4);
}
__device__ __forceinline__ void lru_conv_math(const Frame& F, const f32x4 (&PF)[16], int t2) {
    LAS unsigned char* lds = F.lds; const int c4 = (t2 & 31) * 4, r0 = (t2 >> 5) * 8;
    f32x4 zr[11];
#pragma unroll
    for (int i = 0; i < 11; ++i) { const unsigned zx = __float_as_uint(PF[i].x), zy = __float_as_uint(PF[i].y); zr[i] = (f32x4){bflo(zx), bfhi(zx), bflo(zy), bfhi(zy)}; }
#pragma unroll
    for (int r = 0; r < 8; ++r) {
        const f32x4 y = PF[15] + zr[r] * PF[11] + zr[r + 1] * PF[12] + zr[r + 2] * PF[13] + zr[r + 3] * PF[14];
        u32x2 o; o.x = cvt_pk_bf16(y.x, y.y); o.y = cvt_pk_bf16(y.z, y.w);
        *(LAS u32x2*)(lds + LRU_XC + (r0 + r) * LRU_XC_PITCH + c4 * 2) = o;
    }
}
__device__ __forceinline__ void split_arrive(unsigned* cnt) {
    asm volatile("s_waitcnt vmcnt(0)" ::: "memory");
    __syncthreads();
    if (threadIdx.x == 0) { __builtin_amdgcn_fence(__ATOMIC_RELEASE, "agent"); asm volatile("s_waitcnt vmcnt(0)" ::: "memory"); (void)xb_add(cnt, 1u); }
}
__device__ __forceinline__ void split_wait(unsigned* cnt, unsigned G, unsigned* tmo) {
    if (threadIdx.x == 0) {
        unsigned sp = 0;
        while (xb_ld(cnt) < G) { __builtin_amdgcn_s_sleep(1); if ((++sp & 255u) == 0u) { if (xb_ld(tmo)) break; if (sp > XB_SPIN_CAP) { atomicAdd(tmo, 1u); break; } } }
        __builtin_amdgcn_fence(__ATOMIC_ACQUIRE, "agent"); asm volatile("s_waitcnt vmcnt(0)" ::: "memory");
    }
    __syncthreads();
}
__device__ __forceinline__ void lru_carry_phase(const Frame& F, int l) {
    const float* state_l = inp<I_SL>(F) + (size_t)l * 2 * D;
    const float* AGG = F.AGG(); float* CIN = F.CIN();
    for (int id = F.gw * 64 + F.lane; id < 40 * 2 * D; id += F.NGW * 64) {
        const int c = id & (D - 1), d = (id >> 11) & 1, sq = id >> 12;
        const bool sample = sq >= 32; const int ck0 = sample ? 128 + (sq - 32) * 32 : sq * 4;
        float carry = sample ? state_l[((size_t)(sq - 32) * DEPTH * 2 + d) * D + c] : 0.f;
        const float* ag = AGG + ((size_t)(ck0 * 2 + d) * D + c) * 2; float* ci = CIN + (size_t)(ck0 * 2 + d) * D + c;
        if (!sample) {
            float2 pe[4];
#pragma unroll
            for (int jj = 0; jj < 4; ++jj) pe[jj] = *(const float2*)(ag + (size_t)jj * 4 * D);
            if (d == 0) {
#pragma unroll
                for (int jj = 0; jj < 4; ++jj) { ci[(size_t)jj * 2 * D] = carry; carry = pe[jj].x * carry + pe[jj].y; } }
            else {
#pragma unroll
                for (int jj = 3; jj >= 0; --jj) { ci[(size_t)jj * 2 * D] = carry; carry = pe[jj].x * carry + pe[jj].y; } }
        } else {
            float2 pe[32];
#pragma unroll
            for (int jj = 0; jj < 32; ++jj) pe[jj] = *(const float2*)(ag + (size_t)jj * 4 * D);
            if (d == 0) {
#pragma unroll
                for (int jj = 0; jj < 32; ++jj) { ci[(size_t)jj * 2 * D] = carry; carry = pe[jj].x * carry + pe[jj].y; } }
            else {
#pragma unroll
                for (int jj = 31; jj >= 0; --jj) { ci[(size_t)jj * 2 * D] = carry; carry = pe[jj].x * carry + pe[jj].y; } }
        }
    }
}
__device__ __forceinline__ void lru_gates(const Frame& F, int lane, int wave, const LruCtx& X) {
    typedef float f32x2 __attribute__((ext_vector_type(2)));
    LAS unsigned char* lds = F.lds;
    const int d = wave >> 2, n0 = (wave & 3) * 32, nl = lane & 31, hi = lane >> 5, c = n0 + nl;
    LAS float* Ad = (LAS float*)(lds + (d ? LRU_A1 : LRU_A0)); LAS float* Bd = (LAS float*)(lds + (d ? LRU_B1 : LRU_B0));
    const float bav = X.bav, bxv = X.bxv, c8 = X.c8;
#pragma unroll
    for (int mt = 0; mt < 2; ++mt) {
        f32x16 acc0, acc1;
#pragma unroll
        for (int r = 0; r < 16; ++r) { acc0[r] = 0.f; acc1[r] = 0.f; }
        const LAS unsigned char* ap = lds + LRU_XC + (mt * 32 + nl) * LRU_XC_PITCH + hi * 16;
#pragma unroll
        for (int ks = 0; ks < 8; ++ks) {
            const bf16x8 a0 = *(const LAS bf16x8*)(ap + ks * 32);
            acc0 = __builtin_amdgcn_mfma_f32_32x32x16_bf16(a0, X.bw0[ks], acc0, 0, 0, 0);
            acc1 = __builtin_amdgcn_mfma_f32_32x32x16_bf16(a0, X.bw1[ks], acc1, 0, 0, 0);
        }
        if (X.small) {
#pragma unroll
            for (int r = 0; r < 16; r += 2) {
                const int tl = mt * 32 + crow(r, hi);
                const f32x2 pa = (f32x2){acc0[r], acc0[r + 1]} + bav, px = (f32x2){acc1[r], acc1[r + 1]} + bxv;
                const f32x2 ta = pa * -1.4426950408889634f, tx = px * -1.4426950408889634f;
                const f32x2 ea = (f32x2){__builtin_amdgcn_exp2f(ta.x), __builtin_amdgcn_exp2f(ta.y)} + 1.f, ex = (f32x2){__builtin_amdgcn_exp2f(tx.x), __builtin_amdgcn_exp2f(tx.y)} + 1.f;
                const f32x2 rg = {__builtin_amdgcn_rcpf(ea.x), __builtin_amdgcn_rcpf(ea.y)}, ig = {__builtin_amdgcn_rcpf(ex.x), __builtin_amdgcn_rcpf(ex.y)};
                const f32x2 la = rg * c8;
                f32x2 p = la * (1.f / 720.f) + (1.f / 120.f); p = p * la + (1.f / 24.f); p = p * la + (1.f / 6.f); p = p * la + 0.5f; p = p * la + 1.f;
                const f32x2 e1 = la * p;
                const f32x2 omr = (e1 + 2.f) * e1;
                const f32x2 sq = {__builtin_amdgcn_sqrtf(fmaxf(-omr.x, 0.f)), __builtin_amdgcn_sqrtf(fmaxf(-omr.y, 0.f))};
                const f32x2 xcv = {bf2f(*(const LAS unsigned short*)(lds + LRU_XC + tl * LRU_XC_PITCH + c * 2)), bf2f(*(const LAS unsigned short*)(lds + LRU_XC + (tl + 1) * LRU_XC_PITCH + c * 2))};
                const f32x2 av = e1 + 1.f, bt = sq * ig * xcv;
                Ad[tl * 128 + c] = av.x; Ad[(tl + 1) * 128 + c] = av.y; Bd[tl * 128 + c] = bt.x; Bd[(tl + 1) * 128 + c] = bt.y;
            }
        } else {
#pragma unroll
            for (int r = 0; r < 16; ++r) {
                const int tl = mt * 32 + crow(r, hi);
                const float rg = fsigm(acc0[r] + bav), ig = fsigm(acc1[r] + bxv);
                const float la = c8 * rg, a = __expf(la);
                const float mult = sqrtf(fmaxf(-expm1f(2.f * la), 0.f));
                const float xcv = bf2f(*(const LAS unsigned short*)(lds + LRU_XC + tl * LRU_XC_PITCH + c * 2));
                Ad[tl * 128 + c] = a; Bd[tl * 128 + c] = mult * ig * xcv;
            }
        }
    }
}
template <int PASS>
__device__ __forceinline__ void lru_scan(const Frame& F, int tid, float carry, int l, int ck, int blk, float* __restrict__ AGG) {
    LAS unsigned char* lds = F.lds; const LruGeo G = lru_geo(ck);
    const int d = tid >> 7, c = tid & 127, C = blk * 128 + c;
    const LAS float* Ad = (const LAS float*)(lds + (d ? LRU_A1 : LRU_A0)); LAS float* Bd = (LAS float*)(lds + (d ? LRU_B1 : LRU_B0));
    if (PASS == 1) {
        float h = 0.f, Pp = 1.f;
        if (d == 0) {
#pragma unroll 16
            for (int s = 0; s < 64; ++s) { const float a = Ad[s * 128 + c]; h = a * h + Bd[s * 128 + c]; Pp *= a; }
        } else {
#pragma unroll 16
            for (int s = 0; s < 64; ++s) { const float a = Ad[(63 - s) * 128 + c]; h = a * h + Bd[(63 - s) * 128 + c]; Pp *= a; }
        }
        *(float2*)(AGG + ((size_t)(ck * 2 + d) * D + C) * 2) = make_float2(Pp, h);
    } else {
        const int jc = G.t0 >> 6, nch = G.T >> 6;
        float h = carry;
        if (d == 0) {
#pragma unroll
            for (int s0 = 0; s0 < 64; s0 += 16) { float av[16], bv[16];
#pragma unroll
                for (int i = 0; i < 16; ++i) { av[i] = Ad[(s0 + i) * 128 + c]; bv[i] = Bd[(s0 + i) * 128 + c]; }
#pragma unroll
                for (int i = 0; i < 16; ++i) { h = av[i] * h + bv[i]; bv[i] = h; }
#pragma unroll
                for (int i = 0; i < 16; ++i) Bd[(s0 + i) * 128 + c] = bv[i]; }
        } else {
#pragma unroll
            for (int s0 = 0; s0 < 64; s0 += 16) { float av[16], bv[16];
#pragma unroll
                for (int i = 0; i < 16; ++i) { av[i] = Ad[(63 - s0 - i) * 128 + c]; bv[i] = Bd[(63 - s0 - i) * 128 + c]; }
#pragma unroll
                for (int i = 0; i < 16; ++i) { h = av[i] * h + bv[i]; bv[i] = h; }
#pragma unroll
                for (int i = 0; i < 16; ++i) Bd[(63 - s0 - i) * 128 + c] = bv[i]; }
        }
        if (!G.sample && ((d == 0 && jc == nch - 1) || (d == 1 && jc == 0))) F.new_s()[((size_t)(G.b * DEPTH + l) * 2 + d) * D + C] = h;
    }
}
__device__ __forceinline__ void lru_out(const Frame& F, int tid, int ck, int blk, const u32x4& g0, const u32x4& g1) {
    LAS unsigned char* lds = F.lds; const int m0 = ck * 64, C0 = blk * 128;
    const int row = tid >> 3, c16 = (tid & 7) * 16;
    const LAS float* h0 = (const LAS float*)(lds + LRU_B0) + row * 128 + c16; const LAS float* h1 = (const LAS float*)(lds + LRU_B1) + row * 128 + c16;
    const unsigned gw[8] = {g0.x, g0.y, g0.z, g0.w, g1.x, g1.y, g1.z, g1.w};
    unsigned ow[8];
#pragma unroll
    for (int i = 0; i < 8; ++i) ow[i] = cvt_pk_bf16((h0[2 * i] + h1[2 * i]) * bflo(gw[i]), (h0[2 * i + 1] + h1[2 * i + 1]) * bfhi(gw[i]));
    bf16_t* yp = F.BR() + (size_t)1 * M * D + (size_t)(m0 + row) * D + C0 + c16;
    *(u32x4*)yp = (u32x4){ow[0], ow[1], ow[2], ow[3]}; *(u32x4*)(yp + 8) = (u32x4){ow[4], ow[5], ow[6], ow[7]};
}
template <int PASS>
__device__ __forceinline__ void lru_phase(const Frame& F, int l) {
    LruCtx X; int cur = -1;
    float* AGG = F.AGG(); const float* CIN = F.CIN();
    const float* cwl = inp<I_CW>(F) + (size_t)l * 4 * D; const float* cbl = inp<I_CB>(F) + (size_t)l * D;
    constexpr int NU = 384 * 16;
    int u = F.bx;
    if (u < NU && F.tid >= 256) { f32x4 PF[16]; lru_conv_load(F, PF, F.tid - 256, u >> 4, u & 15, cwl, cbl); lru_conv_math(F, PF, F.tid - 256); }
    __syncthreads();
    for (; u < NU; u += F.G) {
        int tid_ = F.tid; asm volatile("" : "+v"(tid_));
        const int tid = tid_, lane = tid & 63, wave = __builtin_amdgcn_readfirstlane(tid >> 6);
        const int blk = u & 15, ck = u >> 4, un = u + F.G;
        if (blk != cur) { lru_ctx_load(F, l, blk, X); cur = blk; }
        u32x4 g0 = {0u, 0u, 0u, 0u}, g1 = {0u, 0u, 0u, 0u};
        const bf16_t* gp = F.Z() + (size_t)(ck * 64 + (tid >> 3)) * INW + OFF_LG + blk * 128 + (tid & 7) * 16;
        if (wave < 4) {
            float carry = 0.f;
            if (PASS == 2) carry = CIN[(size_t)(ck * 2 + (tid >> 7)) * D + blk * 128 + (tid & 127)];
            lru_gates(F, lane, wave, X);
            __syncthreads();
            if (PASS == 2) { g0 = *(const u32x4*)gp; g1 = *(const u32x4*)(gp + 8); }
            lru_scan<PASS>(F, tid, carry, l, ck, blk, AGG);
            __syncthreads();
        } else {
            f32x4 PF[16];
            if (un < NU) lru_conv_load(F, PF, tid - 256, un >> 4, un & 15, cwl, cbl);
            lru_gates(F, lane, wave, X);
            __syncthreads();
            if (PASS == 2) { g0 = *(const u32x4*)gp; g1 = *(const u32x4*)(gp + 8); }
            if (un < NU) lru_conv_math(F, PF, tid - 256);
            __syncthreads();
        }
        if (PASS == 2) { lru_out(F, tid, ck, blk, g0, g1); __syncthreads(); }
    }
}
constexpr int CM_V = 0, CM_OUT = 32768, CM_OUT_PITCH = 528, CM_RS2 = CM_OUT + 128 * CM_OUT_PITCH;
static_assert(CM_RS2 + 512 <= MISC_OFF, "cm lds map");
struct CmCtx { bf16x8 wa[8]; f32x4 ga, gb; };
__device__ __forceinline__ void cm_ctx_load(const Frame& F, int g, CmCtx& X, const float* __restrict__ cmg) {
    const int qt = F.wave & 3, xl = F.lane & 31, hi = F.lane >> 5;
    const bf16_t* wp = F.CMW() + ((size_t)g * 128 + qt * 32 + xl) * 128 + hi * 8;
#pragma unroll
    for (int i = 0; i < 8; ++i) X.wa[i] = *(const bf16x8*)(wp + i * 16);
    const int sc = (F.tid & 15) * 8;
    X.ga = *(const f32x4*)(cmg + g * 128 + sc); X.gb = *(const f32x4*)(cmg + g * 128 + sc + 4);
}
struct CmPre { u32x4 v[4]; float2 st[4]; };
__device__ __forceinline__ void cm_prefetch(const Frame& F, CmPre& R, int tid, int cn, int g) {
    const int sr = tid >> 4, q16 = tid & 15, sc = q16 * 8, m0 = cn * 128;
    const bf16_t* Zb = F.Z(); const float* ST = F.CVSTAT();
#pragma unroll
    for (int i = 0; i < 4; ++i) { const int p = (i >> 1) * 64 + (i & 1) * 32 + sr;
        R.v[i] = *(const u32x4*)(Zb + (size_t)(m0 + p) * INW + OFF_CV + g * 128 + sc);
        R.st[i] = *(const float2*)(ST + (size_t)(m0 + p) * 32 + q16 * 2); }
}
__device__ __forceinline__ void cm_stage(const Frame& F, const CmPre& R, const CmCtx& X, int tid) {
    LAS unsigned char* lds = F.lds; const int sr = tid >> 4, sc = (tid & 15) * 8;
#pragma unroll
    for (int i = 0; i < 4; ++i) {
        float s = R.st[i].x + R.st[i].y;
        s += __shfl_xor(s, 1); s += __shfl_xor(s, 2); s += __shfl_xor(s, 4); s += __shfl_xor(s, 8);
        const float rs = rsqrtf(s * (1.f / D) + EPS);
        const u32x4 w = R.v[i];
        const f32x4 v0 = (f32x4){bflo(w.x), bfhi(w.x), bflo(w.y), bfhi(w.y)} * X.ga * rs, v1 = (f32x4){bflo(w.z), bfhi(w.z), bflo(w.w), bfhi(w.w)} * X.gb * rs;
        *(LAS u32x4*)(lds + CM_V + (i >> 1) * 16384 + att::v_st((i & 1) * 32 + sr, sc)) = pack8(v0, v1);
    }
}
__device__ __forceinline__ void cm_mfma(const Frame& F, const CmCtx& X, int lane, int wave) {
    LAS unsigned char* lds = F.lds;
    const int qt = wave & 3, chh = wave >> 2, xl = lane & 31, hi = lane >> 5;
    f32x16 o0, o1;
#pragma unroll
    for (int r = 0; r < 16; ++r) { o0[r] = 0.f; o1[r] = 0.f; }
    const int vb = (int)(unsigned)(uintptr_t)(lds + CM_V) + att::v_rd_base(lane);
    if (chh == 0) {
        att::pv_one<0>(o0, vb, X.wa[0], X.wa[1], X.wa[2], X.wa[3]); att::pv_one<1>(o1, vb, X.wa[0], X.wa[1], X.wa[2], X.wa[3]);
        att::pv_one<0>(o0, vb + 16384, X.wa[4], X.wa[5], X.wa[6], X.wa[7]); att::pv_one<1>(o1, vb + 16384, X.wa[4], X.wa[5], X.wa[6], X.wa[7]);
    } else {
        att::pv_one<2>(o0, vb, X.wa[0], X.wa[1], X.wa[2], X.wa[3]); att::pv_one<3>(o1, vb, X.wa[0], X.wa[1], X.wa[2], X.wa[3]);
        att::pv_one<2>(o0, vb + 16384, X.wa[4], X.wa[5], X.wa[6], X.wa[7]); att::pv_one<3>(o1, vb + 16384, X.wa[4], X.wa[5], X.wa[6], X.wa[7]);
    }
#pragma unroll
    for (int r = 0; r < 16; ++r) { const int q = qt * 32 + crow(r, hi);
        *(LAS float*)(lds + CM_OUT + q * CM_OUT_PITCH + (chh * 64 + xl) * 4) = o0[r];
        *(LAS float*)(lds + CM_OUT + q * CM_OUT_PITCH + (chh * 64 + 32 + xl) * 4) = o1[r]; }
}
__device__ __forceinline__ void cm_epilogue(const Frame& F, int tid, int cn, int g, const float* __restrict__ bsg, const u32x4 (&uw)[4]) {
    LAS unsigned char* lds = F.lds; const int q = tid >> 2, c32 = (tid & 3) * 32, m0 = cn * 128; const float bias = bsg[q];
    bf16_t* op = F.BR() + (size_t)2 * M * D + (size_t)(m0 + q) * D + g * 128 + c32;
#pragma unroll
    for (int i = 0; i < 4; ++i) {
        const f32x4 a = *(const LAS f32x4*)(lds + CM_OUT + q * CM_OUT_PITCH + (c32 + i * 8) * 4), b2 = *(const LAS f32x4*)(lds + CM_OUT + q * CM_OUT_PITCH + (c32 + i * 8 + 4) * 4);
        const f32x4 u0 = {bflo(uw[i].x), bfhi(uw[i].x), bflo(uw[i].y), bfhi(uw[i].y)}, u1 = {bflo(uw[i].z), bfhi(uw[i].z), bflo(uw[i].w), bfhi(uw[i].w)};
        *(u32x4*)(op + i * 8) = pack8(u0 * (a + bias), u1 * (b2 + bias));
    }
}
__device__ __forceinline__ void cm_phase(const Frame& F, int l) {
    CmCtx X; int cur = -1;
    const float* cmg = inp<I_CMG>(F) + (size_t)l * D; const float* bs = inp<I_CMBS>(F) + (size_t)l * 16 * 128;
    constexpr int NU = 192 * 16;
    int u = F.bx;
    if (u < NU) { const int g = u & 15; cm_ctx_load(F, g, X, cmg); cur = g; CmPre R; cm_prefetch(F, R, F.tid, u >> 4, g); cm_stage(F, R, X, F.tid); }
    __syncthreads();
    for (; u < NU; u += F.G) {
        int tid_ = F.tid; asm volatile("" : "+v"(tid_));
        const int tid = tid_, lane = tid & 63, wave = __builtin_amdgcn_readfirstlane(tid >> 6);
        const int g = u & 15, cn = u >> 4, un = u + F.G;
        CmPre R;
        if (un < NU) cm_prefetch(F, R, tid, un >> 4, un & 15);
        u32x4 uw[4];
        { const bf16_t* up = F.Z() + (size_t)(cn * 128 + (tid >> 2)) * INW + OFF_CU + g * 128 + (tid & 3) * 32;
#pragma unroll
          for (int i = 0; i < 4; ++i) uw[i] = *(const u32x4*)(up + i * 8); }
        cm_mfma(F, X, lane, wave);
        __syncthreads();
        cm_epilogue(F, tid, cn, g, bs + g * 128, uw);
        if (un < NU) { const int gn = un & 15; if (gn != cur) { cm_ctx_load(F, gn, X, cmg); cur = gn; } cm_stage(F, R, X, tid); }
        __syncthreads();
    }
}
__device__ __forceinline__ void attn_phase(const Frame& F) {
    char* lds = (char*)F.lds;
    const att::bf16* Z = (const att::bf16*)F.Z(); const att::bf16* K = (const att::bf16*)F.KALL(); const att::bf16* V = (const att::bf16*)F.VALL(); att::bf16* O = (att::bf16*)F.BR();
    for (int id = F.vcu; id < 1536; id += F.G) {
        size_t qrow, kvrow; int h, nkeys;
        if (id < 1024) { const int qb = id & 7, b = id >> 7; h = (id >> 3) & 15; qrow = (size_t)MP + (size_t)b * 2048 + qb * 256; kvrow = (size_t)MP + (size_t)b * 2304; nkeys = 2304; }
        else { const int id2 = id - 1024, b = id2 >> 4; h = id2 & 15; qrow = (size_t)b * 256; kvrow = qrow; nkeys = 256; }
        att::attn_dense_body<att::bf16>(Z + qrow * INW + OFF_Q + h * 128, K + kvrow * 512 + (h >> 2) * 128, V + kvrow * 512 + (h >> 2) * 128, O + qrow * D + h * 128, nkeys, lds);
    }
    __syncthreads();
}
}
#ifndef REP_G
#define REP_G 1
#endif
#ifndef REP_A
#define REP_A 1
#endif
#ifndef REP_L
#define REP_L 1
#endif
#ifndef REP_V
#define REP_V 1
#endif
#ifndef REP_R
#define REP_R 1
#endif
#ifndef REP_GSEL
#define REP_GSEL 0
#endif
#ifndef REP_B
#define REP_B 1
#endif
#ifndef PG_ALIGN
#define PG_ALIGN true
#endif
#ifndef REP_C
#define REP_C 1
#endif
namespace fk {
#if REP_G > 1 || REP_GSEL > 0
template <class Base> struct RepOrder {
    Base b; int n;
    __device__ void init_n() { Unit u; n = 0; while (b.next(n, u)) ++n; }
    __device__ bool next(int i, Unit& u) const { if (i >= 2 * n) return false; return b.next(i >= n ? i - n : i, u); }
    __device__ __forceinline__ void a_ready(const Unit&) const {}
    __device__ __forceinline__ void done(const Unit&) const {}
};
#define GEMM_REP(EPI, ORD, g, S, E) do { RepOrder<ORD> RS_; RS_.b = S; RS_.init_n(); pg8::gemm_phase<EPI, RepOrder<ORD>, PG_ALIGN, true>(P.lds, g, RS_, E); } while (0)
#endif
#define GEMM_ONE(EPI, ORD, g, S, E) pg8::gemm_phase<EPI, ORD, PG_ALIGN, true>(P.lds, g, S, E)
#if REP_G > 1
#define GEMM_CALL(ID, EPI, ORD, g, S, E) GEMM_REP(EPI, ORD, g, S, E)
#elif REP_GSEL > 0
#define GEMM_CALL(ID, EPI, ORD, g, S, E) do { if (ID == REP_GSEL) GEMM_REP(EPI, ORD, g, S, E); else GEMM_ONE(EPI, ORD, g, S, E); } while (0)
#else
#define GEMM_CALL(ID, EPI, ORD, g, S, E) GEMM_ONE(EPI, ORD, g, S, E)
#endif
__global__ void __launch_bounds__(NWAVES * 64, 2) mega(Params p) {
    extern __shared__ __attribute__((aligned(16))) unsigned char lds_raw[];
    Frame F;
    F.lds = (LAS unsigned char*)lds_raw;
    F.tid = threadIdx.x; F.lane = F.tid & 63; F.wave = __builtin_amdgcn_readfirstlane(F.tid >> 6);
    F.G = gridDim.x; { const int bx = blockIdx.x; F.vcu = (F.G % 8 == 0) ? (bx % 8) * (F.G / 8) + bx / 8 : bx; }
    F.gw = F.vcu * NWAVES + F.wave; F.NGW = F.G * NWAVES; F.bx = blockIdx.x;
    F.out = p.out; F.ws = p.ws; F.ka = (kaptr_t)__builtin_amdgcn_kernarg_segment_ptr();
    unsigned char* ws = p.ws;
    volatile LAS unsigned* MISC = (volatile LAS unsigned*)(F.lds + MISC_OFF);
    for (int u = F.tid; u < (LDS_BYTES - MISC_OFF) / 4; u += NWAVES * 64) ((LAS unsigned*)(F.lds + MISC_OFF))[u] = 0u;
    __syncthreads();
    unsigned* barw = (unsigned*)(ws + WS_CTL) + CW_BAR + p.li * XCD_BAR_WORDS;
    XcdBarrier bar = xcd_barrier_post(barw, MISC + 8);
    const int lo = p.ph_lo, hi = p.ph_hi;
#define IN_PH(k) (lo <= (k) && (k) < hi)
#if REP_B > 1
#define SEAM(k) do { if ((k) + 1 < hi) { xcd_barrier(bar); xcd_barrier(bar); } } while (0)
#else
#define SEAM(k) do { if ((k) + 1 < hi) xcd_barrier(bar); } while (0)
#endif

    if (IN_PH(0)) { const Frame P = phase_frame(F);
convert_layer(P, 0); mod_partials(P); rope_table(P);
#if REP_V > 1
        __syncthreads(); convert_layer(P, 0); mod_partials(P);
#endif
 SEAM(0); }
    if (IN_PH(1)) { const Frame P = phase_frame(F); mod_reduce(P); SEAM(1); }
    if (IN_PH(2)) { const Frame P = phase_frame(F); rowlocal_phase<0>(P, 0); SEAM(2); }
    for (int l = 0; l < DEPTH; ++l) {
        const int pb = 3 + 9 * l;
        if (IN_PH(pb + 0)) { const Frame P = phase_frame(F);
            pg8::Gemm g{P.H(), P.WIN(), M, INW, D}; pg8::StaticOrder S; S.init(M, INW, P.G, P.bx);
            EpiIn E{P.Z(), P.VALL(), P.new_v(), P.CVSTAT(), l};

GEMM_CALL(1, EpiIn, pg8::StaticOrder, g, S, E);

            SEAM(pb + 0);
        }
        if (IN_PH(pb + 1)) { const Frame P = phase_frame(F);
            unsigned* ctl = (unsigned*)(P.ws + WS_CTL);
            lru_phase<1>(P, l);
#if REP_L > 1
            lru_phase<1>(P, l);
#endif
            split_arrive(ctl + CW_SPLIT + 64 * l);
            prep_phase(P, l);
            __syncthreads();
            cm_phase(P, l);
#if REP_C > 1
            cm_phase(P, l);
#endif
            split_wait(ctl + CW_SPLIT + 64 * l, (unsigned)P.G, barw + XB_TMO);
            lru_carry_phase(P, l);
            SEAM(pb + 1);
        }
        if (IN_PH(pb + 2)) { const Frame P = phase_frame(F);

attn_phase(P);
#if REP_A > 1
            attn_phase(P);
#endif


lru_phase<2>(P, l);
#if REP_L > 1
            lru_phase<2>(P, l);
#endif

            SEAM(pb + 2);
        }
        if (IN_PH(pb + 3)) { const Frame P = phase_frame(F);
            pg8::Gemm g{P.BR(), P.WBR(), 3 * M, 3 * D, D}; MergeOrder S; S.init(P.G, P.bx);
            EpiMerge E{P.Z(), P.MSCR() + (size_t)P.bx * 65536, P.H()};

GEMM_CALL(2, EpiMerge, MergeOrder, g, S, E);

            SEAM(pb + 3);
        }
        if (IN_PH(pb + 4)) { const Frame P = phase_frame(F);
            pg8::Gemm g{P.H(), P.WOUT(), M, D, D}; pg8::StaticOrder S; S.init(M, D, P.G, P.bx);
            EpiF E{P.Fb(), P.FSTAT()};

GEMM_CALL(3, EpiF, pg8::StaticOrder, g, S, E);
            SEAM(pb + 4);

        }
        if (IN_PH(pb + 5)) { const Frame P = phase_frame(F);

#if REP_R > 1
            rowlocal_phase<1>(P, l, 0.f);
#endif
            rowlocal_phase<1>(P, l);
 SEAM(pb + 5); }
        if (IN_PH(pb + 6)) { const Frame P = phase_frame(F);
            pg8::Gemm g{P.H(), P.WFF1(), M, DFF, D}; pg8::StaticOrder S; S.init(M, DFF, P.G, P.bx);
            EpiRelu2 E{P.FFH(), DFF};

GEMM_CALL(4, EpiRelu2, pg8::StaticOrder, g, S, E);

            SEAM(pb + 6);
        }
        if (IN_PH(pb + 7)) { const Frame P = phase_frame(F);
            pg8::Gemm g{P.FFH(), P.WFF2(), M, D, DFF}; pg8::StaticOrder S; S.init(M, D, P.G, P.bx);
            EpiF E{P.Fb(), P.FSTAT()};

GEMM_CALL(5, EpiF, pg8::StaticOrder, g, S, E);
            SEAM(pb + 7);

        }
        if (IN_PH(pb + 8)) { const Frame P = phase_frame(F);


#if REP_R > 1
            if (l + 1 < DEPTH) rowlocal_phase<2>(P, l, 0.f);
#endif
            if (l + 1 < DEPTH) rowlocal_phase<2>(P, l); else rowlocal_phase<3>(P, l);


if (l + 1 < DEPTH) { __syncthreads(); convert_layer(P, l + 1); }
#if REP_V > 1
            if (l + 1 < DEPTH) { __syncthreads(); convert_layer(P, l + 1); }
#endif

            SEAM(pb + 8);
        }
    }
#undef IN_PH
#undef SEAM
}
}
extern "C" void kernel_launch(void* const* d_in, const int* in_sizes, int n_in, void* d_out, int out_size, void* d_ws, size_t ws_size, hipStream_t stream) {
    static int grid = 0;
    if (grid == 0) {
        if (n_in != 32 || out_size != 84410368 || ws_size < fk::WS_END) { fprintf(stderr, "kernel_launch: unexpected shapes: n_in %d out %d ws %zu (need %zu)\n", n_in, out_size, ws_size, (size_t)fk::WS_END); grid = -1; return; }
        int dev = 0, cus = 0;
        if (hipGetDevice(&dev) != hipSuccess || hipDeviceGetAttribute(&cus, hipDeviceAttributeMultiprocessorCount, dev) != hipSuccess) { grid = -1; return; }
        if (hipFuncSetAttribute((const void*)fk::mega, hipFuncAttributeMaxDynamicSharedMemorySize, fk::LDS_BYTES) != hipSuccess) { fprintf(stderr, "kernel_launch: hipFuncSetAttribute failed\n"); grid = -1; return; }
        int per_cu = 0;
        if (hipOccupancyMaxActiveBlocksPerMultiprocessor(&per_cu, (const void*)fk::mega, fk::NWAVES * 64, fk::LDS_BYTES) != hipSuccess || per_cu < 1) fprintf(stderr, "kernel_launch: occupancy query says %d blocks per CU\n", per_cu);
        (void)hipGetLastError();
        grid = cus < 256 ? cus : 256;
    }
    if (grid < 0) return;
    (void)hipMemsetAsync((char*)d_ws + fk::WS_CTL, 0, fk::CTL_ZERO_BYTES, stream);
    fk::Params p{};
    for (int i = 0; i < 32; ++i) p.in[i] = (const float*)d_in[i];
    p.out = (float*)d_out; p.ws = (unsigned char*)d_ws; p.ph_lo = 0; p.ph_hi = fk::NPHASE; p.li = 0; p.pad = 0;
    hipLaunchKernelGGL(fk::mega, dim3(grid), dim3(fk::NWAVES * 64), fk::LDS_BYTES, stream, p);
}
```

```cpp
#include <hip/hip_runtime.h>
#include <hip/hip_bf16.h>
#include <cstdio>
#include <cstdint>
namespace pg8 {
#define PG8_LAS __attribute__((address_space(3)))
typedef unsigned short bf16_t;
typedef short bf16x8 __attribute__((ext_vector_type(8)));
typedef float f32x4 __attribute__((ext_vector_type(4)));
typedef unsigned u32x4 __attribute__((ext_vector_type(4)));
constexpr int BM = 256, BK = 64, HALF = 128, HTB = HALF * BK * 2  , STAGE_BYTES = 8 * HTB, NXCD = 8, WGM = 4;

__host__ __device__ __forceinline__ int lds_byte(int r, int c) { const int st = (r >> 4) * 2 + (c >> 5), rr = r & 15, cc = c & 31, ob = rr * 64 + cc * 2; return st * 1024 + (ob ^ (((ob >> 9) & 1) << 5)); }
__host__ __device__ __forceinline__ void stage_rc(int b, int& R, int& C) { const int st = b / 1024, sb = b % 1024, swz = sb ^ (((sb >> 9) & 1) << 5); R = (st >> 1) * 16 + swz / 64; C = (st & 1) * 32 + (swz % 64) / 2; }
__host__ __device__ __forceinline__ int perm32(int rho) { const int n = rho >> 4, i = rho & 15; return 8 * (i >> 2) + 4 * n + (i & 3); }

struct Unit { int pm, pn; };
struct Gemm { const bf16_t* A; const bf16_t* Bt; int M, N, K; };

struct StaticOrder {
    int nM, nN, nwg, G, c, wgm;
    __host__ __device__ void init(int M, int N, int G_, int c_, int wgm_ = WGM) { nM = M / BM; nN = N / BM; nwg = nM * nN; G = G_; c = c_; wgm = wgm_; }
    __host__ __device__ bool next(int i, Unit& u) const {
        const long L = (long)i * G + c; if (L >= nwg) return false;
        int wgid = (int)L; { const int q = nwg / NXCD, r = nwg % NXCD, xcd = wgid % NXCD, off = wgid / NXCD; wgid = (xcd < r ? xcd * (q + 1) : r * (q + 1) + (xcd - r) * q) + off; }
        const int nig = wgm * nN, gid = wgid / nig, fm = gid * wgm, gsz = (nM - fm) < wgm ? (nM - fm) : wgm;
        u.pm = fm + ((wgid % nig) % gsz); u.pn = (wgid % nig) / gsz; return true;
    }
    __device__ __forceinline__ void a_ready(const Unit&) const {}
    __device__ __forceinline__ void done(const Unit&) const {}
};
__device__ __forceinline__ unsigned cvt_pk_bf16(float lo, float hi) { unsigned r; asm volatile("v_cvt_pk_bf16_f32 %0, %1, %2" : "=v"(r) : "v"(lo), "v"(hi)); return r; }
template <class Epi, class Sched, bool ALIGN_EPI = false, bool SP2 = false>
__device__ __forceinline__ void gemm_phase(PG8_LAS unsigned char* lds, const Gemm g, const Sched& S, const Epi& E) {
    int tid_ = threadIdx.x; asm volatile("" : "+v"(tid_));
    const int tid = tid_, wid = __builtin_amdgcn_readfirstlane(tid >> 6), lane = tid & 63, wr = wid >> 2, wc = wid & 3, fr = lane & 15, fq = lane >> 4;
    const int K = g.K, nt = K / BK;
    unsigned voffA[2], voffB[2];
#pragma unroll
    for (int i = 0; i < 2; ++i) { int R, C; stage_rc(tid * 16 + i * 8192, R, C); const int Rb = Epi::PERM ? ((R & ~31) + perm32(R & 31)) : R;
        voffA[i] = (unsigned)(R * K + C) * 2u; voffB[i] = (unsigned)(Rb * K + C) * 2u; }
    const size_t kstep = (size_t)(BK * 2);
    const size_t hstep = (size_t)HALF * K * 2;
    const size_t tstep = 2 * hstep;
    const unsigned ldsw = (unsigned)wid * 1024u;
    const int aoff = lds_byte(wr * 64 + fr, fq * 8), boff = lds_byte(wc * 32 + fr, fq * 8);
#define PG8_SA(b, h) (((b) * 2 + (h)) * HTB)
#define PG8_SB(b, h) ((4 + (b) * 2 + (h)) * HTB)
#define PG8_STAGE(bufoff, gbase, voff) do { _Pragma("unroll") for (int _i = 0; _i < 2; ++_i) \
        __builtin_amdgcn_global_load_lds((const unsigned*)((const char*)(gbase) + (voff)[_i]), (PG8_LAS unsigned*)(lds + (bufoff) + ldsw + _i * 8192), 16, 0, 0); } while (0)
#define PG8_LDA(dst, b, h) do { _Pragma("unroll") for (int m = 0; m < 4; ++m) _Pragma("unroll") for (int k = 0; k < 2; ++k) dst[m][k] = *(const PG8_LAS bf16x8*)(lds + PG8_SA(b, h) + aoff + m * 2048 + k * 1024); } while (0)
#define PG8_LDB(dst, b, h) do { _Pragma("unroll") for (int n = 0; n < 2; ++n) _Pragma("unroll") for (int k = 0; k < 2; ++k) dst[n][k] = *(const PG8_LAS bf16x8*)(lds + PG8_SB(b, h) + boff + n * 2048 + k * 1024); } while (0)
#define PG8_MMA(ai, bj, At, Bt) do { __builtin_amdgcn_s_setprio(1); _Pragma("unroll") for (int m = 0; m < 4; ++m) _Pragma("unroll") for (int n = 0; n < 2; ++n) _Pragma("unroll") for (int k = 0; k < 2; ++k) \
        acc[ai][bj][m][n] = __builtin_amdgcn_mfma_f32_16x16x32_bf16(Bt[n][k], At[m][k], acc[ai][bj][m][n], 0, 0, 0); __builtin_amdgcn_s_setprio(0); } while (0)
#define PG8_WAIT_V(n) asm volatile("s_waitcnt vmcnt(" #n ")" ::: "memory")
#define PG8_WAIT_L(n) asm volatile("s_waitcnt lgkmcnt(" #n ")" ::: "memory")
#define PG8_BAR __builtin_amdgcn_s_barrier()
#define PG8_SCHED __builtin_amdgcn_sched_barrier(0)
    Unit cur, nxt; int ui = 0;
    if (!S.next(0, cur)) return;
    f32x4 acc[2][2][4][2];
#pragma unroll
    for (int a = 0; a < 2; ++a)
#pragma unroll
        for (int b = 0; b < 2; ++b)
#pragma unroll
            for (int m = 0; m < 4; ++m)
#pragma unroll
                for (int n = 0; n < 2; ++n) acc[a][b][m][n] = (f32x4){0.f, 0.f, 0.f, 0.f};
    bf16x8 At[4][2], B0[2][2], B1[2][2];
    const char* cA = (const char*)g.A + (size_t)cur.pm * tstep; const char* cB = (const char*)g.Bt + (size_t)cur.pn * tstep;
    S.a_ready(cur);
    if constexpr (SP2) {
        PG8_STAGE(PG8_SB(0, 0), cB, voffB); PG8_STAGE(PG8_SB(0, 1), cB + hstep, voffB); PG8_STAGE(PG8_SA(0, 0), cA, voffA); PG8_STAGE(PG8_SA(0, 1), cA + hstep, voffA);
        if (wr == 1) PG8_BAR;
        PG8_WAIT_V(2); PG8_BAR;
        PG8_STAGE(PG8_SB(1, 0), cB + kstep, voffB); PG8_STAGE(PG8_SA(1, 0), cA + kstep, voffA); PG8_STAGE(PG8_SB(1, 1), cB + hstep + kstep, voffB);
        PG8_WAIT_V(6); PG8_BAR;
    } else {
        PG8_STAGE(PG8_SB(0, 0), cB, voffB); PG8_STAGE(PG8_SA(0, 0), cA, voffA); PG8_STAGE(PG8_SB(0, 1), cB + hstep, voffB); PG8_STAGE(PG8_SA(0, 1), cA + hstep, voffA);
        if (wr == 1) PG8_BAR;
        PG8_WAIT_V(4); PG8_BAR;
        PG8_STAGE(PG8_SB(1, 0), cB + kstep, voffB); PG8_STAGE(PG8_SA(1, 0), cA + kstep, voffA); PG8_STAGE(PG8_SB(1, 1), cB + hstep + kstep, voffB);
        PG8_WAIT_V(6); PG8_BAR;
    }
    for (;;) {
        const bool has_next = S.next(ui + 1, nxt);
        const char* nA = has_next ? (const char*)g.A + (size_t)nxt.pm * tstep : cA; const char* nB = has_next ? (const char*)g.Bt + (size_t)nxt.pn * tstep : cB;
        for (int t = 0; t < nt; t += 2) {
            const bool last = (t == nt - 2);
            const char* a1 = cA + (size_t)(t + 1) * kstep;
            const char* a2 = last ? nA : cA + (size_t)(t + 2) * kstep; const char* b2 = last ? nB : cB + (size_t)(t + 2) * kstep;
            const char* a3 = a2 + kstep; const char* b3 = b2 + kstep;
            if (last && has_next) S.a_ready(nxt);
            if constexpr (SP2) {
            PG8_LDB(B0, 0, 0); PG8_LDB(B1, 0, 1); PG8_SCHED; PG8_LDA(At, 0, 0); PG8_STAGE(PG8_SA(1, 1), a1 + hstep, voffA);
            PG8_WAIT_V(8); PG8_WAIT_L(0); PG8_BAR; PG8_MMA(0, 0, At, B0); PG8_MMA(0, 1, At, B1); PG8_BAR; PG8_SCHED;
            PG8_LDA(At, 0, 1); PG8_STAGE(PG8_SB(0, 0), b2, voffB); PG8_STAGE(PG8_SB(0, 1), b2 + hstep, voffB); PG8_STAGE(PG8_SA(0, 0), a2, voffA);
            PG8_WAIT_V(8); PG8_WAIT_L(0); PG8_BAR; PG8_MMA(1, 0, At, B0); PG8_MMA(1, 1, At, B1); PG8_BAR; PG8_SCHED;
            PG8_LDB(B0, 1, 0); PG8_LDB(B1, 1, 1); PG8_SCHED; PG8_LDA(At, 1, 0); PG8_STAGE(PG8_SA(0, 1), a2 + hstep, voffA);
            PG8_WAIT_V(8); PG8_WAIT_L(0); PG8_BAR; PG8_MMA(0, 0, At, B0); PG8_MMA(0, 1, At, B1); PG8_BAR; PG8_SCHED;
            PG8_LDA(At, 1, 1); PG8_STAGE(PG8_SB(1, 0), b3, voffB); PG8_STAGE(PG8_SB(1, 1), b3 + hstep, voffB); PG8_STAGE(PG8_SA(1, 0), a3, voffA);
            PG8_WAIT_V(8); PG8_WAIT_L(0); PG8_BAR; PG8_MMA(1, 0, At, B0); PG8_MMA(1, 1, At, B1); PG8_BAR; PG8_SCHED;
            } else {
            PG8_LDB(B0, 0, 0); PG8_SCHED; PG8_LDA(At, 0, 0); PG8_STAGE(PG8_SA(1, 1), a1 + hstep, voffA);
            PG8_WAIT_L(8); PG8_BAR; PG8_WAIT_L(0); PG8_MMA(0, 0, At, B0); PG8_BAR; PG8_SCHED;
            PG8_LDB(B1, 0, 1); PG8_STAGE(PG8_SB(0, 0), b2, voffB);
            PG8_BAR; PG8_WAIT_L(0); PG8_MMA(0, 1, At, B1); PG8_BAR;
            PG8_LDA(At, 0, 1); PG8_STAGE(PG8_SA(0, 0), a2, voffA);
            PG8_BAR; PG8_WAIT_L(0); PG8_MMA(1, 0, At, B0); PG8_BAR; PG8_SCHED;
            PG8_STAGE(PG8_SB(0, 1), b2 + hstep, voffB);
            PG8_WAIT_V(6); PG8_BAR; PG8_MMA(1, 1, At, B1); PG8_BAR;
            PG8_LDB(B0, 1, 0); PG8_SCHED; PG8_LDA(At, 1, 0); PG8_STAGE(PG8_SA(0, 1), a2 + hstep, voffA);
            PG8_WAIT_L(8); PG8_BAR; PG8_WAIT_L(0); PG8_MMA(0, 0, At, B0); PG8_BAR; PG8_SCHED;
            PG8_LDB(B1, 1, 1); PG8_STAGE(PG8_SB(1, 0), b3, voffB);
            PG8_BAR; PG8_WAIT_L(0); PG8_MMA(0, 1, At, B1); PG8_BAR;
            PG8_LDA(At, 1, 1); PG8_STAGE(PG8_SA(1, 0), a3, voffA);
            PG8_BAR; PG8_WAIT_L(0); PG8_MMA(1, 0, At, B0); PG8_BAR; PG8_SCHED;
            PG8_STAGE(PG8_SB(1, 1), b3 + hstep, voffB);
            PG8_WAIT_V(6); PG8_BAR; PG8_MMA(1, 1, At, B1); PG8_BAR;
            }
        }
        if constexpr (ALIGN_EPI) { if (wr == 0) PG8_BAR; }
        if constexpr (!Epi::AFTER_DRAIN) { E(acc, cur, wr, wc, fr, fq); S.done(cur); }
        if (!has_next) break;
        if (!Epi::keep(cur)) {
#pragma unroll
        for (int a = 0; a < 2; ++a)
#pragma unroll
            for (int b = 0; b < 2; ++b)
#pragma unroll
                for (int m = 0; m < 4; ++m)
#pragma unroll
                    for (int n = 0; n < 2; ++n) acc[a][b][m][n] = (f32x4){0.f, 0.f, 0.f, 0.f};
        }
        cur = nxt; cA = nA; cB = nB; ++ui;
        if constexpr (ALIGN_EPI) { if (wr == 1) PG8_BAR; }
    }
    PG8_WAIT_V(0);
    if constexpr (!ALIGN_EPI) { if (wr == 0) PG8_BAR; }
    PG8_BAR;
    if constexpr (Epi::AFTER_DRAIN) { E.fused(acc, cur, wr, wc, fr, fq, lds, wid, lane); S.done(cur); }
#undef PG8_SA
#undef PG8_SB
#undef PG8_STAGE
#undef PG8_LDA
#undef PG8_LDB
#undef PG8_MMA
#undef PG8_WAIT_V
#undef PG8_WAIT_L
#undef PG8_BAR
#undef PG8_SCHED
}
}
#define GAS __attribute__((address_space(1)))
#define LAS __attribute__((address_space(3)))
typedef unsigned short bf16;
typedef unsigned v4u __attribute__((ext_vector_type(4)));
typedef float f32x4 __attribute__((ext_vector_type(4)));
typedef short bf16x8 __attribute__((ext_vector_type(8)));
typedef GAS unsigned gu32;
typedef GAS unsigned long long gu64;
#define RLX_AGENT __ATOMIC_RELAXED, __HIP_MEMORY_SCOPE_AGENT
#define LDS_WAIT() asm volatile("s_waitcnt lgkmcnt(0)" ::: "memory")
#define VM_WAIT() asm volatile("s_waitcnt vmcnt(0)" ::: "memory")
__device__ __forceinline__ unsigned long long rt() { return __builtin_amdgcn_s_memrealtime(); }
__device__ __forceinline__ unsigned f2bf(float f) { unsigned u = __builtin_bit_cast(unsigned, f); return (u + 0x7fffu + ((u >> 16) & 1u)) >> 16; }
__device__ __forceinline__ unsigned pk2(float lo, float hi) { return f2bf(lo) | (f2bf(hi) << 16); }

#define XB_TMO      128
#define XB_XCNT(j)  (256  + 64 * (j))
#define XB_XSUB(j)  (1280 + 64 * (j))
#define XB_XGEN(j)  (2304 + 64 * (j))
#define XB_TOP      3328
#define XB_TOPGEN   3392
#define XCD_BAR_WORDS 3456
#define XB_SPIN_CAP (1u << 18)

__device__ __forceinline__ unsigned xb_ld(unsigned* p)              { return __hip_atomic_load(p, __ATOMIC_RELAXED, __HIP_MEMORY_SCOPE_AGENT); }
__device__ __forceinline__ unsigned xb_add(unsigned* p, unsigned v) { return __hip_atomic_fetch_add(p, v, __ATOMIC_RELAXED, __HIP_MEMORY_SCOPE_AGENT); }
__device__ __forceinline__ unsigned xb_xcc_id() { return (unsigned)__builtin_amdgcn_s_getreg((3 << 11) | 20) & 0xFu; }
#define XB_SPIN(cond, bar) do { unsigned _sp = 0; while (cond) { __builtin_amdgcn_s_sleep(1); \
    if ((++_sp & 255u) == 0u) { if (xb_ld(&(bar)[XB_TMO])) break; if (_sp > XB_SPIN_CAP) { atomicAdd(&(bar)[XB_TMO], 1u); break; } } } } while (0)

struct XcdBarrier {
    unsigned* bar; unsigned x;
    volatile LAS unsigned* st;
};

__device__ __forceinline__ XcdBarrier xcd_barrier_post(unsigned* bar, volatile LAS unsigned* st) {
    XcdBarrier b; b.bar = bar; b.x = xb_xcc_id(); b.st = st;
    if (threadIdx.x == 0) (void)xb_add(&bar[XB_XCNT(b.x)], 1u);
    return b;
}
__device__ __forceinline__ void xcd_barrier_complete(unsigned* bar, unsigned x, unsigned& nloc, unsigned& nx) {
    const unsigned G = gridDim.x * gridDim.y * gridDim.z;
    unsigned sum, cnt, mine, sp = 0u;
    for (;;) {
        sum = 0u; cnt = 0u; mine = 0u;
#pragma unroll
        for (unsigned j = 0; j < 16; ++j) { const unsigned c = xb_ld(&bar[XB_XCNT(j)]); sum += c; cnt += (c > 0u) ? 1u : 0u; mine = (j == x) ? c : mine; }
        if (sum == G) break;
        __builtin_amdgcn_s_sleep(1);
        if ((++sp & 255u) == 0u) { if (xb_ld(&bar[XB_TMO])) break; if (sp > XB_SPIN_CAP) { atomicAdd(&bar[XB_TMO], 1u); break; } }
    }
    nloc = mine > 0u ? mine : 1u; nx = cnt > 0u ? cnt : 1u;
}

__device__ __forceinline__ void xcd_barrier(const XcdBarrier& b) {
    asm volatile("s_waitcnt vmcnt(0)" ::: "memory");
    __syncthreads();
    if (threadIdx.x == 0) {
        unsigned* bar = b.bar;
        __builtin_amdgcn_s_waitcnt(0);
        unsigned nloc = b.st[0], nx = b.st[1];
        if (nloc == 0u) { xcd_barrier_complete(bar, b.x, nloc, nx); b.st[0] = nloc; b.st[1] = nx; }
        const unsigned old = xb_add(&bar[XB_XSUB(b.x)], 1u);
        const unsigned gen = old / nloc;
        if (old + 1u == (gen + 1u) * nloc) {
            __builtin_amdgcn_fence(__ATOMIC_RELEASE, "agent");
            asm volatile("s_waitcnt vmcnt(0)" ::: "memory");
            const unsigned og = xb_add(&bar[XB_TOP], 1u);
            const unsigned tg = og / nx;
            if (og + 1u == (tg + 1u) * nx) xb_add(&bar[XB_TOPGEN], 1u);
            else XB_SPIN(xb_ld(&bar[XB_TOPGEN]) == tg, bar);
            __builtin_amdgcn_fence(__ATOMIC_ACQUIRE, "agent");
            xb_add(&bar[XB_XGEN(b.x)], 1u);
            asm volatile("s_waitcnt vmcnt(0)" ::: "memory");
        } else {
            XB_SPIN(xb_ld(&bar[XB_XGEN(b.x)]) == gen, bar);
            __builtin_amdgcn_fence(__ATOMIC_ACQUIRE, "agent");
            asm volatile("s_waitcnt vmcnt(0)" ::: "memory");
        }
    }
    __syncthreads();
}
namespace att {
constexpr int   D = 128, NW = 8, QBLK = 32, KVBLK = 64;
constexpr float SCALE = 0.088388347648318440f;
constexpr float THR = 8.f;
constexpr int SDEPTH = 2;
constexpr int LDQ = 17408, LDK = 512, LDO = 2048;
constexpr size_t SHM_V = KVBLK * D * 2, SHM_K = KVBLK * D * 2, SHM_ATTN = 2 * SHM_V + 2 * SHM_K + NW * 64 * 4;
using bf16 = __hip_bfloat16;
using bf16x8 = __attribute__((ext_vector_type(8))) short;
using s16x4  = __attribute__((ext_vector_type(4))) short;
using f32x16 = __attribute__((ext_vector_type(16))) float;
using f32x8  = __attribute__((ext_vector_type(8))) float;
using u32x4  = __attribute__((ext_vector_type(4))) unsigned;
#define KSWZ(row, colB) ((row) * 256 + ((colB) ^ (((row) & 7) << 4)))
#define SBAR() __builtin_amdgcn_sched_barrier(0)
__device__ __forceinline__ int crow(int r, int hi) { return (r & 3) + 8 * (r >> 2) + 4 * hi; }
__device__ __forceinline__ unsigned cvtpk(float lo, float hi) {
  unsigned r; asm volatile("v_cvt_pk_bf16_f32 %0, %1, %2" : "=v"(r) : "v"(lo), "v"(hi)); return r;
}
template <typename TIn> struct Stage;
template <> struct Stage<bf16>  { using T = bf16x8;
  __device__ static __forceinline__ T ld8(const bf16* p) { return *reinterpret_cast<const bf16x8*>(p); }
  __device__ static __forceinline__ bf16x8 tobf(T x) { return x; } };
template <> struct Stage<float> { using T = f32x8;
  __device__ static __forceinline__ T ld8(const float* p) { return *reinterpret_cast<const f32x8*>(p); }
  __device__ static __forceinline__ bf16x8 tobf(T x) {
    u32x4 w = {cvtpk(x[0], x[1]), cvtpk(x[2], x[3]), cvtpk(x[4], x[5]), cvtpk(x[6], x[7])}; return *reinterpret_cast<bf16x8*>(&w); } };

__device__ __forceinline__ void partialSM(f32x16& p0, f32x16& p1, float& m_reg, float& mn, float& alpha) {
  constexpr float C = SCALE * 1.4426950408889634f;
  float pmax = p0[0]; for (int r = 1; r < 16; ++r) pmax = fmaxf(pmax, p0[r]); for (int r = 0; r < 16; ++r) pmax = fmaxf(pmax, p1[r]);
  { auto rr = __builtin_amdgcn_permlane32_swap(__float_as_uint(pmax), __float_as_uint(pmax), false, false);
    pmax = fmaxf(__uint_as_float(rr[0]), __uint_as_float(rr[1])); }
  if (__builtin_expect(__all(pmax - m_reg <= THR / SCALE), 1)) { mn = m_reg; alpha = 1.f; }
  else { mn = fmaxf(m_reg, pmax); alpha = __builtin_amdgcn_exp2f((m_reg - mn) * C); m_reg = mn; }
  float mnC = -mn * C;
  for (int r = 0; r < 16; ++r) p0[r] = fmaf(p0[r], C, mnC); for (int r = 0; r < 16; ++r) p1[r] = fmaf(p1[r], C, mnC);
  for (int r = 0; r < 16; ++r) p0[r] = __builtin_amdgcn_exp2f(p0[r]);
}
__device__ __forceinline__ void finishSM(f32x16& p0, f32x16& p1, float alpha, float& l_reg, bf16x8& pa0, bf16x8& pa1, bf16x8& pa2, bf16x8& pa3) {
  for (int r = 0; r < 16; ++r) p1[r] = __builtin_amdgcn_exp2f(p1[r]);
  float ps = 0; for (int r = 0; r < 16; ++r) ps += p0[r]; for (int r = 0; r < 16; ++r) ps += p1[r];
  { auto rr = __builtin_amdgcn_permlane32_swap(__float_as_uint(ps), __float_as_uint(ps), false, false);
    ps = __uint_as_float(rr[0]) + __uint_as_float(rr[1]); }
  l_reg = l_reg * alpha + ps;
#define PK4(P, BASE, OUT) do { unsigned a0 = cvtpk(P[BASE + 0], P[BASE + 1]), a1 = cvtpk(P[BASE + 2], P[BASE + 3]);   \
    unsigned b0 = cvtpk(P[BASE + 4], P[BASE + 5]), b1 = cvtpk(P[BASE + 6], P[BASE + 7]);                              \
    auto r0 = __builtin_amdgcn_permlane32_swap(a0, b0, false, false); auto r1 = __builtin_amdgcn_permlane32_swap(a1, b1, false, false); \
    u32x4 w = {r0[0], r1[0], r0[1], r1[1]}; OUT = *reinterpret_cast<bf16x8*>(&w); } while (0)
  PK4(p0, 0, pa0); PK4(p0, 8, pa1); PK4(p1, 0, pa2); PK4(p1, 8, pa3);
#undef PK4
}
__device__ __forceinline__ void qkt(f32x16& p0, f32x16& p1, const bf16* Ks, const bf16x8* qr, int r32, int hi) {
  p0 = f32x16{}; p1 = f32x16{};
  for (int d0 = 0; d0 < 8; ++d0) { int cb = (d0 * 16 + hi * 8) * 2;
    bf16x8 b0 = *reinterpret_cast<const bf16x8*>((const char*)Ks + KSWZ(r32, cb));
    bf16x8 b1 = *reinterpret_cast<const bf16x8*>((const char*)Ks + KSWZ(32 + r32, cb));
    p0 = __builtin_amdgcn_mfma_f32_32x32x16_bf16(b0, qr[d0], p0, 0, 0, 0);
    p1 = __builtin_amdgcn_mfma_f32_32x32x16_bf16(b1, qr[d0], p1, 0, 0, 0); }
}
__device__ __forceinline__ int v_st(int k, int c) { const int kk = (k & ~0xC) | ((k & 4) << 1) | ((k & 8) >> 1); return ((kk >> 3) * 4 + (c >> 5)) * 512 + ((kk & 7) * 32 + (c & 31)) * 2; }
__device__ __forceinline__ int v_rd_base(int lane) { return ((lane & 3) << 3) | (((lane >> 2) & 3) << 6) | (((lane >> 4) & 1) << 5) | (((lane >> 5) & 1) << 8); }
constexpr int v_rd_off(int d0, int ks, int half) { return d0 * 512 + ks * 4096 + half * 2048; }
template <int OFF> __device__ __forceinline__ s16x4 tr_read(int vb) {
  s16x4 r; asm volatile("ds_read_b64_tr_b16 %0, %1 offset:%2" : "=&v"(r) : "v"(vb), "i"(OFF) : "memory"); return r;
}
template <int D0> __device__ __forceinline__ void pv_one(f32x16& od, int vb, bf16x8 pa0, bf16x8 pa1, bf16x8 pa2, bf16x8 pa3) {
  const s16x4 l0 = tr_read<v_rd_off(D0, 0, 0)>(vb), h0 = tr_read<v_rd_off(D0, 0, 1)>(vb), l1 = tr_read<v_rd_off(D0, 1, 0)>(vb), h1 = tr_read<v_rd_off(D0, 1, 1)>(vb);
  const s16x4 l2 = tr_read<v_rd_off(D0, 2, 0)>(vb), h2 = tr_read<v_rd_off(D0, 2, 1)>(vb), l3 = tr_read<v_rd_off(D0, 3, 0)>(vb), h3 = tr_read<v_rd_off(D0, 3, 1)>(vb);
  asm volatile("s_waitcnt lgkmcnt(0)" ::: "memory"); SBAR();
#define PK(L, H) (bf16x8){L[0], L[1], L[2], L[3], H[0], H[1], H[2], H[3]}
  od = __builtin_amdgcn_mfma_f32_32x32x16_bf16(pa0, PK(l0, h0), od, 0, 0, 0);
  od = __builtin_amdgcn_mfma_f32_32x32x16_bf16(pa1, PK(l1, h1), od, 0, 0, 0);
  od = __builtin_amdgcn_mfma_f32_32x32x16_bf16(pa2, PK(l2, h2), od, 0, 0, 0);
  od = __builtin_amdgcn_mfma_f32_32x32x16_bf16(pa3, PK(l3, h3), od, 0, 0, 0);
#undef PK
}
__device__ __forceinline__ void pv_d0(f32x16* o, int vb, bf16x8 pa0, bf16x8 pa1, bf16x8 pa2, bf16x8 pa3) {
  pv_one<0>(o[0], vb, pa0, pa1, pa2, pa3); pv_one<1>(o[1], vb, pa0, pa1, pa2, pa3); pv_one<2>(o[2], vb, pa0, pa1, pa2, pa3); pv_one<3>(o[3], vb, pa0, pa1, pa2, pa3);
}

template <typename TQ>
__device__ __forceinline__ void attn_dense_body(const TQ* __restrict__ Qb, const bf16* __restrict__ Kh, const bf16* __restrict__ Vh,
                                                bf16* __restrict__ Ob, int seq, char* lds, const float* __restrict__ gq, const float* __restrict__ rope, int t0) {
  using St = Stage<bf16>; using SQ = Stage<TQ>;
  int tid_ = threadIdx.x; asm volatile("" : "+v"(tid_));
  const int tid = tid_, wid = tid >> 6, lane = tid & 63, r32 = lane & 31, hi = lane >> 5;
  bf16* V_lds = (bf16*)lds; bf16* K_lds = (bf16*)(lds + 2 * SHM_V);
  float* ws = (float*)(lds + 2 * SHM_V + 2 * SHM_K) + wid * 64; float* li_l = ws; float* al_l = ws + 32;
  float m_reg = -1e30f, l_reg = 0; f32x16 o[4] = {}; bf16x8 qr[8];
  const TQ* Qw = Qb + (long)(wid * QBLK + r32) * LDQ + hi * 8;
#pragma unroll
  for (int d0 = 0; d0 < 8; ++d0) qr[d0] = SQ::tobf(SQ::ld8(Qw + d0 * 16));
  const int sr = tid >> 4, sc = (tid & 15) * 8, vst0 = v_st(sr, sc), vst1 = v_st(32 + sr, sc);
  const int vb0 = (int)(uintptr_t)V_lds + v_rd_base(lane);
  struct { typename St::T vs0, vs1, ks0, ks1; } sr_[SDEPTH];
#define SLOAD(i, k0) do { sr_[i].vs0 = St::ld8(&Vh[(long)((k0) + sr) * LDK + sc]); sr_[i].vs1 = St::ld8(&Vh[(long)((k0) + 32 + sr) * LDK + sc]); \
    sr_[i].ks0 = St::ld8(&Kh[(long)((k0) + sr) * LDK + sc]); sr_[i].ks1 = St::ld8(&Kh[(long)((k0) + 32 + sr) * LDK + sc]); } while (0)
  constexpr int SE = 0, SO = SDEPTH - 1;
  SLOAD(SE, 0);
  {
    typedef float f32x4q __attribute__((ext_vector_type(4)));
    float qf[8][8]; float ss = 0.f;
#pragma unroll
    for (int d0 = 0; d0 < 8; ++d0)
#pragma unroll
      for (int j = 0; j < 8; ++j) { const float v = __uint_as_float(((unsigned)(unsigned short)qr[d0][j]) << 16); qf[d0][j] = v; ss += v * v; }
    ss += __shfl_xor(ss, 32);
    const float rs = rsqrtf(ss * (1.f / 128.f) + 1e-6f);
#pragma unroll
    for (int d0 = 0; d0 < 8; ++d0) { const f32x4q g0 = *(const f32x4q*)(gq + d0 * 16 + hi * 8), g1 = *(const f32x4q*)(gq + d0 * 16 + hi * 8 + 4);
#pragma unroll
      for (int j = 0; j < 4; ++j) { qf[d0][j] *= rs * g0[j]; qf[d0][4 + j] *= rs * g1[j]; } }
    if (rope) {
      const int t = t0 + wid * QBLK + r32;
#pragma unroll
      for (int ax = 0; ax < 2; ++ax) { const int pos = ax == 0 ? (t >> 6) : (t & 63);
#pragma unroll
        for (int e = 0; e < 2; ++e) { const int da = ax * 4 + e, db = da + 2; const float* cp = rope + pos * 32 + e * 16 + hi * 8;
          const f32x4q c0 = *(const f32x4q*)cp, c1 = *(const f32x4q*)(cp + 4), s0 = *(const f32x4q*)(cp + 2048), s1 = *(const f32x4q*)(cp + 2048 + 4);
#pragma unroll
          for (int j = 0; j < 8; ++j) { const float c = j < 4 ? c0[j & 3] : c1[j & 3], sn = j < 4 ? s0[j & 3] : s1[j & 3]; const float xa = qf[da][j], xb = qf[db][j]; qf[da][j] = xa * c - xb * sn; qf[db][j] = xa * sn + xb * c; } } }
    }
#pragma unroll
    for (int d0 = 0; d0 < 8; ++d0) { u32x4 w = {cvtpk(qf[d0][0], qf[d0][1]), cvtpk(qf[d0][2], qf[d0][3]), cvtpk(qf[d0][4], qf[d0][5]), cvtpk(qf[d0][6], qf[d0][7])}; qr[d0] = *reinterpret_cast<bf16x8*>(&w); }
  }
#define SWRITE(b, i) do { *(bf16x8*)((char*)V_lds + (b) * SHM_V + vst0) = St::tobf(sr_[i].vs0);          \
    *(bf16x8*)((char*)V_lds + (b) * SHM_V + vst1) = St::tobf(sr_[i].vs1); int kc = sc * 2;               \
    *(bf16x8*)((char*)K_lds + (b) * SHM_K + KSWZ(sr, kc)) = St::tobf(sr_[i].ks0);                       \
    *(bf16x8*)((char*)K_lds + (b) * SHM_K + KSWZ(32 + sr, kc)) = St::tobf(sr_[i].ks1); } while (0)
#define SWAIT() do { if constexpr (SDEPTH == 2) asm volatile("s_waitcnt vmcnt(4)" ::: "memory"); else asm volatile("s_waitcnt vmcnt(0)" ::: "memory"); } while (0)
#define RESC(a) do { if (__any((a) < 1.f)) { if (hi == 0) al_l[r32] = (a); asm volatile("s_waitcnt lgkmcnt(0)" ::: "memory"); \
    for (int d = 0; d < 4; ++d) for (int r = 0; r < 16; ++r) o[d][r] *= al_l[crow(r, hi)]; } } while (0)
  f32x16 pA0, pA1, pB0, pB1; float mnA, mnB, alA, alB; bf16x8 pa0, pa1, pa2, pa3; const int NT = seq / KVBLK;
  asm volatile("s_waitcnt vmcnt(0)" ::: "memory"); SWRITE(0, SE); __syncthreads();
  qkt(pA0, pA1, K_lds, qr, r32, hi); partialSM(pA0, pA1, m_reg, mnA, alA);
  SLOAD(SO, KVBLK); if constexpr (SDEPTH == 2) { if (2 < NT) SLOAD(SE, 2 * KVBLK); }
  SWAIT(); SWRITE(1, SO); __syncthreads();
  for (int j = 1; j + 1 < NT; j += 2) {
    SBAR(); qkt(pB0, pB1, (bf16*)((char*)K_lds + SHM_K), qr, r32, hi);
    finishSM(pA0, pA1, alA, l_reg, pa0, pa1, pa2, pa3); SBAR();
    SLOAD(SO, (j + SDEPTH) * KVBLK); SBAR();
    pv_d0(o, vb0, pa0, pa1, pa2, pa3); partialSM(pB0, pB1, m_reg, mnB, alB);
    __syncthreads(); SWAIT(); SWRITE(0, SE);
    RESC(alB); __syncthreads();
    SBAR(); qkt(pA0, pA1, K_lds, qr, r32, hi);
    finishSM(pB0, pB1, alB, l_reg, pa0, pa1, pa2, pa3); SBAR();
    if (SDEPTH == 1 || j + 3 < NT) SLOAD(SE, (j + 1 + SDEPTH) * KVBLK); SBAR();
    pv_d0(o, vb0 + (int)SHM_V, pa0, pa1, pa2, pa3); partialSM(pA0, pA1, m_reg, mnA, alA);
    __syncthreads(); SWAIT(); SWRITE(1, SO);
    RESC(alA); __syncthreads();
  }
  SBAR(); qkt(pB0, pB1, (bf16*)((char*)K_lds + SHM_K), qr, r32, hi);
  finishSM(pA0, pA1, alA, l_reg, pa0, pa1, pa2, pa3); SBAR();
  pv_d0(o, vb0, pa0, pa1, pa2, pa3); partialSM(pB0, pB1, m_reg, mnB, alB);
  __syncthreads(); RESC(alB);
  finishSM(pB0, pB1, alB, l_reg, pa0, pa1, pa2, pa3); SBAR();
  pv_d0(o, vb0 + (int)SHM_V, pa0, pa1, pa2, pa3);
  if (hi == 0) li_l[r32] = l_reg; asm volatile("s_waitcnt lgkmcnt(0)" ::: "memory");
  float rli[16];
#pragma unroll
  for (int r = 0; r < 16; ++r) rli[r] = __builtin_amdgcn_rcpf(li_l[crow(r, hi)]);
  bf16* Ow = Ob + (long)(wid * QBLK) * LDO;
  { char* stg = lds + SHM_ATTN + wid * (32 * 272);
#pragma unroll
    for (int r = 0; r < 16; ++r) { const int orow = crow(r, hi);
#pragma unroll
      for (int d0 = 0; d0 < 4; ++d0) *(bf16*)(stg + orow * 272 + (d0 * 32 + r32) * 2) = __float2bfloat16(o[d0][r] * rli[r]); }
    asm volatile("s_waitcnt lgkmcnt(0)" ::: "memory");
#pragma unroll
    for (int i = 0; i < 8; ++i) { const int row = i * 4 + (lane >> 4), ch = lane & 15;
      const u32x4 v = *(const u32x4*)(stg + row * 272 + ch * 16);
      *(u32x4*)(Ow + (long)row * LDO + ch * 8) = v; }
  }
#undef SLOAD
#undef SWRITE
#undef SWAIT
#undef RESC
}
#undef KSWZ
#undef SBAR
}
namespace fk {
using pg8::bf16_t; using pg8::f32x4; using pg8::u32x4; using pg8::Unit; using pg8::cvt_pk_bf16;
typedef unsigned u32x2 __attribute__((ext_vector_type(2)));
typedef float f32x16 __attribute__((ext_vector_type(16)));
constexpr int M = 24576, MP = 8192, D = 2048, INW = 17408, DFF = 8192, DEPTH = 4, NWAVES = 8, NCOND = 9;
constexpr int OFF_Q = 0, OFF_K = 2048, OFF_V = 2560, OFF_LX = 3072, OFF_LG = 5120, OFF_CU = 7168, OFF_CV = 9216, OFF_G = 11264;
constexpr int NKVROWS = 26624;
constexpr float EPS = 1e-6f;
constexpr int NPHASE = 3 + 9 * DEPTH;
constexpr int NMODK = 32;
constexpr size_t MiB = 1u << 20;
constexpr size_t WS_CTL = 0, CTL_ZERO_BYTES = 1 * MiB;
constexpr size_t WS_CIN = 1 * MiB  , WS_MODP = 716 * MiB  , WS_MOD = 28 * MiB, WS_ROPE = 30 * MiB, WS_CVSTAT = 31 * MiB, WS_FSTAT = 34 * MiB, WS_AGG = 37 * MiB, WS_WLRU = 49 * MiB, WS_CMW = 51 * MiB;
constexpr size_t WS_WIN = 52 * MiB, WS_WBR = 120 * MiB, WS_WOUT = 144 * MiB, WS_WFF1 = 152 * MiB, WS_WFF2 = 184 * MiB;
constexpr size_t WS_H = 216 * MiB, WS_KALL = 312 * MiB, WS_VALL = 338 * MiB, WS_BR = 364 * MiB, WS_MSCR = 652 * MiB, WS_Z = 716 * MiB, WS_XB = 1532 * MiB  , WS_END = 1628 * MiB;
constexpr size_t WS_FFH = WS_Z, WS_F = WS_Z + 384 * MiB;
constexpr int CW_SPLIT = 2048;
constexpr int CW_BAR = 4096;
constexpr int RING_BYTES = 131072;
constexpr int LRU_XCSZ = 17408, LRU_XCB = 2 * LRU_XCSZ, LRU_HP = 132, LRU_H0 = 4 * LRU_XCSZ, LRU_H1 = LRU_H0 + 64 * LRU_HP * 4;
constexpr int LRU_TAPS = LRU_H1 + 64 * LRU_HP * 4;
static_assert(LRU_TAPS + 5 * 128 * 4 <= 150528, "lru lds map");
constexpr int LRU_XC = 0, LRU_XC_PITCH = 272, LRU_A0 = 17408, LRU_B0 = LRU_A0 + 32768, LRU_A1 = LRU_B0 + 32768, LRU_B1 = LRU_A1 + 32768, LRU_CARRY = LRU_B1 + 32768;
constexpr int CM_VT = 0, CM_VT_PITCH = 272, CM_RS = 128 * 272;
constexpr int MISC_OFF = 150528, LDS_BYTES = 151552;
static_assert(LRU_CARRY + 2048 <= MISC_OFF, "lds map");

struct Params { const float* in[32]; float* out; unsigned char* ws; int ph_lo, ph_hi, li, pad; };

typedef const __attribute__((address_space(4))) void* kaptr_t;
struct Frame {
    LAS unsigned char* lds;
    int tid, lane, wave, vcu, G, gw, NGW, bx;
    float* out; unsigned char* ws; kaptr_t ka;
    __device__ __forceinline__ float* x() const { return out; }
    __device__ __forceinline__ float* new_k() const { return out + 50331648L; }
    __device__ __forceinline__ float* new_v() const { return out + 50331648L + 16777216L; }
    __device__ __forceinline__ float* new_s() const { return out + 50331648L + 2 * 16777216L; }
#define FK_WSP(name, type, off) __device__ __forceinline__ type* name() const { return (type*)(ws + (off)); }
    FK_WSP(MODP, float, WS_MODP) FK_WSP(MOD, float, WS_MOD) FK_WSP(ROPE, float, WS_ROPE) FK_WSP(CVSTAT, float, WS_CVSTAT) FK_WSP(FSTAT, float, WS_FSTAT) FK_WSP(AGG, float, WS_AGG) FK_WSP(CIN, float, WS_CIN) FK_WSP(MSCR, float, WS_MSCR)
    FK_WSP(WLRU, bf16_t, WS_WLRU) FK_WSP(CMW, bf16_t, WS_CMW) FK_WSP(WIN, bf16_t, WS_WIN) FK_WSP(WBR, bf16_t, WS_WBR) FK_WSP(WOUT, bf16_t, WS_WOUT) FK_WSP(WFF1, bf16_t, WS_WFF1) FK_WSP(WFF2, bf16_t, WS_WFF2)
    FK_WSP(H, bf16_t, WS_H) FK_WSP(KALL, bf16_t, WS_KALL) FK_WSP(VALL, bf16_t, WS_VALL) FK_WSP(BR, bf16_t, WS_BR) FK_WSP(Z, bf16_t, WS_Z) FK_WSP(FFH, bf16_t, WS_FFH) FK_WSP(XB, bf16_t, WS_XB) FK_WSP(Fb, bf16_t, WS_F)
#undef FK_WSP
};
enum { I_XP = 0, I_XS, I_CK, I_CV, I_SL, I_C, I_CCTX, I_WMOD, I_BMOD, I_GPM, I_GPOM, I_GPF, I_GPOF, I_WIN, I_GQ, I_GK, I_WAO, I_CW, I_CB, I_LWA, I_LBA, I_LWX, I_LBX, I_LAM, I_WLO, I_CMG, I_CMWS, I_CMBS, I_WCO, I_WOUT, I_WFF1, I_WFF2 };
template <int I> __device__ __forceinline__ const float* inp(const Frame& F) { const GAS float* r; asm volatile("s_load_dwordx2 %0, %1, %2\n\ts_waitcnt lgkmcnt(0)" : "=s"(r) : "s"(F.ka), "i"(I * 8) : "memory"); return (const float*)r; }


__device__ __forceinline__ Frame phase_frame(const Frame& F) {
    Frame P = F; int t = F.tid; int bx = blockIdx.x; int g = F.G; GAS unsigned char* w = (GAS unsigned char*)F.ws; GAS float* o = (GAS float*)F.out;
    asm volatile("" : "+v"(t)); asm volatile("" : "+s"(bx), "+s"(g), "+s"(w), "+s"(o));
    P.tid = t; P.lane = t & 63; P.wave = __builtin_amdgcn_readfirstlane(t >> 6); P.ws = (unsigned char*)w; P.out = (float*)o; P.bx = bx; P.G = g; P.NGW = g * NWAVES;
    P.vcu = (g % 8 == 0) ? (bx % 8) * (g / 8) + bx / 8 : bx; P.gw = P.vcu * NWAVES + P.wave;
    return P;
}
__device__ __forceinline__ float wave_sum(float v) {
#pragma unroll
    for (int o = 1; o < 64; o <<= 1) v += __shfl_xor(v, o);
    return v;
}
__device__ __forceinline__ float bf2f(unsigned short h) { return __uint_as_float((unsigned)h << 16); }
__device__ __forceinline__ float bflo(unsigned w) { return __uint_as_float(w << 16); }
__device__ __forceinline__ float bfhi(unsigned w) { return __uint_as_float(w & 0xffff0000u); }
__device__ __forceinline__ float fsigm(float x) { return __builtin_amdgcn_rcpf(1.f + __builtin_amdgcn_exp2f(-1.4426950408889634f * x)); }
__device__ __forceinline__ float fgelu(float x) { const float u = x * (1.5957691216057308f + 0.0713548162726009f * x * x); return x * fsigm(u); }

struct CvItem { const float* W; bf16_t* WT; int K, N, row_off, sub; };
struct CvRegs { f32x4 v[8][2]; };
__device__ __forceinline__ void cv_load(CvRegs& R, const CvItem& I, int lane) {
    const int nblk = I.N / 64, kb = I.sub / nblk, nb = I.sub % nblk, k0 = 64 * kb, n0 = 64 * nb;
    const float* src = I.W + (size_t)(k0 + 2 * (lane >> 4)) * I.N + n0 + (lane & 15) * 4;
#pragma unroll
    for (int i = 0; i < 8; ++i) { R.v[i][0] = __builtin_nontemporal_load((const f32x4*)(src + (size_t)(8 * i) * I.N)); R.v[i][1] = __builtin_nontemporal_load((const f32x4*)(src + (size_t)(8 * i + 1) * I.N)); }
}
__device__ __forceinline__ void cv_store(const CvRegs& R, const CvItem& I, LAS unsigned char* scr, int lane) {
    const int nblk = I.N / 64, kb = I.sub / nblk, nb = I.sub % nblk, k0 = 64 * kb, n0 = 64 * nb;
    const int n4 = (lane & 15) * 4, kp = lane >> 4;
#pragma unroll
    for (int i = 0; i < 8; ++i) { const int k = 8 * i + 2 * kp;
#pragma unroll
        for (int j = 0; j < 4; ++j) *(LAS unsigned*)(scr + (n4 + j) * 144 + k * 2) = cvt_pk_bf16(R.v[i][0][j], R.v[i][1][j]); }
    LDS_WAIT(); asm volatile("" ::: "memory");
    const int ch = lane & 7;
#pragma unroll
    for (int j = 0; j < 8; ++j) { const int n = (lane >> 3) + 8 * j;
        const v4u o = *(const LAS v4u*)(scr + n * 144 + ch * 16);
        *(GAS v4u*)(I.WT + (size_t)(I.row_off + n0 + n) * I.K + k0 + 8 * ch) = o; }
    LDS_WAIT(); asm volatile("" ::: "memory");
}
#ifndef CVT_TAIL_ITEMS
#define CVT_TAIL_ITEMS 8192
#endif
__device__ __forceinline__ void convert_layer(const Frame& F, int l, int part, int wid, int NW) {
    LAS unsigned char* scr = F.lds + F.wave * 16384;
    constexpr int I_IN = 32 * 272, I_SQ = 32 * 32, I_F1 = 32 * 128, I_F2 = 128 * 32, I_LRU = 64 * 4;
    constexpr int I_TAIL = CVT_TAIL_ITEMS, I_HEAD = I_IN + 4 * I_SQ + I_F1 + I_F2 - I_TAIL;
    static_assert(I_TAIL <= 4 * I_SQ + I_F1 + I_F2, "tail items");
    const int NITEMS = part ? I_TAIL : I_HEAD + I_LRU;
    const float* w_in = inp<I_WIN>(F) + (size_t)l * D * INW; const float* w_ao = inp<I_WAO>(F) + (size_t)l * D * D; const float* w_lo = inp<I_WLO>(F) + (size_t)l * D * D;
    const float* w_co = inp<I_WCO>(F) + (size_t)l * D * D; const float* w_out = inp<I_WOUT>(F) + (size_t)l * D * D; const float* w_f1 = inp<I_WFF1>(F) + (size_t)l * D * DFF;
    const float* w_f2 = inp<I_WFF2>(F) + (size_t)l * DFF * D; const float* lwa = inp<I_LWA>(F) + (size_t)l * 2 * 16 * 16384; const float* lwx = inp<I_LWX>(F) + (size_t)l * 2 * 16 * 16384;
    bf16_t* WIN = F.WIN(); bf16_t* WBR = F.WBR(); bf16_t* WOUT = F.WOUT(); bf16_t* WFF1 = F.WFF1(); bf16_t* WFF2 = F.WFF2(); bf16_t* WLRU = F.WLRU();
    auto decode = [&](int it) -> CvItem {
        int r = part ? it + I_HEAD : (it < I_HEAD ? it : it + I_TAIL);
        if (r < I_IN) return CvItem{w_in, WIN, D, INW, 0, r}; r -= I_IN;
        if (r < I_SQ) return CvItem{w_ao, WBR, D, D, 0, r}; r -= I_SQ;
        if (r < I_SQ) return CvItem{w_lo, WBR, D, D, D, r}; r -= I_SQ;
        if (r < I_SQ) return CvItem{w_co, WBR, D, D, 2 * D, r}; r -= I_SQ;
        if (r < I_SQ) return CvItem{w_out, WOUT, D, D, 0, r}; r -= I_SQ;
        if (r < I_F1) return CvItem{w_f1, WFF1, D, DFF, 0, r}; r -= I_F1;
        if (r < I_F2) return CvItem{w_f2, WFF2, DFF, D, 0, r}; r -= I_F2;
        const int bi = r >> 2, d = bi >> 5, mat = (bi >> 4) & 1, blk = bi & 15;
        return CvItem{(mat ? lwx : lwa) + ((size_t)d * 16 + blk) * 16384, WLRU + (size_t)bi * 16384, 128, 128, 0, r & 3};
    };
    CvRegs A, B;
    int it = wid;
    if (it < NITEMS) cv_load(A, decode(it), F.lane);
    for (; it < NITEMS; it += 2 * NW) {
#pragma unroll
        for (int half = 0; half < 2; ++half) {
            const int ic = it + half * NW, in = ic + NW;
            if (ic >= NITEMS) break;
            CvRegs& cur = half ? B : A; CvRegs& nxt = half ? A : B;
            if (in < NITEMS) cv_load(nxt, decode(in), F.lane);
            cv_store(cur, decode(ic), scr, F.lane);
        }
    }
    if (part) return;
    const float* cw = inp<I_CMWS>(F) + (size_t)l * 16 * 16384;
    for (int i = (F.gw * 64 + F.lane) * 8; i < 16 * 16384; i += F.NGW * 64 * 8) {
        const f32x4 a = *(const f32x4*)(cw + i), b = *(const f32x4*)(cw + i + 4);
        v4u o; o.x = pk2(a.x, a.y); o.y = pk2(a.z, a.w); o.z = pk2(b.x, b.y); o.w = pk2(b.z, b.w);
        *(v4u*)(F.CMW() + i) = o;
    }
}
__device__ __forceinline__ void mod_partials(const Frame& F) {
    LAS float* scr = (LAS float*)(F.lds + F.wave * 16384);
    const float* cctx = inp<I_CCTX>(F); const float* cc = inp<I_C>(F); const float* wmod = inp<I_WMOD>(F);
    for (int it = F.gw; it < DEPTH * 48 * NMODK; it += F.NGW) {
        const int kc = it % NMODK, jb = (it / NMODK) % 48, l = it / (NMODK * 48), k0 = kc * 64;
        for (int e = F.lane; e < NCOND * 64; e += 64) { const int ci = e >> 6, kk = e & 63; const float v = ci == 0 ? cctx[k0 + kk] : cc[(ci - 1) * D + k0 + kk]; scr[e] = v * (1.f / (1.f + __expf(-v))); }
        LDS_WAIT(); asm volatile("" ::: "memory");
        f32x4 acc[NCOND];
#pragma unroll
        for (int ci = 0; ci < NCOND; ++ci) acc[ci] = (f32x4){0.f, 0.f, 0.f, 0.f};
        const float* wp = wmod + ((size_t)l * D + k0) * 12288 + jb * 256 + F.lane * 4;
#pragma unroll
        for (int kb = 0; kb < 64; kb += 16) {
            f32x4 w[16];
#pragma unroll
            for (int kk = 0; kk < 16; ++kk) w[kk] = *(const f32x4*)(wp + (size_t)(kb + kk) * 12288);
#pragma unroll
            for (int kk = 0; kk < 16; ++kk)
#pragma unroll
                for (int ci = 0; ci < NCOND; ++ci) acc[ci] += w[kk] * scr[ci * 64 + kb + kk];
        }
#pragma unroll
        for (int ci = 0; ci < NCOND; ++ci) *(f32x4*)(F.MODP() + (((size_t)kc * DEPTH + l) * NCOND + ci) * 12288 + jb * 256 + F.lane * 4) = acc[ci];
        LDS_WAIT(); asm volatile("" ::: "memory");
    }
}
__device__ __forceinline__ void mod_reduce(const Frame& F) {
    constexpr int NEL = DEPTH * NCOND * 12288;
    for (int i = (F.gw * 64 + F.lane) * 4; i < NEL; i += F.NGW * 64 * 4) {
        const int l = i / (NCOND * 12288), j = i % 12288;
        f32x4 s = *(const f32x4*)(inp<I_BMOD>(F) + (size_t)l * 12288 + j);
#pragma unroll
        for (int kc = 0; kc < NMODK; ++kc) s += *(const f32x4*)(F.MODP() + (size_t)kc * NEL + i);
        *(f32x4*)(F.MOD() + i) = s;
    }
}
__device__ __forceinline__ void rope_table(const Frame& F) {
    if (F.bx == 0) for (int e = F.tid; e < 2048; e += NWAVES * 64) {
        const int pos = e >> 5, f = e & 31; const float inv = exp2f(-(float)f * (13.287712379549449f / 32.f)); float s, c; sincosf((float)pos * inv, &s, &c);
        F.ROPE()[e] = c; F.ROPE()[2048 + e] = s; }
}
__device__ __forceinline__ u32x4 pack8(const f32x4& a, const f32x4& b) { u32x4 w; w.x = cvt_pk_bf16(a[0], a[1]); w.y = cvt_pk_bf16(a[2], a[3]); w.z = cvt_pk_bf16(b[0], b[1]); w.w = cvt_pk_bf16(b[2], b[3]); return w; }
struct RowIn { f32x4 x[4][2]; u32x4 xb[4]; u32x4 f[4]; float st; };
template <bool XF32, bool HAS_F>
__device__ __forceinline__ void row_load(const Frame& F, RowIn& R, const float* xsrc, const bf16_t* xbsrc, const bf16_t* frow, const float* fstat) {
    if (XF32) {
#pragma unroll
        for (int j = 0; j < 4; ++j) { const int e = (j * 64 + F.lane) * 8; R.x[j][0] = __builtin_nontemporal_load((const f32x4*)(xsrc + e)); R.x[j][1] = __builtin_nontemporal_load((const f32x4*)(xsrc + e + 4)); }
    } else {
#pragma unroll
        for (int j = 0; j < 4; ++j) R.xb[j] = __builtin_nontemporal_load((const u32x4*)(xbsrc + (j * 64 + F.lane) * 8));
    }
    if (HAS_F) {
#pragma unroll
        for (int j = 0; j < 4; ++j) R.f[j] = __builtin_nontemporal_load((const u32x4*)(frow + (j * 64 + F.lane) * 8));
        R.st = F.lane < 32 ? fstat[F.lane] : 0.f;
    }
}
template <bool XF32, bool HAS_F, bool HAS_H, bool OUTF32>
__device__ __forceinline__ void row_apply(const Frame& F, RowIn& R, float* xdst, bf16_t* xbdst, const LAS float* pv, bf16_t* hrow, float gs) {
    if (!XF32) {
#pragma unroll
        for (int j = 0; j < 4; ++j) { const u32x4 w = R.xb[j]; R.x[j][0] = (f32x4){bflo(w.x), bfhi(w.x), bflo(w.y), bfhi(w.y)}; R.x[j][1] = (f32x4){bflo(w.z), bfhi(w.z), bflo(w.w), bfhi(w.w)}; }
    }
    if (HAS_F) {
        const float rs = rsqrtf(wave_sum(R.st) * (1.f / D) + EPS) * gs;
#pragma unroll
        for (int j = 0; j < 4; ++j) { const int e = (j * 64 + F.lane) * 8; const u32x4 fw = R.f[j];
            const f32x4 g0 = *(const LAS f32x4*)(pv + e), g1 = *(const LAS f32x4*)(pv + e + 4), p0 = *(const LAS f32x4*)(pv + 2048 + e), p1 = *(const LAS f32x4*)(pv + 2048 + e + 4);
            const f32x4 f0 = {bflo(fw.x), bfhi(fw.x), bflo(fw.y), bfhi(fw.y)}, f1 = {bflo(fw.z), bfhi(fw.z), bflo(fw.w), bfhi(fw.w)};
            R.x[j][0] += g0 * (f0 * rs * p0); R.x[j][1] += g1 * (f1 * rs * p1); }
    }
    if (OUTF32) {
#pragma unroll
        for (int j = 0; j < 4; ++j) { const int e = (j * 64 + F.lane) * 8; __builtin_nontemporal_store(R.x[j][0], (f32x4*)(xdst + e)); __builtin_nontemporal_store(R.x[j][1], (f32x4*)(xdst + e + 4)); }
    } else {
#pragma unroll
        for (int j = 0; j < 4; ++j) __builtin_nontemporal_store(pack8(R.x[j][0], R.x[j][1]), (u32x4*)(xbdst + (j * 64 + F.lane) * 8));
    }
    if (HAS_H) {
        float ss = 0.f;
#pragma unroll
        for (int j = 0; j < 4; ++j)
#pragma unroll
            for (int h = 0; h < 2; ++h) ss += (R.x[j][h].x * R.x[j][h].x + R.x[j][h].y * R.x[j][h].y) + (R.x[j][h].z * R.x[j][h].z + R.x[j][h].w * R.x[j][h].w);
        const float rs = rsqrtf(wave_sum(ss) * (1.f / D) + EPS);
#pragma unroll
        for (int j = 0; j < 4; ++j) { const int e = (j * 64 + F.lane) * 8;
            f32x4 o[2];
#pragma unroll
            for (int h = 0; h < 2; ++h) { const f32x4 g = *(const LAS f32x4*)(pv + 2 * 2048 + e + 4 * h), s1 = *(const LAS f32x4*)(pv + 3 * 2048 + e + 4 * h), s0 = *(const LAS f32x4*)(pv + 4 * 2048 + e + 4 * h); o[h] = R.x[j][h] * rs * g * (s1 + 1.f) + s0; }
            u32x4 w; w.x = cvt_pk_bf16(o[0].x, o[0].y); w.y = cvt_pk_bf16(o[0].z, o[0].w); w.z = cvt_pk_bf16(o[1].x, o[1].y); w.w = cvt_pk_bf16(o[1].z, o[1].w);
            *(u32x4*)(hrow + e) = w; }
    }
}
__device__ __forceinline__ int cond_of_row(int m) { return m < MP ? 0 : 1 + ((m - MP) >> 11); }
template <int MODE>
__device__ __forceinline__ void rowlocal_phase(const Frame& F, int l, float gs = 1.f) {
    constexpr bool HAS_F = MODE != 0, XF32 = MODE == 0, HAS_H = MODE != 3;
    const float* xp = inp<I_XP>(F); const float* xs = inp<I_XS>(F);
    const float* gpost = MODE == 1 ? inp<I_GPOM>(F) + (size_t)l * D : inp<I_GPOF>(F) + (size_t)l * D;
    const float* gpre = MODE == 0 ? inp<I_GPM>(F) : MODE == 1 ? inp<I_GPF>(F) + (size_t)l * D : inp<I_GPM>(F) + (size_t)(l + 1 < DEPTH ? l + 1 : l) * D;
    float* X = F.x(); bf16_t* XB = F.XB(); const bf16_t* Fb = F.Fb(); const float* FS = F.FSTAT(); bf16_t* H = F.H(); const float* MODb = F.MOD();
    LAS float* pv = (LAS float*)F.lds;
    { const int e = F.tid * 4;
      if (HAS_F) *(LAS f32x4*)(pv + 2048 + e) = *(const f32x4*)(gpost + e);
      if (HAS_H) *(LAS f32x4*)(pv + 2 * 2048 + e) = *(const f32x4*)(gpre + e); }
    constexpr int NITEM = M / 32;
    const int nit = F.bx < NITEM ? (NITEM - F.bx + F.G - 1) / F.G : 0, nq = 4 * nit;
    RowIn A, B;
    auto rowof = [&](int q) -> int { return (F.bx + (q >> 2) * F.G) * 32 + F.wave * 4 + (q & 3); };
    auto src = [&](int m) -> const float* { return m < MP ? xp + (size_t)m * D : xs + (size_t)(m - MP) * D; };
    f32x4 pf0 = {0.f, 0.f, 0.f, 0.f}, pf1 = pf0, pf2 = pf0;
    auto modload = [&](int k) {
        const int item = F.bx + k * F.G, ci = item < (MP / 32) ? 0 : 1 + ((item - MP / 32) >> 6), e = F.tid * 4;
        const float* modl = MODb + ((size_t)l * NCOND + ci) * 12288; const float* modn = MODb + ((size_t)(l + 1 < DEPTH ? l + 1 : l) * NCOND + ci) * 12288;
        if (MODE == 1) pf0 = *(const f32x4*)(modl + 2 * D + e);
        if (MODE >= 2) pf0 = *(const f32x4*)(modl + 5 * D + e);
        if (MODE == 0) { pf1 = *(const f32x4*)(modl + 1 * D + e); pf2 = *(const f32x4*)(modl + 0 * D + e); }
        if (MODE == 1) { pf1 = *(const f32x4*)(modl + 4 * D + e); pf2 = *(const f32x4*)(modl + 3 * D + e); }
        if (MODE == 2) { pf1 = *(const f32x4*)(modn + 1 * D + e); pf2 = *(const f32x4*)(modn + 0 * D + e); }
    };
    if (nq > 0) { modload(0); const int m = rowof(0); row_load<XF32, HAS_F>(F, A, src(m), XB + (size_t)m * D, Fb + (size_t)m * D, FS + (size_t)m * 32); }
    for (int q = 0; q < nq; q += 2) {
#pragma unroll
        for (int half = 0; half < 2; ++half) {
            const int qc = q + half, mc = rowof(qc);
            RowIn& cur = half ? B : A; RowIn& nxt = half ? A : B;
            if (qc + 1 < nq) { const int mn = rowof(qc + 1); row_load<XF32, HAS_F>(F, nxt, src(mn), XB + (size_t)mn * D, Fb + (size_t)mn * D, FS + (size_t)mn * 32); }
            if (half == 0 && (qc & 3) == 0) {
                const int e = F.tid * 4;
                __syncthreads();
                if (MODE >= 1) *(LAS f32x4*)(pv + e) = pf0;
                if (MODE <= 2) { *(LAS f32x4*)(pv + 3 * 2048 + e) = pf1; *(LAS f32x4*)(pv + 4 * 2048 + e) = pf2; }
                if (qc + 4 < nq) modload((qc >> 2) + 1);
                __syncthreads();
            }
            row_apply<XF32, HAS_F, HAS_H, MODE == 3>(F, cur, X + (size_t)mc * D, XB + (size_t)mc * D, pv, H + (size_t)mc * D, gs);
        }
    }
}
typedef float f32x2 __attribute__((ext_vector_type(2)));
__device__ __forceinline__ f32x2 sigm2(f32x2 x) { const f32x2 t = x * -1.4426950408889634f; const f32x2 e = (f32x2){__builtin_amdgcn_exp2f(t.x), __builtin_amdgcn_exp2f(t.y)} + 1.f; return (f32x2){__builtin_amdgcn_rcpf(e.x), __builtin_amdgcn_rcpf(e.y)}; }
__device__ __forceinline__ f32x2 gelu2(f32x2 x) { const f32x2 t = x * ((x * x) * -0.10294324f + -2.3022082f);
    const f32x2 e = (f32x2){__builtin_amdgcn_exp2f(t.x), __builtin_amdgcn_exp2f(t.y)} + 1.f; return x * (f32x2){__builtin_amdgcn_rcpf(e.x), __builtin_amdgcn_rcpf(e.y)}; }
__device__ __forceinline__ f32x4 gelu4(const f32x4& v) { const f32x2 a = gelu2((f32x2){v[0], v[1]}), b = gelu2((f32x2){v[2], v[3]}); return (f32x4){a.x, a.y, b.x, b.y}; }
__device__ __forceinline__ f32x4 sigm4(const f32x4& v) { const f32x2 a = sigm2((f32x2){v[0], v[1]}), b = sigm2((f32x2){v[2], v[3]}); return (f32x4){a.x, a.y, b.x, b.y}; }
__device__ __forceinline__ int kv_row(int m) { return m < MP ? m : MP + ((m - MP) >> 11) * 2304 + ((m - MP) & 2047); }
#ifndef Z_NT
#define Z_NT 0
#endif
#if Z_NT
#define ZSTORE(v, p) __builtin_nontemporal_store((v), (p))
#else
#define ZSTORE(v, p) (*(p) = (v))
#endif
struct EpiIn {
    static constexpr bool PERM = true, AFTER_DRAIN = false;
    __device__ __forceinline__ static bool keep(const Unit&) { return false; }
    bf16_t* Z; bf16_t* VALL; float* new_v; float* cvstat; int layer;
    __device__ __forceinline__ void operator()(const f32x4 (&acc)[2][2][4][2], const Unit& u, int wr, int wc, int fr, int fq) const {
        const int pn = u.pn, row0 = u.pm * 256 + wr * 64 + fr, cl = wc * 32 + 8 * fq;
        if (pn >= 10 && pn < 12) {
            const int colv = (pn - 10) * 256 + cl;
#pragma unroll
            for (int ai = 0; ai < 2; ++ai)
#pragma unroll
                for (int m = 0; m < 4; ++m) { const int row = row0 + ai * 128 + m * 16; bf16_t* dst = VALL + (size_t)kv_row(row) * 512 + colv;
#pragma unroll
                    for (int bj = 0; bj < 2; ++bj) { *(u32x4*)(dst + bj * 128) = pack8(acc[ai][bj][m][0], acc[ai][bj][m][1]);
                        if (row < MP) { float* nv = new_v + ((size_t)((row >> 8) * DEPTH + layer) * 256 + (row & 255)) * 512 + colv + bj * 128; *(f32x4*)nv = acc[ai][bj][m][0]; *(f32x4*)(nv + 4) = acc[ai][bj][m][1]; } } }
            return;
        }
        const int mode = (pn < 36) ? 0 : (pn < 44) ? 2 : 3;
        const int col0 = pn * 256 + cl;
#pragma unroll
        for (int ai = 0; ai < 2; ++ai)
#pragma unroll
            for (int m = 0; m < 4; ++m) { const int row = row0 + ai * 128 + m * 16; bf16_t* dst = Z + (size_t)row * INW + col0; float ss = 0.f;
#pragma unroll
                for (int bj = 0; bj < 2; ++bj) { f32x4 v0 = acc[ai][bj][m][0], v1 = acc[ai][bj][m][1];
                    if (mode == 1 || mode == 2) { v0 = gelu4(v0); v1 = gelu4(v1); }
                    if (mode == 2) ss += (v0[0] * v0[0] + v0[1] * v0[1]) + (v0[2] * v0[2] + v0[3] * v0[3]) + (v1[0] * v1[0] + v1[1] * v1[1]) + (v1[2] * v1[2] + v1[3] * v1[3]);
                    ZSTORE(pack8(v0, v1), (u32x4*)(dst + bj * 128)); }
                if (mode == 2) { ss += __shfl_xor(ss, 16); ss += __shfl_xor(ss, 32); if (fq == 0) cvstat[(size_t)row * 32 + (pn - 36) * 4 + wc] = ss; } }
    }
};
struct EpiRelu2 {
    static constexpr bool PERM = true, AFTER_DRAIN = false;
    __device__ __forceinline__ static bool keep(const Unit&) { return false; }
    bf16_t* O; int ldc;
    __device__ __forceinline__ void operator()(const f32x4 (&acc)[2][2][4][2], const Unit& u, int wr, int wc, int fr, int fq) const {
        const int row0 = u.pm * 256 + wr * 64 + fr, col0 = u.pn * 256 + wc * 32 + 8 * fq;
#pragma unroll
        for (int ai = 0; ai < 2; ++ai)
#pragma unroll
            for (int m = 0; m < 4; ++m) { bf16_t* dst = O + (size_t)(row0 + ai * 128 + m * 16) * ldc + col0;
#pragma unroll
                for (int bj = 0; bj < 2; ++bj) { f32x4 v0 = __builtin_elementwise_max(acc[ai][bj][m][0], (f32x4){0.f, 0.f, 0.f, 0.f}), v1 = __builtin_elementwise_max(acc[ai][bj][m][1], (f32x4){0.f, 0.f, 0.f, 0.f});
                    *(u32x4*)(dst + bj * 128) = pack8(v0 * v0, v1 * v1); } }
    }
};
struct EpiF {
    static constexpr bool PERM = true, AFTER_DRAIN = false;
    __device__ __forceinline__ static bool keep(const Unit&) { return false; }
    bf16_t* O; float* stat;
    __device__ __forceinline__ void operator()(const f32x4 (&acc)[2][2][4][2], const Unit& u, int wr, int wc, int fr, int fq) const {
        const int row0 = u.pm * 256 + wr * 64 + fr, col0 = u.pn * 256 + wc * 32 + 8 * fq;
#pragma unroll
        for (int ai = 0; ai < 2; ++ai)
#pragma unroll
            for (int m = 0; m < 4; ++m) { const int row = row0 + ai * 128 + m * 16; bf16_t* dst = O + (size_t)row * D + col0; float ss = 0.f;
#pragma unroll
                for (int bj = 0; bj < 2; ++bj) { const f32x4 v0 = acc[ai][bj][m][0], v1 = acc[ai][bj][m][1];
                    ss += (v0[0] * v0[0] + v0[1] * v0[1]) + (v0[2] * v0[2] + v0[3] * v0[3]) + (v1[0] * v1[0] + v1[1] * v1[1]) + (v1[2] * v1[2] + v1[3] * v1[3]);
                    *(u32x4*)(dst + bj * 128) = pack8(v0, v1); }
                ss += __shfl_xor(ss, 16); ss += __shfl_xor(ss, 32); if (fq == 0) stat[(size_t)row * 32 + u.pn * 4 + wc] = ss; }
    }
};
__device__ __forceinline__ f32x4 negexp4(const u32x2& w) {
    const f32x4 x = {bflo(w.x), bfhi(w.x), bflo(w.y), bfhi(w.y)};
    f32x4 r;
#pragma unroll
    for (int i = 0; i < 4; ++i) r[i] = __builtin_amdgcn_exp2f(__builtin_amdgcn_fmed3f(x[i], -30.f, 30.f) * -1.4426950408889634f) + 1.f;
    return r;
}
__device__ __forceinline__ f32x4 rcp4(const f32x4& v) { return (f32x4){__builtin_amdgcn_rcpf(v[0]), __builtin_amdgcn_rcpf(v[1]), __builtin_amdgcn_rcpf(v[2]), __builtin_amdgcn_rcpf(v[3])}; }
struct EpiMerge {
    static constexpr bool PERM = true, AFTER_DRAIN = false;
    const bf16_t* Z; bf16_t* O;
    __device__ __forceinline__ static bool keep(const Unit& u) { return (u.pn >> 3) < 2; }
    __device__ __forceinline__ void operator()(f32x4 (&acc)[2][2][4][2], const Unit& u, int wr, int wc, int fr, int fq) const {
        const int br = u.pn >> 3, pn = u.pn & 7, pm = u.pm - 96 * br;
        const int rl0 = wr * 64 + fr, cl = wc * 32 + 8 * fq;
        const char* zb = (const char*)(Z + (size_t)(pm * 256) * INW + OFF_G + br * D + pn * 256);
        char* ob = (char*)(O + (size_t)(pm * 256) * D + pn * 256);
        unsigned lz = (unsigned)(rl0 * INW + cl) * 2u, lo = (unsigned)(rl0 * D + cl) * 2u;
        asm volatile("" : "+v"(lz), "+v"(lo));
        const bool last = br == 2;
        u32x4 ga[2][2], gb[2][2];
#pragma unroll
        for (int mm = 0; mm < 2; ++mm)
#pragma unroll
            for (int bj = 0; bj < 2; ++bj) { ga[mm][bj] = *(const u32x4*)(zb + (size_t)((mm * 16) * INW + bj * 128) * 2 + lz); gb[mm][bj] = ga[mm][bj];
                if (!last) gb[mm][bj] = *(const u32x4*)(zb + (size_t)((mm * 16) * INW + bj * 128 + D) * 2 + lz); }
#pragma unroll
        for (int st = 0; st < 4; ++st) {
            const int ai = st >> 1, mh = st & 1;
            u32x4 na[2][2], nb[2][2];
            if (st < 3) {
#pragma unroll
                for (int mm = 0; mm < 2; ++mm)
#pragma unroll
                    for (int bj = 0; bj < 2; ++bj) { const int ro = ((st + 1) >> 1) * 128 + (((st + 1) & 1) * 2 + mm) * 16; na[mm][bj] = *(const u32x4*)(zb + (size_t)(ro * INW + bj * 128) * 2 + lz); nb[mm][bj] = na[mm][bj];
                        if (!last) nb[mm][bj] = *(const u32x4*)(zb + (size_t)(ro * INW + bj * 128 + D) * 2 + lz); }
            }
#pragma unroll
            for (int mm = 0; mm < 2; ++mm)
#pragma unroll
                for (int bj = 0; bj < 2; ++bj) { const int m = mh * 2 + mm, ro = ai * 128 + m * 16; const u32x4 a = ga[mm][bj], b2 = gb[mm][bj];
                    const f32x4 ia0 = rcp4(negexp4((u32x2){a.x, a.y})), ia1 = rcp4(negexp4((u32x2){a.z, a.w}));
                    if (last) *(u32x4*)(ob + (size_t)(ro * D + bj * 128) * 2 + lo) = pack8(acc[ai][bj][m][0] * ia0, acc[ai][bj][m][1] * ia1);
                    else { acc[ai][bj][m][0] *= ia0 * negexp4((u32x2){b2.x, b2.y}); acc[ai][bj][m][1] *= ia1 * negexp4((u32x2){b2.z, b2.w}); } }
            if (st < 3) {
#pragma unroll
                for (int mm = 0; mm < 2; ++mm)
#pragma unroll
                    for (int bj = 0; bj < 2; ++bj) { ga[mm][bj] = na[mm][bj]; gb[mm][bj] = nb[mm][bj]; }
            }
        }
    }
};
struct MergeOrder {
    pg8::StaticOrder so;
    __device__ void init(int G, int c, int wgm) { so.init(M, D, G, c, wgm); }
    __device__ bool next(int i, Unit& u) const { const int br = i % 3; if (!so.next(i / 3, u)) return false; u.pm += 96 * br; u.pn += 8 * br; return true; }
    __device__ __forceinline__ void a_ready(const Unit&) const {}
    __device__ __forceinline__ void done(const Unit&) const {}
};
}
namespace fk {
typedef short bf16x8 __attribute__((ext_vector_type(8)));
struct PrepIn { u32x2 wa[1], wb[1]; f32x4 cs, sn; };
__device__ __forceinline__ void prep_geo(int m, bool& sample, int& b, int& t) { sample = m >= MP; if (!sample) { b = m >> 8; t = m & 255; } else { b = (m - MP) >> 11; t = (m - MP) & 2047; } }
__device__ __forceinline__ void prep_load(const Frame& F, PrepIn& R, int m, const bf16_t* Zb, const float* rope) {
    bool sample; int b, t; prep_geo(m, sample, b, t);
    const int lane = F.lane, j = lane & 7, axis = (lane >> 3) & 1, hsel = lane >> 4, dA = axis * 64 + 4 * j;
    const bf16_t* zrow = Zb + (size_t)m * INW;
    { const int base = OFF_K + hsel * 128 + dA; R.wa[0] = *(const u32x2*)(zrow + base); R.wb[0] = *(const u32x2*)(zrow + base + 32); }
    const int pos = sample ? (axis == 0 ? (t >> 6) : (t & 63)) : 0;
    R.cs = *(const f32x4*)(rope + pos * 32 + 4 * j); R.sn = *(const f32x4*)(rope + 2048 + pos * 32 + 4 * j);
}
__device__ __forceinline__ void prep_apply(const Frame& F, const PrepIn& R, int m, int l, bf16_t* Zb, bf16_t* KALL, float* new_k, const f32x4& gqa, const f32x4& gqb, const f32x4& gka, const f32x4& gkb) {
    bool sample; int b, t; prep_geo(m, sample, b, t);
    const int kvrow = sample ? MP + b * 2304 + t : m;
    const int lane = F.lane, j = lane & 7, axis = (lane >> 3) & 1, hsel = lane >> 4, dA = axis * 64 + 4 * j;
    bf16_t* zrow = Zb + (size_t)m * INW;
    {
        const u32x2 wa = R.wa[0], wb = R.wb[0];
        const f32x4 xa = {bflo(wa.x), bfhi(wa.x), bflo(wa.y), bfhi(wa.y)}, xb = {bflo(wb.x), bfhi(wb.x), bflo(wb.y), bfhi(wb.y)};
        float ss = (xa.x * xa.x + xa.y * xa.y) + (xa.z * xa.z + xa.w * xa.w) + (xb.x * xb.x + xb.y * xb.y) + (xb.z * xb.z + xb.w * xb.w);
        ss += __shfl_xor(ss, 1); ss += __shfl_xor(ss, 2); ss += __shfl_xor(ss, 4); ss += __shfl_xor(ss, 8);
        const float rs = rsqrtf(ss * (1.f / 128.f) + EPS);
        const f32x4 na = xa * rs * gka, nb = xb * rs * gkb;
        const f32x4 ra = na * R.cs - nb * R.sn, rb = na * R.sn + nb * R.cs;
        u32x2 oa, ob; oa.x = cvt_pk_bf16(ra.x, ra.y); oa.y = cvt_pk_bf16(ra.z, ra.w); ob.x = cvt_pk_bf16(rb.x, rb.y); ob.y = cvt_pk_bf16(rb.z, rb.w);
        bf16_t* kd = KALL + (size_t)kvrow * 512 + hsel * 128 + dA; *(u32x2*)kd = oa; *(u32x2*)(kd + 32) = ob;
        if (!sample) { float* nk = new_k + ((size_t)(b * DEPTH + l) * 256 + t) * 512 + hsel * 128 + dA; *(f32x4*)nk = na; *(f32x4*)(nk + 32) = nb; }
    }
}
__device__ __forceinline__ void prep_phase(const Frame& F, int l) {
    {
        bf16_t* Zb = F.Z(); bf16_t* KALL = F.KALL(); float* new_k = F.new_k(); const float* rope = F.ROPE();
        const int j = F.lane & 7, axis = (F.lane >> 3) & 1, dA = axis * 64 + 4 * j, dB = dA + 32;
        const float* gq = inp<I_GQ>(F) + l * 128; const float* gk = inp<I_GK>(F) + l * 128;
        const f32x4 gqa = *(const f32x4*)(gq + dA), gqb = *(const f32x4*)(gq + dB), gka = *(const f32x4*)(gk + dA), gkb = *(const f32x4*)(gk + dB);
        constexpr int NB = 6;
        for (int m = F.gw; m < M; m += NB * F.NGW) {
            PrepIn R[NB];
#pragma unroll
            for (int i = 0; i < NB; ++i) { const int mi = m + i * F.NGW; if (mi < M) prep_load(F, R[i], mi, Zb, rope); }
#pragma unroll
            for (int i = 0; i < NB; ++i) { const int mi = m + i * F.NGW; if (mi < M) prep_apply(F, R[i], mi, l, Zb, KALL, new_k, gqa, gqb, gka, gkb); }
        }
    }
    for (int it = F.gw; it < 2 * 8 * 256; it += 2 * F.NGW) {
        f32x4 a[2], c[2];
#pragma unroll
        for (int i = 0; i < 2; ++i) { const int ii = it + i * F.NGW; if (ii < 2 * 8 * 256) { const int which = ii >> 11, b = (ii >> 8) & 7, p = ii & 255;
            const float* src = (which ? inp<I_CV>(F) : inp<I_CK>(F)) + ((size_t)(b * DEPTH + l) * 256 + p) * 512 + F.lane * 8; a[i] = *(const f32x4*)src; c[i] = *(const f32x4*)(src + 4); } }
#pragma unroll
        for (int i = 0; i < 2; ++i) { const int ii = it + i * F.NGW; if (ii < 2 * 8 * 256) { const int which = ii >> 11, b = (ii >> 8) & 7, p = ii & 255;
            bf16_t* dst = (which ? F.VALL() : F.KALL()) + (size_t)(MP + b * 2304 + 2048 + p) * 512 + F.lane * 8; *(u32x4*)dst = pack8(a[i], c[i]); } }
    }
}
__device__ __forceinline__ int crow(int r, int hi) { return (r & 3) + 8 * (r >> 2) + 4 * hi; }
struct LruCtx {
    bf16x8 bw0[8], bw1[8];
    float bav, bxv, c8;
    bool small;
};
__device__ __forceinline__ void lru_ctx_load(const Frame& F, int l, int blk, LruCtx& X) {
    const int lane = F.lane, wave = F.wave, d = wave >> 2, n0 = (wave & 3) * 32, nl = lane & 31, hi = lane >> 5, C = blk * 128 + n0 + nl;
    const bf16_t* wb0 = F.WLRU() + ((size_t)((d * 2 + 0) * 16 + blk) * 128 + n0 + nl) * 128 + hi * 8;
    const bf16_t* wb1 = F.WLRU() + ((size_t)((d * 2 + 1) * 16 + blk) * 128 + n0 + nl) * 128 + hi * 8;
#pragma unroll
    for (int ks = 0; ks < 8; ++ks) { X.bw0[ks] = *(const bf16x8*)(wb0 + ks * 16); X.bw1[ks] = *(const bf16x8*)(wb1 + ks * 16); }
    X.bav = inp<I_LBA>(F)[(size_t)(l * 2 + d) * D + C]; X.bxv = inp<I_LBX>(F)[(size_t)(l * 2 + d) * D + C];
    const float lam = inp<I_LAM>(F)[(size_t)(l * 2 + d) * D + C];
    const float ex = __expf(-lam);
    const float sp = lam < -20.f ? -lam : ex < 0.05f ? ex * (1.f + ex * (-0.5f + ex * ((1.f / 3.f) + ex * (-0.25f + ex * 0.2f)))) : __logf(1.f + ex);
    X.c8 = -8.f * sp;
    X.small = __all(X.c8 > -0.5f);
}
struct LruGeo { int m0, b, t0, T; bool sample; };
__device__ __forceinline__ LruGeo lru_geo(int ck) { LruGeo g; g.m0 = ck * 64; g.sample = g.m0 >= MP;
    if (!g.sample) { g.b = g.m0 >> 8; g.t0 = g.m0 & 255; g.T = 256; } else { g.b = (g.m0 - MP) >> 11; g.t0 = (g.m0 - MP) & 2047; g.T = 2048; } return g; }
__device__ __forceinline__ void lru_taps_store(const Frame& F, int l, int blk) {
    const float* cwl = inp<I_CW>(F) + (size_t)l * 4 * D; const float* cbl = inp<I_CB>(F) + (size_t)l * D;
    for (int i = F.tid; i < 5 * 128; i += NWAVES * 64) { const int j = i >> 7, c = i & 127; *(LAS float*)(F.lds + LRU_TAPS + i * 4) = j < 4 ? cwl[(size_t)j * D + blk * 128 + c] : cbl[blk * 128 + c]; }
}
__device__ __forceinline__ void lru_conv_load(const Frame& F, u32x2 (&PF)[11], int t2, int ck, int blk) {
    const LruGeo G = lru_geo(ck); const int C0 = blk * 128; const bf16_t* Zb = F.Z();
    const int c4 = (t2 & 31) * 4, r0 = (t2 >> 5) * 8;
#pragma unroll
    for (int i = 0; i < 11; ++i) {
        const int tt = G.t0 + r0 + i - 2; u32x2 z = {0u, 0u};
        if (tt >= 0 && tt < G.T) z = *(const u32x2*)(Zb + (size_t)(G.m0 + r0 + i - 2) * INW + OFF_LX + C0 + c4);
        PF[i] = z;
    }
}
__device__ __forceinline__ void lru_conv_math(const Frame& F, const u32x2 (&PF)[11], int t2, int xc_off) {
    LAS unsigned char* lds = F.lds + xc_off; const int c4 = (t2 & 31) * 4, r0 = (t2 >> 5) * 8;
    const LAS float* tp = (const LAS float*)(F.lds + LRU_TAPS) + c4;
    const f32x4 w0 = *(const LAS f32x4*)tp, w1 = *(const LAS f32x4*)(tp + 128), w2 = *(const LAS f32x4*)(tp + 256), w3 = *(const LAS f32x4*)(tp + 384), bb = *(const LAS f32x4*)(tp + 512);
    f32x4 zr[11];
#pragma unroll
    for (int i = 0; i < 11; ++i) { const unsigned zx = PF[i].x, zy = PF[i].y; zr[i] = (f32x4){bflo(zx), bfhi(zx), bflo(zy), bfhi(zy)}; }
#pragma unroll
    for (int r = 0; r < 8; ++r) {
        const f32x4 y = bb + zr[r] * w0 + zr[r + 1] * w1 + zr[r + 2] * w2 + zr[r + 3] * w3;
        u32x2 o; o.x = cvt_pk_bf16(y.x, y.y); o.y = cvt_pk_bf16(y.z, y.w);
        *(LAS u32x2*)(lds + LRU_XC + (r0 + r) * LRU_XC_PITCH + c4 * 2) = o;
    }
}
__device__ __forceinline__ void split_arrive(unsigned* cnt) {
    asm volatile("s_waitcnt vmcnt(0)" ::: "memory");
    __syncthreads();
    if (threadIdx.x == 0) { __builtin_amdgcn_fence(__ATOMIC_RELEASE, "agent"); asm volatile("s_waitcnt vmcnt(0)" ::: "memory"); (void)xb_add(cnt, 1u); }
}
__device__ __forceinline__ void split_wait(unsigned* cnt, unsigned G, unsigned* tmo) {
    if (threadIdx.x == 0) {
        unsigned sp = 0;
        while (xb_ld(cnt) < G) { __builtin_amdgcn_s_sleep(1); if ((++sp & 255u) == 0u) { if (xb_ld(tmo)) break; if (sp > XB_SPIN_CAP) { atomicAdd(tmo, 1u); break; } } }
        __builtin_amdgcn_fence(__ATOMIC_ACQUIRE, "agent"); asm volatile("s_waitcnt vmcnt(0)" ::: "memory");
    }
    __syncthreads();
}
__device__ __forceinline__ float lru_gates(const Frame& F, int lane, int wave, const LruCtx& X, int xc_off, float carry) {
    typedef float f32x2 __attribute__((ext_vector_type(2)));
    LAS unsigned char* lds = F.lds;
    const int d = wave >> 2, n0 = (wave & 3) * 32, nl = lane & 31, hi = lane >> 5, c = n0 + nl;
    LAS float* Hd = (LAS float*)(lds + (d ? LRU_H1 : LRU_H0));
    const float bav = X.bav, bxv = X.bxv, c8 = X.c8;
    const int tau = 16 * ((nl >> 2) & 1) + 4 * (nl >> 3) + (nl & 3);
    const bool first = d == 0 ? hi == 0 : hi == 1;
    float cin_tile = carry;
#pragma unroll
    for (int step = 0; step < 2; ++step) {
        const int mt = d ? 1 - step : step;
        f32x16 acc0, acc1;
#pragma unroll
        for (int r = 0; r < 16; ++r) { acc0[r] = 0.f; acc1[r] = 0.f; }
        const LAS unsigned char* ap = lds + xc_off + (mt * 32 + tau) * LRU_XC_PITCH + hi * 16;
#pragma unroll
        for (int ks = 0; ks < 8; ++ks) {
            const bf16x8 a0 = *(const LAS bf16x8*)(ap + ks * 32);
            acc0 = __builtin_amdgcn_mfma_f32_32x32x16_bf16(a0, X.bw0[ks], acc0, 0, 0, 0);
            acc1 = __builtin_amdgcn_mfma_f32_32x32x16_bf16(a0, X.bw1[ks], acc1, 0, 0, 0);
        }
        float av[16], bv[16];
        const LAS unsigned char* xcp = lds + xc_off + (mt * 32 + 16 * hi) * LRU_XC_PITCH + c * 2;
        if (X.small) {
#pragma unroll
            for (int r = 0; r < 16; r += 2) {
                const f32x2 pa = (f32x2){acc0[r], acc0[r + 1]} + bav, px = (f32x2){acc1[r], acc1[r + 1]} + bxv;
                const f32x2 ta = pa * -1.4426950408889634f, tx = px * -1.4426950408889634f;
                const f32x2 ea = (f32x2){__builtin_amdgcn_exp2f(ta.x), __builtin_amdgcn_exp2f(ta.y)} + 1.f, ex = (f32x2){__builtin_amdgcn_exp2f(tx.x), __builtin_amdgcn_exp2f(tx.y)} + 1.f;
                const f32x2 rg = {__builtin_amdgcn_rcpf(ea.x), __builtin_amdgcn_rcpf(ea.y)};
                const f32x2 la = rg * c8;
                f32x2 p = la * (1.f / 720.f) + (1.f / 120.f); p = p * la + (1.f / 24.f); p = p * la + (1.f / 6.f); p = p * la + 0.5f; p = p * la + 1.f;
                const f32x2 e1 = la * p;
                const f32x2 omr = (e1 + 2.f) * e1;
                const f32x2 w = {fmaxf(-omr.x, 1e-30f), fmaxf(-omr.y, 1e-30f)};
                const f32x2 wq = w * ex * ex;
                const f32x2 sg = w * (f32x2){__builtin_amdgcn_rsqf(wq.x), __builtin_amdgcn_rsqf(wq.y)};
                const f32x2 xcv = {bf2f(*(const LAS unsigned short*)(xcp + r * LRU_XC_PITCH)), bf2f(*(const LAS unsigned short*)(xcp + (r + 1) * LRU_XC_PITCH))};
                const f32x2 a2 = e1 + 1.f, b2 = sg * xcv;
                av[r] = a2.x; av[r + 1] = a2.y; bv[r] = b2.x; bv[r + 1] = b2.y;
            }
        } else {
#pragma unroll
            for (int r = 0; r < 16; ++r) {
                const float rg = fsigm(acc0[r] + bav), ig = fsigm(acc1[r] + bxv);
                const float la = c8 * rg;
                av[r] = __expf(la);
                bv[r] = sqrtf(fmaxf(-expm1f(2.f * la), 0.f)) * ig * bf2f(*(const LAS unsigned short*)(xcp + r * LRU_XC_PITCH));
            }
        }
        float h = 0.f, Pp = 1.f;
        if (d == 0) {
#pragma unroll
            for (int r = 0; r < 16; ++r) { h = av[r] * h + bv[r]; Pp *= av[r]; bv[r] = h; av[r] = Pp; }
        } else {
#pragma unroll
            for (int r = 15; r >= 0; --r) { h = av[r] * h + bv[r]; Pp *= av[r]; bv[r] = h; av[r] = Pp; }
        }
        const float Po = __shfl_xor(Pp, 32), Eo = __shfl_xor(h, 32);
        const float P1 = first ? Pp : Po, E1 = first ? h : Eo, P2 = first ? Po : Pp, E2 = first ? Eo : h;
        const float cin = first ? cin_tile : P1 * cin_tile + E1;
        LAS float* hp = Hd + (mt * 32 + 16 * hi) * LRU_HP + c;
#pragma unroll
        for (int r = 0; r < 16; ++r) hp[r * LRU_HP] = bv[r] + av[r] * cin;
        cin_tile = P2 * (P1 * cin_tile + E1) + E2;
    }
    return cin_tile;
}
__device__ __forceinline__ void lru_out_lite(const Frame& F, int t2, int hsel, int ck, int blk) {
    const int row = t2 >> 2, c32 = (t2 & 3) * 32;
    const LAS float* h = (const LAS float*)(F.lds + (hsel ? LRU_H1 : LRU_H0)) + row * LRU_HP + c32;
    bf16_t* yp = F.BR() + (size_t)1 * M * D + (size_t)(ck * 64 + row) * D + blk * 128 + c32;
#pragma unroll
    for (int i = 0; i < 4; ++i) { const f32x4 a = *(const LAS f32x4*)(h + i * 8), b2 = *(const LAS f32x4*)(h + i * 8 + 4); *(u32x4*)(yp + i * 8) = pack8(a, b2); }
}
__device__ __forceinline__ void lru_out_full(const Frame& F, int t2, int hsel, int ck, int blk, const u32x4 (&gz)[4], const u32x4 (&pp)[4]) {
    const int row = t2 >> 2, c32 = (t2 & 3) * 32;
    const LAS float* h = (const LAS float*)(F.lds + (hsel ? LRU_H1 : LRU_H0)) + row * LRU_HP + c32;
    bf16_t* yp = F.BR() + (size_t)1 * M * D + (size_t)(ck * 64 + row) * D + blk * 128 + c32;
#pragma unroll
    for (int i = 0; i < 4; ++i) {
        const f32x4 a = *(const LAS f32x4*)(h + i * 8), b2 = *(const LAS f32x4*)(h + i * 8 + 4);
        const f32x4 g0 = gelu4((f32x4){bflo(gz[i].x), bfhi(gz[i].x), bflo(gz[i].y), bfhi(gz[i].y)}), g1 = gelu4((f32x4){bflo(gz[i].z), bfhi(gz[i].z), bflo(gz[i].w), bfhi(gz[i].w)});
        const f32x4 p0 = {bflo(pp[i].x), bfhi(pp[i].x), bflo(pp[i].y), bfhi(pp[i].y)}, p1 = {bflo(pp[i].z), bfhi(pp[i].z), bflo(pp[i].w), bfhi(pp[i].w)};
        *(u32x4*)(yp + i * 8) = pack8((a + p0) * g0, (b2 + p1) * g1);
    }
}
__device__ __forceinline__ void lru_chain(const Frame& F, int l, const LruCtx& X, int ck0, int N, bool sample, int b, int blk) {
    int tid0 = F.tid; asm volatile("" : "+v"(tid0));
    const int g0 = __builtin_amdgcn_readfirstlane(tid0 >> 8), C0 = blk * 128 + ((tid0 >> 6) & 3) * 32 + (tid0 & 31);
    float carry = 0.f;
    if (sample) carry = inp<I_SL>(F)[((size_t)(b * DEPTH + l) * 2 + g0) * D + C0];
    u32x2 PF[11];
    { u32x2 P0[11]; lru_conv_load(F, P0, tid0 & 255, ck0 + (g0 ? N - 1 : 0), blk); lru_conv_math(F, P0, tid0 & 255, g0 ? LRU_XCB : 0); }
    lru_conv_load(F, PF, tid0 & 255, ck0 + (g0 ? N - 2 : 1), blk);
    __syncthreads();
    for (int s = 0, par = 0; s < N; ++s, par ^= 1) {
        int tid_ = F.tid; asm volatile("" : "+v"(tid_));
        const int tid = tid_, lane = tid & 63, wave = __builtin_amdgcn_readfirstlane(tid >> 6), g = wave >> 2, t2 = tid & 255;
        const int xb = g ? LRU_XCB : 0;
        const int cj = g ? N - 1 - s : s, co = g ? s : N - 1 - s;
        const bool full = s >= (N >> 1);
        u32x4 gz[4] = {{0u, 0u, 0u, 0u}, {0u, 0u, 0u, 0u}, {0u, 0u, 0u, 0u}, {0u, 0u, 0u, 0u}}, pp[4] = {{0u, 0u, 0u, 0u}, {0u, 0u, 0u, 0u}, {0u, 0u, 0u, 0u}, {0u, 0u, 0u, 0u}};
        if (full) {
            const size_t mrow = (size_t)((ck0 + cj) * 64 + (t2 >> 2)); const int cc = blk * 128 + (t2 & 3) * 32;
            const bf16_t* gp = F.Z() + mrow * INW + OFF_LG + cc; const bf16_t* pq = F.BR() + (size_t)1 * M * D + mrow * D + cc;
#pragma unroll
            for (int i = 0; i < 4; ++i) { gz[i] = *(const u32x4*)(gp + i * 8); pp[i] = *(const u32x4*)(pq + i * 8); }
        }
        if (s + 1 < N) lru_conv_math(F, PF, t2, xb + (par ^ 1) * LRU_XCSZ);
        if (s + 2 < N) lru_conv_load(F, PF, t2, ck0 + (g ? N - 3 - s : s + 2), blk);
        carry = lru_gates(F, lane, wave, X, xb + par * LRU_XCSZ, carry);
        __syncthreads();
        if (full) lru_out_full(F, t2, g, ck0 + cj, blk, gz, pp); else lru_out_lite(F, t2, 1 - g, ck0 + co, blk);
        __syncthreads();
    }
    if (!sample && (tid0 & 32) == 0) F.new_s()[((size_t)(b * DEPTH + l) * 2 + g0) * D + C0] = carry;
}
#ifndef LRU_CM_N1
#define LRU_CM_N1 3
#endif
__device__ __forceinline__ void lru_chain_phase(const Frame& F, int l) {
    LruCtx X; int cur = -1;
    const bool fast = F.G == 256; const int grp = F.bx >> 4;
    for (int k = 0; ; ++k) {
        int id;
        if (fast) { if (k >= (grp < 8 ? 1 : 4)) break; id = grp < 8 ? F.bx : 128 + ((grp - 8) * 4 + k) * 16 + (F.bx & 15); }
        else { id = F.bx + k * F.G; if (id >= 640) break; }
        const int blk = id & 15; const bool sample = id < 128; const int b = sample ? id >> 4 : (id - 128) >> 4;
        if (blk != cur) { lru_ctx_load(F, l, blk, X); lru_taps_store(F, l, blk); cur = blk; __syncthreads(); }
        lru_chain(F, l, X, sample ? 128 + b * 32 : b * 4, sample ? 32 : 4, sample, b, blk);
    }
}
constexpr int CM_V = 0, CM_OUT = 32768, CM_OUT_PITCH = 528, CM_RS2 = CM_OUT + 128 * CM_OUT_PITCH;
static_assert(CM_RS2 + 512 <= MISC_OFF, "cm lds map");
struct CmCtx { bf16x8 wa[8]; f32x4 ga, gb; };
__device__ __forceinline__ void cm_ctx_load(const Frame& F, int g, CmCtx& X, const float* __restrict__ cmg) {
    const int qt = F.wave & 3, xl = F.lane & 31, hi = F.lane >> 5;
    const bf16_t* wp = F.CMW() + ((size_t)g * 128 + qt * 32 + xl) * 128 + hi * 8;
#pragma unroll
    for (int i = 0; i < 8; ++i) X.wa[i] = *(const bf16x8*)(wp + i * 16);
    const int sc = (F.tid & 15) * 8;
    X.ga = *(const f32x4*)(cmg + g * 128 + sc); X.gb = *(const f32x4*)(cmg + g * 128 + sc + 4);
}
struct CmPre { u32x4 v[4]; float2 st[4]; };
__device__ __forceinline__ void cm_prefetch(const Frame& F, CmPre& R, int tid, int cn, int g) {
    const int sr = tid >> 4, q16 = tid & 15, sc = q16 * 8, m0 = cn * 128;
    const bf16_t* Zb = F.Z(); const float* ST = F.CVSTAT();
#pragma unroll
    for (int i = 0; i < 4; ++i) { const int p = (i >> 1) * 64 + (i & 1) * 32 + sr;
        R.v[i] = *(const u32x4*)(Zb + (size_t)(m0 + p) * INW + OFF_CV + g * 128 + sc);
        R.st[i] = *(const float2*)(ST + (size_t)(m0 + p) * 32 + q16 * 2); }
}
__device__ __forceinline__ void cm_stage(const Frame& F, const CmPre& R, const CmCtx& X, int tid) {
    LAS unsigned char* lds = F.lds; const int sr = tid >> 4, sc = (tid & 15) * 8;
#pragma unroll
    for (int i = 0; i < 4; ++i) {
        float s = R.st[i].x + R.st[i].y;
        s += __shfl_xor(s, 1); s += __shfl_xor(s, 2); s += __shfl_xor(s, 4); s += __shfl_xor(s, 8);
        const float rs = rsqrtf(s * (1.f / D) + EPS);
        const u32x4 w = R.v[i];
        const f32x4 v0 = (f32x4){bflo(w.x), bfhi(w.x), bflo(w.y), bfhi(w.y)} * X.ga * rs, v1 = (f32x4){bflo(w.z), bfhi(w.z), bflo(w.w), bfhi(w.w)} * X.gb * rs;
        *(LAS u32x4*)(lds + CM_V + (i >> 1) * 16384 + att::v_st((i & 1) * 32 + sr, sc)) = pack8(v0, v1);
    }
}
__device__ __forceinline__ void cm_mfma(const Frame& F, const CmCtx& X, int lane, int wave) {
    LAS unsigned char* lds = F.lds;
    const int qt = wave & 3, chh = wave >> 2, xl = lane & 31, hi = lane >> 5;
    f32x16 o0, o1;
#pragma unroll
    for (int r = 0; r < 16; ++r) { o0[r] = 0.f; o1[r] = 0.f; }
    const int vb = (int)(unsigned)(uintptr_t)(lds + CM_V) + att::v_rd_base(lane);
    if (chh == 0) {
        att::pv_one<0>(o0, vb, X.wa[0], X.wa[1], X.wa[2], X.wa[3]); att::pv_one<1>(o1, vb, X.wa[0], X.wa[1], X.wa[2], X.wa[3]);
        att::pv_one<0>(o0, vb + 16384, X.wa[4], X.wa[5], X.wa[6], X.wa[7]); att::pv_one<1>(o1, vb + 16384, X.wa[4], X.wa[5], X.wa[6], X.wa[7]);
    } else {
        att::pv_one<2>(o0, vb, X.wa[0], X.wa[1], X.wa[2], X.wa[3]); att::pv_one<3>(o1, vb, X.wa[0], X.wa[1], X.wa[2], X.wa[3]);
        att::pv_one<2>(o0, vb + 16384, X.wa[4], X.wa[5], X.wa[6], X.wa[7]); att::pv_one<3>(o1, vb + 16384, X.wa[4], X.wa[5], X.wa[6], X.wa[7]);
    }
#pragma unroll
    for (int r = 0; r < 16; ++r) { const int q = qt * 32 + crow(r, hi);
        *(LAS float*)(lds + CM_OUT + q * CM_OUT_PITCH + (chh * 64 + xl) * 4) = o0[r];
        *(LAS float*)(lds + CM_OUT + q * CM_OUT_PITCH + (chh * 64 + 32 + xl) * 4) = o1[r]; }
}
__device__ __forceinline__ void cm_epilogue(const Frame& F, int tid, int cn, int g, const float* __restrict__ bsg, const u32x4 (&uw)[4]) {
    LAS unsigned char* lds = F.lds; const int q = tid >> 2, c32 = (tid & 3) * 32, m0 = cn * 128; const float bias = bsg[q];
    bf16_t* op = F.BR() + (size_t)2 * M * D + (size_t)(m0 + q) * D + g * 128 + c32;
#pragma unroll
    for (int i = 0; i < 4; ++i) {
        const f32x4 a = *(const LAS f32x4*)(lds + CM_OUT + q * CM_OUT_PITCH + (c32 + i * 8) * 4), b2 = *(const LAS f32x4*)(lds + CM_OUT + q * CM_OUT_PITCH + (c32 + i * 8 + 4) * 4);
        const f32x4 u0 = gelu4((f32x4){bflo(uw[i].x), bfhi(uw[i].x), bflo(uw[i].y), bfhi(uw[i].y)}), u1 = gelu4((f32x4){bflo(uw[i].z), bfhi(uw[i].z), bflo(uw[i].w), bfhi(uw[i].w)});
        *(u32x4*)(op + i * 8) = pack8(u0 * (a + bias), u1 * (b2 + bias));
    }
}
__device__ __forceinline__ bool cm_unit(const Frame& F, int i, int& cn, int& g) {
    if (F.G == 256) {
        const int grp = F.bx >> 4; g = F.bx & 15;
        if (grp < 8) { cn = grp + 8 * i; return i < LRU_CM_N1; }
        cn = 8 * LRU_CM_N1 + (grp - 8) + 8 * i; return i < 24 - LRU_CM_N1;
    }
    const int u = F.bx + i * F.G; cn = u >> 4; g = u & 15; return u < 192 * 16;
}
__device__ __forceinline__ void cm_phase(const Frame& F, int l) {
    CmCtx X; int cur = -1;
    const float* cmg = inp<I_CMG>(F) + (size_t)l * D; const float* bs = inp<I_CMBS>(F) + (size_t)l * 16 * 128;
    int cn, g;
    bool have = cm_unit(F, 0, cn, g);
    if (have) { cm_ctx_load(F, g, X, cmg); cur = g; CmPre R; cm_prefetch(F, R, F.tid, cn, g); cm_stage(F, R, X, F.tid); }
    __syncthreads();
    for (int i = 0; have; ++i) {
        int tid_ = F.tid; asm volatile("" : "+v"(tid_));
        const int tid = tid_, lane = tid & 63, wave = __builtin_amdgcn_readfirstlane(tid >> 6);
        int cnn, gn; const bool nxt = cm_unit(F, i + 1, cnn, gn);
        CmPre R;
        if (nxt) cm_prefetch(F, R, tid, cnn, gn);
        u32x4 uw[4];
        { const bf16_t* up = F.Z() + (size_t)(cn * 128 + (tid >> 2)) * INW + OFF_CU + g * 128 + (tid & 3) * 32;
#pragma unroll
          for (int i2 = 0; i2 < 4; ++i2) uw[i2] = *(const u32x4*)(up + i2 * 8); }
        cm_mfma(F, X, lane, wave);
        __syncthreads();
        cm_epilogue(F, tid, cn, g, bs + g * 128, uw);
        if (nxt) { if (gn != cur) { cm_ctx_load(F, gn, X, cmg); cur = gn; } cm_stage(F, R, X, tid); }
        __syncthreads();
        have = nxt; cn = cnn; g = gn;
    }
}
__device__ __forceinline__ void attn_phase(const Frame& F, int l) {
    char* lds = (char*)F.lds;
    const float* gq = inp<I_GQ>(F) + l * 128; const float* rope = F.ROPE();
    const att::bf16* Z = (const att::bf16*)F.Z(); const att::bf16* K = (const att::bf16*)F.KALL(); const att::bf16* V = (const att::bf16*)F.VALL(); att::bf16* O = (att::bf16*)F.BR();
    for (int id = F.vcu; id < 1536; id += F.G) {
        size_t qrow, kvrow; int h, nkeys, t0;
        if (id < 1024) { const int qb = id & 7, b = id >> 7; h = (id >> 3) & 15; qrow = (size_t)MP + (size_t)b * 2048 + qb * 256; kvrow = (size_t)MP + (size_t)b * 2304; nkeys = 2304; t0 = qb * 256; }
        else { const int id2 = id - 1024, b = id2 >> 4; h = id2 & 15; qrow = (size_t)b * 256; kvrow = qrow; nkeys = 256; t0 = 0; }
        att::attn_dense_body<att::bf16>(Z + qrow * INW + OFF_Q + h * 128, K + kvrow * 512 + (h >> 2) * 128, V + kvrow * 512 + (h >> 2) * 128, O + qrow * D + h * 128, nkeys, lds, gq, id < 1024 ? rope : (const float*)nullptr, t0);
    }
    __syncthreads();
}
}
#ifndef REP_G
#define REP_G 1
#endif
#ifndef REP_A
#define REP_A 1
#endif
#ifndef REP_L
#define REP_L 1
#endif
#ifndef REP_V
#define REP_V 1
#endif
#ifndef REP_R
#define REP_R 1
#endif
#ifndef REP_GSEL
#define REP_GSEL 0
#endif
#ifndef REP_B
#define REP_B 1
#endif
#ifndef PG_ALIGN
#define PG_ALIGN true
#endif
#ifndef PG_SP2
#define PG_SP2 true
#endif
#ifndef WGM_IN
#define WGM_IN 4
#endif
#ifndef WGM_N8
#define WGM_N8 4
#endif
#ifndef WGM_F1
#define WGM_F1 4
#endif
#ifndef WGM_F2
#define WGM_F2 4
#endif
#ifndef WGM_MG
#define WGM_MG 4
#endif
#ifndef STAMP_SEL
#define STAMP_SEL 0
#endif
#ifndef STAMP_Q
#define STAMP_Q 20000
#endif
#ifndef REP_C
#define REP_C 1
#endif
namespace fk {
#if REP_G > 1 || REP_GSEL > 0
template <class Base> struct RepOrder {
    Base b; int n;
    __device__ void init_n() { Unit u; n = 0; while (b.next(n, u)) ++n; }
    __device__ bool next(int i, Unit& u) const { if (i >= 2 * n) return false; return b.next(i >= n ? i - n : i, u); }
    __device__ __forceinline__ void a_ready(const Unit&) const {}
    __device__ __forceinline__ void done(const Unit&) const {}
};
#define GEMM_REP(EPI, ORD, g, S, E) do { RepOrder<ORD> RS_; RS_.b = S; RS_.init_n(); pg8::gemm_phase<EPI, RepOrder<ORD>, PG_ALIGN, PG_SP2>(P.lds, g, RS_, E); } while (0)
#endif
#define GEMM_ONE(EPI, ORD, g, S, E) pg8::gemm_phase<EPI, ORD, PG_ALIGN, PG_SP2>(P.lds, g, S, E)
#if REP_G > 1
#define GEMM_CALL(ID, EPI, ORD, g, S, E) GEMM_REP(EPI, ORD, g, S, E)
#elif REP_GSEL > 0
#define GEMM_CALL(ID, EPI, ORD, g, S, E) do { if (ID == REP_GSEL) GEMM_REP(EPI, ORD, g, S, E); else GEMM_ONE(EPI, ORD, g, S, E); } while (0)
#else
#define GEMM_CALL(ID, EPI, ORD, g, S, E) GEMM_ONE(EPI, ORD, g, S, E)
#endif
__global__ void __launch_bounds__(NWAVES * 64, 2) mega(Params p) {
    extern __shared__ __attribute__((aligned(16))) unsigned char lds_raw[];
    Frame F;
    F.lds = (LAS unsigned char*)lds_raw;
    F.tid = threadIdx.x; F.lane = F.tid & 63; F.wave = __builtin_amdgcn_readfirstlane(F.tid >> 6);
    F.G = gridDim.x; { const int bx = blockIdx.x; F.vcu = (F.G % 8 == 0) ? (bx % 8) * (F.G / 8) + bx / 8 : bx; }
    F.gw = F.vcu * NWAVES + F.wave; F.NGW = F.G * NWAVES; F.bx = blockIdx.x;
    F.out = p.out; F.ws = p.ws; F.ka = (kaptr_t)__builtin_amdgcn_kernarg_segment_ptr();
    unsigned char* ws = p.ws;
    volatile LAS unsigned* MISC = (volatile LAS unsigned*)(F.lds + MISC_OFF);
    for (int u = F.tid; u < (LDS_BYTES - MISC_OFF) / 4; u += NWAVES * 64) ((LAS unsigned*)(F.lds + MISC_OFF))[u] = 0u;
    __syncthreads();
    unsigned* barw = (unsigned*)(ws + WS_CTL) + CW_BAR + p.li * XCD_BAR_WORDS;
    XcdBarrier bar = xcd_barrier_post(barw, MISC + 8);
    const int lo = p.ph_lo, hi = p.ph_hi;
    unsigned long long bar_ticks = 0;
#define IN_PH(k) (lo <= (k) && (k) < hi)
#if REP_B > 1
#define SEAM(k) do { if ((k) + 1 < hi) { xcd_barrier(bar); xcd_barrier(bar); } } while (0)
#else
#if defined(STAMP_BLOCK)
#define SEAM(k) do { if ((k) + 1 < hi) { const unsigned long long t0_ = __builtin_amdgcn_s_memrealtime(); xcd_barrier(bar); const int kk_ = ((k) - 3) % 9; const bool isg_ = (k) >= 3 && (kk_ == 0 || kk_ == 3 || kk_ == 4 || kk_ == 6 || kk_ == 7); if (STAMP_SEL == 0 || (STAMP_SEL == 1 && isg_) || (STAMP_SEL == 2 && !isg_)) bar_ticks += __builtin_amdgcn_s_memrealtime() - t0_; } } while (0)
#else
#define SEAM(k) do { if ((k) + 1 < hi) xcd_barrier(bar); } while (0)
#endif
#endif

    if (IN_PH(0)) { const Frame P = phase_frame(F);
convert_layer(P, 0, 0, P.gw, P.NGW); mod_partials(P); rope_table(P);
#if REP_V > 1
        __syncthreads(); convert_layer(P, 0, 0, P.gw, P.NGW); mod_partials(P);
#endif
 SEAM(0); }
    if (IN_PH(1)) { const Frame P = phase_frame(F); mod_reduce(P); SEAM(1); }
    if (IN_PH(2)) { const Frame P = phase_frame(F); rowlocal_phase<0>(P, 0); SEAM(2); }
    for (int l = 0; l < DEPTH; ++l) {
        const int pb = 3 + 9 * l;
        if (IN_PH(pb + 0)) { const Frame P = phase_frame(F);
            pg8::Gemm g{P.H(), P.WIN(), M, INW, D}; pg8::StaticOrder S; S.init(M, INW, P.G, P.bx, WGM_IN);
            EpiIn E{P.Z(), P.VALL(), P.new_v(), P.CVSTAT(), l};

GEMM_CALL(1, EpiIn, pg8::StaticOrder, g, S, E);
            {
                const int rem = ((M / 256) * (INW / 256)) % P.G;
                __syncthreads();
                if (rem == 0 || P.bx >= rem) convert_layer(P, l, 1, rem == 0 ? P.gw : (P.bx - rem) * NWAVES + P.wave, rem == 0 ? P.NGW : (P.G - rem) * NWAVES);
            }
            SEAM(pb + 0);
        }
        if (IN_PH(pb + 1)) { const Frame P = phase_frame(F);
            lru_chain_phase(P, l);
#if REP_L > 1
            lru_chain_phase(P, l);
#endif
            prep_phase(P, l);
            __syncthreads();
            cm_phase(P, l);
#if REP_C > 1
            cm_phase(P, l);
#endif
            SEAM(pb + 1);
        }
        if (IN_PH(pb + 2)) { const Frame P = phase_frame(F);
            attn_phase(P, l);
#if REP_A > 1
            attn_phase(P, l);
#endif
            SEAM(pb + 2);
        }
        if (IN_PH(pb + 3)) { const Frame P = phase_frame(F);
            pg8::Gemm g{P.BR(), P.WBR(), 3 * M, 3 * D, D}; MergeOrder S; S.init(P.G, P.bx, WGM_MG);
            EpiMerge E{P.Z(), P.H()};

GEMM_CALL(2, EpiMerge, MergeOrder, g, S, E);

            SEAM(pb + 3);
        }
        if (IN_PH(pb + 4)) { const Frame P = phase_frame(F);
            pg8::Gemm g{P.H(), P.WOUT(), M, D, D}; pg8::StaticOrder S; S.init(M, D, P.G, P.bx, WGM_N8);
            EpiF E{P.Fb(), P.FSTAT()};

GEMM_CALL(3, EpiF, pg8::StaticOrder, g, S, E);
            SEAM(pb + 4);

        }
        if (IN_PH(pb + 5)) { const Frame P = phase_frame(F);

#if REP_R > 1
            rowlocal_phase<1>(P, l, 0.f);
#endif
            rowlocal_phase<1>(P, l);
 SEAM(pb + 5); }
        if (IN_PH(pb + 6)) { const Frame P = phase_frame(F);
            pg8::Gemm g{P.H(), P.WFF1(), M, DFF, D}; pg8::StaticOrder S; S.init(M, DFF, P.G, P.bx, WGM_F1);
            EpiRelu2 E{P.FFH(), DFF};

GEMM_CALL(4, EpiRelu2, pg8::StaticOrder, g, S, E);

            SEAM(pb + 6);
        }
        if (IN_PH(pb + 7)) { const Frame P = phase_frame(F);
            pg8::Gemm g{P.FFH(), P.WFF2(), M, D, DFF}; pg8::StaticOrder S; S.init(M, D, P.G, P.bx, WGM_F2);
            EpiF E{P.Fb(), P.FSTAT()};

GEMM_CALL(5, EpiF, pg8::StaticOrder, g, S, E);
            SEAM(pb + 7);

        }
        if (IN_PH(pb + 8)) { const Frame P = phase_frame(F);


#if REP_R > 1
            if (l + 1 < DEPTH) rowlocal_phase<2>(P, l, 0.f);
#endif
            if (l + 1 < DEPTH) rowlocal_phase<2>(P, l); else rowlocal_phase<3>(P, l);


if (l + 1 < DEPTH) { __syncthreads(); convert_layer(P, l + 1, 0, P.gw, P.NGW); }
#if REP_V > 1
            if (l + 1 < DEPTH) { __syncthreads(); convert_layer(P, l + 1, 0, P.gw, P.NGW); }
#endif

            SEAM(pb + 8);
        }
    }
#if defined(STAMP_BLOCK)
    if ((int)blockIdx.x == STAMP_BLOCK && threadIdx.x == 0) { __builtin_amdgcn_s_waitcnt(0); p.out[(size_t)STAMP_BLOCK * 32 * 2048] = (float)(((bar_ticks + STAMP_Q / 2) / STAMP_Q) * STAMP_Q); }
#endif
#undef IN_PH
#undef SEAM
}
}
extern "C" void kernel_launch(void* const* d_in, const int* in_sizes, int n_in, void* d_out, int out_size, void* d_ws, size_t ws_size, hipStream_t stream) {
    static int grid = 0;
    if (grid == 0) {
        if (n_in != 32 || out_size != 84410368 || ws_size < fk::WS_END) { fprintf(stderr, "kernel_launch: unexpected shapes: n_in %d out %d ws %zu (need %zu)\n", n_in, out_size, ws_size, (size_t)fk::WS_END); grid = -1; return; }
        int dev = 0, cus = 0;
        if (hipGetDevice(&dev) != hipSuccess || hipDeviceGetAttribute(&cus, hipDeviceAttributeMultiprocessorCount, dev) != hipSuccess) { grid = -1; return; }
        if (hipFuncSetAttribute((const void*)fk::mega, hipFuncAttributeMaxDynamicSharedMemorySize, fk::LDS_BYTES) != hipSuccess) { fprintf(stderr, "kernel_launch: hipFuncSetAttribute failed\n"); grid = -1; return; }
        int per_cu = 0;
        if (hipOccupancyMaxActiveBlocksPerMultiprocessor(&per_cu, (const void*)fk::mega, fk::NWAVES * 64, fk::LDS_BYTES) != hipSuccess || per_cu < 1) fprintf(stderr, "kernel_launch: occupancy query says %d blocks per CU\n", per_cu);
        (void)hipGetLastError();
        grid = cus < 256 ? cus : 256;
    }
    if (grid < 0) return;
    (void)hipMemsetAsync((char*)d_ws + fk::WS_CTL, 0, fk::CTL_ZERO_BYTES, stream);
    fk::Params p{};
    for (int i = 0; i < 32; ++i) p.in[i] = (const float*)d_in[i];
    p.out = (float*)d_out; p.ws = (unsigned char*)d_ws; p.ph_lo = 0; p.ph_hi = fk::NPHASE; p.li = 0; p.pad = 0;
    hipLaunchKernelGGL(fk::mega, dim3(grid), dim3(fk::NWAVES * 64), fk::LDS_BYTES, stream, p);
}
```

```cpp
#include <hip/hip_runtime.h>
#include <hip/hip_bf16.h>
#include <cstdio>
#include <cstdint>
namespace pg8 {
#define PG8_LAS __attribute__((address_space(3)))
typedef unsigned short bf16_t;
typedef short bf16x8 __attribute__((ext_vector_type(8)));
typedef float f32x4 __attribute__((ext_vector_type(4)));
typedef unsigned u32x4 __attribute__((ext_vector_type(4)));
constexpr int BM = 256, BK = 64, HALF = 128, HTB = HALF * BK * 2  , STAGE_BYTES = 8 * HTB, NXCD = 8, WGM = 4;

__host__ __device__ __forceinline__ int lds_byte(int r, int c) { const int st = (r >> 4) * 2 + (c >> 5), rr = r & 15, cc = c & 31, ob = rr * 64 + cc * 2; return st * 1024 + (ob ^ (((ob >> 9) & 1) << 5)); }
__host__ __device__ __forceinline__ void stage_rc(int b, int& R, int& C) { const int st = b / 1024, sb = b % 1024, swz = sb ^ (((sb >> 9) & 1) << 5); R = (st >> 1) * 16 + swz / 64; C = (st & 1) * 32 + (swz % 64) / 2; }
__host__ __device__ __forceinline__ int perm32(int rho) { const int n = rho >> 4, i = rho & 15; return 8 * (i >> 2) + 4 * n + (i & 3); }

struct Unit { int pm, pn; };
struct Gemm { const bf16_t* A; const bf16_t* Bt; int M, N, K; };

struct StaticOrder {
    int nM, nN, nwg, G, c, wgm;
    __host__ __device__ void init(int M, int N, int G_, int c_, int wgm_ = WGM) { nM = M / BM; nN = N / BM; nwg = nM * nN; G = G_; c = c_; wgm = wgm_; }
    __host__ __device__ bool next(int i, Unit& u) const {
        const long L = (long)i * G + c; if (L >= nwg) return false;
        int wgid = (int)L; { const int q = nwg / NXCD, r = nwg % NXCD, xcd = wgid % NXCD, off = wgid / NXCD; wgid = (xcd < r ? xcd * (q + 1) : r * (q + 1) + (xcd - r) * q) + off; }
        const int nig = wgm * nN, gid = wgid / nig, fm = gid * wgm, gsz = (nM - fm) < wgm ? (nM - fm) : wgm;
        u.pm = fm + ((wgid % nig) % gsz); u.pn = (wgid % nig) / gsz; return true;
    }
    __device__ __forceinline__ void a_ready(const Unit&) const {}
    __device__ __forceinline__ void done(const Unit&) const {}
};
__device__ __forceinline__ unsigned cvt_pk_bf16(float lo, float hi) { unsigned r; asm volatile("v_cvt_pk_bf16_f32 %0, %1, %2" : "=v"(r) : "v"(lo), "v"(hi)); return r; }
template <class Epi, class Sched, bool ALIGN_EPI = false, bool SP2 = false>
__device__ __forceinline__ void gemm_phase(PG8_LAS unsigned char* lds, const Gemm g, const Sched& S, const Epi& E) {
    int tid_ = threadIdx.x; asm volatile("" : "+v"(tid_));
    const int tid = tid_, wid = __builtin_amdgcn_readfirstlane(tid >> 6), lane = tid & 63, wr = wid >> 2, wc = wid & 3, fr = lane & 15, fq = lane >> 4;
    const int K = g.K, nt = K / BK;
    unsigned voffA[2], voffB[2];
#pragma unroll
    for (int i = 0; i < 2; ++i) { int R, C; stage_rc(tid * 16 + i * 8192, R, C); const int Rb = Epi::PERM ? ((R & ~31) + perm32(R & 31)) : R;
        voffA[i] = (unsigned)(R * K + C) * 2u; voffB[i] = (unsigned)(Rb * K + C) * 2u; }
    const size_t kstep = (size_t)(BK * 2);
    const size_t hstep = (size_t)HALF * K * 2;
    const size_t tstep = 2 * hstep;
    const unsigned ldsw = (unsigned)wid * 1024u;
    const int aoff = lds_byte(wr * 64 + fr, fq * 8), boff = lds_byte(wc * 32 + fr, fq * 8);
#define PG8_SA(b, h) (((b) * 2 + (h)) * HTB)
#define PG8_SB(b, h) ((4 + (b) * 2 + (h)) * HTB)
#define PG8_STAGE(bufoff, gbase, voff) do { _Pragma("unroll") for (int _i = 0; _i < 2; ++_i) \
        __builtin_amdgcn_global_load_lds((const unsigned*)((const char*)(gbase) + (voff)[_i]), (PG8_LAS unsigned*)(lds + (bufoff) + ldsw + _i * 8192), 16, 0, 0); } while (0)
#define PG8_LDA(dst, b, h) do { _Pragma("unroll") for (int m = 0; m < 4; ++m) _Pragma("unroll") for (int k = 0; k < 2; ++k) dst[m][k] = *(const PG8_LAS bf16x8*)(lds + PG8_SA(b, h) + aoff + m * 2048 + k * 1024); } while (0)
#define PG8_LDB(dst, b, h) do { _Pragma("unroll") for (int n = 0; n < 2; ++n) _Pragma("unroll") for (int k = 0; k < 2; ++k) dst[n][k] = *(const PG8_LAS bf16x8*)(lds + PG8_SB(b, h) + boff + n * 2048 + k * 1024); } while (0)
#define PG8_MMA(ai, bj, At, Bt) do { __builtin_amdgcn_s_setprio(1); _Pragma("unroll") for (int m = 0; m < 4; ++m) _Pragma("unroll") for (int n = 0; n < 2; ++n) _Pragma("unroll") for (int k = 0; k < 2; ++k) \
        acc[ai][bj][m][n] = __builtin_amdgcn_mfma_f32_16x16x32_bf16(Bt[n][k], At[m][k], acc[ai][bj][m][n], 0, 0, 0); __builtin_amdgcn_s_setprio(0); } while (0)
#define PG8_WAIT_V(n) asm volatile("s_waitcnt vmcnt(" #n ")" ::: "memory")
#define PG8_WAIT_L(n) asm volatile("s_waitcnt lgkmcnt(" #n ")" ::: "memory")
#define PG8_BAR __builtin_amdgcn_s_barrier()
#define PG8_SCHED __builtin_amdgcn_sched_barrier(0)
    Unit cur, nxt; int ui = 0;
    if (!S.next(0, cur)) return;
    f32x4 acc[2][2][4][2];
#pragma unroll
    for (int a = 0; a < 2; ++a)
#pragma unroll
        for (int b = 0; b < 2; ++b)
#pragma unroll
            for (int m = 0; m < 4; ++m)
#pragma unroll
                for (int n = 0; n < 2; ++n) acc[a][b][m][n] = (f32x4){0.f, 0.f, 0.f, 0.f};
    bf16x8 At[4][2], B0[2][2], B1[2][2];
    const char* cA = (const char*)g.A + (size_t)cur.pm * tstep; const char* cB = (const char*)g.Bt + (size_t)cur.pn * tstep;
    S.a_ready(cur);
    if constexpr (SP2) {
        PG8_STAGE(PG8_SB(0, 0), cB, voffB); PG8_STAGE(PG8_SB(0, 1), cB + hstep, voffB); PG8_STAGE(PG8_SA(0, 0), cA, voffA); PG8_STAGE(PG8_SA(0, 1), cA + hstep, voffA);
        if (wr == 1) PG8_BAR;
        PG8_WAIT_V(2); PG8_BAR;
        PG8_STAGE(PG8_SB(1, 0), cB + kstep, voffB); PG8_STAGE(PG8_SA(1, 0), cA + kstep, voffA); PG8_STAGE(PG8_SB(1, 1), cB + hstep + kstep, voffB);
        PG8_WAIT_V(6); PG8_BAR;
    } else {
        PG8_STAGE(PG8_SB(0, 0), cB, voffB); PG8_STAGE(PG8_SA(0, 0), cA, voffA); PG8_STAGE(PG8_SB(0, 1), cB + hstep, voffB); PG8_STAGE(PG8_SA(0, 1), cA + hstep, voffA);
        if (wr == 1) PG8_BAR;
        PG8_WAIT_V(4); PG8_BAR;
        PG8_STAGE(PG8_SB(1, 0), cB + kstep, voffB); PG8_STAGE(PG8_SA(1, 0), cA + kstep, voffA); PG8_STAGE(PG8_SB(1, 1), cB + hstep + kstep, voffB);
        PG8_WAIT_V(6); PG8_BAR;
    }
    for (;;) {
        const bool has_next = S.next(ui + 1, nxt);
        const char* nA = has_next ? (const char*)g.A + (size_t)nxt.pm * tstep : cA; const char* nB = has_next ? (const char*)g.Bt + (size_t)nxt.pn * tstep : cB;
        for (int t = 0; t < nt; t += 2) {
            const bool last = (t == nt - 2);
            const char* a1 = cA + (size_t)(t + 1) * kstep;
            const char* a2 = last ? nA : cA + (size_t)(t + 2) * kstep; const char* b2 = last ? nB : cB + (size_t)(t + 2) * kstep;
            const char* a3 = a2 + kstep; const char* b3 = b2 + kstep;
            if (last && has_next) S.a_ready(nxt);
            if constexpr (SP2) {
            PG8_LDB(B0, 0, 0); PG8_LDB(B1, 0, 1); PG8_SCHED; PG8_LDA(At, 0, 0); PG8_STAGE(PG8_SA(1, 1), a1 + hstep, voffA);
            PG8_WAIT_V(8); PG8_WAIT_L(0); PG8_BAR; PG8_MMA(0, 0, At, B0); PG8_MMA(0, 1, At, B1); PG8_BAR; PG8_SCHED;
            PG8_LDA(At, 0, 1); PG8_STAGE(PG8_SB(0, 0), b2, voffB); PG8_STAGE(PG8_SB(0, 1), b2 + hstep, voffB); PG8_STAGE(PG8_SA(0, 0), a2, voffA);
            PG8_WAIT_V(8); PG8_WAIT_L(0); PG8_BAR; PG8_MMA(1, 0, At, B0); PG8_MMA(1, 1, At, B1); PG8_BAR; PG8_SCHED;
            PG8_LDB(B0, 1, 0); PG8_LDB(B1, 1, 1); PG8_SCHED; PG8_LDA(At, 1, 0); PG8_STAGE(PG8_SA(0, 1), a2 + hstep, voffA);
            PG8_WAIT_V(8); PG8_WAIT_L(0); PG8_BAR; PG8_MMA(0, 0, At, B0); PG8_MMA(0, 1, At, B1); PG8_BAR; PG8_SCHED;
            PG8_LDA(At, 1, 1); PG8_STAGE(PG8_SB(1, 0), b3, voffB); PG8_STAGE(PG8_SB(1, 1), b3 + hstep, voffB); PG8_STAGE(PG8_SA(1, 0), a3, voffA);
            PG8_WAIT_V(8); PG8_WAIT_L(0); PG8_BAR; PG8_MMA(1, 0, At, B0); PG8_MMA(1, 1, At, B1); PG8_BAR; PG8_SCHED;
            } else {
            PG8_LDB(B0, 0, 0); PG8_SCHED; PG8_LDA(At, 0, 0); PG8_STAGE(PG8_SA(1, 1), a1 + hstep, voffA);
            PG8_WAIT_L(8); PG8_BAR; PG8_WAIT_L(0); PG8_MMA(0, 0, At, B0); PG8_BAR; PG8_SCHED;
            PG8_LDB(B1, 0, 1); PG8_STAGE(PG8_SB(0, 0), b2, voffB);
            PG8_BAR; PG8_WAIT_L(0); PG8_MMA(0, 1, At, B1); PG8_BAR;
            PG8_LDA(At, 0, 1); PG8_STAGE(PG8_SA(0, 0), a2, voffA);
            PG8_BAR; PG8_WAIT_L(0); PG8_MMA(1, 0, At, B0); PG8_BAR; PG8_SCHED;
            PG8_STAGE(PG8_SB(0, 1), b2 + hstep, voffB);
            PG8_WAIT_V(6); PG8_BAR; PG8_MMA(1, 1, At, B1); PG8_BAR;
            PG8_LDB(B0, 1, 0); PG8_SCHED; PG8_LDA(At, 1, 0); PG8_STAGE(PG8_SA(0, 1), a2 + hstep, voffA);
            PG8_WAIT_L(8); PG8_BAR; PG8_WAIT_L(0); PG8_MMA(0, 0, At, B0); PG8_BAR; PG8_SCHED;
            PG8_LDB(B1, 1, 1); PG8_STAGE(PG8_SB(1, 0), b3, voffB);
            PG8_BAR; PG8_WAIT_L(0); PG8_MMA(0, 1, At, B1); PG8_BAR;
            PG8_LDA(At, 1, 1); PG8_STAGE(PG8_SA(1, 0), a3, voffA);
            PG8_BAR; PG8_WAIT_L(0); PG8_MMA(1, 0, At, B0); PG8_BAR; PG8_SCHED;
            PG8_STAGE(PG8_SB(1, 1), b3 + hstep, voffB);
            PG8_WAIT_V(6); PG8_BAR; PG8_MMA(1, 1, At, B1); PG8_BAR;
            }
        }
        if constexpr (ALIGN_EPI) { if (wr == 0) PG8_BAR; }
        if constexpr (!Epi::AFTER_DRAIN) { E(acc, cur, wr, wc, fr, fq); S.done(cur); }
        if (!has_next) break;
        if (!Epi::keep(cur)) {
#pragma unroll
        for (int a = 0; a < 2; ++a)
#pragma unroll
            for (int b = 0; b < 2; ++b)
#pragma unroll
                for (int m = 0; m < 4; ++m)
#pragma unroll
                    for (int n = 0; n < 2; ++n) acc[a][b][m][n] = (f32x4){0.f, 0.f, 0.f, 0.f};
        }
        cur = nxt; cA = nA; cB = nB; ++ui;
        if constexpr (ALIGN_EPI) { if (wr == 1) PG8_BAR; }
    }
    PG8_WAIT_V(0);
    if constexpr (!ALIGN_EPI) { if (wr == 0) PG8_BAR; }
    PG8_BAR;
    if constexpr (Epi::AFTER_DRAIN) { E.fused(acc, cur, wr, wc, fr, fq, lds, wid, lane); S.done(cur); }
#undef PG8_SA
#undef PG8_SB
#undef PG8_STAGE
#undef PG8_LDA
#undef PG8_LDB
#undef PG8_MMA
#undef PG8_WAIT_V
#undef PG8_WAIT_L
#undef PG8_BAR
#undef PG8_SCHED
}
}
#define GAS __attribute__((address_space(1)))
#define LAS __attribute__((address_space(3)))
typedef unsigned short bf16;
typedef unsigned v4u __attribute__((ext_vector_type(4)));
typedef float f32x4 __attribute__((ext_vector_type(4)));
typedef short bf16x8 __attribute__((ext_vector_type(8)));
typedef GAS unsigned gu32;
typedef GAS unsigned long long gu64;
#define RLX_AGENT __ATOMIC_RELAXED, __HIP_MEMORY_SCOPE_AGENT
#define LDS_WAIT() asm volatile("s_waitcnt lgkmcnt(0)" ::: "memory")
#define VM_WAIT() asm volatile("s_waitcnt vmcnt(0)" ::: "memory")
__device__ __forceinline__ unsigned long long rt() { return __builtin_amdgcn_s_memrealtime(); }
__device__ __forceinline__ unsigned f2bf(float f) { unsigned u = __builtin_bit_cast(unsigned, f); return (u + 0x7fffu + ((u >> 16) & 1u)) >> 16; }
__device__ __forceinline__ unsigned pk2(float lo, float hi) { return f2bf(lo) | (f2bf(hi) << 16); }

#define XB_TMO      128
#define XB_XCNT(j)  (256  + 64 * (j))
#define XB_XSUB(j)  (1280 + 64 * (j))
#define XB_XGEN(j)  (2304 + 64 * (j))
#define XB_TOP      3328
#define XB_TOPGEN   3392
#define XCD_BAR_WORDS 3456
#define XB_SPIN_CAP (1u << 18)

__device__ __forceinline__ unsigned xb_ld(unsigned* p)              { return __hip_atomic_load(p, __ATOMIC_RELAXED, __HIP_MEMORY_SCOPE_AGENT); }
__device__ __forceinline__ unsigned xb_add(unsigned* p, unsigned v) { return __hip_atomic_fetch_add(p, v, __ATOMIC_RELAXED, __HIP_MEMORY_SCOPE_AGENT); }
__device__ __forceinline__ unsigned xb_xcc_id() { return (unsigned)__builtin_amdgcn_s_getreg((3 << 11) | 20) & 0xFu; }
#define XB_SPIN(cond, bar) do { unsigned _sp = 0; while (cond) { __builtin_amdgcn_s_sleep(1); \
    if ((++_sp & 255u) == 0u) { if (xb_ld(&(bar)[XB_TMO])) break; if (_sp > XB_SPIN_CAP) { atomicAdd(&(bar)[XB_TMO], 1u); break; } } } } while (0)

struct XcdBarrier {
    unsigned* bar; unsigned x;
    volatile LAS unsigned* st;
};

__device__ __forceinline__ XcdBarrier xcd_barrier_post(unsigned* bar, volatile LAS unsigned* st) {
    XcdBarrier b; b.bar = bar; b.x = xb_xcc_id(); b.st = st;
    if (threadIdx.x == 0) (void)xb_add(&bar[XB_XCNT(b.x)], 1u);
    return b;
}
__device__ __forceinline__ void xcd_barrier_complete(unsigned* bar, unsigned x, unsigned& nloc, unsigned& nx) {
    const unsigned G = gridDim.x * gridDim.y * gridDim.z;
    unsigned sum, cnt, mine, sp = 0u;
    for (;;) {
        sum = 0u; cnt = 0u; mine = 0u;
#pragma unroll
        for (unsigned j = 0; j < 16; ++j) { const unsigned c = xb_ld(&bar[XB_XCNT(j)]); sum += c; cnt += (c > 0u) ? 1u : 0u; mine = (j == x) ? c : mine; }
        if (sum == G) break;
        __builtin_amdgcn_s_sleep(1);
        if ((++sp & 255u) == 0u) { if (xb_ld(&bar[XB_TMO])) break; if (sp > XB_SPIN_CAP) { atomicAdd(&bar[XB_TMO], 1u); break; } }
    }
    nloc = mine > 0u ? mine : 1u; nx = cnt > 0u ? cnt : 1u;
}

__device__ __forceinline__ void xcd_barrier(const XcdBarrier& b) {
    asm volatile("s_waitcnt vmcnt(0)" ::: "memory");
    __syncthreads();
    if (threadIdx.x == 0) {
        unsigned* bar = b.bar;
        __builtin_amdgcn_s_waitcnt(0);
        unsigned nloc = b.st[0], nx = b.st[1];
        if (nloc == 0u) { xcd_barrier_complete(bar, b.x, nloc, nx); b.st[0] = nloc; b.st[1] = nx; }
        const unsigned old = xb_add(&bar[XB_XSUB(b.x)], 1u);
        const unsigned gen = old / nloc;
        if (old + 1u == (gen + 1u) * nloc) {
            __builtin_amdgcn_fence(__ATOMIC_RELEASE, "agent");
            asm volatile("s_waitcnt vmcnt(0)" ::: "memory");
            const unsigned og = xb_add(&bar[XB_TOP], 1u);
            const unsigned tg = og / nx;
            if (og + 1u == (tg + 1u) * nx) xb_add(&bar[XB_TOPGEN], 1u);
            else XB_SPIN(xb_ld(&bar[XB_TOPGEN]) == tg, bar);
            __builtin_amdgcn_fence(__ATOMIC_ACQUIRE, "agent");
            xb_add(&bar[XB_XGEN(b.x)], 1u);
            asm volatile("s_waitcnt vmcnt(0)" ::: "memory");
        } else {
            XB_SPIN(xb_ld(&bar[XB_XGEN(b.x)]) == gen, bar);
            __builtin_amdgcn_fence(__ATOMIC_ACQUIRE, "agent");
            asm volatile("s_waitcnt vmcnt(0)" ::: "memory");
        }
    }
    __syncthreads();
}
namespace att {
constexpr int   D = 128, NW = 8, QBLK = 32, KVBLK = 64;
constexpr float SCALE = 0.088388347648318440f;
constexpr float THR = 8.f;
constexpr int SDEPTH = 2;
constexpr int LDQ = 17408, LDK = 512, LDO = 2048;
constexpr size_t SHM_V = KVBLK * D * 2, SHM_K = KVBLK * D * 2, SHM_ATTN = 2 * SHM_V + 2 * SHM_K + NW * 64 * 4;
using bf16 = __hip_bfloat16;
using bf16x8 = __attribute__((ext_vector_type(8))) short;
using s16x4  = __attribute__((ext_vector_type(4))) short;
using f32x16 = __attribute__((ext_vector_type(16))) float;
using f32x8  = __attribute__((ext_vector_type(8))) float;
using u32x4  = __attribute__((ext_vector_type(4))) unsigned;
#define KSWZ(row, colB) ((row) * 256 + ((colB) ^ (((row) & 7) << 4)))
#define SBAR() __builtin_amdgcn_sched_barrier(0)
__device__ __forceinline__ int crow(int r, int hi) { return (r & 3) + 8 * (r >> 2) + 4 * hi; }
__device__ __forceinline__ unsigned cvtpk(float lo, float hi) {
  unsigned r; asm volatile("v_cvt_pk_bf16_f32 %0, %1, %2" : "=v"(r) : "v"(lo), "v"(hi)); return r;
}
template <typename TIn> struct Stage;
template <> struct Stage<bf16>  { using T = bf16x8;
  __device__ static __forceinline__ T ld8(const bf16* p) { return *reinterpret_cast<const bf16x8*>(p); }
  __device__ static __forceinline__ bf16x8 tobf(T x) { return x; } };
template <> struct Stage<float> { using T = f32x8;
  __device__ static __forceinline__ T ld8(const float* p) { return *reinterpret_cast<const f32x8*>(p); }
  __device__ static __forceinline__ bf16x8 tobf(T x) {
    u32x4 w = {cvtpk(x[0], x[1]), cvtpk(x[2], x[3]), cvtpk(x[4], x[5]), cvtpk(x[6], x[7])}; return *reinterpret_cast<bf16x8*>(&w); } };

__device__ __forceinline__ void partialSM(f32x16& p0, f32x16& p1, float& m_reg, float& mn, float& alpha) {
  constexpr float C = SCALE * 1.4426950408889634f;
  float pmax = p0[0]; for (int r = 1; r < 16; ++r) pmax = fmaxf(pmax, p0[r]); for (int r = 0; r < 16; ++r) pmax = fmaxf(pmax, p1[r]);
  { auto rr = __builtin_amdgcn_permlane32_swap(__float_as_uint(pmax), __float_as_uint(pmax), false, false);
    pmax = fmaxf(__uint_as_float(rr[0]), __uint_as_float(rr[1])); }
  if (__builtin_expect(__all(pmax - m_reg <= THR / SCALE), 1)) { mn = m_reg; alpha = 1.f; }
  else { mn = fmaxf(m_reg, pmax); alpha = __builtin_amdgcn_exp2f((m_reg - mn) * C); m_reg = mn; }
  float mnC = -mn * C;
  for (int r = 0; r < 16; ++r) p0[r] = fmaf(p0[r], C, mnC); for (int r = 0; r < 16; ++r) p1[r] = fmaf(p1[r], C, mnC);
  for (int r = 0; r < 16; ++r) p0[r] = __builtin_amdgcn_exp2f(p0[r]);
}
__device__ __forceinline__ void finishSM(f32x16& p0, f32x16& p1, float alpha, float& l_reg, bf16x8& pa0, bf16x8& pa1, bf16x8& pa2, bf16x8& pa3) {
  for (int r = 0; r < 16; ++r) p1[r] = __builtin_amdgcn_exp2f(p1[r]);
  float ps = 0; for (int r = 0; r < 16; ++r) ps += p0[r]; for (int r = 0; r < 16; ++r) ps += p1[r];
  { auto rr = __builtin_amdgcn_permlane32_swap(__float_as_uint(ps), __float_as_uint(ps), false, false);
    ps = __uint_as_float(rr[0]) + __uint_as_float(rr[1]); }
  l_reg = l_reg * alpha + ps;
#define PK4(P, BASE, OUT) do { unsigned a0 = cvtpk(P[BASE + 0], P[BASE + 1]), a1 = cvtpk(P[BASE + 2], P[BASE + 3]);   \
    unsigned b0 = cvtpk(P[BASE + 4], P[BASE + 5]), b1 = cvtpk(P[BASE + 6], P[BASE + 7]);                              \
    auto r0 = __builtin_amdgcn_permlane32_swap(a0, b0, false, false); auto r1 = __builtin_amdgcn_permlane32_swap(a1, b1, false, false); \
    u32x4 w = {r0[0], r1[0], r0[1], r1[1]}; OUT = *reinterpret_cast<bf16x8*>(&w); } while (0)
  PK4(p0, 0, pa0); PK4(p0, 8, pa1); PK4(p1, 0, pa2); PK4(p1, 8, pa3);
#undef PK4
}
__device__ __forceinline__ void qkt(f32x16& p0, f32x16& p1, const bf16* Ks, const bf16x8* qr, int r32, int hi) {
  p0 = f32x16{}; p1 = f32x16{};
  for (int d0 = 0; d0 < 8; ++d0) { int cb = (d0 * 16 + hi * 8) * 2;
    bf16x8 b0 = *reinterpret_cast<const bf16x8*>((const char*)Ks + KSWZ(r32, cb));
    bf16x8 b1 = *reinterpret_cast<const bf16x8*>((const char*)Ks + KSWZ(32 + r32, cb));
    p0 = __builtin_amdgcn_mfma_f32_32x32x16_bf16(b0, qr[d0], p0, 0, 0, 0);
    p1 = __builtin_amdgcn_mfma_f32_32x32x16_bf16(b1, qr[d0], p1, 0, 0, 0); }
}
__device__ __forceinline__ int v_st(int k, int c) { const int kk = (k & ~0xC) | ((k & 4) << 1) | ((k & 8) >> 1); return ((kk >> 3) * 4 + (c >> 5)) * 512 + ((kk & 7) * 32 + (c & 31)) * 2; }
__device__ __forceinline__ int v_rd_base(int lane) { return ((lane & 3) << 3) | (((lane >> 2) & 3) << 6) | (((lane >> 4) & 1) << 5) | (((lane >> 5) & 1) << 8); }
constexpr int v_rd_off(int d0, int ks, int half) { return d0 * 512 + ks * 4096 + half * 2048; }
template <int OFF> __device__ __forceinline__ s16x4 tr_read(int vb) {
  s16x4 r; asm volatile("ds_read_b64_tr_b16 %0, %1 offset:%2" : "=&v"(r) : "v"(vb), "i"(OFF) : "memory"); return r;
}
template <int D0> __device__ __forceinline__ void pv_one(f32x16& od, int vb, bf16x8 pa0, bf16x8 pa1, bf16x8 pa2, bf16x8 pa3) {
  const s16x4 l0 = tr_read<v_rd_off(D0, 0, 0)>(vb), h0 = tr_read<v_rd_off(D0, 0, 1)>(vb), l1 = tr_read<v_rd_off(D0, 1, 0)>(vb), h1 = tr_read<v_rd_off(D0, 1, 1)>(vb);
  const s16x4 l2 = tr_read<v_rd_off(D0, 2, 0)>(vb), h2 = tr_read<v_rd_off(D0, 2, 1)>(vb), l3 = tr_read<v_rd_off(D0, 3, 0)>(vb), h3 = tr_read<v_rd_off(D0, 3, 1)>(vb);
  asm volatile("s_waitcnt lgkmcnt(0)" ::: "memory"); SBAR();
#define PK(L, H) (bf16x8){L[0], L[1], L[2], L[3], H[0], H[1], H[2], H[3]}
  od = __builtin_amdgcn_mfma_f32_32x32x16_bf16(pa0, PK(l0, h0), od, 0, 0, 0);
  od = __builtin_amdgcn_mfma_f32_32x32x16_bf16(pa1, PK(l1, h1), od, 0, 0, 0);
  od = __builtin_amdgcn_mfma_f32_32x32x16_bf16(pa2, PK(l2, h2), od, 0, 0, 0);
  od = __builtin_amdgcn_mfma_f32_32x32x16_bf16(pa3, PK(l3, h3), od, 0, 0, 0);
#undef PK
}
__device__ __forceinline__ void pv_d0(f32x16* o, int vb, bf16x8 pa0, bf16x8 pa1, bf16x8 pa2, bf16x8 pa3) {
  pv_one<0>(o[0], vb, pa0, pa1, pa2, pa3); pv_one<1>(o[1], vb, pa0, pa1, pa2, pa3); pv_one<2>(o[2], vb, pa0, pa1, pa2, pa3); pv_one<3>(o[3], vb, pa0, pa1, pa2, pa3);
}

template <typename TQ>
__device__ __forceinline__ void attn_dense_body(const TQ* __restrict__ Qb, const bf16* __restrict__ Kh, const bf16* __restrict__ Vh,
                                                bf16* __restrict__ Ob, int seq, char* lds, const float* __restrict__ gq, const float* __restrict__ rope, int t0) {
  using St = Stage<bf16>; using SQ = Stage<TQ>;
  int tid_ = threadIdx.x; asm volatile("" : "+v"(tid_));
  const int tid = tid_, wid = tid >> 6, lane = tid & 63, r32 = lane & 31, hi = lane >> 5;
  bf16* V_lds = (bf16*)lds; bf16* K_lds = (bf16*)(lds + 2 * SHM_V);
  float* ws = (float*)(lds + 2 * SHM_V + 2 * SHM_K) + wid * 64; float* li_l = ws; float* al_l = ws + 32;
  float m_reg = -1e30f, l_reg = 0; f32x16 o[4] = {}; bf16x8 qr[8];
  const TQ* Qw = Qb + (long)(wid * QBLK + r32) * LDQ + hi * 8;
#pragma unroll
  for (int d0 = 0; d0 < 8; ++d0) qr[d0] = SQ::tobf(SQ::ld8(Qw + d0 * 16));
  {
    typedef float f32x4q __attribute__((ext_vector_type(4)));
    float qf[8][8]; float ss = 0.f;
#pragma unroll
    for (int d0 = 0; d0 < 8; ++d0)
#pragma unroll
      for (int j = 0; j < 8; ++j) { const float v = __uint_as_float(((unsigned)(unsigned short)qr[d0][j]) << 16); qf[d0][j] = v; ss += v * v; }
    ss += __shfl_xor(ss, 32);
    const float rs = rsqrtf(ss * (1.f / 128.f) + 1e-6f);
#pragma unroll
    for (int d0 = 0; d0 < 8; ++d0) { const f32x4q g0 = *(const f32x4q*)(gq + d0 * 16 + hi * 8), g1 = *(const f32x4q*)(gq + d0 * 16 + hi * 8 + 4);
#pragma unroll
      for (int j = 0; j < 4; ++j) { qf[d0][j] *= rs * g0[j]; qf[d0][4 + j] *= rs * g1[j]; } }
    if (rope) {
      const int t = t0 + wid * QBLK + r32;
#pragma unroll
      for (int ax = 0; ax < 2; ++ax) { const int pos = ax == 0 ? (t >> 6) : (t & 63);
#pragma unroll
        for (int e = 0; e < 2; ++e) { const int da = ax * 4 + e, db = da + 2; const float* cp = rope + pos * 32 + e * 16 + hi * 8;
          const f32x4q c0 = *(const f32x4q*)cp, c1 = *(const f32x4q*)(cp + 4), s0 = *(const f32x4q*)(cp + 2048), s1 = *(const f32x4q*)(cp + 2048 + 4);
#pragma unroll
          for (int j = 0; j < 8; ++j) { const float c = j < 4 ? c0[j & 3] : c1[j & 3], sn = j < 4 ? s0[j & 3] : s1[j & 3]; const float xa = qf[da][j], xb = qf[db][j]; qf[da][j] = xa * c - xb * sn; qf[db][j] = xa * sn + xb * c; } } }
    }
#pragma unroll
    for (int d0 = 0; d0 < 8; ++d0) { u32x4 w = {cvtpk(qf[d0][0], qf[d0][1]), cvtpk(qf[d0][2], qf[d0][3]), cvtpk(qf[d0][4], qf[d0][5]), cvtpk(qf[d0][6], qf[d0][7])}; qr[d0] = *reinterpret_cast<bf16x8*>(&w); }
  }
  const int sr = tid >> 4, sc = (tid & 15) * 8, vst0 = v_st(sr, sc), vst1 = v_st(32 + sr, sc);
  const int vb0 = (int)(uintptr_t)V_lds + v_rd_base(lane);
  struct { typename St::T vs0, vs1, ks0, ks1; } sr_[SDEPTH];
#define SLOAD(i, k0) do { sr_[i].vs0 = St::ld8(&Vh[(long)((k0) + sr) * LDK + sc]); sr_[i].vs1 = St::ld8(&Vh[(long)((k0) + 32 + sr) * LDK + sc]); \
    sr_[i].ks0 = St::ld8(&Kh[(long)((k0) + sr) * LDK + sc]); sr_[i].ks1 = St::ld8(&Kh[(long)((k0) + 32 + sr) * LDK + sc]); } while (0)
#define SWRITE(b, i) do { *(bf16x8*)((char*)V_lds + (b) * SHM_V + vst0) = St::tobf(sr_[i].vs0);          \
    *(bf16x8*)((char*)V_lds + (b) * SHM_V + vst1) = St::tobf(sr_[i].vs1); int kc = sc * 2;               \
    *(bf16x8*)((char*)K_lds + (b) * SHM_K + KSWZ(sr, kc)) = St::tobf(sr_[i].ks0);                       \
    *(bf16x8*)((char*)K_lds + (b) * SHM_K + KSWZ(32 + sr, kc)) = St::tobf(sr_[i].ks1); } while (0)
#define SWAIT() do { if constexpr (SDEPTH == 2) asm volatile("s_waitcnt vmcnt(4)" ::: "memory"); else asm volatile("s_waitcnt vmcnt(0)" ::: "memory"); } while (0)
#define RESC(a) do { if (__any((a) < 1.f)) { if (hi == 0) al_l[r32] = (a); asm volatile("s_waitcnt lgkmcnt(0)" ::: "memory"); \
    for (int d = 0; d < 4; ++d) for (int r = 0; r < 16; ++r) o[d][r] *= al_l[crow(r, hi)]; } } while (0)
  f32x16 pA0, pA1, pB0, pB1; float mnA, mnB, alA, alB; bf16x8 pa0, pa1, pa2, pa3; const int NT = seq / KVBLK;
  constexpr int SE = 0, SO = SDEPTH - 1;
  SLOAD(SE, 0); asm volatile("s_waitcnt vmcnt(0)" ::: "memory"); SWRITE(0, SE); __syncthreads();
  qkt(pA0, pA1, K_lds, qr, r32, hi); partialSM(pA0, pA1, m_reg, mnA, alA);
  SLOAD(SO, KVBLK); if constexpr (SDEPTH == 2) { if (2 < NT) SLOAD(SE, 2 * KVBLK); }
  SWAIT(); SWRITE(1, SO); __syncthreads();
  for (int j = 1; j + 1 < NT; j += 2) {
    SBAR(); qkt(pB0, pB1, (bf16*)((char*)K_lds + SHM_K), qr, r32, hi);
    finishSM(pA0, pA1, alA, l_reg, pa0, pa1, pa2, pa3); SBAR();
    SLOAD(SO, (j + SDEPTH) * KVBLK); SBAR();
    pv_d0(o, vb0, pa0, pa1, pa2, pa3); partialSM(pB0, pB1, m_reg, mnB, alB);
    __syncthreads(); SWAIT(); SWRITE(0, SE);
    RESC(alB); __syncthreads();
    SBAR(); qkt(pA0, pA1, K_lds, qr, r32, hi);
    finishSM(pB0, pB1, alB, l_reg, pa0, pa1, pa2, pa3); SBAR();
    if (SDEPTH == 1 || j + 3 < NT) SLOAD(SE, (j + 1 + SDEPTH) * KVBLK); SBAR();
    pv_d0(o, vb0 + (int)SHM_V, pa0, pa1, pa2, pa3); partialSM(pA0, pA1, m_reg, mnA, alA);
    __syncthreads(); SWAIT(); SWRITE(1, SO);
    RESC(alA); __syncthreads();
  }
  SBAR(); qkt(pB0, pB1, (bf16*)((char*)K_lds + SHM_K), qr, r32, hi);
  finishSM(pA0, pA1, alA, l_reg, pa0, pa1, pa2, pa3); SBAR();
  pv_d0(o, vb0, pa0, pa1, pa2, pa3); partialSM(pB0, pB1, m_reg, mnB, alB);
  __syncthreads(); RESC(alB);
  finishSM(pB0, pB1, alB, l_reg, pa0, pa1, pa2, pa3); SBAR();
  pv_d0(o, vb0 + (int)SHM_V, pa0, pa1, pa2, pa3);
  if (hi == 0) li_l[r32] = l_reg; asm volatile("s_waitcnt lgkmcnt(0)" ::: "memory");
  float rli[16];
#pragma unroll
  for (int r = 0; r < 16; ++r) rli[r] = __builtin_amdgcn_rcpf(li_l[crow(r, hi)]);
  bf16* Ow = Ob + (long)(wid * QBLK) * LDO;
  { char* stg = lds + SHM_ATTN + wid * (32 * 272);
#pragma unroll
    for (int r = 0; r < 16; ++r) { const int orow = crow(r, hi);
#pragma unroll
      for (int d0 = 0; d0 < 4; ++d0) *(bf16*)(stg + orow * 272 + (d0 * 32 + r32) * 2) = __float2bfloat16(o[d0][r] * rli[r]); }
    asm volatile("s_waitcnt lgkmcnt(0)" ::: "memory");
#pragma unroll
    for (int i = 0; i < 8; ++i) { const int row = i * 4 + (lane >> 4), ch = lane & 15;
      const u32x4 v = *(const u32x4*)(stg + row * 272 + ch * 16);
      *(u32x4*)(Ow + (long)row * LDO + ch * 8) = v; }
  }
#undef SLOAD
#undef SWRITE
#undef SWAIT
#undef RESC
}
#undef KSWZ
#undef SBAR
}
namespace fk {
using pg8::bf16_t; using pg8::f32x4; using pg8::u32x4; using pg8::Unit; using pg8::cvt_pk_bf16;
typedef unsigned u32x2 __attribute__((ext_vector_type(2)));
typedef float f32x16 __attribute__((ext_vector_type(16)));
constexpr int M = 24576, MP = 8192, D = 2048, INW = 17408, DFF = 8192, DEPTH = 4, NWAVES = 8, NCOND = 9;
constexpr int OFF_Q = 0, OFF_K = 2048, OFF_V = 2560, OFF_LX = 3072, OFF_LG = 5120, OFF_CU = 7168, OFF_CV = 9216, OFF_G = 11264;
constexpr int NKVROWS = 26624;
constexpr float EPS = 1e-6f;
constexpr int NPHASE = 3 + 9 * DEPTH;
constexpr int NMODK = 32;
constexpr size_t MiB = 1u << 20;
constexpr size_t WS_CTL = 0, CTL_ZERO_BYTES = 1 * MiB;
constexpr size_t WS_CIN = 1 * MiB  , WS_MODP = 716 * MiB  , WS_MOD = 28 * MiB, WS_ROPE = 30 * MiB, WS_CVSTAT = 31 * MiB, WS_FSTAT = 34 * MiB, WS_AGG = 37 * MiB, WS_WLRU = 49 * MiB, WS_CMW = 51 * MiB;
constexpr size_t WS_WIN = 52 * MiB, WS_WBR = 120 * MiB, WS_WOUT = 144 * MiB, WS_WFF1 = 152 * MiB, WS_WFF2 = 184 * MiB;
constexpr size_t WS_H = 216 * MiB, WS_KALL = 312 * MiB, WS_VALL = 338 * MiB, WS_BR = 364 * MiB, WS_MSCR = 652 * MiB, WS_Z = 716 * MiB, WS_XB = 1532 * MiB  , WS_END = 1628 * MiB;
constexpr size_t WS_FFH = WS_Z, WS_F = WS_Z + 384 * MiB;
constexpr int CW_SPLIT = 2048;
constexpr int CW_BAR = 4096;
constexpr int RING_BYTES = 131072;
constexpr int LRU_XCSZ = 17408, LRU_XCB = 2 * LRU_XCSZ, LRU_HP = 132, LRU_H0 = 4 * LRU_XCSZ, LRU_H1 = LRU_H0 + 64 * LRU_HP * 4;
constexpr int LRU_TAPS = LRU_H1 + 64 * LRU_HP * 4;
static_assert(LRU_TAPS + 5 * 128 * 4 <= 150528, "lru lds map");
constexpr int LRU_XC = 0, LRU_XC_PITCH = 272, LRU_A0 = 17408, LRU_B0 = LRU_A0 + 32768, LRU_A1 = LRU_B0 + 32768, LRU_B1 = LRU_A1 + 32768, LRU_CARRY = LRU_B1 + 32768;
constexpr int CM_VT = 0, CM_VT_PITCH = 272, CM_RS = 128 * 272;
constexpr int MISC_OFF = 150528, LDS_BYTES = 151552;
static_assert(LRU_CARRY + 2048 <= MISC_OFF, "lds map");

struct Params { const float* in[32]; float* out; unsigned char* ws; int ph_lo, ph_hi, li, pad; };

typedef const __attribute__((address_space(4))) void* kaptr_t;
struct Frame {
    LAS unsigned char* lds;
    int tid, lane, wave, vcu, G, gw, NGW, bx;
    float* out; unsigned char* ws; kaptr_t ka;
    __device__ __forceinline__ float* x() const { return out; }
    __device__ __forceinline__ float* new_k() const { return out + 50331648L; }
    __device__ __forceinline__ float* new_v() const { return out + 50331648L + 16777216L; }
    __device__ __forceinline__ float* new_s() const { return out + 50331648L + 2 * 16777216L; }
#define FK_WSP(name, type, off) __device__ __forceinline__ type* name() const { return (type*)(ws + (off)); }
    FK_WSP(MODP, float, WS_MODP) FK_WSP(MOD, float, WS_MOD) FK_WSP(ROPE, float, WS_ROPE) FK_WSP(CVSTAT, float, WS_CVSTAT) FK_WSP(FSTAT, float, WS_FSTAT) FK_WSP(AGG, float, WS_AGG) FK_WSP(CIN, float, WS_CIN) FK_WSP(MSCR, float, WS_MSCR)
    FK_WSP(WLRU, bf16_t, WS_WLRU) FK_WSP(CMW, bf16_t, WS_CMW) FK_WSP(WIN, bf16_t, WS_WIN) FK_WSP(WBR, bf16_t, WS_WBR) FK_WSP(WOUT, bf16_t, WS_WOUT) FK_WSP(WFF1, bf16_t, WS_WFF1) FK_WSP(WFF2, bf16_t, WS_WFF2)
    FK_WSP(H, bf16_t, WS_H) FK_WSP(KALL, bf16_t, WS_KALL) FK_WSP(VALL, bf16_t, WS_VALL) FK_WSP(BR, bf16_t, WS_BR) FK_WSP(Z, bf16_t, WS_Z) FK_WSP(FFH, bf16_t, WS_FFH) FK_WSP(XB, bf16_t, WS_XB) FK_WSP(Fb, bf16_t, WS_F)
#undef FK_WSP
};
enum { I_XP = 0, I_XS, I_CK, I_CV, I_SL, I_C, I_CCTX, I_WMOD, I_BMOD, I_GPM, I_GPOM, I_GPF, I_GPOF, I_WIN, I_GQ, I_GK, I_WAO, I_CW, I_CB, I_LWA, I_LBA, I_LWX, I_LBX, I_LAM, I_WLO, I_CMG, I_CMWS, I_CMBS, I_WCO, I_WOUT, I_WFF1, I_WFF2 };
template <int I> __device__ __forceinline__ const float* inp(const Frame& F) { const GAS float* r; asm volatile("s_load_dwordx2 %0, %1, %2\n\ts_waitcnt lgkmcnt(0)" : "=s"(r) : "s"(F.ka), "i"(I * 8) : "memory"); return (const float*)r; }


__device__ __forceinline__ Frame phase_frame(const Frame& F) {
    Frame P = F; int t = F.tid; int bx = blockIdx.x; int g = F.G; GAS unsigned char* w = (GAS unsigned char*)F.ws; GAS float* o = (GAS float*)F.out;
    asm volatile("" : "+v"(t)); asm volatile("" : "+s"(bx), "+s"(g), "+s"(w), "+s"(o));
    P.tid = t; P.lane = t & 63; P.wave = __builtin_amdgcn_readfirstlane(t >> 6); P.ws = (unsigned char*)w; P.out = (float*)o; P.bx = bx; P.G = g; P.NGW = g * NWAVES;
    P.vcu = (g % 8 == 0) ? (bx % 8) * (g / 8) + bx / 8 : bx; P.gw = P.vcu * NWAVES + P.wave;
    return P;
}
__device__ __forceinline__ float wave_sum(float v) {
#pragma unroll
    for (int o = 1; o < 64; o <<= 1) v += __shfl_xor(v, o);
    return v;
}
__device__ __forceinline__ float bf2f(unsigned short h) { return __uint_as_float((unsigned)h << 16); }
__device__ __forceinline__ float bflo(unsigned w) { return __uint_as_float(w << 16); }
__device__ __forceinline__ float bfhi(unsigned w) { return __uint_as_float(w & 0xffff0000u); }
__device__ __forceinline__ float fsigm(float x) { return __builtin_amdgcn_rcpf(1.f + __builtin_amdgcn_exp2f(-1.4426950408889634f * x)); }
__device__ __forceinline__ float fgelu(float x) { const float u = x * (1.5957691216057308f + 0.0713548162726009f * x * x); return x * fsigm(u); }

struct CvItem { const float* W; bf16_t* WT; int K, N, row_off, sub; };
struct CvRegs { f32x4 v[8][2]; };
__device__ __forceinline__ void cv_load(CvRegs& R, const CvItem& I, int lane) {
    const int nblk = I.N / 64, kb = I.sub / nblk, nb = I.sub % nblk, k0 = 64 * kb, n0 = 64 * nb;
    const float* src = I.W + (size_t)(k0 + 2 * (lane >> 4)) * I.N + n0 + (lane & 15) * 4;
#pragma unroll
    for (int i = 0; i < 8; ++i) { R.v[i][0] = __builtin_nontemporal_load((const f32x4*)(src + (size_t)(8 * i) * I.N)); R.v[i][1] = __builtin_nontemporal_load((const f32x4*)(src + (size_t)(8 * i + 1) * I.N)); }
}
__device__ __forceinline__ void cv_store(const CvRegs& R, const CvItem& I, LAS unsigned char* scr, int lane) {
    const int nblk = I.N / 64, kb = I.sub / nblk, nb = I.sub % nblk, k0 = 64 * kb, n0 = 64 * nb;
    const int n4 = (lane & 15) * 4, kp = lane >> 4;
#pragma unroll
    for (int i = 0; i < 8; ++i) { const int k = 8 * i + 2 * kp;
#pragma unroll
        for (int j = 0; j < 4; ++j) *(LAS unsigned*)(scr + (n4 + j) * 144 + k * 2) = cvt_pk_bf16(R.v[i][0][j], R.v[i][1][j]); }
    LDS_WAIT(); asm volatile("" ::: "memory");
    const int ch = lane & 7;
#pragma unroll
    for (int j = 0; j < 8; ++j) { const int n = (lane >> 3) + 8 * j;
        const v4u o = *(const LAS v4u*)(scr + n * 144 + ch * 16);
        *(GAS v4u*)(I.WT + (size_t)(I.row_off + n0 + n) * I.K + k0 + 8 * ch) = o; }
    LDS_WAIT(); asm volatile("" ::: "memory");
}
#ifndef CVT_TAIL_ITEMS
#define CVT_TAIL_ITEMS 8192
#endif
__device__ __forceinline__ void convert_layer(const Frame& F, int l, int part, int wid, int NW) {
    LAS unsigned char* scr = F.lds + F.wave * 16384;
    constexpr int I_IN = 32 * 272, I_SQ = 32 * 32, I_F1 = 32 * 128, I_F2 = 128 * 32, I_LRU = 64 * 4;
    constexpr int I_TAIL = CVT_TAIL_ITEMS, I_HEAD = I_IN + 4 * I_SQ + I_F1 + I_F2 - I_TAIL;
    static_assert(I_TAIL <= 4 * I_SQ + I_F1 + I_F2, "tail items");
    const int NITEMS = part ? I_TAIL : I_HEAD + I_LRU;
    const float* w_in = inp<I_WIN>(F) + (size_t)l * D * INW; const float* w_ao = inp<I_WAO>(F) + (size_t)l * D * D; const float* w_lo = inp<I_WLO>(F) + (size_t)l * D * D;
    const float* w_co = inp<I_WCO>(F) + (size_t)l * D * D; const float* w_out = inp<I_WOUT>(F) + (size_t)l * D * D; const float* w_f1 = inp<I_WFF1>(F) + (size_t)l * D * DFF;
    const float* w_f2 = inp<I_WFF2>(F) + (size_t)l * DFF * D; const float* lwa = inp<I_LWA>(F) + (size_t)l * 2 * 16 * 16384; const float* lwx = inp<I_LWX>(F) + (size_t)l * 2 * 16 * 16384;
    bf16_t* WIN = F.WIN(); bf16_t* WBR = F.WBR(); bf16_t* WOUT = F.WOUT(); bf16_t* WFF1 = F.WFF1(); bf16_t* WFF2 = F.WFF2(); bf16_t* WLRU = F.WLRU();
    auto decode = [&](int it) -> CvItem {
        int r = part ? it + I_HEAD : (it < I_HEAD ? it : it + I_TAIL);
        if (r < I_IN) return CvItem{w_in, WIN, D, INW, 0, r}; r -= I_IN;
        if (r < I_SQ) return CvItem{w_ao, WBR, D, D, 0, r}; r -= I_SQ;
        if (r < I_SQ) return CvItem{w_lo, WBR, D, D, D, r}; r -= I_SQ;
        if (r < I_SQ) return CvItem{w_co, WBR, D, D, 2 * D, r}; r -= I_SQ;
        if (r < I_SQ) return CvItem{w_out, WOUT, D, D, 0, r}; r -= I_SQ;
        if (r < I_F1) return CvItem{w_f1, WFF1, D, DFF, 0, r}; r -= I_F1;
        if (r < I_F2) return CvItem{w_f2, WFF2, DFF, D, 0, r}; r -= I_F2;
        const int bi = r >> 2, d = bi >> 5, mat = (bi >> 4) & 1, blk = bi & 15;
        return CvItem{(mat ? lwx : lwa) + ((size_t)d * 16 + blk) * 16384, WLRU + (size_t)bi * 16384, 128, 128, 0, r & 3};
    };
    CvRegs A, B;
    int it = wid;
    if (it < NITEMS) cv_load(A, decode(it), F.lane);
    for (; it < NITEMS; it += 2 * NW) {
#pragma unroll
        for (int half = 0; half < 2; ++half) {
            const int ic = it + half * NW, in = ic + NW;
            if (ic >= NITEMS) break;
            CvRegs& cur = half ? B : A; CvRegs& nxt = half ? A : B;
            if (in < NITEMS) cv_load(nxt, decode(in), F.lane);
            cv_store(cur, decode(ic), scr, F.lane);
        }
    }
    if (part) return;
    const float* cw = inp<I_CMWS>(F) + (size_t)l * 16 * 16384;
    for (int i = (F.gw * 64 + F.lane) * 8; i < 16 * 16384; i += F.NGW * 64 * 8) {
        const f32x4 a = *(const f32x4*)(cw + i), b = *(const f32x4*)(cw + i + 4);
        v4u o; o.x = pk2(a.x, a.y); o.y = pk2(a.z, a.w); o.z = pk2(b.x, b.y); o.w = pk2(b.z, b.w);
        *(v4u*)(F.CMW() + i) = o;
    }
}
__device__ __forceinline__ void mod_partials(const Frame& F) {
    LAS float* scr = (LAS float*)(F.lds + F.wave * 16384);
    const float* cctx = inp<I_CCTX>(F); const float* cc = inp<I_C>(F); const float* wmod = inp<I_WMOD>(F);
    for (int it = F.gw; it < DEPTH * 48 * NMODK; it += F.NGW) {
        const int kc = it % NMODK, jb = (it / NMODK) % 48, l = it / (NMODK * 48), k0 = kc * 64;
        for (int e = F.lane; e < NCOND * 64; e += 64) { const int ci = e >> 6, kk = e & 63; const float v = ci == 0 ? cctx[k0 + kk] : cc[(ci - 1) * D + k0 + kk]; scr[e] = v * (1.f / (1.f + __expf(-v))); }
        LDS_WAIT(); asm volatile("" ::: "memory");
        f32x4 acc[NCOND];
#pragma unroll
        for (int ci = 0; ci < NCOND; ++ci) acc[ci] = (f32x4){0.f, 0.f, 0.f, 0.f};
        const float* wp = wmod + ((size_t)l * D + k0) * 12288 + jb * 256 + F.lane * 4;
#pragma unroll
        for (int kb = 0; kb < 64; kb += 16) {
            f32x4 w[16];
#pragma unroll
            for (int kk = 0; kk < 16; ++kk) w[kk] = *(const f32x4*)(wp + (size_t)(kb + kk) * 12288);
#pragma unroll
            for (int kk = 0; kk < 16; ++kk)
#pragma unroll
                for (int ci = 0; ci < NCOND; ++ci) acc[ci] += w[kk] * scr[ci * 64 + kb + kk];
        }
#pragma unroll
        for (int ci = 0; ci < NCOND; ++ci) *(f32x4*)(F.MODP() + (((size_t)kc * DEPTH + l) * NCOND + ci) * 12288 + jb * 256 + F.lane * 4) = acc[ci];
        LDS_WAIT(); asm volatile("" ::: "memory");
    }
}
__device__ __forceinline__ void mod_reduce(const Frame& F) {
    constexpr int NEL = DEPTH * NCOND * 12288;
    for (int i = (F.gw * 64 + F.lane) * 4; i < NEL; i += F.NGW * 64 * 4) {
        const int l = i / (NCOND * 12288), j = i % 12288;
        f32x4 s = *(const f32x4*)(inp<I_BMOD>(F) + (size_t)l * 12288 + j);
#pragma unroll
        for (int kc = 0; kc < NMODK; ++kc) s += *(const f32x4*)(F.MODP() + (size_t)kc * NEL + i);
        *(f32x4*)(F.MOD() + i) = s;
    }
}
__device__ __forceinline__ void rope_table(const Frame& F) {
    if (F.bx == 0) for (int e = F.tid; e < 2048; e += NWAVES * 64) {
        const int pos = e >> 5, f = e & 31; const float inv = exp2f(-(float)f * (13.287712379549449f / 32.f)); float s, c; sincosf((float)pos * inv, &s, &c);
        F.ROPE()[e] = c; F.ROPE()[2048 + e] = s; }
}
__device__ __forceinline__ u32x4 pack8(const f32x4& a, const f32x4& b) { u32x4 w; w.x = cvt_pk_bf16(a[0], a[1]); w.y = cvt_pk_bf16(a[2], a[3]); w.z = cvt_pk_bf16(b[0], b[1]); w.w = cvt_pk_bf16(b[2], b[3]); return w; }
struct RowIn { f32x4 x[4][2]; u32x4 xb[4]; u32x4 f[4]; float st; };
template <bool XF32, bool HAS_F>
__device__ __forceinline__ void row_load(const Frame& F, RowIn& R, const float* xsrc, const bf16_t* xbsrc, const bf16_t* frow, const float* fstat) {
    if (XF32) {
#pragma unroll
        for (int j = 0; j < 4; ++j) { const int e = (j * 64 + F.lane) * 8; R.x[j][0] = __builtin_nontemporal_load((const f32x4*)(xsrc + e)); R.x[j][1] = __builtin_nontemporal_load((const f32x4*)(xsrc + e + 4)); }
    } else {
#pragma unroll
        for (int j = 0; j < 4; ++j) R.xb[j] = __builtin_nontemporal_load((const u32x4*)(xbsrc + (j * 64 + F.lane) * 8));
    }
    if (HAS_F) {
#pragma unroll
        for (int j = 0; j < 4; ++j) R.f[j] = __builtin_nontemporal_load((const u32x4*)(frow + (j * 64 + F.lane) * 8));
        R.st = F.lane < 32 ? fstat[F.lane] : 0.f;
    }
}
template <bool XF32, bool HAS_F, bool HAS_H, bool OUTF32>
__device__ __forceinline__ void row_apply(const Frame& F, RowIn& R, float* xdst, bf16_t* xbdst, const LAS float* pv, bf16_t* hrow, float gs) {
    if (!XF32) {
#pragma unroll
        for (int j = 0; j < 4; ++j) { const u32x4 w = R.xb[j]; R.x[j][0] = (f32x4){bflo(w.x), bfhi(w.x), bflo(w.y), bfhi(w.y)}; R.x[j][1] = (f32x4){bflo(w.z), bfhi(w.z), bflo(w.w), bfhi(w.w)}; }
    }
    if (HAS_F) {
        const float rs = rsqrtf(wave_sum(R.st) * (1.f / D) + EPS) * gs;
#pragma unroll
        for (int j = 0; j < 4; ++j) { const int e = (j * 64 + F.lane) * 8; const u32x4 fw = R.f[j];
            const f32x4 g0 = *(const LAS f32x4*)(pv + e), g1 = *(const LAS f32x4*)(pv + e + 4), p0 = *(const LAS f32x4*)(pv + 2048 + e), p1 = *(const LAS f32x4*)(pv + 2048 + e + 4);
            const f32x4 f0 = {bflo(fw.x), bfhi(fw.x), bflo(fw.y), bfhi(fw.y)}, f1 = {bflo(fw.z), bfhi(fw.z), bflo(fw.w), bfhi(fw.w)};
            R.x[j][0] += g0 * (f0 * rs * p0); R.x[j][1] += g1 * (f1 * rs * p1); }
    }
    if (OUTF32) {
#pragma unroll
        for (int j = 0; j < 4; ++j) { const int e = (j * 64 + F.lane) * 8; __builtin_nontemporal_store(R.x[j][0], (f32x4*)(xdst + e)); __builtin_nontemporal_store(R.x[j][1], (f32x4*)(xdst + e + 4)); }
    } else {
#pragma unroll
        for (int j = 0; j < 4; ++j) __builtin_nontemporal_store(pack8(R.x[j][0], R.x[j][1]), (u32x4*)(xbdst + (j * 64 + F.lane) * 8));
    }
    if (HAS_H) {
        float ss = 0.f;
#pragma unroll
        for (int j = 0; j < 4; ++j)
#pragma unroll
            for (int h = 0; h < 2; ++h) ss += (R.x[j][h].x * R.x[j][h].x + R.x[j][h].y * R.x[j][h].y) + (R.x[j][h].z * R.x[j][h].z + R.x[j][h].w * R.x[j][h].w);
        const float rs = rsqrtf(wave_sum(ss) * (1.f / D) + EPS);
#pragma unroll
        for (int j = 0; j < 4; ++j) { const int e = (j * 64 + F.lane) * 8;
            f32x4 o[2];
#pragma unroll
            for (int h = 0; h < 2; ++h) { const f32x4 g = *(const LAS f32x4*)(pv + 2 * 2048 + e + 4 * h), s1 = *(const LAS f32x4*)(pv + 3 * 2048 + e + 4 * h), s0 = *(const LAS f32x4*)(pv + 4 * 2048 + e + 4 * h); o[h] = R.x[j][h] * rs * g * (s1 + 1.f) + s0; }
            u32x4 w; w.x = cvt_pk_bf16(o[0].x, o[0].y); w.y = cvt_pk_bf16(o[0].z, o[0].w); w.z = cvt_pk_bf16(o[1].x, o[1].y); w.w = cvt_pk_bf16(o[1].z, o[1].w);
            *(u32x4*)(hrow + e) = w; }
    }
}
__device__ __forceinline__ int cond_of_row(int m) { return m < MP ? 0 : 1 + ((m - MP) >> 11); }
template <int MODE>
__device__ __forceinline__ void rowlocal_phase(const Frame& F, int l, float gs = 1.f) {
    constexpr bool HAS_F = MODE != 0, XF32 = MODE == 0, HAS_H = MODE != 3;
    const float* xp = inp<I_XP>(F); const float* xs = inp<I_XS>(F);
    const float* gpost = MODE == 1 ? inp<I_GPOM>(F) + (size_t)l * D : inp<I_GPOF>(F) + (size_t)l * D;
    const float* gpre = MODE == 0 ? inp<I_GPM>(F) : MODE == 1 ? inp<I_GPF>(F) + (size_t)l * D : inp<I_GPM>(F) + (size_t)(l + 1 < DEPTH ? l + 1 : l) * D;
    float* X = F.x(); bf16_t* XB = F.XB(); const bf16_t* Fb = F.Fb(); const float* FS = F.FSTAT(); bf16_t* H = F.H(); const float* MODb = F.MOD();
    LAS float* pv = (LAS float*)F.lds;
    { const int e = F.tid * 4;
      if (HAS_F) *(LAS f32x4*)(pv + 2048 + e) = *(const f32x4*)(gpost + e);
      if (HAS_H) *(LAS f32x4*)(pv + 2 * 2048 + e) = *(const f32x4*)(gpre + e); }
    constexpr int NITEM = M / 32;
    const int nit = F.bx < NITEM ? (NITEM - F.bx + F.G - 1) / F.G : 0, nq = 4 * nit;
    RowIn A, B;
    auto rowof = [&](int q) -> int { return (F.bx + (q >> 2) * F.G) * 32 + F.wave * 4 + (q & 3); };
    auto src = [&](int m) -> const float* { return m < MP ? xp + (size_t)m * D : xs + (size_t)(m - MP) * D; };
    if (nq > 0) { const int m = rowof(0); row_load<XF32, HAS_F>(F, A, src(m), XB + (size_t)m * D, Fb + (size_t)m * D, FS + (size_t)m * 32); }
    for (int q = 0; q < nq; q += 2) {
#pragma unroll
        for (int half = 0; half < 2; ++half) {
            const int qc = q + half, mc = rowof(qc);
            RowIn& cur = half ? B : A; RowIn& nxt = half ? A : B;
            if (qc + 1 < nq) { const int mn = rowof(qc + 1); row_load<XF32, HAS_F>(F, nxt, src(mn), XB + (size_t)mn * D, Fb + (size_t)mn * D, FS + (size_t)mn * 32); }
            if (half == 0 && (qc & 3) == 0) {
                const int item = F.bx + (qc >> 2) * F.G, ci = item < (MP / 32) ? 0 : 1 + ((item - MP / 32) >> 6), e = F.tid * 4;
                const float* modl = MODb + ((size_t)l * NCOND + ci) * 12288; const float* modn = MODb + ((size_t)(l + 1 < DEPTH ? l + 1 : l) * NCOND + ci) * 12288;
                __syncthreads();
                if (MODE == 1) *(LAS f32x4*)(pv + e) = *(const f32x4*)(modl + 2 * D + e);
                if (MODE >= 2) *(LAS f32x4*)(pv + e) = *(const f32x4*)(modl + 5 * D + e);
                if (MODE == 0) { *(LAS f32x4*)(pv + 3 * 2048 + e) = *(const f32x4*)(modl + 1 * D + e); *(LAS f32x4*)(pv + 4 * 2048 + e) = *(const f32x4*)(modl + 0 * D + e); }
                if (MODE == 1) { *(LAS f32x4*)(pv + 3 * 2048 + e) = *(const f32x4*)(modl + 4 * D + e); *(LAS f32x4*)(pv + 4 * 2048 + e) = *(const f32x4*)(modl + 3 * D + e); }
                if (MODE == 2) { *(LAS f32x4*)(pv + 3 * 2048 + e) = *(const f32x4*)(modn + 1 * D + e); *(LAS f32x4*)(pv + 4 * 2048 + e) = *(const f32x4*)(modn + 0 * D + e); }
                __syncthreads();
            }
            row_apply<XF32, HAS_F, HAS_H, MODE == 3>(F, cur, X + (size_t)mc * D, XB + (size_t)mc * D, pv, H + (size_t)mc * D, gs);
        }
    }
}
typedef float f32x2 __attribute__((ext_vector_type(2)));
__device__ __forceinline__ f32x2 sigm2(f32x2 x) { const f32x2 t = x * -1.4426950408889634f; const f32x2 e = (f32x2){__builtin_amdgcn_exp2f(t.x), __builtin_amdgcn_exp2f(t.y)} + 1.f; return (f32x2){__builtin_amdgcn_rcpf(e.x), __builtin_amdgcn_rcpf(e.y)}; }
__device__ __forceinline__ f32x2 gelu2(f32x2 x) { const f32x2 t = x * ((x * x) * -0.10294324f + -2.3022082f);
    const f32x2 e = (f32x2){__builtin_amdgcn_exp2f(t.x), __builtin_amdgcn_exp2f(t.y)} + 1.f; return x * (f32x2){__builtin_amdgcn_rcpf(e.x), __builtin_amdgcn_rcpf(e.y)}; }
__device__ __forceinline__ f32x4 gelu4(const f32x4& v) { const f32x2 a = gelu2((f32x2){v[0], v[1]}), b = gelu2((f32x2){v[2], v[3]}); return (f32x4){a.x, a.y, b.x, b.y}; }
__device__ __forceinline__ f32x4 sigm4(const f32x4& v) { const f32x2 a = sigm2((f32x2){v[0], v[1]}), b = sigm2((f32x2){v[2], v[3]}); return (f32x4){a.x, a.y, b.x, b.y}; }
__device__ __forceinline__ int kv_row(int m) { return m < MP ? m : MP + ((m - MP) >> 11) * 2304 + ((m - MP) & 2047); }
#ifndef Z_NT
#define Z_NT 0
#endif
#if Z_NT
#define ZSTORE(v, p) __builtin_nontemporal_store((v), (p))
#else
#define ZSTORE(v, p) (*(p) = (v))
#endif
#ifndef GATE_E
#define GATE_E 1
#endif
__device__ __forceinline__ f32x4 eplus4(const f32x4& x) { f32x4 r;
#pragma unroll
    for (int i = 0; i < 4; ++i) r[i] = __builtin_amdgcn_exp2f(__builtin_amdgcn_fmed3f(x[i], -30.f, 30.f) * -1.4426950408889634f) + 1.f;
    return r; }
struct EpiIn {
    static constexpr bool PERM = true, AFTER_DRAIN = false;
    __device__ __forceinline__ static bool keep(const Unit&) { return false; }
    bf16_t* Z; bf16_t* VALL; float* new_v; float* cvstat; int layer;
    __device__ __forceinline__ void operator()(const f32x4 (&acc)[2][2][4][2], const Unit& u, int wr, int wc, int fr, int fq) const {
        const int pn = u.pn, row0 = u.pm * 256 + wr * 64 + fr, cl = wc * 32 + 8 * fq;
        if (pn >= 10 && pn < 12) {
            const int colv = (pn - 10) * 256 + cl;
#pragma unroll
            for (int ai = 0; ai < 2; ++ai)
#pragma unroll
                for (int m = 0; m < 4; ++m) { const int row = row0 + ai * 128 + m * 16; bf16_t* dst = VALL + (size_t)kv_row(row) * 512 + colv;
#pragma unroll
                    for (int bj = 0; bj < 2; ++bj) { *(u32x4*)(dst + bj * 128) = pack8(acc[ai][bj][m][0], acc[ai][bj][m][1]);
                        if (row < MP) { float* nv = new_v + ((size_t)((row >> 8) * DEPTH + layer) * 256 + (row & 255)) * 512 + colv + bj * 128; *(f32x4*)nv = acc[ai][bj][m][0]; *(f32x4*)(nv + 4) = acc[ai][bj][m][1]; } } }
            return;
        }
        const int mode = (pn < 36) ? 0 : (pn < 44) ? 2 : 3;
        const int col0 = pn * 256 + cl;
#pragma unroll
        for (int ai = 0; ai < 2; ++ai)
#pragma unroll
            for (int m = 0; m < 4; ++m) { const int row = row0 + ai * 128 + m * 16; bf16_t* dst = Z + (size_t)row * INW + col0; float ss = 0.f;
#pragma unroll
                for (int bj = 0; bj < 2; ++bj) { f32x4 v0 = acc[ai][bj][m][0], v1 = acc[ai][bj][m][1];
                    if (mode == 1 || mode == 2) { v0 = gelu4(v0); v1 = gelu4(v1); }
#if GATE_E
                    if (mode == 3) { v0 = eplus4(v0); v1 = eplus4(v1); }
#endif
                    if (mode == 2) ss += (v0[0] * v0[0] + v0[1] * v0[1]) + (v0[2] * v0[2] + v0[3] * v0[3]) + (v1[0] * v1[0] + v1[1] * v1[1]) + (v1[2] * v1[2] + v1[3] * v1[3]);
                    ZSTORE(pack8(v0, v1), (u32x4*)(dst + bj * 128)); }
                if (mode == 2) { ss += __shfl_xor(ss, 16); ss += __shfl_xor(ss, 32); if (fq == 0) cvstat[(size_t)row * 32 + (pn - 36) * 4 + wc] = ss; } }
    }
};
struct EpiRelu2 {
    static constexpr bool PERM = true, AFTER_DRAIN = false;
    __device__ __forceinline__ static bool keep(const Unit&) { return false; }
    bf16_t* O; int ldc;
    __device__ __forceinline__ void operator()(const f32x4 (&acc)[2][2][4][2], const Unit& u, int wr, int wc, int fr, int fq) const {
        const int row0 = u.pm * 256 + wr * 64 + fr, col0 = u.pn * 256 + wc * 32 + 8 * fq;
#pragma unroll
        for (int ai = 0; ai < 2; ++ai)
#pragma unroll
            for (int m = 0; m < 4; ++m) { bf16_t* dst = O + (size_t)(row0 + ai * 128 + m * 16) * ldc + col0;
#pragma unroll
                for (int bj = 0; bj < 2; ++bj) { f32x4 v0 = __builtin_elementwise_max(acc[ai][bj][m][0], (f32x4){0.f, 0.f, 0.f, 0.f}), v1 = __builtin_elementwise_max(acc[ai][bj][m][1], (f32x4){0.f, 0.f, 0.f, 0.f});
                    *(u32x4*)(dst + bj * 128) = pack8(v0 * v0, v1 * v1); } }
    }
};
struct EpiF {
    static constexpr bool PERM = true, AFTER_DRAIN = false;
    __device__ __forceinline__ static bool keep(const Unit&) { return false; }
    bf16_t* O; float* stat;
    __device__ __forceinline__ void operator()(const f32x4 (&acc)[2][2][4][2], const Unit& u, int wr, int wc, int fr, int fq) const {
        const int row0 = u.pm * 256 + wr * 64 + fr, col0 = u.pn * 256 + wc * 32 + 8 * fq;
#pragma unroll
        for (int ai = 0; ai < 2; ++ai)
#pragma unroll
            for (int m = 0; m < 4; ++m) { const int row = row0 + ai * 128 + m * 16; bf16_t* dst = O + (size_t)row * D + col0; float ss = 0.f;
#pragma unroll
                for (int bj = 0; bj < 2; ++bj) { const f32x4 v0 = acc[ai][bj][m][0], v1 = acc[ai][bj][m][1];
                    ss += (v0[0] * v0[0] + v0[1] * v0[1]) + (v0[2] * v0[2] + v0[3] * v0[3]) + (v1[0] * v1[0] + v1[1] * v1[1]) + (v1[2] * v1[2] + v1[3] * v1[3]);
                    *(u32x4*)(dst + bj * 128) = pack8(v0, v1); }
                ss += __shfl_xor(ss, 16); ss += __shfl_xor(ss, 32); if (fq == 0) stat[(size_t)row * 32 + u.pn * 4 + wc] = ss; }
    }
};
#if GATE_E
__device__ __forceinline__ f32x4 negexp4(const u32x2& w) { return (f32x4){bflo(w.x), bfhi(w.x), bflo(w.y), bfhi(w.y)}; }
#else
__device__ __forceinline__ f32x4 negexp4(const u32x2& w) {
    const f32x4 x = {bflo(w.x), bfhi(w.x), bflo(w.y), bfhi(w.y)};
    f32x4 r;
#pragma unroll
    for (int i = 0; i < 4; ++i) r[i] = __builtin_amdgcn_exp2f(__builtin_amdgcn_fmed3f(x[i], -30.f, 30.f) * -1.4426950408889634f) + 1.f;
    return r;
}
#endif
__device__ __forceinline__ f32x4 rcp4(const f32x4& v) { return (f32x4){__builtin_amdgcn_rcpf(v[0]), __builtin_amdgcn_rcpf(v[1]), __builtin_amdgcn_rcpf(v[2]), __builtin_amdgcn_rcpf(v[3])}; }
struct EpiMerge {
    static constexpr bool PERM = true, AFTER_DRAIN = false;
    const bf16_t* Z; bf16_t* O;
    __device__ __forceinline__ static bool keep(const Unit& u) { return (u.pn >> 3) < 2; }
    __device__ __forceinline__ void operator()(f32x4 (&acc)[2][2][4][2], const Unit& u, int wr, int wc, int fr, int fq) const {
        const int br = u.pn >> 3, pn = u.pn & 7, pm = u.pm - 96 * br;
        const int rl0 = wr * 64 + fr, cl = wc * 32 + 8 * fq;
        const char* zb = (const char*)(Z + (size_t)(pm * 256) * INW + OFF_G + br * D + pn * 256);
        char* ob = (char*)(O + (size_t)(pm * 256) * D + pn * 256);
        unsigned lz = (unsigned)(rl0 * INW + cl) * 2u, lo = (unsigned)(rl0 * D + cl) * 2u;
        asm volatile("" : "+v"(lz), "+v"(lo));
        const bool last = br == 2;
        u32x4 ga[2][2], gb[2][2];
#pragma unroll
        for (int mm = 0; mm < 2; ++mm)
#pragma unroll
            for (int bj = 0; bj < 2; ++bj) { ga[mm][bj] = *(const u32x4*)(zb + (size_t)((mm * 16) * INW + bj * 128) * 2 + lz); gb[mm][bj] = ga[mm][bj];
                if (!last) gb[mm][bj] = *(const u32x4*)(zb + (size_t)((mm * 16) * INW + bj * 128 + D) * 2 + lz); }
#pragma unroll
        for (int st = 0; st < 4; ++st) {
            const int ai = st >> 1, mh = st & 1;
            u32x4 na[2][2], nb[2][2];
            if (st < 3) {
#pragma unroll
                for (int mm = 0; mm < 2; ++mm)
#pragma unroll
                    for (int bj = 0; bj < 2; ++bj) { const int ro = ((st + 1) >> 1) * 128 + (((st + 1) & 1) * 2 + mm) * 16; na[mm][bj] = *(const u32x4*)(zb + (size_t)(ro * INW + bj * 128) * 2 + lz); nb[mm][bj] = na[mm][bj];
                        if (!last) nb[mm][bj] = *(const u32x4*)(zb + (size_t)(ro * INW + bj * 128 + D) * 2 + lz); }
            }
#pragma unroll
            for (int mm = 0; mm < 2; ++mm)
#pragma unroll
                for (int bj = 0; bj < 2; ++bj) { const int m = mh * 2 + mm, ro = ai * 128 + m * 16; const u32x4 a = ga[mm][bj], b2 = gb[mm][bj];
                    const f32x4 ia0 = rcp4(negexp4((u32x2){a.x, a.y})), ia1 = rcp4(negexp4((u32x2){a.z, a.w}));
                    if (last) *(u32x4*)(ob + (size_t)(ro * D + bj * 128) * 2 + lo) = pack8(acc[ai][bj][m][0] * ia0, acc[ai][bj][m][1] * ia1);
                    else { acc[ai][bj][m][0] *= ia0 * negexp4((u32x2){b2.x, b2.y}); acc[ai][bj][m][1] *= ia1 * negexp4((u32x2){b2.z, b2.w}); } }
            if (st < 3) {
#pragma unroll
                for (int mm = 0; mm < 2; ++mm)
#pragma unroll
                    for (int bj = 0; bj < 2; ++bj) { ga[mm][bj] = na[mm][bj]; gb[mm][bj] = nb[mm][bj]; }
            }
        }
    }
};
struct MergeOrder {
    pg8::StaticOrder so;
    __device__ void init(int G, int c, int wgm) { so.init(M, D, G, c, wgm); }
    __device__ bool next(int i, Unit& u) const { const int br = i % 3; if (!so.next(i / 3, u)) return false; u.pm += 96 * br; u.pn += 8 * br; return true; }
    __device__ __forceinline__ void a_ready(const Unit&) const {}
    __device__ __forceinline__ void done(const Unit&) const {}
};
}
namespace fk {
typedef short bf16x8 __attribute__((ext_vector_type(8)));
struct PrepIn { u32x2 wa[1], wb[1]; f32x4 cs, sn; };
__device__ __forceinline__ void prep_geo(int m, bool& sample, int& b, int& t) { sample = m >= MP; if (!sample) { b = m >> 8; t = m & 255; } else { b = (m - MP) >> 11; t = (m - MP) & 2047; } }
__device__ __forceinline__ void prep_load(const Frame& F, PrepIn& R, int m, const bf16_t* Zb, const float* rope) {
    bool sample; int b, t; prep_geo(m, sample, b, t);
    const int lane = F.lane, j = lane & 7, axis = (lane >> 3) & 1, hsel = lane >> 4, dA = axis * 64 + 4 * j;
    const bf16_t* zrow = Zb + (size_t)m * INW;
    { const int base = OFF_K + hsel * 128 + dA; R.wa[0] = *(const u32x2*)(zrow + base); R.wb[0] = *(const u32x2*)(zrow + base + 32); }
    const int pos = sample ? (axis == 0 ? (t >> 6) : (t & 63)) : 0;
    R.cs = *(const f32x4*)(rope + pos * 32 + 4 * j); R.sn = *(const f32x4*)(rope + 2048 + pos * 32 + 4 * j);
}
__device__ __forceinline__ void prep_apply(const Frame& F, const PrepIn& R, int m, int l, bf16_t* Zb, bf16_t* KALL, float* new_k, const f32x4& gqa, const f32x4& gqb, const f32x4& gka, const f32x4& gkb) {
    bool sample; int b, t; prep_geo(m, sample, b, t);
    const int kvrow = sample ? MP + b * 2304 + t : m;
    const int lane = F.lane, j = lane & 7, axis = (lane >> 3) & 1, hsel = lane >> 4, dA = axis * 64 + 4 * j;
    bf16_t* zrow = Zb + (size_t)m * INW;
    {
        const u32x2 wa = R.wa[0], wb = R.wb[0];
        const f32x4 xa = {bflo(wa.x), bfhi(wa.x), bflo(wa.y), bfhi(wa.y)}, xb = {bflo(wb.x), bfhi(wb.x), bflo(wb.y), bfhi(wb.y)};
        float ss = (xa.x * xa.x + xa.y * xa.y) + (xa.z * xa.z + xa.w * xa.w) + (xb.x * xb.x + xb.y * xb.y) + (xb.z * xb.z + xb.w * xb.w);
        ss += __shfl_xor(ss, 1); ss += __shfl_xor(ss, 2); ss += __shfl_xor(ss, 4); ss += __shfl_xor(ss, 8);
        const float rs = rsqrtf(ss * (1.f / 128.f) + EPS);
        const f32x4 na = xa * rs * gka, nb = xb * rs * gkb;
        const f32x4 ra = na * R.cs - nb * R.sn, rb = na * R.sn + nb * R.cs;
        u32x2 oa, ob; oa.x = cvt_pk_bf16(ra.x, ra.y); oa.y = cvt_pk_bf16(ra.z, ra.w); ob.x = cvt_pk_bf16(rb.x, rb.y); ob.y = cvt_pk_bf16(rb.z, rb.w);
        bf16_t* kd = KALL + (size_t)kvrow * 512 + hsel * 128 + dA; *(u32x2*)kd = oa; *(u32x2*)(kd + 32) = ob;
        if (!sample) { float* nk = new_k + ((size_t)(b * DEPTH + l) * 256 + t) * 512 + hsel * 128 + dA; *(f32x4*)nk = na; *(f32x4*)(nk + 32) = nb; }
    }
}
__device__ __forceinline__ void prep_phase(const Frame& F, int l) {
    {
        bf16_t* Zb = F.Z(); bf16_t* KALL = F.KALL(); float* new_k = F.new_k(); const float* rope = F.ROPE();
        const int j = F.lane & 7, axis = (F.lane >> 3) & 1, dA = axis * 64 + 4 * j, dB = dA + 32;
        const float* gq = inp<I_GQ>(F) + l * 128; const float* gk = inp<I_GK>(F) + l * 128;
        const f32x4 gqa = *(const f32x4*)(gq + dA), gqb = *(const f32x4*)(gq + dB), gka = *(const f32x4*)(gk + dA), gkb = *(const f32x4*)(gk + dB);
        constexpr int NB = 6;
        for (int m = F.gw; m < M; m += NB * F.NGW) {
            PrepIn R[NB];
#pragma unroll
            for (int i = 0; i < NB; ++i) { const int mi = m + i * F.NGW; if (mi < M) prep_load(F, R[i], mi, Zb, rope); }
#pragma unroll
            for (int i = 0; i < NB; ++i) { const int mi = m + i * F.NGW; if (mi < M) prep_apply(F, R[i], mi, l, Zb, KALL, new_k, gqa, gqb, gka, gkb); }
        }
    }
    for (int it = F.gw; it < 2 * 8 * 256; it += 2 * F.NGW) {
        f32x4 a[2], c[2];
#pragma unroll
        for (int i = 0; i < 2; ++i) { const int ii = it + i * F.NGW; if (ii < 2 * 8 * 256) { const int which = ii >> 11, b = (ii >> 8) & 7, p = ii & 255;
            const float* src = (which ? inp<I_CV>(F) : inp<I_CK>(F)) + ((size_t)(b * DEPTH + l) * 256 + p) * 512 + F.lane * 8; a[i] = *(const f32x4*)src; c[i] = *(const f32x4*)(src + 4); } }
#pragma unroll
        for (int i = 0; i < 2; ++i) { const int ii = it + i * F.NGW; if (ii < 2 * 8 * 256) { const int which = ii >> 11, b = (ii >> 8) & 7, p = ii & 255;
            bf16_t* dst = (which ? F.VALL() : F.KALL()) + (size_t)(MP + b * 2304 + 2048 + p) * 512 + F.lane * 8; *(u32x4*)dst = pack8(a[i], c[i]); } }
    }
}
__device__ __forceinline__ int crow(int r, int hi) { return (r & 3) + 8 * (r >> 2) + 4 * hi; }
struct LruCtx {
    bf16x8 bw0[8], bw1[8];
    float bav, bxv, c8;
    bool small;
};
__device__ __forceinline__ void lru_ctx_load(const Frame& F, int l, int blk, LruCtx& X) {
    const int lane = F.lane, wave = F.wave, d = wave >> 2, n0 = (wave & 3) * 32, nl = lane & 31, hi = lane >> 5, C = blk * 128 + n0 + nl;
    const bf16_t* wb0 = F.WLRU() + ((size_t)((d * 2 + 0) * 16 + blk) * 128 + n0 + nl) * 128 + hi * 8;
    const bf16_t* wb1 = F.WLRU() + ((size_t)((d * 2 + 1) * 16 + blk) * 128 + n0 + nl) * 128 + hi * 8;
#pragma unroll
    for (int ks = 0; ks < 8; ++ks) { X.bw0[ks] = *(const bf16x8*)(wb0 + ks * 16); X.bw1[ks] = *(const bf16x8*)(wb1 + ks * 16); }
    X.bav = inp<I_LBA>(F)[(size_t)(l * 2 + d) * D + C]; X.bxv = inp<I_LBX>(F)[(size_t)(l * 2 + d) * D + C];
    const float lam = inp<I_LAM>(F)[(size_t)(l * 2 + d) * D + C];
    const float ex = __expf(-lam);
    const float sp = lam < -20.f ? -lam : ex < 0.05f ? ex * (1.f + ex * (-0.5f + ex * ((1.f / 3.f) + ex * (-0.25f + ex * 0.2f)))) : __logf(1.f + ex);
    X.c8 = -8.f * sp;
    X.small = __all(X.c8 > -0.5f);
}
struct LruGeo { int m0, b, t0, T; bool sample; };
__device__ __forceinline__ LruGeo lru_geo(int ck) { LruGeo g; g.m0 = ck * 64; g.sample = g.m0 >= MP;
    if (!g.sample) { g.b = g.m0 >> 8; g.t0 = g.m0 & 255; g.T = 256; } else { g.b = (g.m0 - MP) >> 11; g.t0 = (g.m0 - MP) & 2047; g.T = 2048; } return g; }
__device__ __forceinline__ void lru_taps_store(const Frame& F, int l, int blk) {
    const float* cwl = inp<I_CW>(F) + (size_t)l * 4 * D; const float* cbl = inp<I_CB>(F) + (size_t)l * D;
    for (int i = F.tid; i < 5 * 128; i += NWAVES * 64) { const int j = i >> 7, c = i & 127; *(LAS float*)(F.lds + LRU_TAPS + i * 4) = j < 4 ? cwl[(size_t)j * D + blk * 128 + c] : cbl[blk * 128 + c]; }
}
__device__ __forceinline__ void lru_conv_load(const Frame& F, u32x2 (&PF)[11], int t2, int ck, int blk) {
    const LruGeo G = lru_geo(ck); const int C0 = blk * 128; const bf16_t* Zb = F.Z();
    const int c4 = (t2 & 31) * 4, r0 = (t2 >> 5) * 8;
#pragma unroll
    for (int i = 0; i < 11; ++i) {
        const int tt = G.t0 + r0 + i - 2; u32x2 z = {0u, 0u};
        if (tt >= 0 && tt < G.T) z = *(const u32x2*)(Zb + (size_t)(G.m0 + r0 + i - 2) * INW + OFF_LX + C0 + c4);
        PF[i] = z;
    }
}
__device__ __forceinline__ void lru_conv_math(const Frame& F, const u32x2 (&PF)[11], int t2, int xc_off) {
    LAS unsigned char* lds = F.lds + xc_off; const int c4 = (t2 & 31) * 4, r0 = (t2 >> 5) * 8;
    const LAS float* tp = (const LAS float*)(F.lds + LRU_TAPS) + c4;
    const f32x4 w0 = *(const LAS f32x4*)tp, w1 = *(const LAS f32x4*)(tp + 128), w2 = *(const LAS f32x4*)(tp + 256), w3 = *(const LAS f32x4*)(tp + 384), bb = *(const LAS f32x4*)(tp + 512);
    f32x4 zr[11];
#pragma unroll
    for (int i = 0; i < 11; ++i) { const unsigned zx = PF[i].x, zy = PF[i].y; zr[i] = (f32x4){bflo(zx), bfhi(zx), bflo(zy), bfhi(zy)}; }
#pragma unroll
    for (int r = 0; r < 8; ++r) {
        const f32x4 y = bb + zr[r] * w0 + zr[r + 1] * w1 + zr[r + 2] * w2 + zr[r + 3] * w3;
        u32x2 o; o.x = cvt_pk_bf16(y.x, y.y); o.y = cvt_pk_bf16(y.z, y.w);
        *(LAS u32x2*)(lds + LRU_XC + (r0 + r) * LRU_XC_PITCH + c4 * 2) = o;
    }
}
__device__ __forceinline__ void split_arrive(unsigned* cnt) {
    asm volatile("s_waitcnt vmcnt(0)" ::: "memory");
    __syncthreads();
    if (threadIdx.x == 0) { __builtin_amdgcn_fence(__ATOMIC_RELEASE, "agent"); asm volatile("s_waitcnt vmcnt(0)" ::: "memory"); (void)xb_add(cnt, 1u); }
}
__device__ __forceinline__ void split_wait(unsigned* cnt, unsigned G, unsigned* tmo) {
    if (threadIdx.x == 0) {
        unsigned sp = 0;
        while (xb_ld(cnt) < G) { __builtin_amdgcn_s_sleep(1); if ((++sp & 255u) == 0u) { if (xb_ld(tmo)) break; if (sp > XB_SPIN_CAP) { atomicAdd(tmo, 1u); break; } } }
        __builtin_amdgcn_fence(__ATOMIC_ACQUIRE, "agent"); asm volatile("s_waitcnt vmcnt(0)" ::: "memory");
    }
    __syncthreads();
}
__device__ __forceinline__ float lru_gates(const Frame& F, int lane, int wave, const LruCtx& X, int xc_off, float carry) {
    typedef float f32x2 __attribute__((ext_vector_type(2)));
    LAS unsigned char* lds = F.lds;
    const int d = wave >> 2, n0 = (wave & 3) * 32, nl = lane & 31, hi = lane >> 5, c = n0 + nl;
    LAS float* Hd = (LAS float*)(lds + (d ? LRU_H1 : LRU_H0));
    const float bav = X.bav, bxv = X.bxv, c8 = X.c8;
    const int tau = 16 * ((nl >> 2) & 1) + 4 * (nl >> 3) + (nl & 3);
    const bool first = d == 0 ? hi == 0 : hi == 1;
    float cin_tile = carry;
#pragma unroll
    for (int step = 0; step < 2; ++step) {
        const int mt = d ? 1 - step : step;
        f32x16 acc0, acc1;
#pragma unroll
        for (int r = 0; r < 16; ++r) { acc0[r] = 0.f; acc1[r] = 0.f; }
        const LAS unsigned char* ap = lds + xc_off + (mt * 32 + tau) * LRU_XC_PITCH + hi * 16;
#pragma unroll
        for (int ks = 0; ks < 8; ++ks) {
            const bf16x8 a0 = *(const LAS bf16x8*)(ap + ks * 32);
            acc0 = __builtin_amdgcn_mfma_f32_32x32x16_bf16(a0, X.bw0[ks], acc0, 0, 0, 0);
            acc1 = __builtin_amdgcn_mfma_f32_32x32x16_bf16(a0, X.bw1[ks], acc1, 0, 0, 0);
        }
        float av[16], bv[16];
        const LAS unsigned char* xcp = lds + xc_off + (mt * 32 + 16 * hi) * LRU_XC_PITCH + c * 2;
        if (X.small) {
#pragma unroll
            for (int r = 0; r < 16; r += 2) {
                const f32x2 pa = (f32x2){acc0[r], acc0[r + 1]} + bav, px = (f32x2){acc1[r], acc1[r + 1]} + bxv;
                const f32x2 ta = pa * -1.4426950408889634f, tx = px * -1.4426950408889634f;
                const f32x2 ea = (f32x2){__builtin_amdgcn_exp2f(ta.x), __builtin_amdgcn_exp2f(ta.y)} + 1.f, ex = (f32x2){__builtin_amdgcn_exp2f(tx.x), __builtin_amdgcn_exp2f(tx.y)} + 1.f;
                const f32x2 rg = {__builtin_amdgcn_rcpf(ea.x), __builtin_amdgcn_rcpf(ea.y)};
                const f32x2 la = rg * c8;
                f32x2 p = la * (1.f / 720.f) + (1.f / 120.f); p = p * la + (1.f / 24.f); p = p * la + (1.f / 6.f); p = p * la + 0.5f; p = p * la + 1.f;
                const f32x2 e1 = la * p;
                const f32x2 omr = (e1 + 2.f) * e1;
                const f32x2 w = {fmaxf(-omr.x, 1e-30f), fmaxf(-omr.y, 1e-30f)};
                const f32x2 wq = w * ex * ex;
                const f32x2 sg = w * (f32x2){__builtin_amdgcn_rsqf(wq.x), __builtin_amdgcn_rsqf(wq.y)};
                const f32x2 xcv = {bf2f(*(const LAS unsigned short*)(xcp + r * LRU_XC_PITCH)), bf2f(*(const LAS unsigned short*)(xcp + (r + 1) * LRU_XC_PITCH))};
                const f32x2 a2 = e1 + 1.f, b2 = sg * xcv;
                av[r] = a2.x; av[r + 1] = a2.y; bv[r] = b2.x; bv[r + 1] = b2.y;
            }
        } else {
#pragma unroll
            for (int r = 0; r < 16; ++r) {
                const float rg = fsigm(acc0[r] + bav), ig = fsigm(acc1[r] + bxv);
                const float la = c8 * rg;
                av[r] = __expf(la);
                bv[r] = sqrtf(fmaxf(-expm1f(2.f * la), 0.f)) * ig * bf2f(*(const LAS unsigned short*)(xcp + r * LRU_XC_PITCH));
            }
        }
        float h = 0.f, Pp = 1.f;
        if (d == 0) {
#pragma unroll
            for (int r = 0; r < 16; ++r) { h = av[r] * h + bv[r]; Pp *= av[r]; bv[r] = h; av[r] = Pp; }
        } else {
#pragma unroll
            for (int r = 15; r >= 0; --r) { h = av[r] * h + bv[r]; Pp *= av[r]; bv[r] = h; av[r] = Pp; }
        }
        const float Po = __shfl_xor(Pp, 32), Eo = __shfl_xor(h, 32);
        const float P1 = first ? Pp : Po, E1 = first ? h : Eo, P2 = first ? Po : Pp, E2 = first ? Eo : h;
        const float cin = first ? cin_tile : P1 * cin_tile + E1;
        LAS float* hp = Hd + (mt * 32 + 16 * hi) * LRU_HP + c;
#pragma unroll
        for (int r = 0; r < 16; ++r) hp[r * LRU_HP] = bv[r] + av[r] * cin;
        cin_tile = P2 * (P1 * cin_tile + E1) + E2;
    }
    return cin_tile;
}
__device__ __forceinline__ void lru_out_lite(const Frame& F, int t2, int hsel, int ck, int blk) {
    const int row = t2 >> 2, c32 = (t2 & 3) * 32;
    const LAS float* h = (const LAS float*)(F.lds + (hsel ? LRU_H1 : LRU_H0)) + row * LRU_HP + c32;
    bf16_t* yp = F.BR() + (size_t)1 * M * D + (size_t)(ck * 64 + row) * D + blk * 128 + c32;
#pragma unroll
    for (int i = 0; i < 4; ++i) { const f32x4 a = *(const LAS f32x4*)(h + i * 8), b2 = *(const LAS f32x4*)(h + i * 8 + 4); *(u32x4*)(yp + i * 8) = pack8(a, b2); }
}
__device__ __forceinline__ void lru_out_full(const Frame& F, int t2, int hsel, int ck, int blk, const u32x4 (&gz)[4], const u32x4 (&pp)[4]) {
    const int row = t2 >> 2, c32 = (t2 & 3) * 32;
    const LAS float* h = (const LAS float*)(F.lds + (hsel ? LRU_H1 : LRU_H0)) + row * LRU_HP + c32;
    bf16_t* yp = F.BR() + (size_t)1 * M * D + (size_t)(ck * 64 + row) * D + blk * 128 + c32;
#pragma unroll
    for (int i = 0; i < 4; ++i) {
        const f32x4 a = *(const LAS f32x4*)(h + i * 8), b2 = *(const LAS f32x4*)(h + i * 8 + 4);
        const f32x4 g0 = gelu4((f32x4){bflo(gz[i].x), bfhi(gz[i].x), bflo(gz[i].y), bfhi(gz[i].y)}), g1 = gelu4((f32x4){bflo(gz[i].z), bfhi(gz[i].z), bflo(gz[i].w), bfhi(gz[i].w)});
        const f32x4 p0 = {bflo(pp[i].x), bfhi(pp[i].x), bflo(pp[i].y), bfhi(pp[i].y)}, p1 = {bflo(pp[i].z), bfhi(pp[i].z), bflo(pp[i].w), bfhi(pp[i].w)};
        *(u32x4*)(yp + i * 8) = pack8((a + p0) * g0, (b2 + p1) * g1);
    }
}
__device__ __forceinline__ void lru_chain(const Frame& F, int l, const LruCtx& X, int ck0, int N, bool sample, int b, int blk) {
    int tid0 = F.tid; asm volatile("" : "+v"(tid0));
    const int g0 = __builtin_amdgcn_readfirstlane(tid0 >> 8), C0 = blk * 128 + ((tid0 >> 6) & 3) * 32 + (tid0 & 31);
    float carry = 0.f;
    if (sample) carry = inp<I_SL>(F)[((size_t)(b * DEPTH + l) * 2 + g0) * D + C0];
    u32x2 PF[11];
    { u32x2 P0[11]; lru_conv_load(F, P0, tid0 & 255, ck0 + (g0 ? N - 1 : 0), blk); lru_conv_math(F, P0, tid0 & 255, g0 ? LRU_XCB : 0); }
    lru_conv_load(F, PF, tid0 & 255, ck0 + (g0 ? N - 2 : 1), blk);
    __syncthreads();
    for (int s = 0, par = 0; s < N; ++s, par ^= 1) {
        int tid_ = F.tid; asm volatile("" : "+v"(tid_));
        const int tid = tid_, lane = tid & 63, wave = __builtin_amdgcn_readfirstlane(tid >> 6), g = wave >> 2, t2 = tid & 255;
        const int xb = g ? LRU_XCB : 0;
        const int cj = g ? N - 1 - s : s, co = g ? s : N - 1 - s;
        const bool full = s >= (N >> 1);
        u32x4 gz[4] = {{0u, 0u, 0u, 0u}, {0u, 0u, 0u, 0u}, {0u, 0u, 0u, 0u}, {0u, 0u, 0u, 0u}}, pp[4] = {{0u, 0u, 0u, 0u}, {0u, 0u, 0u, 0u}, {0u, 0u, 0u, 0u}, {0u, 0u, 0u, 0u}};
        if (full) {
            const size_t mrow = (size_t)((ck0 + cj) * 64 + (t2 >> 2)); const int cc = blk * 128 + (t2 & 3) * 32;
            const bf16_t* gp = F.Z() + mrow * INW + OFF_LG + cc; const bf16_t* pq = F.BR() + (size_t)1 * M * D + mrow * D + cc;
#pragma unroll
            for (int i = 0; i < 4; ++i) { gz[i] = *(const u32x4*)(gp + i * 8); pp[i] = *(const u32x4*)(pq + i * 8); }
        }
        if (s + 1 < N) lru_conv_math(F, PF, t2, xb + (par ^ 1) * LRU_XCSZ);
        if (s + 2 < N) lru_conv_load(F, PF, t2, ck0 + (g ? N - 3 - s : s + 2), blk);
        carry = lru_gates(F, lane, wave, X, xb + par * LRU_XCSZ, carry);
        __syncthreads();
        if (full) lru_out_full(F, t2, g, ck0 + cj, blk, gz, pp); else lru_out_lite(F, t2, 1 - g, ck0 + co, blk);
        __syncthreads();
    }
    if (!sample && (tid0 & 32) == 0) F.new_s()[((size_t)(b * DEPTH + l) * 2 + g0) * D + C0] = carry;
}
#ifndef LRU_CM_N1
#define LRU_CM_N1 3
#endif
__device__ __forceinline__ void lru_chain_phase(const Frame& F, int l) {
    LruCtx X; int cur = -1;
    const bool fast = F.G == 256; const int grp = F.bx >> 4;
    for (int k = 0; ; ++k) {
        int id;
        if (fast) { if (k >= (grp < 8 ? 1 : 4)) break; id = grp < 8 ? F.bx : 128 + ((grp - 8) * 4 + k) * 16 + (F.bx & 15); }
        else { id = F.bx + k * F.G; if (id >= 640) break; }
        const int blk = id & 15; const bool sample = id < 128; const int b = sample ? id >> 4 : (id - 128) >> 4;
        if (blk != cur) { lru_ctx_load(F, l, blk, X); lru_taps_store(F, l, blk); cur = blk; __syncthreads(); }
        lru_chain(F, l, X, sample ? 128 + b * 32 : b * 4, sample ? 32 : 4, sample, b, blk);
    }
}
constexpr int CM_V = 0, CM_OUT = 32768, CM_OUT_PITCH = 528, CM_RS2 = CM_OUT + 128 * CM_OUT_PITCH;
static_assert(CM_RS2 + 512 <= MISC_OFF, "cm lds map");
struct CmCtx { bf16x8 wa[8]; f32x4 ga, gb; };
__device__ __forceinline__ void cm_ctx_load(const Frame& F, int g, CmCtx& X, const float* __restrict__ cmg) {
    const int qt = F.wave & 3, xl = F.lane & 31, hi = F.lane >> 5;
    const bf16_t* wp = F.CMW() + ((size_t)g * 128 + qt * 32 + xl) * 128 + hi * 8;
#pragma unroll
    for (int i = 0; i < 8; ++i) X.wa[i] = *(const bf16x8*)(wp + i * 16);
    const int sc = (F.tid & 15) * 8;
    X.ga = *(const f32x4*)(cmg + g * 128 + sc); X.gb = *(const f32x4*)(cmg + g * 128 + sc + 4);
}
struct CmPre { u32x4 v[4]; float2 st[4]; };
__device__ __forceinline__ void cm_prefetch(const Frame& F, CmPre& R, int tid, int cn, int g) {
    const int sr = tid >> 4, q16 = tid & 15, sc = q16 * 8, m0 = cn * 128;
    const bf16_t* Zb = F.Z(); const float* ST = F.CVSTAT();
#pragma unroll
    for (int i = 0; i < 4; ++i) { const int p = (i >> 1) * 64 + (i & 1) * 32 + sr;
        R.v[i] = *(const u32x4*)(Zb + (size_t)(m0 + p) * INW + OFF_CV + g * 128 + sc);
        R.st[i] = *(const float2*)(ST + (size_t)(m0 + p) * 32 + q16 * 2); }
}
__device__ __forceinline__ void cm_stage(const Frame& F, const CmPre& R, const CmCtx& X, int tid) {
    LAS unsigned char* lds = F.lds; const int sr = tid >> 4, sc = (tid & 15) * 8;
#pragma unroll
    for (int i = 0; i < 4; ++i) {
        float s = R.st[i].x + R.st[i].y;
        s += __shfl_xor(s, 1); s += __shfl_xor(s, 2); s += __shfl_xor(s, 4); s += __shfl_xor(s, 8);
        const float rs = rsqrtf(s * (1.f / D) + EPS);
        const u32x4 w = R.v[i];
        const f32x4 v0 = (f32x4){bflo(w.x), bfhi(w.x), bflo(w.y), bfhi(w.y)} * X.ga * rs, v1 = (f32x4){bflo(w.z), bfhi(w.z), bflo(w.w), bfhi(w.w)} * X.gb * rs;
        *(LAS u32x4*)(lds + CM_V + (i >> 1) * 16384 + att::v_st((i & 1) * 32 + sr, sc)) = pack8(v0, v1);
    }
}
__device__ __forceinline__ void cm_mfma(const Frame& F, const CmCtx& X, int lane, int wave) {
    LAS unsigned char* lds = F.lds;
    const int qt = wave & 3, chh = wave >> 2, xl = lane & 31, hi = lane >> 5;
    f32x16 o0, o1;
#pragma unroll
    for (int r = 0; r < 16; ++r) { o0[r] = 0.f; o1[r] = 0.f; }
    const int vb = (int)(unsigned)(uintptr_t)(lds + CM_V) + att::v_rd_base(lane);
    if (chh == 0) {
        att::pv_one<0>(o0, vb, X.wa[0], X.wa[1], X.wa[2], X.wa[3]); att::pv_one<1>(o1, vb, X.wa[0], X.wa[1], X.wa[2], X.wa[3]);
        att::pv_one<0>(o0, vb + 16384, X.wa[4], X.wa[5], X.wa[6], X.wa[7]); att::pv_one<1>(o1, vb + 16384, X.wa[4], X.wa[5], X.wa[6], X.wa[7]);
    } else {
        att::pv_one<2>(o0, vb, X.wa[0], X.wa[1], X.wa[2], X.wa[3]); att::pv_one<3>(o1, vb, X.wa[0], X.wa[1], X.wa[2], X.wa[3]);
        att::pv_one<2>(o0, vb + 16384, X.wa[4], X.wa[5], X.wa[6], X.wa[7]); att::pv_one<3>(o1, vb + 16384, X.wa[4], X.wa[5], X.wa[6], X.wa[7]);
    }
#pragma unroll
    for (int r = 0; r < 16; ++r) { const int q = qt * 32 + crow(r, hi);
        *(LAS float*)(lds + CM_OUT + q * CM_OUT_PITCH + (chh * 64 + xl) * 4) = o0[r];
        *(LAS float*)(lds + CM_OUT + q * CM_OUT_PITCH + (chh * 64 + 32 + xl) * 4) = o1[r]; }
}
__device__ __forceinline__ void cm_epilogue(const Frame& F, int tid, int cn, int g, const float* __restrict__ bsg, const u32x4 (&uw)[4]) {
    LAS unsigned char* lds = F.lds; const int q = tid >> 2, c32 = (tid & 3) * 32, m0 = cn * 128; const float bias = bsg[q];
    bf16_t* op = F.BR() + (size_t)2 * M * D + (size_t)(m0 + q) * D + g * 128 + c32;
#pragma unroll
    for (int i = 0; i < 4; ++i) {
        const f32x4 a = *(const LAS f32x4*)(lds + CM_OUT + q * CM_OUT_PITCH + (c32 + i * 8) * 4), b2 = *(const LAS f32x4*)(lds + CM_OUT + q * CM_OUT_PITCH + (c32 + i * 8 + 4) * 4);
        const f32x4 u0 = gelu4((f32x4){bflo(uw[i].x), bfhi(uw[i].x), bflo(uw[i].y), bfhi(uw[i].y)}), u1 = gelu4((f32x4){bflo(uw[i].z), bfhi(uw[i].z), bflo(uw[i].w), bfhi(uw[i].w)});
        *(u32x4*)(op + i * 8) = pack8(u0 * (a + bias), u1 * (b2 + bias));
    }
}
__device__ __forceinline__ bool cm_unit(const Frame& F, int i, int& cn, int& g) {
    if (F.G == 256) {
        const int grp = F.bx >> 4; g = F.bx & 15;
        if (grp < 8) { cn = grp + 8 * i; return i < LRU_CM_N1; }
        cn = 8 * LRU_CM_N1 + (grp - 8) + 8 * i; return i < 24 - LRU_CM_N1;
    }
    const int u = F.bx + i * F.G; cn = u >> 4; g = u & 15; return u < 192 * 16;
}
__device__ __forceinline__ void cm_phase(const Frame& F, int l) {
    CmCtx X; int cur = -1;
    const float* cmg = inp<I_CMG>(F) + (size_t)l * D; const float* bs = inp<I_CMBS>(F) + (size_t)l * 16 * 128;
    int cn, g;
    bool have = cm_unit(F, 0, cn, g);
    if (have) { cm_ctx_load(F, g, X, cmg); cur = g; CmPre R; cm_prefetch(F, R, F.tid, cn, g); cm_stage(F, R, X, F.tid); }
    __syncthreads();
    for (int i = 0; have; ++i) {
        int tid_ = F.tid; asm volatile("" : "+v"(tid_));
        const int tid = tid_, lane = tid & 63, wave = __builtin_amdgcn_readfirstlane(tid >> 6);
        int cnn, gn; const bool nxt = cm_unit(F, i + 1, cnn, gn);
        CmPre R;
        if (nxt) cm_prefetch(F, R, tid, cnn, gn);
        u32x4 uw[4];
        { const bf16_t* up = F.Z() + (size_t)(cn * 128 + (tid >> 2)) * INW + OFF_CU + g * 128 + (tid & 3) * 32;
#pragma unroll
          for (int i2 = 0; i2 < 4; ++i2) uw[i2] = *(const u32x4*)(up + i2 * 8); }
        cm_mfma(F, X, lane, wave);
        __syncthreads();
        cm_epilogue(F, tid, cn, g, bs + g * 128, uw);
        if (nxt) { if (gn != cur) { cm_ctx_load(F, gn, X, cmg); cur = gn; } cm_stage(F, R, X, tid); }
        __syncthreads();
        have = nxt; cn = cnn; g = gn;
    }
}
__device__ __forceinline__ void attn_phase(const Frame& F, int l) {
    char* lds = (char*)F.lds;
    const float* gq = inp<I_GQ>(F) + l * 128; const float* rope = F.ROPE();
    const att::bf16* Z = (const att::bf16*)F.Z(); const att::bf16* K = (const att::bf16*)F.KALL(); const att::bf16* V = (const att::bf16*)F.VALL(); att::bf16* O = (att::bf16*)F.BR();
    for (int id = F.vcu; id < 1536; id += F.G) {
        size_t qrow, kvrow; int h, nkeys, t0;
        if (id < 1024) { const int qb = id & 7, b = id >> 7; h = (id >> 3) & 15; qrow = (size_t)MP + (size_t)b * 2048 + qb * 256; kvrow = (size_t)MP + (size_t)b * 2304; nkeys = 2304; t0 = qb * 256; }
        else { const int id2 = id - 1024, b = id2 >> 4; h = id2 & 15; qrow = (size_t)b * 256; kvrow = qrow; nkeys = 256; t0 = 0; }
        att::attn_dense_body<att::bf16>(Z + qrow * INW + OFF_Q + h * 128, K + kvrow * 512 + (h >> 2) * 128, V + kvrow * 512 + (h >> 2) * 128, O + qrow * D + h * 128, nkeys, lds, gq, id < 1024 ? rope : (const float*)nullptr, t0);
    }
    __syncthreads();
}
}
#ifndef REP_G
#define REP_G 1
#endif
#ifndef REP_A
#define REP_A 1
#endif
#ifndef REP_L
#define REP_L 1
#endif
#ifndef REP_V
#define REP_V 1
#endif
#ifndef REP_R
#define REP_R 1
#endif
#ifndef REP_GSEL
#define REP_GSEL 0
#endif
#ifndef REP_B
#define REP_B 1
#endif
#ifndef PG_ALIGN
#define PG_ALIGN true
#endif
#ifndef PG_SP2
#define PG_SP2 true
#endif
#ifndef WGM_IN
#define WGM_IN 4
#endif
#ifndef WGM_N8
#define WGM_N8 4
#endif
#ifndef WGM_F1
#define WGM_F1 4
#endif
#ifndef WGM_F2
#define WGM_F2 4
#endif
#ifndef WGM_MG
#define WGM_MG 4
#endif
#ifndef STAMP_SEL
#define STAMP_SEL 0
#endif
#ifndef STAMP_Q
#define STAMP_Q 20000
#endif
#ifndef REP_C
#define REP_C 1
#endif
namespace fk {
#if REP_G > 1 || REP_GSEL > 0
template <class Base> struct RepOrder {
    Base b; int n;
    __device__ void init_n() { Unit u; n = 0; while (b.next(n, u)) ++n; }
    __device__ bool next(int i, Unit& u) const { if (i >= 2 * n) return false; return b.next(i >= n ? i - n : i, u); }
    __device__ __forceinline__ void a_ready(const Unit&) const {}
    __device__ __forceinline__ void done(const Unit&) const {}
};
#define GEMM_REP(EPI, ORD, g, S, E) do { RepOrder<ORD> RS_; RS_.b = S; RS_.init_n(); pg8::gemm_phase<EPI, RepOrder<ORD>, PG_ALIGN, PG_SP2>(P.lds, g, RS_, E); } while (0)
#endif
#define GEMM_ONE(EPI, ORD, g, S, E) pg8::gemm_phase<EPI, ORD, PG_ALIGN, PG_SP2>(P.lds, g, S, E)
#if REP_G > 1
#define GEMM_CALL(ID, EPI, ORD, g, S, E) GEMM_REP(EPI, ORD, g, S, E)
#elif REP_GSEL > 0
#define GEMM_CALL(ID, EPI, ORD, g, S, E) do { if (ID == REP_GSEL) GEMM_REP(EPI, ORD, g, S, E); else GEMM_ONE(EPI, ORD, g, S, E); } while (0)
#else
#define GEMM_CALL(ID, EPI, ORD, g, S, E) GEMM_ONE(EPI, ORD, g, S, E)
#endif
__global__ void __launch_bounds__(NWAVES * 64, 2) mega(Params p) {
    extern __shared__ __attribute__((aligned(16))) unsigned char lds_raw[];
    Frame F;
    F.lds = (LAS unsigned char*)lds_raw;
    F.tid = threadIdx.x; F.lane = F.tid & 63; F.wave = __builtin_amdgcn_readfirstlane(F.tid >> 6);
    F.G = gridDim.x; { const int bx = blockIdx.x; F.vcu = (F.G % 8 == 0) ? (bx % 8) * (F.G / 8) + bx / 8 : bx; }
    F.gw = F.vcu * NWAVES + F.wave; F.NGW = F.G * NWAVES; F.bx = blockIdx.x;
    F.out = p.out; F.ws = p.ws; F.ka = (kaptr_t)__builtin_amdgcn_kernarg_segment_ptr();
    unsigned char* ws = p.ws;
    volatile LAS unsigned* MISC = (volatile LAS unsigned*)(F.lds + MISC_OFF);
    for (int u = F.tid; u < (LDS_BYTES - MISC_OFF) / 4; u += NWAVES * 64) ((LAS unsigned*)(F.lds + MISC_OFF))[u] = 0u;
    __syncthreads();
    unsigned* barw = (unsigned*)(ws + WS_CTL) + CW_BAR + p.li * XCD_BAR_WORDS;
    XcdBarrier bar = xcd_barrier_post(barw, MISC + 8);
    const int lo = p.ph_lo, hi = p.ph_hi;
    unsigned long long bar_ticks = 0;
#define IN_PH(k) (lo <= (k) && (k) < hi)
#if REP_B > 1
#define SEAM(k) do { if ((k) + 1 < hi) { xcd_barrier(bar); xcd_barrier(bar); } } while (0)
#else
#if defined(STAMP_BLOCK)
#define SEAM(k) do { if ((k) + 1 < hi) { const unsigned long long t0_ = __builtin_amdgcn_s_memrealtime(); xcd_barrier(bar); const int kk_ = ((k) - 3) % 9; const bool isg_ = (k) >= 3 && (kk_ == 0 || kk_ == 3 || kk_ == 4 || kk_ == 6 || kk_ == 7); if (STAMP_SEL == 0 || (STAMP_SEL == 1 && isg_) || (STAMP_SEL == 2 && !isg_)) bar_ticks += __builtin_amdgcn_s_memrealtime() - t0_; } } while (0)
#else
#define SEAM(k) do { if ((k) + 1 < hi) xcd_barrier(bar); } while (0)
#endif
#endif

    if (IN_PH(0)) { const Frame P = phase_frame(F);
convert_layer(P, 0, 0, P.gw, P.NGW); mod_partials(P); rope_table(P);
#if REP_V > 1
        __syncthreads(); convert_layer(P, 0, 0, P.gw, P.NGW); mod_partials(P);
#endif
 SEAM(0); }
    if (IN_PH(1)) { const Frame P = phase_frame(F); mod_reduce(P); SEAM(1); }
    if (IN_PH(2)) { const Frame P = phase_frame(F); rowlocal_phase<0>(P, 0); SEAM(2); }
    for (int l = 0; l < DEPTH; ++l) {
        const int pb = 3 + 9 * l;
        if (IN_PH(pb + 0)) { const Frame P = phase_frame(F);
            pg8::Gemm g{P.H(), P.WIN(), M, INW, D}; pg8::StaticOrder S; S.init(M, INW, P.G, P.bx, WGM_IN);
            EpiIn E{P.Z(), P.VALL(), P.new_v(), P.CVSTAT(), l};

GEMM_CALL(1, EpiIn, pg8::StaticOrder, g, S, E);
            {
                const int rem = ((M / 256) * (INW / 256)) % P.G;
                __syncthreads();
                if (rem == 0 || P.bx >= rem) convert_layer(P, l, 1, rem == 0 ? P.gw : (P.bx - rem) * NWAVES + P.wave, rem == 0 ? P.NGW : (P.G - rem) * NWAVES);
            }
            SEAM(pb + 0);
        }
        if (IN_PH(pb + 1)) { const Frame P = phase_frame(F);
            lru_chain_phase(P, l);
#if REP_L > 1
            lru_chain_phase(P, l);
#endif
            prep_phase(P, l);
            __syncthreads();
            cm_phase(P, l);
#if REP_C > 1
            cm_phase(P, l);
#endif
            SEAM(pb + 1);
        }
        if (IN_PH(pb + 2)) { const Frame P = phase_frame(F);
            attn_phase(P, l);
#if REP_A > 1
            attn_phase(P, l);
#endif
            SEAM(pb + 2);
        }
        if (IN_PH(pb + 3)) { const Frame P = phase_frame(F);
            pg8::Gemm g{P.BR(), P.WBR(), 3 * M, 3 * D, D}; MergeOrder S; S.init(P.G, P.bx, WGM_MG);
            EpiMerge E{P.Z(), P.H()};

GEMM_CALL(2, EpiMerge, MergeOrder, g, S, E);

            SEAM(pb + 3);
        }
        if (IN_PH(pb + 4)) { const Frame P = phase_frame(F);
            pg8::Gemm g{P.H(), P.WOUT(), M, D, D}; pg8::StaticOrder S; S.init(M, D, P.G, P.bx, WGM_N8);
            EpiF E{P.Fb(), P.FSTAT()};

GEMM_CALL(3, EpiF, pg8::StaticOrder, g, S, E);
            SEAM(pb + 4);

        }
        if (IN_PH(pb + 5)) { const Frame P = phase_frame(F);

#if REP_R > 1
            rowlocal_phase<1>(P, l, 0.f);
#endif
            rowlocal_phase<1>(P, l);
 SEAM(pb + 5); }
        if (IN_PH(pb + 6)) { const Frame P = phase_frame(F);
            pg8::Gemm g{P.H(), P.WFF1(), M, DFF, D}; pg8::StaticOrder S; S.init(M, DFF, P.G, P.bx, WGM_F1);
            EpiRelu2 E{P.FFH(), DFF};

GEMM_CALL(4, EpiRelu2, pg8::StaticOrder, g, S, E);

            SEAM(pb + 6);
        }
        if (IN_PH(pb + 7)) { const Frame P = phase_frame(F);
            pg8::Gemm g{P.FFH(), P.WFF2(), M, D, DFF}; pg8::StaticOrder S; S.init(M, D, P.G, P.bx, WGM_F2);
            EpiF E{P.Fb(), P.FSTAT()};

GEMM_CALL(5, EpiF, pg8::StaticOrder, g, S, E);
            SEAM(pb + 7);

        }
        if (IN_PH(pb + 8)) { const Frame P = phase_frame(F);


#if REP_R > 1
            if (l + 1 < DEPTH) rowlocal_phase<2>(P, l, 0.f);
#endif
            if (l + 1 < DEPTH) rowlocal_phase<2>(P, l); else rowlocal_phase<3>(P, l);


if (l + 1 < DEPTH) { __syncthreads(); convert_layer(P, l + 1, 0, P.gw, P.NGW); }
#if REP_V > 1
            if (l + 1 < DEPTH) { __syncthreads(); convert_layer(P, l + 1, 0, P.gw, P.NGW); }
#endif

            SEAM(pb + 8);
        }
    }
#if defined(STAMP_BLOCK)
    if ((int)blockIdx.x == STAMP_BLOCK && threadIdx.x == 0) { __builtin_amdgcn_s_waitcnt(0); p.out[(size_t)STAMP_BLOCK * 32 * 2048] = (float)(((bar_ticks + STAMP_Q / 2) / STAMP_Q) * STAMP_Q); }
#endif
#undef IN_PH
#undef SEAM
}
}
extern "C" void kernel_launch(void* const* d_in, const int* in_sizes, int n_in, void* d_out, int out_size, void* d_ws, size_t ws_size, hipStream_t stream) {
    static int grid = 0;
    if (grid == 0) {
        if (n_in != 32 || out_size != 84410368 || ws_size < fk::WS_END) { fprintf(stderr, "kernel_launch: unexpected shapes: n_in %d out %d ws %zu (need %zu)\n", n_in, out_size, ws_size, (size_t)fk::WS_END); grid = -1; return; }
        int dev = 0, cus = 0;
        if (hipGetDevice(&dev) != hipSuccess || hipDeviceGetAttribute(&cus, hipDeviceAttributeMultiprocessorCount, dev) != hipSuccess) { grid = -1; return; }
        if (hipFuncSetAttribute((const void*)fk::mega, hipFuncAttributeMaxDynamicSharedMemorySize, fk::LDS_BYTES) != hipSuccess) { fprintf(stderr, "kernel_launch: hipFuncSetAttribute failed\n"); grid = -1; return; }
        int per_cu = 0;
        if (hipOccupancyMaxActiveBlocksPerMultiprocessor(&per_cu, (const void*)fk::mega, fk::NWAVES * 64, fk::LDS_BYTES) != hipSuccess || per_cu < 1) fprintf(stderr, "kernel_launch: occupancy query says %d blocks per CU\n", per_cu);
        (void)hipGetLastError();
        grid = cus < 256 ? cus : 256;
    }
    if (grid < 0) return;
    (void)hipMemsetAsync((char*)d_ws + fk::WS_CTL, 0, fk::CTL_ZERO_BYTES, stream);
    fk::Params p{};
    for (int i = 0; i < 32; ++i) p.in[i] = (const float*)d_in[i];
    p.out = (float*)d_out; p.ws = (unsigned char*)d_ws; p.ph_lo = 0; p.ph_hi = fk::NPHASE; p.li = 0; p.pad = 0;
    hipLaunchKernelGGL(fk::mega, dim3(grid), dim3(fk::NWAVES * 64), fk::LDS_BYTES, stream, p);
}
```

```cpp
#include <hip/hip_runtime.h>
#include <hip/hip_bf16.h>
#include <cstdio>
#include <cstdint>
namespace pg8 {
#define PG8_LAS __attribute__((address_space(3)))
typedef unsigned short bf16_t;
typedef short bf16x8 __attribute__((ext_vector_type(8)));
typedef float f32x4 __attribute__((ext_vector_type(4)));
typedef unsigned u32x4 __attribute__((ext_vector_type(4)));
constexpr int BM = 256, BK = 64, HALF = 128, HTB = HALF * BK * 2  , STAGE_BYTES = 8 * HTB, NXCD = 8, WGM = 4;

__host__ __device__ __forceinline__ int lds_byte(int r, int c) { const int st = (r >> 4) * 2 + (c >> 5), rr = r & 15, cc = c & 31, ob = rr * 64 + cc * 2; return st * 1024 + (ob ^ (((ob >> 9) & 1) << 5)); }
__host__ __device__ __forceinline__ void stage_rc(int b, int& R, int& C) { const int st = b / 1024, sb = b % 1024, swz = sb ^ (((sb >> 9) & 1) << 5); R = (st >> 1) * 16 + swz / 64; C = (st & 1) * 32 + (swz % 64) / 2; }
__host__ __device__ __forceinline__ int perm32(int rho) { const int n = rho >> 4, i = rho & 15; return 8 * (i >> 2) + 4 * n + (i & 3); }

struct Unit { int pm, pn; };
struct Gemm { const bf16_t* A; const bf16_t* Bt; int M, N, K; };

struct StaticOrder {
    int nM, nN, nwg, G, c, wgm;
    __host__ __device__ void init(int M, int N, int G_, int c_, int wgm_ = WGM) { nM = M / BM; nN = N / BM; nwg = nM * nN; G = G_; c = c_; wgm = wgm_; }
    __host__ __device__ bool next(int i, Unit& u) const {
        const long L = (long)i * G + c; if (L >= nwg) return false;
        int wgid = (int)L; { const int q = nwg / NXCD, r = nwg % NXCD, xcd = wgid % NXCD, off = wgid / NXCD; wgid = (xcd < r ? xcd * (q + 1) : r * (q + 1) + (xcd - r) * q) + off; }
        const int nig = wgm * nN, gid = wgid / nig, fm = gid * wgm, gsz = (nM - fm) < wgm ? (nM - fm) : wgm;
        u.pm = fm + ((wgid % nig) % gsz); u.pn = (wgid % nig) / gsz; return true;
    }
    __device__ __forceinline__ void a_ready(const Unit&) const {}
    __device__ __forceinline__ void done(const Unit&) const {}
};
__device__ __forceinline__ unsigned cvt_pk_bf16(float lo, float hi) { unsigned r; asm volatile("v_cvt_pk_bf16_f32 %0, %1, %2" : "=v"(r) : "v"(lo), "v"(hi)); return r; }
template <class Epi, class Sched, bool ALIGN_EPI = false, bool SP2 = false>
__device__ __forceinline__ void gemm_phase(PG8_LAS unsigned char* lds, const Gemm g, const Sched& S, const Epi& E) {
    int tid_ = threadIdx.x; asm volatile("" : "+v"(tid_));
    const int tid = tid_, wid = __builtin_amdgcn_readfirstlane(tid >> 6), lane = tid & 63, wr = wid >> 2, wc = wid & 3, fr = lane & 15, fq = lane >> 4;
    const int K = g.K, nt = K / BK;
    unsigned voffA[2], voffB[2];
#pragma unroll
    for (int i = 0; i < 2; ++i) { int R, C; stage_rc(tid * 16 + i * 8192, R, C); const int Rb = Epi::PERM ? ((R & ~31) + perm32(R & 31)) : R;
        voffA[i] = (unsigned)(R * K + C) * 2u; voffB[i] = (unsigned)(Rb * K + C) * 2u; }
    const size_t kstep = (size_t)(BK * 2);
    const size_t hstep = (size_t)HALF * K * 2;
    const size_t tstep = 2 * hstep;
    const unsigned ldsw = (unsigned)wid * 1024u;
    const int aoff = lds_byte(wr * 64 + fr, fq * 8), boff = lds_byte(wc * 32 + fr, fq * 8);
#define PG8_SA(b, h) (((b) * 2 + (h)) * HTB)
#define PG8_SB(b, h) ((4 + (b) * 2 + (h)) * HTB)
#define PG8_STAGE(bufoff, gbase, voff) do { _Pragma("unroll") for (int _i = 0; _i < 2; ++_i) \
        __builtin_amdgcn_global_load_lds((const unsigned*)((const char*)(gbase) + (voff)[_i]), (PG8_LAS unsigned*)(lds + (bufoff) + ldsw + _i * 8192), 16, 0, 0); } while (0)
#define PG8_LDA(dst, b, h) do { _Pragma("unroll") for (int m = 0; m < 4; ++m) _Pragma("unroll") for (int k = 0; k < 2; ++k) dst[m][k] = *(const PG8_LAS bf16x8*)(lds + PG8_SA(b, h) + aoff + m * 2048 + k * 1024); } while (0)
#define PG8_LDB(dst, b, h) do { _Pragma("unroll") for (int n = 0; n < 2; ++n) _Pragma("unroll") for (int k = 0; k < 2; ++k) dst[n][k] = *(const PG8_LAS bf16x8*)(lds + PG8_SB(b, h) + boff + n * 2048 + k * 1024); } while (0)
#define PG8_MMA(ai, bj, At, Bt) do { __builtin_amdgcn_s_setprio(1); _Pragma("unroll") for (int m = 0; m < 4; ++m) _Pragma("unroll") for (int n = 0; n < 2; ++n) _Pragma("unroll") for (int k = 0; k < 2; ++k) \
        acc[ai][bj][m][n] = __builtin_amdgcn_mfma_f32_16x16x32_bf16(Bt[n][k], At[m][k], acc[ai][bj][m][n], 0, 0, 0); __builtin_amdgcn_s_setprio(0); } while (0)
#define PG8_WAIT_V(n) asm volatile("s_waitcnt vmcnt(" #n ")" ::: "memory")
#define PG8_WAIT_L(n) asm volatile("s_waitcnt lgkmcnt(" #n ")" ::: "memory")
#define PG8_BAR __builtin_amdgcn_s_barrier()
#define PG8_SCHED __builtin_amdgcn_sched_barrier(0)
    Unit cur, nxt; int ui = 0;
    if (!S.next(0, cur)) return;
    f32x4 acc[2][2][4][2];
#pragma unroll
    for (int a = 0; a < 2; ++a)
#pragma unroll
        for (int b = 0; b < 2; ++b)
#pragma unroll
            for (int m = 0; m < 4; ++m)
#pragma unroll
                for (int n = 0; n < 2; ++n) acc[a][b][m][n] = (f32x4){0.f, 0.f, 0.f, 0.f};
    bf16x8 At[4][2], B0[2][2], B1[2][2];
    const char* cA = (const char*)g.A + (size_t)cur.pm * tstep; const char* cB = (const char*)g.Bt + (size_t)cur.pn * tstep;
    S.a_ready(cur);
    if constexpr (SP2) {
        PG8_STAGE(PG8_SB(0, 0), cB, voffB); PG8_STAGE(PG8_SB(0, 1), cB + hstep, voffB); PG8_STAGE(PG8_SA(0, 0), cA, voffA); PG8_STAGE(PG8_SA(0, 1), cA + hstep, voffA);
        if (wr == 1) PG8_BAR;
        PG8_WAIT_V(2); PG8_BAR;
        PG8_STAGE(PG8_SB(1, 0), cB + kstep, voffB); PG8_STAGE(PG8_SA(1, 0), cA + kstep, voffA); PG8_STAGE(PG8_SB(1, 1), cB + hstep + kstep, voffB);
        PG8_WAIT_V(6); PG8_BAR;
    } else {
        PG8_STAGE(PG8_SB(0, 0), cB, voffB); PG8_STAGE(PG8_SA(0, 0), cA, voffA); PG8_STAGE(PG8_SB(0, 1), cB + hstep, voffB); PG8_STAGE(PG8_SA(0, 1), cA + hstep, voffA);
        if (wr == 1) PG8_BAR;
        PG8_WAIT_V(4); PG8_BAR;
        PG8_STAGE(PG8_SB(1, 0), cB + kstep, voffB); PG8_STAGE(PG8_SA(1, 0), cA + kstep, voffA); PG8_STAGE(PG8_SB(1, 1), cB + hstep + kstep, voffB);
        PG8_WAIT_V(6); PG8_BAR;
    }
    for (;;) {
        const bool has_next = S.next(ui + 1, nxt);
        const char* nA = has_next ? (const char*)g.A + (size_t)nxt.pm * tstep : cA; const char* nB = has_next ? (const char*)g.Bt + (size_t)nxt.pn * tstep : cB;
        for (int t = 0; t < nt; t += 2) {
            const bool last = (t == nt - 2);
            const char* a1 = cA + (size_t)(t + 1) * kstep;
            const char* a2 = last ? nA : cA + (size_t)(t + 2) * kstep; const char* b2 = last ? nB : cB + (size_t)(t + 2) * kstep;
            const char* a3 = a2 + kstep; const char* b3 = b2 + kstep;
            if (last && has_next) S.a_ready(nxt);
            if constexpr (SP2) {
            PG8_LDB(B0, 0, 0); PG8_LDB(B1, 0, 1); PG8_SCHED; PG8_LDA(At, 0, 0); PG8_STAGE(PG8_SA(1, 1), a1 + hstep, voffA);
            PG8_WAIT_V(8); PG8_WAIT_L(0); PG8_BAR; PG8_MMA(0, 0, At, B0); PG8_MMA(0, 1, At, B1); PG8_BAR; PG8_SCHED;
            PG8_LDA(At, 0, 1); PG8_STAGE(PG8_SB(0, 0), b2, voffB); PG8_STAGE(PG8_SB(0, 1), b2 + hstep, voffB); PG8_STAGE(PG8_SA(0, 0), a2, voffA);
            PG8_WAIT_V(8); PG8_WAIT_L(0); PG8_BAR; PG8_MMA(1, 0, At, B0); PG8_MMA(1, 1, At, B1); PG8_BAR; PG8_SCHED;
            PG8_LDB(B0, 1, 0); PG8_LDB(B1, 1, 1); PG8_SCHED; PG8_LDA(At, 1, 0); PG8_STAGE(PG8_SA(0, 1), a2 + hstep, voffA);
            PG8_WAIT_V(8); PG8_WAIT_L(0); PG8_BAR; PG8_MMA(0, 0, At, B0); PG8_MMA(0, 1, At, B1); PG8_BAR; PG8_SCHED;
            PG8_LDA(At, 1, 1); PG8_STAGE(PG8_SB(1, 0), b3, voffB); PG8_STAGE(PG8_SB(1, 1), b3 + hstep, voffB); PG8_STAGE(PG8_SA(1, 0), a3, voffA);
            PG8_WAIT_V(8); PG8_WAIT_L(0); PG8_BAR; PG8_MMA(1, 0, At, B0); PG8_MMA(1, 1, At, B1); PG8_BAR; PG8_SCHED;
            } else {
            PG8_LDB(B0, 0, 0); PG8_SCHED; PG8_LDA(At, 0, 0); PG8_STAGE(PG8_SA(1, 1), a1 + hstep, voffA);
            PG8_WAIT_L(8); PG8_BAR; PG8_WAIT_L(0); PG8_MMA(0, 0, At, B0); PG8_BAR; PG8_SCHED;
            PG8_LDB(B1, 0, 1); PG8_STAGE(PG8_SB(0, 0), b2, voffB);
            PG8_BAR; PG8_WAIT_L(0); PG8_MMA(0, 1, At, B1); PG8_BAR;
            PG8_LDA(At, 0, 1); PG8_STAGE(PG8_SA(0, 0), a2, voffA);
            PG8_BAR; PG8_WAIT_L(0); PG8_MMA(1, 0, At, B0); PG8_BAR; PG8_SCHED;
            PG8_STAGE(PG8_SB(0, 1), b2 + hstep, voffB);
            PG8_WAIT_V(6); PG8_BAR; PG8_MMA(1, 1, At, B1); PG8_BAR;
            PG8_LDB(B0, 1, 0); PG8_SCHED; PG8_LDA(At, 1, 0); PG8_STAGE(PG8_SA(0, 1), a2 + hstep, voffA);
            PG8_WAIT_L(8); PG8_BAR; PG8_WAIT_L(0); PG8_MMA(0, 0, At, B0); PG8_BAR; PG8_SCHED;
            PG8_LDB(B1, 1, 1); PG8_STAGE(PG8_SB(1, 0), b3, voffB);
            PG8_BAR; PG8_WAIT_L(0); PG8_MMA(0, 1, At, B1); PG8_BAR;
            PG8_LDA(At, 1, 1); PG8_STAGE(PG8_SA(1, 0), a3, voffA);
            PG8_BAR; PG8_WAIT_L(0); PG8_MMA(1, 0, At, B0); PG8_BAR; PG8_SCHED;
            PG8_STAGE(PG8_SB(1, 1), b3 + hstep, voffB);
            PG8_WAIT_V(6); PG8_BAR; PG8_MMA(1, 1, At, B1); PG8_BAR;
            }
        }
        if constexpr (ALIGN_EPI) { if (wr == 0) PG8_BAR; }
        if constexpr (!Epi::AFTER_DRAIN) { E(acc, cur, wr, wc, fr, fq); S.done(cur); }
        if (!has_next) break;
        if (!Epi::keep(cur)) {
#pragma unroll
        for (int a = 0; a < 2; ++a)
#pragma unroll
            for (int b = 0; b < 2; ++b)
#pragma unroll
                for (int m = 0; m < 4; ++m)
#pragma unroll
                    for (int n = 0; n < 2; ++n) acc[a][b][m][n] = (f32x4){0.f, 0.f, 0.f, 0.f};
        }
        cur = nxt; cA = nA; cB = nB; ++ui;
        if constexpr (ALIGN_EPI) { if (wr == 1) PG8_BAR; }
    }
    PG8_WAIT_V(0);
    if constexpr (!ALIGN_EPI) { if (wr == 0) PG8_BAR; }
    PG8_BAR;
    if constexpr (Epi::AFTER_DRAIN) { E.fused(acc, cur, wr, wc, fr, fq, lds, wid, lane); S.done(cur); }
#undef PG8_SA
#undef PG8_SB
#undef PG8_STAGE
#undef PG8_LDA
#undef PG8_LDB
#undef PG8_MMA
#undef PG8_WAIT_V
#undef PG8_WAIT_L
#undef PG8_BAR
#undef PG8_SCHED
}
}
#define GAS __attribute__((address_space(1)))
#define LAS __attribute__((address_space(3)))
typedef unsigned short bf16;
typedef unsigned v4u __attribute__((ext_vector_type(4)));
typedef float f32x4 __attribute__((ext_vector_type(4)));
typedef short bf16x8 __attribute__((ext_vector_type(8)));
typedef GAS unsigned gu32;
typedef GAS unsigned long long gu64;
#define RLX_AGENT __ATOMIC_RELAXED, __HIP_MEMORY_SCOPE_AGENT
#define LDS_WAIT() asm volatile("s_waitcnt lgkmcnt(0)" ::: "memory")
#define VM_WAIT() asm volatile("s_waitcnt vmcnt(0)" ::: "memory")
__device__ __forceinline__ unsigned long long rt() { return __builtin_amdgcn_s_memrealtime(); }
__device__ __forceinline__ unsigned f2bf(float f) { unsigned u = __builtin_bit_cast(unsigned, f); return (u + 0x7fffu + ((u >> 16) & 1u)) >> 16; }
__device__ __forceinline__ unsigned pk2(float lo, float hi) { return f2bf(lo) | (f2bf(hi) << 16); }

#define XB_TMO      128
#define XB_XCNT(j)  (256  + 64 * (j))
#define XB_XSUB(j)  (1280 + 64 * (j))
#define XB_XGEN(j)  (2304 + 64 * (j))
#define XB_TOP      3328
#define XB_TOPGEN   3392
#define XCD_BAR_WORDS 3456
#define XB_SPIN_CAP (1u << 18)

__device__ __forceinline__ unsigned xb_ld(unsigned* p)              { return __hip_atomic_load(p, __ATOMIC_RELAXED, __HIP_MEMORY_SCOPE_AGENT); }
__device__ __forceinline__ unsigned xb_add(unsigned* p, unsigned v) { return __hip_atomic_fetch_add(p, v, __ATOMIC_RELAXED, __HIP_MEMORY_SCOPE_AGENT); }
__device__ __forceinline__ unsigned xb_xcc_id() { return (unsigned)__builtin_amdgcn_s_getreg((3 << 11) | 20) & 0xFu; }
#define XB_SPIN(cond, bar) do { unsigned _sp = 0; while (cond) { __builtin_amdgcn_s_sleep(1); \
    if ((++_sp & 255u) == 0u) { if (xb_ld(&(bar)[XB_TMO])) break; if (_sp > XB_SPIN_CAP) { atomicAdd(&(bar)[XB_TMO], 1u); break; } } } } while (0)

struct XcdBarrier {
    unsigned* bar; unsigned x;
    volatile LAS unsigned* st;
};

__device__ __forceinline__ XcdBarrier xcd_barrier_post(unsigned* bar, volatile LAS unsigned* st) {
    XcdBarrier b; b.bar = bar; b.x = xb_xcc_id(); b.st = st;
    if (threadIdx.x == 0) (void)xb_add(&bar[XB_XCNT(b.x)], 1u);
    return b;
}
__device__ __forceinline__ void xcd_barrier_complete(unsigned* bar, unsigned x, unsigned& nloc, unsigned& nx) {
    const unsigned G = gridDim.x * gridDim.y * gridDim.z;
    unsigned sum, cnt, mine, sp = 0u;
    for (;;) {
        sum = 0u; cnt = 0u; mine = 0u;
#pragma unroll
        for (unsigned j = 0; j < 16; ++j) { const unsigned c = xb_ld(&bar[XB_XCNT(j)]); sum += c; cnt += (c > 0u) ? 1u : 0u; mine = (j == x) ? c : mine; }
        if (sum == G) break;
        __builtin_amdgcn_s_sleep(1);
        if ((++sp & 255u) == 0u) { if (xb_ld(&bar[XB_TMO])) break; if (sp > XB_SPIN_CAP) { atomicAdd(&bar[XB_TMO], 1u); break; } }
    }
    nloc = mine > 0u ? mine : 1u; nx = cnt > 0u ? cnt : 1u;
}

__device__ __forceinline__ void xcd_barrier(const XcdBarrier& b) {
    asm volatile("s_waitcnt vmcnt(0)" ::: "memory");
    __syncthreads();
    if (threadIdx.x == 0) {
        unsigned* bar = b.bar;
        __builtin_amdgcn_s_waitcnt(0);
        unsigned nloc = b.st[0], nx = b.st[1];
        if (nloc == 0u) { xcd_barrier_complete(bar, b.x, nloc, nx); b.st[0] = nloc; b.st[1] = nx; }
        const unsigned old = xb_add(&bar[XB_XSUB(b.x)], 1u);
        const unsigned gen = old / nloc;
        if (old + 1u == (gen + 1u) * nloc) {
            __builtin_amdgcn_fence(__ATOMIC_RELEASE, "agent");
            asm volatile("s_waitcnt vmcnt(0)" ::: "memory");
            const unsigned og = xb_add(&bar[XB_TOP], 1u);
            const unsigned tg = og / nx;
            if (og + 1u == (tg + 1u) * nx) xb_add(&bar[XB_TOPGEN], 1u);
            else XB_SPIN(xb_ld(&bar[XB_TOPGEN]) == tg, bar);
            __builtin_amdgcn_fence(__ATOMIC_ACQUIRE, "agent");
            xb_add(&bar[XB_XGEN(b.x)], 1u);
            asm volatile("s_waitcnt vmcnt(0)" ::: "memory");
        } else {
            XB_SPIN(xb_ld(&bar[XB_XGEN(b.x)]) == gen, bar);
            __builtin_amdgcn_fence(__ATOMIC_ACQUIRE, "agent");
            asm volatile("s_waitcnt vmcnt(0)" ::: "memory");
        }
    }
    __syncthreads();
}
namespace att {
constexpr int   D = 128, NW = 8, QBLK = 32, KVBLK = 64;
constexpr float SCALE = 0.088388347648318440f;
constexpr float THR = 8.f;
constexpr int SDEPTH = 2;
constexpr int LDQ = 17408, LDK = 512, LDO = 2048;
constexpr size_t SHM_V = KVBLK * D * 2, SHM_K = KVBLK * D * 2, SHM_ATTN = 2 * SHM_V + 2 * SHM_K + NW * 64 * 4;
using bf16 = __hip_bfloat16;
using bf16x8 = __attribute__((ext_vector_type(8))) short;
using s16x4  = __attribute__((ext_vector_type(4))) short;
using f32x16 = __attribute__((ext_vector_type(16))) float;
using f32x8  = __attribute__((ext_vector_type(8))) float;
using u32x4  = __attribute__((ext_vector_type(4))) unsigned;
#define KSWZ(row, colB) ((row) * 256 + ((colB) ^ (((row) & 7) << 4)))
#define SBAR() __builtin_amdgcn_sched_barrier(0)
__device__ __forceinline__ int crow(int r, int hi) { return (r & 3) + 8 * (r >> 2) + 4 * hi; }
__device__ __forceinline__ unsigned cvtpk(float lo, float hi) {
  unsigned r; asm volatile("v_cvt_pk_bf16_f32 %0, %1, %2" : "=v"(r) : "v"(lo), "v"(hi)); return r;
}
template <typename TIn> struct Stage;
template <> struct Stage<bf16>  { using T = bf16x8;
  __device__ static __forceinline__ T ld8(const bf16* p) { return *reinterpret_cast<const bf16x8*>(p); }
  __device__ static __forceinline__ bf16x8 tobf(T x) { return x; } };
template <> struct Stage<float> { using T = f32x8;
  __device__ static __forceinline__ T ld8(const float* p) { return *reinterpret_cast<const f32x8*>(p); }
  __device__ static __forceinline__ bf16x8 tobf(T x) {
    u32x4 w = {cvtpk(x[0], x[1]), cvtpk(x[2], x[3]), cvtpk(x[4], x[5]), cvtpk(x[6], x[7])}; return *reinterpret_cast<bf16x8*>(&w); } };

__device__ __forceinline__ void partialSM(f32x16& p0, f32x16& p1, float& m_reg, float& mn, float& alpha) {
  constexpr float C = SCALE * 1.4426950408889634f;
  float pmax = p0[0]; for (int r = 1; r < 16; ++r) pmax = fmaxf(pmax, p0[r]); for (int r = 0; r < 16; ++r) pmax = fmaxf(pmax, p1[r]);
  { auto rr = __builtin_amdgcn_permlane32_swap(__float_as_uint(pmax), __float_as_uint(pmax), false, false);
    pmax = fmaxf(__uint_as_float(rr[0]), __uint_as_float(rr[1])); }
  if (__builtin_expect(__all(pmax - m_reg <= THR / SCALE), 1)) { mn = m_reg; alpha = 1.f; }
  else { mn = fmaxf(m_reg, pmax); alpha = __builtin_amdgcn_exp2f((m_reg - mn) * C); m_reg = mn; }
  float mnC = -mn * C;
  for (int r = 0; r < 16; ++r) p0[r] = fmaf(p0[r], C, mnC); for (int r = 0; r < 16; ++r) p1[r] = fmaf(p1[r], C, mnC);
  for (int r = 0; r < 16; ++r) p0[r] = __builtin_amdgcn_exp2f(p0[r]);
}
__device__ __forceinline__ void finishSM(f32x16& p0, f32x16& p1, float alpha, float& l_reg, bf16x8& pa0, bf16x8& pa1, bf16x8& pa2, bf16x8& pa3) {
  for (int r = 0; r < 16; ++r) p1[r] = __builtin_amdgcn_exp2f(p1[r]);
  float ps = 0; for (int r = 0; r < 16; ++r) ps += p0[r]; for (int r = 0; r < 16; ++r) ps += p1[r];
  { auto rr = __builtin_amdgcn_permlane32_swap(__float_as_uint(ps), __float_as_uint(ps), false, false);
    ps = __uint_as_float(rr[0]) + __uint_as_float(rr[1]); }
  l_reg = l_reg * alpha + ps;
#define PK4(P, BASE, OUT) do { unsigned a0 = cvtpk(P[BASE + 0], P[BASE + 1]), a1 = cvtpk(P[BASE + 2], P[BASE + 3]);   \
    unsigned b0 = cvtpk(P[BASE + 4], P[BASE + 5]), b1 = cvtpk(P[BASE + 6], P[BASE + 7]);                              \
    auto r0 = __builtin_amdgcn_permlane32_swap(a0, b0, false, false); auto r1 = __builtin_amdgcn_permlane32_swap(a1, b1, false, false); \
    u32x4 w = {r0[0], r1[0], r0[1], r1[1]}; OUT = *reinterpret_cast<bf16x8*>(&w); } while (0)
  PK4(p0, 0, pa0); PK4(p0, 8, pa1); PK4(p1, 0, pa2); PK4(p1, 8, pa3);
#undef PK4
}
__device__ __forceinline__ void qkt(f32x16& p0, f32x16& p1, const bf16* Ks, const bf16x8* qr, int r32, int hi) {
  p0 = f32x16{}; p1 = f32x16{};
  for (int d0 = 0; d0 < 8; ++d0) { int cb = (d0 * 16 + hi * 8) * 2;
    bf16x8 b0 = *reinterpret_cast<const bf16x8*>((const char*)Ks + KSWZ(r32, cb));
    bf16x8 b1 = *reinterpret_cast<const bf16x8*>((const char*)Ks + KSWZ(32 + r32, cb));
    p0 = __builtin_amdgcn_mfma_f32_32x32x16_bf16(b0, qr[d0], p0, 0, 0, 0);
    p1 = __builtin_amdgcn_mfma_f32_32x32x16_bf16(b1, qr[d0], p1, 0, 0, 0); }
}
__device__ __forceinline__ int v_st(int k, int c) { const int kk = (k & ~0xC) | ((k & 4) << 1) | ((k & 8) >> 1); return ((kk >> 3) * 4 + (c >> 5)) * 512 + ((kk & 7) * 32 + (c & 31)) * 2; }
__device__ __forceinline__ int v_rd_base(int lane) { return ((lane & 3) << 3) | (((lane >> 2) & 3) << 6) | (((lane >> 4) & 1) << 5) | (((lane >> 5) & 1) << 8); }
constexpr int v_rd_off(int d0, int ks, int half) { return d0 * 512 + ks * 4096 + half * 2048; }
template <int OFF> __device__ __forceinline__ s16x4 tr_read(int vb) {
  s16x4 r; asm volatile("ds_read_b64_tr_b16 %0, %1 offset:%2" : "=&v"(r) : "v"(vb), "i"(OFF) : "memory"); return r;
}
template <int D0> __device__ __forceinline__ void pv_one(f32x16& od, int vb, bf16x8 pa0, bf16x8 pa1, bf16x8 pa2, bf16x8 pa3) {
  const s16x4 l0 = tr_read<v_rd_off(D0, 0, 0)>(vb), h0 = tr_read<v_rd_off(D0, 0, 1)>(vb), l1 = tr_read<v_rd_off(D0, 1, 0)>(vb), h1 = tr_read<v_rd_off(D0, 1, 1)>(vb);
  const s16x4 l2 = tr_read<v_rd_off(D0, 2, 0)>(vb), h2 = tr_read<v_rd_off(D0, 2, 1)>(vb), l3 = tr_read<v_rd_off(D0, 3, 0)>(vb), h3 = tr_read<v_rd_off(D0, 3, 1)>(vb);
  asm volatile("s_waitcnt lgkmcnt(0)" ::: "memory"); SBAR();
#define PK(L, H) (bf16x8){L[0], L[1], L[2], L[3], H[0], H[1], H[2], H[3]}
  od = __builtin_amdgcn_mfma_f32_32x32x16_bf16(pa0, PK(l0, h0), od, 0, 0, 0);
  od = __builtin_amdgcn_mfma_f32_32x32x16_bf16(pa1, PK(l1, h1), od, 0, 0, 0);
  od = __builtin_amdgcn_mfma_f32_32x32x16_bf16(pa2, PK(l2, h2), od, 0, 0, 0);
  od = __builtin_amdgcn_mfma_f32_32x32x16_bf16(pa3, PK(l3, h3), od, 0, 0, 0);
#undef PK
}
__device__ __forceinline__ void pv_d0(f32x16* o, int vb, bf16x8 pa0, bf16x8 pa1, bf16x8 pa2, bf16x8 pa3) {
  pv_one<0>(o[0], vb, pa0, pa1, pa2, pa3); pv_one<1>(o[1], vb, pa0, pa1, pa2, pa3); pv_one<2>(o[2], vb, pa0, pa1, pa2, pa3); pv_one<3>(o[3], vb, pa0, pa1, pa2, pa3);
}

template <typename TQ>
__device__ __forceinline__ void attn_dense_body(const TQ* __restrict__ Qb, const bf16* __restrict__ Kh, const bf16* __restrict__ Vh,
                                                bf16* __restrict__ Ob, int seq, char* lds, const float* __restrict__ gq, const float* __restrict__ rope, int t0) {
  using St = Stage<bf16>; using SQ = Stage<TQ>;
  int tid_ = threadIdx.x; asm volatile("" : "+v"(tid_));
  const int tid = tid_, wid = tid >> 6, lane = tid & 63, r32 = lane & 31, hi = lane >> 5;
  bf16* V_lds = (bf16*)lds; bf16* K_lds = (bf16*)(lds + 2 * SHM_V);
  float* ws = (float*)(lds + 2 * SHM_V + 2 * SHM_K) + wid * 64; float* li_l = ws; float* al_l = ws + 32;
  float m_reg = -1e30f, l_reg = 0; f32x16 o[4] = {}; bf16x8 qr[8];
  const TQ* Qw = Qb + (long)(wid * QBLK + r32) * LDQ + hi * 8;
#pragma unroll
  for (int d0 = 0; d0 < 8; ++d0) qr[d0] = SQ::tobf(SQ::ld8(Qw + d0 * 16));
  {
    typedef float f32x4q __attribute__((ext_vector_type(4)));
    float qf[8][8]; float ss = 0.f;
#pragma unroll
    for (int d0 = 0; d0 < 8; ++d0)
#pragma unroll
      for (int j = 0; j < 8; ++j) { const float v = __uint_as_float(((unsigned)(unsigned short)qr[d0][j]) << 16); qf[d0][j] = v; ss += v * v; }
    ss += __shfl_xor(ss, 32);
    const float rs = rsqrtf(ss * (1.f / 128.f) + 1e-6f);
#pragma unroll
    for (int d0 = 0; d0 < 8; ++d0) { const f32x4q g0 = *(const f32x4q*)(gq + d0 * 16 + hi * 8), g1 = *(const f32x4q*)(gq + d0 * 16 + hi * 8 + 4);
#pragma unroll
      for (int j = 0; j < 4; ++j) { qf[d0][j] *= rs * g0[j]; qf[d0][4 + j] *= rs * g1[j]; } }
    if (rope) {
      const int t = t0 + wid * QBLK + r32;
#pragma unroll
      for (int ax = 0; ax < 2; ++ax) { const int pos = ax == 0 ? (t >> 6) : (t & 63);
#pragma unroll
        for (int e = 0; e < 2; ++e) { const int da = ax * 4 + e, db = da + 2; const float* cp = rope + pos * 32 + e * 16 + hi * 8;
          const f32x4q c0 = *(const f32x4q*)cp, c1 = *(const f32x4q*)(cp + 4), s0 = *(const f32x4q*)(cp + 2048), s1 = *(const f32x4q*)(cp + 2048 + 4);
#pragma unroll
          for (int j = 0; j < 8; ++j) { const float c = j < 4 ? c0[j & 3] : c1[j & 3], sn = j < 4 ? s0[j & 3] : s1[j & 3]; const float xa = qf[da][j], xb = qf[db][j]; qf[da][j] = xa * c - xb * sn; qf[db][j] = xa * sn + xb * c; } } }
    }
#pragma unroll
    for (int d0 = 0; d0 < 8; ++d0) { u32x4 w = {cvtpk(qf[d0][0], qf[d0][1]), cvtpk(qf[d0][2], qf[d0][3]), cvtpk(qf[d0][4], qf[d0][5]), cvtpk(qf[d0][6], qf[d0][7])}; qr[d0] = *reinterpret_cast<bf16x8*>(&w); }
  }
  const int sr = tid >> 4, sc = (tid & 15) * 8, vst0 = v_st(sr, sc), vst1 = v_st(32 + sr, sc);
  const int vb0 = (int)(uintptr_t)V_lds + v_rd_base(lane);
  struct { typename St::T vs0, vs1, ks0, ks1; } sr_[SDEPTH];
#define SLOAD(i, k0) do { sr_[i].vs0 = St::ld8(&Vh[(long)((k0) + sr) * LDK + sc]); sr_[i].vs1 = St::ld8(&Vh[(long)((k0) + 32 + sr) * LDK + sc]); \
    sr_[i].ks0 = St::ld8(&Kh[(long)((k0) + sr) * LDK + sc]); sr_[i].ks1 = St::ld8(&Kh[(long)((k0) + 32 + sr) * LDK + sc]); } while (0)
#define SWRITE(b, i) do { *(bf16x8*)((char*)V_lds + (b) * SHM_V + vst0) = St::tobf(sr_[i].vs0);          \
    *(bf16x8*)((char*)V_lds + (b) * SHM_V + vst1) = St::tobf(sr_[i].vs1); int kc = sc * 2;               \
    *(bf16x8*)((char*)K_lds + (b) * SHM_K + KSWZ(sr, kc)) = St::tobf(sr_[i].ks0);                       \
    *(bf16x8*)((char*)K_lds + (b) * SHM_K + KSWZ(32 + sr, kc)) = St::tobf(sr_[i].ks1); } while (0)
#define SWAIT() do { if constexpr (SDEPTH == 2) asm volatile("s_waitcnt vmcnt(4)" ::: "memory"); else asm volatile("s_waitcnt vmcnt(0)" ::: "memory"); } while (0)
#define RESC(a) do { if (__any((a) < 1.f)) { if (hi == 0) al_l[r32] = (a); asm volatile("s_waitcnt lgkmcnt(0)" ::: "memory"); \
    for (int d = 0; d < 4; ++d) for (int r = 0; r < 16; ++r) o[d][r] *= al_l[crow(r, hi)]; } } while (0)
  f32x16 pA0, pA1, pB0, pB1; float mnA, mnB, alA, alB; bf16x8 pa0, pa1, pa2, pa3; const int NT = seq / KVBLK;
  constexpr int SE = 0, SO = SDEPTH - 1;
  SLOAD(SE, 0); asm volatile("s_waitcnt vmcnt(0)" ::: "memory"); SWRITE(0, SE); __syncthreads();
  qkt(pA0, pA1, K_lds, qr, r32, hi); partialSM(pA0, pA1, m_reg, mnA, alA);
  SLOAD(SO, KVBLK); if constexpr (SDEPTH == 2) { if (2 < NT) SLOAD(SE, 2 * KVBLK); }
  SWAIT(); SWRITE(1, SO); __syncthreads();
  for (int j = 1; j + 1 < NT; j += 2) {
    SBAR(); qkt(pB0, pB1, (bf16*)((char*)K_lds + SHM_K), qr, r32, hi);
    finishSM(pA0, pA1, alA, l_reg, pa0, pa1, pa2, pa3); SBAR();
    SLOAD(SO, (j + SDEPTH) * KVBLK); SBAR();
    pv_d0(o, vb0, pa0, pa1, pa2, pa3); partialSM(pB0, pB1, m_reg, mnB, alB);
    __syncthreads(); SWAIT(); SWRITE(0, SE);
    RESC(alB); __syncthreads();
    SBAR(); qkt(pA0, pA1, K_lds, qr, r32, hi);
    finishSM(pB0, pB1, alB, l_reg, pa0, pa1, pa2, pa3); SBAR();
    if (SDEPTH == 1 || j + 3 < NT) SLOAD(SE, (j + 1 + SDEPTH) * KVBLK); SBAR();
    pv_d0(o, vb0 + (int)SHM_V, pa0, pa1, pa2, pa3); partialSM(pA0, pA1, m_reg, mnA, alA);
    __syncthreads(); SWAIT(); SWRITE(1, SO);
    RESC(alA); __syncthreads();
  }
  SBAR(); qkt(pB0, pB1, (bf16*)((char*)K_lds + SHM_K), qr, r32, hi);
  finishSM(pA0, pA1, alA, l_reg, pa0, pa1, pa2, pa3); SBAR();
  pv_d0(o, vb0, pa0, pa1, pa2, pa3); partialSM(pB0, pB1, m_reg, mnB, alB);
  __syncthreads(); RESC(alB);
  finishSM(pB0, pB1, alB, l_reg, pa0, pa1, pa2, pa3); SBAR();
  pv_d0(o, vb0 + (int)SHM_V, pa0, pa1, pa2, pa3);
  if (hi == 0) li_l[r32] = l_reg; asm volatile("s_waitcnt lgkmcnt(0)" ::: "memory");
  float rli[16];
#pragma unroll
  for (int r = 0; r < 16; ++r) rli[r] = __builtin_amdgcn_rcpf(li_l[crow(r, hi)]);
  bf16* Ow = Ob + (long)(wid * QBLK) * LDO;
  { char* stg = lds + SHM_ATTN + wid * (32 * 272);
#pragma unroll
    for (int r = 0; r < 16; ++r) { const int orow = crow(r, hi);
#pragma unroll
      for (int d0 = 0; d0 < 4; ++d0) *(bf16*)(stg + orow * 272 + (d0 * 32 + r32) * 2) = __float2bfloat16(o[d0][r] * rli[r]); }
    asm volatile("s_waitcnt lgkmcnt(0)" ::: "memory");
#pragma unroll
    for (int i = 0; i < 8; ++i) { const int row = i * 4 + (lane >> 4), ch = lane & 15;
      const u32x4 v = *(const u32x4*)(stg + row * 272 + ch * 16);
      *(u32x4*)(Ow + (long)row * LDO + ch * 8) = v; }
  }
#undef SLOAD
#undef SWRITE
#undef SWAIT
#undef RESC
}
#undef KSWZ
#undef SBAR
}
namespace fk {
using pg8::bf16_t; using pg8::f32x4; using pg8::u32x4; using pg8::Unit; using pg8::cvt_pk_bf16;
typedef unsigned u32x2 __attribute__((ext_vector_type(2)));
typedef float f32x16 __attribute__((ext_vector_type(16)));
constexpr int M = 24576, MP = 8192, D = 2048, INW = 17408, DFF = 8192, DEPTH = 4, NWAVES = 8, NCOND = 9;
constexpr int OFF_Q = 0, OFF_K = 2048, OFF_V = 2560, OFF_LX = 3072, OFF_LG = 5120, OFF_CU = 7168, OFF_CV = 9216, OFF_G = 11264;
constexpr int NKVROWS = 26624;
constexpr float EPS = 1e-6f;
constexpr int NPHASE = 3 + 9 * DEPTH;
constexpr int NMODK = 32;
constexpr size_t MiB = 1u << 20;
constexpr size_t WS_CTL = 0, CTL_ZERO_BYTES = 1 * MiB;
constexpr size_t WS_CIN = 1 * MiB  , WS_MODP = 716 * MiB  , WS_MOD = 28 * MiB, WS_ROPE = 30 * MiB, WS_CVSTAT = 31 * MiB, WS_FSTAT = 34 * MiB, WS_AGG = 37 * MiB, WS_WLRU = 49 * MiB, WS_CMW = 51 * MiB;
constexpr size_t WS_WIN = 52 * MiB, WS_WBR = 120 * MiB, WS_WOUT = 144 * MiB, WS_WFF1 = 152 * MiB, WS_WFF2 = 184 * MiB;
constexpr size_t WS_H = 216 * MiB, WS_KALL = 312 * MiB, WS_VALL = 338 * MiB, WS_BR = 364 * MiB, WS_MSCR = 652 * MiB, WS_Z = 716 * MiB, WS_XB = 1532 * MiB  , WS_END = 1628 * MiB;
constexpr size_t WS_FFH = WS_Z, WS_F = WS_Z + 384 * MiB;
constexpr int CW_SPLIT = 2048;
constexpr int CW_BAR = 4096;
constexpr int RING_BYTES = 131072;
constexpr int LRU_XCSZ = 17408, LRU_XCB = 2 * LRU_XCSZ, LRU_HP = 132, LRU_H0 = 4 * LRU_XCSZ, LRU_H1 = LRU_H0 + 64 * LRU_HP * 4;
constexpr int LRU_TAPS = LRU_H1 + 64 * LRU_HP * 4;
constexpr int LRU_GC = LRU_TAPS + 5 * 128 * 4;
static_assert(LRU_GC + 3 * 256 * 4 <= 150528, "lru lds map");
constexpr int LRU_XC = 0, LRU_XC_PITCH = 272, LRU_A0 = 17408, LRU_B0 = LRU_A0 + 32768, LRU_A1 = LRU_B0 + 32768, LRU_B1 = LRU_A1 + 32768, LRU_CARRY = LRU_B1 + 32768;
constexpr int CM_VT = 0, CM_VT_PITCH = 272, CM_RS = 128 * 272;
constexpr int MISC_OFF = 150528, LDS_BYTES = 151552;
static_assert(LRU_CARRY + 2048 <= MISC_OFF, "lds map");

struct Params { const float* in[32]; float* out; unsigned char* ws; int ph_lo, ph_hi, li, pad; };

typedef const __attribute__((address_space(4))) void* kaptr_t;
struct Frame {
    LAS unsigned char* lds;
    int tid, lane, wave, vcu, G, gw, NGW, bx;
    float* out; unsigned char* ws; kaptr_t ka;
    __device__ __forceinline__ float* x() const { return out; }
    __device__ __forceinline__ float* new_k() const { return out + 50331648L; }
    __device__ __forceinline__ float* new_v() const { return out + 50331648L + 16777216L; }
    __device__ __forceinline__ float* new_s() const { return out + 50331648L + 2 * 16777216L; }
#define FK_WSP(name, type, off) __device__ __forceinline__ type* name() const { return (type*)(ws + (off)); }
    FK_WSP(MODP, float, WS_MODP) FK_WSP(MOD, float, WS_MOD) FK_WSP(ROPE, float, WS_ROPE) FK_WSP(CVSTAT, float, WS_CVSTAT) FK_WSP(FSTAT, float, WS_FSTAT) FK_WSP(AGG, float, WS_AGG) FK_WSP(CIN, float, WS_CIN) FK_WSP(MSCR, float, WS_MSCR)
    FK_WSP(WLRU, bf16_t, WS_WLRU) FK_WSP(CMW, bf16_t, WS_CMW) FK_WSP(WIN, bf16_t, WS_WIN) FK_WSP(WBR, bf16_t, WS_WBR) FK_WSP(WOUT, bf16_t, WS_WOUT) FK_WSP(WFF1, bf16_t, WS_WFF1) FK_WSP(WFF2, bf16_t, WS_WFF2)
    FK_WSP(H, bf16_t, WS_H) FK_WSP(KALL, bf16_t, WS_KALL) FK_WSP(VALL, bf16_t, WS_VALL) FK_WSP(BR, bf16_t, WS_BR) FK_WSP(Z, bf16_t, WS_Z) FK_WSP(FFH, bf16_t, WS_FFH) FK_WSP(XB, bf16_t, WS_XB) FK_WSP(Fb, bf16_t, WS_F)
#undef FK_WSP
};
enum { I_XP = 0, I_XS, I_CK, I_CV, I_SL, I_C, I_CCTX, I_WMOD, I_BMOD, I_GPM, I_GPOM, I_GPF, I_GPOF, I_WIN, I_GQ, I_GK, I_WAO, I_CW, I_CB, I_LWA, I_LBA, I_LWX, I_LBX, I_LAM, I_WLO, I_CMG, I_CMWS, I_CMBS, I_WCO, I_WOUT, I_WFF1, I_WFF2 };
template <int I> __device__ __forceinline__ const float* inp(const Frame& F) { const GAS float* r; asm volatile("s_load_dwordx2 %0, %1, %2\n\ts_waitcnt lgkmcnt(0)" : "=s"(r) : "s"(F.ka), "i"(I * 8) : "memory"); return (const float*)r; }


__device__ __forceinline__ Frame phase_frame(const Frame& F) {
    Frame P = F; int t = F.tid; int bx = blockIdx.x; int g = F.G; GAS unsigned char* w = (GAS unsigned char*)F.ws; GAS float* o = (GAS float*)F.out;
    asm volatile("" : "+v"(t)); asm volatile("" : "+s"(bx), "+s"(g), "+s"(w), "+s"(o));
    P.tid = t; P.lane = t & 63; P.wave = __builtin_amdgcn_readfirstlane(t >> 6); P.ws = (unsigned char*)w; P.out = (float*)o; P.bx = bx; P.G = g; P.NGW = g * NWAVES;
    P.vcu = (g % 8 == 0) ? (bx % 8) * (g / 8) + bx / 8 : bx; P.gw = P.vcu * NWAVES + P.wave;
    return P;
}
__device__ __forceinline__ float wave_sum(float v) {
#pragma unroll
    for (int o = 1; o < 64; o <<= 1) v += __shfl_xor(v, o);
    return v;
}
__device__ __forceinline__ float bf2f(unsigned short h) { return __uint_as_float((unsigned)h << 16); }
__device__ __forceinline__ float bflo(unsigned w) { return __uint_as_float(w << 16); }
__device__ __forceinline__ float bfhi(unsigned w) { return __uint_as_float(w & 0xffff0000u); }
__device__ __forceinline__ float fsigm(float x) { return __builtin_amdgcn_rcpf(1.f + __builtin_amdgcn_exp2f(-1.4426950408889634f * x)); }
__device__ __forceinline__ float fgelu(float x) { const float u = x * (1.5957691216057308f + 0.0713548162726009f * x * x); return x * fsigm(u); }

struct CvItem { const float* W; bf16_t* WT; int K, N, row_off, sub; };
struct CvRegs { f32x4 v[8][2]; };
__device__ __forceinline__ void cv_load(CvRegs& R, const CvItem& I, int lane) {
    const int nblk = I.N / 64, kb = I.sub / nblk, nb = I.sub % nblk, k0 = 64 * kb, n0 = 64 * nb;
    const float* src = I.W + (size_t)(k0 + 2 * (lane >> 4)) * I.N + n0 + (lane & 15) * 4;
#pragma unroll
    for (int i = 0; i < 8; ++i) { R.v[i][0] = __builtin_nontemporal_load((const f32x4*)(src + (size_t)(8 * i) * I.N)); R.v[i][1] = __builtin_nontemporal_load((const f32x4*)(src + (size_t)(8 * i + 1) * I.N)); }
}
__device__ __forceinline__ void cv_store(const CvRegs& R, const CvItem& I, LAS unsigned char* scr, int lane) {
    const int nblk = I.N / 64, kb = I.sub / nblk, nb = I.sub % nblk, k0 = 64 * kb, n0 = 64 * nb;
    const int n4 = (lane & 15) * 4, kp = lane >> 4;
#pragma unroll
    for (int i = 0; i < 8; ++i) { const int k = 8 * i + 2 * kp;
#pragma unroll
        for (int j = 0; j < 4; ++j) *(LAS unsigned*)(scr + (n4 + j) * 144 + k * 2) = cvt_pk_bf16(R.v[i][0][j], R.v[i][1][j]); }
    LDS_WAIT(); asm volatile("" ::: "memory");
    const int ch = lane & 7;
#pragma unroll
    for (int j = 0; j < 8; ++j) { const int n = (lane >> 3) + 8 * j;
        const v4u o = *(const LAS v4u*)(scr + n * 144 + ch * 16);
        *(GAS v4u*)(I.WT + (size_t)(I.row_off + n0 + n) * I.K + k0 + 8 * ch) = o; }
    LDS_WAIT(); asm volatile("" ::: "memory");
}
#ifndef CVT_TAIL_ITEMS
#define CVT_TAIL_ITEMS 8192
#endif
__device__ __forceinline__ void convert_layer(const Frame& F, int l, int part, int wid, int NW) {
    LAS unsigned char* scr = F.lds + F.wave * 16384;
    constexpr int I_IN = 32 * 272, I_SQ = 32 * 32, I_F1 = 32 * 128, I_F2 = 128 * 32, I_LRU = 64 * 4;
    constexpr int I_TAIL = CVT_TAIL_ITEMS, I_HEAD = I_IN + 4 * I_SQ + I_F1 + I_F2 - I_TAIL;
    static_assert(I_TAIL <= 4 * I_SQ + I_F1 + I_F2, "tail items");
    const int NITEMS = part ? I_TAIL : I_HEAD + I_LRU;
    const float* w_in = inp<I_WIN>(F) + (size_t)l * D * INW; const float* w_ao = inp<I_WAO>(F) + (size_t)l * D * D; const float* w_lo = inp<I_WLO>(F) + (size_t)l * D * D;
    const float* w_co = inp<I_WCO>(F) + (size_t)l * D * D; const float* w_out = inp<I_WOUT>(F) + (size_t)l * D * D; const float* w_f1 = inp<I_WFF1>(F) + (size_t)l * D * DFF;
    const float* w_f2 = inp<I_WFF2>(F) + (size_t)l * DFF * D; const float* lwa = inp<I_LWA>(F) + (size_t)l * 2 * 16 * 16384; const float* lwx = inp<I_LWX>(F) + (size_t)l * 2 * 16 * 16384;
    bf16_t* WIN = F.WIN(); bf16_t* WBR = F.WBR(); bf16_t* WOUT = F.WOUT(); bf16_t* WFF1 = F.WFF1(); bf16_t* WFF2 = F.WFF2(); bf16_t* WLRU = F.WLRU();
    auto decode = [&](int it) -> CvItem {
        int r = part ? it + I_HEAD : (it < I_HEAD ? it : it + I_TAIL);
        if (r < I_IN) return CvItem{w_in, WIN, D, INW, 0, r}; r -= I_IN;
        if (r < I_SQ) return CvItem{w_ao, WBR, D, D, 0, r}; r -= I_SQ;
        if (r < I_SQ) return CvItem{w_lo, WBR, D, D, D, r}; r -= I_SQ;
        if (r < I_SQ) return CvItem{w_co, WBR, D, D, 2 * D, r}; r -= I_SQ;
        if (r < I_SQ) return CvItem{w_out, WOUT, D, D, 0, r}; r -= I_SQ;
        if (r < I_F1) return CvItem{w_f1, WFF1, D, DFF, 0, r}; r -= I_F1;
        if (r < I_F2) return CvItem{w_f2, WFF2, DFF, D, 0, r}; r -= I_F2;
        const int bi = r >> 2, d = bi >> 5, mat = (bi >> 4) & 1, blk = bi & 15;
        return CvItem{(mat ? lwx : lwa) + ((size_t)d * 16 + blk) * 16384, WLRU + (size_t)bi * 16384, 128, 128, 0, r & 3};
    };
    CvRegs A, B;
    int it = wid;
    if (it < NITEMS) cv_load(A, decode(it), F.lane);
    for (; it < NITEMS; it += 2 * NW) {
#pragma unroll
        for (int half = 0; half < 2; ++half) {
            const int ic = it + half * NW, in = ic + NW;
            if (ic >= NITEMS) break;
            CvRegs& cur = half ? B : A; CvRegs& nxt = half ? A : B;
            if (in < NITEMS) cv_load(nxt, decode(in), F.lane);
            cv_store(cur, decode(ic), scr, F.lane);
        }
    }
    if (part) return;
    const float* cw = inp<I_CMWS>(F) + (size_t)l * 16 * 16384;
    for (int i = (F.gw * 64 + F.lane) * 8; i < 16 * 16384; i += F.NGW * 64 * 8) {
        const f32x4 a = *(const f32x4*)(cw + i), b = *(const f32x4*)(cw + i + 4);
        v4u o; o.x = pk2(a.x, a.y); o.y = pk2(a.z, a.w); o.z = pk2(b.x, b.y); o.w = pk2(b.z, b.w);
        *(v4u*)(F.CMW() + i) = o;
    }
}
__device__ __forceinline__ void mod_partials(const Frame& F) {
    LAS float* scr = (LAS float*)(F.lds + F.wave * 16384);
    const float* cctx = inp<I_CCTX>(F); const float* cc = inp<I_C>(F); const float* wmod = inp<I_WMOD>(F);
    for (int it = F.gw; it < DEPTH * 48 * NMODK; it += F.NGW) {
        const int kc = it % NMODK, jb = (it / NMODK) % 48, l = it / (NMODK * 48), k0 = kc * 64;
        for (int e = F.lane; e < NCOND * 64; e += 64) { const int ci = e >> 6, kk = e & 63; const float v = ci == 0 ? cctx[k0 + kk] : cc[(ci - 1) * D + k0 + kk]; scr[e] = v * (1.f / (1.f + __expf(-v))); }
        LDS_WAIT(); asm volatile("" ::: "memory");
        f32x4 acc[NCOND];
#pragma unroll
        for (int ci = 0; ci < NCOND; ++ci) acc[ci] = (f32x4){0.f, 0.f, 0.f, 0.f};
        const float* wp = wmod + ((size_t)l * D + k0) * 12288 + jb * 256 + F.lane * 4;
#pragma unroll
        for (int kb = 0; kb < 64; kb += 16) {
            f32x4 w[16];
#pragma unroll
            for (int kk = 0; kk < 16; ++kk) w[kk] = *(const f32x4*)(wp + (size_t)(kb + kk) * 12288);
#pragma unroll
            for (int kk = 0; kk < 16; ++kk)
#pragma unroll
                for (int ci = 0; ci < NCOND; ++ci) acc[ci] += w[kk] * scr[ci * 64 + kb + kk];
        }
#pragma unroll
        for (int ci = 0; ci < NCOND; ++ci) *(f32x4*)(F.MODP() + (((size_t)kc * DEPTH + l) * NCOND + ci) * 12288 + jb * 256 + F.lane * 4) = acc[ci];
        LDS_WAIT(); asm volatile("" ::: "memory");
    }
}
__device__ __forceinline__ void mod_reduce(const Frame& F) {
    constexpr int NEL = DEPTH * NCOND * 12288;
    for (int i = (F.gw * 64 + F.lane) * 4; i < NEL; i += F.NGW * 64 * 4) {
        const int l = i / (NCOND * 12288), j = i % 12288;
        f32x4 s = *(const f32x4*)(inp<I_BMOD>(F) + (size_t)l * 12288 + j);
#pragma unroll
        for (int kc = 0; kc < NMODK; ++kc) s += *(const f32x4*)(F.MODP() + (size_t)kc * NEL + i);
        *(f32x4*)(F.MOD() + i) = s;
    }
}
__device__ __forceinline__ void rope_table(const Frame& F) {
    if (F.bx == 0) for (int e = F.tid; e < 2048; e += NWAVES * 64) {
        const int pos = e >> 5, f = e & 31; const float inv = exp2f(-(float)f * (13.287712379549449f / 32.f)); float s, c; sincosf((float)pos * inv, &s, &c);
        F.ROPE()[e] = c; F.ROPE()[2048 + e] = s; }
}
__device__ __forceinline__ u32x4 pack8(const f32x4& a, const f32x4& b) { u32x4 w; w.x = cvt_pk_bf16(a[0], a[1]); w.y = cvt_pk_bf16(a[2], a[3]); w.z = cvt_pk_bf16(b[0], b[1]); w.w = cvt_pk_bf16(b[2], b[3]); return w; }
struct RowIn { f32x4 x[4][2]; u32x4 xb[4]; u32x4 f[4]; float st; };
template <bool XF32, bool HAS_F>
__device__ __forceinline__ void row_load(const Frame& F, RowIn& R, const float* xsrc, const bf16_t* xbsrc, const bf16_t* frow, const float* fstat) {
    if (XF32) {
#pragma unroll
        for (int j = 0; j < 4; ++j) { const int e = (j * 64 + F.lane) * 8; R.x[j][0] = __builtin_nontemporal_load((const f32x4*)(xsrc + e)); R.x[j][1] = __builtin_nontemporal_load((const f32x4*)(xsrc + e + 4)); }
    } else {
#pragma unroll
        for (int j = 0; j < 4; ++j) R.xb[j] = __builtin_nontemporal_load((const u32x4*)(xbsrc + (j * 64 + F.lane) * 8));
    }
    if (HAS_F) {
#pragma unroll
        for (int j = 0; j < 4; ++j) R.f[j] = __builtin_nontemporal_load((const u32x4*)(frow + (j * 64 + F.lane) * 8));
        R.st = F.lane < 32 ? fstat[F.lane] : 0.f;
    }
}
template <bool XF32, bool HAS_F, bool HAS_H, bool OUTF32>
__device__ __forceinline__ void row_apply(const Frame& F, RowIn& R, float* xdst, bf16_t* xbdst, const LAS float* pv, bf16_t* hrow, float gs) {
    if (!XF32) {
#pragma unroll
        for (int j = 0; j < 4; ++j) { const u32x4 w = R.xb[j]; R.x[j][0] = (f32x4){bflo(w.x), bfhi(w.x), bflo(w.y), bfhi(w.y)}; R.x[j][1] = (f32x4){bflo(w.z), bfhi(w.z), bflo(w.w), bfhi(w.w)}; }
    }
    if (HAS_F) {
        const float rs = rsqrtf(wave_sum(R.st) * (1.f / D) + EPS) * gs;
#pragma unroll
        for (int j = 0; j < 4; ++j) { const int e = (j * 64 + F.lane) * 8; const u32x4 fw = R.f[j];
            const f32x4 g0 = *(const LAS f32x4*)(pv + e), g1 = *(const LAS f32x4*)(pv + e + 4), p0 = *(const LAS f32x4*)(pv + 2048 + e), p1 = *(const LAS f32x4*)(pv + 2048 + e + 4);
            const f32x4 f0 = {bflo(fw.x), bfhi(fw.x), bflo(fw.y), bfhi(fw.y)}, f1 = {bflo(fw.z), bfhi(fw.z), bflo(fw.w), bfhi(fw.w)};
            R.x[j][0] += g0 * (f0 * rs * p0); R.x[j][1] += g1 * (f1 * rs * p1); }
    }
    if (OUTF32) {
#pragma unroll
        for (int j = 0; j < 4; ++j) { const int e = (j * 64 + F.lane) * 8; __builtin_nontemporal_store(R.x[j][0], (f32x4*)(xdst + e)); __builtin_nontemporal_store(R.x[j][1], (f32x4*)(xdst + e + 4)); }
    } else {
#pragma unroll
        for (int j = 0; j < 4; ++j) __builtin_nontemporal_store(pack8(R.x[j][0], R.x[j][1]), (u32x4*)(xbdst + (j * 64 + F.lane) * 8));
    }
    if (HAS_H) {
        float ss = 0.f;
#pragma unroll
        for (int j = 0; j < 4; ++j)
#pragma unroll
            for (int h = 0; h < 2; ++h) ss += (R.x[j][h].x * R.x[j][h].x + R.x[j][h].y * R.x[j][h].y) + (R.x[j][h].z * R.x[j][h].z + R.x[j][h].w * R.x[j][h].w);
        const float rs = rsqrtf(wave_sum(ss) * (1.f / D) + EPS);
#pragma unroll
        for (int j = 0; j < 4; ++j) { const int e = (j * 64 + F.lane) * 8;
            f32x4 o[2];
#pragma unroll
            for (int h = 0; h < 2; ++h) { const f32x4 g = *(const LAS f32x4*)(pv + 2 * 2048 + e + 4 * h), s1 = *(const LAS f32x4*)(pv + 3 * 2048 + e + 4 * h), s0 = *(const LAS f32x4*)(pv + 4 * 2048 + e + 4 * h); o[h] = R.x[j][h] * rs * g * (s1 + 1.f) + s0; }
            u32x4 w; w.x = cvt_pk_bf16(o[0].x, o[0].y); w.y = cvt_pk_bf16(o[0].z, o[0].w); w.z = cvt_pk_bf16(o[1].x, o[1].y); w.w = cvt_pk_bf16(o[1].z, o[1].w);
            *(u32x4*)(hrow + e) = w; }
    }
}
__device__ __forceinline__ int cond_of_row(int m) { return m < MP ? 0 : 1 + ((m - MP) >> 11); }
template <int MODE>
__device__ __forceinline__ void rowlocal_phase(const Frame& F, int l, float gs = 1.f) {
    constexpr bool HAS_F = MODE != 0, XF32 = MODE == 0, HAS_H = MODE != 3;
    const float* xp = inp<I_XP>(F); const float* xs = inp<I_XS>(F);
    const float* gpost = MODE == 1 ? inp<I_GPOM>(F) + (size_t)l * D : inp<I_GPOF>(F) + (size_t)l * D;
    const float* gpre = MODE == 0 ? inp<I_GPM>(F) : MODE == 1 ? inp<I_GPF>(F) + (size_t)l * D : inp<I_GPM>(F) + (size_t)(l + 1 < DEPTH ? l + 1 : l) * D;
    float* X = F.x(); bf16_t* XB = F.XB(); const bf16_t* Fb = F.Fb(); const float* FS = F.FSTAT(); bf16_t* H = F.H(); const float* MODb = F.MOD();
    LAS float* pv = (LAS float*)F.lds;
    { const int e = F.tid * 4;
      if (HAS_F) *(LAS f32x4*)(pv + 2048 + e) = *(const f32x4*)(gpost + e);
      if (HAS_H) *(LAS f32x4*)(pv + 2 * 2048 + e) = *(const f32x4*)(gpre + e); }
    constexpr int NITEM = M / 32;
    const int nit = F.bx < NITEM ? (NITEM - F.bx + F.G - 1) / F.G : 0, nq = 4 * nit;
    RowIn A, B;
    auto rowof = [&](int q) -> int { return (F.bx + (q >> 2) * F.G) * 32 + F.wave * 4 + (q & 3); };
    auto src = [&](int m) -> const float* { return m < MP ? xp + (size_t)m * D : xs + (size_t)(m - MP) * D; };
    if (nq > 0) { const int m = rowof(0); row_load<XF32, HAS_F>(F, A, src(m), XB + (size_t)m * D, Fb + (size_t)m * D, FS + (size_t)m * 32); }
    for (int q = 0; q < nq; q += 2) {
#pragma unroll
        for (int half = 0; half < 2; ++half) {
            const int qc = q + half, mc = rowof(qc);
            RowIn& cur = half ? B : A; RowIn& nxt = half ? A : B;
            if (qc + 1 < nq) { const int mn = rowof(qc + 1); row_load<XF32, HAS_F>(F, nxt, src(mn), XB + (size_t)mn * D, Fb + (size_t)mn * D, FS + (size_t)mn * 32); }
            if (half == 0 && (qc & 3) == 0) {
                const int item = F.bx + (qc >> 2) * F.G, ci = item < (MP / 32) ? 0 : 1 + ((item - MP / 32) >> 6), e = F.tid * 4;
                const float* modl = MODb + ((size_t)l * NCOND + ci) * 12288; const float* modn = MODb + ((size_t)(l + 1 < DEPTH ? l + 1 : l) * NCOND + ci) * 12288;
                __syncthreads();
                if (MODE == 1) *(LAS f32x4*)(pv + e) = *(const f32x4*)(modl + 2 * D + e);
                if (MODE >= 2) *(LAS f32x4*)(pv + e) = *(const f32x4*)(modl + 5 * D + e);
                if (MODE == 0) { *(LAS f32x4*)(pv + 3 * 2048 + e) = *(const f32x4*)(modl + 1 * D + e); *(LAS f32x4*)(pv + 4 * 2048 + e) = *(const f32x4*)(modl + 0 * D + e); }
                if (MODE == 1) { *(LAS f32x4*)(pv + 3 * 2048 + e) = *(const f32x4*)(modl + 4 * D + e); *(LAS f32x4*)(pv + 4 * 2048 + e) = *(const f32x4*)(modl + 3 * D + e); }
                if (MODE == 2) { *(LAS f32x4*)(pv + 3 * 2048 + e) = *(const f32x4*)(modn + 1 * D + e); *(LAS f32x4*)(pv + 4 * 2048 + e) = *(const f32x4*)(modn + 0 * D + e); }
                __syncthreads();
            }
            row_apply<XF32, HAS_F, HAS_H, MODE == 3>(F, cur, X + (size_t)mc * D, XB + (size_t)mc * D, pv, H + (size_t)mc * D, gs);
        }
    }
}
typedef float f32x2 __attribute__((ext_vector_type(2)));
__device__ __forceinline__ f32x2 sigm2(f32x2 x) { const f32x2 t = x * -1.4426950408889634f; const f32x2 e = (f32x2){__builtin_amdgcn_exp2f(t.x), __builtin_amdgcn_exp2f(t.y)} + 1.f; return (f32x2){__builtin_amdgcn_rcpf(e.x), __builtin_amdgcn_rcpf(e.y)}; }
__device__ __forceinline__ f32x2 gelu2(f32x2 x) { const f32x2 t = x * ((x * x) * -0.10294324f + -2.3022082f);
    const f32x2 e = (f32x2){__builtin_amdgcn_exp2f(t.x), __builtin_amdgcn_exp2f(t.y)} + 1.f; return x * (f32x2){__builtin_amdgcn_rcpf(e.x), __builtin_amdgcn_rcpf(e.y)}; }
__device__ __forceinline__ f32x4 gelu4(const f32x4& v) { const f32x2 a = gelu2((f32x2){v[0], v[1]}), b = gelu2((f32x2){v[2], v[3]}); return (f32x4){a.x, a.y, b.x, b.y}; }
__device__ __forceinline__ f32x4 sigm4(const f32x4& v) { const f32x2 a = sigm2((f32x2){v[0], v[1]}), b = sigm2((f32x2){v[2], v[3]}); return (f32x4){a.x, a.y, b.x, b.y}; }
__device__ __forceinline__ int kv_row(int m) { return m < MP ? m : MP + ((m - MP) >> 11) * 2304 + ((m - MP) & 2047); }
#ifndef Z_NT
#define Z_NT 0
#endif
#if Z_NT
#define ZSTORE(v, p) __builtin_nontemporal_store((v), (p))
#else
#define ZSTORE(v, p) (*(p) = (v))
#endif
#ifndef GATE_E
#define GATE_E 1
#endif
__device__ __forceinline__ f32x4 eplus4(const f32x4& x) { f32x4 r;
#pragma unroll
    for (int i = 0; i < 4; ++i) r[i] = __builtin_amdgcn_exp2f(__builtin_amdgcn_fmed3f(x[i], -30.f, 30.f) * -1.4426950408889634f) + 1.f;
    return r; }
struct EpiIn {
    static constexpr bool PERM = true, AFTER_DRAIN = false;
    __device__ __forceinline__ static bool keep(const Unit&) { return false; }
    bf16_t* Z; bf16_t* VALL; float* new_v; float* cvstat; int layer;
    __device__ __forceinline__ void operator()(const f32x4 (&acc)[2][2][4][2], const Unit& u, int wr, int wc, int fr, int fq) const {
        const int pn = u.pn, row0 = u.pm * 256 + wr * 64 + fr, cl = wc * 32 + 8 * fq;
        if (pn >= 10 && pn < 12) {
            const int colv = (pn - 10) * 256 + cl;
#pragma unroll
            for (int ai = 0; ai < 2; ++ai)
#pragma unroll
                for (int m = 0; m < 4; ++m) { const int row = row0 + ai * 128 + m * 16; bf16_t* dst = VALL + (size_t)kv_row(row) * 512 + colv;
#pragma unroll
                    for (int bj = 0; bj < 2; ++bj) { *(u32x4*)(dst + bj * 128) = pack8(acc[ai][bj][m][0], acc[ai][bj][m][1]);
                        if (row < MP) { float* nv = new_v + ((size_t)((row >> 8) * DEPTH + layer) * 256 + (row & 255)) * 512 + colv + bj * 128; *(f32x4*)nv = acc[ai][bj][m][0]; *(f32x4*)(nv + 4) = acc[ai][bj][m][1]; } } }
            return;
        }
        const int mode = (pn < 36) ? 0 : (pn < 44) ? 2 : 3;
        const int col0 = pn * 256 + cl;
#pragma unroll
        for (int ai = 0; ai < 2; ++ai)
#pragma unroll
            for (int m = 0; m < 4; ++m) { const int row = row0 + ai * 128 + m * 16; bf16_t* dst = Z + (size_t)row * INW + col0; float ss = 0.f;
#pragma unroll
                for (int bj = 0; bj < 2; ++bj) { f32x4 v0 = acc[ai][bj][m][0], v1 = acc[ai][bj][m][1];
                    if (mode == 1 || mode == 2) { v0 = gelu4(v0); v1 = gelu4(v1); }
#if GATE_E
                    if (mode == 3) { v0 = eplus4(v0); v1 = eplus4(v1); }
#endif
                    if (mode == 2) ss += (v0[0] * v0[0] + v0[1] * v0[1]) + (v0[2] * v0[2] + v0[3] * v0[3]) + (v1[0] * v1[0] + v1[1] * v1[1]) + (v1[2] * v1[2] + v1[3] * v1[3]);
                    ZSTORE(pack8(v0, v1), (u32x4*)(dst + bj * 128)); }
                if (mode == 2) { ss += __shfl_xor(ss, 16); ss += __shfl_xor(ss, 32); if (fq == 0) cvstat[(size_t)row * 32 + (pn - 36) * 4 + wc] = ss; } }
    }
};
struct EpiRelu2 {
    static constexpr bool PERM = true, AFTER_DRAIN = false;
    __device__ __forceinline__ static bool keep(const Unit&) { return false; }
    bf16_t* O; int ldc;
    __device__ __forceinline__ void operator()(const f32x4 (&acc)[2][2][4][2], const Unit& u, int wr, int wc, int fr, int fq) const {
        const int row0 = u.pm * 256 + wr * 64 + fr, col0 = u.pn * 256 + wc * 32 + 8 * fq;
#pragma unroll
        for (int ai = 0; ai < 2; ++ai)
#pragma unroll
            for (int m = 0; m < 4; ++m) { bf16_t* dst = O + (size_t)(row0 + ai * 128 + m * 16) * ldc + col0;
#pragma unroll
                for (int bj = 0; bj < 2; ++bj) { f32x4 v0 = __builtin_elementwise_max(acc[ai][bj][m][0], (f32x4){0.f, 0.f, 0.f, 0.f}), v1 = __builtin_elementwise_max(acc[ai][bj][m][1], (f32x4){0.f, 0.f, 0.f, 0.f});
                    *(u32x4*)(dst + bj * 128) = pack8(v0 * v0, v1 * v1); } }
    }
};
struct EpiF {
    static constexpr bool PERM = true, AFTER_DRAIN = false;
    __device__ __forceinline__ static bool keep(const Unit&) { return false; }
    bf16_t* O; float* stat;
    __device__ __forceinline__ void operator()(const f32x4 (&acc)[2][2][4][2], const Unit& u, int wr, int wc, int fr, int fq) const {
        const int row0 = u.pm * 256 + wr * 64 + fr, col0 = u.pn * 256 + wc * 32 + 8 * fq;
#pragma unroll
        for (int ai = 0; ai < 2; ++ai)
#pragma unroll
            for (int m = 0; m < 4; ++m) { const int row = row0 + ai * 128 + m * 16; bf16_t* dst = O + (size_t)row * D + col0; float ss = 0.f;
#pragma unroll
                for (int bj = 0; bj < 2; ++bj) { const f32x4 v0 = acc[ai][bj][m][0], v1 = acc[ai][bj][m][1];
                    ss += (v0[0] * v0[0] + v0[1] * v0[1]) + (v0[2] * v0[2] + v0[3] * v0[3]) + (v1[0] * v1[0] + v1[1] * v1[1]) + (v1[2] * v1[2] + v1[3] * v1[3]);
                    *(u32x4*)(dst + bj * 128) = pack8(v0, v1); }
                ss += __shfl_xor(ss, 16); ss += __shfl_xor(ss, 32); if (fq == 0) stat[(size_t)row * 32 + u.pn * 4 + wc] = ss; }
    }
};
#if GATE_E
__device__ __forceinline__ f32x4 negexp4(const u32x2& w) { return (f32x4){bflo(w.x), bfhi(w.x), bflo(w.y), bfhi(w.y)}; }
#else
__device__ __forceinline__ f32x4 negexp4(const u32x2& w) {
    const f32x4 x = {bflo(w.x), bfhi(w.x), bflo(w.y), bfhi(w.y)};
    f32x4 r;
#pragma unroll
    for (int i = 0; i < 4; ++i) r[i] = __builtin_amdgcn_exp2f(__builtin_amdgcn_fmed3f(x[i], -30.f, 30.f) * -1.4426950408889634f) + 1.f;
    return r;
}
#endif
__device__ __forceinline__ f32x4 rcp4(const f32x4& v) { return (f32x4){__builtin_amdgcn_rcpf(v[0]), __builtin_amdgcn_rcpf(v[1]), __builtin_amdgcn_rcpf(v[2]), __builtin_amdgcn_rcpf(v[3])}; }
struct EpiMerge {
    static constexpr bool PERM = true, AFTER_DRAIN = false;
    const bf16_t* Z; bf16_t* O;
    __device__ __forceinline__ static bool keep(const Unit& u) { return (u.pn >> 3) < 2; }
    __device__ __forceinline__ void operator()(f32x4 (&acc)[2][2][4][2], const Unit& u, int wr, int wc, int fr, int fq) const {
        const int br = u.pn >> 3, pn = u.pn & 7, pm = u.pm - 96 * br;
        const int rl0 = wr * 64 + fr, cl = wc * 32 + 8 * fq;
        const char* zb = (const char*)(Z + (size_t)(pm * 256) * INW + OFF_G + br * D + pn * 256);
        char* ob = (char*)(O + (size_t)(pm * 256) * D + pn * 256);
        unsigned lz = (unsigned)(rl0 * INW + cl) * 2u, lo = (unsigned)(rl0 * D + cl) * 2u;
        asm volatile("" : "+v"(lz), "+v"(lo));
        const bool last = br == 2;
        u32x4 ga[2][2], gb[2][2];
#pragma unroll
        for (int mm = 0; mm < 2; ++mm)
#pragma unroll
            for (int bj = 0; bj < 2; ++bj) { ga[mm][bj] = *(const u32x4*)(zb + (size_t)((mm * 16) * INW + bj * 128) * 2 + lz); gb[mm][bj] = ga[mm][bj];
                if (!last) gb[mm][bj] = *(const u32x4*)(zb + (size_t)((mm * 16) * INW + bj * 128 + D) * 2 + lz); }
#pragma unroll
        for (int st = 0; st < 4; ++st) {
            const int ai = st >> 1, mh = st & 1;
            u32x4 na[2][2], nb[2][2];
            if (st < 3) {
#pragma unroll
                for (int mm = 0; mm < 2; ++mm)
#pragma unroll
                    for (int bj = 0; bj < 2; ++bj) { const int ro = ((st + 1) >> 1) * 128 + (((st + 1) & 1) * 2 + mm) * 16; na[mm][bj] = *(const u32x4*)(zb + (size_t)(ro * INW + bj * 128) * 2 + lz); nb[mm][bj] = na[mm][bj];
                        if (!last) nb[mm][bj] = *(const u32x4*)(zb + (size_t)(ro * INW + bj * 128 + D) * 2 + lz); }
            }
#pragma unroll
            for (int mm = 0; mm < 2; ++mm)
#pragma unroll
                for (int bj = 0; bj < 2; ++bj) { const int m = mh * 2 + mm, ro = ai * 128 + m * 16; const u32x4 a = ga[mm][bj], b2 = gb[mm][bj];
                    const f32x4 ia0 = rcp4(negexp4((u32x2){a.x, a.y})), ia1 = rcp4(negexp4((u32x2){a.z, a.w}));
                    if (last) *(u32x4*)(ob + (size_t)(ro * D + bj * 128) * 2 + lo) = pack8(acc[ai][bj][m][0] * ia0, acc[ai][bj][m][1] * ia1);
                    else { acc[ai][bj][m][0] *= ia0 * negexp4((u32x2){b2.x, b2.y}); acc[ai][bj][m][1] *= ia1 * negexp4((u32x2){b2.z, b2.w}); } }
            if (st < 3) {
#pragma unroll
                for (int mm = 0; mm < 2; ++mm)
#pragma unroll
                    for (int bj = 0; bj < 2; ++bj) { ga[mm][bj] = na[mm][bj]; gb[mm][bj] = nb[mm][bj]; }
            }
        }
    }
};
struct MergeOrder {
    pg8::StaticOrder so;
    __device__ void init(int G, int c, int wgm) { so.init(M, D, G, c, wgm); }
    __device__ bool next(int i, Unit& u) const { const int br = i % 3; if (!so.next(i / 3, u)) return false; u.pm += 96 * br; u.pn += 8 * br; return true; }
    __device__ __forceinline__ void a_ready(const Unit&) const {}
    __device__ __forceinline__ void done(const Unit&) const {}
};
}
namespace fk {
typedef short bf16x8 __attribute__((ext_vector_type(8)));
struct PrepIn { u32x2 wa[1], wb[1]; f32x4 cs, sn; };
__device__ __forceinline__ void prep_geo(int m, bool& sample, int& b, int& t) { sample = m >= MP; if (!sample) { b = m >> 8; t = m & 255; } else { b = (m - MP) >> 11; t = (m - MP) & 2047; } }
__device__ __forceinline__ void prep_load(const Frame& F, PrepIn& R, int m, const bf16_t* Zb, const float* rope) {
    bool sample; int b, t; prep_geo(m, sample, b, t);
    const int lane = F.lane, j = lane & 7, axis = (lane >> 3) & 1, hsel = lane >> 4, dA = axis * 64 + 4 * j;
    const bf16_t* zrow = Zb + (size_t)m * INW;
    { const int base = OFF_K + hsel * 128 + dA; R.wa[0] = *(const u32x2*)(zrow + base); R.wb[0] = *(const u32x2*)(zrow + base + 32); }
    const int pos = sample ? (axis == 0 ? (t >> 6) : (t & 63)) : 0;
    R.cs = *(const f32x4*)(rope + pos * 32 + 4 * j); R.sn = *(const f32x4*)(rope + 2048 + pos * 32 + 4 * j);
}
__device__ __forceinline__ void prep_apply(const Frame& F, const PrepIn& R, int m, int l, bf16_t* Zb, bf16_t* KALL, float* new_k, const f32x4& gqa, const f32x4& gqb, const f32x4& gka, const f32x4& gkb) {
    bool sample; int b, t; prep_geo(m, sample, b, t);
    const int kvrow = sample ? MP + b * 2304 + t : m;
    const int lane = F.lane, j = lane & 7, axis = (lane >> 3) & 1, hsel = lane >> 4, dA = axis * 64 + 4 * j;
    bf16_t* zrow = Zb + (size_t)m * INW;
    {
        const u32x2 wa = R.wa[0], wb = R.wb[0];
        const f32x4 xa = {bflo(wa.x), bfhi(wa.x), bflo(wa.y), bfhi(wa.y)}, xb = {bflo(wb.x), bfhi(wb.x), bflo(wb.y), bfhi(wb.y)};
        float ss = (xa.x * xa.x + xa.y * xa.y) + (xa.z * xa.z + xa.w * xa.w) + (xb.x * xb.x + xb.y * xb.y) + (xb.z * xb.z + xb.w * xb.w);
        ss += __shfl_xor(ss, 1); ss += __shfl_xor(ss, 2); ss += __shfl_xor(ss, 4); ss += __shfl_xor(ss, 8);
        const float rs = rsqrtf(ss * (1.f / 128.f) + EPS);
        const f32x4 na = xa * rs * gka, nb = xb * rs * gkb;
        const f32x4 ra = na * R.cs - nb * R.sn, rb = na * R.sn + nb * R.cs;
        u32x2 oa, ob; oa.x = cvt_pk_bf16(ra.x, ra.y); oa.y = cvt_pk_bf16(ra.z, ra.w); ob.x = cvt_pk_bf16(rb.x, rb.y); ob.y = cvt_pk_bf16(rb.z, rb.w);
        bf16_t* kd = KALL + (size_t)kvrow * 512 + hsel * 128 + dA; *(u32x2*)kd = oa; *(u32x2*)(kd + 32) = ob;
        if (!sample) { float* nk = new_k + ((size_t)(b * DEPTH + l) * 256 + t) * 512 + hsel * 128 + dA; *(f32x4*)nk = na; *(f32x4*)(nk + 32) = nb; }
    }
}
__device__ __forceinline__ void prep_phase(const Frame& F, int l) {
    {
        bf16_t* Zb = F.Z(); bf16_t* KALL = F.KALL(); float* new_k = F.new_k(); const float* rope = F.ROPE();
        const int j = F.lane & 7, axis = (F.lane >> 3) & 1, dA = axis * 64 + 4 * j, dB = dA + 32;
        const float* gq = inp<I_GQ>(F) + l * 128; const float* gk = inp<I_GK>(F) + l * 128;
        const f32x4 gqa = *(const f32x4*)(gq + dA), gqb = *(const f32x4*)(gq + dB), gka = *(const f32x4*)(gk + dA), gkb = *(const f32x4*)(gk + dB);
        constexpr int NB = 6;
        for (int m = F.gw; m < M; m += NB * F.NGW) {
            PrepIn R[NB];
#pragma unroll
            for (int i = 0; i < NB; ++i) { const int mi = m + i * F.NGW; if (mi < M) prep_load(F, R[i], mi, Zb, rope); }
#pragma unroll
            for (int i = 0; i < NB; ++i) { const int mi = m + i * F.NGW; if (mi < M) prep_apply(F, R[i], mi, l, Zb, KALL, new_k, gqa, gqb, gka, gkb); }
        }
    }
    for (int it = F.gw; it < 2 * 8 * 256; it += 2 * F.NGW) {
        f32x4 a[2], c[2];
#pragma unroll
        for (int i = 0; i < 2; ++i) { const int ii = it + i * F.NGW; if (ii < 2 * 8 * 256) { const int which = ii >> 11, b = (ii >> 8) & 7, p = ii & 255;
            const float* src = (which ? inp<I_CV>(F) : inp<I_CK>(F)) + ((size_t)(b * DEPTH + l) * 256 + p) * 512 + F.lane * 8; a[i] = *(const f32x4*)src; c[i] = *(const f32x4*)(src + 4); } }
#pragma unroll
        for (int i = 0; i < 2; ++i) { const int ii = it + i * F.NGW; if (ii < 2 * 8 * 256) { const int which = ii >> 11, b = (ii >> 8) & 7, p = ii & 255;
            bf16_t* dst = (which ? F.VALL() : F.KALL()) + (size_t)(MP + b * 2304 + 2048 + p) * 512 + F.lane * 8; *(u32x4*)dst = pack8(a[i], c[i]); } }
    }
}
__device__ __forceinline__ int crow(int r, int hi) { return (r & 3) + 8 * (r >> 2) + 4 * hi; }
struct LruCtx {
    bf16x8 bw0[8], bw1[8];
};
__device__ __forceinline__ void lru_ctx_load(const Frame& F, int l, int blk, LruCtx& X) {
    const int lane = F.lane, wave = F.wave, d = wave >> 2, n0 = (wave & 3) * 32, nl = lane & 31, hi = lane >> 5, C = blk * 128 + n0 + nl;
    const bf16_t* wb0 = F.WLRU() + ((size_t)((d * 2 + 0) * 16 + blk) * 128 + n0 + nl) * 128 + hi * 8;
    const bf16_t* wb1 = F.WLRU() + ((size_t)((d * 2 + 1) * 16 + blk) * 128 + n0 + nl) * 128 + hi * 8;
#pragma unroll
    for (int ks = 0; ks < 8; ++ks) { X.bw0[ks] = *(const bf16x8*)(wb0 + ks * 16); X.bw1[ks] = *(const bf16x8*)(wb1 + ks * 16); }
    const float bav = inp<I_LBA>(F)[(size_t)(l * 2 + d) * D + C], bxv = inp<I_LBX>(F)[(size_t)(l * 2 + d) * D + C];
    const float lam = inp<I_LAM>(F)[(size_t)(l * 2 + d) * D + C];
    const float ex = __expf(-lam);
    const float sp = lam < -20.f ? -lam : ex < 0.05f ? ex * (1.f + ex * (-0.5f + ex * ((1.f / 3.f) + ex * (-0.25f + ex * 0.2f)))) : __logf(1.f + ex);
    if (hi == 0) { LAS float* gc = (LAS float*)(F.lds + LRU_GC) + d * 128 + n0 + nl; gc[0] = bav; gc[256] = bxv; gc[512] = -8.f * sp; }
}
struct LruGeo { int m0, b, t0, T; bool sample; };
__device__ __forceinline__ LruGeo lru_geo(int ck) { LruGeo g; g.m0 = ck * 64; g.sample = g.m0 >= MP;
    if (!g.sample) { g.b = g.m0 >> 8; g.t0 = g.m0 & 255; g.T = 256; } else { g.b = (g.m0 - MP) >> 11; g.t0 = (g.m0 - MP) & 2047; g.T = 2048; } return g; }
__device__ __forceinline__ void lru_taps_store(const Frame& F, int l, int blk) {
    const float* cwl = inp<I_CW>(F) + (size_t)l * 4 * D; const float* cbl = inp<I_CB>(F) + (size_t)l * D;
    for (int i = F.tid; i < 5 * 128; i += NWAVES * 64) { const int j = i >> 7, c = i & 127; *(LAS float*)(F.lds + LRU_TAPS + i * 4) = j < 4 ? cwl[(size_t)j * D + blk * 128 + c] : cbl[blk * 128 + c]; }
}
__device__ __forceinline__ void lru_conv_load(const Frame& F, u32x2 (&PF)[11], int t2, int ck, int blk) {
    const LruGeo G = lru_geo(ck); const int C0 = blk * 128; const bf16_t* Zb = F.Z();
    const int c4 = (t2 & 31) * 4, r0 = (t2 >> 5) * 8;
#pragma unroll
    for (int i = 0; i < 11; ++i) {
        const int tt = G.t0 + r0 + i - 2; u32x2 z = {0u, 0u};
        if (tt >= 0 && tt < G.T) z = *(const u32x2*)(Zb + (size_t)(G.m0 + r0 + i - 2) * INW + OFF_LX + C0 + c4);
        PF[i] = z;
    }
}
__device__ __forceinline__ void lru_conv_math(const Frame& F, const u32x2 (&PF)[11], int t2, int xc_off) {
    LAS unsigned char* lds = F.lds + xc_off; const int c4 = (t2 & 31) * 4, r0 = (t2 >> 5) * 8;
    const LAS float* tp = (const LAS float*)(F.lds + LRU_TAPS) + c4;
    const f32x4 w0 = *(const LAS f32x4*)tp, w1 = *(const LAS f32x4*)(tp + 128), w2 = *(const LAS f32x4*)(tp + 256), w3 = *(const LAS f32x4*)(tp + 384), bb = *(const LAS f32x4*)(tp + 512);
    f32x4 zr[11];
#pragma unroll
    for (int i = 0; i < 11; ++i) { const unsigned zx = PF[i].x, zy = PF[i].y; zr[i] = (f32x4){bflo(zx), bfhi(zx), bflo(zy), bfhi(zy)}; }
#pragma unroll
    for (int r = 0; r < 8; ++r) {
        const f32x4 y = bb + zr[r] * w0 + zr[r + 1] * w1 + zr[r + 2] * w2 + zr[r + 3] * w3;
        u32x2 o; o.x = cvt_pk_bf16(y.x, y.y); o.y = cvt_pk_bf16(y.z, y.w);
        *(LAS u32x2*)(lds + LRU_XC + (r0 + r) * LRU_XC_PITCH + c4 * 2) = o;
    }
}
__device__ __forceinline__ void split_arrive(unsigned* cnt) {
    asm volatile("s_waitcnt vmcnt(0)" ::: "memory");
    __syncthreads();
    if (threadIdx.x == 0) { __builtin_amdgcn_fence(__ATOMIC_RELEASE, "agent"); asm volatile("s_waitcnt vmcnt(0)" ::: "memory"); (void)xb_add(cnt, 1u); }
}
__device__ __forceinline__ void split_wait(unsigned* cnt, unsigned G, unsigned* tmo) {
    if (threadIdx.x == 0) {
        unsigned sp = 0;
        while (xb_ld(cnt) < G) { __builtin_amdgcn_s_sleep(1); if ((++sp & 255u) == 0u) { if (xb_ld(tmo)) break; if (sp > XB_SPIN_CAP) { atomicAdd(tmo, 1u); break; } } }
        __builtin_amdgcn_fence(__ATOMIC_ACQUIRE, "agent"); asm volatile("s_waitcnt vmcnt(0)" ::: "memory");
    }
    __syncthreads();
}
#ifndef LRU_PIPE
#define LRU_PIPE 18
#endif
#ifndef LRU_NOGEN
#define LRU_NOGEN 0
#endif
typedef float f32x2g __attribute__((ext_vector_type(2)));
__device__ __forceinline__ f32x16 lru_mfma8(const LAS unsigned char* ap, const bf16x8 (&bw)[8]) {
    f32x16 acc;
#pragma unroll
    for (int r = 0; r < 16; ++r) acc[r] = 0.f;
#pragma unroll
    for (int ks = 0; ks < 8; ++ks) acc = __builtin_amdgcn_mfma_f32_32x32x16_bf16(*(const LAS bf16x8*)(ap + ks * 32), bw[ks], acc, 0, 0, 0);
    return acc;
}
__device__ __forceinline__ void lru_apath(const f32x16& acc0, float bav, float c8, float (&av)[16]) {
#pragma unroll
    for (int r = 0; r < 16; r += 2) {
        const f32x2g pa = (f32x2g){acc0[r], acc0[r + 1]} + bav;
        const f32x2g ta = pa * -1.4426950408889634f;
        const f32x2g ea = (f32x2g){__builtin_amdgcn_exp2f(ta.x), __builtin_amdgcn_exp2f(ta.y)} + 1.f;
        const f32x2g rg = {__builtin_amdgcn_rcpf(ea.x), __builtin_amdgcn_rcpf(ea.y)};
        const f32x2g la = rg * (c8 * 1.4426950408889634f);
        const f32x2g a2 = {__builtin_amdgcn_exp2f(la.x), __builtin_amdgcn_exp2f(la.y)};
        av[r] = a2.x; av[r + 1] = a2.y;
    }
}
__device__ __forceinline__ void lru_xpath(const f32x16& acc1, float bxv, float (&av)[16], const LAS unsigned char* xcp, LAS float* hp, int d, bool first, float& cin_tile) {
    float bv[16];
#pragma unroll
    for (int r = 0; r < 16; r += 2) {
        const f32x2g px = (f32x2g){acc1[r], acc1[r + 1]} + bxv;
        const f32x2g tx = px * -1.4426950408889634f;
        const f32x2g ex = (f32x2g){__builtin_amdgcn_exp2f(tx.x), __builtin_amdgcn_exp2f(tx.y)} + 1.f;
        const f32x2g a2 = {av[r], av[r + 1]};
        f32x2g w = 1.f - a2 * a2;
        w.x = fmaxf(w.x, 1e-30f); w.y = fmaxf(w.y, 1e-30f);
        const f32x2g wq = w * ex * ex;
        const f32x2g sg = w * (f32x2g){__builtin_amdgcn_rsqf(wq.x), __builtin_amdgcn_rsqf(wq.y)};
        const f32x2g xcv = {bf2f(*(const LAS unsigned short*)(xcp + r * LRU_XC_PITCH)), bf2f(*(const LAS unsigned short*)(xcp + (r + 1) * LRU_XC_PITCH))};
        const f32x2g b2 = sg * xcv;
        bv[r] = b2.x; bv[r + 1] = b2.y;
    }
    float h = 0.f, Pp = 1.f;
    if (d == 0) {
#pragma unroll
        for (int r = 0; r < 16; ++r) { h = av[r] * h + bv[r]; Pp *= av[r]; bv[r] = h; av[r] = Pp; }
    } else {
#pragma unroll
        for (int r = 15; r >= 0; --r) { h = av[r] * h + bv[r]; Pp *= av[r]; bv[r] = h; av[r] = Pp; }
    }
    const float Po = __shfl_xor(Pp, 32), Eo = __shfl_xor(h, 32);
    const float P1 = first ? Pp : Po, E1 = first ? h : Eo, P2 = first ? Po : Pp, E2 = first ? Eo : h;
    const float cin = first ? cin_tile : P1 * cin_tile + E1;
#pragma unroll
    for (int r = 0; r < 16; ++r) hp[r * LRU_HP] = bv[r] + av[r] * cin;
    cin_tile = P2 * (P1 * cin_tile + E1) + E2;
}
#if LRU_PIPE
#define LRU_PIPE8() do { _Pragma("unroll") for (int i_ = 0; i_ < 8; ++i_) { __builtin_amdgcn_sched_group_barrier(0x008, 1, 0); __builtin_amdgcn_sched_group_barrier(0x002, LRU_PIPE, 0); } } while (0)
#else
#define LRU_PIPE8() do { } while (0)
#endif
__device__ __forceinline__ float lru_gates(const Frame& F, int lane, int wave, const LruCtx& X, int xc_off, float carry, bool full, const bf16_t* gp, const bf16_t* pq, u32x4 (&gz)[4], u32x4 (&pp)[4]) {
    LAS unsigned char* lds = F.lds;
    const int d = wave >> 2, n0 = (wave & 3) * 32, nl = lane & 31, hi = lane >> 5, c = n0 + nl;
    LAS float* Hd = (LAS float*)(lds + (d ? LRU_H1 : LRU_H0));
    const LAS float* gc = (const LAS float*)(lds + LRU_GC) + d * 128 + c; const float bav = gc[0], bxv = gc[256], c8 = gc[512];
    const int tau = 16 * ((nl >> 2) & 1) + 4 * (nl >> 3) + (nl & 3);
    const bool first = d == 0 ? hi == 0 : hi == 1;
    float cin_tile = carry;
    const int mtA = d ? 1 : 0, mtB = 1 - mtA;
    const LAS unsigned char* apA = lds + xc_off + (mtA * 32 + tau) * LRU_XC_PITCH + hi * 16; const LAS unsigned char* apB = lds + xc_off + (mtB * 32 + tau) * LRU_XC_PITCH + hi * 16;
    const LAS unsigned char* xcA = lds + xc_off + (mtA * 32 + 16 * hi) * LRU_XC_PITCH + c * 2; const LAS unsigned char* xcB = lds + xc_off + (mtB * 32 + 16 * hi) * LRU_XC_PITCH + c * 2;
    LAS float* hA = Hd + (mtA * 32 + 16 * hi) * LRU_HP + c; LAS float* hB = Hd + (mtB * 32 + 16 * hi) * LRU_HP + c;
    float av[16];
    {
        f32x16 g0 = lru_mfma8(apA, X.bw0);
        __builtin_amdgcn_sched_barrier(0);
        f32x16 g1 = lru_mfma8(apA, X.bw1); lru_apath(g0, bav, c8, av); LRU_PIPE8();
        __builtin_amdgcn_sched_barrier(0);
        g0 = lru_mfma8(apB, X.bw0); lru_xpath(g1, bxv, av, xcA, hA, d, first, cin_tile); LRU_PIPE8();
        __builtin_amdgcn_sched_barrier(0);
        g1 = lru_mfma8(apB, X.bw1); lru_apath(g0, bav, c8, av); LRU_PIPE8();
        __builtin_amdgcn_sched_barrier(0);
        if (full) {
#pragma unroll
            for (int i = 0; i < 4; ++i) { gz[i] = *(const u32x4*)(gp + i * 8); pp[i] = *(const u32x4*)(pq + i * 8); }
        }
        lru_xpath(g1, bxv, av, xcB, hB, d, first, cin_tile);
    }
    return cin_tile;
}
__device__ __forceinline__ void lru_out_lite(const Frame& F, int t2, int hsel, int ck, int blk) {
    const int row = t2 >> 2, c32 = (t2 & 3) * 32;
    const LAS float* h = (const LAS float*)(F.lds + (hsel ? LRU_H1 : LRU_H0)) + row * LRU_HP + c32;
    bf16_t* yp = F.BR() + (size_t)1 * M * D + (size_t)(ck * 64 + row) * D + blk * 128 + c32;
#pragma unroll
    for (int i = 0; i < 4; ++i) { const f32x4 a = *(const LAS f32x4*)(h + i * 8), b2 = *(const LAS f32x4*)(h + i * 8 + 4); *(u32x4*)(yp + i * 8) = pack8(a, b2); }
}
__device__ __forceinline__ void lru_out_full(const Frame& F, int t2, int hsel, int ck, int blk, const u32x4 (&gz)[4], const u32x4 (&pp)[4]) {
    const int row = t2 >> 2, c32 = (t2 & 3) * 32;
    const LAS float* h = (const LAS float*)(F.lds + (hsel ? LRU_H1 : LRU_H0)) + row * LRU_HP + c32;
    bf16_t* yp = F.BR() + (size_t)1 * M * D + (size_t)(ck * 64 + row) * D + blk * 128 + c32;
#pragma unroll
    for (int i = 0; i < 4; ++i) {
        const f32x4 a = *(const LAS f32x4*)(h + i * 8), b2 = *(const LAS f32x4*)(h + i * 8 + 4);
        const f32x4 g0 = gelu4((f32x4){bflo(gz[i].x), bfhi(gz[i].x), bflo(gz[i].y), bfhi(gz[i].y)}), g1 = gelu4((f32x4){bflo(gz[i].z), bfhi(gz[i].z), bflo(gz[i].w), bfhi(gz[i].w)});
        const f32x4 p0 = {bflo(pp[i].x), bfhi(pp[i].x), bflo(pp[i].y), bfhi(pp[i].y)}, p1 = {bflo(pp[i].z), bfhi(pp[i].z), bflo(pp[i].w), bfhi(pp[i].w)};
        *(u32x4*)(yp + i * 8) = pack8((a + p0) * g0, (b2 + p1) * g1);
    }
}
__device__ __forceinline__ void lru_chain(const Frame& F, int l, const LruCtx& X, int ck0, int N, bool sample, int b, int blk) {
    int tid0 = F.tid; asm volatile("" : "+v"(tid0));
    const int g0 = __builtin_amdgcn_readfirstlane(tid0 >> 8), C0 = blk * 128 + ((tid0 >> 6) & 3) * 32 + (tid0 & 31);
    float carry = 0.f;
    if (sample) carry = inp<I_SL>(F)[((size_t)(b * DEPTH + l) * 2 + g0) * D + C0];
    u32x2 PF[11];
    { u32x2 P0[11]; lru_conv_load(F, P0, tid0 & 255, ck0 + (g0 ? N - 1 : 0), blk); lru_conv_math(F, P0, tid0 & 255, g0 ? LRU_XCB : 0); }
    lru_conv_load(F, PF, tid0 & 255, ck0 + (g0 ? N - 2 : 1), blk);
    __syncthreads();
    for (int s = 0, par = 0; s < N; ++s, par ^= 1) {
        int tid_ = F.tid; asm volatile("" : "+v"(tid_));
        const int tid = tid_, lane = tid & 63, wave = __builtin_amdgcn_readfirstlane(tid >> 6), g = wave >> 2, t2 = tid & 255;
        const int xb = g ? LRU_XCB : 0;
        const int cj = g ? N - 1 - s : s, co = g ? s : N - 1 - s;
        const bool full = s >= (N >> 1);
        u32x4 gz[4] = {{0u, 0u, 0u, 0u}, {0u, 0u, 0u, 0u}, {0u, 0u, 0u, 0u}, {0u, 0u, 0u, 0u}}, pp[4] = {{0u, 0u, 0u, 0u}, {0u, 0u, 0u, 0u}, {0u, 0u, 0u, 0u}, {0u, 0u, 0u, 0u}};
        const size_t mrow = (size_t)((ck0 + cj) * 64 + (t2 >> 2)); const int cc = blk * 128 + (t2 & 3) * 32;
        const bf16_t* gp = F.Z() + mrow * INW + OFF_LG + cc; const bf16_t* pq = F.BR() + (size_t)1 * M * D + mrow * D + cc;
        if (s + 1 < N) lru_conv_math(F, PF, t2, xb + (par ^ 1) * LRU_XCSZ);
        if (s + 2 < N) lru_conv_load(F, PF, t2, ck0 + (g ? N - 3 - s : s + 2), blk);
        carry = lru_gates(F, lane, wave, X, xb + par * LRU_XCSZ, carry, full, gp, pq, gz, pp);
        __syncthreads();
        if (full) lru_out_full(F, t2, g, ck0 + cj, blk, gz, pp); else lru_out_lite(F, t2, 1 - g, ck0 + co, blk);
        __syncthreads();
    }
    if (!sample && (tid0 & 32) == 0) F.new_s()[((size_t)(b * DEPTH + l) * 2 + g0) * D + C0] = carry;
}
#ifndef LRU_CM_N1
#define LRU_CM_N1 3
#endif
__device__ __forceinline__ void lru_chain_phase(const Frame& F, int l) {
    LruCtx X; int cur = -1;
    const bool fast = F.G == 256; const int grp = F.bx >> 4;
    for (int k = 0; ; ++k) {
        int id;
        if (fast) { if (k >= (grp < 8 ? 1 : 4)) break; id = grp < 8 ? F.bx : 128 + ((grp - 8) * 4 + k) * 16 + (F.bx & 15); }
        else { id = F.bx + k * F.G; if (id >= 640) break; }
        const int blk = id & 15; const bool sample = id < 128; const int b = sample ? id >> 4 : (id - 128) >> 4;
        if (blk != cur) { lru_ctx_load(F, l, blk, X); lru_taps_store(F, l, blk); cur = blk; __syncthreads(); }
        lru_chain(F, l, X, sample ? 128 + b * 32 : b * 4, sample ? 32 : 4, sample, b, blk);
    }
}
constexpr int CM_V = 0, CM_OUT = 32768, CM_OUT_PITCH = 528, CM_RS2 = CM_OUT + 128 * CM_OUT_PITCH;
static_assert(CM_RS2 + 512 <= MISC_OFF, "cm lds map");
struct CmCtx { bf16x8 wa[8]; f32x4 ga, gb; };
__device__ __forceinline__ void cm_ctx_load(const Frame& F, int g, CmCtx& X, const float* __restrict__ cmg) {
    const int qt = F.wave & 3, xl = F.lane & 31, hi = F.lane >> 5;
    const bf16_t* wp = F.CMW() + ((size_t)g * 128 + qt * 32 + xl) * 128 + hi * 8;
#pragma unroll
    for (int i = 0; i < 8; ++i) X.wa[i] = *(const bf16x8*)(wp + i * 16);
    const int sc = (F.tid & 15) * 8;
    X.ga = *(const f32x4*)(cmg + g * 128 + sc); X.gb = *(const f32x4*)(cmg + g * 128 + sc + 4);
}
struct CmPre { u32x4 v[4]; float2 st[4]; };
__device__ __forceinline__ void cm_prefetch(const Frame& F, CmPre& R, int tid, int cn, int g) {
    const int sr = tid >> 4, q16 = tid & 15, sc = q16 * 8, m0 = cn * 128;
    const bf16_t* Zb = F.Z(); const float* ST = F.CVSTAT();
#pragma unroll
    for (int i = 0; i < 4; ++i) { const int p = (i >> 1) * 64 + (i & 1) * 32 + sr;
        R.v[i] = *(const u32x4*)(Zb + (size_t)(m0 + p) * INW + OFF_CV + g * 128 + sc);
        R.st[i] = *(const float2*)(ST + (size_t)(m0 + p) * 32 + q16 * 2); }
}
__device__ __forceinline__ void cm_stage(const Frame& F, const CmPre& R, const CmCtx& X, int tid) {
    LAS unsigned char* lds = F.lds; const int sr = tid >> 4, sc = (tid & 15) * 8;
#pragma unroll
    for (int i = 0; i < 4; ++i) {
        float s = R.st[i].x + R.st[i].y;
        s += __shfl_xor(s, 1); s += __shfl_xor(s, 2); s += __shfl_xor(s, 4); s += __shfl_xor(s, 8);
        const float rs = rsqrtf(s * (1.f / D) + EPS);
        const u32x4 w = R.v[i];
        const f32x4 v0 = (f32x4){bflo(w.x), bfhi(w.x), bflo(w.y), bfhi(w.y)} * X.ga * rs, v1 = (f32x4){bflo(w.z), bfhi(w.z), bflo(w.w), bfhi(w.w)} * X.gb * rs;
        *(LAS u32x4*)(lds + CM_V + (i >> 1) * 16384 + att::v_st((i & 1) * 32 + sr, sc)) = pack8(v0, v1);
    }
}
__device__ __forceinline__ void cm_mfma(const Frame& F, const CmCtx& X, int lane, int wave) {
    LAS unsigned char* lds = F.lds;
    const int qt = wave & 3, chh = wave >> 2, xl = lane & 31, hi = lane >> 5;
    f32x16 o0, o1;
#pragma unroll
    for (int r = 0; r < 16; ++r) { o0[r] = 0.f; o1[r] = 0.f; }
    const int vb = (int)(unsigned)(uintptr_t)(lds + CM_V) + att::v_rd_base(lane);
    if (chh == 0) {
        att::pv_one<0>(o0, vb, X.wa[0], X.wa[1], X.wa[2], X.wa[3]); att::pv_one<1>(o1, vb, X.wa[0], X.wa[1], X.wa[2], X.wa[3]);
        att::pv_one<0>(o0, vb + 16384, X.wa[4], X.wa[5], X.wa[6], X.wa[7]); att::pv_one<1>(o1, vb + 16384, X.wa[4], X.wa[5], X.wa[6], X.wa[7]);
    } else {
        att::pv_one<2>(o0, vb, X.wa[0], X.wa[1], X.wa[2], X.wa[3]); att::pv_one<3>(o1, vb, X.wa[0], X.wa[1], X.wa[2], X.wa[3]);
        att::pv_one<2>(o0, vb + 16384, X.wa[4], X.wa[5], X.wa[6], X.wa[7]); att::pv_one<3>(o1, vb + 16384, X.wa[4], X.wa[5], X.wa[6], X.wa[7]);
    }
#pragma unroll
    for (int r = 0; r < 16; ++r) { const int q = qt * 32 + crow(r, hi);
        *(LAS float*)(lds + CM_OUT + q * CM_OUT_PITCH + (chh * 64 + xl) * 4) = o0[r];
        *(LAS float*)(lds + CM_OUT + q * CM_OUT_PITCH + (chh * 64 + 32 + xl) * 4) = o1[r]; }
}
__device__ __forceinline__ void cm_epilogue(const Frame& F, int tid, int cn, int g, const float* __restrict__ bsg, const u32x4 (&uw)[4]) {
    LAS unsigned char* lds = F.lds; const int q = tid >> 2, c32 = (tid & 3) * 32, m0 = cn * 128; const float bias = bsg[q];
    bf16_t* op = F.BR() + (size_t)2 * M * D + (size_t)(m0 + q) * D + g * 128 + c32;
#pragma unroll
    for (int i = 0; i < 4; ++i) {
        const f32x4 a = *(const LAS f32x4*)(lds + CM_OUT + q * CM_OUT_PITCH + (c32 + i * 8) * 4), b2 = *(const LAS f32x4*)(lds + CM_OUT + q * CM_OUT_PITCH + (c32 + i * 8 + 4) * 4);
        const f32x4 u0 = gelu4((f32x4){bflo(uw[i].x), bfhi(uw[i].x), bflo(uw[i].y), bfhi(uw[i].y)}), u1 = gelu4((f32x4){bflo(uw[i].z), bfhi(uw[i].z), bflo(uw[i].w), bfhi(uw[i].w)});
        *(u32x4*)(op + i * 8) = pack8(u0 * (a + bias), u1 * (b2 + bias));
    }
}
__device__ __forceinline__ bool cm_unit(const Frame& F, int i, int& cn, int& g) {
    if (F.G == 256) {
        const int grp = F.bx >> 4; g = F.bx & 15;
        if (grp < 8) { cn = grp + 8 * i; return i < LRU_CM_N1; }
        cn = 8 * LRU_CM_N1 + (grp - 8) + 8 * i; return i < 24 - LRU_CM_N1;
    }
    const int u = F.bx + i * F.G; cn = u >> 4; g = u & 15; return u < 192 * 16;
}
__device__ __forceinline__ void cm_phase(const Frame& F, int l) {
    CmCtx X; int cur = -1;
    const float* cmg = inp<I_CMG>(F) + (size_t)l * D; const float* bs = inp<I_CMBS>(F) + (size_t)l * 16 * 128;
    int cn, g;
    bool have = cm_unit(F, 0, cn, g);
    if (have) { cm_ctx_load(F, g, X, cmg); cur = g; CmPre R; cm_prefetch(F, R, F.tid, cn, g); cm_stage(F, R, X, F.tid); }
    __syncthreads();
    for (int i = 0; have; ++i) {
        int tid_ = F.tid; asm volatile("" : "+v"(tid_));
        const int tid = tid_, lane = tid & 63, wave = __builtin_amdgcn_readfirstlane(tid >> 6);
        int cnn, gn; const bool nxt = cm_unit(F, i + 1, cnn, gn);
        CmPre R;
        if (nxt) cm_prefetch(F, R, tid, cnn, gn);
        u32x4 uw[4];
        { const bf16_t* up = F.Z() + (size_t)(cn * 128 + (tid >> 2)) * INW + OFF_CU + g * 128 + (tid & 3) * 32;
#pragma unroll
          for (int i2 = 0; i2 < 4; ++i2) uw[i2] = *(const u32x4*)(up + i2 * 8); }
        cm_mfma(F, X, lane, wave);
        __syncthreads();
        cm_epilogue(F, tid, cn, g, bs + g * 128, uw);
        if (nxt) { if (gn != cur) { cm_ctx_load(F, gn, X, cmg); cur = gn; } cm_stage(F, R, X, tid); }
        __syncthreads();
        have = nxt; cn = cnn; g = gn;
    }
}
__device__ __forceinline__ void attn_phase(const Frame& F, int l) {
    char* lds = (char*)F.lds;
    const float* gq = inp<I_GQ>(F) + l * 128; const float* rope = F.ROPE();
    const att::bf16* Z = (const att::bf16*)F.Z(); const att::bf16* K = (const att::bf16*)F.KALL(); const att::bf16* V = (const att::bf16*)F.VALL(); att::bf16* O = (att::bf16*)F.BR();
    for (int id = F.vcu; id < 1536; id += F.G) {
        size_t qrow, kvrow; int h, nkeys, t0;
        if (id < 1024) { const int qb = id & 7, b = id >> 7; h = (id >> 3) & 15; qrow = (size_t)MP + (size_t)b * 2048 + qb * 256; kvrow = (size_t)MP + (size_t)b * 2304; nkeys = 2304; t0 = qb * 256; }
        else { const int id2 = id - 1024, b = id2 >> 4; h = id2 & 15; qrow = (size_t)b * 256; kvrow = qrow; nkeys = 256; t0 = 0; }
        att::attn_dense_body<att::bf16>(Z + qrow * INW + OFF_Q + h * 128, K + kvrow * 512 + (h >> 2) * 128, V + kvrow * 512 + (h >> 2) * 128, O + qrow * D + h * 128, nkeys, lds, gq, id < 1024 ? rope : (const float*)nullptr, t0);
    }
    __syncthreads();
}
}
#ifndef REP_G
#define REP_G 1
#endif
#ifndef REP_A
#define REP_A 1
#endif
#ifndef REP_L
#define REP_L 1
#endif
#ifndef REP_V
#define REP_V 1
#endif
#ifndef REP_R
#define REP_R 1
#endif
#ifndef REP_GSEL
#define REP_GSEL 0
#endif
#ifndef REP_B
#define REP_B 1
#endif
#ifndef PG_ALIGN
#define PG_ALIGN true
#endif
#ifndef PG_SP2
#define PG_SP2 true
#endif
#ifndef WGM_IN
#define WGM_IN 4
#endif
#ifndef WGM_N8
#define WGM_N8 4
#endif
#ifndef WGM_F1
#define WGM_F1 4
#endif
#ifndef WGM_F2
#define WGM_F2 4
#endif
#ifndef WGM_MG
#define WGM_MG 4
#endif
#ifndef STAMP_SEL
#define STAMP_SEL 0
#endif
#ifndef STAMP_Q
#define STAMP_Q 20000
#endif
#ifndef REP_C
#define REP_C 1
#endif
namespace fk {
#if REP_G > 1 || REP_GSEL > 0
template <class Base> struct RepOrder {
    Base b; int n;
    __device__ void init_n() { Unit u; n = 0; while (b.next(n, u)) ++n; }
    __device__ bool next(int i, Unit& u) const { if (i >= 2 * n) return false; return b.next(i >= n ? i - n : i, u); }
    __device__ __forceinline__ void a_ready(const Unit&) const {}
    __device__ __forceinline__ void done(const Unit&) const {}
};
#define GEMM_REP(EPI, ORD, g, S, E) do { RepOrder<ORD> RS_; RS_.b = S; RS_.init_n(); pg8::gemm_phase<EPI, RepOrder<ORD>, PG_ALIGN, PG_SP2>(P.lds, g, RS_, E); } while (0)
#endif
#define GEMM_ONE(EPI, ORD, g, S, E) pg8::gemm_phase<EPI, ORD, PG_ALIGN, PG_SP2>(P.lds, g, S, E)
#if REP_G > 1
#define GEMM_CALL(ID, EPI, ORD, g, S, E) GEMM_REP(EPI, ORD, g, S, E)
#elif REP_GSEL > 0
#define GEMM_CALL(ID, EPI, ORD, g, S, E) do { if (ID == REP_GSEL) GEMM_REP(EPI, ORD, g, S, E); else GEMM_ONE(EPI, ORD, g, S, E); } while (0)
#else
#define GEMM_CALL(ID, EPI, ORD, g, S, E) GEMM_ONE(EPI, ORD, g, S, E)
#endif
__global__ void __launch_bounds__(NWAVES * 64, 2) mega(Params p) {
    extern __shared__ __attribute__((aligned(16))) unsigned char lds_raw[];
    Frame F;
    F.lds = (LAS unsigned char*)lds_raw;
    F.tid = threadIdx.x; F.lane = F.tid & 63; F.wave = __builtin_amdgcn_readfirstlane(F.tid >> 6);
    F.G = gridDim.x; { const int bx = blockIdx.x; F.vcu = (F.G % 8 == 0) ? (bx % 8) * (F.G / 8) + bx / 8 : bx; }
    F.gw = F.vcu * NWAVES + F.wave; F.NGW = F.G * NWAVES; F.bx = blockIdx.x;
    F.out = p.out; F.ws = p.ws; F.ka = (kaptr_t)__builtin_amdgcn_kernarg_segment_ptr();
    unsigned char* ws = p.ws;
    volatile LAS unsigned* MISC = (volatile LAS unsigned*)(F.lds + MISC_OFF);
    for (int u = F.tid; u < (LDS_BYTES - MISC_OFF) / 4; u += NWAVES * 64) ((LAS unsigned*)(F.lds + MISC_OFF))[u] = 0u;
    __syncthreads();
    unsigned* barw = (unsigned*)(ws + WS_CTL) + CW_BAR + p.li * XCD_BAR_WORDS;
    XcdBarrier bar = xcd_barrier_post(barw, MISC + 8);
    const int lo = p.ph_lo, hi = p.ph_hi;
    unsigned long long bar_ticks = 0;
#define IN_PH(k) (lo <= (k) && (k) < hi)
#if REP_B > 1
#define SEAM(k) do { if ((k) + 1 < hi) { xcd_barrier(bar); xcd_barrier(bar); } } while (0)
#else
#if defined(STAMP_BLOCK)
#define SEAM(k) do { if ((k) + 1 < hi) { const unsigned long long t0_ = __builtin_amdgcn_s_memrealtime(); xcd_barrier(bar); const int kk_ = ((k) - 3) % 9; const bool isg_ = (k) >= 3 && (kk_ == 0 || kk_ == 3 || kk_ == 4 || kk_ == 6 || kk_ == 7); if (STAMP_SEL == 0 || (STAMP_SEL == 1 && isg_) || (STAMP_SEL == 2 && !isg_)) bar_ticks += __builtin_amdgcn_s_memrealtime() - t0_; } } while (0)
#else
#define SEAM(k) do { if ((k) + 1 < hi) xcd_barrier(bar); } while (0)
#endif
#endif

    if (IN_PH(0)) { const Frame P = phase_frame(F);
convert_layer(P, 0, 0, P.gw, P.NGW); mod_partials(P); rope_table(P);
#if REP_V > 1
        __syncthreads(); convert_layer(P, 0, 0, P.gw, P.NGW); mod_partials(P);
#endif
 SEAM(0); }
    if (IN_PH(1)) { const Frame P = phase_frame(F); mod_reduce(P); SEAM(1); }
    if (IN_PH(2)) { const Frame P = phase_frame(F); rowlocal_phase<0>(P, 0); SEAM(2); }
    for (int l = 0; l < DEPTH; ++l) {
        const int pb = 3 + 9 * l;
        if (IN_PH(pb + 0)) { const Frame P = phase_frame(F);
            pg8::Gemm g{P.H(), P.WIN(), M, INW, D}; pg8::StaticOrder S; S.init(M, INW, P.G, P.bx, WGM_IN);
            EpiIn E{P.Z(), P.VALL(), P.new_v(), P.CVSTAT(), l};

GEMM_CALL(1, EpiIn, pg8::StaticOrder, g, S, E);
            {
                const int rem = ((M / 256) * (INW / 256)) % P.G;
                __syncthreads();
                if (rem == 0 || P.bx >= rem) convert_layer(P, l, 1, rem == 0 ? P.gw : (P.bx - rem) * NWAVES + P.wave, rem == 0 ? P.NGW : (P.G - rem) * NWAVES);
            }
            SEAM(pb + 0);
        }
        if (IN_PH(pb + 1)) { const Frame P = phase_frame(F);
            lru_chain_phase(P, l);
#if REP_L > 1
            lru_chain_phase(P, l);
#endif
            prep_phase(P, l);
            __syncthreads();
            cm_phase(P, l);
#if REP_C > 1
            cm_phase(P, l);
#endif
            SEAM(pb + 1);
        }
        if (IN_PH(pb + 2)) { const Frame P = phase_frame(F);
            attn_phase(P, l);
#if REP_A > 1
            attn_phase(P, l);
#endif
            SEAM(pb + 2);
        }
        if (IN_PH(pb + 3)) { const Frame P = phase_frame(F);
            pg8::Gemm g{P.BR(), P.WBR(), 3 * M, 3 * D, D}; MergeOrder S; S.init(P.G, P.bx, WGM_MG);
            EpiMerge E{P.Z(), P.H()};

GEMM_CALL(2, EpiMerge, MergeOrder, g, S, E);

            SEAM(pb + 3);
        }
        if (IN_PH(pb + 4)) { const Frame P = phase_frame(F);
            pg8::Gemm g{P.H(), P.WOUT(), M, D, D}; pg8::StaticOrder S; S.init(M, D, P.G, P.bx, WGM_N8);
            EpiF E{P.Fb(), P.FSTAT()};

GEMM_CALL(3, EpiF, pg8::StaticOrder, g, S, E);
            SEAM(pb + 4);

        }
        if (IN_PH(pb + 5)) { const Frame P = phase_frame(F);

#if REP_R > 1
            rowlocal_phase<1>(P, l, 0.f);
#endif
            rowlocal_phase<1>(P, l);
 SEAM(pb + 5); }
        if (IN_PH(pb + 6)) { const Frame P = phase_frame(F);
            pg8::Gemm g{P.H(), P.WFF1(), M, DFF, D}; pg8::StaticOrder S; S.init(M, DFF, P.G, P.bx, WGM_F1);
            EpiRelu2 E{P.FFH(), DFF};

GEMM_CALL(4, EpiRelu2, pg8::StaticOrder, g, S, E);

            SEAM(pb + 6);
        }
        if (IN_PH(pb + 7)) { const Frame P = phase_frame(F);
            pg8::Gemm g{P.FFH(), P.WFF2(), M, D, DFF}; pg8::StaticOrder S; S.init(M, D, P.G, P.bx, WGM_F2);
            EpiF E{P.Fb(), P.FSTAT()};

GEMM_CALL(5, EpiF, pg8::StaticOrder, g, S, E);
            SEAM(pb + 7);

        }
        if (IN_PH(pb + 8)) { const Frame P = phase_frame(F);


#if REP_R > 1
            if (l + 1 < DEPTH) rowlocal_phase<2>(P, l, 0.f);
#endif
            if (l + 1 < DEPTH) rowlocal_phase<2>(P, l); else rowlocal_phase<3>(P, l);


if (l + 1 < DEPTH) { __syncthreads(); convert_layer(P, l + 1, 0, P.gw, P.NGW); }
#if REP_V > 1
            if (l + 1 < DEPTH) { __syncthreads(); convert_layer(P, l + 1, 0, P.gw, P.NGW); }
#endif

            SEAM(pb + 8);
        }
    }
#if defined(STAMP_BLOCK)
    if ((int)blockIdx.x == STAMP_BLOCK && threadIdx.x == 0) { __builtin_amdgcn_s_waitcnt(0); p.out[(size_t)STAMP_BLOCK * 32 * 2048] = (float)(((bar_ticks + STAMP_Q / 2) / STAMP_Q) * STAMP_Q); }
#endif
#undef IN_PH
#undef SEAM
}
}
extern "C" void kernel_launch(void* const* d_in, const int* in_sizes, int n_in, void* d_out, int out_size, void* d_ws, size_t ws_size, hipStream_t stream) {
    static int grid = 0;
    if (grid == 0) {
        if (n_in != 32 || out_size != 84410368 || ws_size < fk::WS_END) { fprintf(stderr, "kernel_launch: unexpected shapes: n_in %d out %d ws %zu (need %zu)\n", n_in, out_size, ws_size, (size_t)fk::WS_END); grid = -1; return; }
        int dev = 0, cus = 0;
        if (hipGetDevice(&dev) != hipSuccess || hipDeviceGetAttribute(&cus, hipDeviceAttributeMultiprocessorCount, dev) != hipSuccess) { grid = -1; return; }
        if (hipFuncSetAttribute((const void*)fk::mega, hipFuncAttributeMaxDynamicSharedMemorySize, fk::LDS_BYTES) != hipSuccess) { fprintf(stderr, "kernel_launch: hipFuncSetAttribute failed\n"); grid = -1; return; }
        int per_cu = 0;
        if (hipOccupancyMaxActiveBlocksPerMultiprocessor(&per_cu, (const void*)fk::mega, fk::NWAVES * 64, fk::LDS_BYTES) != hipSuccess || per_cu < 1) fprintf(stderr, "kernel_launch: occupancy query says %d blocks per CU\n", per_cu);
        (void)hipGetLastError();
        grid = cus < 256 ? cus : 256;
    }
    if (grid < 0) return;
    (void)hipMemsetAsync((char*)d_ws + fk::WS_CTL, 0, fk::CTL_ZERO_BYTES, stream);
    fk::Params p{};
    for (int i = 0; i < 32; ++i) p.in[i] = (const float*)d_in[i];
    p.out = (float*)d_out; p.ws = (unsigned char*)d_ws; p.ph_lo = 0; p.ph_hi = fk::NPHASE; p.li = 0; p.pad = 0;
    hipLaunchKernelGGL(fk::mega, dim3(grid), dim3(fk::NWAVES * 64), fk::LDS_BYTES, stream, p);
}
```
